# Optimizing an MI355X kernel written in HIP

```python
import jax, jax.numpy as jnp
from jax import lax
import numpy as np

D_MODEL = 1024
BATCH = 2
SEQ = 8192
DEPTH = 2

MEM_LEN = 256
MIX_WIDTH = D_MODEL
HG_WIDTH = MIX_WIDTH // 2
HG_HEADS = 4
HG_DK = HG_WIDTH // HG_HEADS
HG_DV = HG_WIDTH // HG_HEADS
HG_CHUNK = 64
ATT_WIDTH = MIX_WIDTH - HG_WIDTH
ATT_HEADS = 8
ATT_DH = ATT_WIDTH // ATT_HEADS
DILATED_PATTERNS = ((128, 1), (512, 4), (2048, 16))
ROPE_THETA = 10000.0
X_HEADS = 4
X_DH = D_MODEL // X_HEADS
N_GROUPS = 4
EXPERTS_PER_GROUP = 4
N_EXPERTS = N_GROUPS * EXPERTS_PER_GROUP
TOP_K_IN_GROUP = 2
EXPERT_FF = 512
NORM_EPS = 1e-6
IN_PROJ_WIDTH = 4 * HG_WIDTH + 3 * ATT_WIDTH
IN_SPLITS = (HG_WIDTH, 2 * HG_WIDTH, 3 * HG_WIDTH, 4 * HG_WIDTH,
             4 * HG_WIDTH + ATT_WIDTH, 4 * HG_WIDTH + 2 * ATT_WIDTH)

kernel_name = 'hybrid_hgrn2_dilated_attn_hmoe'

F32 = jnp.float32


def rms_norm(x, g):
    xf = x.astype(F32)
    y = xf * lax.rsqrt(jnp.mean(xf * xf, axis=-1, keepdims=True) + NORM_EPS)
    return (y * g.astype(F32)).astype(x.dtype)


def rope(t, positions):
    dh = t.shape[-1]
    inv = ROPE_THETA ** (-jnp.arange(0, dh, 2, dtype=F32) / dh)
    ang = positions.astype(F32)[:, None, :, None] * inv
    cos, sin = jnp.cos(ang), jnp.sin(ang)
    t1, t2 = jnp.split(t, 2, axis=-1)
    return jnp.concatenate([t1 * cos - t2 * sin, t2 * cos + t1 * sin], axis=-1)


def chunked_gated_recurrence(q, k, v, logf):
    B, H, S, dk = q.shape
    dv = v.shape[-1]
    nc = S // HG_CHUNK

    def chunks(t):
        return t.reshape(B, H, nc, HG_CHUNK, t.shape[-1]).transpose(2, 0, 1, 3, 4)

    causal = jnp.tril(jnp.ones((HG_CHUNK, HG_CHUNK), dtype=bool))

    def step(state, xs):
        qc, kc, vc, gc = xs
        b = jnp.cumsum(gc, axis=-2)
        diff = b[:, :, :, None, :] - b[:, :, None, :, :]
        decay = jnp.exp(jnp.where(causal[:, :, None], diff, -jnp.inf))
        scores = jnp.einsum('bhtk,bhsk,bhtsk->bhts', qc, kc, decay)
        o = (jnp.einsum('bhts,bhsv->bhtv', scores, vc)
             + jnp.einsum('bhtk,bhkv->bhtv', qc * jnp.exp(b), state))
        b_last = b[:, :, -1:, :]
        state = (jnp.exp(b_last)[:, :, 0, :, None] * state
                 + jnp.einsum('bhsk,bhsv->bhkv', kc * jnp.exp(b_last - b), vc))
        return state, o

    state0 = jnp.zeros((B, H, dk, dv), F32)
    _, outs = lax.scan(step, state0, (chunks(q), chunks(k), chunks(v), chunks(logf)))
    return outs.transpose(1, 2, 0, 3, 4).reshape(B, H, S, dv)


def hgrn2_mixer(q, f_logit, i, g, lb, out_gain):
    B, S, _ = q.shape

    def heads(t):
        return t.reshape(B, S, HG_HEADS, -1).transpose(0, 2, 1, 3).astype(F32)

    qh, zf, ih = heads(q), heads(f_logit), heads(i)
    lbh = lb.astype(F32).reshape(HG_HEADS, 1, HG_DK)
    f = lbh + (1.0 - lbh) * jax.nn.sigmoid(zf)
    o = chunked_gated_recurrence(qh, 1.0 - f, ih, jnp.log(f))
    o = o * lax.rsqrt(jnp.mean(o * o, axis=-1, keepdims=True) + NORM_EPS)
    o = o * out_gain.astype(F32).reshape(HG_HEADS, 1, HG_DV)
    o = o.transpose(0, 2, 1, 3).reshape(B, S, HG_WIDTH)
    return (o * jax.nn.silu(g.astype(F32))).astype(q.dtype)


def dilated_branch(q, k, v, dilation, n_back):
    B, H, S, dh = q.shape
    L = S // dilation
    blk = n_back
    nb = -(-L // blk)
    pad = nb * blk - L

    def to_blocks(t):
        t = t.reshape(B, H, L, dilation, dh).transpose(0, 1, 3, 2, 4)
        t = jnp.pad(t, ((0, 0), (0, 0), (0, 0), (0, pad), (0, 0)))
        return t.reshape(B, H, dilation, nb, blk, dh)

    def with_prev(t):
        prev = jnp.pad(t, ((0, 0), (0, 0), (0, 0), (1, 0), (0, 0), (0, 0)))[:, :, :, :-1]
        return jnp.concatenate([prev, t], axis=-2)

    qb = to_blocks(q)
    kk, vv = with_prev(to_blocks(k)), with_prev(to_blocks(v))
    s = jnp.einsum('bhrnqd,bhrnkd->bhrnqk', qb, kk)
    qi = jnp.arange(blk)[:, None]
    kj = jnp.arange(2 * blk)[None, :]
    dist = qi + blk - kj
    band = (dist >= 0) & (dist <= n_back)
    valid = band[None] & ((jnp.arange(nb)[:, None, None] > 0) | (kj[None] >= blk))
    s = jnp.where(valid, s, -jnp.inf)
    m = jnp.max(s, axis=-1)
    p = jnp.exp(s - m[..., None])
    den = jnp.sum(p, axis=-1)
    o = jnp.einsum('bhrnqk,bhrnkd->bhrnqd', p, vv) / den[..., None]

    def from_blocks(t):
        c = t.shape[-1]
        t = t.reshape(B, H, dilation, nb * blk, c)[:, :, :, :L]
        return t.transpose(0, 1, 3, 2, 4).reshape(B, H, S, c)

    return from_blocks(o), from_blocks(m[..., None])[..., 0], from_blocks(den[..., None])[..., 0]


def dilated_attention_mixer(q, k, v, positions):
    B, S, _ = q.shape

    def heads(t):
        return t.reshape(B, S, ATT_HEADS, ATT_DH).transpose(0, 2, 1, 3).astype(F32)

    qh = rope(heads(q), positions) * (ATT_DH ** -0.5)
    kh = rope(heads(k), positions)
    vh = heads(v)
    outs, ms, dens = [], [], []
    for window, dilation in DILATED_PATTERNS:
        o, m, d = dilated_branch(qh, kh, vh, dilation, window // dilation)
        outs.append(o)
        ms.append(m)
        dens.append(d)
    outs, ms, dens = jnp.stack(outs), jnp.stack(ms), jnp.stack(dens)
    wts = dens * jnp.exp(ms - jnp.max(ms, axis=0, keepdims=True))
    wts = wts / jnp.sum(wts, axis=0, keepdims=True)
    o = jnp.sum(wts[..., None] * outs, axis=0)
    return o.transpose(0, 2, 1, 3).reshape(B, S, ATT_WIDTH).astype(q.dtype)


def memory_cross_attention(h, mem_n, wq, wkv, wo):
    B, S, D = h.shape
    q = (h @ wq).reshape(B, S, X_HEADS, X_DH)
    k, v = jnp.split(mem_n @ wkv, 2, axis=-1)
    k = k.reshape(B, MEM_LEN, X_HEADS, X_DH)
    v = v.reshape(B, MEM_LEN, X_HEADS, X_DH)
    s = jnp.einsum('bshd,bmhd->bhsm', q, k).astype(F32) * (X_DH ** -0.5)
    p = jax.nn.softmax(s, axis=-1)
    o = jnp.einsum('bhsm,bmhd->bshd', p, v.astype(F32)).reshape(B, S, D)
    return o.astype(h.dtype) @ wo


def hierarchical_moe(h, w_rg, w_re, w_gate, w_up, w_down):
    B, S, D = h.shape
    t = h.reshape(-1, D)
    g_logits = (t @ w_rg).astype(F32)
    g_prob = jax.nn.softmax(g_logits, axis=-1)
    g_sel = jnp.argmax(g_logits, axis=-1)
    g_onehot = jax.nn.one_hot(g_sel, N_GROUPS, dtype=F32)
    g_w = jnp.sum(g_prob * g_onehot, axis=-1, keepdims=True)
    e_logits = (t @ w_re).astype(F32).reshape(-1, N_GROUPS, EXPERTS_PER_GROUP)
    e_in = jnp.einsum('nge,ng->ne', e_logits, g_onehot)
    top_v, top_i = lax.top_k(e_in, TOP_K_IN_GROUP)
    e_w = jax.nn.softmax(top_v, axis=-1) * g_w
    ids = g_sel[:, None] * EXPERTS_PER_GROUP + top_i
    gates = jnp.einsum('nk,nke->ne', e_w, jax.nn.one_hot(ids, N_EXPERTS, dtype=F32))
    hg = jnp.einsum('nd,edf->nef', t, w_gate)
    hu = jnp.einsum('nd,edf->nef', t, w_up)
    act = (jax.nn.silu(hg.astype(F32)) * hu.astype(F32) * gates[..., None]).astype(t.dtype)
    y = jnp.einsum('nef,efd->nd', act, w_down)
    return y.reshape(B, S, D).astype(h.dtype)


def setup_inputs(seed: int = 0) -> dict:
    key = jax.random.key(seed)
    ks = jax.random.split(key, 24)

    def w(k, shape, fan_in):
        return jax.random.normal(k, shape, F32) * (fan_in ** -0.5)

    def gain(k, shape):
        return 1.0 + 0.02 * jax.random.normal(k, shape, F32)

    return {
        'x': jax.random.normal(ks[0], (BATCH, SEQ, D_MODEL), F32),
        'mem': jax.random.normal(ks[1], (BATCH, MEM_LEN, D_MODEL), F32),
        'positions': (jnp.arange(SEQ, dtype=jnp.int32)[None, :]
                      + jax.random.randint(ks[2], (BATCH, 1), 0, 4096, dtype=jnp.int32)),
        'norm_mix': gain(ks[3], (DEPTH, D_MODEL)),
        'w_in': w(ks[4], (DEPTH, D_MODEL, IN_PROJ_WIDTH), D_MODEL),
        'hg_lower_bounds': 1.0 + 0.1 * jax.random.normal(ks[5], (DEPTH, HG_WIDTH), F32),
        'hg_out_norm': gain(ks[6], (DEPTH, HG_WIDTH)),
        'w_out': w(ks[7], (DEPTH, MIX_WIDTH, D_MODEL), MIX_WIDTH),
        'norm_cross': gain(ks[8], (DEPTH, D_MODEL)),
        'norm_mem': gain(ks[9], (DEPTH, D_MODEL)),
        'wq_x': w(ks[10], (DEPTH, D_MODEL, D_MODEL), D_MODEL),
        'wkv_x': w(ks[11], (DEPTH, D_MODEL, 2 * D_MODEL), D_MODEL),
        'wo_x': w(ks[12], (DEPTH, D_MODEL, D_MODEL), D_MODEL),
        'norm_ffn': gain(ks[13], (DEPTH, D_MODEL)),
        'w_router_group': w(ks[14], (DEPTH, D_MODEL, N_GROUPS), D_MODEL),
        'w_router_expert': w(ks[15], (DEPTH, D_MODEL, N_EXPERTS), D_MODEL),
        'w_gate': w(ks[16], (DEPTH, N_EXPERTS, D_MODEL, EXPERT_FF), D_MODEL),
        'w_up': w(ks[17], (DEPTH, N_EXPERTS, D_MODEL, EXPERT_FF), D_MODEL),
        'w_down': w(ks[18], (DEPTH, N_EXPERTS, EXPERT_FF, D_MODEL), EXPERT_FF),
        'norm_final': gain(ks[19], (D_MODEL,)),
    }


def reference(x, mem, positions, norm_mix, w_in, hg_lower_bounds, hg_out_norm, w_out,
              norm_cross, norm_mem, wq_x, wkv_x, wo_x, norm_ffn, w_router_group,
              w_router_expert, w_gate, w_up, w_down, norm_final):
    lb_sm = jax.nn.softmax(hg_lower_bounds.astype(F32), axis=0)
    lbs = jnp.cumsum(lb_sm, axis=0) - lb_sm[0:1]
    for l in range(DEPTH):
        h = rms_norm(x, norm_mix[l])
        proj = h @ w_in[l]
        hq, hf, hi, hgate, aq, ak, av = jnp.split(proj, IN_SPLITS, axis=-1)
        y_hg = hgrn2_mixer(hq, hf, hi, hgate, lbs[l], hg_out_norm[l])
        y_att = dilated_attention_mixer(aq, ak, av, positions)
        x = x + jnp.concatenate([y_hg, y_att], axis=-1) @ w_out[l]
        x = x + memory_cross_attention(rms_norm(x, norm_cross[l]), rms_norm(mem, norm_mem[l]),
                                       wq_x[l], wkv_x[l], wo_x[l])
        x = x + hierarchical_moe(rms_norm(x, norm_ffn[l]), w_router_group[l], w_router_expert[l],
                                 w_gate[l], w_up[l], w_down[l])
    return rms_norm(x, norm_final)
```

```cpp
#include <hip/hip_runtime.h>
#include <cstdio>
#include <cstdint>

#ifndef PH_MASK
#define PH_MASK 0xFFFFFFFFu
#endif
#define PHSEL(n) ((PH_MASK >> (n)) & 1u)
#ifndef MK_PER_PHASE
#define MK_PER_PHASE 0
#endif

#define LAS __attribute__((address_space(3)))
#define GAS __attribute__((address_space(1)))
typedef unsigned short bf16_t;
typedef short bf16x8 __attribute__((ext_vector_type(8)));
typedef float f32x4 __attribute__((ext_vector_type(4)));
typedef float f32x2 __attribute__((ext_vector_type(2)));
typedef unsigned u32x4 __attribute__((ext_vector_type(4)));
typedef unsigned u32x2 __attribute__((ext_vector_type(2)));
typedef GAS unsigned gu32;

constexpr int BATCH = 2, SEQ = 8192, DM = 1024, MT = BATCH * SEQ, DEPTH = 2;
constexpr int MEM_LEN = 256, MEMROWS = BATCH * MEM_LEN;
constexpr int NIN = 3584, HGW = 512, HGH = 4, HGD = 128, CHUNK = 64, NCHUNK = SEQ / CHUNK;
constexpr int ATW = 512, ATH = 8, ATD = 64;
constexpr int NEXP = 16, EFF = 512;
constexpr float EPS = 1e-6f;
constexpr int NWAVES = 8, NTHR = 512;

constexpr size_t MiB = 1u << 20;
constexpr size_t WS_CTL = 0, CTL_ZERO_BYTES = 1 * MiB;
constexpr size_t WS_RSTD = 1 * MiB;
constexpr size_t WS_TOKE = WS_RSTD + 64 * 1024;
constexpr size_t WS_TOKW = WS_TOKE + 128 * 1024;
constexpr size_t WS_TOKL = WS_TOKW + 128 * 1024;
constexpr size_t WS_SLOTRS = WS_TOKL + 128 * 1024;
constexpr size_t WS_SLOTGW = WS_SLOTRS + 160 * 1024;
constexpr size_t WS_WR = 3 * MiB;
constexpr size_t WS_XB = 4 * MiB;
constexpr size_t WS_WIN = 36 * MiB;
constexpr size_t WS_WOUT = 50 * MiB;
constexpr size_t WS_WQS = 54 * MiB;
constexpr size_t WS_WKVT = 58 * MiB;
constexpr size_t WS_WOT = 66 * MiB;
constexpr size_t WS_MEMN = 70 * MiB;
constexpr size_t WS_KV = 72 * MiB;
constexpr size_t WS_WQK = 76 * MiB;
constexpr size_t WS_WVO = 84 * MiB;
constexpr size_t WS_ACT = 92 * MiB;
constexpr size_t WS_END = 320 * MiB;
constexpr size_t A_HG = WS_ACT + 0 * MiB;
constexpr size_t A_AQKV = WS_ACT + 64 * MiB;
constexpr size_t A_QR = WS_ACT + 112 * MiB;
constexpr size_t A_KR = WS_ACT + 128 * MiB;
constexpr size_t A_VT1 = WS_ACT + 144 * MiB;
constexpr size_t A_VT4 = WS_ACT + 160 * MiB;
constexpr size_t A_VT16 = WS_ACT + 176 * MiB;
constexpr size_t A_STATE = WS_ACT + 192 * MiB;
constexpr size_t A_DECAY = WS_ACT + 224 * MiB;
constexpr size_t A_P = WS_ACT + 0 * MiB;
constexpr size_t A_WGU = WS_ACT + 0 * MiB;
constexpr size_t A_WD = WS_ACT + 32 * MiB;
constexpr size_t A_XS = WS_ACT + 48 * MiB;
constexpr size_t A_ACTB = WS_ACT + 120 * MiB;
constexpr size_t A_Y = WS_ACT + 156 * MiB;
constexpr int MAXSLOT = 2 * MT + NEXP * 256;
static_assert(A_Y + (size_t)MAXSLOT * 1024 * 2 <= WS_END, "ws map");
constexpr int CW_BAR = 4096;
constexpr int CW_CNT = 16384;
constexpr int RING_BYTES = 131072;
constexpr int SPARE_OFF = RING_BYTES;
constexpr int LDSCTL_OFF = RING_BYTES + 8192, MISC_OFF = LDSCTL_OFF + 64;
constexpr int LDS_BYTES = 147456;

#define RLX_AGENT __ATOMIC_RELAXED, __HIP_MEMORY_SCOPE_AGENT
#define LDS_WAIT() asm volatile("s_waitcnt lgkmcnt(0)" ::: "memory")
#define VM_WAIT() asm volatile("s_waitcnt vmcnt(0)" ::: "memory")

__device__ __forceinline__ unsigned f2bf(float f) { unsigned u = __builtin_bit_cast(unsigned, f); return (u + 0x7fffu + ((u >> 16) & 1u)) >> 16; }
__device__ __forceinline__ unsigned pk2(float lo, float hi) { return f2bf(lo) | (f2bf(hi) << 16); }
__device__ __forceinline__ float bf2f(unsigned short h) { return __builtin_bit_cast(float, (unsigned)h << 16); }
__device__ __forceinline__ float bflo(unsigned w) { return __builtin_bit_cast(float, w << 16); }
__device__ __forceinline__ float bfhi(unsigned w) { return __builtin_bit_cast(float, w & 0xffff0000u); }
__device__ __forceinline__ unsigned cvt_pk_bf16(float lo, float hi) { unsigned r; asm volatile("v_cvt_pk_bf16_f32 %0, %1, %2" : "=v"(r) : "v"(lo), "v"(hi)); return r; }
__device__ __forceinline__ float wave_sum(float v) {
#pragma unroll
    for (int o = 1; o < 64; o <<= 1) v += __shfl_xor(v, o);
    return v;
}
__device__ __forceinline__ float sigmoidf_(float z) { return 1.f / (1.f + __expf(-z)); }

#define XB_TMO      128
#define XB_XCNT(j)  (256  + 64 * (j))
#define XB_XSUB(j)  (1280 + 64 * (j))
#define XB_XGEN(j)  (2304 + 64 * (j))
#define XB_TOP      3328
#define XB_TOPGEN   3392
#define XCD_BAR_WORDS 3456
#define XB_SPIN_CAP (1u << 18)
__device__ __forceinline__ unsigned xb_ld(unsigned* p)              { return __hip_atomic_load(p, __ATOMIC_RELAXED, __HIP_MEMORY_SCOPE_AGENT); }
__device__ __forceinline__ unsigned xb_add(unsigned* p, unsigned v) { return __hip_atomic_fetch_add(p, v, __ATOMIC_RELAXED, __HIP_MEMORY_SCOPE_AGENT); }
__device__ __forceinline__ unsigned xb_xcc_id() { return (unsigned)__builtin_amdgcn_s_getreg((3 << 11) | 20) & 0xFu; }
#define XB_SPIN(cond, bar) do { unsigned _sp = 0; while (cond) { __builtin_amdgcn_s_sleep(1); \
    if ((++_sp & 255u) == 0u) { if (xb_ld(&(bar)[XB_TMO])) break; if (_sp > XB_SPIN_CAP) { atomicAdd(&(bar)[XB_TMO], 1u); break; } } } } while (0)
struct XcdBarrier { unsigned* bar; unsigned x; volatile LAS unsigned* st; };
__device__ __forceinline__ XcdBarrier xcd_barrier_post(unsigned* bar, volatile LAS unsigned* st) {
    XcdBarrier b; b.bar = bar; b.x = xb_xcc_id(); b.st = st;
    if (threadIdx.x == 0) (void)xb_add(&bar[XB_XCNT(b.x)], 1u);
    return b;
}
__device__ __forceinline__ void xcd_barrier_complete(unsigned* bar, unsigned x, unsigned& nloc, unsigned& nx) {
    const unsigned G = gridDim.x * gridDim.y * gridDim.z;
    unsigned sum, cnt, mine, sp = 0u;
    for (;;) {
        sum = 0u; cnt = 0u; mine = 0u;
#pragma unroll
        for (unsigned j = 0; j < 16; ++j) { const unsigned c = xb_ld(&bar[XB_XCNT(j)]); sum += c; cnt += (c > 0u) ? 1u : 0u; mine = (j == x) ? c : mine; }
        if (sum == G) break;
        __builtin_amdgcn_s_sleep(1);
        if ((++sp & 255u) == 0u) { if (xb_ld(&bar[XB_TMO])) break; if (sp > XB_SPIN_CAP) { atomicAdd(&bar[XB_TMO], 1u); break; } }
    }
    nloc = mine > 0u ? mine : 1u; nx = cnt > 0u ? cnt : 1u;
}
__device__ __forceinline__ void xcd_barrier(const XcdBarrier& b) {
    asm volatile("s_waitcnt vmcnt(0)" ::: "memory");
    __syncthreads();
    if (threadIdx.x == 0) {
        unsigned* bar = b.bar;
        __builtin_amdgcn_s_waitcnt(0);
        unsigned nloc = b.st[0], nx = b.st[1];
        if (nloc == 0u) { xcd_barrier_complete(bar, b.x, nloc, nx); b.st[0] = nloc; b.st[1] = nx; }
        const unsigned old = xb_add(&bar[XB_XSUB(b.x)], 1u);
        const unsigned gen = old / nloc;
        if (old + 1u == (gen + 1u) * nloc) {
            __builtin_amdgcn_fence(__ATOMIC_RELEASE, "agent");
            asm volatile("s_waitcnt vmcnt(0)" ::: "memory");
            const unsigned og = xb_add(&bar[XB_TOP], 1u);
            const unsigned tg = og / nx;
            if (og + 1u == (tg + 1u) * nx) xb_add(&bar[XB_TOPGEN], 1u);
            else XB_SPIN(xb_ld(&bar[XB_TOPGEN]) == tg, bar);
            __builtin_amdgcn_fence(__ATOMIC_ACQUIRE, "agent");
            xb_add(&bar[XB_XGEN(b.x)], 1u);
            asm volatile("s_waitcnt vmcnt(0)" ::: "memory");
        } else {
            XB_SPIN(xb_ld(&bar[XB_XGEN(b.x)]) == gen, bar);
            __builtin_amdgcn_fence(__ATOMIC_ACQUIRE, "agent");
            asm volatile("s_waitcnt vmcnt(0)" ::: "memory");
        }
    }
    __syncthreads();
}

namespace pg8 {
constexpr int BM = 256, BK = 64, HALF = 128, HTB = HALF * BK * 2, STAGE_BYTES = 8 * HTB, NXCD = 8, WGM = 8;
__host__ __device__ __forceinline__ int lds_byte(int r, int c) { const int st = (r >> 4) * 2 + (c >> 5), rr = r & 15, cc = c & 31, ob = rr * 64 + cc * 2; return st * 1024 + (ob ^ (((ob >> 9) & 1) << 5)); }
__host__ __device__ __forceinline__ void stage_rc(int b, int& R, int& C) { const int st = b / 1024, sb = b % 1024, swz = sb ^ (((sb >> 9) & 1) << 5); R = (st >> 1) * 16 + swz / 64; C = (st & 1) * 32 + (swz % 64) / 2; }
__host__ __device__ __forceinline__ int perm32(int rho) { const int n = rho >> 4, i = rho & 15; return 8 * (i >> 2) + 4 * n + (i & 3); }

struct Unit { int pm, pn, aux; const char* a; const char* b; };
typedef f32x4 Acc[2][2][4][2];

template <class Epi, class Sched, bool ALIGN_EPI, bool SP2, int LD, int K>
__device__ __forceinline__ void gemm_phase(LAS unsigned char* lds, const int tid, const Sched& S, const Epi& E) {
    constexpr int lda = LD, ldb = LD;
    const int wid = __builtin_amdgcn_readfirstlane(tid >> 6), lane = tid & 63, wr = wid >> 2, wc = wid & 3, fr = lane & 15, fq = lane >> 4;
    constexpr int nt = K / BK;
    unsigned voffA[2], voffB[2];
#pragma unroll
    for (int i = 0; i < 2; ++i) { int R, C; stage_rc(tid * 16 + i * 8192, R, C); const int Rb = Epi::PERM ? ((R & ~31) + perm32(R & 31)) : R;
        voffA[i] = (unsigned)(R * lda + C) * 2u; voffB[i] = (unsigned)(Rb * ldb + C) * 2u; }
    const size_t kstep = (size_t)(BK * 2);
    const size_t hstepA = (size_t)HALF * lda * 2, hstepB = (size_t)HALF * ldb * 2;
    const unsigned ldsw = (unsigned)wid * 1024u;
    const int aoff = lds_byte(wr * 64 + fr, fq * 8), boff = lds_byte(wc * 32 + fr, fq * 8);
#define PG8_SA(b, h) (((b) * 2 + (h)) * HTB)
#define PG8_SB(b, h) ((4 + (b) * 2 + (h)) * HTB)
#define PG8_STAGE(bufoff, gbase, voff) do { _Pragma("unroll") for (int _i = 0; _i < 2; ++_i) \
        __builtin_amdgcn_global_load_lds((const unsigned*)((const char*)(gbase) + (voff)[_i]), (LAS unsigned*)(lds + (bufoff) + ldsw + _i * 8192), 16, 0, 0); } while (0)
#define PG8_LDA(dst, b, h) do { _Pragma("unroll") for (int m = 0; m < 4; ++m) _Pragma("unroll") for (int k = 0; k < 2; ++k) dst[m][k] = *(const LAS bf16x8*)(lds + PG8_SA(b, h) + aoff + m * 2048 + k * 1024); } while (0)
#define PG8_LDB(dst, b, h) do { _Pragma("unroll") for (int n = 0; n < 2; ++n) _Pragma("unroll") for (int k = 0; k < 2; ++k) dst[n][k] = *(const LAS bf16x8*)(lds + PG8_SB(b, h) + boff + n * 2048 + k * 1024); } while (0)
#define PG8_MMA(ai, bj, At, Bt) do { __builtin_amdgcn_s_setprio(1); _Pragma("unroll") for (int m = 0; m < 4; ++m) _Pragma("unroll") for (int n = 0; n < 2; ++n) _Pragma("unroll") for (int k = 0; k < 2; ++k) \
        acc[ai][bj][m][n] = __builtin_amdgcn_mfma_f32_16x16x32_bf16(Bt[n][k], At[m][k], acc[ai][bj][m][n], 0, 0, 0); __builtin_amdgcn_s_setprio(0); } while (0)
#define PG8_WAIT_V(n) asm volatile("s_waitcnt vmcnt(" #n ")" ::: "memory")
#define PG8_WAIT_L(n) asm volatile("s_waitcnt lgkmcnt(" #n ")" ::: "memory")
#define PG8_BAR __builtin_amdgcn_s_barrier()
#define PG8_SCHED __builtin_amdgcn_sched_barrier(0)
    Unit cur, nxt; int ui = 0;
    if (!S.next(0, cur)) return;
    Acc acc;
#pragma unroll
    for (int a = 0; a < 2; ++a)
#pragma unroll
        for (int b = 0; b < 2; ++b)
#pragma unroll
            for (int m = 0; m < 4; ++m)
#pragma unroll
                for (int n = 0; n < 2; ++n) acc[a][b][m][n] = (f32x4){0.f, 0.f, 0.f, 0.f};
    bf16x8 At[4][2], B0[2][2], B1[2][2];
    const char* cA = cur.a; const char* cB = cur.b;
    if constexpr (SP2) {
        PG8_STAGE(PG8_SB(0, 0), cB, voffB); PG8_STAGE(PG8_SB(0, 1), cB + hstepB, voffB); PG8_STAGE(PG8_SA(0, 0), cA, voffA); PG8_STAGE(PG8_SA(0, 1), cA + hstepA, voffA);
        if (wr == 1) PG8_BAR;
        PG8_WAIT_V(2); PG8_BAR;
        PG8_STAGE(PG8_SB(1, 0), cB + kstep, voffB); PG8_STAGE(PG8_SA(1, 0), cA + kstep, voffA); PG8_STAGE(PG8_SB(1, 1), cB + hstepB + kstep, voffB);
        PG8_WAIT_V(6); PG8_BAR;
    } else {
        PG8_STAGE(PG8_SB(0, 0), cB, voffB); PG8_STAGE(PG8_SA(0, 0), cA, voffA); PG8_STAGE(PG8_SB(0, 1), cB + hstepB, voffB); PG8_STAGE(PG8_SA(0, 1), cA + hstepA, voffA);
        if (wr == 1) PG8_BAR;
        PG8_WAIT_V(4); PG8_BAR;
        PG8_STAGE(PG8_SB(1, 0), cB + kstep, voffB); PG8_STAGE(PG8_SA(1, 0), cA + kstep, voffA); PG8_STAGE(PG8_SB(1, 1), cB + hstepB + kstep, voffB);
        PG8_WAIT_V(6); PG8_BAR;
    }
    for (;;) {
        const bool has_next = S.next(ui + 1, nxt);
        const char* nA = has_next ? nxt.a : cA; const char* nB = has_next ? nxt.b : cB;
#pragma nounroll
        for (int t = 0; t < nt; t += 2) {
            const bool last = (t == nt - 2);
            const char* a1 = cA + (size_t)(t + 1) * kstep;
            const char* a2 = last ? nA : cA + (size_t)(t + 2) * kstep; const char* b2 = last ? nB : cB + (size_t)(t + 2) * kstep;
            const char* a3 = a2 + kstep; const char* b3 = b2 + kstep;
            if constexpr (SP2) {
            PG8_LDB(B0, 0, 0); PG8_LDB(B1, 0, 1); PG8_SCHED; PG8_LDA(At, 0, 0); PG8_STAGE(PG8_SA(1, 1), a1 + hstepA, voffA);
            PG8_WAIT_V(8); PG8_WAIT_L(0); PG8_BAR; PG8_MMA(0, 0, At, B0); PG8_MMA(0, 1, At, B1); PG8_BAR; PG8_SCHED;
            PG8_LDA(At, 0, 1); PG8_STAGE(PG8_SB(0, 0), b2, voffB); PG8_STAGE(PG8_SB(0, 1), b2 + hstepB, voffB); PG8_STAGE(PG8_SA(0, 0), a2, voffA);
            PG8_WAIT_V(8); PG8_WAIT_L(0); PG8_BAR; PG8_MMA(1, 0, At, B0); PG8_MMA(1, 1, At, B1); PG8_BAR; PG8_SCHED;
            PG8_LDB(B0, 1, 0); PG8_LDB(B1, 1, 1); PG8_SCHED; PG8_LDA(At, 1, 0); PG8_STAGE(PG8_SA(0, 1), a2 + hstepA, voffA);
            PG8_WAIT_V(8); PG8_WAIT_L(0); PG8_BAR; PG8_MMA(0, 0, At, B0); PG8_MMA(0, 1, At, B1); PG8_BAR; PG8_SCHED;
            PG8_LDA(At, 1, 1); PG8_STAGE(PG8_SB(1, 0), b3, voffB); PG8_STAGE(PG8_SB(1, 1), b3 + hstepB, voffB); PG8_STAGE(PG8_SA(1, 0), a3, voffA);
            PG8_WAIT_V(8); PG8_WAIT_L(0); PG8_BAR; PG8_MMA(1, 0, At, B0); PG8_MMA(1, 1, At, B1); PG8_BAR; PG8_SCHED;
            } else {
            PG8_LDB(B0, 0, 0); PG8_SCHED; PG8_LDA(At, 0, 0); PG8_STAGE(PG8_SA(1, 1), a1 + hstepA, voffA);
            PG8_WAIT_L(8); PG8_BAR; PG8_WAIT_L(0); PG8_MMA(0, 0, At, B0); PG8_BAR; PG8_SCHED;
            PG8_LDB(B1, 0, 1); PG8_STAGE(PG8_SB(0, 0), b2, voffB);
            PG8_BAR; PG8_WAIT_L(0); PG8_MMA(0, 1, At, B1); PG8_BAR;
            PG8_LDA(At, 0, 1); PG8_STAGE(PG8_SA(0, 0), a2, voffA);
            PG8_BAR; PG8_WAIT_L(0); PG8_MMA(1, 0, At, B0); PG8_BAR; PG8_SCHED;
            PG8_STAGE(PG8_SB(0, 1), b2 + hstepB, voffB);
            PG8_WAIT_V(6); PG8_BAR; PG8_MMA(1, 1, At, B1); PG8_BAR;
            PG8_LDB(B0, 1, 0); PG8_SCHED; PG8_LDA(At, 1, 0); PG8_STAGE(PG8_SA(0, 1), a2 + hstepA, voffA);
            PG8_WAIT_L(8); PG8_BAR; PG8_WAIT_L(0); PG8_MMA(0, 0, At, B0); PG8_BAR; PG8_SCHED;
            PG8_LDB(B1, 1, 1); PG8_STAGE(PG8_SB(1, 0), b3, voffB);
            PG8_BAR; PG8_WAIT_L(0); PG8_MMA(0, 1, At, B1); PG8_BAR;
            PG8_LDA(At, 1, 1); PG8_STAGE(PG8_SA(1, 0), a3, voffA);
            PG8_BAR; PG8_WAIT_L(0); PG8_MMA(1, 0, At, B0); PG8_BAR; PG8_SCHED;
            PG8_STAGE(PG8_SB(1, 1), b3 + hstepB, voffB);
            PG8_WAIT_V(6); PG8_BAR; PG8_MMA(1, 1, At, B1); PG8_BAR;
            }
        }
        if constexpr (ALIGN_EPI) { if (wr == 0) PG8_BAR; }
        E(acc, cur, wr, wc, fr, fq, lds);
        if (!has_next) break;
#pragma unroll
        for (int a = 0; a < 2; ++a)
#pragma unroll
            for (int b = 0; b < 2; ++b)
#pragma unroll
                for (int m = 0; m < 4; ++m)
#pragma unroll
                    for (int n = 0; n < 2; ++n) acc[a][b][m][n] = (f32x4){0.f, 0.f, 0.f, 0.f};
        cur = nxt; cA = nA; cB = nB; ++ui;
        if constexpr (ALIGN_EPI) { if (wr == 1) PG8_BAR; }
    }
    PG8_WAIT_V(0);
    if constexpr (!ALIGN_EPI) { if (wr == 0) PG8_BAR; }
    PG8_BAR;
#undef PG8_SA
#undef PG8_SB
#undef PG8_STAGE
#undef PG8_LDA
#undef PG8_LDB
#undef PG8_MMA
#undef PG8_WAIT_V
#undef PG8_WAIT_L
#undef PG8_BAR
#undef PG8_SCHED
}

struct SchedDense {
    int nM, nN, nwg, G, c; const char* A; const char* B; size_t a_tile, b_tile; int pm_per_batch; size_t b_batch;
    __device__ __forceinline__ bool next(int i, Unit& u) const {
        const long L = (long)i * G + c; if (L >= nwg) return false;
        int wgid = (int)L; { const int q = nwg / NXCD, r = nwg % NXCD, xcd = wgid % NXCD, off = wgid / NXCD; wgid = (xcd < r ? xcd * (q + 1) : r * (q + 1) + (xcd - r) * q) + off; }
        const int nig = WGM * nN, gid = wgid / nig, fm = gid * WGM, gsz = (nM - fm) < WGM ? (nM - fm) : WGM;
        u.pm = fm + ((wgid % nig) % gsz); u.pn = (wgid % nig) / gsz; u.aux = 0;
        u.a = A + (size_t)u.pm * a_tile; u.b = B + (size_t)u.pn * b_tile + (size_t)(u.pm / pm_per_batch) * b_batch; return true;
    }
};
}
using pg8::Unit; using pg8::Acc;

struct EpiBf16 {
    static constexpr bool PERM = true;
    bf16_t* O; int ldc; size_t aux_stride; float scale;
    __device__ __forceinline__ void operator()(const Acc& acc, const Unit& u, int wr, int wc, int fr, int fq, LAS unsigned char*) const {
        bf16_t* base = O + (size_t)u.aux * aux_stride;
        const int row0 = u.pm * 256 + wr * 64 + fr, col0 = u.pn * 256 + wc * 32 + 8 * fq;
#pragma unroll
        for (int ai = 0; ai < 2; ++ai)
#pragma unroll
            for (int m = 0; m < 4; ++m) { bf16_t* rowp = base + (size_t)(row0 + ai * 128 + m * 16) * ldc + col0;
#pragma unroll
                for (int bj = 0; bj < 2; ++bj) { const f32x4 v0 = acc[ai][bj][m][0] * scale, v1 = acc[ai][bj][m][1] * scale;
                    u32x4 w; w.x = cvt_pk_bf16(v0[0], v0[1]); w.y = cvt_pk_bf16(v0[2], v0[3]); w.z = cvt_pk_bf16(v1[0], v1[1]); w.w = cvt_pk_bf16(v1[2], v1[3]);
                    *(u32x4*)(rowp + bj * 128) = w; } }
    }
};
struct EpiKV {
    static constexpr bool PERM = true;
    bf16_t* KB; bf16_t* VB;
    __device__ __forceinline__ void operator()(const Acc& acc, const Unit& u, int wr, int wc, int fr, int fq, LAS unsigned char*) const {
        bf16_t* base = (u.pn < 4 ? KB : VB) + (size_t)u.aux * MEMROWS * DM;
        const int row0 = u.pm * 256 + wr * 64 + fr, col0 = (u.pn & 3) * 256 + wc * 32 + 8 * fq;
#pragma unroll
        for (int ai = 0; ai < 2; ++ai)
#pragma unroll
            for (int m = 0; m < 4; ++m) { bf16_t* rowp = base + (size_t)(row0 + ai * 128 + m * 16) * DM + col0;
#pragma unroll
                for (int bj = 0; bj < 2; ++bj) { const f32x4 v0 = acc[ai][bj][m][0], v1 = acc[ai][bj][m][1];
                    u32x4 w; w.x = cvt_pk_bf16(v0[0], v0[1]); w.y = cvt_pk_bf16(v0[2], v0[3]); w.z = cvt_pk_bf16(v1[0], v1[1]); w.w = cvt_pk_bf16(v1[2], v1[3]);
                    *(u32x4*)(rowp + bj * 128) = w; } }
    }
};
struct EpiProj {
    static constexpr bool PERM = true;
    bf16_t* HG; bf16_t* AQKV; const float* rstd;
    __device__ __forceinline__ void operator()(const Acc& acc, const Unit& u, int wr, int wc, int fr, int fq, LAS unsigned char*) const {
        bf16_t* base; int ldc, colt;
        if (u.pn < 8) { base = HG; ldc = 2048; colt = u.pn * 256; } else { base = AQKV; ldc = 1536; colt = (u.pn - 8) * 256; }
        const int row0 = u.pm * 256 + wr * 64 + fr, col0 = colt + wc * 32 + 8 * fq;
#pragma unroll
        for (int ai = 0; ai < 2; ++ai)
#pragma unroll
            for (int m = 0; m < 4; ++m) { const int row = row0 + ai * 128 + m * 16; const float rs = rstd[row]; bf16_t* rowp = base + (size_t)row * ldc + col0;
#pragma unroll
                for (int bj = 0; bj < 2; ++bj) { const f32x4 v0 = acc[ai][bj][m][0] * rs, v1 = acc[ai][bj][m][1] * rs;
                    u32x4 w; w.x = cvt_pk_bf16(v0[0], v0[1]); w.y = cvt_pk_bf16(v0[2], v0[3]); w.z = cvt_pk_bf16(v1[0], v1[1]); w.w = cvt_pk_bf16(v1[2], v1[3]);
                    *(u32x4*)(rowp + bj * 128) = w; } }
    }
};
struct EpiResAdd {
    static constexpr bool PERM = false;
    float* X;
    __device__ __forceinline__ void operator()(const Acc& acc, const Unit& u, int wr, int wc, int fr, int fq, LAS unsigned char*) const {
        const int row0 = u.pm * 256 + wr * 64 + fr, col0 = u.pn * 256 + wc * 32 + 4 * fq;
#pragma unroll
        for (int ai = 0; ai < 2; ++ai)
#pragma unroll
            for (int m = 0; m < 4; ++m) { float* rowp = X + (size_t)(row0 + ai * 128 + m * 16) * DM + col0;
#pragma unroll
                for (int bj = 0; bj < 2; ++bj)
#pragma unroll
                    for (int n = 0; n < 2; ++n) { f32x4* p = (f32x4*)(rowp + bj * 128 + n * 16); *p = *p + acc[ai][bj][m][n]; } }
    }
};
struct EpiSoftmax {
    static constexpr bool PERM = false;
    bf16_t* P; const float* rstd;
    __device__ __forceinline__ void operator()(Acc& acc, const Unit& u, int wr, int wc, int fr, int fq, LAS unsigned char* lds) const {
        LAS f32x2* EX = (LAS f32x2*)(lds + SPARE_OFF);
        const int row0 = u.pm * 256 + wr * 64 + fr;
        float mw[2][4];
#pragma unroll
        for (int ai = 0; ai < 2; ++ai)
#pragma unroll
            for (int m = 0; m < 4; ++m) {
                const float rs = rstd[row0 + ai * 128 + m * 16];
                float mx = -3.0e38f;
#pragma unroll
                for (int bj = 0; bj < 2; ++bj)
#pragma unroll
                    for (int n = 0; n < 2; ++n) { f32x4 v = acc[ai][bj][m][n] * rs; acc[ai][bj][m][n] = v; mx = fmaxf(mx, fmaxf(fmaxf(v[0], v[1]), fmaxf(v[2], v[3]))); }
                mx = fmaxf(mx, __shfl_xor(mx, 16)); mx = fmaxf(mx, __shfl_xor(mx, 32));
                float sm = 0.f;
#pragma unroll
                for (int bj = 0; bj < 2; ++bj)
#pragma unroll
                    for (int n = 0; n < 2; ++n) { f32x4 v = acc[ai][bj][m][n]; v[0] = __expf(v[0] - mx); v[1] = __expf(v[1] - mx); v[2] = __expf(v[2] - mx); v[3] = __expf(v[3] - mx);
                        acc[ai][bj][m][n] = v; sm += (v[0] + v[1]) + (v[2] + v[3]); }
                sm += __shfl_xor(sm, 16); sm += __shfl_xor(sm, 32);
                mw[ai][m] = mx;
                if (fq == 0) EX[(ai * 128 + wr * 64 + m * 16 + fr) * 4 + wc] = (f32x2){mx, sm};
            }
        asm volatile("s_waitcnt lgkmcnt(0)" ::: "memory"); __builtin_amdgcn_s_barrier(); asm volatile("" ::: "memory");
#pragma unroll
        for (int ai = 0; ai < 2; ++ai)
#pragma unroll
            for (int m = 0; m < 4; ++m) {
                const int rl = ai * 128 + wr * 64 + m * 16 + fr;
                const f32x2 e0 = EX[rl * 4 + 0], e1 = EX[rl * 4 + 1], e2 = EX[rl * 4 + 2], e3 = EX[rl * 4 + 3];
                const float M = fmaxf(fmaxf(e0.x, e1.x), fmaxf(e2.x, e3.x));
                const float Ls = e0.y * __expf(e0.x - M) + e1.y * __expf(e1.x - M) + e2.y * __expf(e2.x - M) + e3.y * __expf(e3.x - M);
                const float f = __expf(mw[ai][m] - M) / Ls;
                bf16_t* rowp = P + (size_t)(row0 + ai * 128 + m * 16) * DM + u.pn * 256 + wc * 32 + 4 * fq;
#pragma unroll
                for (int bj = 0; bj < 2; ++bj)
#pragma unroll
                    for (int n = 0; n < 2; ++n) { const f32x4 v = acc[ai][bj][m][n] * f; u32x2 w; w.x = cvt_pk_bf16(v[0], v[1]); w.y = cvt_pk_bf16(v[2], v[3]);
                        *(u32x2*)(rowp + bj * 128 + n * 16) = w; }
            }
        asm volatile("s_waitcnt lgkmcnt(0)" ::: "memory"); __builtin_amdgcn_s_barrier(); asm volatile("" ::: "memory");
    }
};
struct EpiMoe1 {
    static constexpr bool PERM = true;
    bf16_t* ACTB; const float* srs; const float* sgw;
    __device__ __forceinline__ void operator()(const Acc& acc, const Unit& u, int wr, int wc, int fr, int fq, LAS unsigned char*) const {
        const int row0 = u.pm * 256 + wr * 64 + fr, col0 = u.pn * 128 + wc * 32 + 8 * fq;
#pragma unroll
        for (int ai = 0; ai < 2; ++ai)
#pragma unroll
            for (int m = 0; m < 4; ++m) { const int row = row0 + ai * 128 + m * 16; const float rs = srs[row], gw = sgw[row] * rs;
                float o[8];
#pragma unroll
                for (int n = 0; n < 2; ++n)
#pragma unroll
                    for (int j = 0; j < 4; ++j) { const float g = acc[ai][0][m][n][j] * rs, up = acc[ai][1][m][n][j]; o[n * 4 + j] = g * sigmoidf_(g) * up * gw; }
                u32x4 w; w.x = cvt_pk_bf16(o[0], o[1]); w.y = cvt_pk_bf16(o[2], o[3]); w.z = cvt_pk_bf16(o[4], o[5]); w.w = cvt_pk_bf16(o[6], o[7]);
                *(u32x4*)(ACTB + (size_t)row * EFF + col0) = w; }
    }
};

struct Args { const void* in[20]; float* out; unsigned char* ws; int ph_lo, ph_hi; };
struct Frame {
    LAS unsigned char* lds; volatile LAS unsigned* MISC; gu32* ctl;
    int tid, lane, wave, vcu, G;
    unsigned char* ws; float* out; size_t z;
};

__device__ __forceinline__ void transpose_item(const float* W, int N, const float* scale, bf16_t* WT, int ldt, int row_base, int k0, int n0, LAS float* scr, int lane) {
#pragma unroll 8
    for (int i = 0; i < 32; ++i) { const int kk = 2 * i + (lane >> 5); float v = W[(size_t)(k0 + kk) * N + n0 + (lane & 31)]; if (scale) v *= scale[k0 + kk]; scr[kk * 33 + (lane & 31)] = v; }
    LDS_WAIT(); asm volatile("" ::: "memory");
    const int c = lane & 7;
#pragma unroll
    for (int j = 0; j < 4; ++j) { const int n = (lane >> 3) + 8 * j; const LAS float* s = scr + (8 * c) * 33 + n;
        u32x4 o; o.x = pk2(s[0 * 33], s[1 * 33]); o.y = pk2(s[2 * 33], s[3 * 33]); o.z = pk2(s[4 * 33], s[5 * 33]); o.w = pk2(s[6 * 33], s[7 * 33]);
        *(GAS u32x4*)(WT + (size_t)(row_base + n0 + n) * ldt + k0 + 8 * c) = o; }
    LDS_WAIT(); asm volatile("" ::: "memory");
}
__device__ __forceinline__ void transpose_mat_item(const float* W, int K, int N, const float* scale, bf16_t* WT, int mode, int it, LAS float* scr, int lane) {
    const int nblk = N / 32, kb = it / nblk, nb = it % nblk, k0 = 64 * kb, n0 = 32 * nb;
    int row_base = 0;
    if (mode) row_base = 256 * (n0 / 128) + (n0 % 128) + (mode == 2 ? 128 : 0) - n0;
    transpose_item(W, N, scale, WT, K, row_base, k0, n0, scr, lane);
}

__device__ __forceinline__ float row_norm_prep(const float* xrow, bf16_t* xb_row, float* copy_row, int lane) {
    const GAS f32x4* xr = (const GAS f32x4*)xrow + lane;
    f32x4 v[4]; float s = 0.f;
#pragma unroll
    for (int j = 0; j < 4; ++j) { v[j] = xr[64 * j]; s += (v[j].x * v[j].x + v[j].y * v[j].y) + (v[j].z * v[j].z + v[j].w * v[j].w); }
    const float rstd = 1.f / sqrtf(wave_sum(s) * (1.f / DM) + EPS);
    GAS u32x2* o8 = (GAS u32x2*)xb_row + lane;
#pragma unroll
    for (int j = 0; j < 4; ++j) { u32x2 w; w.x = pk2(v[j].x, v[j].y); w.y = pk2(v[j].z, v[j].w); o8[64 * j] = w; }
    if (copy_row) { GAS f32x4* c = (GAS f32x4*)copy_row + lane;
#pragma unroll
        for (int j = 0; j < 4; ++j) c[64 * j] = v[j]; }
    return rstd;
}

__constant__ double INV_FREQ[32] = {1.0, 0.7498942093324559, 0.5623413251903491, 0.4216965034285822, 0.31622776601683794, 0.23713737056616552, 0.1778279410038923, 0.1333521432163324,
    0.1, 0.07498942093324558, 0.05623413251903491, 0.042169650342858224, 0.03162277660168379, 0.023713737056616554, 0.01778279410038923, 0.01333521432163324,
    0.01, 0.007498942093324558, 0.005623413251903491, 0.004216965034285823, 0.0031622776601683794, 0.0023713737056616554, 0.0017782794100389228, 0.001333521432163324,
    0.001, 0.0007498942093324559, 0.0005623413251903491, 0.00042169650342858224, 0.00031622776601683794, 0.00023713737056616554, 0.00017782794100389227, 0.0001333521432163324};


#define IN_F(i) ((const float*)((const char*)a.in[i] + F.z))
__device__ __forceinline__ void ph_init(Frame& F, const Args& a) {
    LAS float* scr = (LAS float*)(F.lds + F.wave * 16384);
    const int gw = F.vcu * NWAVES + F.wave, NGW = F.G * NWAVES, lane = F.lane;
    unsigned char* ws = F.ws;
    for (int it = gw; it < 2 * 3840; it += NGW) {
        const int l = it / 3840; int r = it % 3840;
        if (r < 1792) { transpose_mat_item(IN_F(4) + (size_t)l * DM * NIN, DM, NIN, IN_F(3) + l * DM, (bf16_t*)(ws + WS_WIN) + (size_t)l * NIN * DM, 0, r, scr, lane); continue; } r -= 1792;
        if (r < 512) { transpose_mat_item(IN_F(7) + (size_t)l * DM * DM, DM, DM, nullptr, (bf16_t*)(ws + WS_WOUT) + (size_t)l * DM * DM, 0, r, scr, lane); continue; } r -= 512;
        if (r < 1024) { transpose_mat_item(IN_F(11) + (size_t)l * DM * 2 * DM, DM, 2 * DM, nullptr, (bf16_t*)(ws + WS_WKVT) + (size_t)l * 2 * DM * DM, 0, r, scr, lane); continue; } r -= 1024;
        transpose_mat_item(IN_F(12) + (size_t)l * DM * DM, DM, DM, nullptr, (bf16_t*)(ws + WS_WOT) + (size_t)l * DM * DM, 0, r, scr, lane);
    }
    for (int r = gw; r < DEPTH * DM; r += NGW) {
        const float sc = IN_F(8)[r] * 0.0625f;
        const GAS f32x4* src = (const GAS f32x4*)(IN_F(10) + (size_t)r * DM) + lane; GAS u32x2* dst = (GAS u32x2*)((bf16_t*)(ws + WS_WQS) + (size_t)r * DM) + lane;
#pragma unroll
        for (int j = 0; j < 4; ++j) { const f32x4 v = src[64 * j] * sc; u32x2 w; w.x = pk2(v.x, v.y); w.y = pk2(v.z, v.w); dst[64 * j] = w; }
    }
    for (int r = gw; r < MEMROWS; r += NGW) {
        const GAS f32x4* xr = (const GAS f32x4*)(IN_F(1) + (size_t)r * DM) + lane;
        f32x4 v[4]; float s = 0.f;
#pragma unroll
        for (int j = 0; j < 4; ++j) { v[j] = xr[64 * j]; s += (v[j].x * v[j].x + v[j].y * v[j].y) + (v[j].z * v[j].z + v[j].w * v[j].w); }
        const float rstd = 1.f / sqrtf(wave_sum(s) * (1.f / DM) + EPS);
        for (int l = 0; l < DEPTH; ++l) {
            const GAS f32x4* g = (const GAS f32x4*)(IN_F(9) + l * DM) + lane; GAS u32x2* dst = (GAS u32x2*)((bf16_t*)(ws + WS_MEMN) + ((size_t)l * MEMROWS + r) * DM) + lane;
#pragma unroll
            for (int j = 0; j < 4; ++j) { const f32x4 o = v[j] * rstd * g[64 * j]; u32x2 w; w.x = pk2(o.x, o.y); w.y = pk2(o.z, o.w); dst[64 * j] = w; }
        }
    }
    for (int r = gw; r < MT; r += NGW) {
        const float rs = row_norm_prep(IN_F(0) + (size_t)r * DM, (bf16_t*)(ws + WS_XB) + (size_t)r * DM, F.out + (size_t)r * DM, lane);
        if (lane == 0) ((float*)(ws + WS_RSTD))[r] = rs;
    }
    for (int i = (F.vcu * NTHR + F.tid); i < DEPTH * DM * 20; i += F.G * NTHR) {
        const int l = i / (DM * 20), k = (i / 20) % DM, j = i % 20;
        const float g = IN_F(13)[l * DM + k];
        const float w = j < 4 ? IN_F(14)[((size_t)l * DM + k) * 4 + j] : IN_F(15)[((size_t)l * DM + k) * 16 + (j - 4)];
        ((float*)(ws + WS_WR))[i] = g * w;
    }
}

struct SchedKV {
    int G, c; const char* memn; const char* wkvt;
    __device__ __forceinline__ bool next(int i, Unit& u) const {
        const int L = i * G + c; if (L >= 32) return false;
        const int l = L >> 4; u.pm = (L >> 3) & 1; u.pn = L & 7; u.aux = l;
        u.a = memn + ((size_t)l * MEMROWS + u.pm * 256) * DM * 2; u.b = wkvt + ((size_t)l * 2 * DM + u.pn * 256) * DM * 2; return true;
    }
};
struct SchedFold {
    int G, c; const char* kb; const char* vb; const char* wqs; const char* wot;
    __device__ __forceinline__ bool next(int i, Unit& u) const {
        const int L = i * G + c; if (L >= 128) return false;
        const int ty = L >> 6, l = (L >> 5) & 1, b = (L >> 4) & 1, h = (L >> 2) & 3, t = L & 3; u.aux = ty * 4 + l * 2 + b;
        if (ty == 0) { u.pm = h; u.pn = t; u.a = kb + (((size_t)l * MEMROWS + b * 256) * DM + h * 256) * 2; u.b = wqs + (((size_t)l * DM + t * 256) * DM + h * 256) * 2; }
        else { u.pm = t; u.pn = h; u.a = wot + (((size_t)l * DM + t * 256) * DM + h * 256) * 2; u.b = vb + (((size_t)l * MEMROWS + b * 256) * DM + h * 256) * 2; }
        return true;
    }
};
struct SchedMoe {
    int G, c, kdim; volatile LAS unsigned* tb; const char* A; const char* B;
    __device__ __forceinline__ bool next(int i, Unit& u) const {
        const int L = i * G + c; const int total = (int)tb[16] * 4; if (L >= total) return false;
        const int mt = L >> 2; u.pm = mt; u.pn = L & 3; int e = 0;
#pragma unroll
        for (int j = 1; j < 16; ++j) e += (mt >= (int)tb[j]) ? 1 : 0;
        u.aux = e; u.a = A + (size_t)mt * 256 * kdim * 2; u.b = B + ((size_t)e * 1024 + u.pn * 256) * kdim * 2; return true;
    }
};

__device__ __forceinline__ void prep_unit(Frame& F, const Args& a, int blk) {
    unsigned char* ws = F.ws; const int lane = F.lane, wave = F.wave, tid = F.tid;
    const bf16_t* AQKV = (const bf16_t*)(ws + A_AQKV); bf16_t* QR = (bf16_t*)(ws + A_QR); bf16_t* KR = (bf16_t*)(ws + A_KR);
    const int row0 = blk * 64, b = row0 / SEQ, s0 = row0 % SEQ;
    LAS unsigned short* Vl = (LAS unsigned short*)F.lds;
#pragma unroll
    for (int p = 0; p < 8; ++p) { const int r = p * 8 + (tid >> 6), ch = tid & 63;
        const u32x4 v = *(const GAS u32x4*)(AQKV + (size_t)(row0 + r) * 1536 + 1024 + ch * 8); *(LAS u32x4*)(Vl + r * 512 + ch * 8) = v; }
    const int j = lane & 31, hg = lane >> 5; const int* pos = (const int*)((const char*)a.in[2] + F.z);
    for (int rr = 0; rr < 8; ++rr) {
        const int row = row0 + wave * 8 + rr;
        const double ang = (double)pos[row] * INV_FREQ[j]; double rev = ang * 0.15915494309189535; rev = rev - __builtin_floor(rev);
        const float fr = (float)rev, cs = __builtin_amdgcn_cosf(fr), sn = __builtin_amdgcn_sinf(fr);
        const bf16_t* src = AQKV + (size_t)row * 1536;
#pragma unroll
        for (int hh = 0; hh < 4; ++hh) { const int c0 = (hg * 4 + hh) * 64 + j;
            const float q1 = bf2f(src[c0]), q2 = bf2f(src[c0 + 32]), k1 = bf2f(src[512 + c0]), k2 = bf2f(src[512 + c0 + 32]);
            QR[(size_t)row * 512 + c0] = (bf16_t)f2bf((q1 * cs - q2 * sn) * 0.125f); QR[(size_t)row * 512 + c0 + 32] = (bf16_t)f2bf((q2 * cs + q1 * sn) * 0.125f);
            KR[(size_t)row * 512 + c0] = (bf16_t)f2bf(k1 * cs - k2 * sn); KR[(size_t)row * 512 + c0 + 32] = (bf16_t)f2bf(k2 * cs + k1 * sn); }
    }
    __syncthreads();
    { const int hd = tid; const size_t rb = ((size_t)(b * ATH + (hd >> 6)) * 64 + (hd & 63)) * SEQ;
      bf16_t* v1 = (bf16_t*)(ws + A_VT1) + rb; bf16_t* v4 = (bf16_t*)(ws + A_VT4) + rb; bf16_t* v16 = (bf16_t*)(ws + A_VT16) + rb;
#pragma unroll
      for (int g = 0; g < 8; ++g) { unsigned w[4];
#pragma unroll
          for (int q = 0; q < 4; ++q) w[q] = (unsigned)Vl[(g * 8 + 2 * q) * 512 + hd] | ((unsigned)Vl[(g * 8 + 2 * q + 1) * 512 + hd] << 16);
          *(u32x4*)(v1 + s0 + g * 8) = (u32x4){w[0], w[1], w[2], w[3]}; }
#pragma unroll
      for (int r = 0; r < 4; ++r)
#pragma unroll
          for (int g = 0; g < 2; ++g) { unsigned w[4];
#pragma unroll
              for (int q = 0; q < 4; ++q) w[q] = (unsigned)Vl[(4 * (g * 8 + 2 * q) + r) * 512 + hd] | ((unsigned)Vl[(4 * (g * 8 + 2 * q + 1) + r) * 512 + hd] << 16);
              *(u32x4*)(v4 + r * (SEQ / 4) + (s0 >> 2) + g * 8) = (u32x4){w[0], w[1], w[2], w[3]}; }
#pragma unroll
      for (int r = 0; r < 16; ++r) { u32x2 w;
          w.x = (unsigned)Vl[(r) * 512 + hd] | ((unsigned)Vl[(16 + r) * 512 + hd] << 16); w.y = (unsigned)Vl[(32 + r) * 512 + hd] | ((unsigned)Vl[(48 + r) * 512 + hd] << 16);
          *(u32x2*)(v16 + r * (SEQ / 16) + (s0 >> 4)) = w; }
    }
    __syncthreads();
}

__device__ __forceinline__ float hg_lb(const Frame& F, const Args& a, int l, int c) { if (l == 0) return 0.f; const float* h = IN_F(5); return sigmoidf_(h[HGW + c] - h[c]); }

__device__ __forceinline__ void hg_a_unit(Frame& F, const Args& a, int l, int unit) {
    unsigned char* ws = F.ws; const int tid = F.tid;
    const int b = unit >> 9, h = (unit >> 7) & 3, c = unit & 127; const int row0 = b * SEQ + c * CHUNK;
    const bf16_t* HG = (const bf16_t*)(ws + A_HG);
    LAS float* Bc = (LAS float*)F.lds; LAS float* KK = (LAS float*)(F.lds + 32768); LAS unsigned short* Vs = (LAS unsigned short*)(F.lds + 65536);
    { const int t = tid >> 3, k0 = (tid & 7) * 16; const bf16_t* rowp = HG + (size_t)(row0 + t) * 2048 + h * 128 + k0;
      const u32x4 z0 = *(const GAS u32x4*)(rowp + 512), z1 = *(const GAS u32x4*)(rowp + 512 + 8), v0 = *(const GAS u32x4*)(rowp + 1024), v1 = *(const GAS u32x4*)(rowp + 1024 + 8);
      const unsigned zz[8] = {z0.x, z0.y, z0.z, z0.w, z1.x, z1.y, z1.z, z1.w};
#pragma unroll
      for (int i = 0; i < 8; ++i) {
#pragma unroll
          for (int hh = 0; hh < 2; ++hh) { const int k = k0 + 2 * i + hh; const float z = hh ? bfhi(zz[i]) : bflo(zz[i]); const float lb = hg_lb(F, a, l, h * 128 + k);
              const float sg = sigmoidf_(z), f = lb + (1.f - lb) * sg; Bc[t * 128 + k] = __logf(f); KK[t * 128 + k] = (1.f - lb) * sigmoidf_(-z); } }
      *(LAS u32x4*)(Vs + t * 128 + k0) = v0; *(LAS u32x4*)(Vs + t * 128 + k0 + 8) = v1; }
    __syncthreads();
    if (tid < 128) { float s = 0.f; for (int t = 0; t < CHUNK; ++t) { s += Bc[t * 128 + tid]; Bc[t * 128 + tid] = s; } ((float*)(ws + A_DECAY))[(size_t)unit * 128 + tid] = __expf(s); }
    __syncthreads();
    { const int t = tid >> 3, k0 = (tid & 7) * 16;
#pragma unroll
      for (int i = 0; i < 16; ++i) { const int k = k0 + i; KK[t * 128 + k] *= __expf(Bc[63 * 128 + k] - Bc[t * 128 + k]); } }
    __syncthreads();
    { const int v = tid & 127, kg = tid >> 7; float acc[32];
#pragma unroll
      for (int i = 0; i < 32; ++i) acc[i] = 0.f;
      for (int s = 0; s < CHUNK; ++s) { const float vv = bf2f(Vs[s * 128 + v]);
#pragma unroll
          for (int i4 = 0; i4 < 8; ++i4) { const f32x4 kk = *(const LAS f32x4*)(KK + s * 128 + kg * 32 + i4 * 4); acc[i4 * 4 + 0] += kk.x * vv; acc[i4 * 4 + 1] += kk.y * vv; acc[i4 * 4 + 2] += kk.z * vv; acc[i4 * 4 + 3] += kk.w * vv; } }
      bf16_t* st = (bf16_t*)(ws + A_STATE) + (size_t)unit * 16384;
#pragma unroll
      for (int i = 0; i < 32; ++i) st[(kg * 32 + i) * 128 + v] = (bf16_t)f2bf(acc[i]); }
    __syncthreads();
}

__device__ __forceinline__ void hg_scan(Frame& F) {
    unsigned char* ws = F.ws;
    for (int gid = F.vcu * NTHR + F.tid; gid < BATCH * HGH * 16384; gid += F.G * NTHR) {
        const int bh = gid >> 14, e = gid & 16383, k = e >> 7;
        bf16_t* st = (bf16_t*)(ws + A_STATE) + (size_t)bh * NCHUNK * 16384 + e; const float* dc = (const float*)(ws + A_DECAY) + (size_t)bh * NCHUNK * 128 + k;
        float S = 0.f;
        for (int c0 = 0; c0 < NCHUNK; c0 += 8) { float kv[8], d[8];
#pragma unroll
            for (int i = 0; i < 8; ++i) { kv[i] = bf2f(st[(size_t)(c0 + i) * 16384]); d[i] = dc[(c0 + i) * 128]; }
#pragma unroll
            for (int i = 0; i < 8; ++i) { st[(size_t)(c0 + i) * 16384] = (bf16_t)f2bf(S); S = d[i] * S + kv[i]; } }
    }
}

__device__ __forceinline__ void hg_c_unit(Frame& F, const Args& a, int l, int unit) {
    unsigned char* ws = F.ws; const int tid = F.tid, lane = F.lane, wave = F.wave;
    const int b = unit >> 9, h = (unit >> 7) & 3, c = unit & 127; const int row0 = b * SEQ + c * CHUNK;
    const bf16_t* HG = (const bf16_t*)(ws + A_HG);
    LAS float* Bc = (LAS float*)F.lds; LAS float* KK = (LAS float*)(F.lds + 32768); LAS unsigned short* Qs = (LAS unsigned short*)(F.lds + 65536); LAS unsigned short* Vs = (LAS unsigned short*)(F.lds + 81920);
    LAS float* SC = (LAS float*)(F.lds + 98304); LAS float* RED = (LAS float*)(F.lds + 114688);
    { const int t = tid >> 3, k0 = (tid & 7) * 16; const bf16_t* rowp = HG + (size_t)(row0 + t) * 2048 + h * 128 + k0;
      const u32x4 q0 = *(const GAS u32x4*)(rowp), q1 = *(const GAS u32x4*)(rowp + 8);
      const u32x4 z0 = *(const GAS u32x4*)(rowp + 512), z1 = *(const GAS u32x4*)(rowp + 512 + 8), v0 = *(const GAS u32x4*)(rowp + 1024), v1 = *(const GAS u32x4*)(rowp + 1024 + 8);
      const unsigned zz[8] = {z0.x, z0.y, z0.z, z0.w, z1.x, z1.y, z1.z, z1.w};
#pragma unroll
      for (int i = 0; i < 8; ++i) {
#pragma unroll
          for (int hh = 0; hh < 2; ++hh) { const int k = k0 + 2 * i + hh; const float z = hh ? bfhi(zz[i]) : bflo(zz[i]); const float lb = hg_lb(F, a, l, h * 128 + k);
              const float sg = sigmoidf_(z), f = lb + (1.f - lb) * sg; Bc[t * 128 + k] = __logf(f); KK[t * 128 + k] = (1.f - lb) * sigmoidf_(-z); } }
      *(LAS u32x4*)(Qs + t * 128 + k0) = q0; *(LAS u32x4*)(Qs + t * 128 + k0 + 8) = q1;
      *(LAS u32x4*)(Vs + t * 128 + k0) = v0; *(LAS u32x4*)(Vs + t * 128 + k0 + 8) = v1; }
    __syncthreads();
    if (tid < 128) { float s = 0.f; for (int t = 0; t < CHUNK; ++t) { s += Bc[t * 128 + tid]; Bc[t * 128 + tid] = s; } }
    __syncthreads();
    { const int t = tid >> 3, sg = tid & 7;
      for (int si = 0; si < 8; ++si) { const int s = sg * 8 + si; float acc = 0.f;
          if (s <= t) { for (int kk = 0; kk < 128; ++kk) { const int k = (kk + lane) & 127; acc += bf2f(Qs[t * 128 + k]) * KK[s * 128 + k] * __expf(Bc[t * 128 + k] - Bc[s * 128 + k]); } }
          SC[t * 64 + s] = acc; } }
    __syncthreads();
    { const int t = tid >> 3, k0 = (tid & 7) * 16;
#pragma unroll
      for (int i = 0; i < 16; ++i) { const int k = k0 + i; Bc[t * 128 + k] = bf2f(Qs[t * 128 + k]) * __expf(Bc[t * 128 + k]); } }
    __syncthreads();
    { const int v = tid & 127, tg = tid >> 7; float acc[16];
#pragma unroll
      for (int i = 0; i < 16; ++i) acc[i] = 0.f;
      for (int s = 0; s < CHUNK; ++s) { const float vv = bf2f(Vs[s * 128 + v]);
#pragma unroll
          for (int i = 0; i < 16; ++i) acc[i] += SC[(tg * 16 + i) * 64 + s] * vv; }
      const bf16_t* st = (const bf16_t*)(ws + A_STATE) + (size_t)unit * 16384;
      for (int k = 0; k < 128; ++k) { const float sv = bf2f(st[k * 128 + v]);
#pragma unroll
          for (int i = 0; i < 16; ++i) acc[i] += Bc[(tg * 16 + i) * 128 + k] * sv; }
#pragma unroll
      for (int i = 0; i < 16; ++i) { const float q = wave_sum(acc[i] * acc[i]); if (lane == 0) RED[wave * 16 + i] = q; }
      __syncthreads();
      const float gain = IN_F(6)[l * HGW + h * 128 + v];
      bf16_t* Y = (bf16_t*)(ws + WS_XB);
#pragma unroll
      for (int i = 0; i < 16; ++i) { const int t = tg * 16 + i; const float ssq = RED[(2 * tg) * 16 + i] + RED[(2 * tg + 1) * 16 + i];
          const float g = bf2f(HG[(size_t)(row0 + t) * 2048 + 1536 + h * 128 + v]);
          const float y = acc[i] * (1.f / sqrtf(ssq * (1.f / 128.f) + EPS)) * gain * (g * sigmoidf_(g));
          Y[(size_t)(row0 + t) * DM + h * 128 + v] = (bf16_t)f2bf(y); } }
    __syncthreads();
}

__device__ __forceinline__ void att_task(Frame& F, int task) {
    unsigned char* ws = F.ws; const int lane = F.lane;
    const int tb = task >> 3, h = task & 7; const int row = tb * 64 + lane, s = row % SEQ;
    const bf16_t* QR = (const bf16_t*)(ws + A_QR); const bf16_t* KR = (const bf16_t*)(ws + A_KR); const bf16_t* AQKV = (const bf16_t*)(ws + A_AQKV);
    float q[64], o[64];
#pragma unroll
    for (int i = 0; i < 8; ++i) { const u32x4 w = *(const GAS u32x4*)(QR + (size_t)row * 512 + h * 64 + i * 8);
        q[i * 8 + 0] = bflo(w.x); q[i * 8 + 1] = bfhi(w.x); q[i * 8 + 2] = bflo(w.y); q[i * 8 + 3] = bfhi(w.y); q[i * 8 + 4] = bflo(w.z); q[i * 8 + 5] = bfhi(w.z); q[i * 8 + 6] = bflo(w.w); q[i * 8 + 7] = bfhi(w.w); }
#pragma unroll
    for (int i = 0; i < 64; ++i) o[i] = 0.f;
    float m = -3.0e38f, lsum = 0.f;
    for (int pat = 0; pat < 3; ++pat) { const int d = pat == 0 ? 1 : (pat == 1 ? 4 : 16);
        for (int j = 0; j <= 128; ++j) { const int off = j * d;
            if (s - off >= 0) {
                const bf16_t* kp = KR + (size_t)(row - off) * 512 + h * 64; const bf16_t* vp = AQKV + (size_t)(row - off) * 1536 + 1024 + h * 64;
                float sc = 0.f;
#pragma unroll
                for (int i = 0; i < 8; ++i) { const u32x4 w = *(const GAS u32x4*)(kp + i * 8);
                    sc += q[i * 8 + 0] * bflo(w.x) + q[i * 8 + 1] * bfhi(w.x) + q[i * 8 + 2] * bflo(w.y) + q[i * 8 + 3] * bfhi(w.y) + q[i * 8 + 4] * bflo(w.z) + q[i * 8 + 5] * bfhi(w.z) + q[i * 8 + 6] * bflo(w.w) + q[i * 8 + 7] * bfhi(w.w); }
                if (sc > m) { const float f = __expf(m - sc); lsum *= f;
#pragma unroll
                    for (int i = 0; i < 64; ++i) o[i] *= f;
                    m = sc; }
                const float p = __expf(sc - m); lsum += p;
#pragma unroll
                for (int i = 0; i < 8; ++i) { const u32x4 w = *(const GAS u32x4*)(vp + i * 8);
                    o[i * 8 + 0] += p * bflo(w.x); o[i * 8 + 1] += p * bfhi(w.x); o[i * 8 + 2] += p * bflo(w.y); o[i * 8 + 3] += p * bfhi(w.y); o[i * 8 + 4] += p * bflo(w.z); o[i * 8 + 5] += p * bfhi(w.z); o[i * 8 + 6] += p * bflo(w.w); o[i * 8 + 7] += p * bfhi(w.w); }
            } } }
    const float inv = 1.f / lsum; bf16_t* Y = (bf16_t*)(ws + WS_XB) + (size_t)row * DM + 512 + h * 64;
#pragma unroll
    for (int i = 0; i < 8; ++i) { u32x4 w; w.x = pk2(o[i * 8] * inv, o[i * 8 + 1] * inv); w.y = pk2(o[i * 8 + 2] * inv, o[i * 8 + 3] * inv); w.z = pk2(o[i * 8 + 4] * inv, o[i * 8 + 5] * inv); w.w = pk2(o[i * 8 + 6] * inv, o[i * 8 + 7] * inv);
        *(GAS u32x4*)(Y + i * 8) = w; }
}

__device__ __forceinline__ void ph_norm(Frame& F, const Args& a) {
    const int gw = F.vcu * NWAVES + F.wave, NGW = F.G * NWAVES;
    for (int r = gw; r < MT; r += NGW) { const float rs = row_norm_prep(F.out + (size_t)r * DM, (bf16_t*)(F.ws + WS_XB) + (size_t)r * DM, nullptr, F.lane); if (F.lane == 0) ((float*)(F.ws + WS_RSTD))[r] = rs; }
}

__device__ __forceinline__ void ph_router(Frame& F, const Args& a, int l) {
    unsigned char* ws = F.ws; const int lane = F.lane;
    const int gw = F.vcu * NWAVES + F.wave, NGW = F.G * NWAVES;
    { LAS float* scr = (LAS float*)(F.lds + F.wave * 16384);
      for (int it = gw; it < 3 * 4096; it += NGW) { const int ty = it >> 12, e = (it >> 8) & 15, r = it & 255;
          if (ty == 0) transpose_mat_item(IN_F(16) + ((size_t)l * NEXP + e) * DM * EFF, DM, EFF, IN_F(13) + l * DM, (bf16_t*)(ws + A_WGU) + (size_t)e * DM * DM, 1, r, scr, lane);
          else if (ty == 1) transpose_mat_item(IN_F(17) + ((size_t)l * NEXP + e) * DM * EFF, DM, EFF, IN_F(13) + l * DM, (bf16_t*)(ws + A_WGU) + (size_t)e * DM * DM, 2, r, scr, lane);
          else transpose_mat_item(IN_F(18) + ((size_t)l * NEXP + e) * EFF * DM, EFF, DM, nullptr, (bf16_t*)(ws + A_WD) + (size_t)e * DM * EFF, 0, r, scr, lane); } }
    __syncthreads();
    LAS float* WRl = (LAS float*)F.lds;
    { const float* src = (const float*)(ws + WS_WR) + (size_t)l * DM * 20; for (int i = F.tid; i < DM * 20; i += NTHR) WRl[(i % 20) * DM + i / 20] = src[i]; }
    __syncthreads();
    unsigned* cnt = (unsigned*)(F.ctl + CW_CNT + l * 16 * 64);
    for (int r = gw; r < MT; r += NGW) {
        const GAS f32x4* xr = (const GAS f32x4*)(F.out + (size_t)r * DM) + lane;
        f32x4 v[4]; float s = 0.f;
#pragma unroll
        for (int j = 0; j < 4; ++j) { v[j] = xr[64 * j]; s += (v[j].x * v[j].x + v[j].y * v[j].y) + (v[j].z * v[j].z + v[j].w * v[j].w); }
        const float rstd = 1.f / sqrtf(wave_sum(s) * (1.f / DM) + EPS);
        GAS u32x2* o8 = (GAS u32x2*)((bf16_t*)(ws + WS_XB) + (size_t)r * DM) + lane;
#pragma unroll
        for (int j = 0; j < 4; ++j) { u32x2 w; w.x = pk2(v[j].x, v[j].y); w.y = pk2(v[j].z, v[j].w); o8[64 * j] = w; }
        float lg[20];
#pragma unroll
        for (int q = 0; q < 20; ++q) lg[q] = 0.f;
#pragma unroll
        for (int j = 0; j < 4; ++j) {
#pragma unroll
            for (int q = 0; q < 20; ++q) { const f32x4 w = *(const LAS f32x4*)(WRl + q * DM + 256 * j + 4 * lane); lg[q] += (v[j].x * w.x + v[j].y * w.y) + (v[j].z * w.z + v[j].w * w.w); }
            asm volatile("" ::: "memory"); }
#pragma unroll
        for (int q = 0; q < 20; ++q) lg[q] = wave_sum(lg[q]) * rstd;
        if (lane == 0) {
            ((float*)(ws + WS_RSTD))[r] = rstd;
            int gs = 0; float gm = lg[0];
#pragma unroll
            for (int q = 1; q < 4; ++q) if (lg[q] > gm) { gm = lg[q]; gs = q; }
            float den = 0.f;
#pragma unroll
            for (int q = 0; q < 4; ++q) den += __expf(lg[q] - gm);
            const float gwt = 1.f / den;
            float e4[4];
#pragma unroll
            for (int q = 0; q < 4; ++q) e4[q] = gs == 0 ? lg[4 + q] : (gs == 1 ? lg[8 + q] : (gs == 2 ? lg[12 + q] : lg[16 + q]));
            int i1 = 0; float v1 = e4[0];
#pragma unroll
            for (int q = 1; q < 4; ++q) if (e4[q] > v1) { v1 = e4[q]; i1 = q; }
            int i2 = -1; float v2 = -3.0e38f;
#pragma unroll
            for (int q = 0; q < 4; ++q) if (q != i1 && e4[q] > v2) { v2 = e4[q]; i2 = q; }
            const float ex = __expf(v2 - v1), w1 = 1.f / (1.f + ex), w2 = ex * w1;
            const int id1 = gs * 4 + i1, id2 = gs * 4 + i2;
            int* te = (int*)(ws + WS_TOKE) + 2 * r; float* tw = (float*)(ws + WS_TOKW) + 2 * r; int* tl = (int*)(ws + WS_TOKL) + 2 * r;
            te[0] = id1; te[1] = id2; tw[0] = w1 * gwt; tw[1] = w2 * gwt;
            tl[0] = (int)__hip_atomic_fetch_add(cnt + 64 * id1, 1u, RLX_AGENT); tl[1] = (int)__hip_atomic_fetch_add(cnt + 64 * id2, 1u, RLX_AGENT);
        }
    }
}

__device__ __forceinline__ void moe_prefix(Frame& F, int l) {
    if (F.tid == 0) { unsigned acc = 0; for (int e = 0; e < 16; ++e) { F.MISC[16 + e] = acc; const unsigned n = __hip_atomic_load((unsigned*)(F.ctl + CW_CNT + l * 16 * 64) + 64 * e, RLX_AGENT); acc += (n + 255u) >> 8; } F.MISC[32] = acc; }
    __syncthreads();
}

__device__ __forceinline__ void ph_scatter(Frame& F, const Args& a, int l) {
    unsigned char* ws = F.ws; const int lane = F.lane;
    moe_prefix(F, l);
    const int gw = F.vcu * NWAVES + F.wave, NGW = F.G * NWAVES;
    for (int p = gw; p < 2 * MT; p += NGW) {
        const int r = p >> 1; const int e = ((const int*)(ws + WS_TOKE))[p]; const int loc = ((const int*)(ws + WS_TOKL))[p];
        const int slot = (int)F.MISC[16 + e] * 256 + loc;
        const GAS u32x4* src = (const GAS u32x4*)((const bf16_t*)(ws + WS_XB) + (size_t)r * DM) + lane; GAS u32x4* dst = (GAS u32x4*)((bf16_t*)(ws + A_XS) + (size_t)slot * DM) + lane;
        dst[0] = src[0]; dst[64] = src[64];
        if (lane == 0) { ((float*)(ws + WS_SLOTRS))[slot] = ((const float*)(ws + WS_RSTD))[r]; ((float*)(ws + WS_SLOTGW))[slot] = ((const float*)(ws + WS_TOKW))[p]; }
        asm volatile("" ::: "memory");
        if (lane == 0) ((int*)(ws + WS_TOKL))[p] = slot;
    }
}

__device__ __forceinline__ void ph_combine(Frame& F, const Args& a, int l) {
    unsigned char* ws = F.ws; const int lane = F.lane;
    const int gw = F.vcu * NWAVES + F.wave, NGW = F.G * NWAVES;
    for (int r = gw; r < MT; r += NGW) {
        const int s0 = ((const int*)(ws + WS_TOKL))[2 * r], s1 = ((const int*)(ws + WS_TOKL))[2 * r + 1];
        GAS f32x4* xr = (GAS f32x4*)(F.out + (size_t)r * DM) + lane;
        const GAS u32x2* y0 = (const GAS u32x2*)((const bf16_t*)(ws + A_Y) + (size_t)s0 * DM) + lane; const GAS u32x2* y1 = (const GAS u32x2*)((const bf16_t*)(ws + A_Y) + (size_t)s1 * DM) + lane;
        f32x4 v[4]; float s = 0.f;
#pragma unroll
        for (int j = 0; j < 4; ++j) { const u32x2 p0 = y0[64 * j], p1 = y1[64 * j]; f32x4 x = xr[64 * j];
            x.x += bflo(p0.x) + bflo(p1.x); x.y += bfhi(p0.x) + bfhi(p1.x); x.z += bflo(p0.y) + bflo(p1.y); x.w += bfhi(p0.y) + bfhi(p1.y);
            v[j] = x; s += (x.x * x.x + x.y * x.y) + (x.z * x.z + x.w * x.w); }
        const float rstd = 1.f / sqrtf(wave_sum(s) * (1.f / DM) + EPS);
        if (l == DEPTH - 1) { const GAS f32x4* g = (const GAS f32x4*)IN_F(19) + lane;
#pragma unroll
            for (int j = 0; j < 4; ++j) xr[64 * j] = v[j] * rstd * g[64 * j];
        } else {
            GAS u32x2* o8 = (GAS u32x2*)((bf16_t*)(ws + WS_XB) + (size_t)r * DM) + lane;
#pragma unroll
            for (int j = 0; j < 4; ++j) { xr[64 * j] = v[j]; u32x2 w; w.x = pk2(v[j].x, v[j].y); w.y = pk2(v[j].z, v[j].w); o8[64 * j] = w; }
            if (lane == 0) ((float*)(ws + WS_RSTD))[r] = rstd;
        }
    }
}

constexpr int NPHASE = 3 + 13 * DEPTH;
__global__ void __launch_bounds__(NTHR, 2) fwd(Args a) {
    extern __shared__ __attribute__((aligned(16))) unsigned char lds_raw[];
    Frame F;
    F.lds = (LAS unsigned char*)lds_raw; F.MISC = (volatile LAS unsigned*)(F.lds + MISC_OFF);
    F.tid = threadIdx.x; F.lane = F.tid & 63; F.wave = __builtin_amdgcn_readfirstlane(F.tid >> 6);
    F.G = gridDim.x; { const int bx = blockIdx.x; F.vcu = (F.G % 8 == 0) ? (bx % 8) * (F.G / 8) + bx / 8 : bx; }
    F.ws = a.ws; F.ctl = (gu32*)(a.ws + WS_CTL); F.out = a.out; F.z = 0;
    for (int u = F.tid; u < (LDS_BYTES - LDSCTL_OFF) / 4; u += NTHR) ((LAS unsigned*)(F.lds + LDSCTL_OFF))[u] = 0u;
    __syncthreads();
    XcdBarrier bar; bar.bar = (unsigned*)(F.ctl + CW_BAR); bar.x = 0; bar.st = nullptr;
    const bool one_launch = (a.ph_hi - a.ph_lo) > 1;
    if (one_launch) bar = xcd_barrier_post((unsigned*)(F.ctl + CW_BAR), F.MISC + 8);
    for (int ph = a.ph_lo; ph < a.ph_hi; ++ph) {
        { int t_ = threadIdx.x; asm volatile("" : "+v"(t_)); F.tid = t_; F.lane = t_ & 63; F.wave = __builtin_amdgcn_readfirstlane(t_ >> 6); }
        size_t z_ = 0; asm volatile("" : "+s"(z_)); F.z = z_; F.ws = a.ws + z_; F.out = (float*)((char*)a.out + z_); F.ctl = (gu32*)(a.ws + z_ + WS_CTL);
        unsigned char* ws = F.ws; int bx = (int)blockIdx.x; asm volatile("" : "+s"(bx));
        if (ph == 0) { if (PHSEL(0)) ph_init(F, a); }
        else if (ph == 1) { if (PHSEL(1)) {
            SchedKV S{F.G, bx, (const char*)(ws + WS_MEMN), (const char*)(ws + WS_WKVT)};
            EpiKV E{(bf16_t*)(ws + WS_KV), (bf16_t*)(ws + WS_KV) + (size_t)DEPTH * MEMROWS * DM};
            pg8::gemm_phase<EpiKV, SchedKV, true, true, DM, DM>(F.lds, F.tid, S, E); }
        } else if (ph == 2) { if (PHSEL(2)) {
            SchedFold S{F.G, bx, (const char*)(ws + WS_KV), (const char*)(ws + WS_KV) + (size_t)DEPTH * MEMROWS * DM * 2, (const char*)(ws + WS_WQS), (const char*)(ws + WS_WOT)};
            EpiBf16 E{(bf16_t*)(ws + WS_WQK), DM, (size_t)DM * DM, 1.f};
            pg8::gemm_phase<EpiBf16, SchedFold, true, true, DM, 256>(F.lds, F.tid, S, E); }
        } else {
            const int l = (ph - 3) / 13, q = (ph - 3) % 13;
            if (q == 0 && PHSEL(3)) {
                pg8::SchedDense S{64, 14, 896, F.G, bx, (const char*)(ws + WS_XB), (const char*)(ws + WS_WIN) + (size_t)l * NIN * DM * 2, (size_t)256 * DM * 2, (size_t)256 * DM * 2, 64, 0};
                EpiProj E{(bf16_t*)(ws + A_HG), (bf16_t*)(ws + A_AQKV), (const float*)(ws + WS_RSTD)};
                pg8::gemm_phase<EpiProj, pg8::SchedDense, true, true, DM, DM>(F.lds, F.tid, S, E);
            } else if (q == 1 && PHSEL(4)) {
                for (int u = F.vcu; u < MT / 64; u += F.G) prep_unit(F, a, u);
                for (int u = F.vcu; u < BATCH * HGH * NCHUNK; u += F.G) hg_a_unit(F, a, l, u);
            } else if (q == 2 && PHSEL(5)) hg_scan(F);
            else if (q == 3 && PHSEL(6)) {
                for (int u = F.vcu; u < BATCH * HGH * NCHUNK; u += F.G) hg_c_unit(F, a, l, u);
                for (int t = F.vcu * NWAVES + F.wave; t < (MT / 64) * ATH; t += F.G * NWAVES) att_task(F, t);
            } else if (q == 4 && PHSEL(7)) {
                pg8::SchedDense S{64, 4, 256, F.G, bx, (const char*)(ws + WS_XB), (const char*)(ws + WS_WOUT) + (size_t)l * DM * DM * 2, (size_t)256 * DM * 2, (size_t)256 * DM * 2, 64, 0};
                EpiResAdd E{F.out};
                pg8::gemm_phase<EpiResAdd, pg8::SchedDense, true, true, DM, DM>(F.lds, F.tid, S, E);
            } else if (q == 5 && PHSEL(8)) ph_norm(F, a);
            else if (q == 6 && PHSEL(9)) {
                pg8::SchedDense S{64, 4, 256, F.G, bx, (const char*)(ws + WS_XB), (const char*)(ws + WS_WQK) + (size_t)l * 2 * DM * DM * 2, (size_t)256 * DM * 2, (size_t)256 * DM * 2, 32, (size_t)DM * DM * 2};
                EpiSoftmax E{(bf16_t*)(ws + A_P), (const float*)(ws + WS_RSTD)};
                pg8::gemm_phase<EpiSoftmax, pg8::SchedDense, true, true, DM, DM>(F.lds, F.tid, S, E);
            } else if (q == 7 && PHSEL(10)) {
                pg8::SchedDense S{64, 4, 256, F.G, bx, (const char*)(ws + A_P), (const char*)(ws + WS_WVO) + (size_t)l * 2 * DM * DM * 2, (size_t)256 * DM * 2, (size_t)256 * DM * 2, 32, (size_t)DM * DM * 2};
                EpiResAdd E{F.out};
                pg8::gemm_phase<EpiResAdd, pg8::SchedDense, true, true, DM, DM>(F.lds, F.tid, S, E);
            } else if (q == 8 && PHSEL(11)) ph_router(F, a, l);
            else if (q == 9 && PHSEL(12)) ph_scatter(F, a, l);
            else if (q == 10 && PHSEL(13)) {
                moe_prefix(F, l);
                SchedMoe S{F.G, bx, DM, F.MISC + 16, (const char*)(ws + A_XS), (const char*)(ws + A_WGU)};
                EpiMoe1 E{(bf16_t*)(ws + A_ACTB), (const float*)(ws + WS_SLOTRS), (const float*)(ws + WS_SLOTGW)};
                pg8::gemm_phase<EpiMoe1, SchedMoe, true, true, DM, DM>(F.lds, F.tid, S, E);
            } else if (q == 11 && PHSEL(14)) {
                moe_prefix(F, l);
                SchedMoe S{F.G, bx, EFF, F.MISC + 16, (const char*)(ws + A_ACTB), (const char*)(ws + A_WD)};
                EpiBf16 E{(bf16_t*)(ws + A_Y), DM, 0, 1.f};
                pg8::gemm_phase<EpiBf16, SchedMoe, true, true, EFF, EFF>(F.lds, F.tid, S, E);
            } else if (q == 12 && PHSEL(15)) ph_combine(F, a, l);
        }
        if (ph + 1 < a.ph_hi) xcd_barrier(bar);
    }
}

extern "C" void kernel_launch(void* const* d_in, const int* in_sizes, int n_in, void* d_out, int out_size, void* d_ws, size_t ws_size, hipStream_t stream) {
    static int grid = 0;
    if (grid == 0) {
        if (n_in != 20 || in_sizes[0] != MT * DM || out_size != MT * DM || ws_size < WS_END) { fprintf(stderr, "kernel_launch: unexpected shapes / workspace (%d inputs, ws %zu)\n", n_in, ws_size); grid = -1; return; }
        int dev = 0, cus = 0, per_cu = 0;
        if (hipGetDevice(&dev) != hipSuccess || hipDeviceGetAttribute(&cus, hipDeviceAttributeMultiprocessorCount, dev) != hipSuccess) { grid = -1; return; }
        if (hipFuncSetAttribute((const void*)fwd, hipFuncAttributeMaxDynamicSharedMemorySize, LDS_BYTES) != hipSuccess) { grid = -1; return; }
        if (hipOccupancyMaxActiveBlocksPerMultiprocessor(&per_cu, (const void*)fwd, NTHR, LDS_BYTES) != hipSuccess || per_cu < 1) { fprintf(stderr, "kernel_launch: occupancy query says %d\n", per_cu); per_cu = 1; }
        (void)hipGetLastError();
        grid = cus * 1;
    }
    if (grid < 0) return;
    (void)hipMemsetAsync((char*)d_ws + WS_CTL, 0, CTL_ZERO_BYTES, stream);
    Args a{};
    for (int i = 0; i < 20; ++i) a.in[i] = d_in[i];
    a.out = (float*)d_out; a.ws = (unsigned char*)d_ws;
#if MK_PER_PHASE
    for (int ph = 0; ph < NPHASE; ++ph) { a.ph_lo = ph; a.ph_hi = ph + 1; hipLaunchKernelGGL(fwd, dim3(grid), dim3(NTHR), LDS_BYTES, stream, a); }
#else
    a.ph_lo = 0; a.ph_hi = NPHASE;
    void* kargs[] = {&a};
    hipError_t e = hipLaunchCooperativeKernel((const void*)fwd, dim3(grid), dim3(NTHR), kargs, LDS_BYTES, stream);
    if (e != hipSuccess) fprintf(stderr, "cooperative launch failed: %s (grid %d)\n", hipGetErrorString(e), grid);
#endif
}
```

```cpp
#include <hip/hip_runtime.h>
#include <cstdio>
#include <cstdint>

#ifndef PH_MASK
#define PH_MASK 0xFFFFFFFFu
#endif
#define PHSEL(n) ((PH_MASK >> (n)) & 1u)
#ifndef PROBE_Q
#define PROBE_Q -1
#endif
#ifndef PROBE_N
#define PROBE_N 1
#endif
#ifndef HG_A_GOLDEN
#define HG_A_GOLDEN 0
#endif
#ifndef HG_C_GOLDEN
#define HG_C_GOLDEN 0
#endif
#ifndef ATT_GOLDEN
#define ATT_GOLDEN 0
#endif
#ifndef MK_PER_PHASE
#define MK_PER_PHASE 0
#endif

#define LAS __attribute__((address_space(3)))
#define GAS __attribute__((address_space(1)))
typedef unsigned short bf16_t;
typedef short bf16x8 __attribute__((ext_vector_type(8)));
typedef float f32x4 __attribute__((ext_vector_type(4)));
typedef float f32x2 __attribute__((ext_vector_type(2)));
typedef unsigned u32x4 __attribute__((ext_vector_type(4)));
typedef unsigned u32x2 __attribute__((ext_vector_type(2)));
typedef GAS unsigned gu32;

constexpr int BATCH = 2, SEQ = 8192, DM = 1024, MT = BATCH * SEQ, DEPTH = 2;
constexpr int MEM_LEN = 256, MEMROWS = BATCH * MEM_LEN;
constexpr int NIN = 3584, HGW = 512, HGH = 4, HGD = 128, CHUNK = 64, NCHUNK = SEQ / CHUNK;
constexpr int ATW = 512, ATH = 8, ATD = 64;
constexpr int NEXP = 16, EFF = 512;
constexpr float EPS = 1e-6f;
constexpr int NWAVES = 8, NTHR = 512;

constexpr size_t MiB = 1u << 20;
constexpr size_t WS_CTL = 0, CTL_ZERO_BYTES = 1 * MiB;
constexpr size_t WS_RSTD = 1 * MiB;
constexpr size_t WS_TOKE = WS_RSTD + 64 * 1024;
constexpr size_t WS_TOKW = WS_TOKE + 128 * 1024;
constexpr size_t WS_TOKL = WS_TOKW + 128 * 1024;
constexpr size_t WS_SLOTRS = WS_TOKL + 128 * 1024;
constexpr size_t WS_SLOTGW = WS_SLOTRS + 160 * 1024;
constexpr size_t WS_WR = 3 * MiB;
constexpr size_t WS_XB = 4 * MiB;
constexpr size_t WS_WIN = 36 * MiB;
constexpr size_t WS_WOUT = 50 * MiB;
constexpr size_t WS_WQS = 54 * MiB;
constexpr size_t WS_WKVT = 58 * MiB;
constexpr size_t WS_WOT = 66 * MiB;
constexpr size_t WS_MEMN = 70 * MiB;
constexpr size_t WS_KV = 72 * MiB;
constexpr size_t WS_WQK = 76 * MiB;
constexpr size_t WS_WVO = 84 * MiB;
constexpr size_t WS_ACT = 92 * MiB;
constexpr size_t WS_END = 320 * MiB;
constexpr size_t A_HG = WS_ACT + 0 * MiB;
constexpr size_t A_AQKV = WS_ACT + 64 * MiB;
constexpr size_t A_QR = WS_ACT + 112 * MiB;
constexpr size_t A_KR = WS_ACT + 128 * MiB;
constexpr size_t A_VT1 = WS_ACT + 144 * MiB;
constexpr size_t A_VT4 = WS_ACT + 160 * MiB;
constexpr size_t A_VT16 = WS_ACT + 176 * MiB;
constexpr size_t A_STATE = WS_ACT + 192 * MiB;
constexpr size_t A_DECAY = WS_ACT + 224 * MiB;
constexpr size_t A_P = WS_ACT + 0 * MiB;
constexpr size_t A_WGU = WS_ACT + 0 * MiB;
constexpr size_t A_WD = WS_ACT + 32 * MiB;
constexpr size_t A_XS = WS_ACT + 48 * MiB;
constexpr size_t A_ACTB = WS_ACT + 120 * MiB;
constexpr size_t A_Y = WS_ACT + 156 * MiB;
constexpr int MAXSLOT = 2 * MT + NEXP * 256;
static_assert(A_Y + (size_t)MAXSLOT * 1024 * 2 <= WS_END, "ws map");
constexpr int CW_BAR = 4096;
constexpr int CW_CNT = 16384;
constexpr int RING_BYTES = 131072;
constexpr int SPARE_OFF = RING_BYTES;
constexpr int LDSCTL_OFF = RING_BYTES + 8192, MISC_OFF = LDSCTL_OFF + 64;
constexpr int LDS_BYTES = 147456;

#define RLX_AGENT __ATOMIC_RELAXED, __HIP_MEMORY_SCOPE_AGENT
#define LDS_WAIT() asm volatile("s_waitcnt lgkmcnt(0)" ::: "memory")
#define VM_WAIT() asm volatile("s_waitcnt vmcnt(0)" ::: "memory")

__device__ __forceinline__ unsigned f2bf(float f) { unsigned u = __builtin_bit_cast(unsigned, f); return (u + 0x7fffu + ((u >> 16) & 1u)) >> 16; }
__device__ __forceinline__ unsigned pk2(float lo, float hi) { return f2bf(lo) | (f2bf(hi) << 16); }
__device__ __forceinline__ float bf2f(unsigned short h) { return __builtin_bit_cast(float, (unsigned)h << 16); }
__device__ __forceinline__ float bflo(unsigned w) { return __builtin_bit_cast(float, w << 16); }
__device__ __forceinline__ float bfhi(unsigned w) { return __builtin_bit_cast(float, w & 0xffff0000u); }
typedef __bf16 bf16x2_t __attribute__((ext_vector_type(2)));
__device__ __forceinline__ unsigned cvt_pk_bf16(float lo, float hi) { f32x2 v = {lo, hi}; bf16x2_t b = __builtin_convertvector(v, bf16x2_t); return __builtin_bit_cast(unsigned, b); }
__device__ __forceinline__ float wave_sum(float v) {
#pragma unroll
    for (int o = 1; o < 64; o <<= 1) v += __shfl_xor(v, o);
    return v;
}
__device__ __forceinline__ float sigmoidf_(float z) { return 1.f / (1.f + __expf(-z)); }

#define XB_TMO      128
#define XB_XCNT(j)  (256  + 64 * (j))
#define XB_XSUB(j)  (1280 + 64 * (j))
#define XB_XGEN(j)  (2304 + 64 * (j))
#define XB_TOP      3328
#define XB_TOPGEN   3392
#define XCD_BAR_WORDS 3456
#define XB_SPIN_CAP (1u << 18)
__device__ __forceinline__ unsigned xb_ld(unsigned* p)              { return __hip_atomic_load(p, __ATOMIC_RELAXED, __HIP_MEMORY_SCOPE_AGENT); }
__device__ __forceinline__ unsigned xb_add(unsigned* p, unsigned v) { return __hip_atomic_fetch_add(p, v, __ATOMIC_RELAXED, __HIP_MEMORY_SCOPE_AGENT); }
__device__ __forceinline__ unsigned xb_xcc_id() { return (unsigned)__builtin_amdgcn_s_getreg((3 << 11) | 20) & 0xFu; }
#define XB_SPIN(cond, bar) do { unsigned _sp = 0; while (cond) { __builtin_amdgcn_s_sleep(1); \
    if ((++_sp & 255u) == 0u) { if (xb_ld(&(bar)[XB_TMO])) break; if (_sp > XB_SPIN_CAP) { atomicAdd(&(bar)[XB_TMO], 1u); break; } } } } while (0)
struct XcdBarrier { unsigned* bar; unsigned x; volatile LAS unsigned* st; };
__device__ __forceinline__ XcdBarrier xcd_barrier_post(unsigned* bar, volatile LAS unsigned* st) {
    XcdBarrier b; b.bar = bar; b.x = xb_xcc_id(); b.st = st;
    if (threadIdx.x == 0) (void)xb_add(&bar[XB_XCNT(b.x)], 1u);
    return b;
}
__device__ __forceinline__ void xcd_barrier_complete(unsigned* bar, unsigned x, unsigned& nloc, unsigned& nx) {
    const unsigned G = gridDim.x * gridDim.y * gridDim.z;
    unsigned sum, cnt, mine, sp = 0u;
    for (;;) {
        sum = 0u; cnt = 0u; mine = 0u;
#pragma unroll
        for (unsigned j = 0; j < 16; ++j) { const unsigned c = xb_ld(&bar[XB_XCNT(j)]); sum += c; cnt += (c > 0u) ? 1u : 0u; mine = (j == x) ? c : mine; }
        if (sum == G) break;
        __builtin_amdgcn_s_sleep(1);
        if ((++sp & 255u) == 0u) { if (xb_ld(&bar[XB_TMO])) break; if (sp > XB_SPIN_CAP) { atomicAdd(&bar[XB_TMO], 1u); break; } }
    }
    nloc = mine > 0u ? mine : 1u; nx = cnt > 0u ? cnt : 1u;
}
__device__ __forceinline__ void xcd_barrier(const XcdBarrier& b) {
    asm volatile("s_waitcnt vmcnt(0)" ::: "memory");
    __syncthreads();
    if (threadIdx.x == 0) {
        unsigned* bar = b.bar;
        __builtin_amdgcn_s_waitcnt(0);
        unsigned nloc = b.st[0], nx = b.st[1];
        if (nloc == 0u) { xcd_barrier_complete(bar, b.x, nloc, nx); b.st[0] = nloc; b.st[1] = nx; }
        const unsigned old = xb_add(&bar[XB_XSUB(b.x)], 1u);
        const unsigned gen = old / nloc;
        if (old + 1u == (gen + 1u) * nloc) {
            __builtin_amdgcn_fence(__ATOMIC_RELEASE, "agent");
            asm volatile("s_waitcnt vmcnt(0)" ::: "memory");
            const unsigned og = xb_add(&bar[XB_TOP], 1u);
            const unsigned tg = og / nx;
            if (og + 1u == (tg + 1u) * nx) xb_add(&bar[XB_TOPGEN], 1u);
            else XB_SPIN(xb_ld(&bar[XB_TOPGEN]) == tg, bar);
            __builtin_amdgcn_fence(__ATOMIC_ACQUIRE, "agent");
            xb_add(&bar[XB_XGEN(b.x)], 1u);
            asm volatile("s_waitcnt vmcnt(0)" ::: "memory");
        } else {
            XB_SPIN(xb_ld(&bar[XB_XGEN(b.x)]) == gen, bar);
            __builtin_amdgcn_fence(__ATOMIC_ACQUIRE, "agent");
            asm volatile("s_waitcnt vmcnt(0)" ::: "memory");
        }
    }
    __syncthreads();
}

namespace pg8 {
constexpr int BM = 256, BK = 64, HALF = 128, HTB = HALF * BK * 2, STAGE_BYTES = 8 * HTB, NXCD = 8, WGM = 8;
__host__ __device__ __forceinline__ int lds_byte(int r, int c) { const int st = (r >> 4) * 2 + (c >> 5), rr = r & 15, cc = c & 31, ob = rr * 64 + cc * 2; return st * 1024 + (ob ^ (((ob >> 9) & 1) << 5)); }
__host__ __device__ __forceinline__ void stage_rc(int b, int& R, int& C) { const int st = b / 1024, sb = b % 1024, swz = sb ^ (((sb >> 9) & 1) << 5); R = (st >> 1) * 16 + swz / 64; C = (st & 1) * 32 + (swz % 64) / 2; }
__host__ __device__ __forceinline__ int perm32(int rho) { const int n = rho >> 4, i = rho & 15; return 8 * (i >> 2) + 4 * n + (i & 3); }

struct Unit { int pm, pn, aux; const char* a; const char* b; };
typedef f32x4 Acc[2][2][4][2];

template <class Epi, class Sched, bool ALIGN_EPI, bool SP2, int LD, int K>
__device__ __forceinline__ void gemm_phase(LAS unsigned char* lds, const int tid, const Sched& S, const Epi& E) {
    constexpr int lda = LD, ldb = LD;
    const int wid = __builtin_amdgcn_readfirstlane(tid >> 6), lane = tid & 63, wr = wid >> 2, wc = wid & 3, fr = lane & 15, fq = lane >> 4;
    constexpr int nt = K / BK;
    unsigned voffA[2], voffB[2];
#pragma unroll
    for (int i = 0; i < 2; ++i) { int R, C; stage_rc(tid * 16 + i * 8192, R, C); const int Rb = Epi::PERM ? ((R & ~31) + perm32(R & 31)) : R;
        voffA[i] = (unsigned)(R * lda + C) * 2u; voffB[i] = (unsigned)(Rb * ldb + C) * 2u; }
    const size_t kstep = (size_t)(BK * 2);
    const size_t hstepA = (size_t)HALF * lda * 2, hstepB = (size_t)HALF * ldb * 2;
    const unsigned ldsw = (unsigned)wid * 1024u;
    const int aoff = lds_byte(wr * 64 + fr, fq * 8), boff = lds_byte(wc * 32 + fr, fq * 8);
#define PG8_SA(b, h) (((b) * 2 + (h)) * HTB)
#define PG8_SB(b, h) ((4 + (b) * 2 + (h)) * HTB)
#define PG8_STAGE(bufoff, gbase, voff) do { _Pragma("unroll") for (int _i = 0; _i < 2; ++_i) \
        __builtin_amdgcn_global_load_lds((const unsigned*)((const char*)(gbase) + (voff)[_i]), (LAS unsigned*)(lds + (bufoff) + ldsw + _i * 8192), 16, 0, 0); } while (0)
#define PG8_LDA(dst, b, h) do { _Pragma("unroll") for (int m = 0; m < 4; ++m) _Pragma("unroll") for (int k = 0; k < 2; ++k) dst[m][k] = *(const LAS bf16x8*)(lds + PG8_SA(b, h) + aoff + m * 2048 + k * 1024); } while (0)
#define PG8_LDB(dst, b, h) do { _Pragma("unroll") for (int n = 0; n < 2; ++n) _Pragma("unroll") for (int k = 0; k < 2; ++k) dst[n][k] = *(const LAS bf16x8*)(lds + PG8_SB(b, h) + boff + n * 2048 + k * 1024); } while (0)
#define PG8_MMA(ai, bj, At, Bt) do { __builtin_amdgcn_s_setprio(1); _Pragma("unroll") for (int m = 0; m < 4; ++m) _Pragma("unroll") for (int n = 0; n < 2; ++n) _Pragma("unroll") for (int k = 0; k < 2; ++k) \
        acc[ai][bj][m][n] = __builtin_amdgcn_mfma_f32_16x16x32_bf16(Bt[n][k], At[m][k], acc[ai][bj][m][n], 0, 0, 0); __builtin_amdgcn_s_setprio(0); } while (0)
#define PG8_WAIT_V(n) asm volatile("s_waitcnt vmcnt(" #n ")" ::: "memory")
#define PG8_WAIT_L(n) asm volatile("s_waitcnt lgkmcnt(" #n ")" ::: "memory")
#define PG8_BAR __builtin_amdgcn_s_barrier()
#define PG8_SCHED __builtin_amdgcn_sched_barrier(0)
    Unit cur, nxt; int ui = 0;
    if (!S.next(0, cur)) return;
    Acc acc;
#pragma unroll
    for (int a = 0; a < 2; ++a)
#pragma unroll
        for (int b = 0; b < 2; ++b)
#pragma unroll
            for (int m = 0; m < 4; ++m)
#pragma unroll
                for (int n = 0; n < 2; ++n) acc[a][b][m][n] = (f32x4){0.f, 0.f, 0.f, 0.f};
    bf16x8 At[4][2], B0[2][2], B1[2][2];
    const char* cA = cur.a; const char* cB = cur.b;
    if constexpr (SP2) {
        PG8_STAGE(PG8_SB(0, 0), cB, voffB); PG8_STAGE(PG8_SB(0, 1), cB + hstepB, voffB); PG8_STAGE(PG8_SA(0, 0), cA, voffA); PG8_STAGE(PG8_SA(0, 1), cA + hstepA, voffA);
        if (wr == 1) PG8_BAR;
        PG8_WAIT_V(2); PG8_BAR;
        PG8_STAGE(PG8_SB(1, 0), cB + kstep, voffB); PG8_STAGE(PG8_SA(1, 0), cA + kstep, voffA); PG8_STAGE(PG8_SB(1, 1), cB + hstepB + kstep, voffB);
        PG8_WAIT_V(6); PG8_BAR;
    } else {
        PG8_STAGE(PG8_SB(0, 0), cB, voffB); PG8_STAGE(PG8_SA(0, 0), cA, voffA); PG8_STAGE(PG8_SB(0, 1), cB + hstepB, voffB); PG8_STAGE(PG8_SA(0, 1), cA + hstepA, voffA);
        if (wr == 1) PG8_BAR;
        PG8_WAIT_V(4); PG8_BAR;
        PG8_STAGE(PG8_SB(1, 0), cB + kstep, voffB); PG8_STAGE(PG8_SA(1, 0), cA + kstep, voffA); PG8_STAGE(PG8_SB(1, 1), cB + hstepB + kstep, voffB);
        PG8_WAIT_V(6); PG8_BAR;
    }
    for (;;) {
        const bool has_next = S.next(ui + 1, nxt);
        const char* nA = has_next ? nxt.a : cA; const char* nB = has_next ? nxt.b : cB;
#pragma nounroll
        for (int t = 0; t < nt; t += 2) {
            const bool last = (t == nt - 2);
            const char* a1 = cA + (size_t)(t + 1) * kstep;
            const char* a2 = last ? nA : cA + (size_t)(t + 2) * kstep; const char* b2 = last ? nB : cB + (size_t)(t + 2) * kstep;
            const char* a3 = a2 + kstep; const char* b3 = b2 + kstep;
            if constexpr (SP2) {
            PG8_LDB(B0, 0, 0); PG8_LDB(B1, 0, 1); PG8_SCHED; PG8_LDA(At, 0, 0); PG8_STAGE(PG8_SA(1, 1), a1 + hstepA, voffA);
            PG8_WAIT_V(8); PG8_WAIT_L(0); PG8_BAR; PG8_MMA(0, 0, At, B0); PG8_MMA(0, 1, At, B1); PG8_BAR; PG8_SCHED;
            PG8_LDA(At, 0, 1); PG8_STAGE(PG8_SB(0, 0), b2, voffB); PG8_STAGE(PG8_SB(0, 1), b2 + hstepB, voffB); PG8_STAGE(PG8_SA(0, 0), a2, voffA);
            PG8_WAIT_V(8); PG8_WAIT_L(0); PG8_BAR; PG8_MMA(1, 0, At, B0); PG8_MMA(1, 1, At, B1); PG8_BAR; PG8_SCHED;
            PG8_LDB(B0, 1, 0); PG8_LDB(B1, 1, 1); PG8_SCHED; PG8_LDA(At, 1, 0); PG8_STAGE(PG8_SA(0, 1), a2 + hstepA, voffA);
            PG8_WAIT_V(8); PG8_WAIT_L(0); PG8_BAR; PG8_MMA(0, 0, At, B0); PG8_MMA(0, 1, At, B1); PG8_BAR; PG8_SCHED;
            PG8_LDA(At, 1, 1); PG8_STAGE(PG8_SB(1, 0), b3, voffB); PG8_STAGE(PG8_SB(1, 1), b3 + hstepB, voffB); PG8_STAGE(PG8_SA(1, 0), a3, voffA);
            PG8_WAIT_V(8); PG8_WAIT_L(0); PG8_BAR; PG8_MMA(1, 0, At, B0); PG8_MMA(1, 1, At, B1); PG8_BAR; PG8_SCHED;
            } else {
            PG8_LDB(B0, 0, 0); PG8_SCHED; PG8_LDA(At, 0, 0); PG8_STAGE(PG8_SA(1, 1), a1 + hstepA, voffA);
            PG8_WAIT_L(8); PG8_BAR; PG8_WAIT_L(0); PG8_MMA(0, 0, At, B0); PG8_BAR; PG8_SCHED;
            PG8_LDB(B1, 0, 1); PG8_STAGE(PG8_SB(0, 0), b2, voffB);
            PG8_BAR; PG8_WAIT_L(0); PG8_MMA(0, 1, At, B1); PG8_BAR;
            PG8_LDA(At, 0, 1); PG8_STAGE(PG8_SA(0, 0), a2, voffA);
            PG8_BAR; PG8_WAIT_L(0); PG8_MMA(1, 0, At, B0); PG8_BAR; PG8_SCHED;
            PG8_STAGE(PG8_SB(0, 1), b2 + hstepB, voffB);
            PG8_WAIT_V(6); PG8_BAR; PG8_MMA(1, 1, At, B1); PG8_BAR;
            PG8_LDB(B0, 1, 0); PG8_SCHED; PG8_LDA(At, 1, 0); PG8_STAGE(PG8_SA(0, 1), a2 + hstepA, voffA);
            PG8_WAIT_L(8); PG8_BAR; PG8_WAIT_L(0); PG8_MMA(0, 0, At, B0); PG8_BAR; PG8_SCHED;
            PG8_LDB(B1, 1, 1); PG8_STAGE(PG8_SB(1, 0), b3, voffB);
            PG8_BAR; PG8_WAIT_L(0); PG8_MMA(0, 1, At, B1); PG8_BAR;
            PG8_LDA(At, 1, 1); PG8_STAGE(PG8_SA(1, 0), a3, voffA);
            PG8_BAR; PG8_WAIT_L(0); PG8_MMA(1, 0, At, B0); PG8_BAR; PG8_SCHED;
            PG8_STAGE(PG8_SB(1, 1), b3 + hstepB, voffB);
            PG8_WAIT_V(6); PG8_BAR; PG8_MMA(1, 1, At, B1); PG8_BAR;
            }
        }
        if constexpr (ALIGN_EPI) { if (wr == 0) PG8_BAR; }
        E(acc, cur, wr, wc, fr, fq, lds);
        if (!has_next) break;
#pragma unroll
        for (int a = 0; a < 2; ++a)
#pragma unroll
            for (int b = 0; b < 2; ++b)
#pragma unroll
                for (int m = 0; m < 4; ++m)
#pragma unroll
                    for (int n = 0; n < 2; ++n) acc[a][b][m][n] = (f32x4){0.f, 0.f, 0.f, 0.f};
        cur = nxt; cA = nA; cB = nB; ++ui;
        if constexpr (ALIGN_EPI) { if (wr == 1) PG8_BAR; }
    }
    PG8_WAIT_V(0);
    if constexpr (!ALIGN_EPI) { if (wr == 0) PG8_BAR; }
    PG8_BAR;
#undef PG8_SA
#undef PG8_SB
#undef PG8_STAGE
#undef PG8_LDA
#undef PG8_LDB
#undef PG8_MMA
#undef PG8_WAIT_V
#undef PG8_WAIT_L
#undef PG8_BAR
#undef PG8_SCHED
}

struct SchedDense {
    int nM, nN, nwg, G, c; const char* A; const char* B; size_t a_tile, b_tile; int pm_per_batch; size_t b_batch;
    __device__ __forceinline__ bool next(int i, Unit& u) const {
        const long L = (long)i * G + c; if (L >= nwg) return false;
        int wgid = (int)L; { const int q = nwg / NXCD, r = nwg % NXCD, xcd = wgid % NXCD, off = wgid / NXCD; wgid = (xcd < r ? xcd * (q + 1) : r * (q + 1) + (xcd - r) * q) + off; }
        const int nig = WGM * nN, gid = wgid / nig, fm = gid * WGM, gsz = (nM - fm) < WGM ? (nM - fm) : WGM;
        u.pm = fm + ((wgid % nig) % gsz); u.pn = (wgid % nig) / gsz; u.aux = 0;
        u.a = A + (size_t)u.pm * a_tile; u.b = B + (size_t)u.pn * b_tile + (size_t)(u.pm / pm_per_batch) * b_batch; return true;
    }
};
}
using pg8::Unit; using pg8::Acc;

struct EpiBf16 {
    static constexpr bool PERM = true;
    bf16_t* O; int ldc; size_t aux_stride; float scale;
    __device__ __forceinline__ void operator()(const Acc& acc, const Unit& u, int wr, int wc, int fr, int fq, LAS unsigned char*) const {
        bf16_t* base = O + (size_t)u.aux * aux_stride;
        const int row0 = u.pm * 256 + wr * 64 + fr, col0 = u.pn * 256 + wc * 32 + 8 * fq;
#pragma unroll
        for (int ai = 0; ai < 2; ++ai)
#pragma unroll
            for (int m = 0; m < 4; ++m) { bf16_t* rowp = base + (size_t)(row0 + ai * 128 + m * 16) * ldc + col0;
#pragma unroll
                for (int bj = 0; bj < 2; ++bj) { const f32x4 v0 = acc[ai][bj][m][0] * scale, v1 = acc[ai][bj][m][1] * scale;
                    u32x4 w; w.x = cvt_pk_bf16(v0[0], v0[1]); w.y = cvt_pk_bf16(v0[2], v0[3]); w.z = cvt_pk_bf16(v1[0], v1[1]); w.w = cvt_pk_bf16(v1[2], v1[3]);
                    *(u32x4*)(rowp + bj * 128) = w; } }
    }
};
struct EpiKV {
    static constexpr bool PERM = true;
    bf16_t* KB; bf16_t* VB;
    __device__ __forceinline__ void operator()(const Acc& acc, const Unit& u, int wr, int wc, int fr, int fq, LAS unsigned char*) const {
        bf16_t* base = (u.pn < 4 ? KB : VB) + (size_t)u.aux * MEMROWS * DM;
        const int row0 = u.pm * 256 + wr * 64 + fr, col0 = (u.pn & 3) * 256 + wc * 32 + 8 * fq;
#pragma unroll
        for (int ai = 0; ai < 2; ++ai)
#pragma unroll
            for (int m = 0; m < 4; ++m) { bf16_t* rowp = base + (size_t)(row0 + ai * 128 + m * 16) * DM + col0;
#pragma unroll
                for (int bj = 0; bj < 2; ++bj) { const f32x4 v0 = acc[ai][bj][m][0], v1 = acc[ai][bj][m][1];
                    u32x4 w; w.x = cvt_pk_bf16(v0[0], v0[1]); w.y = cvt_pk_bf16(v0[2], v0[3]); w.z = cvt_pk_bf16(v1[0], v1[1]); w.w = cvt_pk_bf16(v1[2], v1[3]);
                    *(u32x4*)(rowp + bj * 128) = w; } }
    }
};
struct EpiProj {
    static constexpr bool PERM = true;
    bf16_t* HG; bf16_t* AQKV; const float* rstd;
    __device__ __forceinline__ void operator()(const Acc& acc, const Unit& u, int wr, int wc, int fr, int fq, LAS unsigned char*) const {
        bf16_t* base; int ldc, colt;
        if (u.pn < 8) { base = HG; ldc = 2048; colt = u.pn * 256; } else { base = AQKV; ldc = 1536; colt = (u.pn - 8) * 256; }
        const int row0 = u.pm * 256 + wr * 64 + fr, col0 = colt + wc * 32 + 8 * fq;
#pragma unroll
        for (int ai = 0; ai < 2; ++ai)
#pragma unroll
            for (int m = 0; m < 4; ++m) { const int row = row0 + ai * 128 + m * 16; const float rs = rstd[row]; bf16_t* rowp = base + (size_t)row * ldc + col0;
#pragma unroll
                for (int bj = 0; bj < 2; ++bj) { const f32x4 v0 = acc[ai][bj][m][0] * rs, v1 = acc[ai][bj][m][1] * rs;
                    u32x4 w; w.x = cvt_pk_bf16(v0[0], v0[1]); w.y = cvt_pk_bf16(v0[2], v0[3]); w.z = cvt_pk_bf16(v1[0], v1[1]); w.w = cvt_pk_bf16(v1[2], v1[3]);
                    *(u32x4*)(rowp + bj * 128) = w; } }
    }
};
struct EpiResAdd {
    static constexpr bool PERM = false;
    float* X;
    __device__ __forceinline__ void operator()(const Acc& acc, const Unit& u, int wr, int wc, int fr, int fq, LAS unsigned char*) const {
        const int row0 = u.pm * 256 + wr * 64 + fr, col0 = u.pn * 256 + wc * 32 + 4 * fq;
#pragma unroll
        for (int ai = 0; ai < 2; ++ai)
#pragma unroll
            for (int m = 0; m < 4; ++m) { float* rowp = X + (size_t)(row0 + ai * 128 + m * 16) * DM + col0;
#pragma unroll
                for (int bj = 0; bj < 2; ++bj)
#pragma unroll
                    for (int n = 0; n < 2; ++n) { f32x4* p = (f32x4*)(rowp + bj * 128 + n * 16); *p = *p + acc[ai][bj][m][n]; } }
    }
};
struct EpiSoftmax {
    static constexpr bool PERM = false;
    bf16_t* P; const float* rstd;
    __device__ __forceinline__ void operator()(Acc& acc, const Unit& u, int wr, int wc, int fr, int fq, LAS unsigned char* lds) const {
        LAS f32x2* EX = (LAS f32x2*)(lds + SPARE_OFF);
        const int row0 = u.pm * 256 + wr * 64 + fr;
        float mw[2][4];
#pragma unroll
        for (int ai = 0; ai < 2; ++ai)
#pragma unroll
            for (int m = 0; m < 4; ++m) {
                const float rs = rstd[row0 + ai * 128 + m * 16];
                float mx = -3.0e38f;
#pragma unroll
                for (int bj = 0; bj < 2; ++bj)
#pragma unroll
                    for (int n = 0; n < 2; ++n) { f32x4 v = acc[ai][bj][m][n] * rs; acc[ai][bj][m][n] = v; mx = fmaxf(mx, fmaxf(fmaxf(v[0], v[1]), fmaxf(v[2], v[3]))); }
                mx = fmaxf(mx, __shfl_xor(mx, 16)); mx = fmaxf(mx, __shfl_xor(mx, 32));
                float sm = 0.f;
#pragma unroll
                for (int bj = 0; bj < 2; ++bj)
#pragma unroll
                    for (int n = 0; n < 2; ++n) { f32x4 v = acc[ai][bj][m][n]; v[0] = __expf(v[0] - mx); v[1] = __expf(v[1] - mx); v[2] = __expf(v[2] - mx); v[3] = __expf(v[3] - mx);
                        acc[ai][bj][m][n] = v; sm += (v[0] + v[1]) + (v[2] + v[3]); }
                sm += __shfl_xor(sm, 16); sm += __shfl_xor(sm, 32);
                mw[ai][m] = mx;
                if (fq == 0) EX[(ai * 128 + wr * 64 + m * 16 + fr) * 4 + wc] = (f32x2){mx, sm};
            }
        asm volatile("s_waitcnt lgkmcnt(0)" ::: "memory"); __builtin_amdgcn_s_barrier(); asm volatile("" ::: "memory");
#pragma unroll
        for (int ai = 0; ai < 2; ++ai)
#pragma unroll
            for (int m = 0; m < 4; ++m) {
                const int rl = ai * 128 + wr * 64 + m * 16 + fr;
                const f32x2 e0 = EX[rl * 4 + 0], e1 = EX[rl * 4 + 1], e2 = EX[rl * 4 + 2], e3 = EX[rl * 4 + 3];
                const float M = fmaxf(fmaxf(e0.x, e1.x), fmaxf(e2.x, e3.x));
                const float Ls = e0.y * __expf(e0.x - M) + e1.y * __expf(e1.x - M) + e2.y * __expf(e2.x - M) + e3.y * __expf(e3.x - M);
                const float f = __expf(mw[ai][m] - M) / Ls;
                bf16_t* rowp = P + (size_t)(row0 + ai * 128 + m * 16) * DM + u.pn * 256 + wc * 32 + 4 * fq;
#pragma unroll
                for (int bj = 0; bj < 2; ++bj)
#pragma unroll
                    for (int n = 0; n < 2; ++n) { const f32x4 v = acc[ai][bj][m][n] * f; u32x2 w; w.x = cvt_pk_bf16(v[0], v[1]); w.y = cvt_pk_bf16(v[2], v[3]);
                        *(u32x2*)(rowp + bj * 128 + n * 16) = w; }
            }
        asm volatile("s_waitcnt lgkmcnt(0)" ::: "memory"); __builtin_amdgcn_s_barrier(); asm volatile("" ::: "memory");
    }
};
struct EpiMoe1 {
    static constexpr bool PERM = true;
    bf16_t* ACTB; const float* srs; const float* sgw;
    __device__ __forceinline__ void operator()(const Acc& acc, const Unit& u, int wr, int wc, int fr, int fq, LAS unsigned char*) const {
        const int row0 = u.pm * 256 + wr * 64 + fr, col0 = u.pn * 128 + wc * 32 + 8 * fq;
#pragma unroll
        for (int ai = 0; ai < 2; ++ai)
#pragma unroll
            for (int m = 0; m < 4; ++m) { const int row = row0 + ai * 128 + m * 16; const float rs = srs[row], gw = sgw[row] * rs;
                float o[8];
#pragma unroll
                for (int n = 0; n < 2; ++n)
#pragma unroll
                    for (int j = 0; j < 4; ++j) { const float g = acc[ai][0][m][n][j] * rs, up = acc[ai][1][m][n][j]; o[n * 4 + j] = g * sigmoidf_(g) * up * gw; }
                u32x4 w; w.x = cvt_pk_bf16(o[0], o[1]); w.y = cvt_pk_bf16(o[2], o[3]); w.z = cvt_pk_bf16(o[4], o[5]); w.w = cvt_pk_bf16(o[6], o[7]);
                *(u32x4*)(ACTB + (size_t)row * EFF + col0) = w; }
    }
};

struct Args { const void* in[20]; float* out; unsigned char* ws; int ph_lo, ph_hi; };
struct Frame {
    LAS unsigned char* lds; volatile LAS unsigned* MISC; gu32* ctl;
    int tid, lane, wave, vcu, G;
    unsigned char* ws; float* out; size_t z;
};

__device__ __forceinline__ void transpose_item(const float* W, int N, const float* scale, bf16_t* WT, int ldt, int row_base, int k0, int n0, LAS float* scr, int lane) {
#pragma unroll 8
    for (int i = 0; i < 32; ++i) { const int kk = 2 * i + (lane >> 5); float v = W[(size_t)(k0 + kk) * N + n0 + (lane & 31)]; if (scale) v *= scale[k0 + kk]; scr[kk * 33 + (lane & 31)] = v; }
    LDS_WAIT(); asm volatile("" ::: "memory");
    const int c = lane & 7;
#pragma unroll
    for (int j = 0; j < 4; ++j) { const int n = (lane >> 3) + 8 * j; const LAS float* s = scr + (8 * c) * 33 + n;
        u32x4 o; o.x = pk2(s[0 * 33], s[1 * 33]); o.y = pk2(s[2 * 33], s[3 * 33]); o.z = pk2(s[4 * 33], s[5 * 33]); o.w = pk2(s[6 * 33], s[7 * 33]);
        *(GAS u32x4*)(WT + (size_t)(row_base + n0 + n) * ldt + k0 + 8 * c) = o; }
    LDS_WAIT(); asm volatile("" ::: "memory");
}
__device__ __forceinline__ void transpose_mat_item(const float* W, int K, int N, const float* scale, bf16_t* WT, int mode, int it, LAS float* scr, int lane) {
    const int nblk = N / 32, kb = it / nblk, nb = it % nblk, k0 = 64 * kb, n0 = 32 * nb;
    int row_base = 0;
    if (mode) row_base = 256 * (n0 / 128) + (n0 % 128) + (mode == 2 ? 128 : 0) - n0;
    transpose_item(W, N, scale, WT, K, row_base, k0, n0, scr, lane);
}

__device__ __forceinline__ float row_norm_prep(const float* xrow, bf16_t* xb_row, float* copy_row, int lane) {
    const GAS f32x4* xr = (const GAS f32x4*)xrow + lane;
    f32x4 v[4]; float s = 0.f;
#pragma unroll
    for (int j = 0; j < 4; ++j) { v[j] = xr[64 * j]; s += (v[j].x * v[j].x + v[j].y * v[j].y) + (v[j].z * v[j].z + v[j].w * v[j].w); }
    const float rstd = 1.f / sqrtf(wave_sum(s) * (1.f / DM) + EPS);
    GAS u32x2* o8 = (GAS u32x2*)xb_row + lane;
#pragma unroll
    for (int j = 0; j < 4; ++j) { u32x2 w; w.x = pk2(v[j].x, v[j].y); w.y = pk2(v[j].z, v[j].w); o8[64 * j] = w; }
    if (copy_row) { GAS f32x4* c = (GAS f32x4*)copy_row + lane;
#pragma unroll
        for (int j = 0; j < 4; ++j) c[64 * j] = v[j]; }
    return rstd;
}

__constant__ double INV_FREQ[32] = {1.0, 0.7498942093324559, 0.5623413251903491, 0.4216965034285822, 0.31622776601683794, 0.23713737056616552, 0.1778279410038923, 0.1333521432163324,
    0.1, 0.07498942093324558, 0.05623413251903491, 0.042169650342858224, 0.03162277660168379, 0.023713737056616554, 0.01778279410038923, 0.01333521432163324,
    0.01, 0.007498942093324558, 0.005623413251903491, 0.004216965034285823, 0.0031622776601683794, 0.0023713737056616554, 0.0017782794100389228, 0.001333521432163324,
    0.001, 0.0007498942093324559, 0.0005623413251903491, 0.00042169650342858224, 0.00031622776601683794, 0.00023713737056616554, 0.00017782794100389227, 0.0001333521432163324};


#define IN_F(i) ((const float*)((const char*)a.in[i] + F.z))
__device__ __forceinline__ void ph_init(Frame& F, const Args& a) {
    LAS float* scr = (LAS float*)(F.lds + F.wave * 16384);
    const int gw = F.vcu * NWAVES + F.wave, NGW = F.G * NWAVES, lane = F.lane;
    unsigned char* ws = F.ws;
    for (int it = gw; it < 2 * 3840; it += NGW) {
        const int l = it / 3840; int r = it % 3840;
        if (r < 1792) { transpose_mat_item(IN_F(4) + (size_t)l * DM * NIN, DM, NIN, IN_F(3) + l * DM, (bf16_t*)(ws + WS_WIN) + (size_t)l * NIN * DM, 0, r, scr, lane); continue; } r -= 1792;
        if (r < 512) { transpose_mat_item(IN_F(7) + (size_t)l * DM * DM, DM, DM, nullptr, (bf16_t*)(ws + WS_WOUT) + (size_t)l * DM * DM, 0, r, scr, lane); continue; } r -= 512;
        if (r < 1024) { transpose_mat_item(IN_F(11) + (size_t)l * DM * 2 * DM, DM, 2 * DM, nullptr, (bf16_t*)(ws + WS_WKVT) + (size_t)l * 2 * DM * DM, 0, r, scr, lane); continue; } r -= 1024;
        transpose_mat_item(IN_F(12) + (size_t)l * DM * DM, DM, DM, nullptr, (bf16_t*)(ws + WS_WOT) + (size_t)l * DM * DM, 0, r, scr, lane);
    }
    for (int r = gw; r < DEPTH * DM; r += NGW) {
        const float sc = IN_F(8)[r] * 0.0625f;
        const GAS f32x4* src = (const GAS f32x4*)(IN_F(10) + (size_t)r * DM) + lane; GAS u32x2* dst = (GAS u32x2*)((bf16_t*)(ws + WS_WQS) + (size_t)r * DM) + lane;
#pragma unroll
        for (int j = 0; j < 4; ++j) { const f32x4 v = src[64 * j] * sc; u32x2 w; w.x = pk2(v.x, v.y); w.y = pk2(v.z, v.w); dst[64 * j] = w; }
    }
    for (int r = gw; r < MEMROWS; r += NGW) {
        const GAS f32x4* xr = (const GAS f32x4*)(IN_F(1) + (size_t)r * DM) + lane;
        f32x4 v[4]; float s = 0.f;
#pragma unroll
        for (int j = 0; j < 4; ++j) { v[j] = xr[64 * j]; s += (v[j].x * v[j].x + v[j].y * v[j].y) + (v[j].z * v[j].z + v[j].w * v[j].w); }
        const float rstd = 1.f / sqrtf(wave_sum(s) * (1.f / DM) + EPS);
        for (int l = 0; l < DEPTH; ++l) {
            const GAS f32x4* g = (const GAS f32x4*)(IN_F(9) + l * DM) + lane; GAS u32x2* dst = (GAS u32x2*)((bf16_t*)(ws + WS_MEMN) + ((size_t)l * MEMROWS + r) * DM) + lane;
#pragma unroll
            for (int j = 0; j < 4; ++j) { const f32x4 o = v[j] * rstd * g[64 * j]; u32x2 w; w.x = pk2(o.x, o.y); w.y = pk2(o.z, o.w); dst[64 * j] = w; }
        }
    }
    for (int r = gw; r < MT; r += NGW) {
        const float rs = row_norm_prep(IN_F(0) + (size_t)r * DM, (bf16_t*)(ws + WS_XB) + (size_t)r * DM, F.out + (size_t)r * DM, lane);
        if (lane == 0) ((float*)(ws + WS_RSTD))[r] = rs;
    }
    for (int i = (F.vcu * NTHR + F.tid); i < DEPTH * DM * 20; i += F.G * NTHR) {
        const int l = i / (DM * 20), k = (i / 20) % DM, j = i % 20;
        const float g = IN_F(13)[l * DM + k];
        const float w = j < 4 ? IN_F(14)[((size_t)l * DM + k) * 4 + j] : IN_F(15)[((size_t)l * DM + k) * 16 + (j - 4)];
        ((float*)(ws + WS_WR))[i] = g * w;
    }
}

struct SchedKV {
    int G, c; const char* memn; const char* wkvt;
    __device__ __forceinline__ bool next(int i, Unit& u) const {
        const int L = i * G + c; if (L >= 32) return false;
        const int l = L >> 4; u.pm = (L >> 3) & 1; u.pn = L & 7; u.aux = l;
        u.a = memn + ((size_t)l * MEMROWS + u.pm * 256) * DM * 2; u.b = wkvt + ((size_t)l * 2 * DM + u.pn * 256) * DM * 2; return true;
    }
};
struct SchedFold {
    int G, c; const char* kb; const char* vb; const char* wqs; const char* wot;
    __device__ __forceinline__ bool next(int i, Unit& u) const {
        const int L = i * G + c; if (L >= 128) return false;
        const int ty = L >> 6, l = (L >> 5) & 1, b = (L >> 4) & 1, h = (L >> 2) & 3, t = L & 3; u.aux = ty * 4 + l * 2 + b;
        if (ty == 0) { u.pm = h; u.pn = t; u.a = kb + (((size_t)l * MEMROWS + b * 256) * DM + h * 256) * 2; u.b = wqs + (((size_t)l * DM + t * 256) * DM + h * 256) * 2; }
        else { u.pm = t; u.pn = h; u.a = wot + (((size_t)l * DM + t * 256) * DM + h * 256) * 2; u.b = vb + (((size_t)l * MEMROWS + b * 256) * DM + h * 256) * 2; }
        return true;
    }
};
struct SchedMoe {
    int G, c, kdim; volatile LAS unsigned* tb; const char* A; const char* B;
    __device__ __forceinline__ bool next(int i, Unit& u) const {
        const int L = i * G + c; const int total = (int)tb[16] * 4; if (L >= total) return false;
        const int mt = L >> 2; u.pm = mt; u.pn = L & 3; int e = 0;
#pragma unroll
        for (int j = 1; j < 16; ++j) e += (mt >= (int)tb[j]) ? 1 : 0;
        u.aux = e; u.a = A + (size_t)mt * 256 * kdim * 2; u.b = B + ((size_t)e * 1024 + u.pn * 256) * kdim * 2; return true;
    }
};

__device__ __forceinline__ void prep_unit(Frame& F, const Args& a, int blk) {
    unsigned char* ws = F.ws; const int lane = F.lane, wave = F.wave, tid = F.tid;
    const bf16_t* AQKV = (const bf16_t*)(ws + A_AQKV); bf16_t* QR = (bf16_t*)(ws + A_QR); bf16_t* KR = (bf16_t*)(ws + A_KR);
    const int row0 = blk * 64, b = row0 / SEQ, s0 = row0 % SEQ;
    LAS unsigned short* Vl = (LAS unsigned short*)F.lds;
#pragma unroll
    for (int p = 0; p < 8; ++p) { const int r = p * 8 + (tid >> 6), ch = tid & 63;
        const u32x4 v = *(const GAS u32x4*)(AQKV + (size_t)(row0 + r) * 1536 + 1024 + ch * 8); *(LAS u32x4*)(Vl + r * 512 + ch * 8) = v; }
    const int j = lane & 31, hg = lane >> 5; const int* pos = (const int*)((const char*)a.in[2] + F.z);
    for (int rr = 0; rr < 8; ++rr) {
        const int row = row0 + wave * 8 + rr;
        const double ang = (double)pos[row] * INV_FREQ[j]; double rev = ang * 0.15915494309189535; rev = rev - __builtin_floor(rev);
        const float fr = (float)rev, cs = __builtin_amdgcn_cosf(fr), sn = __builtin_amdgcn_sinf(fr);
        const bf16_t* src = AQKV + (size_t)row * 1536;
#pragma unroll
        for (int hh = 0; hh < 4; ++hh) { const int c0 = (hg * 4 + hh) * 64 + j;
            const float q1 = bf2f(src[c0]), q2 = bf2f(src[c0 + 32]), k1 = bf2f(src[512 + c0]), k2 = bf2f(src[512 + c0 + 32]);
            QR[(size_t)row * 512 + c0] = (bf16_t)f2bf((q1 * cs - q2 * sn) * 0.125f); QR[(size_t)row * 512 + c0 + 32] = (bf16_t)f2bf((q2 * cs + q1 * sn) * 0.125f);
            KR[(size_t)row * 512 + c0] = (bf16_t)f2bf(k1 * cs - k2 * sn); KR[(size_t)row * 512 + c0 + 32] = (bf16_t)f2bf(k2 * cs + k1 * sn); }
    }
    __syncthreads();
    { const int hd = tid; const size_t rb = ((size_t)(b * ATH + (hd >> 6)) * 64 + (hd & 63)) * SEQ;
      bf16_t* v1 = (bf16_t*)(ws + A_VT1) + rb; bf16_t* v4 = (bf16_t*)(ws + A_VT4) + rb; bf16_t* v16 = (bf16_t*)(ws + A_VT16) + rb;
#pragma unroll
      for (int g = 0; g < 8; ++g) { unsigned w[4];
#pragma unroll
          for (int q = 0; q < 4; ++q) w[q] = (unsigned)Vl[(g * 8 + 2 * q) * 512 + hd] | ((unsigned)Vl[(g * 8 + 2 * q + 1) * 512 + hd] << 16);
          *(u32x4*)(v1 + s0 + g * 8) = (u32x4){w[0], w[1], w[2], w[3]}; }
#pragma unroll
      for (int r = 0; r < 4; ++r)
#pragma unroll
          for (int g = 0; g < 2; ++g) { unsigned w[4];
#pragma unroll
              for (int q = 0; q < 4; ++q) w[q] = (unsigned)Vl[(4 * (g * 8 + 2 * q) + r) * 512 + hd] | ((unsigned)Vl[(4 * (g * 8 + 2 * q + 1) + r) * 512 + hd] << 16);
              *(u32x4*)(v4 + r * (SEQ / 4) + (s0 >> 2) + g * 8) = (u32x4){w[0], w[1], w[2], w[3]}; }
#pragma unroll
      for (int r = 0; r < 16; ++r) { u32x2 w;
          w.x = (unsigned)Vl[(r) * 512 + hd] | ((unsigned)Vl[(16 + r) * 512 + hd] << 16); w.y = (unsigned)Vl[(32 + r) * 512 + hd] | ((unsigned)Vl[(48 + r) * 512 + hd] << 16);
          *(u32x2*)(v16 + r * (SEQ / 16) + (s0 >> 4)) = w; }
    }
    __syncthreads();
}

__device__ __forceinline__ float hg_lb(const Frame& F, const Args& a, int l, int c) { if (l == 0) return 0.f; const float* h = IN_F(5); return sigmoidf_(h[HGW + c] - h[c]); }

__device__ __forceinline__ void hg_a_unit(Frame& F, const Args& a, int l, int unit) {
    unsigned char* ws = F.ws; const int tid = F.tid;
    const int b = unit >> 9, h = (unit >> 7) & 3, c = unit & 127; const int row0 = b * SEQ + c * CHUNK;
    const bf16_t* HG = (const bf16_t*)(ws + A_HG);
    LAS float* Bc = (LAS float*)F.lds; LAS float* KK = (LAS float*)(F.lds + 32768); LAS unsigned short* Vs = (LAS unsigned short*)(F.lds + 65536);
    { const int t = tid >> 3, k0 = (tid & 7) * 16; const bf16_t* rowp = HG + (size_t)(row0 + t) * 2048 + h * 128 + k0;
      const u32x4 z0 = *(const GAS u32x4*)(rowp + 512), z1 = *(const GAS u32x4*)(rowp + 512 + 8), v0 = *(const GAS u32x4*)(rowp + 1024), v1 = *(const GAS u32x4*)(rowp + 1024 + 8);
      const unsigned zz[8] = {z0.x, z0.y, z0.z, z0.w, z1.x, z1.y, z1.z, z1.w};
#pragma unroll
      for (int i = 0; i < 8; ++i) {
#pragma unroll
          for (int hh = 0; hh < 2; ++hh) { const int k = k0 + 2 * i + hh; const float z = hh ? bfhi(zz[i]) : bflo(zz[i]); const float lb = hg_lb(F, a, l, h * 128 + k);
              const float sg = sigmoidf_(z), f = lb + (1.f - lb) * sg; Bc[t * 128 + k] = __logf(f); KK[t * 128 + k] = (1.f - lb) * sigmoidf_(-z); } }
      *(LAS u32x4*)(Vs + t * 128 + k0) = v0; *(LAS u32x4*)(Vs + t * 128 + k0 + 8) = v1; }
    __syncthreads();
    if (tid < 128) { float s = 0.f; for (int t = 0; t < CHUNK; ++t) { s += Bc[t * 128 + tid]; Bc[t * 128 + tid] = s; } ((float*)(ws + A_DECAY))[(size_t)unit * 128 + tid] = __expf(s); }
    __syncthreads();
    { const int t = tid >> 3, k0 = (tid & 7) * 16;
#pragma unroll
      for (int i = 0; i < 16; ++i) { const int k = k0 + i; KK[t * 128 + k] *= __expf(Bc[63 * 128 + k] - Bc[t * 128 + k]); } }
    __syncthreads();
    { const int v = tid & 127, kg = tid >> 7; float acc[32];
#pragma unroll
      for (int i = 0; i < 32; ++i) acc[i] = 0.f;
      for (int s = 0; s < CHUNK; ++s) { const float vv = bf2f(Vs[s * 128 + v]);
#pragma unroll
          for (int i4 = 0; i4 < 8; ++i4) { const f32x4 kk = *(const LAS f32x4*)(KK + s * 128 + kg * 32 + i4 * 4); acc[i4 * 4 + 0] += kk.x * vv; acc[i4 * 4 + 1] += kk.y * vv; acc[i4 * 4 + 2] += kk.z * vv; acc[i4 * 4 + 3] += kk.w * vv; } }
      bf16_t* st = (bf16_t*)(ws + A_STATE) + (size_t)unit * 16384;
#pragma unroll
      for (int i = 0; i < 32; ++i) st[v * 128 + (kg * 32 + i)] = (bf16_t)f2bf(acc[i]); }
    __syncthreads();
}


__device__ __forceinline__ void hg_build_b(Frame& F, const Args& a, int l, int h, const bf16_t* rowp  , int k0, float (&bb)[16], float (&kk)[16]) {
    const int tid = F.tid, lane = F.lane, wave = F.wave, tl = lane >> 3;
    LAS float* WT = (LAS float*)F.lds; LAS float* REF = (LAS float*)(F.lds + 4096);
    const u32x4 z0 = *(const GAS u32x4*)(rowp + 512), z1 = *(const GAS u32x4*)(rowp + 512 + 8);
    const unsigned zz[8] = {z0.x, z0.y, z0.z, z0.w, z1.x, z1.y, z1.z, z1.w};
#pragma unroll
    for (int i = 0; i < 16; ++i) { const float z = (i & 1) ? bfhi(zz[i >> 1]) : bflo(zz[i >> 1]); const float lb = hg_lb(F, a, l, h * 128 + k0 + i);
        const float sg = sigmoidf_(z), f = lb + (1.f - lb) * sg; bb[i] = __logf(f); kk[i] = (1.f - lb) * sigmoidf_(-z); }
#pragma unroll
    for (int i = 0; i < 16; ++i) { float x = bb[i]; float y;
        y = __shfl_up(x, 8); if (tl >= 1) x += y;
        y = __shfl_up(x, 16); if (tl >= 2) x += y;
        y = __shfl_up(x, 32); if (tl >= 4) x += y;
        bb[i] = x; }
    if (tl == 7) {
#pragma unroll
        for (int i = 0; i < 16; i += 4) *(LAS f32x4*)(WT + wave * 128 + k0 + i) = (f32x4){bb[i], bb[i + 1], bb[i + 2], bb[i + 3]}; }
    __syncthreads();
    for (int w = 0; w < wave; ++w) {
#pragma unroll
        for (int i = 0; i < 16; i += 4) { const f32x4 p = *(const LAS f32x4*)(WT + w * 128 + k0 + i); bb[i] += p.x; bb[i + 1] += p.y; bb[i + 2] += p.z; bb[i + 3] += p.w; } }
    if (tl == 7 && (wave & 1)) {
#pragma unroll
        for (int i = 0; i < 16; i += 4) *(LAS f32x4*)(REF + (wave >> 1) * 128 + k0 + i) = (f32x4){bb[i], bb[i + 1], bb[i + 2], bb[i + 3]}; }
    __syncthreads();
    (void)tid;
}
__device__ __forceinline__ void st_row16(LAS unsigned char* base, int byteoff, const float (&v)[16]) {
    u32x4 w0, w1; w0.x = pk2(v[0], v[1]); w0.y = pk2(v[2], v[3]); w0.z = pk2(v[4], v[5]); w0.w = pk2(v[6], v[7]); w1.x = pk2(v[8], v[9]); w1.y = pk2(v[10], v[11]); w1.z = pk2(v[12], v[13]); w1.w = pk2(v[14], v[15]);
    *(LAS u32x4*)(base + byteoff) = w0; *(LAS u32x4*)(base + byteoff + 16) = w1;
}
constexpr int HL_RED = 6144, HL_QD = 8192, HL_KD = 25600, HL_QE = 43008, HL_Q1 = 60416, HL_K1 = 69120, HL_Q2 = 77824, HL_K2 = 86528, HL_VT = 95232, HL_SC = 113664;
constexpr int HA_KT = 8192, HA_VT = 26624;
constexpr int RS128 = 272, RS64 = 144;

__device__ __forceinline__ void hg_a2_unit(Frame& F, const Args& a, int l, int unit) {
    unsigned char* ws = F.ws; const int tid = F.tid, lane = F.lane, wave = F.wave;
    const int b = unit >> 9, h = (unit >> 7) & 3, c = unit & 127; const int row0 = b * SEQ + c * CHUNK;
    const int t = tid >> 3, k0 = (tid & 7) * 16;
    const bf16_t* rowp = (const bf16_t*)(ws + A_HG) + (size_t)(row0 + t) * 2048 + h * 128 + k0;
    const u32x4 v0 = *(const GAS u32x4*)(rowp + 1024), v1 = *(const GAS u32x4*)(rowp + 1024 + 8);
    float bb[16], kk[16];
    hg_build_b(F, a, l, h, rowp, k0, bb, kk);
    const LAS float* REF = (const LAS float*)(F.lds + 4096);
    LAS unsigned short* KT = (LAS unsigned short*)(F.lds + HA_KT); LAS unsigned short* VT = (LAS unsigned short*)(F.lds + HA_VT);
    const unsigned vv[8] = {v0.x, v0.y, v0.z, v0.w, v1.x, v1.y, v1.z, v1.w};
#pragma unroll
    for (int i = 0; i < 16; ++i) { const float b63 = REF[3 * 128 + k0 + i];
        KT[(k0 + i) * (RS64 / 2) + t] = (unsigned short)f2bf(kk[i] * __expf(b63 - bb[i]));
        VT[(k0 + i) * (RS64 / 2) + t] = (unsigned short)((i & 1) ? (vv[i >> 1] >> 16) : (vv[i >> 1] & 0xffffu)); }
    if (tid < 128) ((float*)(ws + A_DECAY))[(size_t)unit * 128 + tid] = __expf(REF[3 * 128 + tid]);
    __syncthreads();
    { const int fr = lane & 15, g = lane >> 4;
      bf16x8 af[2];
#pragma unroll
      for (int ks = 0; ks < 2; ++ks) af[ks] = *(const LAS bf16x8*)(F.lds + HA_KT + (wave * 16 + fr) * RS64 + (32 * ks + 8 * g) * 2);
      bf16_t* st = (bf16_t*)(ws + A_STATE) + (size_t)unit * 16384;
#pragma unroll
      for (int vt = 0; vt < 8; ++vt) { f32x4 acc = {0.f, 0.f, 0.f, 0.f};
#pragma unroll
          for (int ks = 0; ks < 2; ++ks) { const bf16x8 bf = *(const LAS bf16x8*)(F.lds + HA_VT + (vt * 16 + fr) * RS64 + (32 * ks + 8 * g) * 2); acc = __builtin_amdgcn_mfma_f32_16x16x32_bf16(af[ks], bf, acc, 0, 0, 0); }
          u32x2 w; w.x = cvt_pk_bf16(acc[0], acc[1]); w.y = cvt_pk_bf16(acc[2], acc[3]);
          *(GAS u32x2*)(st + (vt * 16 + fr) * 128 + wave * 16 + 4 * g) = w; } }
    __syncthreads();
}

__device__ __forceinline__ void hg_c2_unit(Frame& F, const Args& a, int l, int unit) {
    unsigned char* ws = F.ws; const int tid = F.tid, lane = F.lane, wave = F.wave;
    const int b = unit >> 9, h = (unit >> 7) & 3, c = unit & 127; const int row0 = b * SEQ + c * CHUNK;
    const int t = tid >> 3, k0 = (tid & 7) * 16;
    const bf16_t* HG = (const bf16_t*)(ws + A_HG);
    const bf16_t* rowp = HG + (size_t)(row0 + t) * 2048 + h * 128 + k0;
    const u32x4 q0 = *(const GAS u32x4*)(rowp), q1 = *(const GAS u32x4*)(rowp + 8), v0 = *(const GAS u32x4*)(rowp + 1024), v1 = *(const GAS u32x4*)(rowp + 1024 + 8);
    float bb[16], kk[16];
    hg_build_b(F, a, l, h, rowp, k0, bb, kk);
    const LAS float* REF = (const LAS float*)(F.lds + 4096);
    { const unsigned qq[8] = {q0.x, q0.y, q0.z, q0.w, q1.x, q1.y, q1.z, q1.w}, vv[8] = {v0.x, v0.y, v0.z, v0.w, v1.x, v1.y, v1.z, v1.w};
      LAS unsigned short* VT = (LAS unsigned short*)(F.lds + HL_VT);
      float qv[16], tmp[16];
#pragma unroll
      for (int i = 0; i < 16; ++i) { qv[i] = (i & 1) ? bfhi(qq[i >> 1]) : bflo(qq[i >> 1]); VT[(k0 + i) * (RS64 / 2) + t] = (unsigned short)((i & 1) ? (vv[i >> 1] >> 16) : (vv[i >> 1] & 0xffffu)); }
      const int I = t >> 4;
#pragma unroll
      for (int i = 0; i < 16; ++i) { const float be = I ? REF[(I - 1) * 128 + k0 + i] : 0.f; tmp[i] = qv[i] * __expf(bb[i] - be); }
      st_row16(F.lds, HL_QD + t * RS128 + k0 * 2, tmp);
#pragma unroll
      for (int i = 0; i < 16; ++i) { const float be = I ? REF[(I - 1) * 128 + k0 + i] : 0.f; tmp[i] = kk[i] * __expf(fminf(be - bb[i], 60.f)); }
      st_row16(F.lds, HL_KD + t * RS128 + k0 * 2, tmp);
#pragma unroll
      for (int i = 0; i < 16; ++i) tmp[i] = qv[i] * __expf(bb[i]);
      st_row16(F.lds, HL_QE + t * RS128 + k0 * 2, tmp);
#pragma unroll
      for (int i = 0; i < 16; ++i) { const float r1 = REF[1 * 128 + k0 + i]; tmp[i] = (t >= 32) ? qv[i] * __expf(bb[i] - r1) : kk[i] * __expf(r1 - bb[i]); }
      st_row16(F.lds, ((t >= 32) ? HL_Q1 : HL_K1) + (t & 31) * RS128 + k0 * 2, tmp);
#pragma unroll
      for (int i = 0; i < 16; ++i) { const float r2 = REF[((t >= 32) ? 2 : 0) * 128 + k0 + i]; tmp[i] = (t & 16) ? qv[i] * __expf(bb[i] - r2) : kk[i] * __expf(r2 - bb[i]); }
      st_row16(F.lds, ((t & 16) ? HL_Q2 : HL_K2) + ((t & 15) + ((t >= 32) ? 16 : 0)) * RS128 + k0 * 2, tmp);
      for (int i = tid; i < 64 * RS64 / 16; i += NTHR) *(LAS u32x4*)(F.lds + HL_SC + i * 16) = (u32x4){0u, 0u, 0u, 0u};
    }
    __syncthreads();
    const int fr = lane & 15, g = lane >> 4;
    for (int blk = wave; blk < 10; blk += 8) {
        int ko, qo, J, I; bool diag = false;
        if (blk < 4) { ko = HL_KD + blk * 16 * RS128; qo = HL_QD + blk * 16 * RS128; J = blk; I = blk; diag = true; }
        else if (blk == 4) { ko = HL_K2; qo = HL_Q2; J = 0; I = 1; }
        else if (blk == 5) { ko = HL_K2 + 16 * RS128; qo = HL_Q2 + 16 * RS128; J = 2; I = 3; }
        else { const int jj = (blk - 6) >> 1, ii = (blk - 6) & 1; ko = HL_K1 + jj * 16 * RS128; qo = HL_Q1 + ii * 16 * RS128; J = jj; I = 2 + ii; }
        f32x4 acc = {0.f, 0.f, 0.f, 0.f};
#pragma unroll
        for (int ks = 0; ks < 4; ++ks) { const bf16x8 af = *(const LAS bf16x8*)(F.lds + ko + fr * RS128 + (32 * ks + 8 * g) * 2), bf = *(const LAS bf16x8*)(F.lds + qo + fr * RS128 + (32 * ks + 8 * g) * 2);
            acc = __builtin_amdgcn_mfma_f32_16x16x32_bf16(af, bf, acc, 0, 0, 0); }
        if (diag) {
#pragma unroll
            for (int rg = 0; rg < 4; ++rg) if (4 * g + rg > fr) acc[rg] = 0.f; }
        u32x2 w; w.x = cvt_pk_bf16(acc[0], acc[1]); w.y = cvt_pk_bf16(acc[2], acc[3]);
        *(LAS u32x2*)(F.lds + HL_SC + (16 * I + fr) * RS64 + (16 * J + 4 * g) * 2) = w;
    }
    __syncthreads();
    f32x4 o[4];
#pragma unroll
    for (int I = 0; I < 4; ++I) o[I] = (f32x4){0.f, 0.f, 0.f, 0.f};
    { bf16x8 af[2];
#pragma unroll
      for (int ks = 0; ks < 2; ++ks) af[ks] = *(const LAS bf16x8*)(F.lds + HL_VT + (wave * 16 + fr) * RS64 + (32 * ks + 8 * g) * 2);
#pragma unroll
      for (int I = 0; I < 4; ++I)
#pragma unroll
          for (int ks = 0; ks < 2; ++ks) { const bf16x8 bf = *(const LAS bf16x8*)(F.lds + HL_SC + (16 * I + fr) * RS64 + (32 * ks + 8 * g) * 2); o[I] = __builtin_amdgcn_mfma_f32_16x16x32_bf16(af[ks], bf, o[I], 0, 0, 0); }
      const bf16_t* st = (const bf16_t*)(ws + A_STATE) + (size_t)unit * 16384 + (wave * 16 + fr) * 128;
      bf16x8 sf[4];
#pragma unroll
      for (int ks = 0; ks < 4; ++ks) sf[ks] = *(const GAS bf16x8*)(st + 32 * ks + 8 * g);
#pragma unroll
      for (int I = 0; I < 4; ++I)
#pragma unroll
          for (int ks = 0; ks < 4; ++ks) { const bf16x8 bf = *(const LAS bf16x8*)(F.lds + HL_QE + (16 * I + fr) * RS128 + (32 * ks + 8 * g) * 2); o[I] = __builtin_amdgcn_mfma_f32_16x16x32_bf16(sf[ks], bf, o[I], 0, 0, 0); }
    }
    LAS float* RED = (LAS float*)(F.lds + HL_RED);
#pragma unroll
    for (int I = 0; I < 4; ++I) { float q = (o[I][0] * o[I][0] + o[I][1] * o[I][1]) + (o[I][2] * o[I][2] + o[I][3] * o[I][3]); q += __shfl_xor(q, 16); q += __shfl_xor(q, 32); if (g == 0) RED[wave * 64 + 16 * I + fr] = q; }
    __syncthreads();
    { const f32x4 gain = *(const GAS f32x4*)(IN_F(6) + l * HGW + h * 128 + wave * 16 + 4 * g);
      bf16_t* Y = (bf16_t*)(ws + WS_XB);
#pragma unroll
      for (int I = 0; I < 4; ++I) { const int tt = 16 * I + fr; float ssq = 0.f;
#pragma unroll
          for (int w = 0; w < 8; ++w) ssq += RED[w * 64 + tt];
          const float rs = 1.f / sqrtf(ssq * (1.f / 128.f) + EPS);
          const u32x2 gw = *(const GAS u32x2*)(HG + (size_t)(row0 + tt) * 2048 + 1536 + h * 128 + wave * 16 + 4 * g);
          const float g0 = bflo(gw.x), g1 = bfhi(gw.x), g2 = bflo(gw.y), g3 = bfhi(gw.y);
          u32x2 w; w.x = cvt_pk_bf16(o[I][0] * rs * gain.x * (g0 * sigmoidf_(g0)), o[I][1] * rs * gain.y * (g1 * sigmoidf_(g1)));
          w.y = cvt_pk_bf16(o[I][2] * rs * gain.z * (g2 * sigmoidf_(g2)), o[I][3] * rs * gain.w * (g3 * sigmoidf_(g3)));
          *(GAS u32x2*)(Y + (size_t)(row0 + tt) * DM + h * 128 + wave * 16 + 4 * g) = w; } }
    __syncthreads();
}

__device__ __forceinline__ void hg_scan(Frame& F) {
    unsigned char* ws = F.ws;
    for (int gid = F.vcu * NTHR + F.tid; gid < BATCH * HGH * 16384; gid += F.G * NTHR) {
        const int bh = gid >> 14, e = gid & 16383, k = e & 127;
        bf16_t* st = (bf16_t*)(ws + A_STATE) + (size_t)bh * NCHUNK * 16384 + e; const float* dc = (const float*)(ws + A_DECAY) + (size_t)bh * NCHUNK * 128 + k;
        float S = 0.f;
        for (int c0 = 0; c0 < NCHUNK; c0 += 8) { float kv[8], d[8];
#pragma unroll
            for (int i = 0; i < 8; ++i) { kv[i] = bf2f(st[(size_t)(c0 + i) * 16384]); d[i] = dc[(c0 + i) * 128]; }
#pragma unroll
            for (int i = 0; i < 8; ++i) { st[(size_t)(c0 + i) * 16384] = (bf16_t)f2bf(S); S = d[i] * S + kv[i]; } }
    }
}

__device__ __forceinline__ void hg_c_unit(Frame& F, const Args& a, int l, int unit) {
    unsigned char* ws = F.ws; const int tid = F.tid, lane = F.lane, wave = F.wave;
    const int b = unit >> 9, h = (unit >> 7) & 3, c = unit & 127; const int row0 = b * SEQ + c * CHUNK;
    const bf16_t* HG = (const bf16_t*)(ws + A_HG);
    LAS float* Bc = (LAS float*)F.lds; LAS float* KK = (LAS float*)(F.lds + 32768); LAS unsigned short* Qs = (LAS unsigned short*)(F.lds + 65536); LAS unsigned short* Vs = (LAS unsigned short*)(F.lds + 81920);
    LAS float* SC = (LAS float*)(F.lds + 98304); LAS float* RED = (LAS float*)(F.lds + 114688);
    { const int t = tid >> 3, k0 = (tid & 7) * 16; const bf16_t* rowp = HG + (size_t)(row0 + t) * 2048 + h * 128 + k0;
      const u32x4 q0 = *(const GAS u32x4*)(rowp), q1 = *(const GAS u32x4*)(rowp + 8);
      const u32x4 z0 = *(const GAS u32x4*)(rowp + 512), z1 = *(const GAS u32x4*)(rowp + 512 + 8), v0 = *(const GAS u32x4*)(rowp + 1024), v1 = *(const GAS u32x4*)(rowp + 1024 + 8);
      const unsigned zz[8] = {z0.x, z0.y, z0.z, z0.w, z1.x, z1.y, z1.z, z1.w};
#pragma unroll
      for (int i = 0; i < 8; ++i) {
#pragma unroll
          for (int hh = 0; hh < 2; ++hh) { const int k = k0 + 2 * i + hh; const float z = hh ? bfhi(zz[i]) : bflo(zz[i]); const float lb = hg_lb(F, a, l, h * 128 + k);
              const float sg = sigmoidf_(z), f = lb + (1.f - lb) * sg; Bc[t * 128 + k] = __logf(f); KK[t * 128 + k] = (1.f - lb) * sigmoidf_(-z); } }
      *(LAS u32x4*)(Qs + t * 128 + k0) = q0; *(LAS u32x4*)(Qs + t * 128 + k0 + 8) = q1;
      *(LAS u32x4*)(Vs + t * 128 + k0) = v0; *(LAS u32x4*)(Vs + t * 128 + k0 + 8) = v1; }
    __syncthreads();
    if (tid < 128) { float s = 0.f; for (int t = 0; t < CHUNK; ++t) { s += Bc[t * 128 + tid]; Bc[t * 128 + tid] = s; } }
    __syncthreads();
    { const int t = tid >> 3, sg = tid & 7;
      for (int si = 0; si < 8; ++si) { const int s = sg * 8 + si; float acc = 0.f;
          if (s <= t) { for (int kk = 0; kk < 128; ++kk) { const int k = (kk + lane) & 127; acc += bf2f(Qs[t * 128 + k]) * KK[s * 128 + k] * __expf(Bc[t * 128 + k] - Bc[s * 128 + k]); } }
          SC[t * 64 + s] = acc; } }
    __syncthreads();
    { const int t = tid >> 3, k0 = (tid & 7) * 16;
#pragma unroll
      for (int i = 0; i < 16; ++i) { const int k = k0 + i; Bc[t * 128 + k] = bf2f(Qs[t * 128 + k]) * __expf(Bc[t * 128 + k]); } }
    __syncthreads();
    { const int v = tid & 127, tg = tid >> 7; float acc[16];
#pragma unroll
      for (int i = 0; i < 16; ++i) acc[i] = 0.f;
      for (int s = 0; s < CHUNK; ++s) { const float vv = bf2f(Vs[s * 128 + v]);
#pragma unroll
          for (int i = 0; i < 16; ++i) acc[i] += SC[(tg * 16 + i) * 64 + s] * vv; }
      const bf16_t* st = (const bf16_t*)(ws + A_STATE) + (size_t)unit * 16384;
      for (int k = 0; k < 128; ++k) { const float sv = bf2f(st[v * 128 + k]);
#pragma unroll
          for (int i = 0; i < 16; ++i) acc[i] += Bc[(tg * 16 + i) * 128 + k] * sv; }
#pragma unroll
      for (int i = 0; i < 16; ++i) { const float q = wave_sum(acc[i] * acc[i]); if (lane == 0) RED[wave * 16 + i] = q; }
      __syncthreads();
      const float gain = IN_F(6)[l * HGW + h * 128 + v];
      bf16_t* Y = (bf16_t*)(ws + WS_XB);
#pragma unroll
      for (int i = 0; i < 16; ++i) { const int t = tg * 16 + i; const float ssq = RED[(2 * tg) * 16 + i] + RED[(2 * tg + 1) * 16 + i];
          const float g = bf2f(HG[(size_t)(row0 + t) * 2048 + 1536 + h * 128 + v]);
          const float y = acc[i] * (1.f / sqrtf(ssq * (1.f / 128.f) + EPS)) * gain * (g * sigmoidf_(g));
          Y[(size_t)(row0 + t) * DM + h * 128 + v] = (bf16_t)f2bf(y); } }
    __syncthreads();
}

__device__ __forceinline__ void att_task(Frame& F, int task) {
    unsigned char* ws = F.ws; const int lane = F.lane;
    const int tb = task >> 3, h = task & 7; const int row = tb * 64 + lane, s = row % SEQ;
    const bf16_t* QR = (const bf16_t*)(ws + A_QR); const bf16_t* KR = (const bf16_t*)(ws + A_KR); const bf16_t* AQKV = (const bf16_t*)(ws + A_AQKV);
    float q[64], o[64];
#pragma unroll
    for (int i = 0; i < 8; ++i) { const u32x4 w = *(const GAS u32x4*)(QR + (size_t)row * 512 + h * 64 + i * 8);
        q[i * 8 + 0] = bflo(w.x); q[i * 8 + 1] = bfhi(w.x); q[i * 8 + 2] = bflo(w.y); q[i * 8 + 3] = bfhi(w.y); q[i * 8 + 4] = bflo(w.z); q[i * 8 + 5] = bfhi(w.z); q[i * 8 + 6] = bflo(w.w); q[i * 8 + 7] = bfhi(w.w); }
#pragma unroll
    for (int i = 0; i < 64; ++i) o[i] = 0.f;
    float m = -3.0e38f, lsum = 0.f;
    for (int pat = 0; pat < 3; ++pat) { const int d = pat == 0 ? 1 : (pat == 1 ? 4 : 16);
        for (int j = 0; j <= 128; ++j) { const int off = j * d;
            if (s - off >= 0) {
                const bf16_t* kp = KR + (size_t)(row - off) * 512 + h * 64; const bf16_t* vp = AQKV + (size_t)(row - off) * 1536 + 1024 + h * 64;
                float sc = 0.f;
#pragma unroll
                for (int i = 0; i < 8; ++i) { const u32x4 w = *(const GAS u32x4*)(kp + i * 8);
                    sc += q[i * 8 + 0] * bflo(w.x) + q[i * 8 + 1] * bfhi(w.x) + q[i * 8 + 2] * bflo(w.y) + q[i * 8 + 3] * bfhi(w.y) + q[i * 8 + 4] * bflo(w.z) + q[i * 8 + 5] * bfhi(w.z) + q[i * 8 + 6] * bflo(w.w) + q[i * 8 + 7] * bfhi(w.w); }
                if (sc > m) { const float f = __expf(m - sc); lsum *= f;
#pragma unroll
                    for (int i = 0; i < 64; ++i) o[i] *= f;
                    m = sc; }
                const float p = __expf(sc - m); lsum += p;
#pragma unroll
                for (int i = 0; i < 8; ++i) { const u32x4 w = *(const GAS u32x4*)(vp + i * 8);
                    o[i * 8 + 0] += p * bflo(w.x); o[i * 8 + 1] += p * bfhi(w.x); o[i * 8 + 2] += p * bflo(w.y); o[i * 8 + 3] += p * bfhi(w.y); o[i * 8 + 4] += p * bflo(w.z); o[i * 8 + 5] += p * bfhi(w.z); o[i * 8 + 6] += p * bflo(w.w); o[i * 8 + 7] += p * bfhi(w.w); }
            } } }
    const float inv = 1.f / lsum; bf16_t* Y = (bf16_t*)(ws + WS_XB) + (size_t)row * DM + 512 + h * 64;
#pragma unroll
    for (int i = 0; i < 8; ++i) { u32x4 w; w.x = pk2(o[i * 8] * inv, o[i * 8 + 1] * inv); w.y = pk2(o[i * 8 + 2] * inv, o[i * 8 + 3] * inv); w.z = pk2(o[i * 8 + 4] * inv, o[i * 8 + 5] * inv); w.w = pk2(o[i * 8 + 6] * inv, o[i * 8 + 7] * inv);
        *(GAS u32x4*)(Y + i * 8) = w; }
}


typedef float f32x16 __attribute__((ext_vector_type(16)));
template <int D, int PAT>
__device__ __forceinline__ void att_pattern(Frame& F, int b, int h, int s_base, const bf16_t* QR, const bf16_t* KR, const bf16_t* VT) {
    const int lane = F.lane, wave = F.wave, r32 = lane & 31, hi = lane >> 5;
    LAS float* ACC = (LAS float*)F.lds; LAS f32x2* ML = (LAS f32x2*)(F.lds + 133120);
    const int kperm = (r32 & 19) | ((r32 & 4) << 1) | ((r32 & 8) >> 1);
    constexpr int TPC = 16 / D, L = SEQ / D;
    for (int jj = 0; jj < 2; ++jj) {
        const int j = wave + 8 * jj, r = j / TPC, tile = j % TPC, p0 = s_base / D + tile * 32;
        const size_t qrow = (size_t)b * SEQ + (size_t)(p0 + r32) * D + r;
        bf16x8 qf[4];
#pragma unroll
        for (int kk = 0; kk < 4; ++kk) qf[kk] = *(const GAS bf16x8*)(QR + qrow * 512 + h * 64 + 16 * kk + 8 * hi);
        f32x16 sc[5];
#pragma unroll
        for (int kt = 0; kt < 5; ++kt) {
            const int kbase = p0 - 128 + 32 * kt;
            if (kbase >= 0) {
                const bf16_t* kp = KR + ((size_t)b * SEQ + (size_t)(kbase + kperm) * D + r) * 512 + h * 64 + 8 * hi;
                f32x16 acc = {};
#pragma unroll
                for (int kk = 0; kk < 4; ++kk) { const bf16x8 kf = *(const GAS bf16x8*)(kp + 16 * kk); acc = __builtin_amdgcn_mfma_f32_32x32x16_bf16(kf, qf[kk], acc, 0, 0, 0); }
                if (kt == 0) {
#pragma unroll
                    for (int rg = 0; rg < 16; ++rg) { const int kap = 16 * (rg >> 3) + 8 * hi + (rg & 7); if (kap < r32) acc[rg] = -1.0e30f; }
                }
                if (kt == 4) {
#pragma unroll
                    for (int rg = 0; rg < 16; ++rg) { const int kap = 16 * (rg >> 3) + 8 * hi + (rg & 7); if (kap > r32) acc[rg] = -1.0e30f; }
                }
                sc[kt] = acc;
            } else {
#pragma unroll
                for (int rg = 0; rg < 16; ++rg) sc[kt][rg] = -1.0e30f;
            }
        }
        float m = -1.0e30f;
#pragma unroll
        for (int kt = 0; kt < 5; ++kt)
#pragma unroll
            for (int rg = 0; rg < 16; ++rg) m = fmaxf(m, sc[kt][rg]);
        m = fmaxf(m, __shfl_xor(m, 32));
        float lsum = 0.f;
#pragma unroll
        for (int kt = 0; kt < 5; ++kt)
#pragma unroll
            for (int rg = 0; rg < 16; ++rg) { const float p = __expf(sc[kt][rg] - m); sc[kt][rg] = p; lsum += p; }
        lsum += __shfl_xor(lsum, 32);
        f32x16 o[2] = {{}, {}};
#pragma unroll
        for (int kt = 0; kt < 5; ++kt) {
            const int kbase = p0 - 128 + 32 * kt;
            if (kbase >= 0) {
#pragma unroll
                for (int s = 0; s < 2; ++s) {
                    u32x4 pw; pw.x = cvt_pk_bf16(sc[kt][8 * s + 0], sc[kt][8 * s + 1]); pw.y = cvt_pk_bf16(sc[kt][8 * s + 2], sc[kt][8 * s + 3]);
                    pw.z = cvt_pk_bf16(sc[kt][8 * s + 4], sc[kt][8 * s + 5]); pw.w = cvt_pk_bf16(sc[kt][8 * s + 6], sc[kt][8 * s + 7]);
                    const bf16x8 pf = __builtin_bit_cast(bf16x8, pw);
#pragma unroll
                    for (int mt = 0; mt < 2; ++mt) {
                        const bf16x8 vf = *(const GAS bf16x8*)(VT + ((size_t)(b * ATH + h) * 64 + r32 + 32 * mt) * SEQ + (size_t)r * L + kbase + 16 * s + 8 * hi);
                        o[mt] = __builtin_amdgcn_mfma_f32_32x32x16_bf16(vf, pf, o[mt], 0, 0, 0); }
                }
            }
        }
        const int tau = (p0 + r32) * D + r - s_base;
        LAS float* arow = ACC + tau * 65;
        if (PAT == 0) {
#pragma unroll
            for (int mt = 0; mt < 2; ++mt)
#pragma unroll
                for (int rg = 0; rg < 16; ++rg) arow[(rg & 3) + 8 * (rg >> 2) + 4 * hi + 32 * mt] = o[mt][rg];
            if (hi == 0) ML[tau] = (f32x2){m, lsum};
        } else {
            const f32x2 ml = ML[tau];
            const float M = fmaxf(ml.x, m), fo = __expf(ml.x - M), fn = __expf(m - M), lt = ml.y * fo + lsum * fn;
            if (PAT == 1) {
#pragma unroll
                for (int mt = 0; mt < 2; ++mt)
#pragma unroll
                    for (int rg = 0; rg < 16; ++rg) { LAS float* p = arow + (rg & 3) + 8 * (rg >> 2) + 4 * hi + 32 * mt; *p = *p * fo + o[mt][rg] * fn; }
                if (hi == 0) ML[tau] = (f32x2){M, lt};
            } else {
                const float inv = 1.f / lt;
                bf16_t* yrow = (bf16_t*)(F.ws + WS_XB) + ((size_t)b * SEQ + s_base + tau) * DM + 512 + h * 64;
#pragma unroll
                for (int mt = 0; mt < 2; ++mt)
#pragma unroll
                    for (int g = 0; g < 4; ++g) { float v[4];
#pragma unroll
                        for (int e = 0; e < 4; ++e) v[e] = (arow[e + 8 * g + 4 * hi + 32 * mt] * fo + o[mt][4 * g + e] * fn) * inv;
                        u32x2 w; w.x = cvt_pk_bf16(v[0], v[1]); w.y = cvt_pk_bf16(v[2], v[3]);
                        *(GAS u32x2*)(yrow + 8 * g + 4 * hi + 32 * mt) = w; }
            }
        }
    }
}
__device__ __forceinline__ void att_unit(Frame& F, int unit) {
    const int tb = unit >> 3, h = unit & 7, b = tb >> 4, s_base = (tb & 15) * 512;
    const bf16_t* QR = (const bf16_t*)(F.ws + A_QR); const bf16_t* KR = (const bf16_t*)(F.ws + A_KR);
    att_pattern<1, 0>(F, b, h, s_base, QR, KR, (const bf16_t*)(F.ws + A_VT1));
    __syncthreads();
    att_pattern<4, 1>(F, b, h, s_base, QR, KR, (const bf16_t*)(F.ws + A_VT4));
    __syncthreads();
    att_pattern<16, 2>(F, b, h, s_base, QR, KR, (const bf16_t*)(F.ws + A_VT16));
    __syncthreads();
}

__device__ __forceinline__ void ph_norm(Frame& F, const Args& a) {
    const int gw = F.vcu * NWAVES + F.wave, NGW = F.G * NWAVES;
    for (int r = gw; r < MT; r += NGW) { const float rs = row_norm_prep(F.out + (size_t)r * DM, (bf16_t*)(F.ws + WS_XB) + (size_t)r * DM, nullptr, F.lane); if (F.lane == 0) ((float*)(F.ws + WS_RSTD))[r] = rs; }
}

__device__ __forceinline__ void ph_router(Frame& F, const Args& a, int l) {
    unsigned char* ws = F.ws; const int lane = F.lane;
    const int gw = F.vcu * NWAVES + F.wave, NGW = F.G * NWAVES;
    { LAS float* scr = (LAS float*)(F.lds + F.wave * 16384);
      for (int it = gw; it < 3 * 4096; it += NGW) { const int ty = it >> 12, e = (it >> 8) & 15, r = it & 255;
          if (ty == 0) transpose_mat_item(IN_F(16) + ((size_t)l * NEXP + e) * DM * EFF, DM, EFF, IN_F(13) + l * DM, (bf16_t*)(ws + A_WGU) + (size_t)e * DM * DM, 1, r, scr, lane);
          else if (ty == 1) transpose_mat_item(IN_F(17) + ((size_t)l * NEXP + e) * DM * EFF, DM, EFF, IN_F(13) + l * DM, (bf16_t*)(ws + A_WGU) + (size_t)e * DM * DM, 2, r, scr, lane);
          else transpose_mat_item(IN_F(18) + ((size_t)l * NEXP + e) * EFF * DM, EFF, DM, nullptr, (bf16_t*)(ws + A_WD) + (size_t)e * DM * EFF, 0, r, scr, lane); } }
    __syncthreads();
    LAS float* WRl = (LAS float*)F.lds;
    { const float* src = (const float*)(ws + WS_WR) + (size_t)l * DM * 20; for (int i = F.tid; i < DM * 20; i += NTHR) WRl[(i % 20) * DM + i / 20] = src[i]; }
    __syncthreads();
    unsigned* cnt = (unsigned*)(F.ctl + CW_CNT + l * 16 * 64);
    for (int r = gw; r < MT; r += NGW) {
        const GAS f32x4* xr = (const GAS f32x4*)(F.out + (size_t)r * DM) + lane;
        f32x4 v[4]; float s = 0.f;
#pragma unroll
        for (int j = 0; j < 4; ++j) { v[j] = xr[64 * j]; s += (v[j].x * v[j].x + v[j].y * v[j].y) + (v[j].z * v[j].z + v[j].w * v[j].w); }
        const float rstd = 1.f / sqrtf(wave_sum(s) * (1.f / DM) + EPS);
        GAS u32x2* o8 = (GAS u32x2*)((bf16_t*)(ws + WS_XB) + (size_t)r * DM) + lane;
#pragma unroll
        for (int j = 0; j < 4; ++j) { u32x2 w; w.x = pk2(v[j].x, v[j].y); w.y = pk2(v[j].z, v[j].w); o8[64 * j] = w; }
        float lg[20];
#pragma unroll
        for (int q = 0; q < 20; ++q) lg[q] = 0.f;
#pragma unroll
        for (int j = 0; j < 4; ++j) {
#pragma unroll
            for (int q = 0; q < 20; ++q) { const f32x4 w = *(const LAS f32x4*)(WRl + q * DM + 256 * j + 4 * lane); lg[q] += (v[j].x * w.x + v[j].y * w.y) + (v[j].z * w.z + v[j].w * w.w); }
            asm volatile("" ::: "memory"); }
#pragma unroll
        for (int q = 0; q < 20; ++q) lg[q] = wave_sum(lg[q]) * rstd;
        if (lane == 0) {
            ((float*)(ws + WS_RSTD))[r] = rstd;
            int gs = 0; float gm = lg[0];
#pragma unroll
            for (int q = 1; q < 4; ++q) if (lg[q] > gm) { gm = lg[q]; gs = q; }
            float den = 0.f;
#pragma unroll
            for (int q = 0; q < 4; ++q) den += __expf(lg[q] - gm);
            const float gwt = 1.f / den;
            float e4[4];
#pragma unroll
            for (int q = 0; q < 4; ++q) e4[q] = gs == 0 ? lg[4 + q] : (gs == 1 ? lg[8 + q] : (gs == 2 ? lg[12 + q] : lg[16 + q]));
            int i1 = 0; float v1 = e4[0];
#pragma unroll
            for (int q = 1; q < 4; ++q) if (e4[q] > v1) { v1 = e4[q]; i1 = q; }
            int i2 = -1; float v2 = -3.0e38f;
#pragma unroll
            for (int q = 0; q < 4; ++q) if (q != i1 && e4[q] > v2) { v2 = e4[q]; i2 = q; }
            const float ex = __expf(v2 - v1), w1 = 1.f / (1.f + ex), w2 = ex * w1;
            const int id1 = gs * 4 + i1, id2 = gs * 4 + i2;
            int* te = (int*)(ws + WS_TOKE) + 2 * r; float* tw = (float*)(ws + WS_TOKW) + 2 * r; int* tl = (int*)(ws + WS_TOKL) + 2 * r;
            te[0] = id1; te[1] = id2; tw[0] = w1 * gwt; tw[1] = w2 * gwt;
            tl[0] = (int)__hip_atomic_fetch_add(cnt + 64 * id1, 1u, RLX_AGENT); tl[1] = (int)__hip_atomic_fetch_add(cnt + 64 * id2, 1u, RLX_AGENT);
        }
    }
}

__device__ __forceinline__ void moe_prefix(Frame& F, int l) {
    if (F.tid == 0) { unsigned acc = 0; for (int e = 0; e < 16; ++e) { F.MISC[16 + e] = acc; const unsigned n = __hip_atomic_load((unsigned*)(F.ctl + CW_CNT + l * 16 * 64) + 64 * e, RLX_AGENT); acc += (n + 255u) >> 8; } F.MISC[32] = acc; }
    __syncthreads();
}

__device__ __forceinline__ void ph_scatter(Frame& F, const Args& a, int l) {
    unsigned char* ws = F.ws; const int lane = F.lane;
    moe_prefix(F, l);
    const int gw = F.vcu * NWAVES + F.wave, NGW = F.G * NWAVES;
    for (int p = gw; p < 2 * MT; p += NGW) {
        const int r = p >> 1; const int e = ((const int*)(ws + WS_TOKE))[p]; const int loc = ((const int*)(ws + WS_TOKL))[p];
        const int slot = (int)F.MISC[16 + e] * 256 + loc;
        const GAS u32x4* src = (const GAS u32x4*)((const bf16_t*)(ws + WS_XB) + (size_t)r * DM) + lane; GAS u32x4* dst = (GAS u32x4*)((bf16_t*)(ws + A_XS) + (size_t)slot * DM) + lane;
        dst[0] = src[0]; dst[64] = src[64];
        if (lane == 0) { ((float*)(ws + WS_SLOTRS))[slot] = ((const float*)(ws + WS_RSTD))[r]; ((float*)(ws + WS_SLOTGW))[slot] = ((const float*)(ws + WS_TOKW))[p]; }
        asm volatile("" ::: "memory");
        if (lane == 0) ((int*)(ws + WS_TOKL))[p] = slot;
    }
}

__device__ __forceinline__ void ph_combine(Frame& F, const Args& a, int l) {
    unsigned char* ws = F.ws; const int lane = F.lane;
    const int gw = F.vcu * NWAVES + F.wave, NGW = F.G * NWAVES;
    for (int r = gw; r < MT; r += NGW) {
        const int s0 = ((const int*)(ws + WS_TOKL))[2 * r], s1 = ((const int*)(ws + WS_TOKL))[2 * r + 1];
        GAS f32x4* xr = (GAS f32x4*)(F.out + (size_t)r * DM) + lane;
        const GAS u32x2* y0 = (const GAS u32x2*)((const bf16_t*)(ws + A_Y) + (size_t)s0 * DM) + lane; const GAS u32x2* y1 = (const GAS u32x2*)((const bf16_t*)(ws + A_Y) + (size_t)s1 * DM) + lane;
        f32x4 v[4]; float s = 0.f;
#pragma unroll
        for (int j = 0; j < 4; ++j) { const u32x2 p0 = y0[64 * j], p1 = y1[64 * j]; f32x4 x = xr[64 * j];
            x.x += bflo(p0.x) + bflo(p1.x); x.y += bfhi(p0.x) + bfhi(p1.x); x.z += bflo(p0.y) + bflo(p1.y); x.w += bfhi(p0.y) + bfhi(p1.y);
            v[j] = x; s += (x.x * x.x + x.y * x.y) + (x.z * x.z + x.w * x.w); }
        const float rstd = 1.f / sqrtf(wave_sum(s) * (1.f / DM) + EPS);
        if (l == DEPTH - 1) { const GAS f32x4* g = (const GAS f32x4*)IN_F(19) + lane;
#pragma unroll
            for (int j = 0; j < 4; ++j) xr[64 * j] = v[j] * rstd * g[64 * j];
        } else {
            GAS u32x2* o8 = (GAS u32x2*)((bf16_t*)(ws + WS_XB) + (size_t)r * DM) + lane;
#pragma unroll
            for (int j = 0; j < 4; ++j) { xr[64 * j] = v[j]; u32x2 w; w.x = pk2(v[j].x, v[j].y); w.y = pk2(v[j].z, v[j].w); o8[64 * j] = w; }
            if (lane == 0) ((float*)(ws + WS_RSTD))[r] = rstd;
        }
    }
}

constexpr int NPHASE = 3 + 13 * DEPTH + (PROBE_Q >= 0 ? PROBE_N - 1 : 0);
__global__ void __launch_bounds__(NTHR, 2) fwd(Args a) {
    extern __shared__ __attribute__((aligned(16))) unsigned char lds_raw[];
    Frame F;
    F.lds = (LAS unsigned char*)lds_raw; F.MISC = (volatile LAS unsigned*)(F.lds + MISC_OFF);
    F.tid = threadIdx.x; F.lane = F.tid & 63; F.wave = __builtin_amdgcn_readfirstlane(F.tid >> 6);
    F.G = gridDim.x; { const int bx = blockIdx.x; F.vcu = (F.G % 8 == 0) ? (bx % 8) * (F.G / 8) + bx / 8 : bx; }
    F.ws = a.ws; F.ctl = (gu32*)(a.ws + WS_CTL); F.out = a.out; F.z = 0;
    for (int u = F.tid; u < (LDS_BYTES - LDSCTL_OFF) / 4; u += NTHR) ((LAS unsigned*)(F.lds + LDSCTL_OFF))[u] = 0u;
    __syncthreads();
    XcdBarrier bar; bar.bar = (unsigned*)(F.ctl + CW_BAR); bar.x = 0; bar.st = nullptr;
    const bool one_launch = (a.ph_hi - a.ph_lo) > 1;
    if (one_launch) bar = xcd_barrier_post((unsigned*)(F.ctl + CW_BAR), F.MISC + 8);
    for (int pp = a.ph_lo; pp < a.ph_hi; ++pp) {
        int ph = pp;
        if (PROBE_Q >= 0) { constexpr int P = 3 + PROBE_Q; if (pp > P) ph = (pp - (PROBE_N - 1) > P) ? pp - (PROBE_N - 1) : P; }
        { int t_ = threadIdx.x; asm volatile("" : "+v"(t_)); F.tid = t_; F.lane = t_ & 63; F.wave = __builtin_amdgcn_readfirstlane(t_ >> 6); }
        size_t z_ = 0; asm volatile("" : "+s"(z_)); F.z = z_; F.ws = a.ws + z_; F.out = (float*)((char*)a.out + z_); F.ctl = (gu32*)(a.ws + z_ + WS_CTL);
        unsigned char* ws = F.ws; int bx = (int)blockIdx.x; asm volatile("" : "+s"(bx));
        if (ph == 0) { if (PHSEL(0)) ph_init(F, a); }
        else if (ph == 1) { if (PHSEL(1)) {
            SchedKV S{F.G, bx, (const char*)(ws + WS_MEMN), (const char*)(ws + WS_WKVT)};
            EpiKV E{(bf16_t*)(ws + WS_KV), (bf16_t*)(ws + WS_KV) + (size_t)DEPTH * MEMROWS * DM};
            pg8::gemm_phase<EpiKV, SchedKV, true, true, DM, DM>(F.lds, F.tid, S, E); }
        } else if (ph == 2) { if (PHSEL(2)) {
            SchedFold S{F.G, bx, (const char*)(ws + WS_KV), (const char*)(ws + WS_KV) + (size_t)DEPTH * MEMROWS * DM * 2, (const char*)(ws + WS_WQS), (const char*)(ws + WS_WOT)};
            EpiBf16 E{(bf16_t*)(ws + WS_WQK), DM, (size_t)DM * DM, 1.f};
            pg8::gemm_phase<EpiBf16, SchedFold, true, true, DM, 256>(F.lds, F.tid, S, E); }
        } else {
            const int l = (ph - 3) / 13, q = (ph - 3) % 13;
            if (q == 0 && PHSEL(3)) {
                pg8::SchedDense S{64, 14, 896, F.G, bx, (const char*)(ws + WS_XB), (const char*)(ws + WS_WIN) + (size_t)l * NIN * DM * 2, (size_t)256 * DM * 2, (size_t)256 * DM * 2, 64, 0};
                EpiProj E{(bf16_t*)(ws + A_HG), (bf16_t*)(ws + A_AQKV), (const float*)(ws + WS_RSTD)};
                pg8::gemm_phase<EpiProj, pg8::SchedDense, true, true, DM, DM>(F.lds, F.tid, S, E);
            } else if (q == 1 && PHSEL(4)) {
                for (int u = F.vcu; u < MT / 64; u += F.G) prep_unit(F, a, u);
                for (int u = F.vcu; u < BATCH * HGH * NCHUNK; u += F.G) { if (HG_A_GOLDEN) hg_a_unit(F, a, l, u); else hg_a2_unit(F, a, l, u); }
            } else if (q == 2 && PHSEL(5)) hg_scan(F);
            else if (q == 3 && PHSEL(6)) {
                for (int u = F.vcu; u < BATCH * HGH * NCHUNK; u += F.G) { if (HG_C_GOLDEN) hg_c_unit(F, a, l, u); else hg_c2_unit(F, a, l, u); }
#if ATT_GOLDEN
                for (int t = F.vcu * NWAVES + F.wave; t < (MT / 64) * ATH; t += F.G * NWAVES) att_task(F, t);
#else
                for (int u = F.vcu; u < (MT / 512) * ATH; u += F.G) att_unit(F, u);
#endif
            } else if (q == 4 && PHSEL(7)) {
                pg8::SchedDense S{64, 4, 256, F.G, bx, (const char*)(ws + WS_XB), (const char*)(ws + WS_WOUT) + (size_t)l * DM * DM * 2, (size_t)256 * DM * 2, (size_t)256 * DM * 2, 64, 0};
                EpiResAdd E{F.out};
                pg8::gemm_phase<EpiResAdd, pg8::SchedDense, true, true, DM, DM>(F.lds, F.tid, S, E);
            } else if (q == 5 && PHSEL(8)) ph_norm(F, a);
            else if (q == 6 && PHSEL(9)) {
                pg8::SchedDense S{64, 4, 256, F.G, bx, (const char*)(ws + WS_XB), (const char*)(ws + WS_WQK) + (size_t)l * 2 * DM * DM * 2, (size_t)256 * DM * 2, (size_t)256 * DM * 2, 32, (size_t)DM * DM * 2};
                EpiSoftmax E{(bf16_t*)(ws + A_P), (const float*)(ws + WS_RSTD)};
                pg8::gemm_phase<EpiSoftmax, pg8::SchedDense, true, true, DM, DM>(F.lds, F.tid, S, E);
            } else if (q == 7 && PHSEL(10)) {
                pg8::SchedDense S{64, 4, 256, F.G, bx, (const char*)(ws + A_P), (const char*)(ws + WS_WVO) + (size_t)l * 2 * DM * DM * 2, (size_t)256 * DM * 2, (size_t)256 * DM * 2, 32, (size_t)DM * DM * 2};
                EpiResAdd E{F.out};
                pg8::gemm_phase<EpiResAdd, pg8::SchedDense, true, true, DM, DM>(F.lds, F.tid, S, E);
            } else if (q == 8 && PHSEL(11)) ph_router(F, a, l);
            else if (q == 9 && PHSEL(12)) ph_scatter(F, a, l);
            else if (q == 10 && PHSEL(13)) {
                moe_prefix(F, l);
                SchedMoe S{F.G, bx, DM, F.MISC + 16, (const char*)(ws + A_XS), (const char*)(ws + A_WGU)};
                EpiMoe1 E{(bf16_t*)(ws + A_ACTB), (const float*)(ws + WS_SLOTRS), (const float*)(ws + WS_SLOTGW)};
                pg8::gemm_phase<EpiMoe1, SchedMoe, true, true, DM, DM>(F.lds, F.tid, S, E);
            } else if (q == 11 && PHSEL(14)) {
                moe_prefix(F, l);
                SchedMoe S{F.G, bx, EFF, F.MISC + 16, (const char*)(ws + A_ACTB), (const char*)(ws + A_WD)};
                EpiBf16 E{(bf16_t*)(ws + A_Y), DM, 0, 1.f};
                pg8::gemm_phase<EpiBf16, SchedMoe, true, true, EFF, EFF>(F.lds, F.tid, S, E);
            } else if (q == 12 && PHSEL(15)) ph_combine(F, a, l);
        }
        if (pp + 1 < a.ph_hi) xcd_barrier(bar);
    }
}

extern "C" void kernel_launch(void* const* d_in, const int* in_sizes, int n_in, void* d_out, int out_size, void* d_ws, size_t ws_size, hipStream_t stream) {
    static int grid = 0;
    if (grid == 0) {
        if (n_in != 20 || in_sizes[0] != MT * DM || out_size != MT * DM || ws_size < WS_END) { fprintf(stderr, "kernel_launch: unexpected shapes / workspace (%d inputs, ws %zu)\n", n_in, ws_size); grid = -1; return; }
        int dev = 0, cus = 0, per_cu = 0;
        if (hipGetDevice(&dev) != hipSuccess || hipDeviceGetAttribute(&cus, hipDeviceAttributeMultiprocessorCount, dev) != hipSuccess) { grid = -1; return; }
        if (hipFuncSetAttribute((const void*)fwd, hipFuncAttributeMaxDynamicSharedMemorySize, LDS_BYTES) != hipSuccess) { grid = -1; return; }
        if (hipOccupancyMaxActiveBlocksPerMultiprocessor(&per_cu, (const void*)fwd, NTHR, LDS_BYTES) != hipSuccess || per_cu < 1) { fprintf(stderr, "kernel_launch: occupancy query says %d\n", per_cu); per_cu = 1; }
        (void)hipGetLastError();
        grid = cus * 1;
    }
    if (grid < 0) return;
    (void)hipMemsetAsync((char*)d_ws + WS_CTL, 0, CTL_ZERO_BYTES, stream);
    Args a{};
    for (int i = 0; i < 20; ++i) a.in[i] = d_in[i];
    a.out = (float*)d_out; a.ws = (unsigned char*)d_ws;
#if MK_PER_PHASE
    for (int ph = 0; ph < NPHASE; ++ph) { a.ph_lo = ph; a.ph_hi = ph + 1; hipLaunchKernelGGL(fwd, dim3(grid), dim3(NTHR), LDS_BYTES, stream, a); }
#else
    a.ph_lo = 0; a.ph_hi = NPHASE;
    void* kargs[] = {&a};
    hipError_t e = hipLaunchCooperativeKernel((const void*)fwd, dim3(grid), dim3(NTHR), kargs, LDS_BYTES, stream);
    if (e != hipSuccess) fprintf(stderr, "cooperative launch failed: %s (grid %d)\n", hipGetErrorString(e), grid);
#endif
}
```

```cpp
#include <hip/hip_runtime.h>
#include <cstdio>
#include <cstdint>

#ifndef PH_MASK
#define PH_MASK 0xFFFFFFFFu
#endif
#define PHSEL(n) ((PH_MASK >> (n)) & 1u)
#ifndef PROBE_ATT_N
#define PROBE_ATT_N 1
#endif
#ifndef PROBE_HGC_N
#define PROBE_HGC_N 1
#endif
#ifndef PROBE_HGA_N
#define PROBE_HGA_N 1
#endif
#ifndef PROBE_PREP_N
#define PROBE_PREP_N 1
#endif
#ifndef PROBE_HGC_STOP
#define PROBE_HGC_STOP 0
#endif
#ifndef PROBE_P
#define PROBE_P -1
#endif
#ifndef PROBE_N
#define PROBE_N 1
#endif
#ifndef HG_A_GOLDEN
#define HG_A_GOLDEN 0
#endif
#ifndef HG_C_GOLDEN
#define HG_C_GOLDEN 0
#endif
#ifndef ATT_GOLDEN
#define ATT_GOLDEN 0
#endif
#ifndef MK_PER_PHASE
#define MK_PER_PHASE 0
#endif

#define LAS __attribute__((address_space(3)))
#define GAS __attribute__((address_space(1)))
typedef unsigned short bf16_t;
typedef short bf16x8 __attribute__((ext_vector_type(8)));
typedef float f32x4 __attribute__((ext_vector_type(4)));
typedef float f32x2 __attribute__((ext_vector_type(2)));
typedef unsigned u32x4 __attribute__((ext_vector_type(4)));
typedef unsigned u32x2 __attribute__((ext_vector_type(2)));
typedef GAS unsigned gu32;

constexpr int BATCH = 2, SEQ = 8192, DM = 1024, MT = BATCH * SEQ, DEPTH = 2;
constexpr int MEM_LEN = 256, MEMROWS = BATCH * MEM_LEN;
constexpr int NIN = 3584, HGW = 512, HGH = 4, HGD = 128, CHUNK = 64, NCHUNK = SEQ / CHUNK;
constexpr int ATW = 512, ATH = 8, ATD = 64;
constexpr int NEXP = 16, EFF = 512;
constexpr float EPS = 1e-6f;
constexpr int NWAVES = 8, NTHR = 512;

constexpr size_t MiB = 1u << 20;
constexpr size_t WS_CTL = 0, CTL_ZERO_BYTES = 1 * MiB;
constexpr size_t WS_RSTD = 1 * MiB;
constexpr size_t WS_TOKE = WS_RSTD + 64 * 1024;
constexpr size_t WS_TOKW = WS_TOKE + 128 * 1024;
constexpr size_t WS_TOKL = WS_TOKW + 128 * 1024;
constexpr size_t WS_SLOTRS = WS_TOKL + 128 * 1024;
constexpr size_t WS_SLOTGW = WS_SLOTRS + 160 * 1024;
constexpr size_t WS_WR = 3 * MiB;
constexpr size_t WS_LBT = 3 * MiB + 256 * 1024;
constexpr size_t WS_XB = 4 * MiB;
constexpr size_t WS_WIN = 36 * MiB;
constexpr size_t WS_WOUT = 50 * MiB;
constexpr size_t WS_WQS = 54 * MiB;
constexpr size_t WS_WKVT = 58 * MiB;
constexpr size_t WS_WOT = 66 * MiB;
constexpr size_t WS_MEMN = 70 * MiB;
constexpr size_t WS_KV = 72 * MiB;
constexpr size_t WS_WQK = 76 * MiB;
constexpr size_t WS_WVO = 84 * MiB;
constexpr size_t WS_ACT = 92 * MiB;
constexpr size_t WS_CS = 320 * MiB;
constexpr size_t WS_END = 324 * MiB;
constexpr size_t A_HG = WS_ACT + 0 * MiB;
constexpr size_t A_KF1 = WS_ACT + 64 * MiB;
constexpr size_t A_KF4 = WS_ACT + 80 * MiB;
constexpr size_t A_KF16 = WS_ACT + 96 * MiB;
constexpr size_t A_QR = WS_ACT + 112 * MiB;
constexpr size_t A_V = WS_ACT + 128 * MiB;
constexpr size_t A_VT1 = WS_ACT + 144 * MiB;
constexpr size_t A_VT4 = WS_ACT + 160 * MiB;
constexpr size_t A_VT16 = WS_ACT + 176 * MiB;
constexpr size_t A_STATE = WS_ACT + 192 * MiB;
constexpr size_t A_DECAY = WS_ACT + 224 * MiB;
constexpr size_t A_P = WS_ACT + 0 * MiB;
constexpr size_t A_WGU = WS_ACT + 0 * MiB;
constexpr size_t A_WD = WS_ACT + 32 * MiB;
constexpr size_t A_XS = WS_ACT + 48 * MiB;
constexpr size_t A_ACTB = WS_ACT + 120 * MiB;
constexpr size_t A_Y = WS_ACT + 156 * MiB;
constexpr int MAXSLOT = 2 * MT + NEXP * 256;
static_assert(A_Y + (size_t)MAXSLOT * 1024 * 2 <= WS_END, "ws map");
constexpr int CW_BAR = 4096;
constexpr int CW_CNT = 16384;
constexpr int RING_BYTES = 131072;
constexpr int SPARE_OFF = RING_BYTES;
constexpr int LDSCTL_OFF = RING_BYTES + 8192, MISC_OFF = LDSCTL_OFF + 64;
constexpr int LDS_BYTES = 147456;

#define RLX_AGENT __ATOMIC_RELAXED, __HIP_MEMORY_SCOPE_AGENT
#define LDS_WAIT() asm volatile("s_waitcnt lgkmcnt(0)" ::: "memory")
#define VM_WAIT() asm volatile("s_waitcnt vmcnt(0)" ::: "memory")

__device__ __forceinline__ unsigned f2bf(float f) { unsigned u = __builtin_bit_cast(unsigned, f); return (u + 0x7fffu + ((u >> 16) & 1u)) >> 16; }
__device__ __forceinline__ unsigned pk2(float lo, float hi) { return f2bf(lo) | (f2bf(hi) << 16); }
__device__ __forceinline__ float bf2f(unsigned short h) { return __builtin_bit_cast(float, (unsigned)h << 16); }
__device__ __forceinline__ float bflo(unsigned w) { return __builtin_bit_cast(float, w << 16); }
__device__ __forceinline__ float bfhi(unsigned w) { return __builtin_bit_cast(float, w & 0xffff0000u); }
typedef __bf16 bf16x2_t __attribute__((ext_vector_type(2)));
__device__ __forceinline__ unsigned cvt_pk_bf16(float lo, float hi) { f32x2 v = {lo, hi}; bf16x2_t b = __builtin_convertvector(v, bf16x2_t); return __builtin_bit_cast(unsigned, b); }
__device__ __forceinline__ float wave_sum(float v) {
#pragma unroll
    for (int o = 1; o < 64; o <<= 1) v += __shfl_xor(v, o);
    return v;
}
__device__ __forceinline__ float sigmoidf_(float z) { return __builtin_amdgcn_rcpf(1.f + __builtin_amdgcn_exp2f(-1.4426950408889634f * z)); }
__device__ __forceinline__ float ex2(float x) { return __builtin_amdgcn_exp2f(x); }
constexpr float LOG2E = 1.4426950408889634f;

#define XB_TMO      128
#define XB_XCNT(j)  (256  + 64 * (j))
#define XB_XSUB(j)  (1280 + 64 * (j))
#define XB_XGEN(j)  (2304 + 64 * (j))
#define XB_TOP      3328
#define XB_TOPGEN   3392
#define XCD_BAR_WORDS 3456
#define XB_SPIN_CAP (1u << 18)
__device__ __forceinline__ unsigned xb_ld(unsigned* p)              { return __hip_atomic_load(p, __ATOMIC_RELAXED, __HIP_MEMORY_SCOPE_AGENT); }
__device__ __forceinline__ unsigned xb_add(unsigned* p, unsigned v) { return __hip_atomic_fetch_add(p, v, __ATOMIC_RELAXED, __HIP_MEMORY_SCOPE_AGENT); }
__device__ __forceinline__ unsigned xb_xcc_id() { return (unsigned)__builtin_amdgcn_s_getreg((3 << 11) | 20) & 0xFu; }
#define XB_SPIN(cond, bar) do { unsigned _sp = 0; while (cond) { __builtin_amdgcn_s_sleep(1); \
    if ((++_sp & 255u) == 0u) { if (xb_ld(&(bar)[XB_TMO])) break; if (_sp > XB_SPIN_CAP) { atomicAdd(&(bar)[XB_TMO], 1u); break; } } } } while (0)
struct XcdBarrier { unsigned* bar; unsigned x; volatile LAS unsigned* st; };
__device__ __forceinline__ XcdBarrier xcd_barrier_post(unsigned* bar, volatile LAS unsigned* st) {
    XcdBarrier b; b.bar = bar; b.x = xb_xcc_id(); b.st = st;
    if (threadIdx.x == 0) (void)xb_add(&bar[XB_XCNT(b.x)], 1u);
    return b;
}
__device__ __forceinline__ void xcd_barrier_complete(unsigned* bar, unsigned x, unsigned& nloc, unsigned& nx) {
    const unsigned G = gridDim.x * gridDim.y * gridDim.z;
    unsigned sum, cnt, mine, sp = 0u;
    for (;;) {
        sum = 0u; cnt = 0u; mine = 0u;
#pragma unroll
        for (unsigned j = 0; j < 16; ++j) { const unsigned c = xb_ld(&bar[XB_XCNT(j)]); sum += c; cnt += (c > 0u) ? 1u : 0u; mine = (j == x) ? c : mine; }
        if (sum == G) break;
        __builtin_amdgcn_s_sleep(1);
        if ((++sp & 255u) == 0u) { if (xb_ld(&bar[XB_TMO])) break; if (sp > XB_SPIN_CAP) { atomicAdd(&bar[XB_TMO], 1u); break; } }
    }
    nloc = mine > 0u ? mine : 1u; nx = cnt > 0u ? cnt : 1u;
}
__device__ __forceinline__ void xcd_barrier(const XcdBarrier& b) {
    asm volatile("s_waitcnt vmcnt(0)" ::: "memory");
    __syncthreads();
    if (threadIdx.x == 0) {
        unsigned* bar = b.bar;
        __builtin_amdgcn_s_waitcnt(0);
        unsigned nloc = b.st[0], nx = b.st[1];
        if (nloc == 0u) { xcd_barrier_complete(bar, b.x, nloc, nx); b.st[0] = nloc; b.st[1] = nx; }
        const unsigned old = xb_add(&bar[XB_XSUB(b.x)], 1u);
        const unsigned gen = old / nloc;
        if (old + 1u == (gen + 1u) * nloc) {
            __builtin_amdgcn_fence(__ATOMIC_RELEASE, "agent");
            asm volatile("s_waitcnt vmcnt(0)" ::: "memory");
            const unsigned og = xb_add(&bar[XB_TOP], 1u);
            const unsigned tg = og / nx;
            if (og + 1u == (tg + 1u) * nx) xb_add(&bar[XB_TOPGEN], 1u);
            else XB_SPIN(xb_ld(&bar[XB_TOPGEN]) == tg, bar);
            __builtin_amdgcn_fence(__ATOMIC_ACQUIRE, "agent");
            xb_add(&bar[XB_XGEN(b.x)], 1u);
            asm volatile("s_waitcnt vmcnt(0)" ::: "memory");
        } else {
            XB_SPIN(xb_ld(&bar[XB_XGEN(b.x)]) == gen, bar);
            __builtin_amdgcn_fence(__ATOMIC_ACQUIRE, "agent");
            asm volatile("s_waitcnt vmcnt(0)" ::: "memory");
        }
    }
    __syncthreads();
}

namespace pg8 {
constexpr int BM = 256, BK = 64, HALF = 128, HTB = HALF * BK * 2, STAGE_BYTES = 8 * HTB, NXCD = 8, WGM = 8;
__host__ __device__ __forceinline__ int lds_byte(int r, int c) { const int st = (r >> 4) * 2 + (c >> 5), rr = r & 15, cc = c & 31, ob = rr * 64 + cc * 2; return st * 1024 + (ob ^ (((ob >> 9) & 1) << 5)); }
__host__ __device__ __forceinline__ void stage_rc(int b, int& R, int& C) { const int st = b / 1024, sb = b % 1024, swz = sb ^ (((sb >> 9) & 1) << 5); R = (st >> 1) * 16 + swz / 64; C = (st & 1) * 32 + (swz % 64) / 2; }
__host__ __device__ __forceinline__ int perm32(int rho) { const int n = rho >> 4, i = rho & 15; return 8 * (i >> 2) + 4 * n + (i & 3); }

struct Unit { int pm, pn, aux; const char* a; const char* b; };
typedef f32x4 Acc[2][2][4][2];

template <class Epi, class Sched, bool ALIGN_EPI, bool SP2, int LD, int K>
__device__ __forceinline__ void gemm_phase(LAS unsigned char* lds, const int tid, const Sched& S, const Epi& E) {
    constexpr int lda = LD, ldb = LD;
    const int wid = __builtin_amdgcn_readfirstlane(tid >> 6), lane = tid & 63, wr = wid >> 2, wc = wid & 3, fr = lane & 15, fq = lane >> 4;
    constexpr int nt = K / BK;
    unsigned voffA[2], voffB[2];
#pragma unroll
    for (int i = 0; i < 2; ++i) { int R, C; stage_rc(tid * 16 + i * 8192, R, C); const int Rb = Epi::PERM ? ((R & ~31) + perm32(R & 31)) : R;
        voffA[i] = (unsigned)(R * lda + C) * 2u; voffB[i] = (unsigned)(Rb * ldb + C) * 2u; }
    const size_t kstep = (size_t)(BK * 2);
    const size_t hstepA = (size_t)HALF * lda * 2, hstepB = (size_t)HALF * ldb * 2;
    const unsigned ldsw = (unsigned)wid * 1024u;
    const int aoff = lds_byte(wr * 64 + fr, fq * 8), boff = lds_byte(wc * 32 + fr, fq * 8);
#define PG8_SA(b, h) (((b) * 2 + (h)) * HTB)
#define PG8_SB(b, h) ((4 + (b) * 2 + (h)) * HTB)
#define PG8_STAGE(bufoff, gbase, voff) do { _Pragma("unroll") for (int _i = 0; _i < 2; ++_i) \
        __builtin_amdgcn_global_load_lds((const unsigned*)((const char*)(gbase) + (voff)[_i]), (LAS unsigned*)(lds + (bufoff) + ldsw + _i * 8192), 16, 0, 0); } while (0)
#define PG8_LDA(dst, b, h) do { _Pragma("unroll") for (int m = 0; m < 4; ++m) _Pragma("unroll") for (int k = 0; k < 2; ++k) dst[m][k] = *(const LAS bf16x8*)(lds + PG8_SA(b, h) + aoff + m * 2048 + k * 1024); } while (0)
#define PG8_LDB(dst, b, h) do { _Pragma("unroll") for (int n = 0; n < 2; ++n) _Pragma("unroll") for (int k = 0; k < 2; ++k) dst[n][k] = *(const LAS bf16x8*)(lds + PG8_SB(b, h) + boff + n * 2048 + k * 1024); } while (0)
#define PG8_MMA(ai, bj, At, Bt) do { __builtin_amdgcn_s_setprio(1); _Pragma("unroll") for (int m = 0; m < 4; ++m) _Pragma("unroll") for (int n = 0; n < 2; ++n) _Pragma("unroll") for (int k = 0; k < 2; ++k) \
        acc[ai][bj][m][n] = __builtin_amdgcn_mfma_f32_16x16x32_bf16(Bt[n][k], At[m][k], acc[ai][bj][m][n], 0, 0, 0); __builtin_amdgcn_s_setprio(0); } while (0)
#define PG8_WAIT_V(n) asm volatile("s_waitcnt vmcnt(" #n ")" ::: "memory")
#define PG8_WAIT_L(n) asm volatile("s_waitcnt lgkmcnt(" #n ")" ::: "memory")
#define PG8_BAR __builtin_amdgcn_s_barrier()
#define PG8_SCHED __builtin_amdgcn_sched_barrier(0)
    Unit cur, nxt; int ui = 0;
    if (!S.next(0, cur)) return;
    Acc acc;
#pragma unroll
    for (int a = 0; a < 2; ++a)
#pragma unroll
        for (int b = 0; b < 2; ++b)
#pragma unroll
            for (int m = 0; m < 4; ++m)
#pragma unroll
                for (int n = 0; n < 2; ++n) acc[a][b][m][n] = (f32x4){0.f, 0.f, 0.f, 0.f};
    bf16x8 At[4][2], B0[2][2], B1[2][2];
    const char* cA = cur.a; const char* cB = cur.b;
    if constexpr (SP2) {
        PG8_STAGE(PG8_SB(0, 0), cB, voffB); PG8_STAGE(PG8_SB(0, 1), cB + hstepB, voffB); PG8_STAGE(PG8_SA(0, 0), cA, voffA); PG8_STAGE(PG8_SA(0, 1), cA + hstepA, voffA);
        if (wr == 1) PG8_BAR;
        PG8_WAIT_V(2); PG8_BAR;
        PG8_STAGE(PG8_SB(1, 0), cB + kstep, voffB); PG8_STAGE(PG8_SA(1, 0), cA + kstep, voffA); PG8_STAGE(PG8_SB(1, 1), cB + hstepB + kstep, voffB);
        PG8_WAIT_V(6); PG8_BAR;
    } else {
        PG8_STAGE(PG8_SB(0, 0), cB, voffB); PG8_STAGE(PG8_SA(0, 0), cA, voffA); PG8_STAGE(PG8_SB(0, 1), cB + hstepB, voffB); PG8_STAGE(PG8_SA(0, 1), cA + hstepA, voffA);
        if (wr == 1) PG8_BAR;
        PG8_WAIT_V(4); PG8_BAR;
        PG8_STAGE(PG8_SB(1, 0), cB + kstep, voffB); PG8_STAGE(PG8_SA(1, 0), cA + kstep, voffA); PG8_STAGE(PG8_SB(1, 1), cB + hstepB + kstep, voffB);
        PG8_WAIT_V(6); PG8_BAR;
    }
    for (;;) {
        const bool has_next = S.next(ui + 1, nxt);
        const char* nA = has_next ? nxt.a : cA; const char* nB = has_next ? nxt.b : cB;
#pragma nounroll
        for (int t = 0; t < nt; t += 2) {
            const bool last = (t == nt - 2);
            const char* a1 = cA + (size_t)(t + 1) * kstep;
            const char* a2 = last ? nA : cA + (size_t)(t + 2) * kstep; const char* b2 = last ? nB : cB + (size_t)(t + 2) * kstep;
            const char* a3 = a2 + kstep; const char* b3 = b2 + kstep;
            if constexpr (SP2) {
            PG8_LDB(B0, 0, 0); PG8_LDB(B1, 0, 1); PG8_SCHED; PG8_LDA(At, 0, 0); PG8_STAGE(PG8_SA(1, 1), a1 + hstepA, voffA);
            PG8_WAIT_V(8); PG8_WAIT_L(0); PG8_BAR; PG8_MMA(0, 0, At, B0); PG8_MMA(0, 1, At, B1); PG8_BAR; PG8_SCHED;
            PG8_LDA(At, 0, 1); PG8_STAGE(PG8_SB(0, 0), b2, voffB); PG8_STAGE(PG8_SB(0, 1), b2 + hstepB, voffB); PG8_STAGE(PG8_SA(0, 0), a2, voffA);
            PG8_WAIT_V(8); PG8_WAIT_L(0); PG8_BAR; PG8_MMA(1, 0, At, B0); PG8_MMA(1, 1, At, B1); PG8_BAR; PG8_SCHED;
            PG8_LDB(B0, 1, 0); PG8_LDB(B1, 1, 1); PG8_SCHED; PG8_LDA(At, 1, 0); PG8_STAGE(PG8_SA(0, 1), a2 + hstepA, voffA);
            PG8_WAIT_V(8); PG8_WAIT_L(0); PG8_BAR; PG8_MMA(0, 0, At, B0); PG8_MMA(0, 1, At, B1); PG8_BAR; PG8_SCHED;
            PG8_LDA(At, 1, 1); PG8_STAGE(PG8_SB(1, 0), b3, voffB); PG8_STAGE(PG8_SB(1, 1), b3 + hstepB, voffB); PG8_STAGE(PG8_SA(1, 0), a3, voffA);
            PG8_WAIT_V(8); PG8_WAIT_L(0); PG8_BAR; PG8_MMA(1, 0, At, B0); PG8_MMA(1, 1, At, B1); PG8_BAR; PG8_SCHED;
            } else {
            PG8_LDB(B0, 0, 0); PG8_SCHED; PG8_LDA(At, 0, 0); PG8_STAGE(PG8_SA(1, 1), a1 + hstepA, voffA);
            PG8_WAIT_L(8); PG8_BAR; PG8_WAIT_L(0); PG8_MMA(0, 0, At, B0); PG8_BAR; PG8_SCHED;
            PG8_LDB(B1, 0, 1); PG8_STAGE(PG8_SB(0, 0), b2, voffB);
            PG8_BAR; PG8_WAIT_L(0); PG8_MMA(0, 1, At, B1); PG8_BAR;
            PG8_LDA(At, 0, 1); PG8_STAGE(PG8_SA(0, 0), a2, voffA);
            PG8_BAR; PG8_WAIT_L(0); PG8_MMA(1, 0, At, B0); PG8_BAR; PG8_SCHED;
            PG8_STAGE(PG8_SB(0, 1), b2 + hstepB, voffB);
            PG8_WAIT_V(6); PG8_BAR; PG8_MMA(1, 1, At, B1); PG8_BAR;
            PG8_LDB(B0, 1, 0); PG8_SCHED; PG8_LDA(At, 1, 0); PG8_STAGE(PG8_SA(0, 1), a2 + hstepA, voffA);
            PG8_WAIT_L(8); PG8_BAR; PG8_WAIT_L(0); PG8_MMA(0, 0, At, B0); PG8_BAR; PG8_SCHED;
            PG8_LDB(B1, 1, 1); PG8_STAGE(PG8_SB(1, 0), b3, voffB);
            PG8_BAR; PG8_WAIT_L(0); PG8_MMA(0, 1, At, B1); PG8_BAR;
            PG8_LDA(At, 1, 1); PG8_STAGE(PG8_SA(1, 0), a3, voffA);
            PG8_BAR; PG8_WAIT_L(0); PG8_MMA(1, 0, At, B0); PG8_BAR; PG8_SCHED;
            PG8_STAGE(PG8_SB(1, 1), b3 + hstepB, voffB);
            PG8_WAIT_V(6); PG8_BAR; PG8_MMA(1, 1, At, B1); PG8_BAR;
            }
        }
        if constexpr (ALIGN_EPI) { if (wr == 0) PG8_BAR; }
        E(acc, cur, wr, wc, fr, fq, lds);
        if (!has_next) break;
#pragma unroll
        for (int a = 0; a < 2; ++a)
#pragma unroll
            for (int b = 0; b < 2; ++b)
#pragma unroll
                for (int m = 0; m < 4; ++m)
#pragma unroll
                    for (int n = 0; n < 2; ++n) acc[a][b][m][n] = (f32x4){0.f, 0.f, 0.f, 0.f};
        cur = nxt; cA = nA; cB = nB; ++ui;
        if constexpr (ALIGN_EPI) { if (wr == 1) PG8_BAR; }
    }
    PG8_WAIT_V(0);
    if constexpr (!ALIGN_EPI) { if (wr == 0) PG8_BAR; }
    PG8_BAR;
#undef PG8_SA
#undef PG8_SB
#undef PG8_STAGE
#undef PG8_LDA
#undef PG8_LDB
#undef PG8_MMA
#undef PG8_WAIT_V
#undef PG8_WAIT_L
#undef PG8_BAR
#undef PG8_SCHED
}

struct SchedDense {
    int nM, nN, nwg, G, c; const char* A; const char* B; size_t a_tile, b_tile; int pm_per_batch; size_t b_batch;
    __device__ __forceinline__ bool next(int i, Unit& u) const {
        const long L = (long)i * G + c; if (L >= nwg) return false;
        int wgid = (int)L; { const int q = nwg / NXCD, r = nwg % NXCD, xcd = wgid % NXCD, off = wgid / NXCD; wgid = (xcd < r ? xcd * (q + 1) : r * (q + 1) + (xcd - r) * q) + off; }
        const int nig = WGM * nN, gid = wgid / nig, fm = gid * WGM, gsz = (nM - fm) < WGM ? (nM - fm) : WGM;
        u.pm = fm + ((wgid % nig) % gsz); u.pn = (wgid % nig) / gsz; u.aux = 0;
        u.a = A + (size_t)u.pm * a_tile; u.b = B + (size_t)u.pn * b_tile + (size_t)(u.pm / pm_per_batch) * b_batch; return true;
    }
};
}
using pg8::Unit; using pg8::Acc;

struct EpiBf16 {
    static constexpr bool PERM = true;
    bf16_t* O; int ldc; size_t aux_stride; float scale;
    __device__ __forceinline__ void operator()(const Acc& acc, const Unit& u, int wr, int wc, int fr, int fq, LAS unsigned char*) const {
        bf16_t* base = O + (size_t)u.aux * aux_stride;
        const int row0 = u.pm * 256 + wr * 64 + fr, col0 = u.pn * 256 + wc * 32 + 8 * fq;
#pragma unroll
        for (int ai = 0; ai < 2; ++ai)
#pragma unroll
            for (int m = 0; m < 4; ++m) { bf16_t* rowp = base + (size_t)(row0 + ai * 128 + m * 16) * ldc + col0;
#pragma unroll
                for (int bj = 0; bj < 2; ++bj) { const f32x4 v0 = acc[ai][bj][m][0] * scale, v1 = acc[ai][bj][m][1] * scale;
                    u32x4 w; w.x = cvt_pk_bf16(v0[0], v0[1]); w.y = cvt_pk_bf16(v0[2], v0[3]); w.z = cvt_pk_bf16(v1[0], v1[1]); w.w = cvt_pk_bf16(v1[2], v1[3]);
                    *(u32x4*)(rowp + bj * 128) = w; } }
    }
};
struct EpiKV {
    static constexpr bool PERM = true;
    bf16_t* KB; bf16_t* VB;
    __device__ __forceinline__ void operator()(const Acc& acc, const Unit& u, int wr, int wc, int fr, int fq, LAS unsigned char*) const {
        bf16_t* base = (u.pn < 4 ? KB : VB) + (size_t)u.aux * MEMROWS * DM;
        const int row0 = u.pm * 256 + wr * 64 + fr, col0 = (u.pn & 3) * 256 + wc * 32 + 8 * fq;
#pragma unroll
        for (int ai = 0; ai < 2; ++ai)
#pragma unroll
            for (int m = 0; m < 4; ++m) { bf16_t* rowp = base + (size_t)(row0 + ai * 128 + m * 16) * DM + col0;
#pragma unroll
                for (int bj = 0; bj < 2; ++bj) { const f32x4 v0 = acc[ai][bj][m][0], v1 = acc[ai][bj][m][1];
                    u32x4 w; w.x = cvt_pk_bf16(v0[0], v0[1]); w.y = cvt_pk_bf16(v0[2], v0[3]); w.z = cvt_pk_bf16(v1[0], v1[1]); w.w = cvt_pk_bf16(v1[2], v1[3]);
                    *(u32x4*)(rowp + bj * 128) = w; } }
    }
};
struct EpiProj {
    static constexpr bool PERM = true;
    bf16_t* HG; bf16_t* QR; bf16_t* KF; bf16_t* V; const float* rstd; const f32x2* CS;
    __device__ __forceinline__ void operator()(const Acc& acc, const Unit& u, int wr, int wc, int fr, int fq, LAS unsigned char*) const {
        const int row0 = u.pm * 256 + wr * 64 + fr;
        if (u.pn < 8 || u.pn >= 12) {
            bf16_t* base; int ldc, colt;
            if (u.pn < 8) { base = HG; ldc = 2048; colt = u.pn * 256; } else { base = V; ldc = 512; colt = (u.pn - 12) * 256; }
            const int col0 = colt + wc * 32 + 8 * fq;
#pragma unroll
            for (int ai = 0; ai < 2; ++ai)
#pragma unroll
                for (int m = 0; m < 4; ++m) { const int row = row0 + ai * 128 + m * 16; const float rs = rstd[row]; bf16_t* rowp = base + (size_t)row * ldc + col0;
#pragma unroll
                    for (int bj = 0; bj < 2; ++bj) { const f32x4 v0 = acc[ai][bj][m][0] * rs, v1 = acc[ai][bj][m][1] * rs;
                        u32x4 w; w.x = cvt_pk_bf16(v0[0], v0[1]); w.y = cvt_pk_bf16(v0[2], v0[3]); w.z = cvt_pk_bf16(v1[0], v1[1]); w.w = cvt_pk_bf16(v1[2], v1[3]);
                        *(u32x4*)(rowp + bj * 128) = w; } }
        } else {
            const bool isk = u.pn >= 10; const int head = 4 * (u.pn & 1) + wc;
#pragma unroll
            for (int ai = 0; ai < 2; ++ai)
#pragma unroll
                for (int m = 0; m < 4; ++m) { const int row = row0 + ai * 128 + m * 16; const float rs = rstd[row] * (isk ? 1.f : 0.125f);
                    const f32x4* cs = (const f32x4*)(CS + (size_t)row * 32 + 8 * fq); const f32x4 c0 = cs[0], c1 = cs[1], c2 = cs[2], c3 = cs[3];
                    const float co[8] = {c0.x, c0.z, c1.x, c1.z, c2.x, c2.z, c3.x, c3.z}, si[8] = {c0.y, c0.w, c1.y, c1.w, c2.y, c2.w, c3.y, c3.w};
                    float lo[8], hi[8];
#pragma unroll
                    for (int n = 0; n < 2; ++n)
#pragma unroll
                        for (int e = 0; e < 4; ++e) { const int j = 4 * n + e; const float x1 = acc[ai][0][m][n][e] * rs, x2 = acc[ai][1][m][n][e] * rs; lo[j] = x1 * co[j] - x2 * si[j]; hi[j] = x2 * co[j] + x1 * si[j]; }
                    u32x4 wl, wh; wl.x = cvt_pk_bf16(lo[0], lo[1]); wl.y = cvt_pk_bf16(lo[2], lo[3]); wl.z = cvt_pk_bf16(lo[4], lo[5]); wl.w = cvt_pk_bf16(lo[6], lo[7]);
                    wh.x = cvt_pk_bf16(hi[0], hi[1]); wh.y = cvt_pk_bf16(hi[2], hi[3]); wh.z = cvt_pk_bf16(hi[4], hi[5]); wh.w = cvt_pk_bf16(hi[6], hi[7]);
                    if (!isk) { bf16_t* rowp = QR + (size_t)row * 512 + head * 64 + 8 * fq; *(u32x4*)rowp = wl; *(u32x4*)(rowp + 32) = wh; }
                    else {
                        const int b = row >> 13, s = row & (SEQ - 1); const size_t bh = (size_t)(b * ATH + head) * (SEQ * 64);
#pragma unroll
                        for (int pat = 0; pat < 3; ++pat) { const int D = pat == 0 ? 1 : (pat == 1 ? 4 : 16), sh = pat * 2; const int r = s & (D - 1), p = s >> sh, T = p >> 5, k5 = p & 31;
                            const int rho = (k5 & 19) | ((k5 & 4) << 1) | ((k5 & 8) >> 1);
                            bf16_t* kf = KF + (size_t)pat * (MT * 512) + bh + ((size_t)(r * (SEQ / 32 >> sh) + T) * 4) * 512;
                            *(u32x4*)(kf + ((fq >> 1) * 64 + rho + 32 * (fq & 1)) * 8) = wl; *(u32x4*)(kf + ((2 + (fq >> 1)) * 64 + rho + 32 * (fq & 1)) * 8) = wh; }
                    } }
        }
    }
};
struct EpiResAdd {
    static constexpr bool PERM = false;
    float* X;
    __device__ __forceinline__ void operator()(const Acc& acc, const Unit& u, int wr, int wc, int fr, int fq, LAS unsigned char*) const {
        const int row0 = u.pm * 256 + wr * 64 + fr, col0 = u.pn * 256 + wc * 32 + 4 * fq;
#pragma unroll
        for (int ai = 0; ai < 2; ++ai)
#pragma unroll
            for (int m = 0; m < 4; ++m) { float* rowp = X + (size_t)(row0 + ai * 128 + m * 16) * DM + col0;
#pragma unroll
                for (int bj = 0; bj < 2; ++bj)
#pragma unroll
                    for (int n = 0; n < 2; ++n) { f32x4* p = (f32x4*)(rowp + bj * 128 + n * 16); *p = *p + acc[ai][bj][m][n]; } }
    }
};
struct EpiSoftmax {
    static constexpr bool PERM = false;
    bf16_t* P; const float* rstd;
    __device__ __forceinline__ void operator()(Acc& acc, const Unit& u, int wr, int wc, int fr, int fq, LAS unsigned char* lds) const {
        LAS f32x2* EX = (LAS f32x2*)(lds + SPARE_OFF);
        const int row0 = u.pm * 256 + wr * 64 + fr;
        float mw[2][4];
#pragma unroll
        for (int ai = 0; ai < 2; ++ai)
#pragma unroll
            for (int m = 0; m < 4; ++m) {
                const float rs = rstd[row0 + ai * 128 + m * 16];
                float mx = -3.0e38f;
#pragma unroll
                for (int bj = 0; bj < 2; ++bj)
#pragma unroll
                    for (int n = 0; n < 2; ++n) { f32x4 v = acc[ai][bj][m][n] * rs; acc[ai][bj][m][n] = v; mx = fmaxf(mx, fmaxf(fmaxf(v[0], v[1]), fmaxf(v[2], v[3]))); }
                mx = fmaxf(mx, __shfl_xor(mx, 16)); mx = fmaxf(mx, __shfl_xor(mx, 32));
                float sm = 0.f;
#pragma unroll
                for (int bj = 0; bj < 2; ++bj)
#pragma unroll
                    for (int n = 0; n < 2; ++n) { f32x4 v = acc[ai][bj][m][n]; v[0] = __expf(v[0] - mx); v[1] = __expf(v[1] - mx); v[2] = __expf(v[2] - mx); v[3] = __expf(v[3] - mx);
                        acc[ai][bj][m][n] = v; sm += (v[0] + v[1]) + (v[2] + v[3]); }
                sm += __shfl_xor(sm, 16); sm += __shfl_xor(sm, 32);
                mw[ai][m] = mx;
                if (fq == 0) EX[(ai * 128 + wr * 64 + m * 16 + fr) * 4 + wc] = (f32x2){mx, sm};
            }
        asm volatile("s_waitcnt lgkmcnt(0)" ::: "memory"); __builtin_amdgcn_s_barrier(); asm volatile("" ::: "memory");
#pragma unroll
        for (int ai = 0; ai < 2; ++ai)
#pragma unroll
            for (int m = 0; m < 4; ++m) {
                const int rl = ai * 128 + wr * 64 + m * 16 + fr;
                const f32x2 e0 = EX[rl * 4 + 0], e1 = EX[rl * 4 + 1], e2 = EX[rl * 4 + 2], e3 = EX[rl * 4 + 3];
                const float M = fmaxf(fmaxf(e0.x, e1.x), fmaxf(e2.x, e3.x));
                const float Ls = e0.y * __expf(e0.x - M) + e1.y * __expf(e1.x - M) + e2.y * __expf(e2.x - M) + e3.y * __expf(e3.x - M);
                const float f = __expf(mw[ai][m] - M) / Ls;
                bf16_t* rowp = P + (size_t)(row0 + ai * 128 + m * 16) * DM + u.pn * 256 + wc * 32 + 4 * fq;
#pragma unroll
                for (int bj = 0; bj < 2; ++bj)
#pragma unroll
                    for (int n = 0; n < 2; ++n) { const f32x4 v = acc[ai][bj][m][n] * f; u32x2 w; w.x = cvt_pk_bf16(v[0], v[1]); w.y = cvt_pk_bf16(v[2], v[3]);
                        *(u32x2*)(rowp + bj * 128 + n * 16) = w; }
            }
        asm volatile("s_waitcnt lgkmcnt(0)" ::: "memory"); __builtin_amdgcn_s_barrier(); asm volatile("" ::: "memory");
    }
};
struct EpiMoe1 {
    static constexpr bool PERM = true;
    bf16_t* ACTB; const float* srs; const float* sgw;
    __device__ __forceinline__ void operator()(const Acc& acc, const Unit& u, int wr, int wc, int fr, int fq, LAS unsigned char*) const {
        const int row0 = u.pm * 256 + wr * 64 + fr, col0 = u.pn * 128 + wc * 32 + 8 * fq;
#pragma unroll
        for (int ai = 0; ai < 2; ++ai)
#pragma unroll
            for (int m = 0; m < 4; ++m) { const int row = row0 + ai * 128 + m * 16; const float rs = srs[row], gw = sgw[row] * rs;
                float o[8];
#pragma unroll
                for (int n = 0; n < 2; ++n)
#pragma unroll
                    for (int j = 0; j < 4; ++j) { const float g = acc[ai][0][m][n][j] * rs, up = acc[ai][1][m][n][j]; o[n * 4 + j] = g * sigmoidf_(g) * up * gw; }
                u32x4 w; w.x = cvt_pk_bf16(o[0], o[1]); w.y = cvt_pk_bf16(o[2], o[3]); w.z = cvt_pk_bf16(o[4], o[5]); w.w = cvt_pk_bf16(o[6], o[7]);
                *(u32x4*)(ACTB + (size_t)row * EFF + col0) = w; }
    }
};

struct Args { const void* in[20]; float* out; unsigned char* ws; int ph_lo, ph_hi; };
struct Frame {
    LAS unsigned char* lds; volatile LAS unsigned* MISC; gu32* ctl;
    int tid, lane, wave, vcu, G;
    unsigned char* ws; float* out; size_t z;
};

__device__ __forceinline__ void transpose_item(const float* W, int N, const float* scale, bf16_t* WT, int ldt, int row_base, int k0, int n0, LAS float* scr, int lane) {
#pragma unroll 8
    for (int i = 0; i < 32; ++i) { const int kk = 2 * i + (lane >> 5); float v = W[(size_t)(k0 + kk) * N + n0 + (lane & 31)]; if (scale) v *= scale[k0 + kk]; scr[kk * 33 + (lane & 31)] = v; }
    LDS_WAIT(); asm volatile("" ::: "memory");
    const int c = lane & 7;
#pragma unroll
    for (int j = 0; j < 4; ++j) { const int n = (lane >> 3) + 8 * j; const LAS float* s = scr + (8 * c) * 33 + n;
        u32x4 o; o.x = pk2(s[0 * 33], s[1 * 33]); o.y = pk2(s[2 * 33], s[3 * 33]); o.z = pk2(s[4 * 33], s[5 * 33]); o.w = pk2(s[6 * 33], s[7 * 33]);
        *(GAS u32x4*)(WT + (size_t)(row_base + n0 + n) * ldt + k0 + 8 * c) = o; }
    LDS_WAIT(); asm volatile("" ::: "memory");
}
__device__ __forceinline__ void transpose_mat_item(const float* W, int K, int N, const float* scale, bf16_t* WT, int mode, int it, LAS float* scr, int lane) {
    const int nblk = N / 32, kb = it / nblk, nb = it % nblk, k0 = 64 * kb, n0 = 32 * nb;
    int row_base = 0;
    if (mode == 1 || mode == 2) row_base = 256 * (n0 / 128) + (n0 % 128) + (mode == 2 ? 128 : 0) - n0;
    if (mode == 3 && n0 >= 2048 && n0 < 3072) {
        const int blk = (n0 - 2048) / 512, np = (n0 - 2048) % 512, head = np / 64, d = np % 64;
        row_base = 2048 + blk * 512 + (head / 4) * 256 + 128 * (d / 32) + 32 * (head % 4) + (d % 32) - n0; }
    transpose_item(W, N, scale, WT, K, row_base, k0, n0, scr, lane);
}

__device__ __forceinline__ float row_norm_prep(const float* xrow, bf16_t* xb_row, float* copy_row, int lane) {
    const GAS f32x4* xr = (const GAS f32x4*)xrow + lane;
    f32x4 v[4]; float s = 0.f;
#pragma unroll
    for (int j = 0; j < 4; ++j) { v[j] = xr[64 * j]; s += (v[j].x * v[j].x + v[j].y * v[j].y) + (v[j].z * v[j].z + v[j].w * v[j].w); }
    const float rstd = 1.f / sqrtf(wave_sum(s) * (1.f / DM) + EPS);
    GAS u32x2* o8 = (GAS u32x2*)xb_row + lane;
#pragma unroll
    for (int j = 0; j < 4; ++j) { u32x2 w; w.x = pk2(v[j].x, v[j].y); w.y = pk2(v[j].z, v[j].w); o8[64 * j] = w; }
    if (copy_row) { GAS f32x4* c = (GAS f32x4*)copy_row + lane;
#pragma unroll
        for (int j = 0; j < 4; ++j) c[64 * j] = v[j]; }
    return rstd;
}

__constant__ double INV_FREQ[32] = {1.0, 0.7498942093324559, 0.5623413251903491, 0.4216965034285822, 0.31622776601683794, 0.23713737056616552, 0.1778279410038923, 0.1333521432163324,
    0.1, 0.07498942093324558, 0.05623413251903491, 0.042169650342858224, 0.03162277660168379, 0.023713737056616554, 0.01778279410038923, 0.01333521432163324,
    0.01, 0.007498942093324558, 0.005623413251903491, 0.004216965034285823, 0.0031622776601683794, 0.0023713737056616554, 0.0017782794100389228, 0.001333521432163324,
    0.001, 0.0007498942093324559, 0.0005623413251903491, 0.00042169650342858224, 0.00031622776601683794, 0.00023713737056616554, 0.00017782794100389227, 0.0001333521432163324};


#define IN_F(i) ((const float*)((const char*)a.in[i] + F.z))
__device__ __forceinline__ float hg_lb(const Frame& F, const Args& a, int l, int c) { if (l == 0) return 0.f; const float* h = IN_F(5); return sigmoidf_(h[HGW + c] - h[c]); }
__device__ __forceinline__ void ph_init(Frame& F, const Args& a) {
    LAS float* scr = (LAS float*)(F.lds + F.wave * 16384);
    const int gw = F.vcu * NWAVES + F.wave, NGW = F.G * NWAVES, lane = F.lane;
    unsigned char* ws = F.ws;
    for (int it = gw; it < 2 * 3840; it += NGW) {
        const int l = it / 3840; int r = it % 3840;
        if (r < 1792) { transpose_mat_item(IN_F(4) + (size_t)l * DM * NIN, DM, NIN, IN_F(3) + l * DM, (bf16_t*)(ws + WS_WIN) + (size_t)l * NIN * DM, 3, r, scr, lane); continue; } r -= 1792;
        if (r < 512) { transpose_mat_item(IN_F(7) + (size_t)l * DM * DM, DM, DM, nullptr, (bf16_t*)(ws + WS_WOUT) + (size_t)l * DM * DM, 0, r, scr, lane); continue; } r -= 512;
        if (r < 1024) { transpose_mat_item(IN_F(11) + (size_t)l * DM * 2 * DM, DM, 2 * DM, nullptr, (bf16_t*)(ws + WS_WKVT) + (size_t)l * 2 * DM * DM, 0, r, scr, lane); continue; } r -= 1024;
        transpose_mat_item(IN_F(12) + (size_t)l * DM * DM, DM, DM, nullptr, (bf16_t*)(ws + WS_WOT) + (size_t)l * DM * DM, 0, r, scr, lane);
    }
    for (int r = gw; r < DEPTH * DM; r += NGW) {
        const float sc = IN_F(8)[r] * 0.0625f;
        const GAS f32x4* src = (const GAS f32x4*)(IN_F(10) + (size_t)r * DM) + lane; GAS u32x2* dst = (GAS u32x2*)((bf16_t*)(ws + WS_WQS) + (size_t)r * DM) + lane;
#pragma unroll
        for (int j = 0; j < 4; ++j) { const f32x4 v = src[64 * j] * sc; u32x2 w; w.x = pk2(v.x, v.y); w.y = pk2(v.z, v.w); dst[64 * j] = w; }
    }
    for (int r = gw; r < MEMROWS; r += NGW) {
        const GAS f32x4* xr = (const GAS f32x4*)(IN_F(1) + (size_t)r * DM) + lane;
        f32x4 v[4]; float s = 0.f;
#pragma unroll
        for (int j = 0; j < 4; ++j) { v[j] = xr[64 * j]; s += (v[j].x * v[j].x + v[j].y * v[j].y) + (v[j].z * v[j].z + v[j].w * v[j].w); }
        const float rstd = 1.f / sqrtf(wave_sum(s) * (1.f / DM) + EPS);
        for (int l = 0; l < DEPTH; ++l) {
            const GAS f32x4* g = (const GAS f32x4*)(IN_F(9) + l * DM) + lane; GAS u32x2* dst = (GAS u32x2*)((bf16_t*)(ws + WS_MEMN) + ((size_t)l * MEMROWS + r) * DM) + lane;
#pragma unroll
            for (int j = 0; j < 4; ++j) { const f32x4 o = v[j] * rstd * g[64 * j]; u32x2 w; w.x = pk2(o.x, o.y); w.y = pk2(o.z, o.w); dst[64 * j] = w; }
        }
    }
    for (int r = gw; r < MT; r += NGW) {
        const float rs = row_norm_prep(IN_F(0) + (size_t)r * DM, (bf16_t*)(ws + WS_XB) + (size_t)r * DM, F.out + (size_t)r * DM, lane);
        if (lane == 0) ((float*)(ws + WS_RSTD))[r] = rs;
    }
    for (int i = (F.vcu * NTHR + F.tid); i < DEPTH * HGW; i += F.G * NTHR) ((float*)(ws + WS_LBT))[i] = hg_lb(F, a, i / HGW, i % HGW);
    { const int* pos = (const int*)((const char*)a.in[2] + F.z);
      for (int i = (F.vcu * NTHR + F.tid); i < MT * 32; i += F.G * NTHR) { const double ang = (double)pos[i >> 5] * INV_FREQ[i & 31]; double rev = ang * 0.15915494309189535; rev = rev - __builtin_floor(rev);
          const float fr = (float)rev; ((f32x2*)(ws + WS_CS))[i] = (f32x2){__builtin_amdgcn_cosf(fr), __builtin_amdgcn_sinf(fr)}; } }
    for (int i = (F.vcu * NTHR + F.tid); i < DEPTH * DM * 20; i += F.G * NTHR) {
        const int l = i / (DM * 20), k = (i / 20) % DM, j = i % 20;
        const float g = IN_F(13)[l * DM + k];
        const float w = j < 4 ? IN_F(14)[((size_t)l * DM + k) * 4 + j] : IN_F(15)[((size_t)l * DM + k) * 16 + (j - 4)];
        ((float*)(ws + WS_WR))[i] = g * w;
    }
}

struct SchedKV {
    int G, c; const char* memn; const char* wkvt;
    __device__ __forceinline__ bool next(int i, Unit& u) const {
        const int L = i * G + c; if (L >= 32) return false;
        const int l = L >> 4; u.pm = (L >> 3) & 1; u.pn = L & 7; u.aux = l;
        u.a = memn + ((size_t)l * MEMROWS + u.pm * 256) * DM * 2; u.b = wkvt + ((size_t)l * 2 * DM + u.pn * 256) * DM * 2; return true;
    }
};
struct SchedFold {
    int G, c; const char* kb; const char* vb; const char* wqs; const char* wot;
    __device__ __forceinline__ bool next(int i, Unit& u) const {
        const int L = i * G + c; if (L >= 128) return false;
        const int ty = L >> 6, l = (L >> 5) & 1, b = (L >> 4) & 1, h = (L >> 2) & 3, t = L & 3; u.aux = ty * 4 + l * 2 + b;
        if (ty == 0) { u.pm = h; u.pn = t; u.a = kb + (((size_t)l * MEMROWS + b * 256) * DM + h * 256) * 2; u.b = wqs + (((size_t)l * DM + t * 256) * DM + h * 256) * 2; }
        else { u.pm = t; u.pn = h; u.a = wot + (((size_t)l * DM + t * 256) * DM + h * 256) * 2; u.b = vb + (((size_t)l * MEMROWS + b * 256) * DM + h * 256) * 2; }
        return true;
    }
};
struct SchedMoe {
    int G, c, kdim; volatile LAS unsigned* tb; const char* A; const char* B;
    __device__ __forceinline__ bool next(int i, Unit& u) const {
        const int L = i * G + c; const int total = (int)tb[16] * 4; if (L >= total) return false;
        const int mt = L >> 2; u.pm = mt; u.pn = L & 3; int e = 0;
#pragma unroll
        for (int j = 1; j < 16; ++j) e += (mt >= (int)tb[j]) ? 1 : 0;
        u.aux = e; u.a = A + (size_t)mt * 256 * kdim * 2; u.b = B + ((size_t)e * 1024 + u.pn * 256) * kdim * 2; return true;
    }
};

__device__ __forceinline__ void vf_unit(Frame& F, int unit) {
    unsigned char* ws = F.ws; const int tid = F.tid;
    const int tb = unit >> 3, h = unit & 7, b = tb >> 4, s_base = (tb & 15) * 512;
    LAS unsigned short* Vl = (LAS unsigned short*)F.lds;
    const bf16_t* V = (const bf16_t*)(ws + A_V) + ((size_t)b * SEQ + s_base) * 512 + h * 64;
#pragma unroll
    for (int p = 0; p < 8; ++p) { const int c = p * 512 + tid, row = c >> 3, ch = c & 7; *(LAS u32x4*)(Vl + row * 72 + ch * 8) = *(const GAS u32x4*)(V + (size_t)row * 512 + ch * 8); }
    __syncthreads();
    const size_t bh = (size_t)(b * ATH + h) * (SEQ * 64);
    for (int it = 0; it < 24; ++it) { const int pc = it * 512 + tid, tile = pc >> 8, q = pc & 255, s = q >> 7, mt = (q >> 6) & 1, ln = q & 63, dim = (ln & 31) + 32 * mt, hi = ln >> 5;
        const int pat = tile >> 4, j16 = tile & 15, sh = pat * 2, D = 1 << sh;
        const int TPC = 16 >> sh, r = j16 / TPC, tl = j16 % TPC;
        const int pl = tl * 32 + 16 * s + 8 * hi;
        unsigned w[4];
#pragma unroll
        for (int jj = 0; jj < 4; ++jj) { const int t0 = ((pl + 2 * jj) << sh) + r, t1 = ((pl + 2 * jj + 1) << sh) + r; w[jj] = (unsigned)Vl[t0 * 72 + dim] | ((unsigned)Vl[t1 * 72 + dim] << 16); }
        const int T = (s_base >> sh >> 5) + tl;
        bf16_t* vf = (bf16_t*)(ws + A_VT1) + (size_t)pat * (MT * 512) + bh + ((size_t)(r * (SEQ / 32 >> sh) + T) * 4 + s * 2 + mt) * 512 + ln * 8;
        *(GAS u32x4*)vf = (u32x4){w[0], w[1], w[2], w[3]}; }
    __syncthreads();
}

__device__ __forceinline__ void hg_build_b(Frame& F, int l, int h, const u32x4 z0, const u32x4 z1, int k0, float (&bb)[16], float (&kk)[16]) {
    const int tid = F.tid, lane = F.lane, wave = F.wave, tl = lane >> 3;
    LAS float* WT = (LAS float*)F.lds; LAS float* REF = (LAS float*)(F.lds + 4096);
    const unsigned zz[8] = {z0.x, z0.y, z0.z, z0.w, z1.x, z1.y, z1.z, z1.w};
    float lbv[16];
#pragma unroll
    for (int i = 0; i < 16; i += 4) { const f32x4 t4 = *(const GAS f32x4*)((const float*)(F.ws + WS_LBT) + l * HGW + h * 128 + k0 + i); lbv[i] = t4.x; lbv[i + 1] = t4.y; lbv[i + 2] = t4.z; lbv[i + 3] = t4.w; }
#pragma unroll
    for (int i = 0; i < 16; ++i) { const float z = (i & 1) ? bfhi(zz[i >> 1]) : bflo(zz[i >> 1]); const float lb = lbv[i];
        const float e = ex2(-LOG2E * z), sg = __builtin_amdgcn_rcpf(1.f + e), f = lb + (1.f - lb) * sg; bb[i] = __builtin_amdgcn_logf(f); kk[i] = (1.f - lb) * (e * sg); }
#pragma unroll
    for (int i = 0; i < 16; ++i) { float x = bb[i]; float y;
        y = __shfl_up(x, 8); if (tl >= 1) x += y;
        y = __shfl_up(x, 16); if (tl >= 2) x += y;
        y = __shfl_up(x, 32); if (tl >= 4) x += y;
        bb[i] = x; }
    if (tl == 7) {
#pragma unroll
        for (int i = 0; i < 16; i += 4) *(LAS f32x4*)(WT + wave * 128 + k0 + i) = (f32x4){bb[i], bb[i + 1], bb[i + 2], bb[i + 3]}; }
    __syncthreads();
    for (int w = 0; w < wave; ++w) {
#pragma unroll
        for (int i = 0; i < 16; i += 4) { const f32x4 p = *(const LAS f32x4*)(WT + w * 128 + k0 + i); bb[i] += p.x; bb[i + 1] += p.y; bb[i + 2] += p.z; bb[i + 3] += p.w; } }
    if (tl == 7 && (wave & 1)) {
#pragma unroll
        for (int i = 0; i < 16; i += 4) *(LAS f32x4*)(REF + (wave >> 1) * 128 + k0 + i) = (f32x4){bb[i], bb[i + 1], bb[i + 2], bb[i + 3]}; }
    __syncthreads();
    (void)tid;
}
__device__ __forceinline__ void st_row16(LAS unsigned char* base, int byteoff, const float (&v)[16]) {
    u32x4 w0, w1; w0.x = cvt_pk_bf16(v[0], v[1]); w0.y = cvt_pk_bf16(v[2], v[3]); w0.z = cvt_pk_bf16(v[4], v[5]); w0.w = cvt_pk_bf16(v[6], v[7]); w1.x = cvt_pk_bf16(v[8], v[9]); w1.y = cvt_pk_bf16(v[10], v[11]); w1.z = cvt_pk_bf16(v[12], v[13]); w1.w = cvt_pk_bf16(v[14], v[15]);
    *(LAS u32x4*)(base + byteoff) = w0; *(LAS u32x4*)(base + byteoff + 16) = w1;
}
constexpr int HL_RED = 6144, HL_QD = 8192, HL_KD = 25600, HL_QE = 43008, HL_Q1 = 60416, HL_K1 = 69120, HL_Q2 = 77824, HL_K2 = 86528, HL_VT = 95232, HL_SC = 113664;
constexpr int HA_KT = 8192, HA_VT = 26624;
constexpr int RS128 = 272, RS64 = 144;

struct HgIn { u32x4 z0, z1, q0, q1, v0, v1; };
template <bool NEEDQ> __device__ __forceinline__ HgIn hg_load(Frame& F, int unit) {
    HgIn R;
    const int b = unit >> 9, h = (unit >> 7) & 3, c = unit & 127; const int row0 = b * SEQ + c * CHUNK, t = F.tid >> 3, k0 = (F.tid & 7) * 16;
    const bf16_t* rowp = (const bf16_t*)(F.ws + A_HG) + (size_t)(row0 + t) * 2048 + h * 128 + k0;
    R.z0 = *(const GAS u32x4*)(rowp + 512); R.z1 = *(const GAS u32x4*)(rowp + 512 + 8); R.v0 = *(const GAS u32x4*)(rowp + 1024); R.v1 = *(const GAS u32x4*)(rowp + 1024 + 8);
    if (NEEDQ) { R.q0 = *(const GAS u32x4*)(rowp); R.q1 = *(const GAS u32x4*)(rowp + 8); } else { R.q0 = R.z0; R.q1 = R.z1; }
    return R;
}
__device__ __forceinline__ void hg_a2_unit(Frame& F, const Args& a, int l, int unit, const HgIn& R) {
    unsigned char* ws = F.ws; const int tid = F.tid, lane = F.lane, wave = F.wave;
    const int h = (unit >> 7) & 3;
    const int t = tid >> 3, k0 = (tid & 7) * 16;
    const u32x4 v0 = R.v0, v1 = R.v1;
    float bb[16], kk[16];
    hg_build_b(F, l, h, R.z0, R.z1, k0, bb, kk);
    const LAS float* REF = (const LAS float*)(F.lds + 4096);
    LAS unsigned short* KT = (LAS unsigned short*)(F.lds + HA_KT); LAS unsigned short* VT = (LAS unsigned short*)(F.lds + HA_VT);
    const unsigned vv[8] = {v0.x, v0.y, v0.z, v0.w, v1.x, v1.y, v1.z, v1.w};
#pragma unroll
    for (int i = 0; i < 16; ++i) { const float b63 = REF[3 * 128 + k0 + i];
        KT[(k0 + i) * (RS64 / 2) + t] = (unsigned short)f2bf(kk[i] * ex2(b63 - bb[i]));
        VT[(k0 + i) * (RS64 / 2) + t] = (unsigned short)((i & 1) ? (vv[i >> 1] >> 16) : (vv[i >> 1] & 0xffffu)); }
    if (tid < 128) ((float*)(ws + A_DECAY))[(size_t)unit * 128 + tid] = ex2(REF[3 * 128 + tid]);
    __syncthreads();
    { const int fr = lane & 15, g = lane >> 4;
      bf16x8 af[2];
#pragma unroll
      for (int ks = 0; ks < 2; ++ks) af[ks] = *(const LAS bf16x8*)(F.lds + HA_KT + (wave * 16 + fr) * RS64 + (32 * ks + 8 * g) * 2);
      bf16_t* st = (bf16_t*)(ws + A_STATE) + (size_t)unit * 16384;
#pragma unroll
      for (int vt = 0; vt < 8; ++vt) { f32x4 acc = {0.f, 0.f, 0.f, 0.f};
#pragma unroll
          for (int ks = 0; ks < 2; ++ks) { const bf16x8 bf = *(const LAS bf16x8*)(F.lds + HA_VT + (vt * 16 + fr) * RS64 + (32 * ks + 8 * g) * 2); acc = __builtin_amdgcn_mfma_f32_16x16x32_bf16(af[ks], bf, acc, 0, 0, 0); }
          u32x2 w; w.x = cvt_pk_bf16(acc[0], acc[1]); w.y = cvt_pk_bf16(acc[2], acc[3]);
          *(GAS u32x2*)(st + (vt * 16 + fr) * 128 + wave * 16 + 4 * g) = w; } }
    __syncthreads();
}

template <int STOP> __device__ __forceinline__ void hg_c2_unit(Frame& F, const Args& a, int l, int unit, const HgIn& R) {
    unsigned char* ws = F.ws; const int tid = F.tid, lane = F.lane, wave = F.wave;
    const int b = unit >> 9, h = (unit >> 7) & 3, c = unit & 127; const int row0 = b * SEQ + c * CHUNK;
    const int t = tid >> 3, k0 = (tid & 7) * 16;
    const int fr = lane & 15, g = lane >> 4;
    const bf16_t* HG = (const bf16_t*)(ws + A_HG);
    const u32x4 q0 = R.q0, q1 = R.q1, v0 = R.v0, v1 = R.v1;
    bf16x8 sf[4]; u32x2 gwv[4];
    { const bf16_t* st = (const bf16_t*)(ws + A_STATE) + (size_t)unit * 16384 + (wave * 16 + fr) * 128;
#pragma unroll
      for (int ks = 0; ks < 4; ++ks) sf[ks] = *(const GAS bf16x8*)(st + 32 * ks + 8 * g);
#pragma unroll
      for (int I = 0; I < 4; ++I) gwv[I] = *(const GAS u32x2*)(HG + (size_t)(row0 + 16 * I + fr) * 2048 + 1536 + h * 128 + wave * 16 + 4 * g); }
    const f32x4 gain = *(const GAS f32x4*)(IN_F(6) + l * HGW + h * 128 + wave * 16 + 4 * g);
    float bb[16], kk[16];
    hg_build_b(F, l, h, R.z0, R.z1, k0, bb, kk);
    if (STOP == 1) { asm volatile("" :: "v"(bb[0]), "v"(kk[0]), "v"(sf[0]), "v"(gwv[0]), "v"(gain)); return; }
    const LAS float* REF = (const LAS float*)(F.lds + 4096);
    { const unsigned qq[8] = {q0.x, q0.y, q0.z, q0.w, q1.x, q1.y, q1.z, q1.w}, vv[8] = {v0.x, v0.y, v0.z, v0.w, v1.x, v1.y, v1.z, v1.w};
      LAS unsigned short* VT = (LAS unsigned short*)(F.lds + HL_VT);
      float qv[16], tmp[16];
#pragma unroll
      for (int i = 0; i < 16; ++i) { qv[i] = (i & 1) ? bfhi(qq[i >> 1]) : bflo(qq[i >> 1]); VT[(k0 + i) * (RS64 / 2) + t] = (unsigned short)((i & 1) ? (vv[i >> 1] >> 16) : (vv[i >> 1] & 0xffffu)); }
      const int I = wave >> 1;
      float rf[16];
#pragma unroll
      for (int i = 0; i < 16; i += 4) { f32x4 r4 = {0.f, 0.f, 0.f, 0.f}; if (I) r4 = *(const LAS f32x4*)(REF + (I - 1) * 128 + k0 + i); rf[i] = r4.x; rf[i + 1] = r4.y; rf[i + 2] = r4.z; rf[i + 3] = r4.w; }
#pragma unroll
      for (int i = 0; i < 16; ++i) tmp[i] = qv[i] * ex2(bb[i] - rf[i]);
      st_row16(F.lds, HL_QD + t * RS128 + k0 * 2, tmp);
#pragma unroll
      for (int i = 0; i < 16; ++i) tmp[i] = kk[i] * ex2(fminf(rf[i] - bb[i], 86.f));
      st_row16(F.lds, HL_KD + t * RS128 + k0 * 2, tmp);
#pragma unroll
      for (int i = 0; i < 16; ++i) tmp[i] = qv[i] * ex2(bb[i]);
      st_row16(F.lds, HL_QE + t * RS128 + k0 * 2, tmp);
#pragma unroll
      for (int i = 0; i < 16; i += 4) { const f32x4 r4 = *(const LAS f32x4*)(REF + 1 * 128 + k0 + i); rf[i] = r4.x; rf[i + 1] = r4.y; rf[i + 2] = r4.z; rf[i + 3] = r4.w; }
      if (wave >= 4) {
#pragma unroll
          for (int i = 0; i < 16; ++i) tmp[i] = qv[i] * ex2(bb[i] - rf[i]);
          st_row16(F.lds, HL_Q1 + (t & 31) * RS128 + k0 * 2, tmp);
      } else {
#pragma unroll
          for (int i = 0; i < 16; ++i) tmp[i] = kk[i] * ex2(rf[i] - bb[i]);
          st_row16(F.lds, HL_K1 + (t & 31) * RS128 + k0 * 2, tmp);
      }
#pragma unroll
      for (int i = 0; i < 16; i += 4) { const f32x4 r4 = *(const LAS f32x4*)(REF + ((wave >= 4) ? 2 : 0) * 128 + k0 + i); rf[i] = r4.x; rf[i + 1] = r4.y; rf[i + 2] = r4.z; rf[i + 3] = r4.w; }
      if (wave & 2) {
#pragma unroll
          for (int i = 0; i < 16; ++i) tmp[i] = qv[i] * ex2(bb[i] - rf[i]);
          st_row16(F.lds, HL_Q2 + ((t & 15) + ((wave >= 4) ? 16 : 0)) * RS128 + k0 * 2, tmp);
      } else {
#pragma unroll
          for (int i = 0; i < 16; ++i) tmp[i] = kk[i] * ex2(rf[i] - bb[i]);
          st_row16(F.lds, HL_K2 + ((t & 15) + ((wave >= 4) ? 16 : 0)) * RS128 + k0 * 2, tmp);
      }
      for (int i = tid; i < 64 * RS64 / 16; i += NTHR) *(LAS u32x4*)(F.lds + HL_SC + i * 16) = (u32x4){0u, 0u, 0u, 0u};
    }
    __syncthreads();
    if (STOP == 2) { asm volatile("" :: "v"(sf[0]), "v"(gwv[0]), "v"(gain)); return; }
    for (int blk = wave; blk < 10; blk += 8) {
        int ko, qo, J, I; bool diag = false;
        if (blk < 4) { ko = HL_KD + blk * 16 * RS128; qo = HL_QD + blk * 16 * RS128; J = blk; I = blk; diag = true; }
        else if (blk == 4) { ko = HL_K2; qo = HL_Q2; J = 0; I = 1; }
        else if (blk == 5) { ko = HL_K2 + 16 * RS128; qo = HL_Q2 + 16 * RS128; J = 2; I = 3; }
        else { const int jj = (blk - 6) >> 1, ii = (blk - 6) & 1; ko = HL_K1 + jj * 16 * RS128; qo = HL_Q1 + ii * 16 * RS128; J = jj; I = 2 + ii; }
        f32x4 acc = {0.f, 0.f, 0.f, 0.f};
#pragma unroll
        for (int ks = 0; ks < 4; ++ks) { const bf16x8 af = *(const LAS bf16x8*)(F.lds + ko + fr * RS128 + (32 * ks + 8 * g) * 2), bf = *(const LAS bf16x8*)(F.lds + qo + fr * RS128 + (32 * ks + 8 * g) * 2);
            acc = __builtin_amdgcn_mfma_f32_16x16x32_bf16(af, bf, acc, 0, 0, 0); }
        if (diag) {
#pragma unroll
            for (int rg = 0; rg < 4; ++rg) if (4 * g + rg > fr) acc[rg] = 0.f; }
        u32x2 w; w.x = cvt_pk_bf16(acc[0], acc[1]); w.y = cvt_pk_bf16(acc[2], acc[3]);
        *(LAS u32x2*)(F.lds + HL_SC + (16 * I + fr) * RS64 + (16 * J + 4 * g) * 2) = w;
    }
    __syncthreads();
    if (STOP == 3) { asm volatile("" :: "v"(sf[0]), "v"(gwv[0]), "v"(gain)); return; }
    f32x4 o[4];
#pragma unroll
    for (int I = 0; I < 4; ++I) o[I] = (f32x4){0.f, 0.f, 0.f, 0.f};
    { bf16x8 af[2];
#pragma unroll
      for (int ks = 0; ks < 2; ++ks) af[ks] = *(const LAS bf16x8*)(F.lds + HL_VT + (wave * 16 + fr) * RS64 + (32 * ks + 8 * g) * 2);
#pragma unroll
      for (int I = 0; I < 4; ++I)
#pragma unroll
          for (int ks = 0; ks < 2; ++ks) { const bf16x8 bf = *(const LAS bf16x8*)(F.lds + HL_SC + (16 * I + fr) * RS64 + (32 * ks + 8 * g) * 2); o[I] = __builtin_amdgcn_mfma_f32_16x16x32_bf16(af[ks], bf, o[I], 0, 0, 0); }
#pragma unroll
      for (int I = 0; I < 4; ++I)
#pragma unroll
          for (int ks = 0; ks < 4; ++ks) { const bf16x8 bf = *(const LAS bf16x8*)(F.lds + HL_QE + (16 * I + fr) * RS128 + (32 * ks + 8 * g) * 2); o[I] = __builtin_amdgcn_mfma_f32_16x16x32_bf16(sf[ks], bf, o[I], 0, 0, 0); }
    }
    if (STOP == 4) { asm volatile("" :: "v"(o[0]), "v"(o[1]), "v"(o[2]), "v"(o[3]), "v"(gwv[0]), "v"(gain)); return; }
    LAS float* RED = (LAS float*)(F.lds + HL_RED);
#pragma unroll
    for (int I = 0; I < 4; ++I) { float q = (o[I][0] * o[I][0] + o[I][1] * o[I][1]) + (o[I][2] * o[I][2] + o[I][3] * o[I][3]); q += __shfl_xor(q, 16); q += __shfl_xor(q, 32); if (g == 0) RED[wave * 64 + 16 * I + fr] = q; }
    __syncthreads();
    { bf16_t* Y = (bf16_t*)(ws + WS_XB);
#pragma unroll
      for (int I = 0; I < 4; ++I) { const int tt = 16 * I + fr; float ssq = 0.f;
#pragma unroll
          for (int w = 0; w < 8; ++w) ssq += RED[w * 64 + tt];
          const float rs = __builtin_amdgcn_rsqf(ssq * (1.f / 128.f) + EPS);
          const u32x2 gw = gwv[I];
          const float g0 = bflo(gw.x), g1 = bfhi(gw.x), g2 = bflo(gw.y), g3 = bfhi(gw.y);
          u32x2 w; w.x = cvt_pk_bf16(o[I][0] * rs * gain.x * (g0 * sigmoidf_(g0)), o[I][1] * rs * gain.y * (g1 * sigmoidf_(g1)));
          w.y = cvt_pk_bf16(o[I][2] * rs * gain.z * (g2 * sigmoidf_(g2)), o[I][3] * rs * gain.w * (g3 * sigmoidf_(g3)));
          *(GAS u32x2*)(Y + (size_t)(row0 + tt) * DM + h * 128 + wave * 16 + 4 * g) = w; } }
    __syncthreads();
}

__device__ __forceinline__ void hg_scan(Frame& F) {
    unsigned char* ws = F.ws;
    for (int gid = F.vcu * NTHR + F.tid; gid < BATCH * HGH * 16384; gid += F.G * NTHR) {
        const int bh = gid >> 14, e = gid & 16383, k = e & 127;
        bf16_t* st = (bf16_t*)(ws + A_STATE) + (size_t)bh * NCHUNK * 16384 + e; const float* dc = (const float*)(ws + A_DECAY) + (size_t)bh * NCHUNK * 128 + k;
        float S = 0.f;
        for (int c0 = 0; c0 < NCHUNK; c0 += 8) { float kv[8], d[8];
#pragma unroll
            for (int i = 0; i < 8; ++i) { kv[i] = bf2f(st[(size_t)(c0 + i) * 16384]); d[i] = dc[(c0 + i) * 128]; }
#pragma unroll
            for (int i = 0; i < 8; ++i) { st[(size_t)(c0 + i) * 16384] = (bf16_t)f2bf(S); S = d[i] * S + kv[i]; } }
    }
}


typedef float f32x16 __attribute__((ext_vector_type(16)));
template <int D, int PAT>
__device__ __forceinline__ void att_pattern(Frame& F, int b, int h, int s_base, const bf16_t* QR, const bf16_t* KF, const bf16_t* VF) {
    const int lane = F.lane, wave = F.wave, r32 = lane & 31, hi = lane >> 5;
    LAS float* ACC = (LAS float*)F.lds; LAS f32x2* ML = (LAS f32x2*)(F.lds + 133120);
    constexpr int TPC = 16 / D, NT = SEQ / D / 32;
    const size_t bh = (size_t)(b * ATH + h) * (SEQ * 64);
    for (int jj = 0; jj < 2; ++jj) {
        const int j = wave + 8 * jj, r = j / TPC, tile = j % TPC, p0 = s_base / D + tile * 32;
        const size_t qrow = (size_t)b * SEQ + (size_t)(p0 + r32) * D + r;
        bf16x8 qf[4];
#pragma unroll
        for (int kk = 0; kk < 4; ++kk) qf[kk] = *(const GAS bf16x8*)(QR + qrow * 512 + h * 64 + 16 * kk + 8 * hi);
        bf16x8 kf[5][4];
#pragma unroll
        for (int kt = 0; kt < 5; ++kt) { const int kb = p0 - 128 + 32 * kt, kbc = kb < 0 ? 0 : kb;
            const bf16_t* kp = KF + bh + ((size_t)(r * NT + (kbc >> 5)) * 4) * 512 + lane * 8;
#pragma unroll
            for (int kk = 0; kk < 4; ++kk) kf[kt][kk] = *(const GAS bf16x8*)(kp + kk * 512); }
        f32x16 sc[5];
#pragma unroll
        for (int kt = 0; kt < 5; ++kt) {
            f32x16 acc = {};
#pragma unroll
            for (int kk = 0; kk < 4; ++kk) acc = __builtin_amdgcn_mfma_f32_32x32x16_bf16(kf[kt][kk], qf[kk], acc, 0, 0, 0);
            sc[kt] = acc;
        }
        bf16x8 vfr[5][2][2];
#pragma unroll
        for (int kt = 0; kt < 5; ++kt) { const int kb = p0 - 128 + 32 * kt, kbc = kb < 0 ? 0 : kb;
#pragma unroll
            for (int s = 0; s < 2; ++s)
#pragma unroll
                for (int mt = 0; mt < 2; ++mt) vfr[kt][s][mt] = *(const GAS bf16x8*)(VF + bh + ((size_t)(r * NT + (kbc >> 5)) * 4 + s * 2 + mt) * 512 + lane * 8); }
#pragma unroll
        for (int kt = 0; kt < 5; ++kt) { const bool dead = (p0 - 128 + 32 * kt) < 0;
#pragma unroll
            for (int rg = 0; rg < 16; ++rg) { const int kap = 16 * (rg >> 3) + 8 * hi + (rg & 7);
                bool bad = dead; if (kt == 0) bad = bad || (kap < r32); if (kt == 4) bad = bad || (kap > r32);
                if (bad) sc[kt][rg] = -1.0e30f; } }
        float m = -1.0e30f;
#pragma unroll
        for (int kt = 0; kt < 5; ++kt)
#pragma unroll
            for (int rg = 0; rg < 16; ++rg) m = fmaxf(m, sc[kt][rg]);
        m = fmaxf(m, __shfl_xor(m, 32));
        float lsum = 0.f;
#pragma unroll
        for (int kt = 0; kt < 5; ++kt)
#pragma unroll
            for (int rg = 0; rg < 16; ++rg) { const float p = __expf(sc[kt][rg] - m); sc[kt][rg] = p; lsum += p; }
        lsum += __shfl_xor(lsum, 32);
        f32x16 o[2] = {{}, {}};
#pragma unroll
        for (int kt = 0; kt < 5; ++kt) {
#pragma unroll
            for (int s = 0; s < 2; ++s) {
                u32x4 pw; pw.x = cvt_pk_bf16(sc[kt][8 * s + 0], sc[kt][8 * s + 1]); pw.y = cvt_pk_bf16(sc[kt][8 * s + 2], sc[kt][8 * s + 3]);
                pw.z = cvt_pk_bf16(sc[kt][8 * s + 4], sc[kt][8 * s + 5]); pw.w = cvt_pk_bf16(sc[kt][8 * s + 6], sc[kt][8 * s + 7]);
                const bf16x8 pf = __builtin_bit_cast(bf16x8, pw);
#pragma unroll
                for (int mt = 0; mt < 2; ++mt) o[mt] = __builtin_amdgcn_mfma_f32_32x32x16_bf16(vfr[kt][s][mt], pf, o[mt], 0, 0, 0);
            }
        }
        const int tau = (p0 + r32) * D + r - s_base;
        LAS float* arow = ACC + tau * 65;
        if (PAT == 0) {
#pragma unroll
            for (int mt = 0; mt < 2; ++mt)
#pragma unroll
                for (int rg = 0; rg < 16; ++rg) arow[(rg & 3) + 8 * (rg >> 2) + 4 * hi + 32 * mt] = o[mt][rg];
            if (hi == 0) ML[tau] = (f32x2){m, lsum};
        } else {
            const f32x2 ml = ML[tau];
            const float M = fmaxf(ml.x, m), fo = __expf(ml.x - M), fn = __expf(m - M), lt = ml.y * fo + lsum * fn;
            if (PAT == 1) {
#pragma unroll
                for (int mt = 0; mt < 2; ++mt)
#pragma unroll
                    for (int rg = 0; rg < 16; ++rg) { LAS float* p = arow + (rg & 3) + 8 * (rg >> 2) + 4 * hi + 32 * mt; *p = *p * fo + o[mt][rg] * fn; }
                if (hi == 0) ML[tau] = (f32x2){M, lt};
            } else {
                const float inv = 1.f / lt;
                bf16_t* yrow = (bf16_t*)(F.ws + WS_XB) + ((size_t)b * SEQ + s_base + tau) * DM + 512 + h * 64;
#pragma unroll
                for (int mt = 0; mt < 2; ++mt)
#pragma unroll
                    for (int g = 0; g < 4; ++g) { float v[4];
#pragma unroll
                        for (int e = 0; e < 4; ++e) v[e] = (arow[e + 8 * g + 4 * hi + 32 * mt] * fo + o[mt][4 * g + e] * fn) * inv;
                        u32x2 w; w.x = cvt_pk_bf16(v[0], v[1]); w.y = cvt_pk_bf16(v[2], v[3]);
                        *(GAS u32x2*)(yrow + 8 * g + 4 * hi + 32 * mt) = w; }
            }
        }
    }
}
__device__ __forceinline__ void att_unit(Frame& F, int unit) {
    const int tb = unit >> 3, h = unit & 7, b = tb >> 4, s_base = (tb & 15) * 512;
    const bf16_t* QR = (const bf16_t*)(F.ws + A_QR);
    att_pattern<1, 0>(F, b, h, s_base, QR, (const bf16_t*)(F.ws + A_KF1), (const bf16_t*)(F.ws + A_VT1));
    __syncthreads();
    att_pattern<4, 1>(F, b, h, s_base, QR, (const bf16_t*)(F.ws + A_KF4), (const bf16_t*)(F.ws + A_VT4));
    __syncthreads();
    att_pattern<16, 2>(F, b, h, s_base, QR, (const bf16_t*)(F.ws + A_KF16), (const bf16_t*)(F.ws + A_VT16));
    __syncthreads();
}

__device__ __forceinline__ void ph_norm(Frame& F, const Args& a) {
    const int gw = F.vcu * NWAVES + F.wave, NGW = F.G * NWAVES;
    for (int r = gw; r < MT; r += NGW) { const float rs = row_norm_prep(F.out + (size_t)r * DM, (bf16_t*)(F.ws + WS_XB) + (size_t)r * DM, nullptr, F.lane); if (F.lane == 0) ((float*)(F.ws + WS_RSTD))[r] = rs; }
}

__device__ __forceinline__ void ph_router(Frame& F, const Args& a, int l) {
    unsigned char* ws = F.ws; const int lane = F.lane;
    const int gw = F.vcu * NWAVES + F.wave, NGW = F.G * NWAVES;
    { LAS float* scr = (LAS float*)(F.lds + F.wave * 16384);
      for (int it = gw; it < 3 * 4096; it += NGW) { const int ty = it >> 12, e = (it >> 8) & 15, r = it & 255;
          if (ty == 0) transpose_mat_item(IN_F(16) + ((size_t)l * NEXP + e) * DM * EFF, DM, EFF, IN_F(13) + l * DM, (bf16_t*)(ws + A_WGU) + (size_t)e * DM * DM, 1, r, scr, lane);
          else if (ty == 1) transpose_mat_item(IN_F(17) + ((size_t)l * NEXP + e) * DM * EFF, DM, EFF, IN_F(13) + l * DM, (bf16_t*)(ws + A_WGU) + (size_t)e * DM * DM, 2, r, scr, lane);
          else transpose_mat_item(IN_F(18) + ((size_t)l * NEXP + e) * EFF * DM, EFF, DM, nullptr, (bf16_t*)(ws + A_WD) + (size_t)e * DM * EFF, 0, r, scr, lane); } }
    __syncthreads();
    LAS float* WRl = (LAS float*)F.lds;
    { const float* src = (const float*)(ws + WS_WR) + (size_t)l * DM * 20; for (int i = F.tid; i < DM * 20; i += NTHR) WRl[(i % 20) * DM + i / 20] = src[i]; }
    __syncthreads();
    unsigned* cnt = (unsigned*)(F.ctl + CW_CNT + l * 16 * 64);
    for (int r = gw; r < MT; r += NGW) {
        const GAS f32x4* xr = (const GAS f32x4*)(F.out + (size_t)r * DM) + lane;
        f32x4 v[4]; float s = 0.f;
#pragma unroll
        for (int j = 0; j < 4; ++j) { v[j] = xr[64 * j]; s += (v[j].x * v[j].x + v[j].y * v[j].y) + (v[j].z * v[j].z + v[j].w * v[j].w); }
        const float rstd = 1.f / sqrtf(wave_sum(s) * (1.f / DM) + EPS);
        GAS u32x2* o8 = (GAS u32x2*)((bf16_t*)(ws + WS_XB) + (size_t)r * DM) + lane;
#pragma unroll
        for (int j = 0; j < 4; ++j) { u32x2 w; w.x = pk2(v[j].x, v[j].y); w.y = pk2(v[j].z, v[j].w); o8[64 * j] = w; }
        float lg[20];
#pragma unroll
        for (int q = 0; q < 20; ++q) lg[q] = 0.f;
#pragma unroll
        for (int j = 0; j < 4; ++j) {
#pragma unroll
            for (int q = 0; q < 20; ++q) { const f32x4 w = *(const LAS f32x4*)(WRl + q * DM + 256 * j + 4 * lane); lg[q] += (v[j].x * w.x + v[j].y * w.y) + (v[j].z * w.z + v[j].w * w.w); }
            asm volatile("" ::: "memory"); }
#pragma unroll
        for (int q = 0; q < 20; ++q) lg[q] = wave_sum(lg[q]) * rstd;
        if (lane == 0) {
            ((float*)(ws + WS_RSTD))[r] = rstd;
            int gs = 0; float gm = lg[0];
#pragma unroll
            for (int q = 1; q < 4; ++q) if (lg[q] > gm) { gm = lg[q]; gs = q; }
            float den = 0.f;
#pragma unroll
            for (int q = 0; q < 4; ++q) den += __expf(lg[q] - gm);
            const float gwt = 1.f / den;
            float e4[4];
#pragma unroll
            for (int q = 0; q < 4; ++q) e4[q] = gs == 0 ? lg[4 + q] : (gs == 1 ? lg[8 + q] : (gs == 2 ? lg[12 + q] : lg[16 + q]));
            int i1 = 0; float v1 = e4[0];
#pragma unroll
            for (int q = 1; q < 4; ++q) if (e4[q] > v1) { v1 = e4[q]; i1 = q; }
            int i2 = -1; float v2 = -3.0e38f;
#pragma unroll
            for (int q = 0; q < 4; ++q) if (q != i1 && e4[q] > v2) { v2 = e4[q]; i2 = q; }
            const float ex = __expf(v2 - v1), w1 = 1.f / (1.f + ex), w2 = ex * w1;
            const int id1 = gs * 4 + i1, id2 = gs * 4 + i2;
            int* te = (int*)(ws + WS_TOKE) + 2 * r; float* tw = (float*)(ws + WS_TOKW) + 2 * r; int* tl = (int*)(ws + WS_TOKL) + 2 * r;
            te[0] = id1; te[1] = id2; tw[0] = w1 * gwt; tw[1] = w2 * gwt;
            tl[0] = (int)__hip_atomic_fetch_add(cnt + 64 * id1, 1u, RLX_AGENT); tl[1] = (int)__hip_atomic_fetch_add(cnt + 64 * id2, 1u, RLX_AGENT);
        }
    }
}

__device__ __forceinline__ void moe_prefix(Frame& F, int l) {
    if (F.tid == 0) { unsigned acc = 0; for (int e = 0; e < 16; ++e) { F.MISC[16 + e] = acc; const unsigned n = __hip_atomic_load((unsigned*)(F.ctl + CW_CNT + l * 16 * 64) + 64 * e, RLX_AGENT); acc += (n + 255u) >> 8; } F.MISC[32] = acc; }
    __syncthreads();
}

__device__ __forceinline__ void ph_scatter(Frame& F, const Args& a, int l) {
    unsigned char* ws = F.ws; const int lane = F.lane;
    moe_prefix(F, l);
    const int gw = F.vcu * NWAVES + F.wave, NGW = F.G * NWAVES;
    for (int p = gw; p < 2 * MT; p += NGW) {
        const int r = p >> 1; const int e = ((const int*)(ws + WS_TOKE))[p]; const int loc = ((const int*)(ws + WS_TOKL))[p];
        const int slot = (int)F.MISC[16 + e] * 256 + loc;
        const GAS u32x4* src = (const GAS u32x4*)((const bf16_t*)(ws + WS_XB) + (size_t)r * DM) + lane; GAS u32x4* dst = (GAS u32x4*)((bf16_t*)(ws + A_XS) + (size_t)slot * DM) + lane;
        dst[0] = src[0]; dst[64] = src[64];
        if (lane == 0) { ((float*)(ws + WS_SLOTRS))[slot] = ((const float*)(ws + WS_RSTD))[r]; ((float*)(ws + WS_SLOTGW))[slot] = ((const float*)(ws + WS_TOKW))[p]; }
        asm volatile("" ::: "memory");
        if (lane == 0) ((int*)(ws + WS_TOKL))[p] = slot;
    }
}

__device__ __forceinline__ void ph_combine(Frame& F, const Args& a, int l) {
    unsigned char* ws = F.ws; const int lane = F.lane;
    const int gw = F.vcu * NWAVES + F.wave, NGW = F.G * NWAVES;
    for (int r = gw; r < MT; r += NGW) {
        const int s0 = ((const int*)(ws + WS_TOKL))[2 * r], s1 = ((const int*)(ws + WS_TOKL))[2 * r + 1];
        GAS f32x4* xr = (GAS f32x4*)(F.out + (size_t)r * DM) + lane;
        const GAS u32x2* y0 = (const GAS u32x2*)((const bf16_t*)(ws + A_Y) + (size_t)s0 * DM) + lane; const GAS u32x2* y1 = (const GAS u32x2*)((const bf16_t*)(ws + A_Y) + (size_t)s1 * DM) + lane;
        f32x4 v[4]; float s = 0.f;
#pragma unroll
        for (int j = 0; j < 4; ++j) { const u32x2 p0 = y0[64 * j], p1 = y1[64 * j]; f32x4 x = xr[64 * j];
            x.x += bflo(p0.x) + bflo(p1.x); x.y += bfhi(p0.x) + bfhi(p1.x); x.z += bflo(p0.y) + bflo(p1.y); x.w += bfhi(p0.y) + bfhi(p1.y);
            v[j] = x; s += (x.x * x.x + x.y * x.y) + (x.z * x.z + x.w * x.w); }
        const float rstd = 1.f / sqrtf(wave_sum(s) * (1.f / DM) + EPS);
        if (l == DEPTH - 1) { const GAS f32x4* g = (const GAS f32x4*)IN_F(19) + lane;
#pragma unroll
            for (int j = 0; j < 4; ++j) xr[64 * j] = v[j] * rstd * g[64 * j];
        } else {
            GAS u32x2* o8 = (GAS u32x2*)((bf16_t*)(ws + WS_XB) + (size_t)r * DM) + lane;
#pragma unroll
            for (int j = 0; j < 4; ++j) { xr[64 * j] = v[j]; u32x2 w; w.x = pk2(v[j].x, v[j].y); w.y = pk2(v[j].z, v[j].w); o8[64 * j] = w; }
            if (lane == 0) ((float*)(ws + WS_RSTD))[r] = rstd;
        }
    }
}

constexpr int NPHASE = 3 + 13 * DEPTH + (PROBE_P >= 0 ? PROBE_N - 1 : 0);
__global__ void __launch_bounds__(NTHR, 2) fwd(Args a) {
    extern __shared__ __attribute__((aligned(16))) unsigned char lds_raw[];
    Frame F;
    F.lds = (LAS unsigned char*)lds_raw; F.MISC = (volatile LAS unsigned*)(F.lds + MISC_OFF);
    F.tid = threadIdx.x; F.lane = F.tid & 63; F.wave = __builtin_amdgcn_readfirstlane(F.tid >> 6);
    F.G = gridDim.x; { const int bx = blockIdx.x; F.vcu = (F.G % 8 == 0) ? (bx % 8) * (F.G / 8) + bx / 8 : bx; }
    F.ws = a.ws; F.ctl = (gu32*)(a.ws + WS_CTL); F.out = a.out; F.z = 0;
    for (int u = F.tid; u < (LDS_BYTES - LDSCTL_OFF) / 4; u += NTHR) ((LAS unsigned*)(F.lds + LDSCTL_OFF))[u] = 0u;
    __syncthreads();
    XcdBarrier bar; bar.bar = (unsigned*)(F.ctl + CW_BAR); bar.x = 0; bar.st = nullptr;
    const bool one_launch = (a.ph_hi - a.ph_lo) > 1;
    if (one_launch) bar = xcd_barrier_post((unsigned*)(F.ctl + CW_BAR), F.MISC + 8);
    for (int pp = a.ph_lo; pp < a.ph_hi; ++pp) {
        int ph = pp;
        if (PROBE_P >= 0) { constexpr int P = PROBE_P; if (pp > P) ph = (pp - (PROBE_N - 1) > P) ? pp - (PROBE_N - 1) : P; }
        { int t_ = threadIdx.x; asm volatile("" : "+v"(t_)); F.tid = t_; F.lane = t_ & 63; F.wave = __builtin_amdgcn_readfirstlane(t_ >> 6); }
        size_t z_ = 0; asm volatile("" : "+s"(z_)); F.z = z_; F.ws = a.ws + z_; F.out = (float*)((char*)a.out + z_); F.ctl = (gu32*)(a.ws + z_ + WS_CTL);
        unsigned char* ws = F.ws; int bx = (int)blockIdx.x; asm volatile("" : "+s"(bx));
        if (ph == 0) { if (PHSEL(0)) ph_init(F, a); }
        else if (ph == 1) { if (PHSEL(1)) {
            SchedKV S{F.G, bx, (const char*)(ws + WS_MEMN), (const char*)(ws + WS_WKVT)};
            EpiKV E{(bf16_t*)(ws + WS_KV), (bf16_t*)(ws + WS_KV) + (size_t)DEPTH * MEMROWS * DM};
            pg8::gemm_phase<EpiKV, SchedKV, true, true, DM, DM>(F.lds, F.tid, S, E); }
        } else if (ph == 2) { if (PHSEL(2)) {
            SchedFold S{F.G, bx, (const char*)(ws + WS_KV), (const char*)(ws + WS_KV) + (size_t)DEPTH * MEMROWS * DM * 2, (const char*)(ws + WS_WQS), (const char*)(ws + WS_WOT)};
            EpiBf16 E{(bf16_t*)(ws + WS_WQK), DM, (size_t)DM * DM, 1.f};
            pg8::gemm_phase<EpiBf16, SchedFold, true, true, DM, 256>(F.lds, F.tid, S, E); }
        } else {
            const int l = (ph - 3) / 13, q = (ph - 3) % 13;
            if (q == 0 && PHSEL(3)) {
                pg8::SchedDense S{64, 14, 896, F.G, bx, (const char*)(ws + WS_XB), (const char*)(ws + WS_WIN) + (size_t)l * NIN * DM * 2, (size_t)256 * DM * 2, (size_t)256 * DM * 2, 64, 0};
                EpiProj E{(bf16_t*)(ws + A_HG), (bf16_t*)(ws + A_QR), (bf16_t*)(ws + A_KF1), (bf16_t*)(ws + A_V), (const float*)(ws + WS_RSTD), (const f32x2*)(ws + WS_CS)};
                pg8::gemm_phase<EpiProj, pg8::SchedDense, true, true, DM, DM>(F.lds, F.tid, S, E);
            } else if (q == 1 && PHSEL(4)) {
                for (int rep = 0; rep < PROBE_PREP_N; ++rep) for (int u = F.vcu; u < (MT / 512) * ATH; u += F.G) vf_unit(F, u);
                for (int rep = 0; rep < PROBE_HGA_N; ++rep) { constexpr int NU = BATCH * HGH * NCHUNK; HgIn R = hg_load<false>(F, F.vcu < NU ? F.vcu : NU - 1);
                    for (int u = F.vcu; u < NU; u += F.G) { const HgIn Rn = hg_load<false>(F, u + F.G < NU ? u + F.G : NU - 1); hg_a2_unit(F, a, l, u, R); R = Rn; } }
            } else if (q == 2 && PHSEL(5)) hg_scan(F);
            else if (q == 3 && PHSEL(6)) {
                for (int rep = 0; rep < PROBE_HGC_N; ++rep) { constexpr int NU = BATCH * HGH * NCHUNK; HgIn R = hg_load<true>(F, F.vcu < NU ? F.vcu : NU - 1);
                    for (int u = F.vcu; u < NU; u += F.G) { const HgIn Rn = hg_load<true>(F, u + F.G < NU ? u + F.G : NU - 1); if (rep + 1 < PROBE_HGC_N) hg_c2_unit<PROBE_HGC_STOP>(F, a, l, u, R); else hg_c2_unit<0>(F, a, l, u, R); R = Rn; } }
#if ATT_GOLDEN
                for (int t = F.vcu * NWAVES + F.wave; t < (MT / 64) * ATH; t += F.G * NWAVES) att_task(F, t);
#else
                for (int rep = 0; rep < PROBE_ATT_N; ++rep) for (int u = F.vcu; u < (MT / 512) * ATH; u += F.G) att_unit(F, u);
#endif
            } else if (q == 4 && PHSEL(7)) {
                pg8::SchedDense S{64, 4, 256, F.G, bx, (const char*)(ws + WS_XB), (const char*)(ws + WS_WOUT) + (size_t)l * DM * DM * 2, (size_t)256 * DM * 2, (size_t)256 * DM * 2, 64, 0};
                EpiResAdd E{F.out};
                pg8::gemm_phase<EpiResAdd, pg8::SchedDense, true, true, DM, DM>(F.lds, F.tid, S, E);
            } else if (q == 5 && PHSEL(8)) ph_norm(F, a);
            else if (q == 6 && PHSEL(9)) {
                pg8::SchedDense S{64, 4, 256, F.G, bx, (const char*)(ws + WS_XB), (const char*)(ws + WS_WQK) + (size_t)l * 2 * DM * DM * 2, (size_t)256 * DM * 2, (size_t)256 * DM * 2, 32, (size_t)DM * DM * 2};
                EpiSoftmax E{(bf16_t*)(ws + A_P), (const float*)(ws + WS_RSTD)};
                pg8::gemm_phase<EpiSoftmax, pg8::SchedDense, true, true, DM, DM>(F.lds, F.tid, S, E);
            } else if (q == 7 && PHSEL(10)) {
                pg8::SchedDense S{64, 4, 256, F.G, bx, (const char*)(ws + A_P), (const char*)(ws + WS_WVO) + (size_t)l * 2 * DM * DM * 2, (size_t)256 * DM * 2, (size_t)256 * DM * 2, 32, (size_t)DM * DM * 2};
                EpiResAdd E{F.out};
                pg8::gemm_phase<EpiResAdd, pg8::SchedDense, true, true, DM, DM>(F.lds, F.tid, S, E);
            } else if (q == 8 && PHSEL(11)) ph_router(F, a, l);
            else if (q == 9 && PHSEL(12)) ph_scatter(F, a, l);
            else if (q == 10 && PHSEL(13)) {
                moe_prefix(F, l);
                SchedMoe S{F.G, bx, DM, F.MISC + 16, (const char*)(ws + A_XS), (const char*)(ws + A_WGU)};
                EpiMoe1 E{(bf16_t*)(ws + A_ACTB), (const float*)(ws + WS_SLOTRS), (const float*)(ws + WS_SLOTGW)};
                pg8::gemm_phase<EpiMoe1, SchedMoe, true, true, DM, DM>(F.lds, F.tid, S, E);
            } else if (q == 11 && PHSEL(14)) {
                moe_prefix(F, l);
                SchedMoe S{F.G, bx, EFF, F.MISC + 16, (const char*)(ws + A_ACTB), (const char*)(ws + A_WD)};
                EpiBf16 E{(bf16_t*)(ws + A_Y), DM, 0, 1.f};
                pg8::gemm_phase<EpiBf16, SchedMoe, true, true, EFF, EFF>(F.lds, F.tid, S, E);
            } else if (q == 12 && PHSEL(15)) ph_combine(F, a, l);
        }
        if (pp + 1 < a.ph_hi) xcd_barrier(bar);
    }
}

extern "C" void kernel_launch(void* const* d_in, const int* in_sizes, int n_in, void* d_out, int out_size, void* d_ws, size_t ws_size, hipStream_t stream) {
    static int grid = 0;
    if (grid == 0) {
        if (n_in != 20 || in_sizes[0] != MT * DM || out_size != MT * DM || ws_size < WS_END) { fprintf(stderr, "kernel_launch: unexpected shapes / workspace (%d inputs, ws %zu)\n", n_in, ws_size); grid = -1; return; }
        int dev = 0, cus = 0, per_cu = 0;
        if (hipGetDevice(&dev) != hipSuccess || hipDeviceGetAttribute(&cus, hipDeviceAttributeMultiprocessorCount, dev) != hipSuccess) { grid = -1; return; }
        if (hipFuncSetAttribute((const void*)fwd, hipFuncAttributeMaxDynamicSharedMemorySize, LDS_BYTES) != hipSuccess) { grid = -1; return; }
        if (hipOccupancyMaxActiveBlocksPerMultiprocessor(&per_cu, (const void*)fwd, NTHR, LDS_BYTES) != hipSuccess || per_cu < 1) { fprintf(stderr, "kernel_launch: occupancy query says %d\n", per_cu); per_cu = 1; }
        (void)hipGetLastError();
        grid = cus * 1;
    }
    if (grid < 0) return;
    (void)hipMemsetAsync((char*)d_ws + WS_CTL, 0, CTL_ZERO_BYTES, stream);
    Args a{};
    for (int i = 0; i < 20; ++i) a.in[i] = d_in[i];
    a.out = (float*)d_out; a.ws = (unsigned char*)d_ws;
#if MK_PER_PHASE
    for (int ph = 0; ph < NPHASE; ++ph) { a.ph_lo = ph; a.ph_hi = ph + 1; hipLaunchKernelGGL(fwd, dim3(grid), dim3(NTHR), LDS_BYTES, stream, a); }
#else
    a.ph_lo = 0; a.ph_hi = NPHASE;
    void* kargs[] = {&a};
    hipError_t e = hipLaunchCooperativeKernel((const void*)fwd, dim3(grid), dim3(NTHR), kargs, LDS_BYTES, stream);
    if (e != hipSuccess) fprintf(stderr, "cooperative launch failed: %s (grid %d)\n", hipGetErrorString(e), grid);
#endif
}
```

```cpp
#include <hip/hip_runtime.h>
#include <cstdio>
#include <cstdint>

#ifndef PH_MASK
#define PH_MASK 0xFFFFFFFFu
#endif
#define PHSEL(n) ((PH_MASK >> (n)) & 1u)
#ifndef PROBE_ATT_N
#define PROBE_ATT_N 1
#endif
#ifndef PROBE_HGC_N
#define PROBE_HGC_N 1
#endif
#ifndef PROBE_HGA_N
#define PROBE_HGA_N 1
#endif
#ifndef PROBE_PREP_N
#define PROBE_PREP_N 1
#endif
#ifndef PROBE_HGC_STOP
#define PROBE_HGC_STOP 0
#endif
#ifndef PROBE_P
#define PROBE_P -1
#endif
#ifndef PROBE_N
#define PROBE_N 1
#endif
#ifndef HG_A_GOLDEN
#define HG_A_GOLDEN 0
#endif
#ifndef HG_C_GOLDEN
#define HG_C_GOLDEN 0
#endif
#ifndef ATT_GOLDEN
#define ATT_GOLDEN 0
#endif
#ifndef MK_PER_PHASE
#define MK_PER_PHASE 0
#endif

#define LAS __attribute__((address_space(3)))
#define GAS __attribute__((address_space(1)))
typedef unsigned short bf16_t;
typedef short bf16x8 __attribute__((ext_vector_type(8)));
typedef float f32x4 __attribute__((ext_vector_type(4)));
typedef float f32x2 __attribute__((ext_vector_type(2)));
typedef unsigned u32x4 __attribute__((ext_vector_type(4)));
typedef unsigned u32x2 __attribute__((ext_vector_type(2)));
typedef GAS unsigned gu32;

constexpr int BATCH = 2, SEQ = 8192, DM = 1024, MT = BATCH * SEQ, DEPTH = 2;
constexpr int MEM_LEN = 256, MEMROWS = BATCH * MEM_LEN;
constexpr int NIN = 3584, HGW = 512, HGH = 4, HGD = 128, CHUNK = 64, NCHUNK = SEQ / CHUNK;
constexpr int ATW = 512, ATH = 8, ATD = 64;
constexpr int NEXP = 16, EFF = 512;
constexpr float EPS = 1e-6f;
constexpr int NWAVES = 8, NTHR = 512;

constexpr size_t MiB = 1u << 20;
constexpr size_t WS_CTL = 0, CTL_ZERO_BYTES = 1 * MiB;
constexpr size_t WS_RSTD = 1 * MiB;
constexpr size_t WS_TOKE = WS_RSTD + 64 * 1024;
constexpr size_t WS_TOKW = WS_TOKE + 128 * 1024;
constexpr size_t WS_TOKL = WS_TOKW + 128 * 1024;
constexpr size_t WS_SLOTRS = WS_TOKL + 128 * 1024;
constexpr size_t WS_SLOTGW = WS_SLOTRS + 160 * 1024;
constexpr size_t WS_PERM = WS_SLOTGW + 160 * 1024;
constexpr size_t WS_WR = 3 * MiB;
constexpr size_t WS_LBT = 3 * MiB + 256 * 1024;
constexpr size_t WS_XB = 4 * MiB;
constexpr size_t WS_WIN = 36 * MiB;
constexpr size_t WS_WOUT = 50 * MiB;
constexpr size_t WS_WQS = 54 * MiB;
constexpr size_t WS_WKVT = 58 * MiB;
constexpr size_t WS_WOT = 66 * MiB;
constexpr size_t WS_MEMN = 70 * MiB;
constexpr size_t WS_KV = 72 * MiB;
constexpr size_t WS_WQK = 76 * MiB;
constexpr size_t WS_WVO = 84 * MiB;
constexpr size_t WS_ACT = 92 * MiB;
constexpr size_t WS_CS = 320 * MiB;
constexpr size_t WS_END = 324 * MiB;
constexpr size_t A_HG = WS_ACT + 0 * MiB;
constexpr size_t A_KF1 = WS_ACT + 64 * MiB;
constexpr size_t A_KF4 = WS_ACT + 80 * MiB;
constexpr size_t A_KF16 = WS_ACT + 96 * MiB;
constexpr size_t A_QR = WS_ACT + 112 * MiB;
constexpr size_t A_V = WS_ACT + 128 * MiB;
constexpr size_t A_VT1 = WS_ACT + 144 * MiB;
constexpr size_t A_VT4 = WS_ACT + 160 * MiB;
constexpr size_t A_VT16 = WS_ACT + 176 * MiB;
constexpr size_t A_STATE = WS_ACT + 192 * MiB;
constexpr size_t A_DECAY = WS_ACT + 224 * MiB;
constexpr size_t A_P = WS_ACT + 0 * MiB;
constexpr size_t A_WGU = WS_ACT + 0 * MiB;
constexpr size_t A_WD = WS_ACT + 32 * MiB;
constexpr size_t A_XS = WS_ACT + 48 * MiB;
constexpr size_t A_ACTB = WS_ACT + 120 * MiB;
constexpr size_t A_Y = WS_ACT + 156 * MiB;
constexpr int MAXSLOT = 2 * MT + NEXP * 256;
static_assert(A_Y + (size_t)MAXSLOT * 1024 * 2 <= WS_END, "ws map");
constexpr int CW_BAR = 4096;
constexpr int CW_KMAX = 12288;
constexpr int CW_CNT = 16384;
constexpr int RING_BYTES = 131072;
constexpr int SPARE_OFF = RING_BYTES;
constexpr int LDSCTL_OFF = RING_BYTES + 8192, MISC_OFF = LDSCTL_OFF + 64;
constexpr int LDS_BYTES = 147456;

#define RLX_AGENT __ATOMIC_RELAXED, __HIP_MEMORY_SCOPE_AGENT
#define LDS_WAIT() asm volatile("s_waitcnt lgkmcnt(0)" ::: "memory")
#define VM_WAIT() asm volatile("s_waitcnt vmcnt(0)" ::: "memory")

__device__ __forceinline__ unsigned f2bf(float f) { unsigned u = __builtin_bit_cast(unsigned, f); return (u + 0x7fffu + ((u >> 16) & 1u)) >> 16; }
__device__ __forceinline__ unsigned pk2(float lo, float hi) { return f2bf(lo) | (f2bf(hi) << 16); }
__device__ __forceinline__ float bf2f(unsigned short h) { return __builtin_bit_cast(float, (unsigned)h << 16); }
__device__ __forceinline__ float bflo(unsigned w) { return __builtin_bit_cast(float, w << 16); }
__device__ __forceinline__ float bfhi(unsigned w) { return __builtin_bit_cast(float, w & 0xffff0000u); }
typedef __bf16 bf16x2_t __attribute__((ext_vector_type(2)));
__device__ __forceinline__ unsigned cvt_pk_bf16(float lo, float hi) { f32x2 v = {lo, hi}; bf16x2_t b = __builtin_convertvector(v, bf16x2_t); return __builtin_bit_cast(unsigned, b); }
__device__ __forceinline__ float wave_sum(float v) {
#pragma unroll
    for (int o = 1; o < 64; o <<= 1) v += __shfl_xor(v, o);
    return v;
}
__device__ __forceinline__ float sigmoidf_(float z) { return __builtin_amdgcn_rcpf(1.f + __builtin_amdgcn_exp2f(-1.4426950408889634f * z)); }
__device__ __forceinline__ float ex2(float x) { return __builtin_amdgcn_exp2f(x); }
constexpr float LOG2E = 1.4426950408889634f;

#define XB_TMO      128
#define XB_XCNT(j)  (256  + 64 * (j))
#define XB_XSUB(j)  (1280 + 64 * (j))
#define XB_XGEN(j)  (2304 + 64 * (j))
#define XB_TOP      3328
#define XB_TOPGEN   3392
#define XCD_BAR_WORDS 3456
#define XB_SPIN_CAP (1u << 18)
__device__ __forceinline__ unsigned xb_ld(unsigned* p)              { return __hip_atomic_load(p, __ATOMIC_RELAXED, __HIP_MEMORY_SCOPE_AGENT); }
__device__ __forceinline__ unsigned xb_add(unsigned* p, unsigned v) { return __hip_atomic_fetch_add(p, v, __ATOMIC_RELAXED, __HIP_MEMORY_SCOPE_AGENT); }
__device__ __forceinline__ unsigned xb_xcc_id() { return (unsigned)__builtin_amdgcn_s_getreg((3 << 11) | 20) & 0xFu; }
#define XB_SPIN(cond, bar) do { unsigned _sp = 0; while (cond) { __builtin_amdgcn_s_sleep(1); \
    if ((++_sp & 255u) == 0u) { if (xb_ld(&(bar)[XB_TMO])) break; if (_sp > XB_SPIN_CAP) { atomicAdd(&(bar)[XB_TMO], 1u); break; } } } } while (0)
struct XcdBarrier { unsigned* bar; unsigned x; volatile LAS unsigned* st; };
__device__ __forceinline__ XcdBarrier xcd_barrier_post(unsigned* bar, volatile LAS unsigned* st) {
    XcdBarrier b; b.bar = bar; b.x = xb_xcc_id(); b.st = st;
    if (threadIdx.x == 0) (void)xb_add(&bar[XB_XCNT(b.x)], 1u);
    return b;
}
__device__ __forceinline__ void xcd_barrier_complete(unsigned* bar, unsigned x, unsigned& nloc, unsigned& nx) {
    const unsigned G = gridDim.x * gridDim.y * gridDim.z;
    unsigned sum, cnt, mine, sp = 0u;
    for (;;) {
        sum = 0u; cnt = 0u; mine = 0u;
#pragma unroll
        for (unsigned j = 0; j < 16; ++j) { const unsigned c = xb_ld(&bar[XB_XCNT(j)]); sum += c; cnt += (c > 0u) ? 1u : 0u; mine = (j == x) ? c : mine; }
        if (sum == G) break;
        __builtin_amdgcn_s_sleep(1);
        if ((++sp & 255u) == 0u) { if (xb_ld(&bar[XB_TMO])) break; if (sp > XB_SPIN_CAP) { atomicAdd(&bar[XB_TMO], 1u); break; } }
    }
    nloc = mine > 0u ? mine : 1u; nx = cnt > 0u ? cnt : 1u;
}
__device__ __forceinline__ void xcd_barrier(const XcdBarrier& b) {
    asm volatile("s_waitcnt vmcnt(0)" ::: "memory");
    __syncthreads();
    if (threadIdx.x == 0) {
        unsigned* bar = b.bar;
        __builtin_amdgcn_s_waitcnt(0);
        unsigned nloc = b.st[0], nx = b.st[1];
        if (nloc == 0u) { xcd_barrier_complete(bar, b.x, nloc, nx); b.st[0] = nloc; b.st[1] = nx; }
        const unsigned old = xb_add(&bar[XB_XSUB(b.x)], 1u);
        const unsigned gen = old / nloc;
        if (old + 1u == (gen + 1u) * nloc) {
            __builtin_amdgcn_fence(__ATOMIC_RELEASE, "agent");
            asm volatile("s_waitcnt vmcnt(0)" ::: "memory");
            const unsigned og = xb_add(&bar[XB_TOP], 1u);
            const unsigned tg = og / nx;
            if (og + 1u == (tg + 1u) * nx) xb_add(&bar[XB_TOPGEN], 1u);
            else XB_SPIN(xb_ld(&bar[XB_TOPGEN]) == tg, bar);
            __builtin_amdgcn_fence(__ATOMIC_ACQUIRE, "agent");
            xb_add(&bar[XB_XGEN(b.x)], 1u);
            asm volatile("s_waitcnt vmcnt(0)" ::: "memory");
        } else {
            XB_SPIN(xb_ld(&bar[XB_XGEN(b.x)]) == gen, bar);
            __builtin_amdgcn_fence(__ATOMIC_ACQUIRE, "agent");
            asm volatile("s_waitcnt vmcnt(0)" ::: "memory");
        }
    }
    __syncthreads();
}

namespace pg8 {
constexpr int BM = 256, BK = 64, HALF = 128, HTB = HALF * BK * 2, STAGE_BYTES = 8 * HTB, NXCD = 8, WGM = 8;
__host__ __device__ __forceinline__ int lds_byte(int r, int c) { const int st = (r >> 4) * 2 + (c >> 5), rr = r & 15, cc = c & 31, ob = rr * 64 + cc * 2; return st * 1024 + (ob ^ (((ob >> 9) & 1) << 5)); }
__host__ __device__ __forceinline__ void stage_rc(int b, int& R, int& C) { const int st = b / 1024, sb = b % 1024, swz = sb ^ (((sb >> 9) & 1) << 5); R = (st >> 1) * 16 + swz / 64; C = (st & 1) * 32 + (swz % 64) / 2; }
__host__ __device__ __forceinline__ int perm32(int rho) { const int n = rho >> 4, i = rho & 15; return 8 * (i >> 2) + 4 * n + (i & 3); }

struct Unit { int pm, pn, aux; const char* a; const char* b; };
typedef f32x4 Acc[2][2][4][2];

template <class Epi, class Sched, bool ALIGN_EPI, bool SP2, int LD, int K, bool GATHER = false>
__device__ __forceinline__ void gemm_phase(LAS unsigned char* lds, const int tid, const Sched& S, const Epi& E) {
    constexpr int lda = LD, ldb = LD;
    const int wid = __builtin_amdgcn_readfirstlane(tid >> 6), lane = tid & 63, wr = wid >> 2, wc = wid & 3, fr = lane & 15, fq = lane >> 4;
    constexpr int nt = K / BK;
    unsigned voffA[2], voffB[2];
#pragma unroll
    for (int i = 0; i < 2; ++i) { int R, C; stage_rc(tid * 16 + i * 8192, R, C); const int Rb = Epi::PERM ? ((R & ~31) + perm32(R & 31)) : R;
        voffA[i] = (unsigned)(R * lda + C) * 2u; voffB[i] = (unsigned)(Rb * ldb + C) * 2u; }
    const size_t kstep = (size_t)(BK * 2);
    const size_t hstepA = (size_t)HALF * lda * 2, hstepB = (size_t)HALF * ldb * 2;
    const unsigned ldsw = (unsigned)wid * 1024u;
    const int aoff = lds_byte(wr * 64 + fr, fq * 8), boff = lds_byte(wc * 32 + fr, fq * 8);
#define PG8_SA(b, h) (((b) * 2 + (h)) * HTB)
#define PG8_SB(b, h) ((4 + (b) * 2 + (h)) * HTB)
#define PG8_STAGE(bufoff, gbase, voff) do { _Pragma("unroll") for (int _i = 0; _i < 2; ++_i) \
        __builtin_amdgcn_global_load_lds((const unsigned*)((const char*)(gbase) + (voff)[_i]), (LAS unsigned*)(lds + (bufoff) + ldsw + _i * 8192), 16, 0, 0); } while (0)
#define PG8_STAGE_A(bufoff, gbase, half, usenext) do { if constexpr (GATHER) { const unsigned _p = (usenext) ? vn[half] : vc[half]; unsigned _v[2]; _v[0] = (_p & 0xffffu) * (unsigned)(lda * 2) + gc2; _v[1] = (_p >> 16) * (unsigned)(lda * 2) + gc2; PG8_STAGE(bufoff, gbase, _v); } \
        else { PG8_STAGE(bufoff, (gbase) + (half) * hstepA, voffA); } } while (0)
#define PG8_LDA(dst, b, h) do { _Pragma("unroll") for (int m = 0; m < 4; ++m) _Pragma("unroll") for (int k = 0; k < 2; ++k) dst[m][k] = *(const LAS bf16x8*)(lds + PG8_SA(b, h) + aoff + m * 2048 + k * 1024); } while (0)
#define PG8_LDB(dst, b, h) do { _Pragma("unroll") for (int n = 0; n < 2; ++n) _Pragma("unroll") for (int k = 0; k < 2; ++k) dst[n][k] = *(const LAS bf16x8*)(lds + PG8_SB(b, h) + boff + n * 2048 + k * 1024); } while (0)
#define PG8_MMA(ai, bj, At, Bt) do { __builtin_amdgcn_s_setprio(1); _Pragma("unroll") for (int m = 0; m < 4; ++m) _Pragma("unroll") for (int n = 0; n < 2; ++n) _Pragma("unroll") for (int k = 0; k < 2; ++k) \
        acc[ai][bj][m][n] = __builtin_amdgcn_mfma_f32_16x16x32_bf16(Bt[n][k], At[m][k], acc[ai][bj][m][n], 0, 0, 0); __builtin_amdgcn_s_setprio(0); } while (0)
#define PG8_WAIT_V(n) asm volatile("s_waitcnt vmcnt(" #n ")" ::: "memory")
#define PG8_WAIT_L(n) asm volatile("s_waitcnt lgkmcnt(" #n ")" ::: "memory")
#define PG8_BAR __builtin_amdgcn_s_barrier()
#define PG8_SCHED __builtin_amdgcn_sched_barrier(0)
    Unit cur, nxt; int ui = 0;
    if (!S.next(0, cur)) return;
    Acc acc;
#pragma unroll
    for (int a = 0; a < 2; ++a)
#pragma unroll
        for (int b = 0; b < 2; ++b)
#pragma unroll
            for (int m = 0; m < 4; ++m)
#pragma unroll
                for (int n = 0; n < 2; ++n) acc[a][b][m][n] = (f32x4){0.f, 0.f, 0.f, 0.f};
    bf16x8 At[4][2], B0[2][2], B1[2][2];
    const char* cA = cur.a; const char* cB = cur.b;
    unsigned vc[2], vn[2], gc2 = 0;
    if constexpr (GATHER) { int R0, C0; stage_rc(tid * 16, R0, C0); gc2 = (unsigned)C0 * 2u;
#pragma unroll
        for (int h = 0; h < 2; ++h) { vc[h] = (unsigned)S.src_row(cur, 128 * h + R0) | ((unsigned)S.src_row(cur, 128 * h + R0 + 64) << 16); vn[h] = vc[h]; }
    }
    static_assert(SP2, "only the two-MFMA-blocks-per-barrier-pair loop is kept");
    {
        PG8_STAGE(PG8_SB(0, 0), cB, voffB); PG8_STAGE(PG8_SB(0, 1), cB + hstepB, voffB); PG8_STAGE_A(PG8_SA(0, 0), cA, 0, false); PG8_STAGE_A(PG8_SA(0, 1), cA, 1, false);
        if (wr == 1) PG8_BAR;
        PG8_WAIT_V(2); PG8_BAR;
        PG8_STAGE(PG8_SB(1, 0), cB + kstep, voffB); PG8_STAGE_A(PG8_SA(1, 0), cA + kstep, 0, false); PG8_STAGE(PG8_SB(1, 1), cB + hstepB + kstep, voffB);
        PG8_WAIT_V(6); PG8_BAR;
    }
    for (;;) {
        const bool has_next = S.next(ui + 1, nxt);
        const char* nA = has_next ? nxt.a : cA; const char* nB = has_next ? nxt.b : cB;
        if constexpr (GATHER) { if (has_next) { int R0, C0; stage_rc(tid * 16, R0, C0);
#pragma unroll
            for (int h = 0; h < 2; ++h) vn[h] = (unsigned)S.src_row(nxt, 128 * h + R0) | ((unsigned)S.src_row(nxt, 128 * h + R0 + 64) << 16); } }
#pragma nounroll
        for (int t = 0; t < nt; t += 2) {
            const bool last = (t == nt - 2);
            const char* a1 = cA + (size_t)(t + 1) * kstep;
            const char* a2 = last ? nA : cA + (size_t)(t + 2) * kstep; const char* b2 = last ? nB : cB + (size_t)(t + 2) * kstep;
            const char* a3 = a2 + kstep; const char* b3 = b2 + kstep;
            {
            PG8_LDB(B0, 0, 0); PG8_LDB(B1, 0, 1); PG8_SCHED; PG8_LDA(At, 0, 0); PG8_STAGE_A(PG8_SA(1, 1), a1, 1, false);
            PG8_WAIT_V(8); PG8_WAIT_L(0); PG8_BAR; PG8_MMA(0, 0, At, B0); PG8_MMA(0, 1, At, B1); PG8_BAR; PG8_SCHED;
            PG8_LDA(At, 0, 1); PG8_STAGE(PG8_SB(0, 0), b2, voffB); PG8_STAGE(PG8_SB(0, 1), b2 + hstepB, voffB); PG8_STAGE_A(PG8_SA(0, 0), a2, 0, last);
            PG8_WAIT_V(8); PG8_WAIT_L(0); PG8_BAR; PG8_MMA(1, 0, At, B0); PG8_MMA(1, 1, At, B1); PG8_BAR; PG8_SCHED;
            PG8_LDB(B0, 1, 0); PG8_LDB(B1, 1, 1); PG8_SCHED; PG8_LDA(At, 1, 0); PG8_STAGE_A(PG8_SA(0, 1), a2, 1, last);
            PG8_WAIT_V(8); PG8_WAIT_L(0); PG8_BAR; PG8_MMA(0, 0, At, B0); PG8_MMA(0, 1, At, B1); PG8_BAR; PG8_SCHED;
            PG8_LDA(At, 1, 1); PG8_STAGE(PG8_SB(1, 0), b3, voffB); PG8_STAGE(PG8_SB(1, 1), b3 + hstepB, voffB); PG8_STAGE_A(PG8_SA(1, 0), a3, 0, last);
            PG8_WAIT_V(8); PG8_WAIT_L(0); PG8_BAR; PG8_MMA(1, 0, At, B0); PG8_MMA(1, 1, At, B1); PG8_BAR; PG8_SCHED;
            }
        }
        if constexpr (ALIGN_EPI) { if (wr == 0) PG8_BAR; }
        E(acc, cur, wr, wc, fr, fq, lds);
        if (!has_next) break;
#pragma unroll
        for (int a = 0; a < 2; ++a)
#pragma unroll
            for (int b = 0; b < 2; ++b)
#pragma unroll
                for (int m = 0; m < 4; ++m)
#pragma unroll
                    for (int n = 0; n < 2; ++n) acc[a][b][m][n] = (f32x4){0.f, 0.f, 0.f, 0.f};
        cur = nxt; cA = nA; cB = nB; ++ui;
        if constexpr (GATHER) { vc[0] = vn[0]; vc[1] = vn[1]; }
        if constexpr (ALIGN_EPI) { if (wr == 1) PG8_BAR; }
    }
    PG8_WAIT_V(0);
    if constexpr (!ALIGN_EPI) { if (wr == 0) PG8_BAR; }
    PG8_BAR;
#undef PG8_SA
#undef PG8_SB
#undef PG8_STAGE
#undef PG8_STAGE_A
#undef PG8_LDA
#undef PG8_LDB
#undef PG8_MMA
#undef PG8_WAIT_V
#undef PG8_WAIT_L
#undef PG8_BAR
#undef PG8_SCHED
}

struct SchedDense {
    int nM, nN, nwg, G, c; const char* A; const char* B; size_t a_tile, b_tile; int pm_per_batch; size_t b_batch;
    __device__ __forceinline__ bool next(int i, Unit& u) const {
        const long L = (long)i * G + c; if (L >= nwg) return false;
        int wgid = (int)L; { const int q = nwg / NXCD, r = nwg % NXCD, xcd = wgid % NXCD, off = wgid / NXCD; wgid = (xcd < r ? xcd * (q + 1) : r * (q + 1) + (xcd - r) * q) + off; }
        const int nig = WGM * nN, gid = wgid / nig, fm = gid * WGM, gsz = (nM - fm) < WGM ? (nM - fm) : WGM;
        u.pm = fm + ((wgid % nig) % gsz); u.pn = (wgid % nig) / gsz; u.aux = 0;
        u.a = A + (size_t)u.pm * a_tile; u.b = B + (size_t)u.pn * b_tile + (size_t)(u.pm / pm_per_batch) * b_batch; return true;
    }
};
}
using pg8::Unit; using pg8::Acc;

struct EpiBf16 {
    static constexpr bool PERM = true;
    bf16_t* O; int ldc; size_t aux_stride; float scale;
    __device__ __forceinline__ void operator()(const Acc& acc, const Unit& u, int wr, int wc, int fr, int fq, LAS unsigned char*) const {
        bf16_t* base = O + (size_t)u.aux * aux_stride;
        const int row0 = u.pm * 256 + wr * 64 + fr, col0 = u.pn * 256 + wc * 32 + 8 * fq;
#pragma unroll
        for (int ai = 0; ai < 2; ++ai)
#pragma unroll
            for (int m = 0; m < 4; ++m) { bf16_t* rowp = base + (size_t)(row0 + ai * 128 + m * 16) * ldc + col0;
#pragma unroll
                for (int bj = 0; bj < 2; ++bj) { const f32x4 v0 = acc[ai][bj][m][0] * scale, v1 = acc[ai][bj][m][1] * scale;
                    u32x4 w; w.x = cvt_pk_bf16(v0[0], v0[1]); w.y = cvt_pk_bf16(v0[2], v0[3]); w.z = cvt_pk_bf16(v1[0], v1[1]); w.w = cvt_pk_bf16(v1[2], v1[3]);
                    *(u32x4*)(rowp + bj * 128) = w; } }
    }
};
struct EpiKV {
    static constexpr bool PERM = true;
    bf16_t* KB; bf16_t* VB;
    __device__ __forceinline__ void operator()(const Acc& acc, const Unit& u, int wr, int wc, int fr, int fq, LAS unsigned char*) const {
        bf16_t* base = (u.pn < 4 ? KB : VB) + (size_t)u.aux * MEMROWS * DM;
        const int row0 = u.pm * 256 + wr * 64 + fr, col0 = (u.pn & 3) * 256 + wc * 32 + 8 * fq;
#pragma unroll
        for (int ai = 0; ai < 2; ++ai)
#pragma unroll
            for (int m = 0; m < 4; ++m) { bf16_t* rowp = base + (size_t)(row0 + ai * 128 + m * 16) * DM + col0;
#pragma unroll
                for (int bj = 0; bj < 2; ++bj) { const f32x4 v0 = acc[ai][bj][m][0], v1 = acc[ai][bj][m][1];
                    u32x4 w; w.x = cvt_pk_bf16(v0[0], v0[1]); w.y = cvt_pk_bf16(v0[2], v0[3]); w.z = cvt_pk_bf16(v1[0], v1[1]); w.w = cvt_pk_bf16(v1[2], v1[3]);
                    *(u32x4*)(rowp + bj * 128) = w; } }
    }
};
struct EpiProj {
    static constexpr bool PERM = true;
    bf16_t* HG; bf16_t* QR; bf16_t* KF; bf16_t* V; const float* rstd; const f32x2* CS; unsigned* kmax;
    __device__ __forceinline__ void operator()(const Acc& acc, const Unit& u, int wr, int wc, int fr, int fq, LAS unsigned char*) const {
        const int row0 = u.pm * 256 + wr * 64 + fr;
        if (u.pn < 8 || u.pn >= 12) {
            bf16_t* base; int ldc, colt;
            if (u.pn < 8) { base = HG; ldc = 2048; colt = u.pn * 256; } else { base = V; ldc = 512; colt = (u.pn - 12) * 256; }
            const int col0 = colt + wc * 32 + 8 * fq;
#pragma unroll
            for (int ai = 0; ai < 2; ++ai)
#pragma unroll
                for (int m = 0; m < 4; ++m) { const int row = row0 + ai * 128 + m * 16; const float rs = rstd[row]; bf16_t* rowp = base + (size_t)row * ldc + col0;
#pragma unroll
                    for (int bj = 0; bj < 2; ++bj) { const f32x4 v0 = acc[ai][bj][m][0] * rs, v1 = acc[ai][bj][m][1] * rs;
                        u32x4 w; w.x = cvt_pk_bf16(v0[0], v0[1]); w.y = cvt_pk_bf16(v0[2], v0[3]); w.z = cvt_pk_bf16(v1[0], v1[1]); w.w = cvt_pk_bf16(v1[2], v1[3]);
                        *(u32x4*)(rowp + bj * 128) = w; } }
        } else {
            const bool isk = u.pn >= 10; const int head = 4 * (u.pn & 1) + wc;
            float kn2max = 0.f;
#pragma unroll
            for (int ai = 0; ai < 2; ++ai)
#pragma unroll
                for (int m = 0; m < 4; ++m) { const int row = row0 + ai * 128 + m * 16; const float rs = rstd[row] * (isk ? 1.f : 0.125f * LOG2E);
                    const f32x4* cs = (const f32x4*)(CS + (size_t)row * 32 + 8 * fq); const f32x4 c0 = cs[0], c1 = cs[1], c2 = cs[2], c3 = cs[3];
                    const float co[8] = {c0.x, c0.z, c1.x, c1.z, c2.x, c2.z, c3.x, c3.z}, si[8] = {c0.y, c0.w, c1.y, c1.w, c2.y, c2.w, c3.y, c3.w};
                    float lo[8], hi[8];
#pragma unroll
                    for (int n = 0; n < 2; ++n)
#pragma unroll
                        for (int e = 0; e < 4; ++e) { const int j = 4 * n + e; const float x1 = acc[ai][0][m][n][e] * rs, x2 = acc[ai][1][m][n][e] * rs; lo[j] = x1 * co[j] - x2 * si[j]; hi[j] = x2 * co[j] + x1 * si[j]; }
                    u32x4 wl, wh; wl.x = cvt_pk_bf16(lo[0], lo[1]); wl.y = cvt_pk_bf16(lo[2], lo[3]); wl.z = cvt_pk_bf16(lo[4], lo[5]); wl.w = cvt_pk_bf16(lo[6], lo[7]);
                    wh.x = cvt_pk_bf16(hi[0], hi[1]); wh.y = cvt_pk_bf16(hi[2], hi[3]); wh.z = cvt_pk_bf16(hi[4], hi[5]); wh.w = cvt_pk_bf16(hi[6], hi[7]);
                    if (!isk) { bf16_t* rowp = QR + (size_t)row * 512 + head * 64 + 8 * fq; *(u32x4*)rowp = wl; *(u32x4*)(rowp + 32) = wh; }
                    else { { float n2 = 0.f;
#pragma unroll
                          for (int j = 0; j < 8; ++j) n2 += lo[j] * lo[j] + hi[j] * hi[j];
                          n2 += __shfl_xor(n2, 16); n2 += __shfl_xor(n2, 32); kn2max = fmaxf(kn2max, n2); }
                        const int b = row >> 13, s = row & (SEQ - 1); const size_t bh = (size_t)(b * ATH + head) * (SEQ * 64);
#pragma unroll
                        for (int pat = 0; pat < 3; ++pat) { const int D = pat == 0 ? 1 : (pat == 1 ? 4 : 16), sh = pat * 2; const int r = s & (D - 1), p = s >> sh, T = p >> 5, k5 = p & 31;
                            const int rho = (k5 & 19) | ((k5 & 4) << 1) | ((k5 & 8) >> 1);
                            bf16_t* kf = KF + (size_t)pat * (MT * 512) + bh + ((size_t)(r * (SEQ / 32 >> sh) + T) * 4) * 512;
                            *(u32x4*)(kf + ((fq >> 1) * 64 + rho + 32 * (fq & 1)) * 8) = wl; *(u32x4*)(kf + ((2 + (fq >> 1)) * 64 + rho + 32 * (fq & 1)) * 8) = wh; }
                    } }
            if (isk) { kn2max = fmaxf(kn2max, __shfl_xor(kn2max, 1)); kn2max = fmaxf(kn2max, __shfl_xor(kn2max, 2)); kn2max = fmaxf(kn2max, __shfl_xor(kn2max, 4)); kn2max = fmaxf(kn2max, __shfl_xor(kn2max, 8));
                if (fr == 0 && fq == 0) __hip_atomic_fetch_max(kmax + ((u.pm >> 5) * ATH + head), __float_as_uint(kn2max), __ATOMIC_RELAXED, __HIP_MEMORY_SCOPE_AGENT); }
        }
    }
};
struct EpiResAdd {
    static constexpr bool PERM = false;
    float* X;
    __device__ __forceinline__ void operator()(const Acc& acc, const Unit& u, int wr, int wc, int fr, int fq, LAS unsigned char*) const {
        const int row0 = u.pm * 256 + wr * 64 + fr, col0 = u.pn * 256 + wc * 32 + 4 * fq;
#pragma unroll
        for (int ai = 0; ai < 2; ++ai)
#pragma unroll
            for (int m = 0; m < 4; ++m) { float* rowp = X + (size_t)(row0 + ai * 128 + m * 16) * DM + col0;
#pragma unroll
                for (int bj = 0; bj < 2; ++bj)
#pragma unroll
                    for (int n = 0; n < 2; ++n) { f32x4* p = (f32x4*)(rowp + bj * 128 + n * 16); *p = *p + acc[ai][bj][m][n]; } }
    }
};
struct EpiSoftmax {
    static constexpr bool PERM = false;
    bf16_t* P; const float* rstd;
    __device__ __forceinline__ void operator()(Acc& acc, const Unit& u, int wr, int wc, int fr, int fq, LAS unsigned char* lds) const {
        LAS f32x2* EX = (LAS f32x2*)(lds + SPARE_OFF);
        const int row0 = u.pm * 256 + wr * 64 + fr;
        float mw[2][4];
#pragma unroll
        for (int ai = 0; ai < 2; ++ai)
#pragma unroll
            for (int m = 0; m < 4; ++m) {
                const float rs = rstd[row0 + ai * 128 + m * 16];
                float mx = -3.0e38f;
#pragma unroll
                for (int bj = 0; bj < 2; ++bj)
#pragma unroll
                    for (int n = 0; n < 2; ++n) { f32x4 v = acc[ai][bj][m][n] * rs; acc[ai][bj][m][n] = v; mx = fmaxf(mx, fmaxf(fmaxf(v[0], v[1]), fmaxf(v[2], v[3]))); }
                mx = fmaxf(mx, __shfl_xor(mx, 16)); mx = fmaxf(mx, __shfl_xor(mx, 32));
                float sm = 0.f;
#pragma unroll
                for (int bj = 0; bj < 2; ++bj)
#pragma unroll
                    for (int n = 0; n < 2; ++n) { f32x4 v = acc[ai][bj][m][n]; v[0] = __expf(v[0] - mx); v[1] = __expf(v[1] - mx); v[2] = __expf(v[2] - mx); v[3] = __expf(v[3] - mx);
                        acc[ai][bj][m][n] = v; sm += (v[0] + v[1]) + (v[2] + v[3]); }
                sm += __shfl_xor(sm, 16); sm += __shfl_xor(sm, 32);
                mw[ai][m] = mx;
                if (fq == 0) EX[(ai * 128 + wr * 64 + m * 16 + fr) * 4 + wc] = (f32x2){mx, sm};
            }
        asm volatile("s_waitcnt lgkmcnt(0)" ::: "memory"); __builtin_amdgcn_s_barrier(); asm volatile("" ::: "memory");
#pragma unroll
        for (int ai = 0; ai < 2; ++ai)
#pragma unroll
            for (int m = 0; m < 4; ++m) {
                const int rl = ai * 128 + wr * 64 + m * 16 + fr;
                const f32x2 e0 = EX[rl * 4 + 0], e1 = EX[rl * 4 + 1], e2 = EX[rl * 4 + 2], e3 = EX[rl * 4 + 3];
                const float M = fmaxf(fmaxf(e0.x, e1.x), fmaxf(e2.x, e3.x));
                const float Ls = e0.y * __expf(e0.x - M) + e1.y * __expf(e1.x - M) + e2.y * __expf(e2.x - M) + e3.y * __expf(e3.x - M);
                const float f = __expf(mw[ai][m] - M) / Ls;
                bf16_t* rowp = P + (size_t)(row0 + ai * 128 + m * 16) * DM + u.pn * 256 + wc * 32 + 4 * fq;
#pragma unroll
                for (int bj = 0; bj < 2; ++bj)
#pragma unroll
                    for (int n = 0; n < 2; ++n) { const f32x4 v = acc[ai][bj][m][n] * f; u32x2 w; w.x = cvt_pk_bf16(v[0], v[1]); w.y = cvt_pk_bf16(v[2], v[3]);
                        *(u32x2*)(rowp + bj * 128 + n * 16) = w; }
            }
        asm volatile("s_waitcnt lgkmcnt(0)" ::: "memory"); __builtin_amdgcn_s_barrier(); asm volatile("" ::: "memory");
    }
};
struct EpiMoe1 {
    static constexpr bool PERM = true;
    bf16_t* ACTB; const float* srs; const float* sgw;
    __device__ __forceinline__ void operator()(const Acc& acc, const Unit& u, int wr, int wc, int fr, int fq, LAS unsigned char*) const {
        const int row0 = u.pm * 256 + wr * 64 + fr, col0 = u.pn * 128 + wc * 32 + 8 * fq;
#pragma unroll
        for (int ai = 0; ai < 2; ++ai)
#pragma unroll
            for (int m = 0; m < 4; ++m) { const int row = row0 + ai * 128 + m * 16; const float rs = srs[row], gw = sgw[row] * rs;
                float o[8];
#pragma unroll
                for (int n = 0; n < 2; ++n)
#pragma unroll
                    for (int j = 0; j < 4; ++j) { const float g = acc[ai][0][m][n][j] * rs, up = acc[ai][1][m][n][j]; o[n * 4 + j] = g * sigmoidf_(g) * up * gw; }
                u32x4 w; w.x = cvt_pk_bf16(o[0], o[1]); w.y = cvt_pk_bf16(o[2], o[3]); w.z = cvt_pk_bf16(o[4], o[5]); w.w = cvt_pk_bf16(o[6], o[7]);
                *(u32x4*)(ACTB + (size_t)row * EFF + col0) = w; }
    }
};

struct Args { const void* in[20]; float* out; unsigned char* ws; int ph_lo, ph_hi; };
struct Frame {
    LAS unsigned char* lds; volatile LAS unsigned* MISC; gu32* ctl;
    int tid, lane, wave, vcu, G;
    unsigned char* ws; float* out; size_t z;
};

__device__ __forceinline__ void transpose_item(const float* W, int N, const float* scale, bf16_t* WT, int ldt, int row_base, int k0, int n0, LAS float* scr, int lane) {
    f32x4 v[8];
#pragma unroll
    for (int i = 0; i < 8; ++i) v[i] = *(const GAS f32x4*)(W + (size_t)(k0 + 8 * i + (lane >> 3)) * N + n0 + 4 * (lane & 7));
#pragma unroll
    for (int i = 0; i < 8; ++i) { const int kk = 8 * i + (lane >> 3); f32x4 x = v[i]; if (scale) x = x * scale[k0 + kk]; LAS float* d = scr + kk * 33 + 4 * (lane & 7); d[0] = x.x; d[1] = x.y; d[2] = x.z; d[3] = x.w; }
    LDS_WAIT(); asm volatile("" ::: "memory");
    const int c = lane & 7;
#pragma unroll
    for (int j = 0; j < 4; ++j) { const int n = (lane >> 3) + 8 * j; const LAS float* s = scr + (8 * c) * 33 + n;
        u32x4 o; o.x = pk2(s[0 * 33], s[1 * 33]); o.y = pk2(s[2 * 33], s[3 * 33]); o.z = pk2(s[4 * 33], s[5 * 33]); o.w = pk2(s[6 * 33], s[7 * 33]);
        *(GAS u32x4*)(WT + (size_t)(row_base + n0 + n) * ldt + k0 + 8 * c) = o; }
    LDS_WAIT(); asm volatile("" ::: "memory");
}
__device__ __forceinline__ void transpose_mat_item(const float* W, int K, int N, const float* scale, bf16_t* WT, int mode, int it, LAS float* scr, int lane) {
    const int nblk = N / 32, kb = it / nblk, nb = it % nblk, k0 = 64 * kb, n0 = 32 * nb;
    int row_base = 0;
    if (mode == 1 || mode == 2) row_base = 256 * (n0 / 128) + (n0 % 128) + (mode == 2 ? 128 : 0) - n0;
    if (mode == 3 && n0 >= 2048 && n0 < 3072) {
        const int blk = (n0 - 2048) / 512, np = (n0 - 2048) % 512, head = np / 64, d = np % 64;
        row_base = 2048 + blk * 512 + (head / 4) * 256 + 128 * (d / 32) + 32 * (head % 4) + (d % 32) - n0; }
    transpose_item(W, N, scale, WT, K, row_base, k0, n0, scr, lane);
}

__device__ __forceinline__ float row_norm_prep(const float* xrow, bf16_t* xb_row, float* copy_row, int lane) {
    const GAS f32x4* xr = (const GAS f32x4*)xrow + lane;
    f32x4 v[4]; float s = 0.f;
#pragma unroll
    for (int j = 0; j < 4; ++j) { v[j] = xr[64 * j]; s += (v[j].x * v[j].x + v[j].y * v[j].y) + (v[j].z * v[j].z + v[j].w * v[j].w); }
    const float rstd = 1.f / sqrtf(wave_sum(s) * (1.f / DM) + EPS);
    GAS u32x2* o8 = (GAS u32x2*)xb_row + lane;
#pragma unroll
    for (int j = 0; j < 4; ++j) { u32x2 w; w.x = pk2(v[j].x, v[j].y); w.y = pk2(v[j].z, v[j].w); o8[64 * j] = w; }
    if (copy_row) { GAS f32x4* c = (GAS f32x4*)copy_row + lane;
#pragma unroll
        for (int j = 0; j < 4; ++j) c[64 * j] = v[j]; }
    return rstd;
}

__constant__ double INV_FREQ[32] = {1.0, 0.7498942093324559, 0.5623413251903491, 0.4216965034285822, 0.31622776601683794, 0.23713737056616552, 0.1778279410038923, 0.1333521432163324,
    0.1, 0.07498942093324558, 0.05623413251903491, 0.042169650342858224, 0.03162277660168379, 0.023713737056616554, 0.01778279410038923, 0.01333521432163324,
    0.01, 0.007498942093324558, 0.005623413251903491, 0.004216965034285823, 0.0031622776601683794, 0.0023713737056616554, 0.0017782794100389228, 0.001333521432163324,
    0.001, 0.0007498942093324559, 0.0005623413251903491, 0.00042169650342858224, 0.00031622776601683794, 0.00023713737056616554, 0.00017782794100389227, 0.0001333521432163324};


#define IN_F(i) ((const float*)((const char*)a.in[i] + F.z))
__device__ __forceinline__ float hg_lb(const Frame& F, const Args& a, int l, int c) { if (l == 0) return 0.f; const float* h = IN_F(5); return sigmoidf_(h[HGW + c] - h[c]); }
__device__ __forceinline__ void ph_init(Frame& F, const Args& a) {
    LAS float* scr = (LAS float*)(F.lds + F.wave * 16384);
    const int gw = F.vcu * NWAVES + F.wave, NGW = F.G * NWAVES, lane = F.lane;
    unsigned char* ws = F.ws;
    for (int it = gw; it < 2 * 3840; it += NGW) {
        const int l = it / 3840; int r = it % 3840;
        if (r < 1792) { transpose_mat_item(IN_F(4) + (size_t)l * DM * NIN, DM, NIN, IN_F(3) + l * DM, (bf16_t*)(ws + WS_WIN) + (size_t)l * NIN * DM, 3, r, scr, lane); continue; } r -= 1792;
        if (r < 512) { transpose_mat_item(IN_F(7) + (size_t)l * DM * DM, DM, DM, nullptr, (bf16_t*)(ws + WS_WOUT) + (size_t)l * DM * DM, 0, r, scr, lane); continue; } r -= 512;
        if (r < 1024) { transpose_mat_item(IN_F(11) + (size_t)l * DM * 2 * DM, DM, 2 * DM, nullptr, (bf16_t*)(ws + WS_WKVT) + (size_t)l * 2 * DM * DM, 0, r, scr, lane); continue; } r -= 1024;
        transpose_mat_item(IN_F(12) + (size_t)l * DM * DM, DM, DM, nullptr, (bf16_t*)(ws + WS_WOT) + (size_t)l * DM * DM, 0, r, scr, lane);
    }
    for (int r = gw; r < DEPTH * DM; r += NGW) {
        const float sc = IN_F(8)[r] * 0.0625f;
        const GAS f32x4* src = (const GAS f32x4*)(IN_F(10) + (size_t)r * DM) + lane; GAS u32x2* dst = (GAS u32x2*)((bf16_t*)(ws + WS_WQS) + (size_t)r * DM) + lane;
#pragma unroll
        for (int j = 0; j < 4; ++j) { const f32x4 v = src[64 * j] * sc; u32x2 w; w.x = pk2(v.x, v.y); w.y = pk2(v.z, v.w); dst[64 * j] = w; }
    }
    for (int r = gw; r < MEMROWS; r += NGW) {
        const GAS f32x4* xr = (const GAS f32x4*)(IN_F(1) + (size_t)r * DM) + lane;
        f32x4 v[4]; float s = 0.f;
#pragma unroll
        for (int j = 0; j < 4; ++j) { v[j] = xr[64 * j]; s += (v[j].x * v[j].x + v[j].y * v[j].y) + (v[j].z * v[j].z + v[j].w * v[j].w); }
        const float rstd = 1.f / sqrtf(wave_sum(s) * (1.f / DM) + EPS);
        for (int l = 0; l < DEPTH; ++l) {
            const GAS f32x4* g = (const GAS f32x4*)(IN_F(9) + l * DM) + lane; GAS u32x2* dst = (GAS u32x2*)((bf16_t*)(ws + WS_MEMN) + ((size_t)l * MEMROWS + r) * DM) + lane;
#pragma unroll
            for (int j = 0; j < 4; ++j) { const f32x4 o = v[j] * rstd * g[64 * j]; u32x2 w; w.x = pk2(o.x, o.y); w.y = pk2(o.z, o.w); dst[64 * j] = w; }
        }
    }
    for (int r = gw; r < MT; r += NGW) {
        const float rs = row_norm_prep(IN_F(0) + (size_t)r * DM, (bf16_t*)(ws + WS_XB) + (size_t)r * DM, F.out + (size_t)r * DM, lane);
        if (lane == 0) ((float*)(ws + WS_RSTD))[r] = rs;
    }
    for (int i = (F.vcu * NTHR + F.tid); i < DEPTH * HGW; i += F.G * NTHR) ((float*)(ws + WS_LBT))[i] = hg_lb(F, a, i / HGW, i % HGW);
    { const int* pos = (const int*)((const char*)a.in[2] + F.z);
      for (int i = (F.vcu * NTHR + F.tid); i < MT * 32; i += F.G * NTHR) { const double ang = (double)pos[i >> 5] * INV_FREQ[i & 31]; double rev = ang * 0.15915494309189535; rev = rev - __builtin_floor(rev);
          const float fr = (float)rev; ((f32x2*)(ws + WS_CS))[i] = (f32x2){__builtin_amdgcn_cosf(fr), __builtin_amdgcn_sinf(fr)}; } }
    for (int i = (F.vcu * NTHR + F.tid); i < DEPTH * DM * 20; i += F.G * NTHR) {
        const int l = i / (DM * 20), k = (i / 20) % DM, j = i % 20;
        const float g = IN_F(13)[l * DM + k];
        const float w = j < 4 ? IN_F(14)[((size_t)l * DM + k) * 4 + j] : IN_F(15)[((size_t)l * DM + k) * 16 + (j - 4)];
        ((float*)(ws + WS_WR))[i] = g * w;
    }
}

struct SchedKV {
    int G, c; const char* memn; const char* wkvt;
    __device__ __forceinline__ bool next(int i, Unit& u) const {
        const int L = i * G + c; if (L >= 32) return false;
        const int l = L >> 4; u.pm = (L >> 3) & 1; u.pn = L & 7; u.aux = l;
        u.a = memn + ((size_t)l * MEMROWS + u.pm * 256) * DM * 2; u.b = wkvt + ((size_t)l * 2 * DM + u.pn * 256) * DM * 2; return true;
    }
};
struct SchedFold {
    int G, c; const char* kb; const char* vb; const char* wqs; const char* wot;
    __device__ __forceinline__ bool next(int i, Unit& u) const {
        const int L = i * G + c; if (L >= 128) return false;
        const int ty = L >> 6, l = (L >> 5) & 1, b = (L >> 4) & 1, h = (L >> 2) & 3, t = L & 3; u.aux = ty * 4 + l * 2 + b;
        if (ty == 0) { u.pm = h; u.pn = t; u.a = kb + (((size_t)l * MEMROWS + b * 256) * DM + h * 256) * 2; u.b = wqs + (((size_t)l * DM + t * 256) * DM + h * 256) * 2; }
        else { u.pm = t; u.pn = h; u.a = wot + (((size_t)l * DM + t * 256) * DM + h * 256) * 2; u.b = vb + (((size_t)l * MEMROWS + b * 256) * DM + h * 256) * 2; }
        return true;
    }
};
struct SchedMoe {
    int G, c, kdim; volatile LAS unsigned* tb; const char* A; const char* B; const int* perm; bool gather;
    __device__ __forceinline__ bool next(int i, Unit& u) const {
        const int L = i * G + c; const int total = (int)tb[16] * 4; if (L >= total) return false;
        const int mt = L >> 2; u.pm = mt; u.pn = L & 3; int e = 0;
#pragma unroll
        for (int j = 1; j < 16; ++j) e += (mt >= (int)tb[j]) ? 1 : 0;
        u.aux = e; u.a = gather ? A : A + (size_t)mt * 256 * kdim * 2; u.b = B + ((size_t)e * 1024 + u.pn * 256) * kdim * 2; return true;
    }
    __device__ __forceinline__ int src_row(const Unit& u, int r) const { return perm[u.pm * 256 + r]; }
};

__device__ __forceinline__ void vf_unit(Frame& F, int unit) {
    unsigned char* ws = F.ws; const int tid = F.tid;
    const int tb = unit >> 3, h = unit & 7, b = tb >> 4, s_base = (tb & 15) * 512;
    LAS unsigned short* Vl = (LAS unsigned short*)F.lds;
    const bf16_t* V = (const bf16_t*)(ws + A_V) + ((size_t)b * SEQ + s_base) * 512 + h * 64;
#pragma unroll
    for (int p = 0; p < 8; ++p) { const int c = p * 512 + tid, row = c >> 3, ch = c & 7; *(LAS u32x4*)(Vl + row * 72 + ch * 8) = *(const GAS u32x4*)(V + (size_t)row * 512 + ch * 8); }
    __syncthreads();
    const size_t bh = (size_t)(b * ATH + h) * (SEQ * 64);
    for (int it = 0; it < 24; ++it) { const int pc = it * 512 + tid, tile = pc >> 8, q = pc & 255, s = q >> 7, mt = (q >> 6) & 1, ln = q & 63, dim = (ln & 31) + 32 * mt, hi = ln >> 5;
        const int pat = tile >> 4, j16 = tile & 15, sh = pat * 2, D = 1 << sh;
        const int TPC = 16 >> sh, r = j16 / TPC, tl = j16 % TPC;
        const int pl = tl * 32 + 16 * s + 8 * hi;
        unsigned w[4];
#pragma unroll
        for (int jj = 0; jj < 4; ++jj) { const int t0 = ((pl + 2 * jj) << sh) + r, t1 = ((pl + 2 * jj + 1) << sh) + r; w[jj] = (unsigned)Vl[t0 * 72 + dim] | ((unsigned)Vl[t1 * 72 + dim] << 16); }
        const int T = (s_base >> sh >> 5) + tl;
        bf16_t* vf = (bf16_t*)(ws + A_VT1) + (size_t)pat * (MT * 512) + bh + ((size_t)(r * (SEQ / 32 >> sh) + T) * 4 + s * 2 + mt) * 512 + ln * 8;
        *(GAS u32x4*)vf = (u32x4){w[0], w[1], w[2], w[3]}; }
    __syncthreads();
}

__device__ __forceinline__ void hg_build_b(Frame& F, int l, int h, const u32x4 z0, const u32x4 z1, int k0, float (&bb)[16], float (&kk)[16]) {
    const int tid = F.tid, lane = F.lane, wave = F.wave, tl = lane >> 3;
    LAS float* WT = (LAS float*)F.lds; LAS float* REF = (LAS float*)(F.lds + 4096);
    const unsigned zz[8] = {z0.x, z0.y, z0.z, z0.w, z1.x, z1.y, z1.z, z1.w};
    float lbv[16];
#pragma unroll
    for (int i = 0; i < 16; i += 4) { const f32x4 t4 = *(const GAS f32x4*)((const float*)(F.ws + WS_LBT) + l * HGW + h * 128 + k0 + i); lbv[i] = t4.x; lbv[i + 1] = t4.y; lbv[i + 2] = t4.z; lbv[i + 3] = t4.w; }
#pragma unroll
    for (int i = 0; i < 16; ++i) { const float z = (i & 1) ? bfhi(zz[i >> 1]) : bflo(zz[i >> 1]); const float lb = lbv[i];
        const float e = ex2(-LOG2E * z), sg = __builtin_amdgcn_rcpf(1.f + e), f = lb + (1.f - lb) * sg; bb[i] = __builtin_amdgcn_logf(f); kk[i] = (1.f - lb) * (e * sg); }
#pragma unroll
    for (int i = 0; i < 16; ++i) { float x = bb[i]; float y;
        y = __shfl_up(x, 8); if (tl >= 1) x += y;
        y = __shfl_up(x, 16); if (tl >= 2) x += y;
        y = __shfl_up(x, 32); if (tl >= 4) x += y;
        bb[i] = x; }
    if (tl == 7) {
#pragma unroll
        for (int i = 0; i < 16; i += 4) *(LAS f32x4*)(WT + wave * 128 + k0 + i) = (f32x4){bb[i], bb[i + 1], bb[i + 2], bb[i + 3]}; }
    __syncthreads();
    for (int w = 0; w < wave; ++w) {
#pragma unroll
        for (int i = 0; i < 16; i += 4) { const f32x4 p = *(const LAS f32x4*)(WT + w * 128 + k0 + i); bb[i] += p.x; bb[i + 1] += p.y; bb[i + 2] += p.z; bb[i + 3] += p.w; } }
    if (tl == 7 && (wave & 1)) {
#pragma unroll
        for (int i = 0; i < 16; i += 4) *(LAS f32x4*)(REF + (wave >> 1) * 128 + k0 + i) = (f32x4){bb[i], bb[i + 1], bb[i + 2], bb[i + 3]}; }
    __syncthreads();
    (void)tid;
}
__device__ __forceinline__ void st_row16(LAS unsigned char* base, int byteoff, const float (&v)[16]) {
    u32x4 w0, w1; w0.x = cvt_pk_bf16(v[0], v[1]); w0.y = cvt_pk_bf16(v[2], v[3]); w0.z = cvt_pk_bf16(v[4], v[5]); w0.w = cvt_pk_bf16(v[6], v[7]); w1.x = cvt_pk_bf16(v[8], v[9]); w1.y = cvt_pk_bf16(v[10], v[11]); w1.z = cvt_pk_bf16(v[12], v[13]); w1.w = cvt_pk_bf16(v[14], v[15]);
    *(LAS u32x4*)(base + byteoff) = w0; *(LAS u32x4*)(base + byteoff + 16) = w1;
}
constexpr int HL_RED = 6144, HL_QD = 8192, HL_KD = 25600, HL_QE = 43008, HL_Q1 = 60416, HL_K1 = 69120, HL_Q2 = 77824, HL_K2 = 86528, HL_VT = 95232, HL_SC = 113664;
constexpr int HA_KT = 8192, HA_VT = 26624;
constexpr int RS128 = 272, RS64 = 144;

struct HgIn { u32x4 z0, z1, q0, q1, v0, v1; };
template <bool NEEDQ> __device__ __forceinline__ HgIn hg_load(Frame& F, int unit) {
    HgIn R;
    const int b = unit >> 9, h = (unit >> 7) & 3, c = unit & 127; const int row0 = b * SEQ + c * CHUNK, t = F.tid >> 3, k0 = (F.tid & 7) * 16;
    const bf16_t* rowp = (const bf16_t*)(F.ws + A_HG) + (size_t)(row0 + t) * 2048 + h * 128 + k0;
    R.z0 = *(const GAS u32x4*)(rowp + 512); R.z1 = *(const GAS u32x4*)(rowp + 512 + 8); R.v0 = *(const GAS u32x4*)(rowp + 1024); R.v1 = *(const GAS u32x4*)(rowp + 1024 + 8);
    if (NEEDQ) { R.q0 = *(const GAS u32x4*)(rowp); R.q1 = *(const GAS u32x4*)(rowp + 8); } else { R.q0 = R.z0; R.q1 = R.z1; }
    return R;
}
__device__ __forceinline__ void hg_a2_unit(Frame& F, const Args& a, int l, int unit, const HgIn& R) {
    unsigned char* ws = F.ws; const int tid = F.tid, lane = F.lane, wave = F.wave;
    const int h = (unit >> 7) & 3;
    const int t = tid >> 3, k0 = (tid & 7) * 16;
    const u32x4 v0 = R.v0, v1 = R.v1;
    float bb[16], kk[16];
    hg_build_b(F, l, h, R.z0, R.z1, k0, bb, kk);
    const LAS float* REF = (const LAS float*)(F.lds + 4096);
    LAS unsigned short* KT = (LAS unsigned short*)(F.lds + HA_KT); LAS unsigned short* VT = (LAS unsigned short*)(F.lds + HA_VT);
    const unsigned vv[8] = {v0.x, v0.y, v0.z, v0.w, v1.x, v1.y, v1.z, v1.w};
#pragma unroll
    for (int i = 0; i < 16; ++i) { const float b63 = REF[3 * 128 + k0 + i];
        KT[(k0 + i) * (RS64 / 2) + t] = (unsigned short)f2bf(kk[i] * ex2(b63 - bb[i]));
        VT[(k0 + i) * (RS64 / 2) + t] = (unsigned short)((i & 1) ? (vv[i >> 1] >> 16) : (vv[i >> 1] & 0xffffu)); }
    if (tid < 128) ((float*)(ws + A_DECAY))[(size_t)unit * 128 + tid] = ex2(REF[3 * 128 + tid]);
    __syncthreads();
    { const int fr = lane & 15, g = lane >> 4;
      bf16x8 af[2];
#pragma unroll
      for (int ks = 0; ks < 2; ++ks) af[ks] = *(const LAS bf16x8*)(F.lds + HA_KT + (wave * 16 + fr) * RS64 + (32 * ks + 8 * g) * 2);
      bf16_t* st = (bf16_t*)(ws + A_STATE) + (size_t)unit * 16384;
#pragma unroll
      for (int vt = 0; vt < 8; ++vt) { f32x4 acc = {0.f, 0.f, 0.f, 0.f};
#pragma unroll
          for (int ks = 0; ks < 2; ++ks) { const bf16x8 bf = *(const LAS bf16x8*)(F.lds + HA_VT + (vt * 16 + fr) * RS64 + (32 * ks + 8 * g) * 2); acc = __builtin_amdgcn_mfma_f32_16x16x32_bf16(af[ks], bf, acc, 0, 0, 0); }
          u32x2 w; w.x = cvt_pk_bf16(acc[0], acc[1]); w.y = cvt_pk_bf16(acc[2], acc[3]);
          *(GAS u32x2*)(st + (vt * 16 + fr) * 128 + wave * 16 + 4 * g) = w; } }
    __syncthreads();
}

template <int STOP> __device__ __forceinline__ void hg_c2_unit(Frame& F, const Args& a, int l, int unit, const HgIn& R) {
    unsigned char* ws = F.ws; const int tid = F.tid, lane = F.lane, wave = F.wave;
    const int b = unit >> 9, h = (unit >> 7) & 3, c = unit & 127; const int row0 = b * SEQ + c * CHUNK;
    const int t = tid >> 3, k0 = (tid & 7) * 16;
    const int fr = lane & 15, g = lane >> 4;
    const bf16_t* HG = (const bf16_t*)(ws + A_HG);
    const u32x4 q0 = R.q0, q1 = R.q1, v0 = R.v0, v1 = R.v1;
    bf16x8 sf[4]; u32x2 gwv[4];
    { const bf16_t* st = (const bf16_t*)(ws + A_STATE) + (size_t)unit * 16384 + (wave * 16 + fr) * 128;
#pragma unroll
      for (int ks = 0; ks < 4; ++ks) sf[ks] = *(const GAS bf16x8*)(st + 32 * ks + 8 * g);
#pragma unroll
      for (int I = 0; I < 4; ++I) gwv[I] = *(const GAS u32x2*)(HG + (size_t)(row0 + 16 * I + fr) * 2048 + 1536 + h * 128 + wave * 16 + 4 * g); }
    const f32x4 gain = *(const GAS f32x4*)(IN_F(6) + l * HGW + h * 128 + wave * 16 + 4 * g);
    float bb[16], kk[16];
    hg_build_b(F, l, h, R.z0, R.z1, k0, bb, kk);
    if (STOP == 1) { asm volatile("" :: "v"(bb[0]), "v"(kk[0]), "v"(sf[0]), "v"(gwv[0]), "v"(gain)); return; }
    const LAS float* REF = (const LAS float*)(F.lds + 4096);
    { const unsigned qq[8] = {q0.x, q0.y, q0.z, q0.w, q1.x, q1.y, q1.z, q1.w}, vv[8] = {v0.x, v0.y, v0.z, v0.w, v1.x, v1.y, v1.z, v1.w};
      LAS unsigned short* VT = (LAS unsigned short*)(F.lds + HL_VT);
      float qv[16], tmp[16];
#pragma unroll
      for (int i = 0; i < 16; ++i) { qv[i] = (i & 1) ? bfhi(qq[i >> 1]) : bflo(qq[i >> 1]); VT[(k0 + i) * (RS64 / 2) + t] = (unsigned short)((i & 1) ? (vv[i >> 1] >> 16) : (vv[i >> 1] & 0xffffu)); }
      const int I = wave >> 1;
      float rf[16];
#pragma unroll
      for (int i = 0; i < 16; i += 4) { f32x4 r4 = {0.f, 0.f, 0.f, 0.f}; if (I) r4 = *(const LAS f32x4*)(REF + (I - 1) * 128 + k0 + i); rf[i] = r4.x; rf[i + 1] = r4.y; rf[i + 2] = r4.z; rf[i + 3] = r4.w; }
#pragma unroll
      for (int i = 0; i < 16; ++i) tmp[i] = qv[i] * ex2(bb[i] - rf[i]);
      st_row16(F.lds, HL_QD + t * RS128 + k0 * 2, tmp);
#pragma unroll
      for (int i = 0; i < 16; ++i) tmp[i] = kk[i] * ex2(fminf(rf[i] - bb[i], 86.f));
      st_row16(F.lds, HL_KD + t * RS128 + k0 * 2, tmp);
#pragma unroll
      for (int i = 0; i < 16; ++i) tmp[i] = qv[i] * ex2(bb[i]);
      st_row16(F.lds, HL_QE + t * RS128 + k0 * 2, tmp);
#pragma unroll
      for (int i = 0; i < 16; i += 4) { const f32x4 r4 = *(const LAS f32x4*)(REF + 1 * 128 + k0 + i); rf[i] = r4.x; rf[i + 1] = r4.y; rf[i + 2] = r4.z; rf[i + 3] = r4.w; }
      if (wave >= 4) {
#pragma unroll
          for (int i = 0; i < 16; ++i) tmp[i] = qv[i] * ex2(bb[i] - rf[i]);
          st_row16(F.lds, HL_Q1 + (t & 31) * RS128 + k0 * 2, tmp);
      } else {
#pragma unroll
          for (int i = 0; i < 16; ++i) tmp[i] = kk[i] * ex2(rf[i] - bb[i]);
          st_row16(F.lds, HL_K1 + (t & 31) * RS128 + k0 * 2, tmp);
      }
#pragma unroll
      for (int i = 0; i < 16; i += 4) { const f32x4 r4 = *(const LAS f32x4*)(REF + ((wave >= 4) ? 2 : 0) * 128 + k0 + i); rf[i] = r4.x; rf[i + 1] = r4.y; rf[i + 2] = r4.z; rf[i + 3] = r4.w; }
      if (wave & 2) {
#pragma unroll
          for (int i = 0; i < 16; ++i) tmp[i] = qv[i] * ex2(bb[i] - rf[i]);
          st_row16(F.lds, HL_Q2 + ((t & 15) + ((wave >= 4) ? 16 : 0)) * RS128 + k0 * 2, tmp);
      } else {
#pragma unroll
          for (int i = 0; i < 16; ++i) tmp[i] = kk[i] * ex2(rf[i] - bb[i]);
          st_row16(F.lds, HL_K2 + ((t & 15) + ((wave >= 4) ? 16 : 0)) * RS128 + k0 * 2, tmp);
      }
      for (int i = tid; i < 64 * RS64 / 16; i += NTHR) *(LAS u32x4*)(F.lds + HL_SC + i * 16) = (u32x4){0u, 0u, 0u, 0u};
    }
    __syncthreads();
    if (STOP == 2) { asm volatile("" :: "v"(sf[0]), "v"(gwv[0]), "v"(gain)); return; }
    for (int blk = wave; blk < 10; blk += 8) {
        int ko, qo, J, I; bool diag = false;
        if (blk < 4) { ko = HL_KD + blk * 16 * RS128; qo = HL_QD + blk * 16 * RS128; J = blk; I = blk; diag = true; }
        else if (blk == 4) { ko = HL_K2; qo = HL_Q2; J = 0; I = 1; }
        else if (blk == 5) { ko = HL_K2 + 16 * RS128; qo = HL_Q2 + 16 * RS128; J = 2; I = 3; }
        else { const int jj = (blk - 6) >> 1, ii = (blk - 6) & 1; ko = HL_K1 + jj * 16 * RS128; qo = HL_Q1 + ii * 16 * RS128; J = jj; I = 2 + ii; }
        f32x4 acc = {0.f, 0.f, 0.f, 0.f};
#pragma unroll
        for (int ks = 0; ks < 4; ++ks) { const bf16x8 af = *(const LAS bf16x8*)(F.lds + ko + fr * RS128 + (32 * ks + 8 * g) * 2), bf = *(const LAS bf16x8*)(F.lds + qo + fr * RS128 + (32 * ks + 8 * g) * 2);
            acc = __builtin_amdgcn_mfma_f32_16x16x32_bf16(af, bf, acc, 0, 0, 0); }
        if (diag) {
#pragma unroll
            for (int rg = 0; rg < 4; ++rg) if (4 * g + rg > fr) acc[rg] = 0.f; }
        u32x2 w; w.x = cvt_pk_bf16(acc[0], acc[1]); w.y = cvt_pk_bf16(acc[2], acc[3]);
        *(LAS u32x2*)(F.lds + HL_SC + (16 * I + fr) * RS64 + (16 * J + 4 * g) * 2) = w;
    }
    __syncthreads();
    if (STOP == 3) { asm volatile("" :: "v"(sf[0]), "v"(gwv[0]), "v"(gain)); return; }
    f32x4 o[4];
#pragma unroll
    for (int I = 0; I < 4; ++I) o[I] = (f32x4){0.f, 0.f, 0.f, 0.f};
    { bf16x8 af[2];
#pragma unroll
      for (int ks = 0; ks < 2; ++ks) af[ks] = *(const LAS bf16x8*)(F.lds + HL_VT + (wave * 16 + fr) * RS64 + (32 * ks + 8 * g) * 2);
#pragma unroll
      for (int I = 0; I < 4; ++I)
#pragma unroll
          for (int ks = 0; ks < 2; ++ks) { const bf16x8 bf = *(const LAS bf16x8*)(F.lds + HL_SC + (16 * I + fr) * RS64 + (32 * ks + 8 * g) * 2); o[I] = __builtin_amdgcn_mfma_f32_16x16x32_bf16(af[ks], bf, o[I], 0, 0, 0); }
#pragma unroll
      for (int I = 0; I < 4; ++I)
#pragma unroll
          for (int ks = 0; ks < 4; ++ks) { const bf16x8 bf = *(const LAS bf16x8*)(F.lds + HL_QE + (16 * I + fr) * RS128 + (32 * ks + 8 * g) * 2); o[I] = __builtin_amdgcn_mfma_f32_16x16x32_bf16(sf[ks], bf, o[I], 0, 0, 0); }
    }
    if (STOP == 4) { asm volatile("" :: "v"(o[0]), "v"(o[1]), "v"(o[2]), "v"(o[3]), "v"(gwv[0]), "v"(gain)); return; }
    LAS float* RED = (LAS float*)(F.lds + HL_RED);
#pragma unroll
    for (int I = 0; I < 4; ++I) { float q = (o[I][0] * o[I][0] + o[I][1] * o[I][1]) + (o[I][2] * o[I][2] + o[I][3] * o[I][3]); q += __shfl_xor(q, 16); q += __shfl_xor(q, 32); if (g == 0) RED[wave * 64 + 16 * I + fr] = q; }
    __syncthreads();
    { bf16_t* Y = (bf16_t*)(ws + WS_XB);
#pragma unroll
      for (int I = 0; I < 4; ++I) { const int tt = 16 * I + fr; float ssq = 0.f;
#pragma unroll
          for (int w = 0; w < 8; ++w) ssq += RED[w * 64 + tt];
          const float rs = __builtin_amdgcn_rsqf(ssq * (1.f / 128.f) + EPS);
          const u32x2 gw = gwv[I];
          const float g0 = bflo(gw.x), g1 = bfhi(gw.x), g2 = bflo(gw.y), g3 = bfhi(gw.y);
          u32x2 w; w.x = cvt_pk_bf16(o[I][0] * rs * gain.x * (g0 * sigmoidf_(g0)), o[I][1] * rs * gain.y * (g1 * sigmoidf_(g1)));
          w.y = cvt_pk_bf16(o[I][2] * rs * gain.z * (g2 * sigmoidf_(g2)), o[I][3] * rs * gain.w * (g3 * sigmoidf_(g3)));
          *(GAS u32x2*)(Y + (size_t)(row0 + tt) * DM + h * 128 + wave * 16 + 4 * g) = w; } }
    __syncthreads();
}

__device__ __forceinline__ void hg_scan(Frame& F) {
    unsigned char* ws = F.ws;
    for (int gid = F.vcu * NTHR + F.tid; gid < BATCH * HGH * 16384; gid += F.G * NTHR) {
        const int bh = gid >> 14, e = gid & 16383, k = e & 127;
        bf16_t* st = (bf16_t*)(ws + A_STATE) + (size_t)bh * NCHUNK * 16384 + e; const float* dc = (const float*)(ws + A_DECAY) + (size_t)bh * NCHUNK * 128 + k;
        float S = 0.f;
        for (int c0 = 0; c0 < NCHUNK; c0 += 8) { float kv[8], d[8];
#pragma unroll
            for (int i = 0; i < 8; ++i) { kv[i] = bf2f(st[(size_t)(c0 + i) * 16384]); d[i] = dc[(c0 + i) * 128]; }
#pragma unroll
            for (int i = 0; i < 8; ++i) { st[(size_t)(c0 + i) * 16384] = (bf16_t)f2bf(S); S = d[i] * S + kv[i]; } }
    }
}


typedef float f32x16 __attribute__((ext_vector_type(16)));
template <int D, int PAT>
__device__ __forceinline__ void att_pattern(Frame& F, int b, int h, int s_base, float kmax2, const bf16_t* QR, const bf16_t* KF, const bf16_t* VF) {
    const int lane = F.lane, wave = F.wave, r32 = lane & 31, hi = lane >> 5;
    LAS float* ACC = (LAS float*)F.lds; LAS float* LS = (LAS float*)(F.lds + 131072);
    constexpr int TPC = 16 / D, NT = SEQ / D / 32;
    const size_t bh = (size_t)(b * ATH + h) * (SEQ * 64);
    for (int jj = 0; jj < 2; ++jj) {
        const int j = wave + 8 * jj, r = j / TPC, tile = j % TPC, p0 = s_base / D + tile * 32;
        const size_t qrow = (size_t)b * SEQ + (size_t)(p0 + r32) * D + r;
        bf16x8 qf[4];
#pragma unroll
        for (int kk = 0; kk < 4; ++kk) qf[kk] = *(const GAS bf16x8*)(QR + qrow * 512 + h * 64 + 16 * kk + 8 * hi);
        float qn2 = 0.f;
#pragma unroll
        for (int kk = 0; kk < 4; ++kk)
#pragma unroll
            for (int e = 0; e < 8; ++e) { const float x = bf2f((unsigned short)qf[kk][e]); qn2 += x * x; }
        qn2 += __shfl_xor(qn2, 32);
        const float negM = -sqrtf(qn2 * kmax2);
        f32x16 o[2] = {{}, {}}; float lsum = 0.f;
#pragma unroll
        for (int kt = 0; kt < 5; ++kt) {
            const float c0 = (p0 - 128 + 32 * kt) < 0 ? -1.0e30f : negM;
            bf16x8 vfr[2][2], kf[4];
            { const int kb = p0 - 128 + 32 * kt, kbc = kb < 0 ? 0 : kb;
              const bf16_t* kp = KF + bh + ((size_t)(r * NT + (kbc >> 5)) * 4) * 512 + lane * 8;
#pragma unroll
              for (int kk = 0; kk < 4; ++kk) kf[kk] = *(const GAS bf16x8*)(kp + kk * 512);
#pragma unroll
              for (int s = 0; s < 2; ++s)
#pragma unroll
                  for (int mt = 0; mt < 2; ++mt) vfr[s][mt] = *(const GAS bf16x8*)(VF + bh + ((size_t)(r * NT + (kbc >> 5)) * 4 + s * 2 + mt) * 512 + lane * 8); }
            f32x16 acc;
#pragma unroll
            for (int rg = 0; rg < 16; ++rg) acc[rg] = c0;
#pragma unroll
            for (int kk = 0; kk < 4; ++kk) acc = __builtin_amdgcn_mfma_f32_32x32x16_bf16(kf[kk], qf[kk], acc, 0, 0, 0);
            if (kt == 0 || kt == 4) {
#pragma unroll
                for (int rg = 0; rg < 16; ++rg) { const int kap = 16 * (rg >> 3) + 8 * hi + (rg & 7); if (kt == 0 ? (kap < r32) : (kap > r32)) acc[rg] = -1.0e30f; } }
#pragma unroll
            for (int rg = 0; rg < 16; ++rg) { acc[rg] = ex2(acc[rg]); lsum += acc[rg]; }
#pragma unroll
            for (int s = 0; s < 2; ++s) {
                u32x4 pw; pw.x = cvt_pk_bf16(acc[8 * s + 0], acc[8 * s + 1]); pw.y = cvt_pk_bf16(acc[8 * s + 2], acc[8 * s + 3]);
                pw.z = cvt_pk_bf16(acc[8 * s + 4], acc[8 * s + 5]); pw.w = cvt_pk_bf16(acc[8 * s + 6], acc[8 * s + 7]);
                const bf16x8 pf = __builtin_bit_cast(bf16x8, pw);
#pragma unroll
                for (int mt = 0; mt < 2; ++mt) o[mt] = __builtin_amdgcn_mfma_f32_32x32x16_bf16(vfr[s][mt], pf, o[mt], 0, 0, 0);
            }
        }
        lsum += __shfl_xor(lsum, 32);
        const int tau = (p0 + r32) * D + r - s_base, gsw = (tau ^ (tau >> 5)) & 31;
        LAS float* arow = ACC + tau * 64;
#pragma unroll
        for (int mt = 0; mt < 2; ++mt)
#pragma unroll
            for (int rg = 0; rg < 16; ++rg) { LAS float* p = arow + ((((rg & 3) + 8 * (rg >> 2) + 4 * hi) ^ gsw) + 32 * mt); if (PAT == 0) *p = o[mt][rg]; else *p += o[mt][rg]; }
        if (hi == 0) { if (PAT == 0) LS[tau] = lsum; else LS[tau] += lsum; }
    }
}
__device__ __forceinline__ void att_unit(Frame& F, int l, int unit) {
    const int tb = unit >> 3, h = unit & 7, b = tb >> 4, s_base = (tb & 15) * 512;
    const bf16_t* QR = (const bf16_t*)(F.ws + A_QR);
    LAS float* ACC = (LAS float*)F.lds; LAS float* LS = (LAS float*)(F.lds + 131072);
    const float kmax2 = __uint_as_float(__hip_atomic_load((unsigned*)(F.ctl + CW_KMAX + l * 16) + b * ATH + h, RLX_AGENT)) * 1.02f;
    att_pattern<1, 0>(F, b, h, s_base, kmax2, QR, (const bf16_t*)(F.ws + A_KF1), (const bf16_t*)(F.ws + A_VT1));
    __syncthreads();
    att_pattern<4, 1>(F, b, h, s_base, kmax2, QR, (const bf16_t*)(F.ws + A_KF4), (const bf16_t*)(F.ws + A_VT4));
    __syncthreads();
    att_pattern<16, 2>(F, b, h, s_base, kmax2, QR, (const bf16_t*)(F.ws + A_KF16), (const bf16_t*)(F.ws + A_VT16));
    __syncthreads();
    { const int tau = F.tid, gsw = (tau ^ (tau >> 5)) & 31; const LAS float* arow = ACC + tau * 64; const float inv = __builtin_amdgcn_rcpf(LS[tau]);
      bf16_t* yrow = (bf16_t*)(F.ws + WS_XB) + ((size_t)b * SEQ + s_base + tau) * DM + 512 + h * 64;
#pragma unroll
      for (int c = 0; c < 8; ++c) { float v[8];
#pragma unroll
          for (int e = 0; e < 8; ++e) v[e] = arow[((8 * c + e) & 32) + (((8 * c + e) & 31) ^ gsw)] * inv;
          u32x4 w; w.x = cvt_pk_bf16(v[0], v[1]); w.y = cvt_pk_bf16(v[2], v[3]); w.z = cvt_pk_bf16(v[4], v[5]); w.w = cvt_pk_bf16(v[6], v[7]); *(GAS u32x4*)(yrow + 8 * c) = w; } }
    __syncthreads();
}

__device__ __forceinline__ void ph_norm(Frame& F, const Args& a) {
    const int gw = F.vcu * NWAVES + F.wave, NGW = F.G * NWAVES;
    for (int r = gw; r < MT; r += NGW) { const float rs = row_norm_prep(F.out + (size_t)r * DM, (bf16_t*)(F.ws + WS_XB) + (size_t)r * DM, nullptr, F.lane); if (F.lane == 0) ((float*)(F.ws + WS_RSTD))[r] = rs; }
}

__device__ __forceinline__ void ph_router(Frame& F, const Args& a, int l) {
    unsigned char* ws = F.ws; const int lane = F.lane;
    const int gw = F.vcu * NWAVES + F.wave, NGW = F.G * NWAVES;
    { LAS float* scr = (LAS float*)(F.lds + F.wave * 16384);
      for (int it = gw; it < 3 * 4096; it += NGW) { const int ty = it >> 12, e = (it >> 8) & 15, r = it & 255;
          if (ty == 0) transpose_mat_item(IN_F(16) + ((size_t)l * NEXP + e) * DM * EFF, DM, EFF, IN_F(13) + l * DM, (bf16_t*)(ws + A_WGU) + (size_t)e * DM * DM, 1, r, scr, lane);
          else if (ty == 1) transpose_mat_item(IN_F(17) + ((size_t)l * NEXP + e) * DM * EFF, DM, EFF, IN_F(13) + l * DM, (bf16_t*)(ws + A_WGU) + (size_t)e * DM * DM, 2, r, scr, lane);
          else transpose_mat_item(IN_F(18) + ((size_t)l * NEXP + e) * EFF * DM, EFF, DM, nullptr, (bf16_t*)(ws + A_WD) + (size_t)e * DM * EFF, 0, r, scr, lane); } }
    __syncthreads();
    LAS float* WRl = (LAS float*)F.lds;
    { const float* src = (const float*)(ws + WS_WR) + (size_t)l * DM * 20; for (int i = F.tid; i < DM * 20; i += NTHR) WRl[(i % 20) * DM + i / 20] = src[i]; }
    __syncthreads();
    unsigned* cnt = (unsigned*)(F.ctl + CW_CNT + l * 16 * 64);
    for (int r = gw; r < MT; r += NGW) {
        const GAS f32x4* xr = (const GAS f32x4*)(F.out + (size_t)r * DM) + lane;
        f32x4 v[4]; float s = 0.f;
#pragma unroll
        for (int j = 0; j < 4; ++j) { v[j] = xr[64 * j]; s += (v[j].x * v[j].x + v[j].y * v[j].y) + (v[j].z * v[j].z + v[j].w * v[j].w); }
        const float rstd = 1.f / sqrtf(wave_sum(s) * (1.f / DM) + EPS);
        GAS u32x2* o8 = (GAS u32x2*)((bf16_t*)(ws + WS_XB) + (size_t)r * DM) + lane;
#pragma unroll
        for (int j = 0; j < 4; ++j) { u32x2 w; w.x = pk2(v[j].x, v[j].y); w.y = pk2(v[j].z, v[j].w); o8[64 * j] = w; }
        float lg[20];
#pragma unroll
        for (int q = 0; q < 20; ++q) lg[q] = 0.f;
#pragma unroll
        for (int j = 0; j < 4; ++j) {
#pragma unroll
            for (int q = 0; q < 20; ++q) { const f32x4 w = *(const LAS f32x4*)(WRl + q * DM + 256 * j + 4 * lane); lg[q] += (v[j].x * w.x + v[j].y * w.y) + (v[j].z * w.z + v[j].w * w.w); }
            asm volatile("" ::: "memory"); }
#pragma unroll
        for (int q = 0; q < 20; ++q) lg[q] = wave_sum(lg[q]) * rstd;
        if (lane == 0) {
            ((float*)(ws + WS_RSTD))[r] = rstd;
            int gs = 0; float gm = lg[0];
#pragma unroll
            for (int q = 1; q < 4; ++q) if (lg[q] > gm) { gm = lg[q]; gs = q; }
            float den = 0.f;
#pragma unroll
            for (int q = 0; q < 4; ++q) den += __expf(lg[q] - gm);
            const float gwt = 1.f / den;
            float e4[4];
#pragma unroll
            for (int q = 0; q < 4; ++q) e4[q] = gs == 0 ? lg[4 + q] : (gs == 1 ? lg[8 + q] : (gs == 2 ? lg[12 + q] : lg[16 + q]));
            int i1 = 0; float v1 = e4[0];
#pragma unroll
            for (int q = 1; q < 4; ++q) if (e4[q] > v1) { v1 = e4[q]; i1 = q; }
            int i2 = -1; float v2 = -3.0e38f;
#pragma unroll
            for (int q = 0; q < 4; ++q) if (q != i1 && e4[q] > v2) { v2 = e4[q]; i2 = q; }
            const float ex = __expf(v2 - v1), w1 = 1.f / (1.f + ex), w2 = ex * w1;
            const int id1 = gs * 4 + i1, id2 = gs * 4 + i2;
            int* te = (int*)(ws + WS_TOKE) + 2 * r; float* tw = (float*)(ws + WS_TOKW) + 2 * r; int* tl = (int*)(ws + WS_TOKL) + 2 * r;
            te[0] = id1; te[1] = id2; tw[0] = w1 * gwt; tw[1] = w2 * gwt;
            tl[0] = (int)__hip_atomic_fetch_add(cnt + 64 * id1, 1u, RLX_AGENT); tl[1] = (int)__hip_atomic_fetch_add(cnt + 64 * id2, 1u, RLX_AGENT);
        }
    }
}

__device__ __forceinline__ void moe_prefix(Frame& F, int l) {
    if (F.tid == 0) { unsigned acc = 0; for (int e = 0; e < 16; ++e) { F.MISC[16 + e] = acc; const unsigned n = __hip_atomic_load((unsigned*)(F.ctl + CW_CNT + l * 16 * 64) + 64 * e, RLX_AGENT); acc += (n + 255u) >> 8; } F.MISC[32] = acc; }
    __syncthreads();
}

__device__ __forceinline__ void ph_scatter(Frame& F, const Args& a, int l) {
    unsigned char* ws = F.ws;
    moe_prefix(F, l);
    int* perm = (int*)(ws + WS_PERM); float* srs = (float*)(ws + WS_SLOTRS); float* sgw = (float*)(ws + WS_SLOTGW);
    const int gt = F.vcu * NTHR + F.tid, NGT = F.G * NTHR;
    for (int p = gt; p < 2 * MT; p += NGT) {
        const int r = p >> 1; const int e = ((const int*)(ws + WS_TOKE))[p]; const int loc = ((const int*)(ws + WS_TOKL))[p];
        const int slot = (int)F.MISC[16 + e] * 256 + loc;
        perm[slot] = r; srs[slot] = ((const float*)(ws + WS_RSTD))[r]; sgw[slot] = ((const float*)(ws + WS_TOKW))[p];
        ((int*)(ws + WS_TOKL))[p] = slot;
    }
    for (int e = 0; e < NEXP; ++e) {
        const int n = (int)__hip_atomic_load((unsigned*)(F.ctl + CW_CNT + l * 16 * 64) + 64 * e, RLX_AGENT); const int s0 = (int)F.MISC[16 + e] * 256 + n, s1 = (int)F.MISC[17 + e] * 256;
        for (int s = s0 + gt; s < s1; s += NGT) { perm[s] = 0; srs[s] = 0.f; sgw[s] = 0.f; }
    }
}

__device__ __forceinline__ void ph_combine(Frame& F, const Args& a, int l) {
    unsigned char* ws = F.ws; const int lane = F.lane;
    const int gw = F.vcu * NWAVES + F.wave, NGW = F.G * NWAVES;
    for (int r = gw; r < MT; r += NGW) {
        const int s0 = ((const int*)(ws + WS_TOKL))[2 * r], s1 = ((const int*)(ws + WS_TOKL))[2 * r + 1];
        GAS f32x4* xr = (GAS f32x4*)(F.out + (size_t)r * DM) + lane;
        const GAS u32x2* y0 = (const GAS u32x2*)((const bf16_t*)(ws + A_Y) + (size_t)s0 * DM) + lane; const GAS u32x2* y1 = (const GAS u32x2*)((const bf16_t*)(ws + A_Y) + (size_t)s1 * DM) + lane;
        f32x4 v[4]; float s = 0.f;
#pragma unroll
        for (int j = 0; j < 4; ++j) { const u32x2 p0 = y0[64 * j], p1 = y1[64 * j]; f32x4 x = xr[64 * j];
            x.x += bflo(p0.x) + bflo(p1.x); x.y += bfhi(p0.x) + bfhi(p1.x); x.z += bflo(p0.y) + bflo(p1.y); x.w += bfhi(p0.y) + bfhi(p1.y);
            v[j] = x; s += (x.x * x.x + x.y * x.y) + (x.z * x.z + x.w * x.w); }
        const float rstd = 1.f / sqrtf(wave_sum(s) * (1.f / DM) + EPS);
        if (l == DEPTH - 1) { const GAS f32x4* g = (const GAS f32x4*)IN_F(19) + lane;
#pragma unroll
            for (int j = 0; j < 4; ++j) xr[64 * j] = v[j] * rstd * g[64 * j];
        } else {
            GAS u32x2* o8 = (GAS u32x2*)((bf16_t*)(ws + WS_XB) + (size_t)r * DM) + lane;
#pragma unroll
            for (int j = 0; j < 4; ++j) { xr[64 * j] = v[j]; u32x2 w; w.x = pk2(v[j].x, v[j].y); w.y = pk2(v[j].z, v[j].w); o8[64 * j] = w; }
            if (lane == 0) ((float*)(ws + WS_RSTD))[r] = rstd;
        }
    }
}

constexpr int NPHASE = 3 + 13 * DEPTH + (PROBE_P >= 0 ? PROBE_N - 1 : 0);
__global__ void __launch_bounds__(NTHR, 2) fwd(Args a) {
    extern __shared__ __attribute__((aligned(16))) unsigned char lds_raw[];
    Frame F;
    F.lds = (LAS unsigned char*)lds_raw; F.MISC = (volatile LAS unsigned*)(F.lds + MISC_OFF);
    F.tid = threadIdx.x; F.lane = F.tid & 63; F.wave = __builtin_amdgcn_readfirstlane(F.tid >> 6);
    F.G = gridDim.x; { const int bx = blockIdx.x; F.vcu = (F.G % 8 == 0) ? (bx % 8) * (F.G / 8) + bx / 8 : bx; }
    F.ws = a.ws; F.ctl = (gu32*)(a.ws + WS_CTL); F.out = a.out; F.z = 0;
    for (int u = F.tid; u < (LDS_BYTES - LDSCTL_OFF) / 4; u += NTHR) ((LAS unsigned*)(F.lds + LDSCTL_OFF))[u] = 0u;
    __syncthreads();
    XcdBarrier bar; bar.bar = (unsigned*)(F.ctl + CW_BAR); bar.x = 0; bar.st = nullptr;
    const bool one_launch = (a.ph_hi - a.ph_lo) > 1;
    if (one_launch) bar = xcd_barrier_post((unsigned*)(F.ctl + CW_BAR), F.MISC + 8);
    for (int pp = a.ph_lo; pp < a.ph_hi; ++pp) {
        int ph = pp;
        if (PROBE_P >= 0) { constexpr int P = PROBE_P; if (pp > P) ph = (pp - (PROBE_N - 1) > P) ? pp - (PROBE_N - 1) : P; }
        { int t_ = threadIdx.x; asm volatile("" : "+v"(t_)); F.tid = t_; F.lane = t_ & 63; F.wave = __builtin_amdgcn_readfirstlane(t_ >> 6); }
        size_t z_ = 0; asm volatile("" : "+s"(z_)); F.z = z_; F.ws = a.ws + z_; F.out = (float*)((char*)a.out + z_); F.ctl = (gu32*)(a.ws + z_ + WS_CTL);
        unsigned char* ws = F.ws; int bx = (int)blockIdx.x; asm volatile("" : "+s"(bx));
        if (ph == 0) { if (PHSEL(0)) ph_init(F, a); }
        else if (ph == 1) { if (PHSEL(1)) {
            SchedKV S{F.G, bx, (const char*)(ws + WS_MEMN), (const char*)(ws + WS_WKVT)};
            EpiKV E{(bf16_t*)(ws + WS_KV), (bf16_t*)(ws + WS_KV) + (size_t)DEPTH * MEMROWS * DM};
            pg8::gemm_phase<EpiKV, SchedKV, true, true, DM, DM>(F.lds, F.tid, S, E); }
        } else if (ph == 2) { if (PHSEL(2)) {
            SchedFold S{F.G, bx, (const char*)(ws + WS_KV), (const char*)(ws + WS_KV) + (size_t)DEPTH * MEMROWS * DM * 2, (const char*)(ws + WS_WQS), (const char*)(ws + WS_WOT)};
            EpiBf16 E{(bf16_t*)(ws + WS_WQK), DM, (size_t)DM * DM, 1.f};
            pg8::gemm_phase<EpiBf16, SchedFold, true, true, DM, 256>(F.lds, F.tid, S, E); }
        } else {
            const int l = (ph - 3) / 13, q = (ph - 3) % 13;
            if (q == 0 && PHSEL(3)) {
                pg8::SchedDense S{64, 14, 896, F.G, bx, (const char*)(ws + WS_XB), (const char*)(ws + WS_WIN) + (size_t)l * NIN * DM * 2, (size_t)256 * DM * 2, (size_t)256 * DM * 2, 64, 0};
                EpiProj E{(bf16_t*)(ws + A_HG), (bf16_t*)(ws + A_QR), (bf16_t*)(ws + A_KF1), (bf16_t*)(ws + A_V), (const float*)(ws + WS_RSTD), (const f32x2*)(ws + WS_CS), (unsigned*)(F.ctl + CW_KMAX + l * 16)};
                pg8::gemm_phase<EpiProj, pg8::SchedDense, true, true, DM, DM>(F.lds, F.tid, S, E);
            } else if (q == 1 && PHSEL(4)) {
                for (int rep = 0; rep < PROBE_PREP_N; ++rep) for (int u = F.vcu; u < (MT / 512) * ATH; u += F.G) vf_unit(F, u);
                for (int rep = 0; rep < PROBE_HGA_N; ++rep) { constexpr int NU = BATCH * HGH * NCHUNK; HgIn R = hg_load<false>(F, F.vcu < NU ? F.vcu : NU - 1);
                    for (int u = F.vcu; u < NU; u += F.G) { const HgIn Rn = hg_load<false>(F, u + F.G < NU ? u + F.G : NU - 1); hg_a2_unit(F, a, l, u, R); R = Rn; } }
            } else if (q == 2 && PHSEL(5)) hg_scan(F);
            else if (q == 3 && PHSEL(6)) {
                for (int rep = 0; rep < PROBE_HGC_N; ++rep) { constexpr int NU = BATCH * HGH * NCHUNK; HgIn R = hg_load<true>(F, F.vcu < NU ? F.vcu : NU - 1);
                    for (int u = F.vcu; u < NU; u += F.G) { const HgIn Rn = hg_load<true>(F, u + F.G < NU ? u + F.G : NU - 1); if (rep + 1 < PROBE_HGC_N) hg_c2_unit<PROBE_HGC_STOP>(F, a, l, u, R); else hg_c2_unit<0>(F, a, l, u, R); R = Rn; } }
#if ATT_GOLDEN
                for (int t = F.vcu * NWAVES + F.wave; t < (MT / 64) * ATH; t += F.G * NWAVES) att_task(F, t);
#else
                for (int rep = 0; rep < PROBE_ATT_N; ++rep) for (int u = F.vcu; u < (MT / 512) * ATH; u += F.G) att_unit(F, l, u);
#endif
            } else if (q == 4 && PHSEL(7)) {
                pg8::SchedDense S{64, 4, 256, F.G, bx, (const char*)(ws + WS_XB), (const char*)(ws + WS_WOUT) + (size_t)l * DM * DM * 2, (size_t)256 * DM * 2, (size_t)256 * DM * 2, 64, 0};
                EpiResAdd E{F.out};
                pg8::gemm_phase<EpiResAdd, pg8::SchedDense, true, true, DM, DM>(F.lds, F.tid, S, E);
            } else if (q == 5 && PHSEL(8)) ph_norm(F, a);
            else if (q == 6 && PHSEL(9)) {
                pg8::SchedDense S{64, 4, 256, F.G, bx, (const char*)(ws + WS_XB), (const char*)(ws + WS_WQK) + (size_t)l * 2 * DM * DM * 2, (size_t)256 * DM * 2, (size_t)256 * DM * 2, 32, (size_t)DM * DM * 2};
                EpiSoftmax E{(bf16_t*)(ws + A_P), (const float*)(ws + WS_RSTD)};
                pg8::gemm_phase<EpiSoftmax, pg8::SchedDense, true, true, DM, DM>(F.lds, F.tid, S, E);
            } else if (q == 7 && PHSEL(10)) {
                pg8::SchedDense S{64, 4, 256, F.G, bx, (const char*)(ws + A_P), (const char*)(ws + WS_WVO) + (size_t)l * 2 * DM * DM * 2, (size_t)256 * DM * 2, (size_t)256 * DM * 2, 32, (size_t)DM * DM * 2};
                EpiResAdd E{F.out};
                pg8::gemm_phase<EpiResAdd, pg8::SchedDense, true, true, DM, DM>(F.lds, F.tid, S, E);
            } else if (q == 8 && PHSEL(11)) ph_router(F, a, l);
            else if (q == 9 && PHSEL(12)) ph_scatter(F, a, l);
            else if (q == 10 && PHSEL(13)) {
                moe_prefix(F, l);
                SchedMoe S{F.G, bx, DM, F.MISC + 16, (const char*)(ws + WS_XB), (const char*)(ws + A_WGU), (const int*)(ws + WS_PERM), true};
                EpiMoe1 E{(bf16_t*)(ws + A_ACTB), (const float*)(ws + WS_SLOTRS), (const float*)(ws + WS_SLOTGW)};
                pg8::gemm_phase<EpiMoe1, SchedMoe, true, true, DM, DM, true>(F.lds, F.tid, S, E);
            } else if (q == 11 && PHSEL(14)) {
                moe_prefix(F, l);
                SchedMoe S{F.G, bx, EFF, F.MISC + 16, (const char*)(ws + A_ACTB), (const char*)(ws + A_WD), nullptr, false};
                EpiBf16 E{(bf16_t*)(ws + A_Y), DM, 0, 1.f};
                pg8::gemm_phase<EpiBf16, SchedMoe, true, true, EFF, EFF>(F.lds, F.tid, S, E);
            } else if (q == 12 && PHSEL(15)) ph_combine(F, a, l);
        }
        if (pp + 1 < a.ph_hi) xcd_barrier(bar);
    }
}

extern "C" void kernel_launch(void* const* d_in, const int* in_sizes, int n_in, void* d_out, int out_size, void* d_ws, size_t ws_size, hipStream_t stream) {
    static int grid = 0;
    if (grid == 0) {
        if (n_in != 20 || in_sizes[0] != MT * DM || out_size != MT * DM || ws_size < WS_END) { fprintf(stderr, "kernel_launch: unexpected shapes / workspace (%d inputs, ws %zu)\n", n_in, ws_size); grid = -1; return; }
        int dev = 0, cus = 0, per_cu = 0;
        if (hipGetDevice(&dev) != hipSuccess || hipDeviceGetAttribute(&cus, hipDeviceAttributeMultiprocessorCount, dev) != hipSuccess) { grid = -1; return; }
        if (hipFuncSetAttribute((const void*)fwd, hipFuncAttributeMaxDynamicSharedMemorySize, LDS_BYTES) != hipSuccess) { grid = -1; return; }
        if (hipOccupancyMaxActiveBlocksPerMultiprocessor(&per_cu, (const void*)fwd, NTHR, LDS_BYTES) != hipSuccess || per_cu < 1) { fprintf(stderr, "kernel_launch: occupancy query says %d\n", per_cu); per_cu = 1; }
        (void)hipGetLastError();
        grid = cus * 1;
    }
    if (grid < 0) return;
    (void)hipMemsetAsync((char*)d_ws + WS_CTL, 0, CTL_ZERO_BYTES, stream);
    Args a{};
    for (int i = 0; i < 20; ++i) a.in[i] = d_in[i];
    a.out = (float*)d_out; a.ws = (unsigned char*)d_ws;
#if MK_PER_PHASE
    for (int ph = 0; ph < NPHASE; ++ph) { a.ph_lo = ph; a.ph_hi = ph + 1; hipLaunchKernelGGL(fwd, dim3(grid), dim3(NTHR), LDS_BYTES, stream, a); }
#else
    a.ph_lo = 0; a.ph_hi = NPHASE;
    void* kargs[] = {&a};
    hipError_t e = hipLaunchCooperativeKernel((const void*)fwd, dim3(grid), dim3(NTHR), kargs, LDS_BYTES, stream);
    if (e != hipSuccess) fprintf(stderr, "cooperative launch failed: %s (grid %d)\n", hipGetErrorString(e), grid);
#endif
}
```

```cpp
#include <hip/hip_runtime.h>
#include <cstdio>
#include <cstdint>

#ifndef PH_MASK
#define PH_MASK 0xFFFFFFFFu
#endif
#define PHSEL(n) ((PH_MASK >> (n)) & 1u)
#ifndef PROBE_ATT_N
#define PROBE_ATT_N 1
#endif
#ifndef PROBE_HGC_N
#define PROBE_HGC_N 1
#endif
#ifndef PROBE_HGA_N
#define PROBE_HGA_N 1
#endif
#ifndef PROBE_PREP_N
#define PROBE_PREP_N 1
#endif
#ifndef PROBE_HGC_STOP
#define PROBE_HGC_STOP 0
#endif
#ifndef PROBE_P
#define PROBE_P -1
#endif
#ifndef PROBE_N
#define PROBE_N 1
#endif
#ifndef HG_A_GOLDEN
#define HG_A_GOLDEN 0
#endif
#ifndef HG_C_GOLDEN
#define HG_C_GOLDEN 0
#endif
#ifndef ATT_GOLDEN
#define ATT_GOLDEN 0
#endif
#ifndef MK_PER_PHASE
#define MK_PER_PHASE 0
#endif

#define LAS __attribute__((address_space(3)))
#define GAS __attribute__((address_space(1)))
typedef unsigned short bf16_t;
typedef short bf16x8 __attribute__((ext_vector_type(8)));
typedef float f32x4 __attribute__((ext_vector_type(4)));
typedef float f32x2 __attribute__((ext_vector_type(2)));
typedef unsigned u32x4 __attribute__((ext_vector_type(4)));
typedef unsigned u32x2 __attribute__((ext_vector_type(2)));
typedef GAS unsigned gu32;

constexpr int BATCH = 2, SEQ = 8192, DM = 1024, MT = BATCH * SEQ, DEPTH = 2;
constexpr int MEM_LEN = 256, MEMROWS = BATCH * MEM_LEN;
constexpr int NIN = 3584, HGW = 512, HGH = 4, HGD = 128, CHUNK = 64, NCHUNK = SEQ / CHUNK;
constexpr int ATW = 512, ATH = 8, ATD = 64;
constexpr int NEXP = 16, EFF = 512;
constexpr float EPS = 1e-6f;
constexpr int NWAVES = 8, NTHR = 512;

constexpr size_t MiB = 1u << 20;
constexpr size_t WS_CTL = 0, CTL_ZERO_BYTES = 1 * MiB;
constexpr size_t WS_RSTD = 1 * MiB;
constexpr size_t WS_TOKE = WS_RSTD + 64 * 1024;
constexpr size_t WS_TOKW = WS_TOKE + 128 * 1024;
constexpr size_t WS_TOKL = WS_TOKW + 128 * 1024;
constexpr size_t WS_SLOTRS = WS_TOKL + 128 * 1024;
constexpr size_t WS_SLOTGW = WS_SLOTRS + 160 * 1024;
constexpr size_t WS_PERM = WS_SLOTGW + 160 * 1024;
constexpr size_t WS_WR = 3 * MiB;
constexpr size_t WS_LBT = 3 * MiB + 256 * 1024;
constexpr size_t WS_XB = 4 * MiB;
constexpr size_t WS_WIN = 36 * MiB;
constexpr size_t WS_WOUT = 50 * MiB;
constexpr size_t WS_WQS = 54 * MiB;
constexpr size_t WS_WKVT = 58 * MiB;
constexpr size_t WS_WOT = 66 * MiB;
constexpr size_t WS_MEMN = 70 * MiB;
constexpr size_t WS_KV = 72 * MiB;
constexpr size_t WS_WQK = 76 * MiB;
constexpr size_t WS_WVO = 84 * MiB;
constexpr size_t WS_ACT = 92 * MiB;
constexpr size_t WS_CS = 320 * MiB;
constexpr size_t WS_END = 324 * MiB;
constexpr size_t A_HG = WS_ACT + 0 * MiB;
constexpr size_t A_KF1 = WS_ACT + 64 * MiB;
constexpr size_t A_KF4 = WS_ACT + 80 * MiB;
constexpr size_t A_KF16 = WS_ACT + 96 * MiB;
constexpr size_t A_QR = WS_ACT + 112 * MiB;
constexpr size_t A_V = WS_ACT + 128 * MiB;
constexpr size_t A_VT1 = WS_ACT + 144 * MiB;
constexpr size_t A_VT4 = WS_ACT + 160 * MiB;
constexpr size_t A_VT16 = WS_ACT + 176 * MiB;
constexpr size_t A_STATE = WS_ACT + 192 * MiB;
constexpr size_t A_DECAY = WS_ACT + 224 * MiB;
constexpr size_t A_P = WS_ACT + 0 * MiB;
constexpr size_t A_WGU = WS_ACT + 0 * MiB;
constexpr size_t A_WD = WS_ACT + 32 * MiB;
constexpr size_t A_PERM2 = WS_ACT + 48 * MiB;
constexpr size_t A_SRS2 = WS_ACT + 49 * MiB;
constexpr size_t A_SGW2 = WS_ACT + 50 * MiB;
constexpr size_t A_ACTB = WS_ACT + 120 * MiB;
constexpr size_t A_Y = WS_ACT + 156 * MiB;
constexpr int MAXSLOT = 2 * MT + NEXP * 256;
static_assert(A_Y + (size_t)MAXSLOT * 1024 * 2 <= WS_END, "ws map");
constexpr int CW_BAR = 4096;
constexpr int CW_KMAX = 12288;
constexpr int CW_CNT = 16384;
constexpr int RING_BYTES = 131072;
constexpr int SPARE_OFF = RING_BYTES;
constexpr int LDSCTL_OFF = RING_BYTES + 8192, MISC_OFF = LDSCTL_OFF + 64;
constexpr int LDS_BYTES = 147456;

#define RLX_AGENT __ATOMIC_RELAXED, __HIP_MEMORY_SCOPE_AGENT
#define LDS_WAIT() asm volatile("s_waitcnt lgkmcnt(0)" ::: "memory")
#define VM_WAIT() asm volatile("s_waitcnt vmcnt(0)" ::: "memory")

__device__ __forceinline__ unsigned f2bf(float f) { unsigned u = __builtin_bit_cast(unsigned, f); return (u + 0x7fffu + ((u >> 16) & 1u)) >> 16; }
__device__ __forceinline__ unsigned pk2(float lo, float hi) { return f2bf(lo) | (f2bf(hi) << 16); }
__device__ __forceinline__ float bf2f(unsigned short h) { return __builtin_bit_cast(float, (unsigned)h << 16); }
__device__ __forceinline__ float bflo(unsigned w) { return __builtin_bit_cast(float, w << 16); }
__device__ __forceinline__ float bfhi(unsigned w) { return __builtin_bit_cast(float, w & 0xffff0000u); }
typedef __bf16 bf16x2_t __attribute__((ext_vector_type(2)));
__device__ __forceinline__ unsigned cvt_pk_bf16(float lo, float hi) { f32x2 v = {lo, hi}; bf16x2_t b = __builtin_convertvector(v, bf16x2_t); return __builtin_bit_cast(unsigned, b); }
__device__ __forceinline__ float wave_sum(float v) {
#pragma unroll
    for (int o = 1; o < 64; o <<= 1) v += __shfl_xor(v, o);
    return v;
}
__device__ __forceinline__ float sigmoidf_(float z) { return __builtin_amdgcn_rcpf(1.f + __builtin_amdgcn_exp2f(-1.4426950408889634f * z)); }
__device__ __forceinline__ float ex2(float x) { return __builtin_amdgcn_exp2f(x); }
constexpr float LOG2E = 1.4426950408889634f;

#define XB_TMO      128
#define XB_XCNT(j)  (256  + 64 * (j))
#define XB_XSUB(j)  (1280 + 64 * (j))
#define XB_XGEN(j)  (2304 + 64 * (j))
#define XB_TOP      3328
#define XB_TOPGEN   3392
#define XCD_BAR_WORDS 3456
#define XB_SPIN_CAP (1u << 18)
__device__ __forceinline__ unsigned xb_ld(unsigned* p)              { return __hip_atomic_load(p, __ATOMIC_RELAXED, __HIP_MEMORY_SCOPE_AGENT); }
__device__ __forceinline__ unsigned xb_add(unsigned* p, unsigned v) { return __hip_atomic_fetch_add(p, v, __ATOMIC_RELAXED, __HIP_MEMORY_SCOPE_AGENT); }
__device__ __forceinline__ unsigned xb_xcc_id() { return (unsigned)__builtin_amdgcn_s_getreg((3 << 11) | 20) & 0xFu; }
#define XB_SPIN(cond, bar) do { unsigned _sp = 0; while (cond) { __builtin_amdgcn_s_sleep(1); \
    if ((++_sp & 255u) == 0u) { if (xb_ld(&(bar)[XB_TMO])) break; if (_sp > XB_SPIN_CAP) { atomicAdd(&(bar)[XB_TMO], 1u); break; } } } } while (0)
struct XcdBarrier { unsigned* bar; unsigned x; volatile LAS unsigned* st; };
__device__ __forceinline__ XcdBarrier xcd_barrier_post(unsigned* bar, volatile LAS unsigned* st) {
    XcdBarrier b; b.bar = bar; b.x = xb_xcc_id(); b.st = st;
    if (threadIdx.x == 0) (void)xb_add(&bar[XB_XCNT(b.x)], 1u);
    return b;
}
__device__ __forceinline__ void xcd_barrier_complete(unsigned* bar, unsigned x, unsigned& nloc, unsigned& nx) {
    const unsigned G = gridDim.x * gridDim.y * gridDim.z;
    unsigned sum, cnt, mine, sp = 0u;
    for (;;) {
        sum = 0u; cnt = 0u; mine = 0u;
#pragma unroll
        for (unsigned j = 0; j < 16; ++j) { const unsigned c = xb_ld(&bar[XB_XCNT(j)]); sum += c; cnt += (c > 0u) ? 1u : 0u; mine = (j == x) ? c : mine; }
        if (sum == G) break;
        __builtin_amdgcn_s_sleep(1);
        if ((++sp & 255u) == 0u) { if (xb_ld(&bar[XB_TMO])) break; if (sp > XB_SPIN_CAP) { atomicAdd(&bar[XB_TMO], 1u); break; } }
    }
    nloc = mine > 0u ? mine : 1u; nx = cnt > 0u ? cnt : 1u;
}
__device__ __forceinline__ void xcd_barrier(const XcdBarrier& b) {
    asm volatile("s_waitcnt vmcnt(0)" ::: "memory");
    __syncthreads();
    if (threadIdx.x == 0) {
        unsigned* bar = b.bar;
        __builtin_amdgcn_s_waitcnt(0);
        unsigned nloc = b.st[0], nx = b.st[1];
        if (nloc == 0u) { xcd_barrier_complete(bar, b.x, nloc, nx); b.st[0] = nloc; b.st[1] = nx; }
        const unsigned old = xb_add(&bar[XB_XSUB(b.x)], 1u);
        const unsigned gen = old / nloc;
        if (old + 1u == (gen + 1u) * nloc) {
            __builtin_amdgcn_fence(__ATOMIC_RELEASE, "agent");
            asm volatile("s_waitcnt vmcnt(0)" ::: "memory");
            const unsigned og = xb_add(&bar[XB_TOP], 1u);
            const unsigned tg = og / nx;
            if (og + 1u == (tg + 1u) * nx) xb_add(&bar[XB_TOPGEN], 1u);
            else XB_SPIN(xb_ld(&bar[XB_TOPGEN]) == tg, bar);
            __builtin_amdgcn_fence(__ATOMIC_ACQUIRE, "agent");
            xb_add(&bar[XB_XGEN(b.x)], 1u);
            asm volatile("s_waitcnt vmcnt(0)" ::: "memory");
        } else {
            XB_SPIN(xb_ld(&bar[XB_XGEN(b.x)]) == gen, bar);
            __builtin_amdgcn_fence(__ATOMIC_ACQUIRE, "agent");
            asm volatile("s_waitcnt vmcnt(0)" ::: "memory");
        }
    }
    __syncthreads();
}

namespace pg8 {
constexpr int BM = 256, BK = 64, HALF = 128, HTB = HALF * BK * 2, STAGE_BYTES = 8 * HTB, NXCD = 8, WGM = 8;
__host__ __device__ __forceinline__ int lds_byte(int r, int c) { const int st = (r >> 4) * 2 + (c >> 5), rr = r & 15, cc = c & 31, ob = rr * 64 + cc * 2; return st * 1024 + (ob ^ (((ob >> 9) & 1) << 5)); }
__host__ __device__ __forceinline__ void stage_rc(int b, int& R, int& C) { const int st = b / 1024, sb = b % 1024, swz = sb ^ (((sb >> 9) & 1) << 5); R = (st >> 1) * 16 + swz / 64; C = (st & 1) * 32 + (swz % 64) / 2; }
__host__ __device__ __forceinline__ int perm32(int rho) { const int n = rho >> 4, i = rho & 15; return 8 * (i >> 2) + 4 * n + (i & 3); }

struct Unit { int pm, pn, aux, lr; const char* a; const char* b; };
typedef f32x4 Acc[2][2][4][2];

template <class Epi, class Sched, bool ALIGN_EPI, bool SP2, int LD, int K, bool GATHER = false>
__device__ __forceinline__ void gemm_phase(LAS unsigned char* lds, const int tid, const Sched& S, const Epi& E) {
    constexpr int lda = LD, ldb = LD;
    const int wid = __builtin_amdgcn_readfirstlane(tid >> 6), lane = tid & 63, wr = wid >> 2, wc = wid & 3, fr = lane & 15, fq = lane >> 4;
    constexpr int nt = K / BK;
    unsigned voffA[2], voffB[2];
#pragma unroll
    for (int i = 0; i < 2; ++i) { int R, C; stage_rc(tid * 16 + i * 8192, R, C); const int Rb = Epi::PERM ? ((R & ~31) + perm32(R & 31)) : R;
        voffA[i] = (unsigned)(R * lda + C) * 2u; voffB[i] = (unsigned)(Rb * ldb + C) * 2u; }
    const size_t kstep = (size_t)(BK * 2);
    const size_t hstepA = (size_t)HALF * lda * 2, hstepB = (size_t)HALF * ldb * 2;
    const unsigned ldsw = (unsigned)wid * 1024u;
    const int aoff = lds_byte(wr * 64 + fr, fq * 8), boff = lds_byte(wc * 32 + fr, fq * 8);
#define PG8_SA(b, h) (((b) * 2 + (h)) * HTB)
#define PG8_SB(b, h) ((4 + (b) * 2 + (h)) * HTB)
#define PG8_STAGE(bufoff, gbase, voff) do { _Pragma("unroll") for (int _i = 0; _i < 2; ++_i) \
        __builtin_amdgcn_global_load_lds((const unsigned*)((const char*)(gbase) + (voff)[_i]), (LAS unsigned*)(lds + (bufoff) + ldsw + _i * 8192), 16, 0, 0); } while (0)
#define PG8_STAGE_A(bufoff, gbase, half, usenext) do { if constexpr (GATHER) { const unsigned _p = (usenext) ? vn[half] : vc[half]; unsigned _v[2]; _v[0] = (_p & 0xffffu) * (unsigned)(lda * 2) + gc2; _v[1] = (_p >> 16) * (unsigned)(lda * 2) + gc2; PG8_STAGE(bufoff, gbase, _v); } \
        else { PG8_STAGE(bufoff, (gbase) + (half) * hstepA, voffA); } } while (0)
#define PG8_LDA(dst, b, h) do { _Pragma("unroll") for (int m = 0; m < 4; ++m) _Pragma("unroll") for (int k = 0; k < 2; ++k) dst[m][k] = *(const LAS bf16x8*)(lds + PG8_SA(b, h) + aoff + m * 2048 + k * 1024); } while (0)
#define PG8_LDB(dst, b, h) do { _Pragma("unroll") for (int n = 0; n < 2; ++n) _Pragma("unroll") for (int k = 0; k < 2; ++k) dst[n][k] = *(const LAS bf16x8*)(lds + PG8_SB(b, h) + boff + n * 2048 + k * 1024); } while (0)
#define PG8_MMA(ai, bj, At, Bt) do { __builtin_amdgcn_s_setprio(1); _Pragma("unroll") for (int m = 0; m < 4; ++m) _Pragma("unroll") for (int n = 0; n < 2; ++n) _Pragma("unroll") for (int k = 0; k < 2; ++k) \
        acc[ai][bj][m][n] = __builtin_amdgcn_mfma_f32_16x16x32_bf16(Bt[n][k], At[m][k], acc[ai][bj][m][n], 0, 0, 0); __builtin_amdgcn_s_setprio(0); } while (0)
#define PG8_WAIT_V(n) asm volatile("s_waitcnt vmcnt(" #n ")" ::: "memory")
#define PG8_WAIT_L(n) asm volatile("s_waitcnt lgkmcnt(" #n ")" ::: "memory")
#define PG8_BAR __builtin_amdgcn_s_barrier()
#define PG8_SCHED __builtin_amdgcn_sched_barrier(0)
    Unit cur, nxt; int ui = 0;
    if (!S.next(0, cur)) return;
    Acc acc;
#pragma unroll
    for (int a = 0; a < 2; ++a)
#pragma unroll
        for (int b = 0; b < 2; ++b)
#pragma unroll
            for (int m = 0; m < 4; ++m)
#pragma unroll
                for (int n = 0; n < 2; ++n) acc[a][b][m][n] = (f32x4){0.f, 0.f, 0.f, 0.f};
    bf16x8 At[4][2], B0[2][2], B1[2][2];
    const char* cA = cur.a; const char* cB = cur.b;
    unsigned vc[2], vn[2], gc2 = 0;
    if constexpr (GATHER) { int R0, C0; stage_rc(tid * 16, R0, C0); gc2 = (unsigned)C0 * 2u;
#pragma unroll
        for (int h = 0; h < 2; ++h) { vc[h] = (unsigned)S.src_row(cur, 128 * h + R0) | ((unsigned)S.src_row(cur, 128 * h + R0 + 64) << 16); vn[h] = vc[h]; }
    }
    static_assert(SP2, "only the two-MFMA-blocks-per-barrier-pair loop is kept");
    {
        PG8_STAGE(PG8_SB(0, 0), cB, voffB); PG8_STAGE(PG8_SB(0, 1), cB + hstepB, voffB); PG8_STAGE_A(PG8_SA(0, 0), cA, 0, false); PG8_STAGE_A(PG8_SA(0, 1), cA, 1, false);
        if (wr == 1) PG8_BAR;
        PG8_WAIT_V(2); PG8_BAR;
        PG8_STAGE(PG8_SB(1, 0), cB + kstep, voffB); PG8_STAGE_A(PG8_SA(1, 0), cA + kstep, 0, false); PG8_STAGE(PG8_SB(1, 1), cB + hstepB + kstep, voffB);
        PG8_WAIT_V(6); PG8_BAR;
    }
    for (;;) {
        const bool has_next = S.next(ui + 1, nxt);
        const char* nA = has_next ? nxt.a : cA; const char* nB = has_next ? nxt.b : cB;
        if constexpr (GATHER) { if (has_next) { int R0, C0; stage_rc(tid * 16, R0, C0);
#pragma unroll
            for (int h = 0; h < 2; ++h) vn[h] = (unsigned)S.src_row(nxt, 128 * h + R0) | ((unsigned)S.src_row(nxt, 128 * h + R0 + 64) << 16); } }
#pragma nounroll
        for (int t = 0; t < nt; t += 2) {
            const bool last = (t == nt - 2);
            const char* a1 = cA + (size_t)(t + 1) * kstep;
            const char* a2 = last ? nA : cA + (size_t)(t + 2) * kstep; const char* b2 = last ? nB : cB + (size_t)(t + 2) * kstep;
            const char* a3 = a2 + kstep; const char* b3 = b2 + kstep;
            {
            PG8_LDB(B0, 0, 0); PG8_LDB(B1, 0, 1); PG8_SCHED; PG8_LDA(At, 0, 0); PG8_STAGE_A(PG8_SA(1, 1), a1, 1, false);
            PG8_WAIT_V(8); PG8_WAIT_L(0); PG8_BAR; PG8_MMA(0, 0, At, B0); PG8_MMA(0, 1, At, B1); PG8_BAR; PG8_SCHED;
            PG8_LDA(At, 0, 1); PG8_STAGE(PG8_SB(0, 0), b2, voffB); PG8_STAGE(PG8_SB(0, 1), b2 + hstepB, voffB); PG8_STAGE_A(PG8_SA(0, 0), a2, 0, last);
            PG8_WAIT_V(8); PG8_WAIT_L(0); PG8_BAR; PG8_MMA(1, 0, At, B0); PG8_MMA(1, 1, At, B1); PG8_BAR; PG8_SCHED;
            PG8_LDB(B0, 1, 0); PG8_LDB(B1, 1, 1); PG8_SCHED; PG8_LDA(At, 1, 0); PG8_STAGE_A(PG8_SA(0, 1), a2, 1, last);
            PG8_WAIT_V(8); PG8_WAIT_L(0); PG8_BAR; PG8_MMA(0, 0, At, B0); PG8_MMA(0, 1, At, B1); PG8_BAR; PG8_SCHED;
            PG8_LDA(At, 1, 1); PG8_STAGE(PG8_SB(1, 0), b3, voffB); PG8_STAGE(PG8_SB(1, 1), b3 + hstepB, voffB); PG8_STAGE_A(PG8_SA(1, 0), a3, 0, last);
            PG8_WAIT_V(8); PG8_WAIT_L(0); PG8_BAR; PG8_MMA(1, 0, At, B0); PG8_MMA(1, 1, At, B1); PG8_BAR; PG8_SCHED;
            }
        }
        if constexpr (ALIGN_EPI) { if (wr == 0) PG8_BAR; }
        E(acc, cur, wr, wc, fr, fq, lds);
        if (!has_next) break;
#pragma unroll
        for (int a = 0; a < 2; ++a)
#pragma unroll
            for (int b = 0; b < 2; ++b)
#pragma unroll
                for (int m = 0; m < 4; ++m)
#pragma unroll
                    for (int n = 0; n < 2; ++n) acc[a][b][m][n] = (f32x4){0.f, 0.f, 0.f, 0.f};
        cur = nxt; cA = nA; cB = nB; ++ui;
        if constexpr (GATHER) { vc[0] = vn[0]; vc[1] = vn[1]; }
        if constexpr (ALIGN_EPI) { if (wr == 1) PG8_BAR; }
    }
    PG8_WAIT_V(0);
    if constexpr (!ALIGN_EPI) { if (wr == 0) PG8_BAR; }
    PG8_BAR;
#undef PG8_SA
#undef PG8_SB
#undef PG8_STAGE
#undef PG8_STAGE_A
#undef PG8_LDA
#undef PG8_LDB
#undef PG8_MMA
#undef PG8_WAIT_V
#undef PG8_WAIT_L
#undef PG8_BAR
#undef PG8_SCHED
}

struct SchedDense {
    int nM, nN, nwg, G, c; const char* A; const char* B; size_t a_tile, b_tile; int pm_per_batch; size_t b_batch;
    __device__ __forceinline__ bool next(int i, Unit& u) const {
        const long L = (long)i * G + c; if (L >= nwg) return false;
        int wgid = (int)L; { const int q = nwg / NXCD, r = nwg % NXCD, xcd = wgid % NXCD, off = wgid / NXCD; wgid = (xcd < r ? xcd * (q + 1) : r * (q + 1) + (xcd - r) * q) + off; }
        const int nig = WGM * nN, gid = wgid / nig, fm = gid * WGM, gsz = (nM - fm) < WGM ? (nM - fm) : WGM;
        u.pm = fm + ((wgid % nig) % gsz); u.pn = (wgid % nig) / gsz; u.aux = 0;
        u.a = A + (size_t)u.pm * a_tile; u.b = B + (size_t)u.pn * b_tile + (size_t)(u.pm / pm_per_batch) * b_batch; return true;
    }
};
}
using pg8::Unit; using pg8::Acc;

struct EpiBf16 {
    static constexpr bool PERM = true;
    bf16_t* O; int ldc; size_t aux_stride; float scale;
    __device__ __forceinline__ void operator()(const Acc& acc, const Unit& u, int wr, int wc, int fr, int fq, LAS unsigned char*) const {
        bf16_t* base = O + (size_t)u.aux * aux_stride;
        const int row0 = u.pm * 256 + wr * 64 + fr, col0 = u.pn * 256 + wc * 32 + 8 * fq;
#pragma unroll
        for (int ai = 0; ai < 2; ++ai)
#pragma unroll
            for (int m = 0; m < 4; ++m) { bf16_t* rowp = base + (size_t)(row0 + ai * 128 + m * 16) * ldc + col0;
#pragma unroll
                for (int bj = 0; bj < 2; ++bj) { const f32x4 v0 = acc[ai][bj][m][0] * scale, v1 = acc[ai][bj][m][1] * scale;
                    u32x4 w; w.x = cvt_pk_bf16(v0[0], v0[1]); w.y = cvt_pk_bf16(v0[2], v0[3]); w.z = cvt_pk_bf16(v1[0], v1[1]); w.w = cvt_pk_bf16(v1[2], v1[3]);
                    *(u32x4*)(rowp + bj * 128) = w; } }
    }
};
struct EpiKV {
    static constexpr bool PERM = true;
    bf16_t* KB; bf16_t* VB;
    __device__ __forceinline__ void operator()(const Acc& acc, const Unit& u, int wr, int wc, int fr, int fq, LAS unsigned char*) const {
        bf16_t* base = (u.pn < 4 ? KB : VB) + (size_t)u.aux * MEMROWS * DM;
        const int row0 = u.pm * 256 + wr * 64 + fr, col0 = (u.pn & 3) * 256 + wc * 32 + 8 * fq;
#pragma unroll
        for (int ai = 0; ai < 2; ++ai)
#pragma unroll
            for (int m = 0; m < 4; ++m) { bf16_t* rowp = base + (size_t)(row0 + ai * 128 + m * 16) * DM + col0;
#pragma unroll
                for (int bj = 0; bj < 2; ++bj) { const f32x4 v0 = acc[ai][bj][m][0], v1 = acc[ai][bj][m][1];
                    u32x4 w; w.x = cvt_pk_bf16(v0[0], v0[1]); w.y = cvt_pk_bf16(v0[2], v0[3]); w.z = cvt_pk_bf16(v1[0], v1[1]); w.w = cvt_pk_bf16(v1[2], v1[3]);
                    *(u32x4*)(rowp + bj * 128) = w; } }
    }
};
struct EpiProj {
    static constexpr bool PERM = true;
    bf16_t* HG; bf16_t* QR; bf16_t* KF; bf16_t* V; const float* rstd; const f32x2* CS; unsigned* kmax;
    __device__ __forceinline__ void operator()(const Acc& acc, const Unit& u, int wr, int wc, int fr, int fq, LAS unsigned char*) const {
        const int row0 = u.pm * 256 + wr * 64 + fr;
        if (u.pn < 8 || u.pn >= 12) {
            bf16_t* base; int ldc, colt;
            if (u.pn < 8) { base = HG; ldc = 2048; colt = u.pn * 256; } else { base = V; ldc = 512; colt = (u.pn - 12) * 256; }
            const int col0 = colt + wc * 32 + 8 * fq;
#pragma unroll
            for (int ai = 0; ai < 2; ++ai)
#pragma unroll
                for (int m = 0; m < 4; ++m) { const int row = row0 + ai * 128 + m * 16; const float rs = rstd[row]; bf16_t* rowp = base + (size_t)row * ldc + col0;
#pragma unroll
                    for (int bj = 0; bj < 2; ++bj) { const f32x4 v0 = acc[ai][bj][m][0] * rs, v1 = acc[ai][bj][m][1] * rs;
                        u32x4 w; w.x = cvt_pk_bf16(v0[0], v0[1]); w.y = cvt_pk_bf16(v0[2], v0[3]); w.z = cvt_pk_bf16(v1[0], v1[1]); w.w = cvt_pk_bf16(v1[2], v1[3]);
                        *(u32x4*)(rowp + bj * 128) = w; } }
        } else {
            const bool isk = u.pn >= 10; const int head = 4 * (u.pn & 1) + wc;
            float kn2max = 0.f;
#pragma unroll
            for (int ai = 0; ai < 2; ++ai)
#pragma unroll
                for (int m = 0; m < 4; ++m) { const int row = row0 + ai * 128 + m * 16; const float rs = rstd[row] * (isk ? 1.f : 0.125f * LOG2E);
                    const f32x4* cs = (const f32x4*)(CS + (size_t)row * 32 + 8 * fq); const f32x4 c0 = cs[0], c1 = cs[1], c2 = cs[2], c3 = cs[3];
                    const float co[8] = {c0.x, c0.z, c1.x, c1.z, c2.x, c2.z, c3.x, c3.z}, si[8] = {c0.y, c0.w, c1.y, c1.w, c2.y, c2.w, c3.y, c3.w};
                    float lo[8], hi[8];
#pragma unroll
                    for (int n = 0; n < 2; ++n)
#pragma unroll
                        for (int e = 0; e < 4; ++e) { const int j = 4 * n + e; const float x1 = acc[ai][0][m][n][e] * rs, x2 = acc[ai][1][m][n][e] * rs; lo[j] = x1 * co[j] - x2 * si[j]; hi[j] = x2 * co[j] + x1 * si[j]; }
                    u32x4 wl, wh; wl.x = cvt_pk_bf16(lo[0], lo[1]); wl.y = cvt_pk_bf16(lo[2], lo[3]); wl.z = cvt_pk_bf16(lo[4], lo[5]); wl.w = cvt_pk_bf16(lo[6], lo[7]);
                    wh.x = cvt_pk_bf16(hi[0], hi[1]); wh.y = cvt_pk_bf16(hi[2], hi[3]); wh.z = cvt_pk_bf16(hi[4], hi[5]); wh.w = cvt_pk_bf16(hi[6], hi[7]);
                    if (!isk) { bf16_t* rowp = QR + (size_t)row * 512 + head * 64 + 8 * fq; *(u32x4*)rowp = wl; *(u32x4*)(rowp + 32) = wh; }
                    else { { float n2 = 0.f;
#pragma unroll
                          for (int j = 0; j < 8; ++j) n2 += lo[j] * lo[j] + hi[j] * hi[j];
                          n2 += __shfl_xor(n2, 16); n2 += __shfl_xor(n2, 32); kn2max = fmaxf(kn2max, n2); }
                        const int b = row >> 13, s = row & (SEQ - 1); const size_t bh = (size_t)(b * ATH + head) * (SEQ * 64);
#pragma unroll
                        for (int pat = 0; pat < 3; ++pat) { const int D = pat == 0 ? 1 : (pat == 1 ? 4 : 16), sh = pat * 2; const int r = s & (D - 1), p = s >> sh, T = p >> 5, k5 = p & 31;
                            const int rho = (k5 & 19) | ((k5 & 4) << 1) | ((k5 & 8) >> 1);
                            bf16_t* kf = KF + (size_t)pat * (MT * 512) + bh + ((size_t)(r * (SEQ / 32 >> sh) + T) * 4) * 512;
                            *(u32x4*)(kf + ((fq >> 1) * 64 + rho + 32 * (fq & 1)) * 8) = wl; *(u32x4*)(kf + ((2 + (fq >> 1)) * 64 + rho + 32 * (fq & 1)) * 8) = wh; }
                    } }
            if (isk) { kn2max = fmaxf(kn2max, __shfl_xor(kn2max, 1)); kn2max = fmaxf(kn2max, __shfl_xor(kn2max, 2)); kn2max = fmaxf(kn2max, __shfl_xor(kn2max, 4)); kn2max = fmaxf(kn2max, __shfl_xor(kn2max, 8));
                if (fr == 0 && fq == 0) __hip_atomic_fetch_max(kmax + ((u.pm >> 5) * ATH + head), __float_as_uint(kn2max), __ATOMIC_RELAXED, __HIP_MEMORY_SCOPE_AGENT); }
        }
    }
};
struct EpiResAdd {
    static constexpr bool PERM = false;
    const float* Xs; float* X; float dm;
    __device__ __forceinline__ void operator()(const Acc& acc, const Unit& u, int wr, int wc, int fr, int fq, LAS unsigned char*) const {
        const int row0 = u.pm * 256 + wr * 64 + fr, col0 = u.pn * 256 + wc * 32 + 4 * fq;
#pragma unroll
        for (int ai = 0; ai < 2; ++ai) {
            f32x4 xv[4][2][2];
#pragma unroll
            for (int m = 0; m < 4; ++m) { const size_t off = (size_t)(row0 + ai * 128 + m * 16) * DM + col0;
#pragma unroll
                for (int bj = 0; bj < 2; ++bj)
#pragma unroll
                    for (int n = 0; n < 2; ++n) xv[m][bj][n] = *(const f32x4*)(Xs + off + bj * 128 + n * 16); }
            asm volatile("" ::: "memory");
#pragma unroll
            for (int m = 0; m < 4; ++m) { const size_t off = (size_t)(row0 + ai * 128 + m * 16) * DM + col0;
#pragma unroll
                for (int bj = 0; bj < 2; ++bj)
#pragma unroll
                    for (int n = 0; n < 2; ++n) *(f32x4*)(X + off + bj * 128 + n * 16) = xv[m][bj][n] + acc[ai][bj][m][n] * dm; }
        }
    }
};
struct EpiSoftmax {
    static constexpr bool PERM = false;
    bf16_t* P; const float* rstd;
    __device__ __forceinline__ void operator()(Acc& acc, const Unit& u, int wr, int wc, int fr, int fq, LAS unsigned char* lds) const {
        LAS f32x2* EX = (LAS f32x2*)(lds + SPARE_OFF);
        const int row0 = u.pm * 256 + wr * 64 + fr;
        float mw[2][4];
#pragma unroll
        for (int ai = 0; ai < 2; ++ai)
#pragma unroll
            for (int m = 0; m < 4; ++m) {
                const float rs = rstd[row0 + ai * 128 + m * 16];
                float mx = -3.0e38f;
#pragma unroll
                for (int bj = 0; bj < 2; ++bj)
#pragma unroll
                    for (int n = 0; n < 2; ++n) { f32x4 v = acc[ai][bj][m][n] * rs; acc[ai][bj][m][n] = v; mx = fmaxf(mx, fmaxf(fmaxf(v[0], v[1]), fmaxf(v[2], v[3]))); }
                mx = fmaxf(mx, __shfl_xor(mx, 16)); mx = fmaxf(mx, __shfl_xor(mx, 32));
                float sm = 0.f;
#pragma unroll
                for (int bj = 0; bj < 2; ++bj)
#pragma unroll
                    for (int n = 0; n < 2; ++n) { f32x4 v = acc[ai][bj][m][n]; v[0] = __expf(v[0] - mx); v[1] = __expf(v[1] - mx); v[2] = __expf(v[2] - mx); v[3] = __expf(v[3] - mx);
                        acc[ai][bj][m][n] = v; sm += (v[0] + v[1]) + (v[2] + v[3]); }
                sm += __shfl_xor(sm, 16); sm += __shfl_xor(sm, 32);
                mw[ai][m] = mx;
                if (fq == 0) EX[(ai * 128 + wr * 64 + m * 16 + fr) * 4 + wc] = (f32x2){mx, sm};
            }
        asm volatile("s_waitcnt lgkmcnt(0)" ::: "memory"); __builtin_amdgcn_s_barrier(); asm volatile("" ::: "memory");
#pragma unroll
        for (int ai = 0; ai < 2; ++ai)
#pragma unroll
            for (int m = 0; m < 4; ++m) {
                const int rl = ai * 128 + wr * 64 + m * 16 + fr;
                const f32x2 e0 = EX[rl * 4 + 0], e1 = EX[rl * 4 + 1], e2 = EX[rl * 4 + 2], e3 = EX[rl * 4 + 3];
                const float M = fmaxf(fmaxf(e0.x, e1.x), fmaxf(e2.x, e3.x));
                const float Ls = e0.y * __expf(e0.x - M) + e1.y * __expf(e1.x - M) + e2.y * __expf(e2.x - M) + e3.y * __expf(e3.x - M);
                const float f = __expf(mw[ai][m] - M) / Ls;
                bf16_t* rowp = P + (size_t)(row0 + ai * 128 + m * 16) * DM + u.pn * 256 + wc * 32 + 4 * fq;
#pragma unroll
                for (int bj = 0; bj < 2; ++bj)
#pragma unroll
                    for (int n = 0; n < 2; ++n) { const f32x4 v = acc[ai][bj][m][n] * f; u32x2 w; w.x = cvt_pk_bf16(v[0], v[1]); w.y = cvt_pk_bf16(v[2], v[3]);
                        *(u32x2*)(rowp + bj * 128 + n * 16) = w; }
            }
        asm volatile("s_waitcnt lgkmcnt(0)" ::: "memory"); __builtin_amdgcn_s_barrier(); asm volatile("" ::: "memory");
    }
};
struct EpiMoe1 {
    static constexpr bool PERM = true;
    bf16_t* ACTB; const float* srs; const float* sgw;
    __device__ __forceinline__ void operator()(const Acc& acc, const Unit& u, int wr, int wc, int fr, int fq, LAS unsigned char*) const {
        const int row0 = u.pm * 256 + wr * 64 + fr, col0 = u.pn * 128 + wc * 32 + 8 * fq;
#pragma unroll
        for (int ai = 0; ai < 2; ++ai)
#pragma unroll
            for (int m = 0; m < 4; ++m) { const int row = row0 + ai * 128 + m * 16; const int lrow = u.aux * 16384 + u.lr + wr * 64 + fr + ai * 128 + m * 16; const float rs = srs[lrow], gw = sgw[lrow] * rs;
                float o[8];
#pragma unroll
                for (int n = 0; n < 2; ++n)
#pragma unroll
                    for (int j = 0; j < 4; ++j) { const float g = acc[ai][0][m][n][j] * rs, up = acc[ai][1][m][n][j]; o[n * 4 + j] = g * sigmoidf_(g) * up * gw; }
                u32x4 w; w.x = cvt_pk_bf16(o[0], o[1]); w.y = cvt_pk_bf16(o[2], o[3]); w.z = cvt_pk_bf16(o[4], o[5]); w.w = cvt_pk_bf16(o[6], o[7]);
                *(u32x4*)(ACTB + (size_t)row * EFF + col0) = w; }
    }
};

struct Args { const void* in[20]; float* out; unsigned char* ws; int ph_lo, ph_hi; };
struct Frame {
    LAS unsigned char* lds; volatile LAS unsigned* MISC; gu32* ctl;
    int tid, lane, wave, vcu, G;
    unsigned char* ws; float* out; size_t z; int dry;
};

__device__ __forceinline__ void transpose_item(const float* W, int N, const float* scale, bf16_t* WT, int ldt, int row_base, int k0, int n0, LAS float* scr, int lane) {
    f32x4 v[8];
#pragma unroll
    for (int i = 0; i < 8; ++i) v[i] = *(const GAS f32x4*)(W + (size_t)(k0 + 8 * i + (lane >> 3)) * N + n0 + 4 * (lane & 7));
#pragma unroll
    for (int i = 0; i < 8; ++i) { const int kk = 8 * i + (lane >> 3); f32x4 x = v[i]; if (scale) x = x * scale[k0 + kk]; LAS float* d = scr + kk * 33 + 4 * (lane & 7); d[0] = x.x; d[1] = x.y; d[2] = x.z; d[3] = x.w; }
    LDS_WAIT(); asm volatile("" ::: "memory");
    const int c = lane & 7;
#pragma unroll
    for (int j = 0; j < 4; ++j) { const int n = (lane >> 3) + 8 * j; const LAS float* s = scr + (8 * c) * 33 + n;
        u32x4 o; o.x = pk2(s[0 * 33], s[1 * 33]); o.y = pk2(s[2 * 33], s[3 * 33]); o.z = pk2(s[4 * 33], s[5 * 33]); o.w = pk2(s[6 * 33], s[7 * 33]);
        *(GAS u32x4*)(WT + (size_t)(row_base + n0 + n) * ldt + k0 + 8 * c) = o; }
    LDS_WAIT(); asm volatile("" ::: "memory");
}
__device__ __forceinline__ void transpose_mat_item(const float* W, int K, int N, const float* scale, bf16_t* WT, int mode, int it, LAS float* scr, int lane) {
    const int nblk = N / 32, kb = it / nblk, nb = it % nblk, k0 = 64 * kb, n0 = 32 * nb;
    int row_base = 0;
    if (mode == 1 || mode == 2) row_base = 256 * (n0 / 128) + (n0 % 128) + (mode == 2 ? 128 : 0) - n0;
    if (mode == 3 && n0 >= 2048 && n0 < 3072) {
        const int blk = (n0 - 2048) / 512, np = (n0 - 2048) % 512, head = np / 64, d = np % 64;
        row_base = 2048 + blk * 512 + (head / 4) * 256 + 128 * (d / 32) + 32 * (head % 4) + (d % 32) - n0; }
    transpose_item(W, N, scale, WT, K, row_base, k0, n0, scr, lane);
}

__device__ __forceinline__ float row_norm_prep(const float* xrow, bf16_t* xb_row, float* copy_row, int lane) {
    const GAS f32x4* xr = (const GAS f32x4*)xrow + lane;
    f32x4 v[4]; float s = 0.f;
#pragma unroll
    for (int j = 0; j < 4; ++j) { v[j] = xr[64 * j]; s += (v[j].x * v[j].x + v[j].y * v[j].y) + (v[j].z * v[j].z + v[j].w * v[j].w); }
    const float rstd = 1.f / sqrtf(wave_sum(s) * (1.f / DM) + EPS);
    GAS u32x2* o8 = (GAS u32x2*)xb_row + lane;
#pragma unroll
    for (int j = 0; j < 4; ++j) { u32x2 w; w.x = pk2(v[j].x, v[j].y); w.y = pk2(v[j].z, v[j].w); o8[64 * j] = w; }
    if (copy_row) { GAS f32x4* c = (GAS f32x4*)copy_row + lane;
#pragma unroll
        for (int j = 0; j < 4; ++j) c[64 * j] = v[j]; }
    return rstd;
}

__constant__ double INV_FREQ[32] = {1.0, 0.7498942093324559, 0.5623413251903491, 0.4216965034285822, 0.31622776601683794, 0.23713737056616552, 0.1778279410038923, 0.1333521432163324,
    0.1, 0.07498942093324558, 0.05623413251903491, 0.042169650342858224, 0.03162277660168379, 0.023713737056616554, 0.01778279410038923, 0.01333521432163324,
    0.01, 0.007498942093324558, 0.005623413251903491, 0.004216965034285823, 0.0031622776601683794, 0.0023713737056616554, 0.0017782794100389228, 0.001333521432163324,
    0.001, 0.0007498942093324559, 0.0005623413251903491, 0.00042169650342858224, 0.00031622776601683794, 0.00023713737056616554, 0.00017782794100389227, 0.0001333521432163324};


#define IN_F(i) ((const float*)((const char*)a.in[i] + F.z))
__device__ __forceinline__ float hg_lb(const Frame& F, const Args& a, int l, int c) { if (l == 0) return 0.f; const float* h = IN_F(5); return sigmoidf_(h[HGW + c] - h[c]); }
__device__ __forceinline__ void conv_small_item(Frame& F, const Args& a, int l, int r, LAS float* scr) {
    unsigned char* ws = F.ws; const int lane = F.lane;
    if (r < 1792) { transpose_mat_item(IN_F(4) + (size_t)l * DM * NIN, DM, NIN, IN_F(3) + l * DM, (bf16_t*)(ws + WS_WIN) + (size_t)l * NIN * DM, 3, r, scr, lane); return; } r -= 1792;
    if (r < 512) { transpose_mat_item(IN_F(7) + (size_t)l * DM * DM, DM, DM, nullptr, (bf16_t*)(ws + WS_WOUT) + (size_t)l * DM * DM, 0, r, scr, lane); return; } r -= 512;
    if (r < 1024) { transpose_mat_item(IN_F(11) + (size_t)l * DM * 2 * DM, DM, 2 * DM, nullptr, (bf16_t*)(ws + WS_WKVT) + (size_t)l * 2 * DM * DM, 0, r, scr, lane); return; } r -= 1024;
    transpose_mat_item(IN_F(12) + (size_t)l * DM * DM, DM, DM, nullptr, (bf16_t*)(ws + WS_WOT) + (size_t)l * DM * DM, 0, r, scr, lane);
}
__device__ __forceinline__ void conv_wq_row(Frame& F, const Args& a, int r) {
    const int lane = F.lane; const float sc = IN_F(8)[r] * 0.0625f;
    const GAS f32x4* src = (const GAS f32x4*)(IN_F(10) + (size_t)r * DM) + lane; GAS u32x2* dst = (GAS u32x2*)((bf16_t*)(F.ws + WS_WQS) + (size_t)r * DM) + lane;
#pragma unroll
    for (int j = 0; j < 4; ++j) { const f32x4 v = src[64 * j] * sc; u32x2 w; w.x = pk2(v.x, v.y); w.y = pk2(v.z, v.w); dst[64 * j] = w; }
}
__device__ __forceinline__ void conv_small_l1(Frame& F, const Args& a, int wi, int nw) {
    LAS float* scr = (LAS float*)(F.lds + F.wave * 16384);
    for (int it = wi; it < 2816; it += nw) conv_small_item(F, a, 1, it < 2304 ? it : it + 1024, scr);
    for (int r = wi; r < DM; r += nw) conv_wq_row(F, a, DM + r);
}
__device__ __forceinline__ void ph_init(Frame& F, const Args& a) {
    LAS float* scr = (LAS float*)(F.lds + F.wave * 16384);
    const int gw = F.vcu * NWAVES + F.wave, NGW = F.G * NWAVES, lane = F.lane;
    unsigned char* ws = F.ws;
    for (int it = gw; it < 3840 + 1024; it += NGW) {
        if (it < 3840) conv_small_item(F, a, 0, it, scr); else conv_small_item(F, a, 1, 2304 + (it - 3840), scr); }
    for (int r = gw; r < DM; r += NGW) conv_wq_row(F, a, r);
    for (int r = gw; r < MEMROWS; r += NGW) {
        const GAS f32x4* xr = (const GAS f32x4*)(IN_F(1) + (size_t)r * DM) + lane;
        f32x4 v[4]; float s = 0.f;
#pragma unroll
        for (int j = 0; j < 4; ++j) { v[j] = xr[64 * j]; s += (v[j].x * v[j].x + v[j].y * v[j].y) + (v[j].z * v[j].z + v[j].w * v[j].w); }
        const float rstd = 1.f / sqrtf(wave_sum(s) * (1.f / DM) + EPS);
        for (int l = 0; l < DEPTH; ++l) {
            const GAS f32x4* g = (const GAS f32x4*)(IN_F(9) + l * DM) + lane; GAS u32x2* dst = (GAS u32x2*)((bf16_t*)(ws + WS_MEMN) + ((size_t)l * MEMROWS + r) * DM) + lane;
#pragma unroll
            for (int j = 0; j < 4; ++j) { const f32x4 o = v[j] * rstd * g[64 * j]; u32x2 w; w.x = pk2(o.x, o.y); w.y = pk2(o.z, o.w); dst[64 * j] = w; }
        }
    }
    for (int r = gw; r < MT; r += NGW) {
        const float rs = row_norm_prep(IN_F(0) + (size_t)r * DM, (bf16_t*)(ws + WS_XB) + (size_t)r * DM, nullptr, lane);
        if (lane == 0) ((float*)(ws + WS_RSTD))[r] = rs;
    }
    for (int i = (F.vcu * NTHR + F.tid); i < DEPTH * HGW; i += F.G * NTHR) ((float*)(ws + WS_LBT))[i] = hg_lb(F, a, i / HGW, i % HGW);
    { const int* pos = (const int*)((const char*)a.in[2] + F.z);
      for (int i = (F.vcu * NTHR + F.tid); i < MT * 32; i += F.G * NTHR) { const double ang = (double)pos[i >> 5] * INV_FREQ[i & 31]; double rev = ang * 0.15915494309189535; rev = rev - __builtin_floor(rev);
          const float fr = (float)rev; ((f32x2*)(ws + WS_CS))[i] = (f32x2){__builtin_amdgcn_cosf(fr), __builtin_amdgcn_sinf(fr)}; } }
    for (int i = (F.vcu * NTHR + F.tid); i < DEPTH * 32 * DM; i += F.G * NTHR) {
        const int l = i / (32 * DM), n = (i / DM) % 32, k = i % DM;
        float w = 0.f;
        if (n < 4) w = IN_F(14)[((size_t)l * DM + k) * 4 + n]; else if (n < 20) w = IN_F(15)[((size_t)l * DM + k) * 16 + (n - 4)];
        w *= IN_F(13)[l * DM + k];
        const unsigned hi = f2bf(w); const float rem = w - bf2f((unsigned short)hi);
        ((bf16_t*)(ws + WS_WR))[i] = (bf16_t)hi; ((bf16_t*)(ws + WS_WR) + DEPTH * 32 * DM)[i] = (bf16_t)f2bf(rem);
    }
}

struct SchedKV {
    int G, c; const char* memn; const char* wkvt;
    __device__ __forceinline__ bool next(int i, Unit& u) const {
        const int L = i * G + c; if (L >= 32) return false;
        const int l = L >> 4; u.pm = (L >> 3) & 1; u.pn = L & 7; u.aux = l;
        u.a = memn + ((size_t)l * MEMROWS + u.pm * 256) * DM * 2; u.b = wkvt + ((size_t)l * 2 * DM + u.pn * 256) * DM * 2; return true;
    }
};
struct SchedFold {
    int G, c; const char* kb; const char* vb; const char* wqs; const char* wot;
    __device__ __forceinline__ bool next(int i, Unit& u) const {
        const int L = i * G + c; if (L >= 128) return false;
        const int ty = L >> 6, l = (L >> 5) & 1, b = (L >> 4) & 1, h = (L >> 2) & 3, t = L & 3; u.aux = ty * 4 + l * 2 + b;
        if (ty == 0) { u.pm = h; u.pn = t; u.a = kb + (((size_t)l * MEMROWS + b * 256) * DM + h * 256) * 2; u.b = wqs + (((size_t)l * DM + t * 256) * DM + h * 256) * 2; }
        else { u.pm = t; u.pn = h; u.a = wot + (((size_t)l * DM + t * 256) * DM + h * 256) * 2; u.b = vb + (((size_t)l * MEMROWS + b * 256) * DM + h * 256) * 2; }
        return true;
    }
};
struct SchedMoe {
    int G, c, kdim; volatile LAS unsigned* tb; const char* A; const char* B; const int* perm2; const unsigned* cnt; bool gather;
    __device__ __forceinline__ bool next(int i, Unit& u) const {
        const int L = i * G + c; const int total = (int)tb[16] * 4; if (L >= total) return false;
        const int mt = L >> 2; u.pm = mt; u.pn = L & 3; int e = 0;
#pragma unroll
        for (int j = 1; j < 16; ++j) e += (mt >= (int)tb[j]) ? 1 : 0;
        u.aux = e; u.lr = (mt - (int)tb[e]) * 256; u.a = gather ? A : A + (size_t)mt * 256 * kdim * 2; u.b = B + ((size_t)e * 1024 + u.pn * 256) * kdim * 2; return true;
    }
    __device__ __forceinline__ int src_row(const Unit& u, int r) const { const int lrow = u.lr + r; const int n = (int)cnt[64 * u.aux]; return lrow < n ? perm2[u.aux * 16384 + lrow] : 0; }
};

__device__ __forceinline__ void vf_unit(Frame& F, int unit) {
    unsigned char* ws = F.ws; const int tid = F.tid;
    const int tb = unit >> 3, h = unit & 7, b = tb >> 4, s_base = (tb & 15) * 512;
    LAS unsigned short* Vl = (LAS unsigned short*)F.lds;
    const bf16_t* V = (const bf16_t*)(ws + A_V) + ((size_t)b * SEQ + s_base) * 512 + h * 64;
#pragma unroll
    for (int p = 0; p < 8; ++p) { const int c = p * 512 + tid, row = c >> 3, ch = c & 7; *(LAS u32x4*)(Vl + row * 72 + ch * 8) = *(const GAS u32x4*)(V + (size_t)row * 512 + ch * 8); }
    __syncthreads();
    const size_t bh = (size_t)(b * ATH + h) * (SEQ * 64);
    for (int it = 0; it < 24; ++it) { const int pc = it * 512 + tid, tile = pc >> 8, q = pc & 255, s = q >> 7, mt = (q >> 6) & 1, ln = q & 63, dim = (ln & 31) + 32 * mt, hi = ln >> 5;
        const int pat = tile >> 4, j16 = tile & 15, sh = pat * 2, D = 1 << sh;
        const int TPC = 16 >> sh, r = j16 / TPC, tl = j16 % TPC;
        const int pl = tl * 32 + 16 * s + 8 * hi;
        unsigned w[4];
#pragma unroll
        for (int jj = 0; jj < 4; ++jj) { const int t0 = ((pl + 2 * jj) << sh) + r, t1 = ((pl + 2 * jj + 1) << sh) + r; w[jj] = (unsigned)Vl[t0 * 72 + dim] | ((unsigned)Vl[t1 * 72 + dim] << 16); }
        const int T = (s_base >> sh >> 5) + tl;
        bf16_t* vf = (bf16_t*)(ws + A_VT1) + (size_t)pat * (MT * 512) + bh + ((size_t)(r * (SEQ / 32 >> sh) + T) * 4 + s * 2 + mt) * 512 + ln * 8;
        *(GAS u32x4*)vf = (u32x4){w[0], w[1], w[2], w[3]}; }
    __syncthreads();
}

__device__ __forceinline__ void hg_build_b(Frame& F, int l, int h, const u32x4 z0, const u32x4 z1, int k0, float (&bb)[16], float (&kk)[16]) {
    const int tid = F.tid, lane = F.lane, wave = F.wave, tl = lane >> 3;
    LAS float* WT = (LAS float*)F.lds; LAS float* REF = (LAS float*)(F.lds + 4096);
    const unsigned zz[8] = {z0.x, z0.y, z0.z, z0.w, z1.x, z1.y, z1.z, z1.w};
    float lbv[16];
#pragma unroll
    for (int i = 0; i < 16; i += 4) { const f32x4 t4 = *(const GAS f32x4*)((const float*)(F.ws + WS_LBT) + l * HGW + h * 128 + k0 + i); lbv[i] = t4.x; lbv[i + 1] = t4.y; lbv[i + 2] = t4.z; lbv[i + 3] = t4.w; }
#pragma unroll
    for (int i = 0; i < 16; ++i) { const float z = (i & 1) ? bfhi(zz[i >> 1]) : bflo(zz[i >> 1]); const float lb = lbv[i];
        const float e = ex2(-LOG2E * z), sg = __builtin_amdgcn_rcpf(1.f + e), f = lb + (1.f - lb) * sg; bb[i] = __builtin_amdgcn_logf(f); kk[i] = (1.f - lb) * (e * sg); }
#pragma unroll
    for (int i = 0; i < 16; ++i) { float x = bb[i]; float y;
        y = __shfl_up(x, 8); if (tl >= 1) x += y;
        y = __shfl_up(x, 16); if (tl >= 2) x += y;
        y = __shfl_up(x, 32); if (tl >= 4) x += y;
        bb[i] = x; }
    if (tl == 7) {
#pragma unroll
        for (int i = 0; i < 16; i += 4) *(LAS f32x4*)(WT + wave * 128 + k0 + i) = (f32x4){bb[i], bb[i + 1], bb[i + 2], bb[i + 3]}; }
    __syncthreads();
    for (int w = 0; w < wave; ++w) {
#pragma unroll
        for (int i = 0; i < 16; i += 4) { const f32x4 p = *(const LAS f32x4*)(WT + w * 128 + k0 + i); bb[i] += p.x; bb[i + 1] += p.y; bb[i + 2] += p.z; bb[i + 3] += p.w; } }
    if (tl == 7 && (wave & 1)) {
#pragma unroll
        for (int i = 0; i < 16; i += 4) *(LAS f32x4*)(REF + (wave >> 1) * 128 + k0 + i) = (f32x4){bb[i], bb[i + 1], bb[i + 2], bb[i + 3]}; }
    __syncthreads();
    (void)tid;
}
__device__ __forceinline__ void st_row16(LAS unsigned char* base, int byteoff, const float (&v)[16]) {
    u32x4 w0, w1; w0.x = cvt_pk_bf16(v[0], v[1]); w0.y = cvt_pk_bf16(v[2], v[3]); w0.z = cvt_pk_bf16(v[4], v[5]); w0.w = cvt_pk_bf16(v[6], v[7]); w1.x = cvt_pk_bf16(v[8], v[9]); w1.y = cvt_pk_bf16(v[10], v[11]); w1.z = cvt_pk_bf16(v[12], v[13]); w1.w = cvt_pk_bf16(v[14], v[15]);
    *(LAS u32x4*)(base + byteoff) = w0; *(LAS u32x4*)(base + byteoff + 16) = w1;
}
constexpr int HL_RED = 6144, HL_QD = 8192, HL_KD = 25600, HL_QE = 43008, HL_Q1 = 60416, HL_K1 = 69120, HL_Q2 = 77824, HL_K2 = 86528, HL_VT = 95232, HL_SC = 113664;
constexpr int HA_KT = 8192, HA_VT = 26624;
constexpr int RS128 = 272, RS64 = 144;

struct HgIn { u32x4 z0, z1, q0, q1, v0, v1; };
template <bool NEEDQ> __device__ __forceinline__ HgIn hg_load(Frame& F, int unit) {
    HgIn R;
    const int b = unit >> 9, h = (unit >> 7) & 3, c = unit & 127; const int row0 = b * SEQ + c * CHUNK, t = F.tid >> 3, k0 = (F.tid & 7) * 16;
    const bf16_t* rowp = (const bf16_t*)(F.ws + A_HG) + (size_t)(row0 + t) * 2048 + h * 128 + k0;
    R.z0 = *(const GAS u32x4*)(rowp + 512); R.z1 = *(const GAS u32x4*)(rowp + 512 + 8); R.v0 = *(const GAS u32x4*)(rowp + 1024); R.v1 = *(const GAS u32x4*)(rowp + 1024 + 8);
    if (NEEDQ) { R.q0 = *(const GAS u32x4*)(rowp); R.q1 = *(const GAS u32x4*)(rowp + 8); } else { R.q0 = R.z0; R.q1 = R.z1; }
    return R;
}
__device__ __forceinline__ void hg_a2_unit(Frame& F, const Args& a, int l, int unit, const HgIn& R) {
    unsigned char* ws = F.ws; const int tid = F.tid, lane = F.lane, wave = F.wave;
    const int h = (unit >> 7) & 3;
    const int t = tid >> 3, k0 = (tid & 7) * 16;
    const u32x4 v0 = R.v0, v1 = R.v1;
    float bb[16], kk[16];
    hg_build_b(F, l, h, R.z0, R.z1, k0, bb, kk);
    const LAS float* REF = (const LAS float*)(F.lds + 4096);
    LAS unsigned short* KT = (LAS unsigned short*)(F.lds + HA_KT); LAS unsigned short* VT = (LAS unsigned short*)(F.lds + HA_VT);
    const unsigned vv[8] = {v0.x, v0.y, v0.z, v0.w, v1.x, v1.y, v1.z, v1.w};
#pragma unroll
    for (int i = 0; i < 16; ++i) { const float b63 = REF[3 * 128 + k0 + i];
        KT[(k0 + i) * (RS64 / 2) + t] = (unsigned short)f2bf(kk[i] * ex2(b63 - bb[i]));
        VT[(k0 + i) * (RS64 / 2) + t] = (unsigned short)((i & 1) ? (vv[i >> 1] >> 16) : (vv[i >> 1] & 0xffffu)); }
    if (tid < 128) ((float*)(ws + A_DECAY))[(size_t)unit * 128 + tid] = ex2(REF[3 * 128 + tid]);
    __syncthreads();
    { const int fr = lane & 15, g = lane >> 4;
      bf16x8 af[2];
#pragma unroll
      for (int ks = 0; ks < 2; ++ks) af[ks] = *(const LAS bf16x8*)(F.lds + HA_KT + (wave * 16 + fr) * RS64 + (32 * ks + 8 * g) * 2);
      bf16_t* st = (bf16_t*)(ws + A_STATE) + (size_t)unit * 16384;
#pragma unroll
      for (int vt = 0; vt < 8; ++vt) { f32x4 acc = {0.f, 0.f, 0.f, 0.f};
#pragma unroll
          for (int ks = 0; ks < 2; ++ks) { const bf16x8 bf = *(const LAS bf16x8*)(F.lds + HA_VT + (vt * 16 + fr) * RS64 + (32 * ks + 8 * g) * 2); acc = __builtin_amdgcn_mfma_f32_16x16x32_bf16(af[ks], bf, acc, 0, 0, 0); }
          u32x2 w; w.x = cvt_pk_bf16(acc[0], acc[1]); w.y = cvt_pk_bf16(acc[2], acc[3]);
          *(GAS u32x2*)(st + (vt * 16 + fr) * 128 + wave * 16 + 4 * g) = w; } }
    __syncthreads();
}

template <int STOP> __device__ __forceinline__ void hg_c2_unit(Frame& F, const Args& a, int l, int unit, const HgIn& R) {
    unsigned char* ws = F.ws; const int tid = F.tid, lane = F.lane, wave = F.wave;
    const int b = unit >> 9, h = (unit >> 7) & 3, c = unit & 127; const int row0 = b * SEQ + c * CHUNK;
    const int t = tid >> 3, k0 = (tid & 7) * 16;
    const int fr = lane & 15, g = lane >> 4;
    const bf16_t* HG = (const bf16_t*)(ws + A_HG);
    const u32x4 q0 = R.q0, q1 = R.q1, v0 = R.v0, v1 = R.v1;
    bf16x8 sf[4]; u32x2 gwv[4];
    { const bf16_t* st = (const bf16_t*)(ws + A_STATE) + (size_t)unit * 16384 + (wave * 16 + fr) * 128;
#pragma unroll
      for (int ks = 0; ks < 4; ++ks) sf[ks] = *(const GAS bf16x8*)(st + 32 * ks + 8 * g);
#pragma unroll
      for (int I = 0; I < 4; ++I) gwv[I] = *(const GAS u32x2*)(HG + (size_t)(row0 + 16 * I + fr) * 2048 + 1536 + h * 128 + wave * 16 + 4 * g); }
    const f32x4 gain = *(const GAS f32x4*)(IN_F(6) + l * HGW + h * 128 + wave * 16 + 4 * g);
    float bb[16], kk[16];
    hg_build_b(F, l, h, R.z0, R.z1, k0, bb, kk);
    if (STOP == 1) { asm volatile("" :: "v"(bb[0]), "v"(kk[0]), "v"(sf[0]), "v"(gwv[0]), "v"(gain)); return; }
    const LAS float* REF = (const LAS float*)(F.lds + 4096);
    { const unsigned qq[8] = {q0.x, q0.y, q0.z, q0.w, q1.x, q1.y, q1.z, q1.w}, vv[8] = {v0.x, v0.y, v0.z, v0.w, v1.x, v1.y, v1.z, v1.w};
      LAS unsigned short* VT = (LAS unsigned short*)(F.lds + HL_VT);
      float qv[16], tmp[16];
#pragma unroll
      for (int i = 0; i < 16; ++i) { qv[i] = (i & 1) ? bfhi(qq[i >> 1]) : bflo(qq[i >> 1]); VT[(k0 + i) * (RS64 / 2) + t] = (unsigned short)((i & 1) ? (vv[i >> 1] >> 16) : (vv[i >> 1] & 0xffffu)); }
      const int I = wave >> 1;
      float rf[16];
#pragma unroll
      for (int i = 0; i < 16; i += 4) { f32x4 r4 = {0.f, 0.f, 0.f, 0.f}; if (I) r4 = *(const LAS f32x4*)(REF + (I - 1) * 128 + k0 + i); rf[i] = r4.x; rf[i + 1] = r4.y; rf[i + 2] = r4.z; rf[i + 3] = r4.w; }
#pragma unroll
      for (int i = 0; i < 16; ++i) tmp[i] = qv[i] * ex2(bb[i] - rf[i]);
      st_row16(F.lds, HL_QD + t * RS128 + k0 * 2, tmp);
#pragma unroll
      for (int i = 0; i < 16; ++i) tmp[i] = kk[i] * ex2(fminf(rf[i] - bb[i], 86.f));
      st_row16(F.lds, HL_KD + t * RS128 + k0 * 2, tmp);
#pragma unroll
      for (int i = 0; i < 16; ++i) tmp[i] = qv[i] * ex2(bb[i]);
      st_row16(F.lds, HL_QE + t * RS128 + k0 * 2, tmp);
#pragma unroll
      for (int i = 0; i < 16; i += 4) { const f32x4 r4 = *(const LAS f32x4*)(REF + 1 * 128 + k0 + i); rf[i] = r4.x; rf[i + 1] = r4.y; rf[i + 2] = r4.z; rf[i + 3] = r4.w; }
      if (wave >= 4) {
#pragma unroll
          for (int i = 0; i < 16; ++i) tmp[i] = qv[i] * ex2(bb[i] - rf[i]);
          st_row16(F.lds, HL_Q1 + (t & 31) * RS128 + k0 * 2, tmp);
      } else {
#pragma unroll
          for (int i = 0; i < 16; ++i) tmp[i] = kk[i] * ex2(rf[i] - bb[i]);
          st_row16(F.lds, HL_K1 + (t & 31) * RS128 + k0 * 2, tmp);
      }
#pragma unroll
      for (int i = 0; i < 16; i += 4) { const f32x4 r4 = *(const LAS f32x4*)(REF + ((wave >= 4) ? 2 : 0) * 128 + k0 + i); rf[i] = r4.x; rf[i + 1] = r4.y; rf[i + 2] = r4.z; rf[i + 3] = r4.w; }
      if (wave & 2) {
#pragma unroll
          for (int i = 0; i < 16; ++i) tmp[i] = qv[i] * ex2(bb[i] - rf[i]);
          st_row16(F.lds, HL_Q2 + ((t & 15) + ((wave >= 4) ? 16 : 0)) * RS128 + k0 * 2, tmp);
      } else {
#pragma unroll
          for (int i = 0; i < 16; ++i) tmp[i] = kk[i] * ex2(rf[i] - bb[i]);
          st_row16(F.lds, HL_K2 + ((t & 15) + ((wave >= 4) ? 16 : 0)) * RS128 + k0 * 2, tmp);
      }
      for (int i = tid; i < 64 * RS64 / 16; i += NTHR) *(LAS u32x4*)(F.lds + HL_SC + i * 16) = (u32x4){0u, 0u, 0u, 0u};
    }
    __syncthreads();
    if (STOP == 2) { asm volatile("" :: "v"(sf[0]), "v"(gwv[0]), "v"(gain)); return; }
    for (int blk = wave; blk < 10; blk += 8) {
        int ko, qo, J, I; bool diag = false;
        if (blk < 4) { ko = HL_KD + blk * 16 * RS128; qo = HL_QD + blk * 16 * RS128; J = blk; I = blk; diag = true; }
        else if (blk == 4) { ko = HL_K2; qo = HL_Q2; J = 0; I = 1; }
        else if (blk == 5) { ko = HL_K2 + 16 * RS128; qo = HL_Q2 + 16 * RS128; J = 2; I = 3; }
        else { const int jj = (blk - 6) >> 1, ii = (blk - 6) & 1; ko = HL_K1 + jj * 16 * RS128; qo = HL_Q1 + ii * 16 * RS128; J = jj; I = 2 + ii; }
        f32x4 acc = {0.f, 0.f, 0.f, 0.f};
#pragma unroll
        for (int ks = 0; ks < 4; ++ks) { const bf16x8 af = *(const LAS bf16x8*)(F.lds + ko + fr * RS128 + (32 * ks + 8 * g) * 2), bf = *(const LAS bf16x8*)(F.lds + qo + fr * RS128 + (32 * ks + 8 * g) * 2);
            acc = __builtin_amdgcn_mfma_f32_16x16x32_bf16(af, bf, acc, 0, 0, 0); }
        if (diag) {
#pragma unroll
            for (int rg = 0; rg < 4; ++rg) if (4 * g + rg > fr) acc[rg] = 0.f; }
        u32x2 w; w.x = cvt_pk_bf16(acc[0], acc[1]); w.y = cvt_pk_bf16(acc[2], acc[3]);
        *(LAS u32x2*)(F.lds + HL_SC + (16 * I + fr) * RS64 + (16 * J + 4 * g) * 2) = w;
    }
    __syncthreads();
    if (STOP == 3) { asm volatile("" :: "v"(sf[0]), "v"(gwv[0]), "v"(gain)); return; }
    f32x4 o[4];
#pragma unroll
    for (int I = 0; I < 4; ++I) o[I] = (f32x4){0.f, 0.f, 0.f, 0.f};
    { bf16x8 af[2];
#pragma unroll
      for (int ks = 0; ks < 2; ++ks) af[ks] = *(const LAS bf16x8*)(F.lds + HL_VT + (wave * 16 + fr) * RS64 + (32 * ks + 8 * g) * 2);
#pragma unroll
      for (int I = 0; I < 4; ++I)
#pragma unroll
          for (int ks = 0; ks < 2; ++ks) { const bf16x8 bf = *(const LAS bf16x8*)(F.lds + HL_SC + (16 * I + fr) * RS64 + (32 * ks + 8 * g) * 2); o[I] = __builtin_amdgcn_mfma_f32_16x16x32_bf16(af[ks], bf, o[I], 0, 0, 0); }
#pragma unroll
      for (int I = 0; I < 4; ++I)
#pragma unroll
          for (int ks = 0; ks < 4; ++ks) { const bf16x8 bf = *(const LAS bf16x8*)(F.lds + HL_QE + (16 * I + fr) * RS128 + (32 * ks + 8 * g) * 2); o[I] = __builtin_amdgcn_mfma_f32_16x16x32_bf16(sf[ks], bf, o[I], 0, 0, 0); }
    }
    if (STOP == 4) { asm volatile("" :: "v"(o[0]), "v"(o[1]), "v"(o[2]), "v"(o[3]), "v"(gwv[0]), "v"(gain)); return; }
    LAS float* RED = (LAS float*)(F.lds + HL_RED);
#pragma unroll
    for (int I = 0; I < 4; ++I) { float q = (o[I][0] * o[I][0] + o[I][1] * o[I][1]) + (o[I][2] * o[I][2] + o[I][3] * o[I][3]); q += __shfl_xor(q, 16); q += __shfl_xor(q, 32); if (g == 0) RED[wave * 64 + 16 * I + fr] = q; }
    __syncthreads();
    { bf16_t* Y = (bf16_t*)(ws + WS_XB);
#pragma unroll
      for (int I = 0; I < 4; ++I) { const int tt = 16 * I + fr; float ssq = 0.f;
#pragma unroll
          for (int w = 0; w < 8; ++w) ssq += RED[w * 64 + tt];
          const float rs = __builtin_amdgcn_rsqf(ssq * (1.f / 128.f) + EPS);
          const u32x2 gw = gwv[I];
          const float g0 = bflo(gw.x), g1 = bfhi(gw.x), g2 = bflo(gw.y), g3 = bfhi(gw.y);
          u32x2 w; w.x = cvt_pk_bf16(o[I][0] * rs * gain.x * (g0 * sigmoidf_(g0)), o[I][1] * rs * gain.y * (g1 * sigmoidf_(g1)));
          w.y = cvt_pk_bf16(o[I][2] * rs * gain.z * (g2 * sigmoidf_(g2)), o[I][3] * rs * gain.w * (g3 * sigmoidf_(g3)));
          *(GAS u32x2*)(Y + (size_t)(row0 + tt) * DM + h * 128 + wave * 16 + 4 * g) = w; } }
    __syncthreads();
}

__device__ __forceinline__ void hg_scan(Frame& F) {
    unsigned char* ws = F.ws;
    for (int gid = F.vcu * NTHR + F.tid; gid < BATCH * HGH * 16384; gid += F.G * NTHR) {
        const int bh = gid >> 14, e = gid & 16383, k = e & 127;
        bf16_t* st = (bf16_t*)(ws + A_STATE) + (size_t)bh * NCHUNK * 16384 + e; const float* dc = (const float*)(ws + A_DECAY) + (size_t)bh * NCHUNK * 128 + k;
        float S = 0.f;
        for (int c0 = 0; c0 < NCHUNK; c0 += 8) { float kv[8], d[8];
#pragma unroll
            for (int i = 0; i < 8; ++i) { kv[i] = bf2f(st[(size_t)(c0 + i) * 16384]); d[i] = dc[(c0 + i) * 128]; }
#pragma unroll
            for (int i = 0; i < 8; ++i) { st[(size_t)(c0 + i) * 16384] = (bf16_t)f2bf(F.dry ? kv[i] : S); S = d[i] * S + kv[i]; } }
    }
}


typedef float f32x16 __attribute__((ext_vector_type(16)));
template <int D, int PAT>
__device__ __forceinline__ void att_pattern(Frame& F, int b, int h, int s_base, float kmax2, const bf16_t* QR, const bf16_t* KF, const bf16_t* VF) {
    const int lane = F.lane, wave = F.wave, r32 = lane & 31, hi = lane >> 5;
    LAS float* ACC = (LAS float*)F.lds; LAS float* LS = (LAS float*)(F.lds + 131072);
    constexpr int TPC = 16 / D, NT = SEQ / D / 32;
    const size_t bh = (size_t)(b * ATH + h) * (SEQ * 64);
    for (int jj = 0; jj < 2; ++jj) {
        const int j = wave + 8 * jj, r = j / TPC, tile = j % TPC, p0 = s_base / D + tile * 32;
        const size_t qrow = (size_t)b * SEQ + (size_t)(p0 + r32) * D + r;
        bf16x8 qf[4];
#pragma unroll
        for (int kk = 0; kk < 4; ++kk) qf[kk] = *(const GAS bf16x8*)(QR + qrow * 512 + h * 64 + 16 * kk + 8 * hi);
        float qn2 = 0.f;
#pragma unroll
        for (int kk = 0; kk < 4; ++kk)
#pragma unroll
            for (int e = 0; e < 8; ++e) { const float x = bf2f((unsigned short)qf[kk][e]); qn2 += x * x; }
        qn2 += __shfl_xor(qn2, 32);
        const float negM = -sqrtf(qn2 * kmax2);
        f32x16 o[2] = {{}, {}}; float lsum = 0.f;
#pragma unroll
        for (int kt = 0; kt < 5; ++kt) {
            const float c0 = (p0 - 128 + 32 * kt) < 0 ? -1.0e30f : negM;
            bf16x8 vfr[2][2], kf[4];
            { const int kb = p0 - 128 + 32 * kt, kbc = kb < 0 ? 0 : kb;
              const bf16_t* kp = KF + bh + ((size_t)(r * NT + (kbc >> 5)) * 4) * 512 + lane * 8;
#pragma unroll
              for (int kk = 0; kk < 4; ++kk) kf[kk] = *(const GAS bf16x8*)(kp + kk * 512);
#pragma unroll
              for (int s = 0; s < 2; ++s)
#pragma unroll
                  for (int mt = 0; mt < 2; ++mt) vfr[s][mt] = *(const GAS bf16x8*)(VF + bh + ((size_t)(r * NT + (kbc >> 5)) * 4 + s * 2 + mt) * 512 + lane * 8); }
            f32x16 acc;
#pragma unroll
            for (int rg = 0; rg < 16; ++rg) acc[rg] = c0;
#pragma unroll
            for (int kk = 0; kk < 4; ++kk) acc = __builtin_amdgcn_mfma_f32_32x32x16_bf16(kf[kk], qf[kk], acc, 0, 0, 0);
            if (kt == 0 || kt == 4) {
#pragma unroll
                for (int rg = 0; rg < 16; ++rg) { const int kap = 16 * (rg >> 3) + 8 * hi + (rg & 7); if (kt == 0 ? (kap < r32) : (kap > r32)) acc[rg] = -1.0e30f; } }
#pragma unroll
            for (int rg = 0; rg < 16; ++rg) { acc[rg] = ex2(acc[rg]); lsum += acc[rg]; }
#pragma unroll
            for (int s = 0; s < 2; ++s) {
                u32x4 pw; pw.x = cvt_pk_bf16(acc[8 * s + 0], acc[8 * s + 1]); pw.y = cvt_pk_bf16(acc[8 * s + 2], acc[8 * s + 3]);
                pw.z = cvt_pk_bf16(acc[8 * s + 4], acc[8 * s + 5]); pw.w = cvt_pk_bf16(acc[8 * s + 6], acc[8 * s + 7]);
                const bf16x8 pf = __builtin_bit_cast(bf16x8, pw);
#pragma unroll
                for (int mt = 0; mt < 2; ++mt) o[mt] = __builtin_amdgcn_mfma_f32_32x32x16_bf16(vfr[s][mt], pf, o[mt], 0, 0, 0);
            }
        }
        lsum += __shfl_xor(lsum, 32);
        const int tau = (p0 + r32) * D + r - s_base, gsw = (tau ^ (tau >> 5)) & 31;
        LAS float* arow = ACC + tau * 64;
#pragma unroll
        for (int mt = 0; mt < 2; ++mt)
#pragma unroll
            for (int rg = 0; rg < 16; ++rg) { LAS float* p = arow + ((((rg & 3) + 8 * (rg >> 2) + 4 * hi) ^ gsw) + 32 * mt); if (PAT == 0) *p = o[mt][rg]; else *p += o[mt][rg]; }
        if (hi == 0) { if (PAT == 0) LS[tau] = lsum; else LS[tau] += lsum; }
    }
}
__device__ __forceinline__ void att_unit(Frame& F, int l, int unit) {
    const int tb = unit >> 3, h = unit & 7, b = tb >> 4, s_base = (tb & 15) * 512;
    const bf16_t* QR = (const bf16_t*)(F.ws + A_QR);
    LAS float* ACC = (LAS float*)F.lds; LAS float* LS = (LAS float*)(F.lds + 131072);
    const float kmax2 = __uint_as_float(__hip_atomic_load((unsigned*)(F.ctl + CW_KMAX + l * 16) + b * ATH + h, RLX_AGENT)) * 1.02f;
    att_pattern<1, 0>(F, b, h, s_base, kmax2, QR, (const bf16_t*)(F.ws + A_KF1), (const bf16_t*)(F.ws + A_VT1));
    __syncthreads();
    att_pattern<4, 1>(F, b, h, s_base, kmax2, QR, (const bf16_t*)(F.ws + A_KF4), (const bf16_t*)(F.ws + A_VT4));
    __syncthreads();
    att_pattern<16, 2>(F, b, h, s_base, kmax2, QR, (const bf16_t*)(F.ws + A_KF16), (const bf16_t*)(F.ws + A_VT16));
    __syncthreads();
    { const int tau = F.tid, gsw = (tau ^ (tau >> 5)) & 31; const LAS float* arow = ACC + tau * 64; const float inv = __builtin_amdgcn_rcpf(LS[tau]);
      bf16_t* yrow = (bf16_t*)(F.ws + WS_XB) + ((size_t)b * SEQ + s_base + tau) * DM + 512 + h * 64;
#pragma unroll
      for (int c = 0; c < 8; ++c) { float v[8];
#pragma unroll
          for (int e = 0; e < 8; ++e) v[e] = arow[((8 * c + e) & 32) + (((8 * c + e) & 31) ^ gsw)] * inv;
          u32x4 w; w.x = cvt_pk_bf16(v[0], v[1]); w.y = cvt_pk_bf16(v[2], v[3]); w.z = cvt_pk_bf16(v[4], v[5]); w.w = cvt_pk_bf16(v[6], v[7]); *(GAS u32x4*)(yrow + 8 * c) = w; } }
    __syncthreads();
}

__device__ __forceinline__ void ph_norm(Frame& F, const Args& a) {
    const int gw = F.vcu * NWAVES + F.wave, NGW = F.G * NWAVES;
    for (int r = gw; r < MT; r += NGW) { const float rs = row_norm_prep(F.out + (size_t)r * DM, (bf16_t*)(F.ws + WS_XB) + (size_t)r * DM, nullptr, F.lane); if (F.lane == 0) ((float*)(F.ws + WS_RSTD))[r] = rs; }
}

__device__ __forceinline__ void ph_router(Frame& F, const Args& a, int l) {
    unsigned char* ws = F.ws; const int lane = F.lane;
    const int gw = F.vcu * NWAVES + F.wave, NGW = F.G * NWAVES;
    { LAS float* scr = (LAS float*)(F.lds + F.wave * 16384);
      for (int it = gw; it < 3 * 4096; it += NGW) { const int ty = it >> 12, e = (it >> 8) & 15, r = it & 255;
          if (ty == 0) transpose_mat_item(IN_F(16) + ((size_t)l * NEXP + e) * DM * EFF, DM, EFF, IN_F(13) + l * DM, (bf16_t*)(ws + A_WGU) + (size_t)e * DM * DM, 1, r, scr, lane);
          else if (ty == 1) transpose_mat_item(IN_F(17) + ((size_t)l * NEXP + e) * DM * EFF, DM, EFF, IN_F(13) + l * DM, (bf16_t*)(ws + A_WGU) + (size_t)e * DM * DM, 2, r, scr, lane);
          else transpose_mat_item(IN_F(18) + ((size_t)l * NEXP + e) * EFF * DM, EFF, DM, nullptr, (bf16_t*)(ws + A_WD) + (size_t)e * DM * EFF, 0, r, scr, lane); } }
    __syncthreads();
    unsigned* cnt = (unsigned*)(F.ctl + CW_CNT + l * 16 * 64);
    LAS unsigned* LCNT = (LAS unsigned*)(F.lds + 81920); LAS unsigned* LBASE = (LAS unsigned*)(F.lds + 81984);
    LAS float* LG = (LAS float*)F.lds;
    LAS float* SS = (LAS float*)(F.lds + 16384);
    if (F.tid < 16) LCNT[F.tid] = 0u;
    const bf16_t* WH = (const bf16_t*)(ws + WS_WR) + (size_t)l * 32 * DM; const bf16_t* WL = WH + DEPTH * 32 * DM;
    const int fr = lane & 15, g = lane >> 4, tile = F.wave & 3, kh = F.wave >> 2;
    for (int rt = F.vcu; rt < MT / 64; rt += F.G) {
        const int row = rt * 64 + tile * 16 + fr;
        const float* xrow = F.out + (size_t)row * DM + kh * 512 + 8 * g; bf16_t* xbrow = (bf16_t*)(ws + WS_XB) + (size_t)row * DM + kh * 512 + 8 * g;
        f32x4 acc[2] = {{0.f, 0.f, 0.f, 0.f}, {0.f, 0.f, 0.f, 0.f}}; float ssq = 0.f;
#pragma unroll 4
        for (int ks = 0; ks < 16; ++ks) {
            const f32x4 x0 = *(const GAS f32x4*)(xrow + 32 * ks), x1 = *(const GAS f32x4*)(xrow + 32 * ks + 4);
            ssq += ((x0.x * x0.x + x0.y * x0.y) + (x0.z * x0.z + x0.w * x0.w)) + ((x1.x * x1.x + x1.y * x1.y) + (x1.z * x1.z + x1.w * x1.w));
            u32x4 hw; hw.x = cvt_pk_bf16(x0.x, x0.y); hw.y = cvt_pk_bf16(x0.z, x0.w); hw.z = cvt_pk_bf16(x1.x, x1.y); hw.w = cvt_pk_bf16(x1.z, x1.w);
            u32x4 lw; lw.x = cvt_pk_bf16(x0.x - bflo(hw.x), x0.y - bfhi(hw.x)); lw.y = cvt_pk_bf16(x0.z - bflo(hw.y), x0.w - bfhi(hw.y)); lw.z = cvt_pk_bf16(x1.x - bflo(hw.z), x1.y - bfhi(hw.z)); lw.w = cvt_pk_bf16(x1.z - bflo(hw.w), x1.w - bfhi(hw.w));
            *(GAS u32x4*)(xbrow + 32 * ks) = hw;
            const bf16x8 ah = __builtin_bit_cast(bf16x8, hw), al = __builtin_bit_cast(bf16x8, lw);
#pragma unroll
            for (int ct = 0; ct < 2; ++ct) { const size_t wo = (size_t)(16 * ct + fr) * DM + kh * 512 + 32 * ks + 8 * g;
                const bf16x8 bh = *(const GAS bf16x8*)(WH + wo), bl = *(const GAS bf16x8*)(WL + wo);
                acc[ct] = __builtin_amdgcn_mfma_f32_16x16x32_bf16(ah, bh, acc[ct], 0, 0, 0); acc[ct] = __builtin_amdgcn_mfma_f32_16x16x32_bf16(ah, bl, acc[ct], 0, 0, 0); acc[ct] = __builtin_amdgcn_mfma_f32_16x16x32_bf16(al, bh, acc[ct], 0, 0, 0); }
        }
        ssq += __shfl_xor(ssq, 16); ssq += __shfl_xor(ssq, 32);
        if (g == 0) SS[kh * 64 + tile * 16 + fr] = ssq;
#pragma unroll
        for (int ct = 0; ct < 2; ++ct)
#pragma unroll
            for (int rg = 0; rg < 4; ++rg) LG[(kh * 64 + tile * 16 + 4 * g + rg) * 32 + 16 * ct + fr] = acc[ct][rg];
        __syncthreads();
        if (F.tid < 64) { const int rl = F.tid, r = rt * 64 + rl;
            const float rstd = __builtin_amdgcn_rsqf((SS[rl] + SS[64 + rl]) * (1.f / DM) + EPS);
            float lg[20];
#pragma unroll
            for (int q = 0; q < 20; q += 4) { const f32x4 p0 = *(const LAS f32x4*)(LG + rl * 32 + q), p1 = *(const LAS f32x4*)(LG + (64 + rl) * 32 + q); lg[q] = (p0.x + p1.x) * rstd; lg[q + 1] = (p0.y + p1.y) * rstd; lg[q + 2] = (p0.z + p1.z) * rstd; lg[q + 3] = (p0.w + p1.w) * rstd; }
            ((float*)(ws + WS_RSTD))[r] = rstd;
            int gs = 0; float gm = lg[0];
#pragma unroll
            for (int q = 1; q < 4; ++q) if (lg[q] > gm) { gm = lg[q]; gs = q; }
            float den = 0.f;
#pragma unroll
            for (int q = 0; q < 4; ++q) den += __expf(lg[q] - gm);
            const float gwt = __builtin_amdgcn_rcpf(den);
            float e4[4];
#pragma unroll
            for (int q = 0; q < 4; ++q) e4[q] = gs == 0 ? lg[4 + q] : (gs == 1 ? lg[8 + q] : (gs == 2 ? lg[12 + q] : lg[16 + q]));
            int i1 = 0; float v1 = e4[0];
#pragma unroll
            for (int q = 1; q < 4; ++q) if (e4[q] > v1) { v1 = e4[q]; i1 = q; }
            int i2 = -1; float v2 = -3.0e38f;
#pragma unroll
            for (int q = 0; q < 4; ++q) if (q != i1 && e4[q] > v2) { v2 = e4[q]; i2 = q; }
            const float ex = __expf(v2 - v1), w1 = __builtin_amdgcn_rcpf(1.f + ex), w2 = ex * w1;
            const int id1 = gs * 4 + i1, id2 = gs * 4 + i2;
            int* te = (int*)(ws + WS_TOKE) + 2 * r; float* tw = (float*)(ws + WS_TOKW) + 2 * r; int* tl = (int*)(ws + WS_TOKL) + 2 * r;
            te[0] = id1; te[1] = id2; tw[0] = w1 * gwt; tw[1] = w2 * gwt;
            tl[0] = (int)__hip_atomic_fetch_add(LCNT + id1, 1u, __ATOMIC_RELAXED, __HIP_MEMORY_SCOPE_WORKGROUP); tl[1] = (int)__hip_atomic_fetch_add(LCNT + id2, 1u, __ATOMIC_RELAXED, __HIP_MEMORY_SCOPE_WORKGROUP);
        }
        __syncthreads();
    }
    __syncthreads();
    if (F.tid < 16) LBASE[F.tid] = __hip_atomic_fetch_add(cnt + 64 * F.tid, F.dry ? 0u : LCNT[F.tid], RLX_AGENT);
    __syncthreads();
    for (int rt = F.vcu; rt < MT / 64; rt += F.G) {
        if (F.tid < 128) { const int r = rt * 64 + (F.tid >> 1), k = F.tid & 1;
            const int e = ((const int*)(ws + WS_TOKE))[2 * r + k]; const int li = ((const int*)(ws + WS_TOKL))[2 * r + k] + (int)LBASE[e];
            ((int*)(ws + WS_TOKL))[2 * r + k] = li; ((int*)(ws + A_PERM2))[e * 16384 + li] = r; ((float*)(ws + A_SRS2))[e * 16384 + li] = ((const float*)(ws + WS_RSTD))[r]; ((float*)(ws + A_SGW2))[e * 16384 + li] = ((const float*)(ws + WS_TOKW))[2 * r + k]; } }
}

__device__ __forceinline__ void moe_prefix(Frame& F, int l) {
    if (F.tid == 0) { unsigned acc = 0; for (int e = 0; e < 16; ++e) { F.MISC[16 + e] = acc; const unsigned n = __hip_atomic_load((unsigned*)(F.ctl + CW_CNT + l * 16 * 64) + 64 * e, RLX_AGENT); acc += (n + 255u) >> 8; } F.MISC[32] = acc; }
    __syncthreads();
}

__device__ __forceinline__ void ph_combine(Frame& F, const Args& a, int l) {
    unsigned char* ws = F.ws; const int lane = F.lane;
    const int gw = F.vcu * NWAVES + F.wave, NGW = F.G * NWAVES;
    moe_prefix(F, l);
    const int* tlr = (const int*)(ws + WS_TOKL); const int* te = (const int*)(ws + WS_TOKE); const bf16_t* Y = (const bf16_t*)(ws + A_Y);
    auto slot_of = [&](int p) { return (int)F.MISC[16 + te[p]] * 256 + tlr[p]; };
    auto clampr = [&](int r) { return r < MT ? r : MT - 1; };
    int r = gw; if (r >= MT) return;
    int s0 = slot_of(2 * r), s1 = slot_of(2 * r + 1);
    int rn = clampr(r + NGW); int sn0 = slot_of(2 * rn), sn1 = slot_of(2 * rn + 1);
    f32x4 xv[4]; u32x2 ya[4], yb[4];
#pragma unroll
    for (int j = 0; j < 4; ++j) { xv[j] = ((const GAS f32x4*)(F.out + (size_t)r * DM) + lane)[64 * j]; ya[j] = ((const GAS u32x2*)(Y + (size_t)s0 * DM) + lane)[64 * j]; yb[j] = ((const GAS u32x2*)(Y + (size_t)s1 * DM) + lane)[64 * j]; }
    for (; r < MT; r += NGW) {
        const int rnn = clampr(r + 2 * NGW); const int snn0 = slot_of(2 * rnn), snn1 = slot_of(2 * rnn + 1);
        f32x4 xn[4]; u32x2 yan[4], ybn[4];
#pragma unroll
        for (int j = 0; j < 4; ++j) { xn[j] = ((const GAS f32x4*)(F.out + (size_t)rn * DM) + lane)[64 * j]; yan[j] = ((const GAS u32x2*)(Y + (size_t)sn0 * DM) + lane)[64 * j]; ybn[j] = ((const GAS u32x2*)(Y + (size_t)sn1 * DM) + lane)[64 * j]; }
        GAS f32x4* xr = (GAS f32x4*)(F.out + (size_t)r * DM) + lane;
        f32x4 v[4]; float s = 0.f;
#pragma unroll
        for (int j = 0; j < 4; ++j) { const u32x2 p0 = ya[j], p1 = yb[j]; f32x4 x = xv[j];
            const float dm = F.dry ? 0.f : 1.f; x.x += dm * (bflo(p0.x) + bflo(p1.x)); x.y += dm * (bfhi(p0.x) + bfhi(p1.x)); x.z += dm * (bflo(p0.y) + bflo(p1.y)); x.w += dm * (bfhi(p0.y) + bfhi(p1.y));
            v[j] = x; s += (x.x * x.x + x.y * x.y) + (x.z * x.z + x.w * x.w); }
        const float rstd = __builtin_amdgcn_rsqf(wave_sum(s) * (1.f / DM) + EPS);
        if (l == DEPTH - 1) { const GAS f32x4* g = (const GAS f32x4*)IN_F(19) + lane;
#pragma unroll
            for (int j = 0; j < 4; ++j) xr[64 * j] = v[j] * rstd * g[64 * j];
        } else {
            GAS u32x2* o8 = (GAS u32x2*)((bf16_t*)(ws + WS_XB) + (size_t)r * DM) + lane;
#pragma unroll
            for (int j = 0; j < 4; ++j) { xr[64 * j] = v[j]; u32x2 w; w.x = cvt_pk_bf16(v[j].x, v[j].y); w.y = cvt_pk_bf16(v[j].z, v[j].w); o8[64 * j] = w; }
            if (lane == 0) ((float*)(ws + WS_RSTD))[r] = rstd;
        }
#pragma unroll
        for (int j = 0; j < 4; ++j) { xv[j] = xn[j]; ya[j] = yan[j]; yb[j] = ybn[j]; }
        rn = rnn; sn0 = snn0; sn1 = snn1;
    }
}

constexpr int NPHASE = 1 + 12 * DEPTH + (PROBE_P >= 0 ? PROBE_N - 1 : 0);
__global__ void __launch_bounds__(NTHR, 2) fwd(Args a) {
    extern __shared__ __attribute__((aligned(16))) unsigned char lds_raw[];
    Frame F;
    F.lds = (LAS unsigned char*)lds_raw; F.MISC = (volatile LAS unsigned*)(F.lds + MISC_OFF);
    F.tid = threadIdx.x; F.lane = F.tid & 63; F.wave = __builtin_amdgcn_readfirstlane(F.tid >> 6);
    F.G = gridDim.x; { const int bx = blockIdx.x; F.vcu = (F.G % 8 == 0) ? (bx % 8) * (F.G / 8) + bx / 8 : bx; }
    F.ws = a.ws; F.ctl = (gu32*)(a.ws + WS_CTL); F.out = a.out; F.z = 0;
    for (int u = F.tid; u < (LDS_BYTES - LDSCTL_OFF) / 4; u += NTHR) ((LAS unsigned*)(F.lds + LDSCTL_OFF))[u] = 0u;
    __syncthreads();
    XcdBarrier bar; bar.bar = (unsigned*)(F.ctl + CW_BAR); bar.x = 0; bar.st = nullptr;
    const bool one_launch = (a.ph_hi - a.ph_lo) > 1;
    if (one_launch) bar = xcd_barrier_post((unsigned*)(F.ctl + CW_BAR), F.MISC + 8);
    for (int pp = a.ph_lo; pp < a.ph_hi; ++pp) {
        int ph = pp;
        F.dry = 0;
        if (PROBE_P >= 0) { constexpr int P = PROBE_P; if (pp > P) ph = (pp - (PROBE_N - 1) > P) ? pp - (PROBE_N - 1) : P; if (ph == P && pp < P + PROBE_N - 1) F.dry = 1; }
        { int t_ = threadIdx.x; asm volatile("" : "+v"(t_)); F.tid = t_; F.lane = t_ & 63; F.wave = __builtin_amdgcn_readfirstlane(t_ >> 6); }
        size_t z_ = 0; asm volatile("" : "+s"(z_)); F.z = z_; F.ws = a.ws + z_; F.out = (float*)((char*)a.out + z_); F.ctl = (gu32*)(a.ws + z_ + WS_CTL);
        unsigned char* ws = F.ws; int bx = (int)blockIdx.x; asm volatile("" : "+s"(bx));
        if (ph == 0) { if (PHSEL(0)) ph_init(F, a); }
        else {
            const int l = (ph - 1) / 12, qq = (ph - 1) % 12, q = qq < 9 ? qq : qq + 1;
            if (q == 0 && PHSEL(3)) {
                pg8::SchedDense S{64, 14, 896, F.G, bx, (const char*)(ws + WS_XB), (const char*)(ws + WS_WIN) + (size_t)l * NIN * DM * 2, (size_t)256 * DM * 2, (size_t)256 * DM * 2, 64, 0};
                EpiProj E{(bf16_t*)(ws + A_HG), (bf16_t*)(ws + A_QR), (bf16_t*)(ws + A_KF1), (bf16_t*)(ws + A_V), (const float*)(ws + WS_RSTD), (const f32x2*)(ws + WS_CS), (unsigned*)(F.ctl + CW_KMAX + l * 16)};
                pg8::gemm_phase<EpiProj, pg8::SchedDense, true, true, DM, DM>(F.lds, F.tid, S, E);
                if (l == 0) {
                    const bool part = (F.G == 256);
                    { size_t z2 = 0; asm volatile("" : "+s"(z2)); ws = F.ws + z2; F.ws = ws; int t2 = F.tid; asm volatile("" : "+v"(t2)); F.tid = t2; F.lane = t2 & 63; }
                    if (!part || (bx >= 128 && bx < 160)) { SchedKV SK{part ? 32 : F.G, part ? bx - 128 : bx, (const char*)(ws + WS_MEMN), (const char*)(ws + WS_WKVT)};
                        EpiKV EK{(bf16_t*)(ws + WS_KV), (bf16_t*)(ws + WS_KV) + (size_t)DEPTH * MEMROWS * DM};
                        pg8::gemm_phase<EpiKV, SchedKV, true, true, DM, DM>(F.lds, F.tid, SK, EK); }
                    if (!part || bx >= 160) conv_small_l1(F, a, part ? (bx - 160) * NWAVES + F.wave : F.vcu * NWAVES + F.wave, part ? 96 * NWAVES : F.G * NWAVES);
                }
            } else if (q == 1 && PHSEL(4)) {
                for (int rep = 0; rep < PROBE_PREP_N; ++rep) for (int u = F.vcu; u < (MT / 512) * ATH; u += F.G) vf_unit(F, u);
                for (int rep = 0; rep < PROBE_HGA_N; ++rep) { constexpr int NU = BATCH * HGH * NCHUNK; HgIn R = hg_load<false>(F, F.vcu < NU ? F.vcu : NU - 1);
                    for (int u = F.vcu; u < NU; u += F.G) { const HgIn Rn = hg_load<false>(F, u + F.G < NU ? u + F.G : NU - 1); hg_a2_unit(F, a, l, u, R); R = Rn; } }
                if (l == 0) {
                    { size_t z2 = 0; asm volatile("" : "+s"(z2)); ws = F.ws + z2; F.ws = ws; int t2 = F.tid; asm volatile("" : "+v"(t2)); F.tid = t2; F.lane = t2 & 63; }
                    SchedFold SF{F.G, bx, (const char*)(ws + WS_KV), (const char*)(ws + WS_KV) + (size_t)DEPTH * MEMROWS * DM * 2, (const char*)(ws + WS_WQS), (const char*)(ws + WS_WOT)};
                    EpiBf16 EF{(bf16_t*)(ws + WS_WQK), DM, (size_t)DM * DM, 1.f};
                    pg8::gemm_phase<EpiBf16, SchedFold, true, true, DM, 256>(F.lds, F.tid, SF, EF); }
            } else if (q == 2 && PHSEL(5)) hg_scan(F);
            else if (q == 3 && PHSEL(6)) {
                for (int rep = 0; rep < PROBE_HGC_N; ++rep) { constexpr int NU = BATCH * HGH * NCHUNK; HgIn R = hg_load<true>(F, F.vcu < NU ? F.vcu : NU - 1);
                    for (int u = F.vcu; u < NU; u += F.G) { const HgIn Rn = hg_load<true>(F, u + F.G < NU ? u + F.G : NU - 1); if (rep + 1 < PROBE_HGC_N) hg_c2_unit<PROBE_HGC_STOP>(F, a, l, u, R); else hg_c2_unit<0>(F, a, l, u, R); R = Rn; } }
#if ATT_GOLDEN
                for (int t = F.vcu * NWAVES + F.wave; t < (MT / 64) * ATH; t += F.G * NWAVES) att_task(F, t);
#else
                for (int rep = 0; rep < PROBE_ATT_N; ++rep) for (int u = F.vcu; u < (MT / 512) * ATH; u += F.G) att_unit(F, l, u);
#endif
            } else if (q == 4 && PHSEL(7)) {
                pg8::SchedDense S{64, 4, 256, F.G, bx, (const char*)(ws + WS_XB), (const char*)(ws + WS_WOUT) + (size_t)l * DM * DM * 2, (size_t)256 * DM * 2, (size_t)256 * DM * 2, 64, 0};
                EpiResAdd E{l == 0 ? IN_F(0) : (const float*)F.out, F.out, F.dry ? 0.f : 1.f};
                pg8::gemm_phase<EpiResAdd, pg8::SchedDense, true, true, DM, DM>(F.lds, F.tid, S, E);
            } else if (q == 5 && PHSEL(8)) ph_norm(F, a);
            else if (q == 6 && PHSEL(9)) {
                pg8::SchedDense S{64, 4, 256, F.G, bx, (const char*)(ws + WS_XB), (const char*)(ws + WS_WQK) + (size_t)l * 2 * DM * DM * 2, (size_t)256 * DM * 2, (size_t)256 * DM * 2, 32, (size_t)DM * DM * 2};
                EpiSoftmax E{(bf16_t*)(ws + A_P), (const float*)(ws + WS_RSTD)};
                pg8::gemm_phase<EpiSoftmax, pg8::SchedDense, true, true, DM, DM>(F.lds, F.tid, S, E);
            } else if (q == 7 && PHSEL(10)) {
                pg8::SchedDense S{64, 4, 256, F.G, bx, (const char*)(ws + A_P), (const char*)(ws + WS_WVO) + (size_t)l * 2 * DM * DM * 2, (size_t)256 * DM * 2, (size_t)256 * DM * 2, 32, (size_t)DM * DM * 2};
                EpiResAdd E{(const float*)F.out, F.out, F.dry ? 0.f : 1.f};
                pg8::gemm_phase<EpiResAdd, pg8::SchedDense, true, true, DM, DM>(F.lds, F.tid, S, E);
            } else if (q == 8 && PHSEL(11)) ph_router(F, a, l);
            else if (q == 10 && PHSEL(13)) {
                moe_prefix(F, l);
                SchedMoe S{F.G, bx, DM, F.MISC + 16, (const char*)(ws + WS_XB), (const char*)(ws + A_WGU), (const int*)(ws + A_PERM2), (const unsigned*)(F.ctl + CW_CNT + l * 16 * 64), true};
                EpiMoe1 E{(bf16_t*)(ws + A_ACTB), (const float*)(ws + A_SRS2), (const float*)(ws + A_SGW2)};
                pg8::gemm_phase<EpiMoe1, SchedMoe, true, true, DM, DM, true>(F.lds, F.tid, S, E);
            } else if (q == 11 && PHSEL(14)) {
                moe_prefix(F, l);
                SchedMoe S{F.G, bx, EFF, F.MISC + 16, (const char*)(ws + A_ACTB), (const char*)(ws + A_WD), nullptr, nullptr, false};
                EpiBf16 E{(bf16_t*)(ws + A_Y), DM, 0, 1.f};
                pg8::gemm_phase<EpiBf16, SchedMoe, true, true, EFF, EFF>(F.lds, F.tid, S, E);
            } else if (q == 12 && PHSEL(15)) ph_combine(F, a, l);
        }
        if (pp + 1 < a.ph_hi) xcd_barrier(bar);
    }
}

extern "C" void kernel_launch(void* const* d_in, const int* in_sizes, int n_in, void* d_out, int out_size, void* d_ws, size_t ws_size, hipStream_t stream) {
    static int grid = 0;
    if (grid == 0) {
        if (n_in != 20 || in_sizes[0] != MT * DM || out_size != MT * DM || ws_size < WS_END) { fprintf(stderr, "kernel_launch: unexpected shapes / workspace (%d inputs, ws %zu)\n", n_in, ws_size); grid = -1; return; }
        int dev = 0, cus = 0, per_cu = 0;
        if (hipGetDevice(&dev) != hipSuccess || hipDeviceGetAttribute(&cus, hipDeviceAttributeMultiprocessorCount, dev) != hipSuccess) { grid = -1; return; }
        if (hipFuncSetAttribute((const void*)fwd, hipFuncAttributeMaxDynamicSharedMemorySize, LDS_BYTES) != hipSuccess) { grid = -1; return; }
        if (hipOccupancyMaxActiveBlocksPerMultiprocessor(&per_cu, (const void*)fwd, NTHR, LDS_BYTES) != hipSuccess || per_cu < 1) { fprintf(stderr, "kernel_launch: occupancy query says %d\n", per_cu); per_cu = 1; }
        (void)hipGetLastError();
        grid = cus * 1;
    }
    if (grid < 0) return;
    (void)hipMemsetAsync((char*)d_ws + WS_CTL, 0, CTL_ZERO_BYTES, stream);
    Args a{};
    for (int i = 0; i < 20; ++i) a.in[i] = d_in[i];
    a.out = (float*)d_out; a.ws = (unsigned char*)d_ws;
#if MK_PER_PHASE
    for (int ph = 0; ph < NPHASE; ++ph) { a.ph_lo = ph; a.ph_hi = ph + 1; hipLaunchKernelGGL(fwd, dim3(grid), dim3(NTHR), LDS_BYTES, stream, a); }
#else
    a.ph_lo = 0; a.ph_hi = NPHASE;
    void* kargs[] = {&a};
    hipError_t e = hipLaunchCooperativeKernel((const void*)fwd, dim3(grid), dim3(NTHR), kargs, LDS_BYTES, stream);
    if (e != hipSuccess) fprintf(stderr, "cooperative launch failed: %s (grid %d)\n", hipGetErrorString(e), grid);
#endif
}
```

```cpp
#include <hip/hip_runtime.h>
#include <cstdio>
#include <cstdint>

#ifndef PH_MASK
#define PH_MASK 0xFFFFFFFFu
#endif
#define PHSEL(n) ((PH_MASK >> (n)) & 1u)
#ifndef PROBE_ATT_N
#define PROBE_ATT_N 1
#endif
#ifndef PROBE_HGC_N
#define PROBE_HGC_N 1
#endif
#ifndef PROBE_HGA_N
#define PROBE_HGA_N 1
#endif
#ifndef PROBE_PREP_N
#define PROBE_PREP_N 1
#endif
#ifndef PROBE_HGC_STOP
#define PROBE_HGC_STOP 0
#endif
#ifndef PROBE_P
#define PROBE_P -1
#endif
#ifndef PROBE_N
#define PROBE_N 1
#endif
#ifndef HG_A_GOLDEN
#define HG_A_GOLDEN 0
#endif
#ifndef HG_C_GOLDEN
#define HG_C_GOLDEN 0
#endif
#ifndef ATT_GOLDEN
#define ATT_GOLDEN 0
#endif
#ifndef MK_PER_PHASE
#define MK_PER_PHASE 0
#endif

#define LAS __attribute__((address_space(3)))
#define GAS __attribute__((address_space(1)))
typedef unsigned short bf16_t;
typedef short bf16x8 __attribute__((ext_vector_type(8)));
typedef float f32x4 __attribute__((ext_vector_type(4)));
typedef float f32x2 __attribute__((ext_vector_type(2)));
typedef unsigned u32x4 __attribute__((ext_vector_type(4)));
typedef unsigned u32x2 __attribute__((ext_vector_type(2)));
typedef GAS unsigned gu32;

constexpr int BATCH = 2, SEQ = 8192, DM = 1024, MT = BATCH * SEQ, DEPTH = 2;
constexpr int MEM_LEN = 256, MEMROWS = BATCH * MEM_LEN;
constexpr int NIN = 3584, HGW = 512, HGH = 4, HGD = 128, CHUNK = 64, NCHUNK = SEQ / CHUNK;
constexpr int ATW = 512, ATH = 8, ATD = 64;
constexpr int NEXP = 16, EFF = 512;
constexpr float EPS = 1e-6f;
constexpr int NWAVES = 8, NTHR = 512;

constexpr size_t MiB = 1u << 20;
constexpr size_t WS_CTL = 0, CTL_ZERO_BYTES = 1 * MiB;
constexpr size_t WS_RSTD = 1 * MiB;
constexpr size_t WS_TOKE = WS_RSTD + 64 * 1024;
constexpr size_t WS_TOKW = WS_TOKE + 128 * 1024;
constexpr size_t WS_TOKL = WS_TOKW + 128 * 1024;
constexpr size_t WS_SLOTRS = WS_TOKL + 128 * 1024;
constexpr size_t WS_SLOTGW = WS_SLOTRS + 160 * 1024;
constexpr size_t WS_PERM = WS_SLOTGW + 160 * 1024;
constexpr size_t WS_WR = 3 * MiB;
constexpr size_t WS_LBT = 3 * MiB + 256 * 1024;
constexpr size_t WS_SSQP = 3 * MiB + 512 * 1024;
constexpr size_t WS_XB = 4 * MiB;
constexpr size_t WS_WIN = 36 * MiB;
constexpr size_t WS_WOUT = 50 * MiB;
constexpr size_t WS_WQS = 54 * MiB;
constexpr size_t WS_WKVT = 58 * MiB;
constexpr size_t WS_WOT = 66 * MiB;
constexpr size_t WS_MEMN = 70 * MiB;
constexpr size_t WS_KV = 72 * MiB;
constexpr size_t WS_WQK = 76 * MiB;
constexpr size_t WS_WVO = 84 * MiB;
constexpr size_t WS_ACT = 92 * MiB;
constexpr size_t WS_CS = 320 * MiB;
constexpr size_t WS_END = 324 * MiB;
constexpr size_t A_HG = WS_ACT + 0 * MiB;
constexpr size_t A_KF1 = WS_ACT + 64 * MiB;
constexpr size_t A_KF4 = WS_ACT + 80 * MiB;
constexpr size_t A_KF16 = WS_ACT + 96 * MiB;
constexpr size_t A_QR = WS_ACT + 112 * MiB;
constexpr size_t A_V = WS_ACT + 128 * MiB;
constexpr size_t A_VT1 = WS_ACT + 144 * MiB;
constexpr size_t A_VT4 = WS_ACT + 160 * MiB;
constexpr size_t A_VT16 = WS_ACT + 176 * MiB;
constexpr size_t A_STATE = WS_ACT + 192 * MiB;
constexpr size_t A_DECAY = WS_ACT + 224 * MiB;
constexpr size_t A_XB2 = WS_ACT + 0 * MiB;
constexpr size_t A_P = WS_ACT + 32 * MiB;
constexpr size_t A_WGU = WS_ACT + 0 * MiB;
constexpr size_t A_WD = WS_ACT + 32 * MiB;
constexpr size_t A_PERM2 = WS_ACT + 48 * MiB;
constexpr size_t A_SRS2 = WS_ACT + 49 * MiB;
constexpr size_t A_SGW2 = WS_ACT + 50 * MiB;
constexpr size_t A_ACTB = WS_ACT + 120 * MiB;
constexpr size_t A_Y = WS_ACT + 156 * MiB;
constexpr int MAXSLOT = 2 * MT + NEXP * 256;
static_assert(A_Y + (size_t)MAXSLOT * 1024 * 2 <= WS_END, "ws map");
constexpr int CW_BAR = 4096;
constexpr int CW_KMAX = 12288;
constexpr int CW_DONE = 24576;
constexpr int CW_CNT = 16384;
constexpr int RING_BYTES = 131072;
constexpr int SPARE_OFF = RING_BYTES;
constexpr int LDSCTL_OFF = RING_BYTES + 8192, MISC_OFF = LDSCTL_OFF + 64;
constexpr int LDS_BYTES = 147456;

#define RLX_AGENT __ATOMIC_RELAXED, __HIP_MEMORY_SCOPE_AGENT
#define LDS_WAIT() asm volatile("s_waitcnt lgkmcnt(0)" ::: "memory")
#define VM_WAIT() asm volatile("s_waitcnt vmcnt(0)" ::: "memory")

__device__ __forceinline__ unsigned f2bf(float f) { unsigned u = __builtin_bit_cast(unsigned, f); return (u + 0x7fffu + ((u >> 16) & 1u)) >> 16; }
__device__ __forceinline__ unsigned pk2(float lo, float hi) { return f2bf(lo) | (f2bf(hi) << 16); }
__device__ __forceinline__ float bf2f(unsigned short h) { return __builtin_bit_cast(float, (unsigned)h << 16); }
__device__ __forceinline__ float bflo(unsigned w) { return __builtin_bit_cast(float, w << 16); }
__device__ __forceinline__ float bfhi(unsigned w) { return __builtin_bit_cast(float, w & 0xffff0000u); }
typedef __bf16 bf16x2_t __attribute__((ext_vector_type(2)));
__device__ __forceinline__ unsigned cvt_pk_bf16(float lo, float hi) { f32x2 v = {lo, hi}; bf16x2_t b = __builtin_convertvector(v, bf16x2_t); return __builtin_bit_cast(unsigned, b); }
__device__ __forceinline__ float wave_sum(float v) {
#pragma unroll
    for (int o = 1; o < 64; o <<= 1) v += __shfl_xor(v, o);
    return v;
}
__device__ __forceinline__ float sigmoidf_(float z) { return __builtin_amdgcn_rcpf(1.f + __builtin_amdgcn_exp2f(-1.4426950408889634f * z)); }
__device__ __forceinline__ float ex2(float x) { return __builtin_amdgcn_exp2f(x); }
constexpr float LOG2E = 1.4426950408889634f;

#define XB_TMO      128
#define XB_XCNT(j)  (256  + 64 * (j))
#define XB_XSUB(j)  (1280 + 64 * (j))
#define XB_XGEN(j)  (2304 + 64 * (j))
#define XB_TOP      3328
#define XB_TOPGEN   3392
#define XCD_BAR_WORDS 3456
#define XB_SPIN_CAP (1u << 18)
__device__ __forceinline__ unsigned xb_ld(unsigned* p)              { return __hip_atomic_load(p, __ATOMIC_RELAXED, __HIP_MEMORY_SCOPE_AGENT); }
__device__ __forceinline__ unsigned xb_add(unsigned* p, unsigned v) { return __hip_atomic_fetch_add(p, v, __ATOMIC_RELAXED, __HIP_MEMORY_SCOPE_AGENT); }
__device__ __forceinline__ unsigned xb_xcc_id() { return (unsigned)__builtin_amdgcn_s_getreg((3 << 11) | 20) & 0xFu; }
#define XB_SPIN(cond, bar) do { unsigned _sp = 0; while (cond) { __builtin_amdgcn_s_sleep(1); \
    if ((++_sp & 255u) == 0u) { if (xb_ld(&(bar)[XB_TMO])) break; if (_sp > XB_SPIN_CAP) { atomicAdd(&(bar)[XB_TMO], 1u); break; } } } } while (0)
struct XcdBarrier { unsigned* bar; unsigned x; volatile LAS unsigned* st; };
__device__ __forceinline__ XcdBarrier xcd_barrier_post(unsigned* bar, volatile LAS unsigned* st) {
    XcdBarrier b; b.bar = bar; b.x = xb_xcc_id(); b.st = st;
    if (threadIdx.x == 0) (void)xb_add(&bar[XB_XCNT(b.x)], 1u);
    return b;
}
__device__ __forceinline__ void xcd_barrier_complete(unsigned* bar, unsigned x, unsigned& nloc, unsigned& nx) {
    const unsigned G = gridDim.x * gridDim.y * gridDim.z;
    unsigned sum, cnt, mine, sp = 0u;
    for (;;) {
        sum = 0u; cnt = 0u; mine = 0u;
#pragma unroll
        for (unsigned j = 0; j < 16; ++j) { const unsigned c = xb_ld(&bar[XB_XCNT(j)]); sum += c; cnt += (c > 0u) ? 1u : 0u; mine = (j == x) ? c : mine; }
        if (sum == G) break;
        __builtin_amdgcn_s_sleep(1);
        if ((++sp & 255u) == 0u) { if (xb_ld(&bar[XB_TMO])) break; if (sp > XB_SPIN_CAP) { atomicAdd(&bar[XB_TMO], 1u); break; } }
    }
    nloc = mine > 0u ? mine : 1u; nx = cnt > 0u ? cnt : 1u;
}
__device__ __forceinline__ void xcd_barrier(const XcdBarrier& b) {
    asm volatile("s_waitcnt vmcnt(0)" ::: "memory");
    __syncthreads();
    if (threadIdx.x == 0) {
        unsigned* bar = b.bar;
        __builtin_amdgcn_s_waitcnt(0);
        unsigned nloc = b.st[0], nx = b.st[1];
        if (nloc == 0u) { xcd_barrier_complete(bar, b.x, nloc, nx); b.st[0] = nloc; b.st[1] = nx; }
        const unsigned old = xb_add(&bar[XB_XSUB(b.x)], 1u);
        const unsigned gen = old / nloc;
        if (old + 1u == (gen + 1u) * nloc) {
            __builtin_amdgcn_fence(__ATOMIC_RELEASE, "agent");
            asm volatile("s_waitcnt vmcnt(0)" ::: "memory");
            const unsigned og = xb_add(&bar[XB_TOP], 1u);
            const unsigned tg = og / nx;
            if (og + 1u == (tg + 1u) * nx) xb_add(&bar[XB_TOPGEN], 1u);
            else XB_SPIN(xb_ld(&bar[XB_TOPGEN]) == tg, bar);
            __builtin_amdgcn_fence(__ATOMIC_ACQUIRE, "agent");
            xb_add(&bar[XB_XGEN(b.x)], 1u);
            asm volatile("s_waitcnt vmcnt(0)" ::: "memory");
        } else {
            XB_SPIN(xb_ld(&bar[XB_XGEN(b.x)]) == gen, bar);
            __builtin_amdgcn_fence(__ATOMIC_ACQUIRE, "agent");
            asm volatile("s_waitcnt vmcnt(0)" ::: "memory");
        }
    }
    __syncthreads();
}

namespace pg8 {
constexpr int BM = 256, BK = 64, HALF = 128, HTB = HALF * BK * 2, STAGE_BYTES = 8 * HTB, NXCD = 8, WGM = 8;
__host__ __device__ __forceinline__ int lds_byte(int r, int c) { const int st = (r >> 4) * 2 + (c >> 5), rr = r & 15, cc = c & 31, ob = rr * 64 + cc * 2; return st * 1024 + (ob ^ (((ob >> 9) & 1) << 5)); }
__host__ __device__ __forceinline__ void stage_rc(int b, int& R, int& C) { const int st = b / 1024, sb = b % 1024, swz = sb ^ (((sb >> 9) & 1) << 5); R = (st >> 1) * 16 + swz / 64; C = (st & 1) * 32 + (swz % 64) / 2; }
__host__ __device__ __forceinline__ int perm32(int rho) { const int n = rho >> 4, i = rho & 15; return 8 * (i >> 2) + 4 * n + (i & 3); }

struct Unit { int pm, pn, aux, lr; const char* a; const char* b; };
typedef f32x4 Acc[2][2][4][2];

template <class Epi, class Sched, bool ALIGN_EPI, bool SP2, int LD, int K, bool GATHER = false>
__device__ __forceinline__ void gemm_phase(LAS unsigned char* lds, const int tid, const Sched& S, const Epi& E) {
    constexpr int lda = LD, ldb = LD;
    const int wid = __builtin_amdgcn_readfirstlane(tid >> 6), lane = tid & 63, wr = wid >> 2, wc = wid & 3, fr = lane & 15, fq = lane >> 4;
    constexpr int nt = K / BK;
    unsigned voffA[2], voffB[2];
#pragma unroll
    for (int i = 0; i < 2; ++i) { int R, C; stage_rc(tid * 16 + i * 8192, R, C); const int Rb = Epi::PERM ? ((R & ~31) + perm32(R & 31)) : R;
        voffA[i] = (unsigned)(R * lda + C) * 2u; voffB[i] = (unsigned)(Rb * ldb + C) * 2u; }
    const size_t kstep = (size_t)(BK * 2);
    const size_t hstepA = (size_t)HALF * lda * 2, hstepB = (size_t)HALF * ldb * 2;
    const unsigned ldsw = (unsigned)wid * 1024u;
    const int aoff = lds_byte(wr * 64 + fr, fq * 8), boff = lds_byte(wc * 32 + fr, fq * 8);
#define PG8_SA(b, h) (((b) * 2 + (h)) * HTB)
#define PG8_SB(b, h) ((4 + (b) * 2 + (h)) * HTB)
#define PG8_STAGE(bufoff, gbase, voff) do { _Pragma("unroll") for (int _i = 0; _i < 2; ++_i) \
        __builtin_amdgcn_global_load_lds((const unsigned*)((const char*)(gbase) + (voff)[_i]), (LAS unsigned*)(lds + (bufoff) + ldsw + _i * 8192), 16, 0, 0); } while (0)
#define PG8_STAGE_A(bufoff, gbase, half, usenext) do { if constexpr (GATHER) { const unsigned _p = (usenext) ? vn[half] : vc[half]; unsigned _v[2]; _v[0] = (_p & 0xffffu) * (unsigned)(lda * 2) + gc2; _v[1] = (_p >> 16) * (unsigned)(lda * 2) + gc2; PG8_STAGE(bufoff, gbase, _v); } \
        else { PG8_STAGE(bufoff, (gbase) + (half) * hstepA, voffA); } } while (0)
#define PG8_LDA(dst, b, h) do { _Pragma("unroll") for (int m = 0; m < 4; ++m) _Pragma("unroll") for (int k = 0; k < 2; ++k) dst[m][k] = *(const LAS bf16x8*)(lds + PG8_SA(b, h) + aoff + m * 2048 + k * 1024); } while (0)
#define PG8_LDB(dst, b, h) do { _Pragma("unroll") for (int n = 0; n < 2; ++n) _Pragma("unroll") for (int k = 0; k < 2; ++k) dst[n][k] = *(const LAS bf16x8*)(lds + PG8_SB(b, h) + boff + n * 2048 + k * 1024); } while (0)
#define PG8_MMA(ai, bj, At, Bt) do { __builtin_amdgcn_s_setprio(1); _Pragma("unroll") for (int m = 0; m < 4; ++m) _Pragma("unroll") for (int n = 0; n < 2; ++n) _Pragma("unroll") for (int k = 0; k < 2; ++k) \
        acc[ai][bj][m][n] = __builtin_amdgcn_mfma_f32_16x16x32_bf16(Bt[n][k], At[m][k], acc[ai][bj][m][n], 0, 0, 0); __builtin_amdgcn_s_setprio(0); } while (0)
#define PG8_WAIT_V(n) asm volatile("s_waitcnt vmcnt(" #n ")" ::: "memory")
#define PG8_WAIT_L(n) asm volatile("s_waitcnt lgkmcnt(" #n ")" ::: "memory")
#define PG8_BAR __builtin_amdgcn_s_barrier()
#define PG8_SCHED __builtin_amdgcn_sched_barrier(0)
    Unit cur, nxt; int ui = 0;
    if (!S.next(0, cur)) return;
    Acc acc;
#pragma unroll
    for (int a = 0; a < 2; ++a)
#pragma unroll
        for (int b = 0; b < 2; ++b)
#pragma unroll
            for (int m = 0; m < 4; ++m)
#pragma unroll
                for (int n = 0; n < 2; ++n) acc[a][b][m][n] = (f32x4){0.f, 0.f, 0.f, 0.f};
    bf16x8 At[4][2], B0[2][2], B1[2][2];
    const char* cA = cur.a; const char* cB = cur.b;
    unsigned vc[2], vn[2], gc2 = 0;
    if constexpr (GATHER) { int R0, C0; stage_rc(tid * 16, R0, C0); gc2 = (unsigned)C0 * 2u;
#pragma unroll
        for (int h = 0; h < 2; ++h) { vc[h] = (unsigned)S.src_row(cur, 128 * h + R0) | ((unsigned)S.src_row(cur, 128 * h + R0 + 64) << 16); vn[h] = vc[h]; }
    }
    static_assert(SP2, "only the two-MFMA-blocks-per-barrier-pair loop is kept");
    {
        PG8_STAGE(PG8_SB(0, 0), cB, voffB); PG8_STAGE(PG8_SB(0, 1), cB + hstepB, voffB); PG8_STAGE_A(PG8_SA(0, 0), cA, 0, false); PG8_STAGE_A(PG8_SA(0, 1), cA, 1, false);
        if (wr == 1) PG8_BAR;
        PG8_WAIT_V(2); PG8_BAR;
        PG8_STAGE(PG8_SB(1, 0), cB + kstep, voffB); PG8_STAGE_A(PG8_SA(1, 0), cA + kstep, 0, false); PG8_STAGE(PG8_SB(1, 1), cB + hstepB + kstep, voffB);
        PG8_WAIT_V(6); PG8_BAR;
    }
    for (;;) {
        const bool has_next = S.next(ui + 1, nxt);
        const char* nA = has_next ? nxt.a : cA; const char* nB = has_next ? nxt.b : cB;
        if constexpr (GATHER) { if (has_next) { int R0, C0; stage_rc(tid * 16, R0, C0);
#pragma unroll
            for (int h = 0; h < 2; ++h) vn[h] = (unsigned)S.src_row(nxt, 128 * h + R0) | ((unsigned)S.src_row(nxt, 128 * h + R0 + 64) << 16); } }
#pragma nounroll
        for (int t = 0; t < nt; t += 2) {
            const bool last = (t == nt - 2);
            const char* a1 = cA + (size_t)(t + 1) * kstep;
            const char* a2 = last ? nA : cA + (size_t)(t + 2) * kstep; const char* b2 = last ? nB : cB + (size_t)(t + 2) * kstep;
            const char* a3 = a2 + kstep; const char* b3 = b2 + kstep;
            {
            PG8_LDB(B0, 0, 0); PG8_LDB(B1, 0, 1); PG8_SCHED; PG8_LDA(At, 0, 0); PG8_STAGE_A(PG8_SA(1, 1), a1, 1, false);
            PG8_WAIT_V(8); PG8_WAIT_L(0); PG8_BAR; PG8_MMA(0, 0, At, B0); PG8_MMA(0, 1, At, B1); PG8_BAR; PG8_SCHED;
            PG8_LDA(At, 0, 1); PG8_STAGE(PG8_SB(0, 0), b2, voffB); PG8_STAGE(PG8_SB(0, 1), b2 + hstepB, voffB); PG8_STAGE_A(PG8_SA(0, 0), a2, 0, last);
            PG8_WAIT_V(8); PG8_WAIT_L(0); PG8_BAR; PG8_MMA(1, 0, At, B0); PG8_MMA(1, 1, At, B1); PG8_BAR; PG8_SCHED;
            PG8_LDB(B0, 1, 0); PG8_LDB(B1, 1, 1); PG8_SCHED; PG8_LDA(At, 1, 0); PG8_STAGE_A(PG8_SA(0, 1), a2, 1, last);
            PG8_WAIT_V(8); PG8_WAIT_L(0); PG8_BAR; PG8_MMA(0, 0, At, B0); PG8_MMA(0, 1, At, B1); PG8_BAR; PG8_SCHED;
            PG8_LDA(At, 1, 1); PG8_STAGE(PG8_SB(1, 0), b3, voffB); PG8_STAGE(PG8_SB(1, 1), b3 + hstepB, voffB); PG8_STAGE_A(PG8_SA(1, 0), a3, 0, last);
            PG8_WAIT_V(8); PG8_WAIT_L(0); PG8_BAR; PG8_MMA(1, 0, At, B0); PG8_MMA(1, 1, At, B1); PG8_BAR; PG8_SCHED;
            }
        }
        if constexpr (ALIGN_EPI) { if (wr == 0) PG8_BAR; }
        E(acc, cur, wr, wc, fr, fq, lds);
        if (!has_next) break;
#pragma unroll
        for (int a = 0; a < 2; ++a)
#pragma unroll
            for (int b = 0; b < 2; ++b)
#pragma unroll
                for (int m = 0; m < 4; ++m)
#pragma unroll
                    for (int n = 0; n < 2; ++n) acc[a][b][m][n] = (f32x4){0.f, 0.f, 0.f, 0.f};
        cur = nxt; cA = nA; cB = nB; ++ui;
        if constexpr (GATHER) { vc[0] = vn[0]; vc[1] = vn[1]; }
        if constexpr (ALIGN_EPI) { if (wr == 1) PG8_BAR; }
    }
    PG8_WAIT_V(0);
    if constexpr (!ALIGN_EPI) { if (wr == 0) PG8_BAR; }
    PG8_BAR;
#undef PG8_SA
#undef PG8_SB
#undef PG8_STAGE
#undef PG8_STAGE_A
#undef PG8_LDA
#undef PG8_LDB
#undef PG8_MMA
#undef PG8_WAIT_V
#undef PG8_WAIT_L
#undef PG8_BAR
#undef PG8_SCHED
}

struct SchedDense {
    int nM, nN, nwg, G, c; const char* A; const char* B; size_t a_tile, b_tile; int pm_per_batch; size_t b_batch;
    __device__ __forceinline__ bool next(int i, Unit& u) const {
        const long L = (long)i * G + c; if (L >= nwg) return false;
        int wgid = (int)L; { const int q = nwg / NXCD, r = nwg % NXCD, xcd = wgid % NXCD, off = wgid / NXCD; wgid = (xcd < r ? xcd * (q + 1) : r * (q + 1) + (xcd - r) * q) + off; }
        const int nig = WGM * nN, gid = wgid / nig, fm = gid * WGM, gsz = (nM - fm) < WGM ? (nM - fm) : WGM;
        u.pm = fm + ((wgid % nig) % gsz); u.pn = (wgid % nig) / gsz; u.aux = 0;
        u.a = A + (size_t)u.pm * a_tile; u.b = B + (size_t)u.pn * b_tile + (size_t)(u.pm / pm_per_batch) * b_batch; return true;
    }
};
}
using pg8::Unit; using pg8::Acc;

struct EpiBf16 {
    static constexpr bool PERM = true;
    bf16_t* O; int ldc; size_t aux_stride; float scale;
    __device__ __forceinline__ void operator()(const Acc& acc, const Unit& u, int wr, int wc, int fr, int fq, LAS unsigned char*) const {
        bf16_t* base = O + (size_t)u.aux * aux_stride;
        const int row0 = u.pm * 256 + wr * 64 + fr, col0 = u.pn * 256 + wc * 32 + 8 * fq;
#pragma unroll
        for (int ai = 0; ai < 2; ++ai)
#pragma unroll
            for (int m = 0; m < 4; ++m) { bf16_t* rowp = base + (size_t)(row0 + ai * 128 + m * 16) * ldc + col0;
#pragma unroll
                for (int bj = 0; bj < 2; ++bj) { const f32x4 v0 = acc[ai][bj][m][0] * scale, v1 = acc[ai][bj][m][1] * scale;
                    u32x4 w; w.x = cvt_pk_bf16(v0[0], v0[1]); w.y = cvt_pk_bf16(v0[2], v0[3]); w.z = cvt_pk_bf16(v1[0], v1[1]); w.w = cvt_pk_bf16(v1[2], v1[3]);
                    *(u32x4*)(rowp + bj * 128) = w; } }
    }
};
struct EpiKV {
    static constexpr bool PERM = true;
    bf16_t* KB; bf16_t* VB;
    __device__ __forceinline__ void operator()(const Acc& acc, const Unit& u, int wr, int wc, int fr, int fq, LAS unsigned char*) const {
        bf16_t* base = (u.pn < 4 ? KB : VB) + (size_t)u.aux * MEMROWS * DM;
        const int row0 = u.pm * 256 + wr * 64 + fr, col0 = (u.pn & 3) * 256 + wc * 32 + 8 * fq;
#pragma unroll
        for (int ai = 0; ai < 2; ++ai)
#pragma unroll
            for (int m = 0; m < 4; ++m) { bf16_t* rowp = base + (size_t)(row0 + ai * 128 + m * 16) * DM + col0;
#pragma unroll
                for (int bj = 0; bj < 2; ++bj) { const f32x4 v0 = acc[ai][bj][m][0], v1 = acc[ai][bj][m][1];
                    u32x4 w; w.x = cvt_pk_bf16(v0[0], v0[1]); w.y = cvt_pk_bf16(v0[2], v0[3]); w.z = cvt_pk_bf16(v1[0], v1[1]); w.w = cvt_pk_bf16(v1[2], v1[3]);
                    *(u32x4*)(rowp + bj * 128) = w; } }
    }
};
struct EpiProj {
    static constexpr bool PERM = true;
    bf16_t* HG; bf16_t* QR; bf16_t* KF; bf16_t* V; const float* rstd; const f32x2* CS; unsigned* kmax;
    __device__ __forceinline__ void operator()(const Acc& acc, const Unit& u, int wr, int wc, int fr, int fq, LAS unsigned char*) const {
        const int row0 = u.pm * 256 + wr * 64 + fr;
        if (u.pn < 8 || u.pn >= 12) {
            bf16_t* base; int ldc, colt;
            if (u.pn < 8) { base = HG; ldc = 2048; colt = u.pn * 256; } else { base = V; ldc = 512; colt = (u.pn - 12) * 256; }
            const int col0 = colt + wc * 32 + 8 * fq;
#pragma unroll
            for (int ai = 0; ai < 2; ++ai)
#pragma unroll
                for (int m = 0; m < 4; ++m) { const int row = row0 + ai * 128 + m * 16; const float rs = rstd[row]; bf16_t* rowp = base + (size_t)row * ldc + col0;
#pragma unroll
                    for (int bj = 0; bj < 2; ++bj) { const f32x4 v0 = acc[ai][bj][m][0] * rs, v1 = acc[ai][bj][m][1] * rs;
                        u32x4 w; w.x = cvt_pk_bf16(v0[0], v0[1]); w.y = cvt_pk_bf16(v0[2], v0[3]); w.z = cvt_pk_bf16(v1[0], v1[1]); w.w = cvt_pk_bf16(v1[2], v1[3]);
                        *(u32x4*)(rowp + bj * 128) = w; } }
        } else {
            const bool isk = u.pn >= 10; const int head = 4 * (u.pn & 1) + wc;
            float kn2max = 0.f;
#pragma unroll
            for (int ai = 0; ai < 2; ++ai)
#pragma unroll
                for (int m = 0; m < 4; ++m) { const int row = row0 + ai * 128 + m * 16; const float rs = rstd[row] * (isk ? 1.f : 0.125f * LOG2E);
                    const f32x4* cs = (const f32x4*)(CS + (size_t)row * 32 + 8 * fq); const f32x4 c0 = cs[0], c1 = cs[1], c2 = cs[2], c3 = cs[3];
                    const float co[8] = {c0.x, c0.z, c1.x, c1.z, c2.x, c2.z, c3.x, c3.z}, si[8] = {c0.y, c0.w, c1.y, c1.w, c2.y, c2.w, c3.y, c3.w};
                    float lo[8], hi[8];
#pragma unroll
                    for (int n = 0; n < 2; ++n)
#pragma unroll
                        for (int e = 0; e < 4; ++e) { const int j = 4 * n + e; const float x1 = acc[ai][0][m][n][e] * rs, x2 = acc[ai][1][m][n][e] * rs; lo[j] = x1 * co[j] - x2 * si[j]; hi[j] = x2 * co[j] + x1 * si[j]; }
                    u32x4 wl, wh; wl.x = cvt_pk_bf16(lo[0], lo[1]); wl.y = cvt_pk_bf16(lo[2], lo[3]); wl.z = cvt_pk_bf16(lo[4], lo[5]); wl.w = cvt_pk_bf16(lo[6], lo[7]);
                    wh.x = cvt_pk_bf16(hi[0], hi[1]); wh.y = cvt_pk_bf16(hi[2], hi[3]); wh.z = cvt_pk_bf16(hi[4], hi[5]); wh.w = cvt_pk_bf16(hi[6], hi[7]);
                    if (!isk) { bf16_t* rowp = QR + (size_t)row * 512 + head * 64 + 8 * fq; *(u32x4*)rowp = wl; *(u32x4*)(rowp + 32) = wh; }
                    else { { float n2 = 0.f;
#pragma unroll
                          for (int j = 0; j < 8; ++j) n2 += lo[j] * lo[j] + hi[j] * hi[j];
                          n2 += __shfl_xor(n2, 16); n2 += __shfl_xor(n2, 32); kn2max = fmaxf(kn2max, n2); }
                        const int b = row >> 13, s = row & (SEQ - 1); const size_t bh = (size_t)(b * ATH + head) * (SEQ * 64);
#pragma unroll
                        for (int pat = 0; pat < 3; ++pat) { const int D = pat == 0 ? 1 : (pat == 1 ? 4 : 16), sh = pat * 2; const int r = s & (D - 1), p = s >> sh, T = p >> 5, k5 = p & 31;
                            const int rho = (k5 & 19) | ((k5 & 4) << 1) | ((k5 & 8) >> 1);
                            bf16_t* kf = KF + (size_t)pat * (MT * 512) + bh + ((size_t)(r * (SEQ / 32 >> sh) + T) * 4) * 512;
                            *(u32x4*)(kf + ((fq >> 1) * 64 + rho + 32 * (fq & 1)) * 8) = wl; *(u32x4*)(kf + ((2 + (fq >> 1)) * 64 + rho + 32 * (fq & 1)) * 8) = wh; }
                    } }
            if (isk) { kn2max = fmaxf(kn2max, __shfl_xor(kn2max, 1)); kn2max = fmaxf(kn2max, __shfl_xor(kn2max, 2)); kn2max = fmaxf(kn2max, __shfl_xor(kn2max, 4)); kn2max = fmaxf(kn2max, __shfl_xor(kn2max, 8));
                if (fr == 0 && fq == 0) __hip_atomic_fetch_max(kmax + ((u.pm >> 5) * ATH + head), __float_as_uint(kn2max), __ATOMIC_RELAXED, __HIP_MEMORY_SCOPE_AGENT); }
        }
    }
};
struct EpiResAdd {
    static constexpr bool PERM = false;
    const float* Xs; float* X; float dm;
    __device__ __forceinline__ void operator()(const Acc& acc, const Unit& u, int wr, int wc, int fr, int fq, LAS unsigned char*) const {
        const int row0 = u.pm * 256 + wr * 64 + fr, col0 = u.pn * 256 + wc * 32 + 4 * fq;
#pragma unroll
        for (int ai = 0; ai < 2; ++ai) {
            f32x4 xv[4][2][2];
#pragma unroll
            for (int m = 0; m < 4; ++m) { const size_t off = (size_t)(row0 + ai * 128 + m * 16) * DM + col0;
#pragma unroll
                for (int bj = 0; bj < 2; ++bj)
#pragma unroll
                    for (int n = 0; n < 2; ++n) xv[m][bj][n] = *(const f32x4*)(Xs + off + bj * 128 + n * 16); }
            asm volatile("" ::: "memory");
#pragma unroll
            for (int m = 0; m < 4; ++m) { const size_t off = (size_t)(row0 + ai * 128 + m * 16) * DM + col0;
#pragma unroll
                for (int bj = 0; bj < 2; ++bj)
#pragma unroll
                    for (int n = 0; n < 2; ++n) *(f32x4*)(X + off + bj * 128 + n * 16) = xv[m][bj][n] + acc[ai][bj][m][n] * dm; }
        }
    }
};
struct EpiResNorm {
    static constexpr bool PERM = false;
    const float* Xs; float* X; bf16_t* XB; float* SSQP;
    __device__ __forceinline__ void operator()(const Acc& acc, const Unit& u, int wr, int wc, int fr, int fq, LAS unsigned char* lds) const {
        LAS float* EX = (LAS float*)(lds + SPARE_OFF);
        const int row0 = u.pm * 256 + wr * 64 + fr, col0 = u.pn * 256 + wc * 32 + 4 * fq;
#pragma unroll
        for (int ai = 0; ai < 2; ++ai)
#pragma unroll
            for (int m = 0; m < 4; ++m) { const size_t off = (size_t)(row0 + ai * 128 + m * 16) * DM + col0; float s = 0.f;
#pragma unroll
                for (int bj = 0; bj < 2; ++bj)
#pragma unroll
                    for (int n = 0; n < 2; ++n) { const f32x4 v = *(const f32x4*)(Xs + off + bj * 128 + n * 16) + acc[ai][bj][m][n]; *(f32x4*)(X + off + bj * 128 + n * 16) = v;
                        u32x2 w; w.x = cvt_pk_bf16(v[0], v[1]); w.y = cvt_pk_bf16(v[2], v[3]); *(u32x2*)(XB + off + bj * 128 + n * 16) = w;
                        s += (v[0] * v[0] + v[1] * v[1]) + (v[2] * v[2] + v[3] * v[3]); }
                s += __shfl_xor(s, 16); s += __shfl_xor(s, 32);
                if (fq == 0) EX[(ai * 128 + wr * 64 + m * 16 + fr) * 4 + wc] = s; }
        asm volatile("s_waitcnt lgkmcnt(0)" ::: "memory"); __builtin_amdgcn_s_barrier(); asm volatile("" ::: "memory");
        { const int t = (wr * 4 + wc) * 64 + fq * 16 + fr; if (t < 256) { const f32x4 e = *(const LAS f32x4*)(EX + t * 4); SSQP[(size_t)(u.pm * 256 + t) * 4 + u.pn] = (e.x + e.y) + (e.z + e.w); } }
        asm volatile("s_waitcnt lgkmcnt(0)" ::: "memory"); __builtin_amdgcn_s_barrier(); asm volatile("" ::: "memory");
    }
};
struct EpiSoftmax {
    static constexpr bool PERM = false;
    bf16_t* P; const float* SSQP;
    __device__ __forceinline__ void operator()(Acc& acc, const Unit& u, int wr, int wc, int fr, int fq, LAS unsigned char* lds) const {
        LAS f32x2* EX = (LAS f32x2*)(lds + SPARE_OFF);
        const int row0 = u.pm * 256 + wr * 64 + fr;
        float mw[2][4];
#pragma unroll
        for (int ai = 0; ai < 2; ++ai)
#pragma unroll
            for (int m = 0; m < 4; ++m) {
                const f32x4 pq = *(const f32x4*)(SSQP + (size_t)(row0 + ai * 128 + m * 16) * 4); const float rs = __builtin_amdgcn_rsqf(((pq.x + pq.y) + (pq.z + pq.w)) * (1.f / DM) + EPS);
                float mx = -3.0e38f;
#pragma unroll
                for (int bj = 0; bj < 2; ++bj)
#pragma unroll
                    for (int n = 0; n < 2; ++n) { f32x4 v = acc[ai][bj][m][n] * rs; acc[ai][bj][m][n] = v; mx = fmaxf(mx, fmaxf(fmaxf(v[0], v[1]), fmaxf(v[2], v[3]))); }
                mx = fmaxf(mx, __shfl_xor(mx, 16)); mx = fmaxf(mx, __shfl_xor(mx, 32));
                float sm = 0.f;
#pragma unroll
                for (int bj = 0; bj < 2; ++bj)
#pragma unroll
                    for (int n = 0; n < 2; ++n) { f32x4 v = acc[ai][bj][m][n]; v[0] = __expf(v[0] - mx); v[1] = __expf(v[1] - mx); v[2] = __expf(v[2] - mx); v[3] = __expf(v[3] - mx);
                        acc[ai][bj][m][n] = v; sm += (v[0] + v[1]) + (v[2] + v[3]); }
                sm += __shfl_xor(sm, 16); sm += __shfl_xor(sm, 32);
                mw[ai][m] = mx;
                if (fq == 0) EX[(ai * 128 + wr * 64 + m * 16 + fr) * 4 + wc] = (f32x2){mx, sm};
            }
        asm volatile("s_waitcnt lgkmcnt(0)" ::: "memory"); __builtin_amdgcn_s_barrier(); asm volatile("" ::: "memory");
#pragma unroll
        for (int ai = 0; ai < 2; ++ai)
#pragma unroll
            for (int m = 0; m < 4; ++m) {
                const int rl = ai * 128 + wr * 64 + m * 16 + fr;
                const f32x2 e0 = EX[rl * 4 + 0], e1 = EX[rl * 4 + 1], e2 = EX[rl * 4 + 2], e3 = EX[rl * 4 + 3];
                const float M = fmaxf(fmaxf(e0.x, e1.x), fmaxf(e2.x, e3.x));
                const float Ls = e0.y * __expf(e0.x - M) + e1.y * __expf(e1.x - M) + e2.y * __expf(e2.x - M) + e3.y * __expf(e3.x - M);
                const float f = __expf(mw[ai][m] - M) / Ls;
                bf16_t* rowp = P + (size_t)(row0 + ai * 128 + m * 16) * DM + u.pn * 256 + wc * 32 + 4 * fq;
#pragma unroll
                for (int bj = 0; bj < 2; ++bj)
#pragma unroll
                    for (int n = 0; n < 2; ++n) { const f32x4 v = acc[ai][bj][m][n] * f; u32x2 w; w.x = cvt_pk_bf16(v[0], v[1]); w.y = cvt_pk_bf16(v[2], v[3]);
                        *(u32x2*)(rowp + bj * 128 + n * 16) = w; }
            }
        asm volatile("s_waitcnt lgkmcnt(0)" ::: "memory"); __builtin_amdgcn_s_barrier(); asm volatile("" ::: "memory");
    }
};
struct EpiMoe1 {
    static constexpr bool PERM = true;
    bf16_t* ACTB; const float* srs; const float* sgw;
    __device__ __forceinline__ void operator()(const Acc& acc, const Unit& u, int wr, int wc, int fr, int fq, LAS unsigned char*) const {
        const int row0 = u.pm * 256 + wr * 64 + fr, col0 = u.pn * 128 + wc * 32 + 8 * fq;
#pragma unroll
        for (int ai = 0; ai < 2; ++ai)
#pragma unroll
            for (int m = 0; m < 4; ++m) { const int row = row0 + ai * 128 + m * 16; const int lrow = u.aux * 16384 + u.lr + wr * 64 + fr + ai * 128 + m * 16; const float rs = srs[lrow], gw = sgw[lrow] * rs;
                float o[8];
#pragma unroll
                for (int n = 0; n < 2; ++n)
#pragma unroll
                    for (int j = 0; j < 4; ++j) { const float g = acc[ai][0][m][n][j] * rs, up = acc[ai][1][m][n][j]; o[n * 4 + j] = g * sigmoidf_(g) * up * gw; }
                u32x4 w; w.x = cvt_pk_bf16(o[0], o[1]); w.y = cvt_pk_bf16(o[2], o[3]); w.z = cvt_pk_bf16(o[4], o[5]); w.w = cvt_pk_bf16(o[6], o[7]);
                *(u32x4*)(ACTB + (size_t)row * EFF + col0) = w; }
    }
};

struct Args { const void* in[20]; float* out; unsigned char* ws; int ph_lo, ph_hi; };
struct Frame {
    LAS unsigned char* lds; volatile LAS unsigned* MISC; gu32* ctl;
    int tid, lane, wave, vcu, G;
    unsigned char* ws; float* out; size_t z; int dry;
};

__device__ __forceinline__ void transpose_item(const float* W, int N, const float* scale, bf16_t* WT, int ldt, int row_base, int k0, int n0, LAS float* scr, int lane) {
    f32x4 v[8];
#pragma unroll
    for (int i = 0; i < 8; ++i) v[i] = *(const GAS f32x4*)(W + (size_t)(k0 + 8 * i + (lane >> 3)) * N + n0 + 4 * (lane & 7));
#pragma unroll
    for (int i = 0; i < 8; ++i) { const int kk = 8 * i + (lane >> 3); f32x4 x = v[i]; if (scale) x = x * scale[k0 + kk]; LAS float* d = scr + kk * 33 + 4 * (lane & 7); d[0] = x.x; d[1] = x.y; d[2] = x.z; d[3] = x.w; }
    LDS_WAIT(); asm volatile("" ::: "memory");
    const int c = lane & 7;
#pragma unroll
    for (int j = 0; j < 4; ++j) { const int n = (lane >> 3) + 8 * j; const LAS float* s = scr + (8 * c) * 33 + n;
        u32x4 o; o.x = pk2(s[0 * 33], s[1 * 33]); o.y = pk2(s[2 * 33], s[3 * 33]); o.z = pk2(s[4 * 33], s[5 * 33]); o.w = pk2(s[6 * 33], s[7 * 33]);
        *(GAS u32x4*)(WT + (size_t)(row_base + n0 + n) * ldt + k0 + 8 * c) = o; }
    LDS_WAIT(); asm volatile("" ::: "memory");
}
__device__ __forceinline__ void transpose_mat_item(const float* W, int K, int N, const float* scale, bf16_t* WT, int mode, int it, LAS float* scr, int lane) {
    const int nblk = N / 32, kb = it / nblk, nb = it % nblk, k0 = 64 * kb, n0 = 32 * nb;
    int row_base = 0;
    if (mode == 1 || mode == 2) row_base = 256 * (n0 / 128) + (n0 % 128) + (mode == 2 ? 128 : 0) - n0;
    if (mode == 3 && n0 >= 2048 && n0 < 3072) {
        const int blk = (n0 - 2048) / 512, np = (n0 - 2048) % 512, head = np / 64, d = np % 64;
        row_base = 2048 + blk * 512 + (head / 4) * 256 + 128 * (d / 32) + 32 * (head % 4) + (d % 32) - n0; }
    transpose_item(W, N, scale, WT, K, row_base, k0, n0, scr, lane);
}

__device__ __forceinline__ float row_norm_prep(const float* xrow, bf16_t* xb_row, float* copy_row, int lane) {
    const GAS f32x4* xr = (const GAS f32x4*)xrow + lane;
    f32x4 v[4]; float s = 0.f;
#pragma unroll
    for (int j = 0; j < 4; ++j) { v[j] = xr[64 * j]; s += (v[j].x * v[j].x + v[j].y * v[j].y) + (v[j].z * v[j].z + v[j].w * v[j].w); }
    const float rstd = 1.f / sqrtf(wave_sum(s) * (1.f / DM) + EPS);
    GAS u32x2* o8 = (GAS u32x2*)xb_row + lane;
#pragma unroll
    for (int j = 0; j < 4; ++j) { u32x2 w; w.x = pk2(v[j].x, v[j].y); w.y = pk2(v[j].z, v[j].w); o8[64 * j] = w; }
    if (copy_row) { GAS f32x4* c = (GAS f32x4*)copy_row + lane;
#pragma unroll
        for (int j = 0; j < 4; ++j) c[64 * j] = v[j]; }
    return rstd;
}

__constant__ double INV_FREQ[32] = {1.0, 0.7498942093324559, 0.5623413251903491, 0.4216965034285822, 0.31622776601683794, 0.23713737056616552, 0.1778279410038923, 0.1333521432163324,
    0.1, 0.07498942093324558, 0.05623413251903491, 0.042169650342858224, 0.03162277660168379, 0.023713737056616554, 0.01778279410038923, 0.01333521432163324,
    0.01, 0.007498942093324558, 0.005623413251903491, 0.004216965034285823, 0.0031622776601683794, 0.0023713737056616554, 0.0017782794100389228, 0.001333521432163324,
    0.001, 0.0007498942093324559, 0.0005623413251903491, 0.00042169650342858224, 0.00031622776601683794, 0.00023713737056616554, 0.00017782794100389227, 0.0001333521432163324};


#define IN_F(i) ((const float*)((const char*)a.in[i] + F.z))
__device__ __forceinline__ float hg_lb(const Frame& F, const Args& a, int l, int c) { if (l == 0) return 0.f; const float* h = IN_F(5); return sigmoidf_(h[HGW + c] - h[c]); }
__device__ __forceinline__ void conv_small_item(Frame& F, const Args& a, int l, int r, LAS float* scr) {
    unsigned char* ws = F.ws; const int lane = F.lane;
    if (r < 1792) { transpose_mat_item(IN_F(4) + (size_t)l * DM * NIN, DM, NIN, IN_F(3) + l * DM, (bf16_t*)(ws + WS_WIN) + (size_t)l * NIN * DM, 3, r, scr, lane); return; } r -= 1792;
    if (r < 512) { transpose_mat_item(IN_F(7) + (size_t)l * DM * DM, DM, DM, nullptr, (bf16_t*)(ws + WS_WOUT) + (size_t)l * DM * DM, 0, r, scr, lane); return; } r -= 512;
    if (r < 1024) { transpose_mat_item(IN_F(11) + (size_t)l * DM * 2 * DM, DM, 2 * DM, nullptr, (bf16_t*)(ws + WS_WKVT) + (size_t)l * 2 * DM * DM, 0, r, scr, lane); return; } r -= 1024;
    transpose_mat_item(IN_F(12) + (size_t)l * DM * DM, DM, DM, nullptr, (bf16_t*)(ws + WS_WOT) + (size_t)l * DM * DM, 0, r, scr, lane);
}
__device__ __forceinline__ void conv_wq_row(Frame& F, const Args& a, int r) {
    const int lane = F.lane; const float sc = IN_F(8)[r] * 0.0625f;
    const GAS f32x4* src = (const GAS f32x4*)(IN_F(10) + (size_t)r * DM) + lane; GAS u32x2* dst = (GAS u32x2*)((bf16_t*)(F.ws + WS_WQS) + (size_t)r * DM) + lane;
#pragma unroll
    for (int j = 0; j < 4; ++j) { const f32x4 v = src[64 * j] * sc; u32x2 w; w.x = pk2(v.x, v.y); w.y = pk2(v.z, v.w); dst[64 * j] = w; }
}
__device__ __forceinline__ void conv_small_l1(Frame& F, const Args& a, int wi, int nw) {
    LAS float* scr = (LAS float*)(F.lds + F.wave * 16384);
    for (int it = wi; it < 2816; it += nw) conv_small_item(F, a, 1, it < 2304 ? it : it + 1024, scr);
    for (int r = wi; r < DM; r += nw) conv_wq_row(F, a, DM + r);
}
__device__ __forceinline__ void ph_init(Frame& F, const Args& a) {
    LAS float* scr = (LAS float*)(F.lds + F.wave * 16384);
    const int gw = F.vcu * NWAVES + F.wave, NGW = F.G * NWAVES, lane = F.lane;
    unsigned char* ws = F.ws;
    for (int it = gw; it < 3840 + 1024; it += NGW) {
        if (it < 3840) conv_small_item(F, a, 0, it, scr); else conv_small_item(F, a, 1, 2304 + (it - 3840), scr); }
    for (int r = gw; r < DM; r += NGW) conv_wq_row(F, a, r);
    for (int r = gw; r < MEMROWS; r += NGW) {
        const GAS f32x4* xr = (const GAS f32x4*)(IN_F(1) + (size_t)r * DM) + lane;
        f32x4 v[4]; float s = 0.f;
#pragma unroll
        for (int j = 0; j < 4; ++j) { v[j] = xr[64 * j]; s += (v[j].x * v[j].x + v[j].y * v[j].y) + (v[j].z * v[j].z + v[j].w * v[j].w); }
        const float rstd = 1.f / sqrtf(wave_sum(s) * (1.f / DM) + EPS);
        for (int l = 0; l < DEPTH; ++l) {
            const GAS f32x4* g = (const GAS f32x4*)(IN_F(9) + l * DM) + lane; GAS u32x2* dst = (GAS u32x2*)((bf16_t*)(ws + WS_MEMN) + ((size_t)l * MEMROWS + r) * DM) + lane;
#pragma unroll
            for (int j = 0; j < 4; ++j) { const f32x4 o = v[j] * rstd * g[64 * j]; u32x2 w; w.x = pk2(o.x, o.y); w.y = pk2(o.z, o.w); dst[64 * j] = w; }
        }
    }
    for (int r = gw; r < MT; r += NGW) {
        const float rs = row_norm_prep(IN_F(0) + (size_t)r * DM, (bf16_t*)(ws + WS_XB) + (size_t)r * DM, nullptr, lane);
        if (lane == 0) ((float*)(ws + WS_RSTD))[r] = rs;
    }
    for (int i = (F.vcu * NTHR + F.tid); i < DEPTH * HGW; i += F.G * NTHR) ((float*)(ws + WS_LBT))[i] = hg_lb(F, a, i / HGW, i % HGW);
    { const int* pos = (const int*)((const char*)a.in[2] + F.z);
      for (int i = (F.vcu * NTHR + F.tid); i < MT * 32; i += F.G * NTHR) { const double ang = (double)pos[i >> 5] * INV_FREQ[i & 31]; double rev = ang * 0.15915494309189535; rev = rev - __builtin_floor(rev);
          const float fr = (float)rev; ((f32x2*)(ws + WS_CS))[i] = (f32x2){__builtin_amdgcn_cosf(fr), __builtin_amdgcn_sinf(fr)}; } }
    for (int i = (F.vcu * NTHR + F.tid); i < DEPTH * 32 * DM; i += F.G * NTHR) {
        const int l = i / (32 * DM), n = (i / DM) % 32, k = i % DM;
        float w = 0.f;
        if (n < 4) w = IN_F(14)[((size_t)l * DM + k) * 4 + n]; else if (n < 20) w = IN_F(15)[((size_t)l * DM + k) * 16 + (n - 4)];
        w *= IN_F(13)[l * DM + k];
        const unsigned hi = f2bf(w); const float rem = w - bf2f((unsigned short)hi);
        ((bf16_t*)(ws + WS_WR))[i] = (bf16_t)hi; ((bf16_t*)(ws + WS_WR) + DEPTH * 32 * DM)[i] = (bf16_t)f2bf(rem);
    }
}

struct SchedKV {
    int G, c; const char* memn; const char* wkvt;
    __device__ __forceinline__ bool next(int i, Unit& u) const {
        const int L = i * G + c; if (L >= 32) return false;
        const int l = L >> 4; u.pm = (L >> 3) & 1; u.pn = L & 7; u.aux = l;
        u.a = memn + ((size_t)l * MEMROWS + u.pm * 256) * DM * 2; u.b = wkvt + ((size_t)l * 2 * DM + u.pn * 256) * DM * 2; return true;
    }
};
struct SchedFold {
    int G, c; const char* kb; const char* vb; const char* wqs; const char* wot;
    __device__ __forceinline__ bool next(int i, Unit& u) const {
        const int L = i * G + c; if (L >= 128) return false;
        const int ty = L >> 6, l = (L >> 5) & 1, b = (L >> 4) & 1, h = (L >> 2) & 3, t = L & 3; u.aux = ty * 4 + l * 2 + b;
        if (ty == 0) { u.pm = h; u.pn = t; u.a = kb + (((size_t)l * MEMROWS + b * 256) * DM + h * 256) * 2; u.b = wqs + (((size_t)l * DM + t * 256) * DM + h * 256) * 2; }
        else { u.pm = t; u.pn = h; u.a = wot + (((size_t)l * DM + t * 256) * DM + h * 256) * 2; u.b = vb + (((size_t)l * MEMROWS + b * 256) * DM + h * 256) * 2; }
        return true;
    }
};
struct SchedMoe {
    int G, c, kdim; volatile LAS unsigned* tb; const char* A; const char* B; const int* perm2; const unsigned* cnt; bool gather; int mode, early, rem; unsigned* done;
    __device__ __forceinline__ bool next(int i, Unit& u) const {
        const int total = __builtin_amdgcn_readfirstlane((int)tb[16]) * 4; int L;
        if (mode == 0) L = i * G + c;
        else if (mode == 1) { L = i * G + c; if (L >= early) return false; }
        else if (mode == 2) { if (i > 0 || c >= rem) return false; L = early + c; }
        else { const int cc = c >= rem ? c - rem : c - rem + G; L = c >= rem ? (i == 0 ? cc : (G - rem) + (i - 1) * G + cc) : (G - rem) + i * G + cc; }
        if (L >= total) return false;
        const int mt = L >> 2; u.pm = mt; u.pn = L & 3; int e = 0;
#pragma unroll
        for (int j = 1; j < 16; ++j) e += (mt >= __builtin_amdgcn_readfirstlane((int)tb[j])) ? 1 : 0;
        u.aux = e; u.lr = (mt - __builtin_amdgcn_readfirstlane((int)tb[e])) * 256; u.a = gather ? A : A + (size_t)mt * 256 * kdim * 2; u.b = B + ((size_t)e * 1024 + u.pn * 256) * kdim * 2;
        if (mode == 3 && L >= early) {
            unsigned spins = 0; while (__hip_atomic_load(done + mt, __ATOMIC_RELAXED, __HIP_MEMORY_SCOPE_AGENT) < 4u) { __builtin_amdgcn_s_sleep(8); if (++spins > (1u << 18)) break; }
            __builtin_amdgcn_fence(__ATOMIC_ACQUIRE, "agent"); asm volatile("s_waitcnt vmcnt(0)" ::: "memory"); }
        return true;
    }
    __device__ __forceinline__ int src_row(const Unit& u, int r) const { const int lrow = u.lr + r; const int n = __builtin_amdgcn_readfirstlane((int)cnt[64 * u.aux]); return lrow < n ? perm2[u.aux * 16384 + lrow] : 0; }
};

__device__ __forceinline__ void vf_unit(Frame& F, int unit) {
    unsigned char* ws = F.ws; const int tid = F.tid;
    const int tb = unit >> 3, h = unit & 7, b = tb >> 4, s_base = (tb & 15) * 512;
    LAS unsigned short* Vl = (LAS unsigned short*)F.lds;
    const bf16_t* V = (const bf16_t*)(ws + A_V) + ((size_t)b * SEQ + s_base) * 512 + h * 64;
#pragma unroll
    for (int p = 0; p < 8; ++p) { const int c = p * 512 + tid, row = c >> 3, ch = c & 7; *(LAS u32x4*)(Vl + row * 72 + ch * 8) = *(const GAS u32x4*)(V + (size_t)row * 512 + ch * 8); }
    __syncthreads();
    const size_t bh = (size_t)(b * ATH + h) * (SEQ * 64);
    for (int it = 0; it < 24; ++it) { const int pc = it * 512 + tid, tile = pc >> 8, q = pc & 255, s = q >> 7, mt = (q >> 6) & 1, ln = q & 63, dim = (ln & 31) + 32 * mt, hi = ln >> 5;
        const int pat = tile >> 4, j16 = tile & 15, sh = pat * 2, D = 1 << sh;
        const int TPC = 16 >> sh, r = j16 / TPC, tl = j16 % TPC;
        const int pl = tl * 32 + 16 * s + 8 * hi;
        unsigned w[4];
#pragma unroll
        for (int jj = 0; jj < 4; ++jj) { const int t0 = ((pl + 2 * jj) << sh) + r, t1 = ((pl + 2 * jj + 1) << sh) + r; w[jj] = (unsigned)Vl[t0 * 72 + dim] | ((unsigned)Vl[t1 * 72 + dim] << 16); }
        const int T = (s_base >> sh >> 5) + tl;
        bf16_t* vf = (bf16_t*)(ws + A_VT1) + (size_t)pat * (MT * 512) + bh + ((size_t)(r * (SEQ / 32 >> sh) + T) * 4 + s * 2 + mt) * 512 + ln * 8;
        *(GAS u32x4*)vf = (u32x4){w[0], w[1], w[2], w[3]}; }
    __syncthreads();
}

__device__ __forceinline__ void hg_build_b(Frame& F, int l, int h, const u32x4 z0, const u32x4 z1, int k0, float (&bb)[16], float (&kk)[16]) {
    const int tid = F.tid, lane = F.lane, wave = F.wave, tl = lane >> 3;
    LAS float* WT = (LAS float*)F.lds; LAS float* REF = (LAS float*)(F.lds + 4096);
    const unsigned zz[8] = {z0.x, z0.y, z0.z, z0.w, z1.x, z1.y, z1.z, z1.w};
    float lbv[16];
#pragma unroll
    for (int i = 0; i < 16; i += 4) { const f32x4 t4 = *(const GAS f32x4*)((const float*)(F.ws + WS_LBT) + l * HGW + h * 128 + k0 + i); lbv[i] = t4.x; lbv[i + 1] = t4.y; lbv[i + 2] = t4.z; lbv[i + 3] = t4.w; }
#pragma unroll
    for (int i = 0; i < 16; ++i) { const float z = (i & 1) ? bfhi(zz[i >> 1]) : bflo(zz[i >> 1]); const float lb = lbv[i];
        const float e = ex2(-LOG2E * z), sg = __builtin_amdgcn_rcpf(1.f + e), f = lb + (1.f - lb) * sg; bb[i] = __builtin_amdgcn_logf(f); kk[i] = (1.f - lb) * (e * sg); }
#pragma unroll
    for (int i = 0; i < 16; ++i) { float x = bb[i]; float y;
        y = __shfl_up(x, 8); if (tl >= 1) x += y;
        y = __shfl_up(x, 16); if (tl >= 2) x += y;
        y = __shfl_up(x, 32); if (tl >= 4) x += y;
        bb[i] = x; }
    if (tl == 7) {
#pragma unroll
        for (int i = 0; i < 16; i += 4) *(LAS f32x4*)(WT + wave * 128 + k0 + i) = (f32x4){bb[i], bb[i + 1], bb[i + 2], bb[i + 3]}; }
    __syncthreads();
    for (int w = 0; w < wave; ++w) {
#pragma unroll
        for (int i = 0; i < 16; i += 4) { const f32x4 p = *(const LAS f32x4*)(WT + w * 128 + k0 + i); bb[i] += p.x; bb[i + 1] += p.y; bb[i + 2] += p.z; bb[i + 3] += p.w; } }
    if (tl == 7 && (wave & 1)) {
#pragma unroll
        for (int i = 0; i < 16; i += 4) *(LAS f32x4*)(REF + (wave >> 1) * 128 + k0 + i) = (f32x4){bb[i], bb[i + 1], bb[i + 2], bb[i + 3]}; }
    __syncthreads();
    (void)tid;
}
__device__ __forceinline__ void st_row16(LAS unsigned char* base, int byteoff, const float (&v)[16]) {
    u32x4 w0, w1; w0.x = cvt_pk_bf16(v[0], v[1]); w0.y = cvt_pk_bf16(v[2], v[3]); w0.z = cvt_pk_bf16(v[4], v[5]); w0.w = cvt_pk_bf16(v[6], v[7]); w1.x = cvt_pk_bf16(v[8], v[9]); w1.y = cvt_pk_bf16(v[10], v[11]); w1.z = cvt_pk_bf16(v[12], v[13]); w1.w = cvt_pk_bf16(v[14], v[15]);
    *(LAS u32x4*)(base + byteoff) = w0; *(LAS u32x4*)(base + byteoff + 16) = w1;
}
constexpr int HL_RED = 6144, HL_QD = 8192, HL_KD = 25600, HL_QE = 43008, HL_Q1 = 60416, HL_K1 = 69120, HL_Q2 = 77824, HL_K2 = 86528, HL_VT = 95232, HL_SC = 113664;
constexpr int HA_KT = 8192, HA_VT = 26624;
constexpr int RS128 = 272, RS64 = 144;

struct HgIn { u32x4 z0, z1, q0, q1, v0, v1; };
template <bool NEEDQ> __device__ __forceinline__ HgIn hg_load(Frame& F, int unit) {
    HgIn R;
    const int b = unit >> 9, h = (unit >> 7) & 3, c = unit & 127; const int row0 = b * SEQ + c * CHUNK, t = F.tid >> 3, k0 = (F.tid & 7) * 16;
    const bf16_t* rowp = (const bf16_t*)(F.ws + A_HG) + (size_t)(row0 + t) * 2048 + h * 128 + k0;
    R.z0 = *(const GAS u32x4*)(rowp + 512); R.z1 = *(const GAS u32x4*)(rowp + 512 + 8); R.v0 = *(const GAS u32x4*)(rowp + 1024); R.v1 = *(const GAS u32x4*)(rowp + 1024 + 8);
    if (NEEDQ) { R.q0 = *(const GAS u32x4*)(rowp); R.q1 = *(const GAS u32x4*)(rowp + 8); } else { R.q0 = R.z0; R.q1 = R.z1; }
    return R;
}
__device__ __forceinline__ void hg_a2_unit(Frame& F, const Args& a, int l, int unit, const HgIn& R) {
    unsigned char* ws = F.ws; const int tid = F.tid, lane = F.lane, wave = F.wave;
    const int h = (unit >> 7) & 3;
    const int t = tid >> 3, k0 = (tid & 7) * 16;
    const u32x4 v0 = R.v0, v1 = R.v1;
    float bb[16], kk[16];
    hg_build_b(F, l, h, R.z0, R.z1, k0, bb, kk);
    const LAS float* REF = (const LAS float*)(F.lds + 4096);
    LAS unsigned short* KT = (LAS unsigned short*)(F.lds + HA_KT); LAS unsigned short* VT = (LAS unsigned short*)(F.lds + HA_VT);
    const unsigned vv[8] = {v0.x, v0.y, v0.z, v0.w, v1.x, v1.y, v1.z, v1.w};
#pragma unroll
    for (int i = 0; i < 16; ++i) { const float b63 = REF[3 * 128 + k0 + i];
        KT[(k0 + i) * (RS64 / 2) + t] = (unsigned short)f2bf(kk[i] * ex2(b63 - bb[i]));
        VT[(k0 + i) * (RS64 / 2) + t] = (unsigned short)((i & 1) ? (vv[i >> 1] >> 16) : (vv[i >> 1] & 0xffffu)); }
    if (tid < 128) ((float*)(ws + A_DECAY))[(size_t)unit * 128 + tid] = ex2(REF[3 * 128 + tid]);
    __syncthreads();
    { const int fr = lane & 15, g = lane >> 4;
      bf16x8 af[2];
#pragma unroll
      for (int ks = 0; ks < 2; ++ks) af[ks] = *(const LAS bf16x8*)(F.lds + HA_KT + (wave * 16 + fr) * RS64 + (32 * ks + 8 * g) * 2);
      bf16_t* st = (bf16_t*)(ws + A_STATE) + (size_t)unit * 16384;
#pragma unroll
      for (int vt = 0; vt < 8; ++vt) { f32x4 acc = {0.f, 0.f, 0.f, 0.f};
#pragma unroll
          for (int ks = 0; ks < 2; ++ks) { const bf16x8 bf = *(const LAS bf16x8*)(F.lds + HA_VT + (vt * 16 + fr) * RS64 + (32 * ks + 8 * g) * 2); acc = __builtin_amdgcn_mfma_f32_16x16x32_bf16(af[ks], bf, acc, 0, 0, 0); }
          u32x2 w; w.x = cvt_pk_bf16(acc[0], acc[1]); w.y = cvt_pk_bf16(acc[2], acc[3]);
          *(GAS u32x2*)(st + (vt * 16 + fr) * 128 + wave * 16 + 4 * g) = w; } }
    __syncthreads();
}

template <int STOP> __device__ __forceinline__ void hg_c2_unit(Frame& F, const Args& a, int l, int unit, const HgIn& R) {
    unsigned char* ws = F.ws; const int tid = F.tid, lane = F.lane, wave = F.wave;
    const int b = unit >> 9, h = (unit >> 7) & 3, c = unit & 127; const int row0 = b * SEQ + c * CHUNK;
    const int t = tid >> 3, k0 = (tid & 7) * 16;
    const int fr = lane & 15, g = lane >> 4;
    const bf16_t* HG = (const bf16_t*)(ws + A_HG);
    const u32x4 q0 = R.q0, q1 = R.q1, v0 = R.v0, v1 = R.v1;
    bf16x8 sf[4]; u32x2 gwv[4];
    { const bf16_t* st = (const bf16_t*)(ws + A_STATE) + (size_t)unit * 16384 + (wave * 16 + fr) * 128;
#pragma unroll
      for (int ks = 0; ks < 4; ++ks) sf[ks] = *(const GAS bf16x8*)(st + 32 * ks + 8 * g);
#pragma unroll
      for (int I = 0; I < 4; ++I) gwv[I] = *(const GAS u32x2*)(HG + (size_t)(row0 + 16 * I + fr) * 2048 + 1536 + h * 128 + wave * 16 + 4 * g); }
    const f32x4 gain = *(const GAS f32x4*)(IN_F(6) + l * HGW + h * 128 + wave * 16 + 4 * g);
    float bb[16], kk[16];
    hg_build_b(F, l, h, R.z0, R.z1, k0, bb, kk);
    if (STOP == 1) { asm volatile("" :: "v"(bb[0]), "v"(kk[0]), "v"(sf[0]), "v"(gwv[0]), "v"(gain)); return; }
    const LAS float* REF = (const LAS float*)(F.lds + 4096);
    { const unsigned qq[8] = {q0.x, q0.y, q0.z, q0.w, q1.x, q1.y, q1.z, q1.w}, vv[8] = {v0.x, v0.y, v0.z, v0.w, v1.x, v1.y, v1.z, v1.w};
      LAS unsigned short* VT = (LAS unsigned short*)(F.lds + HL_VT);
      float qv[16], tmp[16];
#pragma unroll
      for (int i = 0; i < 16; ++i) { qv[i] = (i & 1) ? bfhi(qq[i >> 1]) : bflo(qq[i >> 1]); VT[(k0 + i) * (RS64 / 2) + t] = (unsigned short)((i & 1) ? (vv[i >> 1] >> 16) : (vv[i >> 1] & 0xffffu)); }
      const int I = wave >> 1;
      float rf[16];
#pragma unroll
      for (int i = 0; i < 16; i += 4) { f32x4 r4 = {0.f, 0.f, 0.f, 0.f}; if (I) r4 = *(const LAS f32x4*)(REF + (I - 1) * 128 + k0 + i); rf[i] = r4.x; rf[i + 1] = r4.y; rf[i + 2] = r4.z; rf[i + 3] = r4.w; }
#pragma unroll
      for (int i = 0; i < 16; ++i) tmp[i] = qv[i] * ex2(bb[i] - rf[i]);
      st_row16(F.lds, HL_QD + t * RS128 + k0 * 2, tmp);
#pragma unroll
      for (int i = 0; i < 16; ++i) tmp[i] = kk[i] * ex2(fminf(rf[i] - bb[i], 86.f));
      st_row16(F.lds, HL_KD + t * RS128 + k0 * 2, tmp);
#pragma unroll
      for (int i = 0; i < 16; ++i) tmp[i] = qv[i] * ex2(bb[i]);
      st_row16(F.lds, HL_QE + t * RS128 + k0 * 2, tmp);
#pragma unroll
      for (int i = 0; i < 16; i += 4) { const f32x4 r4 = *(const LAS f32x4*)(REF + 1 * 128 + k0 + i); rf[i] = r4.x; rf[i + 1] = r4.y; rf[i + 2] = r4.z; rf[i + 3] = r4.w; }
      if (wave >= 4) {
#pragma unroll
          for (int i = 0; i < 16; ++i) tmp[i] = qv[i] * ex2(bb[i] - rf[i]);
          st_row16(F.lds, HL_Q1 + (t & 31) * RS128 + k0 * 2, tmp);
      } else {
#pragma unroll
          for (int i = 0; i < 16; ++i) tmp[i] = kk[i] * ex2(rf[i] - bb[i]);
          st_row16(F.lds, HL_K1 + (t & 31) * RS128 + k0 * 2, tmp);
      }
#pragma unroll
      for (int i = 0; i < 16; i += 4) { const f32x4 r4 = *(const LAS f32x4*)(REF + ((wave >= 4) ? 2 : 0) * 128 + k0 + i); rf[i] = r4.x; rf[i + 1] = r4.y; rf[i + 2] = r4.z; rf[i + 3] = r4.w; }
      if (wave & 2) {
#pragma unroll
          for (int i = 0; i < 16; ++i) tmp[i] = qv[i] * ex2(bb[i] - rf[i]);
          st_row16(F.lds, HL_Q2 + ((t & 15) + ((wave >= 4) ? 16 : 0)) * RS128 + k0 * 2, tmp);
      } else {
#pragma unroll
          for (int i = 0; i < 16; ++i) tmp[i] = kk[i] * ex2(rf[i] - bb[i]);
          st_row16(F.lds, HL_K2 + ((t & 15) + ((wave >= 4) ? 16 : 0)) * RS128 + k0 * 2, tmp);
      }
      for (int i = tid; i < 64 * RS64 / 16; i += NTHR) *(LAS u32x4*)(F.lds + HL_SC + i * 16) = (u32x4){0u, 0u, 0u, 0u};
    }
    __syncthreads();
    if (STOP == 2) { asm volatile("" :: "v"(sf[0]), "v"(gwv[0]), "v"(gain)); return; }
    for (int blk = wave; blk < 10; blk += 8) {
        int ko, qo, J, I; bool diag = false;
        if (blk < 4) { ko = HL_KD + blk * 16 * RS128; qo = HL_QD + blk * 16 * RS128; J = blk; I = blk; diag = true; }
        else if (blk == 4) { ko = HL_K2; qo = HL_Q2; J = 0; I = 1; }
        else if (blk == 5) { ko = HL_K2 + 16 * RS128; qo = HL_Q2 + 16 * RS128; J = 2; I = 3; }
        else { const int jj = (blk - 6) >> 1, ii = (blk - 6) & 1; ko = HL_K1 + jj * 16 * RS128; qo = HL_Q1 + ii * 16 * RS128; J = jj; I = 2 + ii; }
        f32x4 acc = {0.f, 0.f, 0.f, 0.f};
#pragma unroll
        for (int ks = 0; ks < 4; ++ks) { const bf16x8 af = *(const LAS bf16x8*)(F.lds + ko + fr * RS128 + (32 * ks + 8 * g) * 2), bf = *(const LAS bf16x8*)(F.lds + qo + fr * RS128 + (32 * ks + 8 * g) * 2);
            acc = __builtin_amdgcn_mfma_f32_16x16x32_bf16(af, bf, acc, 0, 0, 0); }
        if (diag) {
#pragma unroll
            for (int rg = 0; rg < 4; ++rg) if (4 * g + rg > fr) acc[rg] = 0.f; }
        u32x2 w; w.x = cvt_pk_bf16(acc[0], acc[1]); w.y = cvt_pk_bf16(acc[2], acc[3]);
        *(LAS u32x2*)(F.lds + HL_SC + (16 * I + fr) * RS64 + (16 * J + 4 * g) * 2) = w;
    }
    __syncthreads();
    if (STOP == 3) { asm volatile("" :: "v"(sf[0]), "v"(gwv[0]), "v"(gain)); return; }
    f32x4 o[4];
#pragma unroll
    for (int I = 0; I < 4; ++I) o[I] = (f32x4){0.f, 0.f, 0.f, 0.f};
    { bf16x8 af[2];
#pragma unroll
      for (int ks = 0; ks < 2; ++ks) af[ks] = *(const LAS bf16x8*)(F.lds + HL_VT + (wave * 16 + fr) * RS64 + (32 * ks + 8 * g) * 2);
#pragma unroll
      for (int I = 0; I < 4; ++I)
#pragma unroll
          for (int ks = 0; ks < 2; ++ks) { const bf16x8 bf = *(const LAS bf16x8*)(F.lds + HL_SC + (16 * I + fr) * RS64 + (32 * ks + 8 * g) * 2); o[I] = __builtin_amdgcn_mfma_f32_16x16x32_bf16(af[ks], bf, o[I], 0, 0, 0); }
#pragma unroll
      for (int I = 0; I < 4; ++I)
#pragma unroll
          for (int ks = 0; ks < 4; ++ks) { const bf16x8 bf = *(const LAS bf16x8*)(F.lds + HL_QE + (16 * I + fr) * RS128 + (32 * ks + 8 * g) * 2); o[I] = __builtin_amdgcn_mfma_f32_16x16x32_bf16(sf[ks], bf, o[I], 0, 0, 0); }
    }
    if (STOP == 4) { asm volatile("" :: "v"(o[0]), "v"(o[1]), "v"(o[2]), "v"(o[3]), "v"(gwv[0]), "v"(gain)); return; }
    LAS float* RED = (LAS float*)(F.lds + HL_RED);
#pragma unroll
    for (int I = 0; I < 4; ++I) { float q = (o[I][0] * o[I][0] + o[I][1] * o[I][1]) + (o[I][2] * o[I][2] + o[I][3] * o[I][3]); q += __shfl_xor(q, 16); q += __shfl_xor(q, 32); if (g == 0) RED[wave * 64 + 16 * I + fr] = q; }
    __syncthreads();
    { bf16_t* Y = (bf16_t*)(ws + WS_XB);
#pragma unroll
      for (int I = 0; I < 4; ++I) { const int tt = 16 * I + fr; float ssq = 0.f;
#pragma unroll
          for (int w = 0; w < 8; ++w) ssq += RED[w * 64 + tt];
          const float rs = __builtin_amdgcn_rsqf(ssq * (1.f / 128.f) + EPS);
          const u32x2 gw = gwv[I];
          const float g0 = bflo(gw.x), g1 = bfhi(gw.x), g2 = bflo(gw.y), g3 = bfhi(gw.y);
          u32x2 w; w.x = cvt_pk_bf16(o[I][0] * rs * gain.x * (g0 * sigmoidf_(g0)), o[I][1] * rs * gain.y * (g1 * sigmoidf_(g1)));
          w.y = cvt_pk_bf16(o[I][2] * rs * gain.z * (g2 * sigmoidf_(g2)), o[I][3] * rs * gain.w * (g3 * sigmoidf_(g3)));
          *(GAS u32x2*)(Y + (size_t)(row0 + tt) * DM + h * 128 + wave * 16 + 4 * g) = w; } }
    __syncthreads();
}

__device__ __forceinline__ void hg_scan(Frame& F) {
    unsigned char* ws = F.ws;
    for (int gid = F.vcu * NTHR + F.tid; gid < BATCH * HGH * 16384; gid += F.G * NTHR) {
        const int bh = gid >> 14, e = gid & 16383, k = e & 127;
        bf16_t* st = (bf16_t*)(ws + A_STATE) + (size_t)bh * NCHUNK * 16384 + e; const float* dc = (const float*)(ws + A_DECAY) + (size_t)bh * NCHUNK * 128 + k;
        float S = 0.f;
        for (int c0 = 0; c0 < NCHUNK; c0 += 8) { float kv[8], d[8];
#pragma unroll
            for (int i = 0; i < 8; ++i) { kv[i] = bf2f(st[(size_t)(c0 + i) * 16384]); d[i] = dc[(c0 + i) * 128]; }
#pragma unroll
            for (int i = 0; i < 8; ++i) { st[(size_t)(c0 + i) * 16384] = (bf16_t)f2bf(F.dry ? kv[i] : S); S = d[i] * S + kv[i]; } }
    }
}


typedef float f32x16 __attribute__((ext_vector_type(16)));
template <int D, int PAT>
__device__ __forceinline__ void att_pattern(Frame& F, int b, int h, int s_base, float kmax2, const bf16_t* QR, const bf16_t* KF, const bf16_t* VF) {
    const int lane = F.lane, wave = F.wave, r32 = lane & 31, hi = lane >> 5;
    LAS float* ACC = (LAS float*)F.lds; LAS float* LS = (LAS float*)(F.lds + 131072);
    constexpr int TPC = 16 / D, NT = SEQ / D / 32;
    const size_t bh = (size_t)(b * ATH + h) * (SEQ * 64);
    for (int jj = 0; jj < 2; ++jj) {
        const int j = wave + 8 * jj, r = j / TPC, tile = j % TPC, p0 = s_base / D + tile * 32;
        const size_t qrow = (size_t)b * SEQ + (size_t)(p0 + r32) * D + r;
        bf16x8 qf[4];
#pragma unroll
        for (int kk = 0; kk < 4; ++kk) qf[kk] = *(const GAS bf16x8*)(QR + qrow * 512 + h * 64 + 16 * kk + 8 * hi);
        float qn2 = 0.f;
#pragma unroll
        for (int kk = 0; kk < 4; ++kk)
#pragma unroll
            for (int e = 0; e < 8; ++e) { const float x = bf2f((unsigned short)qf[kk][e]); qn2 += x * x; }
        qn2 += __shfl_xor(qn2, 32);
        const float negM = -sqrtf(qn2 * kmax2);
        f32x16 o[2] = {{}, {}}; float lsum = 0.f;
#pragma unroll
        for (int kt = 0; kt < 5; ++kt) {
            const float c0 = (p0 - 128 + 32 * kt) < 0 ? -1.0e30f : negM;
            bf16x8 vfr[2][2], kf[4];
            { const int kb = p0 - 128 + 32 * kt, kbc = kb < 0 ? 0 : kb;
              const bf16_t* kp = KF + bh + ((size_t)(r * NT + (kbc >> 5)) * 4) * 512 + lane * 8;
#pragma unroll
              for (int kk = 0; kk < 4; ++kk) kf[kk] = *(const GAS bf16x8*)(kp + kk * 512);
#pragma unroll
              for (int s = 0; s < 2; ++s)
#pragma unroll
                  for (int mt = 0; mt < 2; ++mt) vfr[s][mt] = *(const GAS bf16x8*)(VF + bh + ((size_t)(r * NT + (kbc >> 5)) * 4 + s * 2 + mt) * 512 + lane * 8); }
            f32x16 acc;
#pragma unroll
            for (int rg = 0; rg < 16; ++rg) acc[rg] = c0;
#pragma unroll
            for (int kk = 0; kk < 4; ++kk) acc = __builtin_amdgcn_mfma_f32_32x32x16_bf16(kf[kk], qf[kk], acc, 0, 0, 0);
            if (kt == 0 || kt == 4) {
#pragma unroll
                for (int rg = 0; rg < 16; ++rg) { const int kap = 16 * (rg >> 3) + 8 * hi + (rg & 7); if (kt == 0 ? (kap < r32) : (kap > r32)) acc[rg] = -1.0e30f; } }
#pragma unroll
            for (int rg = 0; rg < 16; ++rg) { acc[rg] = ex2(acc[rg]); lsum += acc[rg]; }
#pragma unroll
            for (int s = 0; s < 2; ++s) {
                u32x4 pw; pw.x = cvt_pk_bf16(acc[8 * s + 0], acc[8 * s + 1]); pw.y = cvt_pk_bf16(acc[8 * s + 2], acc[8 * s + 3]);
                pw.z = cvt_pk_bf16(acc[8 * s + 4], acc[8 * s + 5]); pw.w = cvt_pk_bf16(acc[8 * s + 6], acc[8 * s + 7]);
                const bf16x8 pf = __builtin_bit_cast(bf16x8, pw);
#pragma unroll
                for (int mt = 0; mt < 2; ++mt) o[mt] = __builtin_amdgcn_mfma_f32_32x32x16_bf16(vfr[s][mt], pf, o[mt], 0, 0, 0);
            }
        }
        lsum += __shfl_xor(lsum, 32);
        const int tau = (p0 + r32) * D + r - s_base, gsw = (tau ^ (tau >> 5)) & 31;
        LAS float* arow = ACC + tau * 64;
#pragma unroll
        for (int mt = 0; mt < 2; ++mt)
#pragma unroll
            for (int rg = 0; rg < 16; ++rg) { LAS float* p = arow + ((((rg & 3) + 8 * (rg >> 2) + 4 * hi) ^ gsw) + 32 * mt); if (PAT == 0) *p = o[mt][rg]; else *p += o[mt][rg]; }
        if (hi == 0) { if (PAT == 0) LS[tau] = lsum; else LS[tau] += lsum; }
    }
}
__device__ __forceinline__ void att_unit(Frame& F, int l, int unit) {
    const int tb = unit >> 3, h = unit & 7, b = tb >> 4, s_base = (tb & 15) * 512;
    const bf16_t* QR = (const bf16_t*)(F.ws + A_QR);
    LAS float* ACC = (LAS float*)F.lds; LAS float* LS = (LAS float*)(F.lds + 131072);
    const float kmax2 = __uint_as_float(__hip_atomic_load((unsigned*)(F.ctl + CW_KMAX + l * 16) + b * ATH + h, RLX_AGENT)) * 1.02f;
    att_pattern<1, 0>(F, b, h, s_base, kmax2, QR, (const bf16_t*)(F.ws + A_KF1), (const bf16_t*)(F.ws + A_VT1));
    __syncthreads();
    att_pattern<4, 1>(F, b, h, s_base, kmax2, QR, (const bf16_t*)(F.ws + A_KF4), (const bf16_t*)(F.ws + A_VT4));
    __syncthreads();
    att_pattern<16, 2>(F, b, h, s_base, kmax2, QR, (const bf16_t*)(F.ws + A_KF16), (const bf16_t*)(F.ws + A_VT16));
    __syncthreads();
    { const int tau = F.tid, gsw = (tau ^ (tau >> 5)) & 31; const LAS float* arow = ACC + tau * 64; const float inv = __builtin_amdgcn_rcpf(LS[tau]);
      bf16_t* yrow = (bf16_t*)(F.ws + WS_XB) + ((size_t)b * SEQ + s_base + tau) * DM + 512 + h * 64;
#pragma unroll
      for (int c = 0; c < 8; ++c) { float v[8];
#pragma unroll
          for (int e = 0; e < 8; ++e) v[e] = arow[((8 * c + e) & 32) + (((8 * c + e) & 31) ^ gsw)] * inv;
          u32x4 w; w.x = cvt_pk_bf16(v[0], v[1]); w.y = cvt_pk_bf16(v[2], v[3]); w.z = cvt_pk_bf16(v[4], v[5]); w.w = cvt_pk_bf16(v[6], v[7]); *(GAS u32x4*)(yrow + 8 * c) = w; } }
    __syncthreads();
}

__device__ __forceinline__ void ph_norm(Frame& F, const Args& a) {
    const int gw = F.vcu * NWAVES + F.wave, NGW = F.G * NWAVES;
    for (int r = gw; r < MT; r += NGW) { const float rs = row_norm_prep(F.out + (size_t)r * DM, (bf16_t*)(F.ws + WS_XB) + (size_t)r * DM, nullptr, F.lane); if (F.lane == 0) ((float*)(F.ws + WS_RSTD))[r] = rs; }
}

__device__ __forceinline__ void ph_router(Frame& F, const Args& a, int l) {
    unsigned char* ws = F.ws; const int lane = F.lane;
    const int gw = F.vcu * NWAVES + F.wave, NGW = F.G * NWAVES;
    { LAS float* scr = (LAS float*)(F.lds + F.wave * 16384);
      for (int it = gw; it < 3 * 4096; it += NGW) { const int ty = it >> 12, e = (it >> 8) & 15, r = it & 255;
          if (ty == 0) transpose_mat_item(IN_F(16) + ((size_t)l * NEXP + e) * DM * EFF, DM, EFF, IN_F(13) + l * DM, (bf16_t*)(ws + A_WGU) + (size_t)e * DM * DM, 1, r, scr, lane);
          else if (ty == 1) transpose_mat_item(IN_F(17) + ((size_t)l * NEXP + e) * DM * EFF, DM, EFF, IN_F(13) + l * DM, (bf16_t*)(ws + A_WGU) + (size_t)e * DM * DM, 2, r, scr, lane);
          else transpose_mat_item(IN_F(18) + ((size_t)l * NEXP + e) * EFF * DM, EFF, DM, nullptr, (bf16_t*)(ws + A_WD) + (size_t)e * DM * EFF, 0, r, scr, lane); } }
    __syncthreads();
    unsigned* cnt = (unsigned*)(F.ctl + CW_CNT + l * 16 * 64);
    LAS unsigned* LCNT = (LAS unsigned*)(F.lds + 81920); LAS unsigned* LBASE = (LAS unsigned*)(F.lds + 81984);
    LAS float* LG = (LAS float*)F.lds;
    LAS float* SS = (LAS float*)(F.lds + 16384);
    if (F.tid < 16) LCNT[F.tid] = 0u;
    const bf16_t* WH = (const bf16_t*)(ws + WS_WR) + (size_t)l * 32 * DM; const bf16_t* WL = WH + DEPTH * 32 * DM;
    const int fr = lane & 15, g = lane >> 4, tile = F.wave & 3, kh = F.wave >> 2;
    for (int rt = F.vcu; rt < MT / 64; rt += F.G) {
        const int row = rt * 64 + tile * 16 + fr;
        const float* xrow = F.out + (size_t)row * DM + kh * 512 + 8 * g; bf16_t* xbrow = (bf16_t*)(ws + WS_XB) + (size_t)row * DM + kh * 512 + 8 * g;
        f32x4 acc[2] = {{0.f, 0.f, 0.f, 0.f}, {0.f, 0.f, 0.f, 0.f}}; float ssq = 0.f;
#pragma unroll 4
        for (int ks = 0; ks < 16; ++ks) {
            const f32x4 x0 = *(const GAS f32x4*)(xrow + 32 * ks), x1 = *(const GAS f32x4*)(xrow + 32 * ks + 4);
            ssq += ((x0.x * x0.x + x0.y * x0.y) + (x0.z * x0.z + x0.w * x0.w)) + ((x1.x * x1.x + x1.y * x1.y) + (x1.z * x1.z + x1.w * x1.w));
            u32x4 hw; hw.x = cvt_pk_bf16(x0.x, x0.y); hw.y = cvt_pk_bf16(x0.z, x0.w); hw.z = cvt_pk_bf16(x1.x, x1.y); hw.w = cvt_pk_bf16(x1.z, x1.w);
            u32x4 lw; lw.x = cvt_pk_bf16(x0.x - bflo(hw.x), x0.y - bfhi(hw.x)); lw.y = cvt_pk_bf16(x0.z - bflo(hw.y), x0.w - bfhi(hw.y)); lw.z = cvt_pk_bf16(x1.x - bflo(hw.z), x1.y - bfhi(hw.z)); lw.w = cvt_pk_bf16(x1.z - bflo(hw.w), x1.w - bfhi(hw.w));
            *(GAS u32x4*)(xbrow + 32 * ks) = hw;
            const bf16x8 ah = __builtin_bit_cast(bf16x8, hw), al = __builtin_bit_cast(bf16x8, lw);
#pragma unroll
            for (int ct = 0; ct < 2; ++ct) { const size_t wo = (size_t)(16 * ct + fr) * DM + kh * 512 + 32 * ks + 8 * g;
                const bf16x8 bh = *(const GAS bf16x8*)(WH + wo), bl = *(const GAS bf16x8*)(WL + wo);
                acc[ct] = __builtin_amdgcn_mfma_f32_16x16x32_bf16(ah, bh, acc[ct], 0, 0, 0); acc[ct] = __builtin_amdgcn_mfma_f32_16x16x32_bf16(ah, bl, acc[ct], 0, 0, 0); acc[ct] = __builtin_amdgcn_mfma_f32_16x16x32_bf16(al, bh, acc[ct], 0, 0, 0); }
        }
        ssq += __shfl_xor(ssq, 16); ssq += __shfl_xor(ssq, 32);
        if (g == 0) SS[kh * 64 + tile * 16 + fr] = ssq;
#pragma unroll
        for (int ct = 0; ct < 2; ++ct)
#pragma unroll
            for (int rg = 0; rg < 4; ++rg) LG[(kh * 64 + tile * 16 + 4 * g + rg) * 32 + 16 * ct + fr] = acc[ct][rg];
        __syncthreads();
        if (F.tid < 64) { const int rl = F.tid, r = rt * 64 + rl;
            const float rstd = __builtin_amdgcn_rsqf((SS[rl] + SS[64 + rl]) * (1.f / DM) + EPS);
            float lg[20];
#pragma unroll
            for (int q = 0; q < 20; q += 4) { const f32x4 p0 = *(const LAS f32x4*)(LG + rl * 32 + q), p1 = *(const LAS f32x4*)(LG + (64 + rl) * 32 + q); lg[q] = (p0.x + p1.x) * rstd; lg[q + 1] = (p0.y + p1.y) * rstd; lg[q + 2] = (p0.z + p1.z) * rstd; lg[q + 3] = (p0.w + p1.w) * rstd; }
            ((float*)(ws + WS_RSTD))[r] = rstd;
            int gs = 0; float gm = lg[0];
#pragma unroll
            for (int q = 1; q < 4; ++q) if (lg[q] > gm) { gm = lg[q]; gs = q; }
            float den = 0.f;
#pragma unroll
            for (int q = 0; q < 4; ++q) den += __expf(lg[q] - gm);
            const float gwt = __builtin_amdgcn_rcpf(den);
            float e4[4];
#pragma unroll
            for (int q = 0; q < 4; ++q) e4[q] = gs == 0 ? lg[4 + q] : (gs == 1 ? lg[8 + q] : (gs == 2 ? lg[12 + q] : lg[16 + q]));
            int i1 = 0; float v1 = e4[0];
#pragma unroll
            for (int q = 1; q < 4; ++q) if (e4[q] > v1) { v1 = e4[q]; i1 = q; }
            int i2 = -1; float v2 = -3.0e38f;
#pragma unroll
            for (int q = 0; q < 4; ++q) if (q != i1 && e4[q] > v2) { v2 = e4[q]; i2 = q; }
            const float ex = __expf(v2 - v1), w1 = __builtin_amdgcn_rcpf(1.f + ex), w2 = ex * w1;
            const int id1 = gs * 4 + i1, id2 = gs * 4 + i2;
            int* te = (int*)(ws + WS_TOKE) + 2 * r; float* tw = (float*)(ws + WS_TOKW) + 2 * r; int* tl = (int*)(ws + WS_TOKL) + 2 * r;
            te[0] = id1; te[1] = id2; tw[0] = w1 * gwt; tw[1] = w2 * gwt;
            tl[0] = (int)__hip_atomic_fetch_add(LCNT + id1, 1u, __ATOMIC_RELAXED, __HIP_MEMORY_SCOPE_WORKGROUP); tl[1] = (int)__hip_atomic_fetch_add(LCNT + id2, 1u, __ATOMIC_RELAXED, __HIP_MEMORY_SCOPE_WORKGROUP);
        }
        __syncthreads();
    }
    __syncthreads();
    if (F.tid < 16) LBASE[F.tid] = __hip_atomic_fetch_add(cnt + 64 * F.tid, F.dry ? 0u : LCNT[F.tid], RLX_AGENT);
    __syncthreads();
    for (int rt = F.vcu; rt < MT / 64; rt += F.G) {
        if (F.tid < 128) { const int r = rt * 64 + (F.tid >> 1), k = F.tid & 1;
            const int e = ((const int*)(ws + WS_TOKE))[2 * r + k]; const int li = ((const int*)(ws + WS_TOKL))[2 * r + k] + (int)LBASE[e];
            ((int*)(ws + WS_TOKL))[2 * r + k] = li; ((int*)(ws + A_PERM2))[e * 16384 + li] = r; ((float*)(ws + A_SRS2))[e * 16384 + li] = ((const float*)(ws + WS_RSTD))[r]; ((float*)(ws + A_SGW2))[e * 16384 + li] = ((const float*)(ws + WS_TOKW))[2 * r + k]; } }
}

__device__ __forceinline__ void moe_prefix(Frame& F, int l) {
    if (F.tid == 0) { unsigned acc = 0; for (int e = 0; e < 16; ++e) { F.MISC[16 + e] = acc; const unsigned n = __hip_atomic_load((unsigned*)(F.ctl + CW_CNT + l * 16 * 64) + 64 * e, RLX_AGENT); acc += (n + 255u) >> 8; } F.MISC[32] = acc; }
    __syncthreads();
}

__device__ __forceinline__ void ph_combine(Frame& F, const Args& a, int l) {
    unsigned char* ws = F.ws; const int lane = F.lane;
    const int gw = F.vcu * NWAVES + F.wave, NGW = F.G * NWAVES;
    moe_prefix(F, l);
    const int* tlr = (const int*)(ws + WS_TOKL); const int* te = (const int*)(ws + WS_TOKE); const bf16_t* Y = (const bf16_t*)(ws + A_Y);
    auto slot_of = [&](int p) { return (int)F.MISC[16 + te[p]] * 256 + tlr[p]; };
    auto clampr = [&](int r) { return r < MT ? r : MT - 1; };
    int r = gw; if (r >= MT) return;
    int s0 = slot_of(2 * r), s1 = slot_of(2 * r + 1);
    int rn = clampr(r + NGW); int sn0 = slot_of(2 * rn), sn1 = slot_of(2 * rn + 1);
    f32x4 xv[4]; u32x2 ya[4], yb[4];
#pragma unroll
    for (int j = 0; j < 4; ++j) { xv[j] = ((const GAS f32x4*)(F.out + (size_t)r * DM) + lane)[64 * j]; ya[j] = ((const GAS u32x2*)(Y + (size_t)s0 * DM) + lane)[64 * j]; yb[j] = ((const GAS u32x2*)(Y + (size_t)s1 * DM) + lane)[64 * j]; }
    for (; r < MT; r += NGW) {
        const int rnn = clampr(r + 2 * NGW); const int snn0 = slot_of(2 * rnn), snn1 = slot_of(2 * rnn + 1);
        f32x4 xn[4]; u32x2 yan[4], ybn[4];
#pragma unroll
        for (int j = 0; j < 4; ++j) { xn[j] = ((const GAS f32x4*)(F.out + (size_t)rn * DM) + lane)[64 * j]; yan[j] = ((const GAS u32x2*)(Y + (size_t)sn0 * DM) + lane)[64 * j]; ybn[j] = ((const GAS u32x2*)(Y + (size_t)sn1 * DM) + lane)[64 * j]; }
        GAS f32x4* xr = (GAS f32x4*)(F.out + (size_t)r * DM) + lane;
        f32x4 v[4]; float s = 0.f;
#pragma unroll
        for (int j = 0; j < 4; ++j) { const u32x2 p0 = ya[j], p1 = yb[j]; f32x4 x = xv[j];
            const float dm = F.dry ? 0.f : 1.f; x.x += dm * (bflo(p0.x) + bflo(p1.x)); x.y += dm * (bfhi(p0.x) + bfhi(p1.x)); x.z += dm * (bflo(p0.y) + bflo(p1.y)); x.w += dm * (bfhi(p0.y) + bfhi(p1.y));
            v[j] = x; s += (x.x * x.x + x.y * x.y) + (x.z * x.z + x.w * x.w); }
        const float rstd = __builtin_amdgcn_rsqf(wave_sum(s) * (1.f / DM) + EPS);
        if (l == DEPTH - 1) { const GAS f32x4* g = (const GAS f32x4*)IN_F(19) + lane;
#pragma unroll
            for (int j = 0; j < 4; ++j) xr[64 * j] = v[j] * rstd * g[64 * j];
        } else {
            GAS u32x2* o8 = (GAS u32x2*)((bf16_t*)(ws + WS_XB) + (size_t)r * DM) + lane;
#pragma unroll
            for (int j = 0; j < 4; ++j) { xr[64 * j] = v[j]; u32x2 w; w.x = cvt_pk_bf16(v[j].x, v[j].y); w.y = cvt_pk_bf16(v[j].z, v[j].w); o8[64 * j] = w; }
            if (lane == 0) ((float*)(ws + WS_RSTD))[r] = rstd;
        }
#pragma unroll
        for (int j = 0; j < 4; ++j) { xv[j] = xn[j]; ya[j] = yan[j]; yb[j] = ybn[j]; }
        rn = rnn; sn0 = snn0; sn1 = snn1;
    }
}

constexpr int NPHASE = 1 + 11 * DEPTH + (PROBE_P >= 0 ? PROBE_N - 1 : 0);
__global__ void __launch_bounds__(NTHR, 2) fwd(Args a) {
    extern __shared__ __attribute__((aligned(16))) unsigned char lds_raw[];
    Frame F;
    F.lds = (LAS unsigned char*)lds_raw; F.MISC = (volatile LAS unsigned*)(F.lds + MISC_OFF);
    F.tid = threadIdx.x; F.lane = F.tid & 63; F.wave = __builtin_amdgcn_readfirstlane(F.tid >> 6);
    F.G = gridDim.x; { const int bx = blockIdx.x; F.vcu = (F.G % 8 == 0) ? (bx % 8) * (F.G / 8) + bx / 8 : bx; }
    F.ws = a.ws; F.ctl = (gu32*)(a.ws + WS_CTL); F.out = a.out; F.z = 0;
    for (int u = F.tid; u < (LDS_BYTES - LDSCTL_OFF) / 4; u += NTHR) ((LAS unsigned*)(F.lds + LDSCTL_OFF))[u] = 0u;
    __syncthreads();
    XcdBarrier bar; bar.bar = (unsigned*)(F.ctl + CW_BAR); bar.x = 0; bar.st = nullptr;
    const bool one_launch = (a.ph_hi - a.ph_lo) > 1;
    if (one_launch) bar = xcd_barrier_post((unsigned*)(F.ctl + CW_BAR), F.MISC + 8);
    for (int pp = a.ph_lo; pp < a.ph_hi; ++pp) {
        int ph = pp;
        F.dry = 0;
        if (PROBE_P >= 0) { constexpr int P = PROBE_P; if (pp > P) ph = (pp - (PROBE_N - 1) > P) ? pp - (PROBE_N - 1) : P; if (ph == P && pp < P + PROBE_N - 1) F.dry = 1; }
        { int t_ = threadIdx.x; asm volatile("" : "+v"(t_)); F.tid = t_; F.lane = t_ & 63; F.wave = __builtin_amdgcn_readfirstlane(t_ >> 6); }
        size_t z_ = 0; asm volatile("" : "+s"(z_)); F.z = z_; F.ws = a.ws + z_; F.out = (float*)((char*)a.out + z_); F.ctl = (gu32*)(a.ws + z_ + WS_CTL);
        unsigned char* ws = F.ws; int bx = (int)blockIdx.x; asm volatile("" : "+s"(bx));
        if (ph == 0) { if (PHSEL(0)) ph_init(F, a); }
        else {
            const int l = (ph - 1) / 11, qq = (ph - 1) % 11, q = qq < 5 ? qq : (qq < 8 ? qq + 1 : qq + 2);
            if (q == 0 && PHSEL(3)) {
                pg8::SchedDense S{64, 14, 896, F.G, bx, (const char*)(ws + WS_XB), (const char*)(ws + WS_WIN) + (size_t)l * NIN * DM * 2, (size_t)256 * DM * 2, (size_t)256 * DM * 2, 64, 0};
                EpiProj E{(bf16_t*)(ws + A_HG), (bf16_t*)(ws + A_QR), (bf16_t*)(ws + A_KF1), (bf16_t*)(ws + A_V), (const float*)(ws + WS_RSTD), (const f32x2*)(ws + WS_CS), (unsigned*)(F.ctl + CW_KMAX + l * 16)};
                pg8::gemm_phase<EpiProj, pg8::SchedDense, true, true, DM, DM>(F.lds, F.tid, S, E);
                if (l == 0) {
                    const bool part = (F.G == 256);
                    { size_t z2 = 0; asm volatile("" : "+s"(z2)); ws = F.ws + z2; F.ws = ws; int t2 = F.tid; asm volatile("" : "+v"(t2)); F.tid = t2; F.lane = t2 & 63; }
                    if (!part || (bx >= 128 && bx < 160)) { SchedKV SK{part ? 32 : F.G, part ? bx - 128 : bx, (const char*)(ws + WS_MEMN), (const char*)(ws + WS_WKVT)};
                        EpiKV EK{(bf16_t*)(ws + WS_KV), (bf16_t*)(ws + WS_KV) + (size_t)DEPTH * MEMROWS * DM};
                        pg8::gemm_phase<EpiKV, SchedKV, true, true, DM, DM>(F.lds, F.tid, SK, EK); }
                    if (!part || bx >= 160) conv_small_l1(F, a, part ? (bx - 160) * NWAVES + F.wave : F.vcu * NWAVES + F.wave, part ? 96 * NWAVES : F.G * NWAVES);
                }
            } else if (q == 1 && PHSEL(4)) {
                for (int rep = 0; rep < PROBE_PREP_N; ++rep) for (int u = F.vcu; u < (MT / 512) * ATH; u += F.G) vf_unit(F, u);
                for (int rep = 0; rep < PROBE_HGA_N; ++rep) { constexpr int NU = BATCH * HGH * NCHUNK; HgIn R = hg_load<false>(F, F.vcu < NU ? F.vcu : NU - 1);
                    for (int u = F.vcu; u < NU; u += F.G) { const HgIn Rn = hg_load<false>(F, u + F.G < NU ? u + F.G : NU - 1); hg_a2_unit(F, a, l, u, R); R = Rn; } }
                if (l == 0) {
                    { size_t z2 = 0; asm volatile("" : "+s"(z2)); ws = F.ws + z2; F.ws = ws; int t2 = F.tid; asm volatile("" : "+v"(t2)); F.tid = t2; F.lane = t2 & 63; }
                    SchedFold SF{F.G, bx, (const char*)(ws + WS_KV), (const char*)(ws + WS_KV) + (size_t)DEPTH * MEMROWS * DM * 2, (const char*)(ws + WS_WQS), (const char*)(ws + WS_WOT)};
                    EpiBf16 EF{(bf16_t*)(ws + WS_WQK), DM, (size_t)DM * DM, 1.f};
                    pg8::gemm_phase<EpiBf16, SchedFold, true, true, DM, 256>(F.lds, F.tid, SF, EF); }
            } else if (q == 2 && PHSEL(5)) hg_scan(F);
            else if (q == 3 && PHSEL(6)) {
                for (int rep = 0; rep < PROBE_HGC_N; ++rep) { constexpr int NU = BATCH * HGH * NCHUNK; HgIn R = hg_load<true>(F, F.vcu < NU ? F.vcu : NU - 1);
                    for (int u = F.vcu; u < NU; u += F.G) { const HgIn Rn = hg_load<true>(F, u + F.G < NU ? u + F.G : NU - 1); if (rep + 1 < PROBE_HGC_N) hg_c2_unit<PROBE_HGC_STOP>(F, a, l, u, R); else hg_c2_unit<0>(F, a, l, u, R); R = Rn; } }
#if ATT_GOLDEN
                for (int t = F.vcu * NWAVES + F.wave; t < (MT / 64) * ATH; t += F.G * NWAVES) att_task(F, t);
#else
                for (int rep = 0; rep < PROBE_ATT_N; ++rep) for (int u = F.vcu; u < (MT / 512) * ATH; u += F.G) att_unit(F, l, u);
#endif
            } else if (q == 4 && PHSEL(7)) {
                pg8::SchedDense S{64, 4, 256, F.G, bx, (const char*)(ws + WS_XB), (const char*)(ws + WS_WOUT) + (size_t)l * DM * DM * 2, (size_t)256 * DM * 2, (size_t)256 * DM * 2, 64, 0};
                EpiResNorm E{l == 0 ? IN_F(0) : (const float*)F.out, F.out, (bf16_t*)(ws + A_XB2), (float*)(ws + WS_SSQP)};
                pg8::gemm_phase<EpiResNorm, pg8::SchedDense, true, true, DM, DM>(F.lds, F.tid, S, E);
            } else if (q == 5 && PHSEL(8)) ph_norm(F, a);
            else if (q == 6 && PHSEL(9)) {
                pg8::SchedDense S{64, 4, 256, F.G, bx, (const char*)(ws + A_XB2), (const char*)(ws + WS_WQK) + (size_t)l * 2 * DM * DM * 2, (size_t)256 * DM * 2, (size_t)256 * DM * 2, 32, (size_t)DM * DM * 2};
                EpiSoftmax E{(bf16_t*)(ws + A_P), (const float*)(ws + WS_SSQP)};
                pg8::gemm_phase<EpiSoftmax, pg8::SchedDense, true, true, DM, DM>(F.lds, F.tid, S, E);
            } else if (q == 7 && PHSEL(10)) {
                pg8::SchedDense S{64, 4, 256, F.G, bx, (const char*)(ws + A_P), (const char*)(ws + WS_WVO) + (size_t)l * 2 * DM * DM * 2, (size_t)256 * DM * 2, (size_t)256 * DM * 2, 32, (size_t)DM * DM * 2};
                EpiResAdd E{(const float*)F.out, F.out, F.dry ? 0.f : 1.f};
                pg8::gemm_phase<EpiResAdd, pg8::SchedDense, true, true, DM, DM>(F.lds, F.tid, S, E);
            } else if (q == 8 && PHSEL(11)) ph_router(F, a, l);
            else if (q == 10 && PHSEL(13)) {
                moe_prefix(F, l);
                const int total = __builtin_amdgcn_readfirstlane((int)F.MISC[32]) * 4, early = (total / F.G) * F.G;
                SchedMoe S{F.G, bx, DM, F.MISC + 16, (const char*)(ws + WS_XB), (const char*)(ws + A_WGU), (const int*)(ws + A_PERM2), (const unsigned*)(F.ctl + CW_CNT + l * 16 * 64), true, 1, early, total - early, nullptr};
                EpiMoe1 E{(bf16_t*)(ws + A_ACTB), (const float*)(ws + A_SRS2), (const float*)(ws + A_SGW2)};
                pg8::gemm_phase<EpiMoe1, SchedMoe, true, true, DM, DM, true>(F.lds, F.tid, S, E);
            } else if (q == 11 && PHSEL(14)) {
                moe_prefix(F, l);
                const int total = __builtin_amdgcn_readfirstlane((int)F.MISC[32]) * 4, early = (total / F.G) * F.G, rem = total - early;
                unsigned* done = (unsigned*)(F.ctl + CW_DONE + l * 256);
                if (bx < rem) {
                    SchedMoe S{F.G, bx, DM, F.MISC + 16, (const char*)(ws + WS_XB), (const char*)(ws + A_WGU), (const int*)(ws + A_PERM2), (const unsigned*)(F.ctl + CW_CNT + l * 16 * 64), true, 2, early, rem, nullptr};
                    EpiMoe1 E{(bf16_t*)(ws + A_ACTB), (const float*)(ws + A_SRS2), (const float*)(ws + A_SGW2)};
                    pg8::gemm_phase<EpiMoe1, SchedMoe, true, true, DM, DM, true>(F.lds, F.tid, S, E);
                    if (F.tid == 0) { __builtin_amdgcn_fence(__ATOMIC_RELEASE, "agent"); asm volatile("s_waitcnt vmcnt(0)" ::: "memory"); __hip_atomic_fetch_add(done + ((early + bx) >> 2), 1u, __ATOMIC_RELAXED, __HIP_MEMORY_SCOPE_AGENT); }
                }
                { size_t z2 = 0; asm volatile("" : "+s"(z2)); ws = F.ws + z2; F.ws = ws; int t2 = F.tid; asm volatile("" : "+v"(t2)); F.tid = t2; F.lane = t2 & 63; }
                SchedMoe S{F.G, bx, EFF, F.MISC + 16, (const char*)(ws + A_ACTB), (const char*)(ws + A_WD), nullptr, nullptr, false, 3, early, rem, done};
                EpiBf16 E{(bf16_t*)(ws + A_Y), DM, 0, 1.f};
                pg8::gemm_phase<EpiBf16, SchedMoe, true, true, EFF, EFF>(F.lds, F.tid, S, E);
            } else if (q == 12 && PHSEL(15)) ph_combine(F, a, l);
        }
        if (pp + 1 < a.ph_hi) xcd_barrier(bar);
    }
}

extern "C" void kernel_launch(void* const* d_in, const int* in_sizes, int n_in, void* d_out, int out_size, void* d_ws, size_t ws_size, hipStream_t stream) {
    static int grid = 0;
    if (grid == 0) {
        if (n_in != 20 || in_sizes[0] != MT * DM || out_size != MT * DM || ws_size < WS_END) { fprintf(stderr, "kernel_launch: unexpected shapes / workspace (%d inputs, ws %zu)\n", n_in, ws_size); grid = -1; return; }
        int dev = 0, cus = 0, per_cu = 0;
        if (hipGetDevice(&dev) != hipSuccess || hipDeviceGetAttribute(&cus, hipDeviceAttributeMultiprocessorCount, dev) != hipSuccess) { grid = -1; return; }
        if (hipFuncSetAttribute((const void*)fwd, hipFuncAttributeMaxDynamicSharedMemorySize, LDS_BYTES) != hipSuccess) { grid = -1; return; }
        if (hipOccupancyMaxActiveBlocksPerMultiprocessor(&per_cu, (const void*)fwd, NTHR, LDS_BYTES) != hipSuccess || per_cu < 1) { fprintf(stderr, "kernel_launch: occupancy query says %d\n", per_cu); per_cu = 1; }
        (void)hipGetLastError();
        grid = cus * 1;
    }
    if (grid < 0) return;
    (void)hipMemsetAsync((char*)d_ws + WS_CTL, 0, CTL_ZERO_BYTES, stream);
    Args a{};
    for (int i = 0; i < 20; ++i) a.in[i] = d_in[i];
    a.out = (float*)d_out; a.ws = (unsigned char*)d_ws;
#if MK_PER_PHASE
    for (int ph = 0; ph < NPHASE; ++ph) { a.ph_lo = ph; a.ph_hi = ph + 1; hipLaunchKernelGGL(fwd, dim3(grid), dim3(NTHR), LDS_BYTES, stream, a); }
#else
    a.ph_lo = 0; a.ph_hi = NPHASE;
    void* kargs[] = {&a};
    hipError_t e = hipLaunchCooperativeKernel((const void*)fwd, dim3(grid), dim3(NTHR), kargs, LDS_BYTES, stream);
    if (e != hipSuccess) fprintf(stderr, "cooperative launch failed: %s (grid %d)\n", hipGetErrorString(e), grid);
#endif
}
```

```cpp
#include <hip/hip_runtime.h>
#include <cstdio>
#include <cstdint>

#ifndef PH_MASK
#define PH_MASK 0xFFFFFFFFu
#endif
#define PHSEL(n) ((PH_MASK >> (n)) & 1u)
#ifndef PROBE_ATT_N
#define PROBE_ATT_N 1
#endif
#ifndef PROBE_HGC_N
#define PROBE_HGC_N 1
#endif
#ifndef PROBE_HGA_N
#define PROBE_HGA_N 1
#endif
#ifndef PROBE_PREP_N
#define PROBE_PREP_N 1
#endif
#ifndef PROBE_HGC_STOP
#define PROBE_HGC_STOP 0
#endif
#ifndef PROBE_P
#define PROBE_P -1
#endif
#ifndef PROBE_N
#define PROBE_N 1
#endif
#ifndef HG_A_GOLDEN
#define HG_A_GOLDEN 0
#endif
#ifndef HG_C_GOLDEN
#define HG_C_GOLDEN 0
#endif
#ifndef ATT_GOLDEN
#define ATT_GOLDEN 0
#endif
#ifndef MK_PER_PHASE
#define MK_PER_PHASE 0
#endif

#define LAS __attribute__((address_space(3)))
#define GAS __attribute__((address_space(1)))
typedef unsigned short bf16_t;
typedef short bf16x8 __attribute__((ext_vector_type(8)));
typedef float f32x4 __attribute__((ext_vector_type(4)));
typedef float f32x2 __attribute__((ext_vector_type(2)));
typedef unsigned u32x4 __attribute__((ext_vector_type(4)));
typedef unsigned u32x2 __attribute__((ext_vector_type(2)));
typedef GAS unsigned gu32;

constexpr int BATCH = 2, SEQ = 8192, DM = 1024, MT = BATCH * SEQ, DEPTH = 2;
constexpr int MEM_LEN = 256, MEMROWS = BATCH * MEM_LEN;
constexpr int NIN = 3584, HGW = 512, HGH = 4, HGD = 128, CHUNK = 64, NCHUNK = SEQ / CHUNK;
constexpr int ATW = 512, ATH = 8, ATD = 64;
constexpr int NEXP = 16, EFF = 512;
constexpr float EPS = 1e-6f;
constexpr int NWAVES = 8, NTHR = 512;

constexpr size_t MiB = 1u << 20;
constexpr size_t WS_CTL = 0, CTL_ZERO_BYTES = 1 * MiB;
constexpr size_t WS_RSTD = 1 * MiB;
constexpr size_t WS_TOKE = WS_RSTD + 64 * 1024;
constexpr size_t WS_TOKW = WS_TOKE + 128 * 1024;
constexpr size_t WS_TOKL = WS_TOKW + 128 * 1024;
constexpr size_t WS_SLOTRS = WS_TOKL + 128 * 1024;
constexpr size_t WS_SLOTGW = WS_SLOTRS + 160 * 1024;
constexpr size_t WS_PERM = WS_SLOTGW + 160 * 1024;
constexpr size_t WS_WR = 3 * MiB;
constexpr size_t WS_LBT = 3 * MiB + 256 * 1024;
constexpr size_t WS_SSQP = 3 * MiB + 512 * 1024;
constexpr size_t WS_XB = 4 * MiB;
constexpr size_t WS_WIN = 36 * MiB;
constexpr size_t WS_WOUT = 50 * MiB;
constexpr size_t WS_WQS = 54 * MiB;
constexpr size_t WS_WKVT = 58 * MiB;
constexpr size_t WS_WOT = 66 * MiB;
constexpr size_t WS_MEMN = 70 * MiB;
constexpr size_t WS_KV = 72 * MiB;
constexpr size_t WS_WQK = 76 * MiB;
constexpr size_t WS_WVO = 84 * MiB;
constexpr size_t WS_ACT = 92 * MiB;
constexpr size_t WS_CS = 320 * MiB;
constexpr size_t WS_END = 324 * MiB;
constexpr size_t A_HG = WS_ACT + 0 * MiB;
constexpr size_t A_KF1 = WS_ACT + 64 * MiB;
constexpr size_t A_KF4 = WS_ACT + 80 * MiB;
constexpr size_t A_KF16 = WS_ACT + 96 * MiB;
constexpr size_t A_QR = WS_ACT + 112 * MiB;
constexpr size_t A_V = WS_ACT + 128 * MiB;
constexpr size_t A_VT1 = WS_ACT + 144 * MiB;
constexpr size_t A_VT4 = WS_ACT + 160 * MiB;
constexpr size_t A_VT16 = WS_ACT + 176 * MiB;
constexpr size_t A_STATE = WS_ACT + 192 * MiB;
constexpr size_t A_DECAY = WS_ACT + 224 * MiB;
constexpr size_t A_XB2 = WS_ACT + 0 * MiB;
constexpr size_t A_P = WS_ACT + 32 * MiB;
constexpr size_t A_WGU = WS_ACT + 0 * MiB;
constexpr size_t A_WD = WS_ACT + 32 * MiB;
constexpr size_t A_PERM2 = WS_ACT + 48 * MiB;
constexpr size_t A_SRS2 = WS_ACT + 49 * MiB;
constexpr size_t A_SGW2 = WS_ACT + 50 * MiB;
constexpr size_t A_ACTB = WS_ACT + 120 * MiB;
constexpr size_t A_Y = WS_ACT + 156 * MiB;
constexpr int MAXSLOT = 2 * MT + NEXP * 256;
static_assert(A_Y + (size_t)MAXSLOT * 1024 * 2 <= WS_END, "ws map");
constexpr int CW_BAR = 4096;
constexpr int CW_KMAX = 12288;
constexpr int CW_DONE = 24576;
constexpr int CW_CNT = 16384;
constexpr int RING_BYTES = 131072;
constexpr int SPARE_OFF = RING_BYTES;
constexpr int LDSCTL_OFF = RING_BYTES + 8192, MISC_OFF = LDSCTL_OFF + 64;
constexpr int LDS_BYTES = 147456;

#define RLX_AGENT __ATOMIC_RELAXED, __HIP_MEMORY_SCOPE_AGENT
#define LDS_WAIT() asm volatile("s_waitcnt lgkmcnt(0)" ::: "memory")
#define VM_WAIT() asm volatile("s_waitcnt vmcnt(0)" ::: "memory")

__device__ __forceinline__ unsigned f2bf(float f) { unsigned u = __builtin_bit_cast(unsigned, f); return (u + 0x7fffu + ((u >> 16) & 1u)) >> 16; }
__device__ __forceinline__ unsigned pk2(float lo, float hi) { return f2bf(lo) | (f2bf(hi) << 16); }
__device__ __forceinline__ float bf2f(unsigned short h) { return __builtin_bit_cast(float, (unsigned)h << 16); }
__device__ __forceinline__ float bflo(unsigned w) { return __builtin_bit_cast(float, w << 16); }
__device__ __forceinline__ float bfhi(unsigned w) { return __builtin_bit_cast(float, w & 0xffff0000u); }
typedef __bf16 bf16x2_t __attribute__((ext_vector_type(2)));
__device__ __forceinline__ unsigned cvt_pk_bf16(float lo, float hi) { f32x2 v = {lo, hi}; bf16x2_t b = __builtin_convertvector(v, bf16x2_t); return __builtin_bit_cast(unsigned, b); }
__device__ __forceinline__ float wave_sum(float v) {
#pragma unroll
    for (int o = 1; o < 64; o <<= 1) v += __shfl_xor(v, o);
    return v;
}
__device__ __forceinline__ float sigmoidf_(float z) { return __builtin_amdgcn_rcpf(1.f + __builtin_amdgcn_exp2f(-1.4426950408889634f * z)); }
__device__ __forceinline__ float ex2(float x) { return __builtin_amdgcn_exp2f(x); }
constexpr float LOG2E = 1.4426950408889634f;

#define XB_TMO      128
#define XB_XCNT(j)  (256  + 64 * (j))
#define XB_XSUB(j)  (1280 + 64 * (j))
#define XB_XGEN(j)  (2304 + 64 * (j))
#define XB_TOP      3328
#define XB_TOPGEN   3392
#define XCD_BAR_WORDS 3456
#define XB_SPIN_CAP (1u << 18)
__device__ __forceinline__ unsigned xb_ld(unsigned* p)              { return __hip_atomic_load(p, __ATOMIC_RELAXED, __HIP_MEMORY_SCOPE_AGENT); }
__device__ __forceinline__ unsigned xb_add(unsigned* p, unsigned v) { return __hip_atomic_fetch_add(p, v, __ATOMIC_RELAXED, __HIP_MEMORY_SCOPE_AGENT); }
__device__ __forceinline__ unsigned xb_xcc_id() { return (unsigned)__builtin_amdgcn_s_getreg((3 << 11) | 20) & 0xFu; }
#define XB_SPIN(cond, bar) do { unsigned _sp = 0; while (cond) { __builtin_amdgcn_s_sleep(1); \
    if ((++_sp & 255u) == 0u) { if (xb_ld(&(bar)[XB_TMO])) break; if (_sp > XB_SPIN_CAP) { atomicAdd(&(bar)[XB_TMO], 1u); break; } } } } while (0)
struct XcdBarrier { unsigned* bar; unsigned x; volatile LAS unsigned* st; };
__device__ __forceinline__ XcdBarrier xcd_barrier_post(unsigned* bar, volatile LAS unsigned* st) {
    XcdBarrier b; b.bar = bar; b.x = xb_xcc_id(); b.st = st;
    if (threadIdx.x == 0) (void)xb_add(&bar[XB_XCNT(b.x)], 1u);
    return b;
}
__device__ __forceinline__ void xcd_barrier_complete(unsigned* bar, unsigned x, unsigned& nloc, unsigned& nx) {
    const unsigned G = gridDim.x * gridDim.y * gridDim.z;
    unsigned sum, cnt, mine, sp = 0u;
    for (;;) {
        sum = 0u; cnt = 0u; mine = 0u;
#pragma unroll
        for (unsigned j = 0; j < 16; ++j) { const unsigned c = xb_ld(&bar[XB_XCNT(j)]); sum += c; cnt += (c > 0u) ? 1u : 0u; mine = (j == x) ? c : mine; }
        if (sum == G) break;
        __builtin_amdgcn_s_sleep(1);
        if ((++sp & 255u) == 0u) { if (xb_ld(&bar[XB_TMO])) break; if (sp > XB_SPIN_CAP) { atomicAdd(&bar[XB_TMO], 1u); break; } }
    }
    nloc = mine > 0u ? mine : 1u; nx = cnt > 0u ? cnt : 1u;
}
__device__ __forceinline__ void xcd_barrier(const XcdBarrier& b) {
    asm volatile("s_waitcnt vmcnt(0)" ::: "memory");
    __syncthreads();
    if (threadIdx.x == 0) {
        unsigned* bar = b.bar;
        __builtin_amdgcn_s_waitcnt(0);
        unsigned nloc = b.st[0], nx = b.st[1];
        if (nloc == 0u) { xcd_barrier_complete(bar, b.x, nloc, nx); b.st[0] = nloc; b.st[1] = nx; }
        const unsigned old = xb_add(&bar[XB_XSUB(b.x)], 1u);
        const unsigned gen = old / nloc;
        if (old + 1u == (gen + 1u) * nloc) {
            __builtin_amdgcn_fence(__ATOMIC_RELEASE, "agent");
            asm volatile("s_waitcnt vmcnt(0)" ::: "memory");
            const unsigned og = xb_add(&bar[XB_TOP], 1u);
            const unsigned tg = og / nx;
            if (og + 1u == (tg + 1u) * nx) xb_add(&bar[XB_TOPGEN], 1u);
            else XB_SPIN(xb_ld(&bar[XB_TOPGEN]) == tg, bar);
            __builtin_amdgcn_fence(__ATOMIC_ACQUIRE, "agent");
            xb_add(&bar[XB_XGEN(b.x)], 1u);
            asm volatile("s_waitcnt vmcnt(0)" ::: "memory");
        } else {
            XB_SPIN(xb_ld(&bar[XB_XGEN(b.x)]) == gen, bar);
            __builtin_amdgcn_fence(__ATOMIC_ACQUIRE, "agent");
            asm volatile("s_waitcnt vmcnt(0)" ::: "memory");
        }
    }
    __syncthreads();
}

namespace pg8 {
constexpr int BM = 256, BK = 64, HALF = 128, HTB = HALF * BK * 2, STAGE_BYTES = 8 * HTB, NXCD = 8, WGM = 8;
__host__ __device__ __forceinline__ int lds_byte(int r, int c) { const int st = (r >> 4) * 2 + (c >> 5), rr = r & 15, cc = c & 31, ob = rr * 64 + cc * 2; return st * 1024 + (ob ^ (((ob >> 9) & 1) << 5)); }
__host__ __device__ __forceinline__ void stage_rc(int b, int& R, int& C) { const int st = b / 1024, sb = b % 1024, swz = sb ^ (((sb >> 9) & 1) << 5); R = (st >> 1) * 16 + swz / 64; C = (st & 1) * 32 + (swz % 64) / 2; }
__host__ __device__ __forceinline__ int perm32(int rho) { const int n = rho >> 4, i = rho & 15; return 8 * (i >> 2) + 4 * n + (i & 3); }

struct Unit { int pm, pn, aux, lr; const char* a; const char* b; };
typedef f32x4 Acc[2][2][4][2];

template <class Epi, class Sched, bool ALIGN_EPI, bool SP2, int LD, int K, bool GATHER = false>
__device__ __forceinline__ void gemm_phase(LAS unsigned char* lds, const int tid, const Sched& S, const Epi& E) {
    constexpr int lda = LD, ldb = LD;
    const int wid = __builtin_amdgcn_readfirstlane(tid >> 6), lane = tid & 63, wr = wid >> 2, wc = wid & 3, fr = lane & 15, fq = lane >> 4;
    constexpr int nt = K / BK;
    unsigned voffA[2], voffB[2];
#pragma unroll
    for (int i = 0; i < 2; ++i) { int R, C; stage_rc(tid * 16 + i * 8192, R, C); const int Rb = Epi::PERM ? ((R & ~31) + perm32(R & 31)) : R;
        voffA[i] = (unsigned)(R * lda + C) * 2u; voffB[i] = (unsigned)(Rb * ldb + C) * 2u; }
    const size_t kstep = (size_t)(BK * 2);
    const size_t hstepA = (size_t)HALF * lda * 2, hstepB = (size_t)HALF * ldb * 2;
    const unsigned ldsw = (unsigned)wid * 1024u;
    const int aoff = lds_byte(wr * 64 + fr, fq * 8), boff = lds_byte(wc * 32 + fr, fq * 8);
#define PG8_SA(b, h) (((b) * 2 + (h)) * HTB)
#define PG8_SB(b, h) ((4 + (b) * 2 + (h)) * HTB)
#define PG8_STAGE(bufoff, gbase, voff) do { _Pragma("unroll") for (int _i = 0; _i < 2; ++_i) \
        __builtin_amdgcn_global_load_lds((const unsigned*)((const char*)(gbase) + (voff)[_i]), (LAS unsigned*)(lds + (bufoff) + ldsw + _i * 8192), 16, 0, 0); } while (0)
#define PG8_STAGE_A(bufoff, gbase, half, usenext) do { if constexpr (GATHER) { const unsigned _p = (usenext) ? vn[half] : vc[half]; unsigned _v[2]; _v[0] = (_p & 0xffffu) * (unsigned)(lda * 2) + gc2; _v[1] = (_p >> 16) * (unsigned)(lda * 2) + gc2; PG8_STAGE(bufoff, gbase, _v); } \
        else { PG8_STAGE(bufoff, (gbase) + (half) * hstepA, voffA); } } while (0)
#define PG8_LDA(dst, b, h) do { _Pragma("unroll") for (int m = 0; m < 4; ++m) _Pragma("unroll") for (int k = 0; k < 2; ++k) dst[m][k] = *(const LAS bf16x8*)(lds + PG8_SA(b, h) + aoff + m * 2048 + k * 1024); } while (0)
#define PG8_LDB(dst, b, h) do { _Pragma("unroll") for (int n = 0; n < 2; ++n) _Pragma("unroll") for (int k = 0; k < 2; ++k) dst[n][k] = *(const LAS bf16x8*)(lds + PG8_SB(b, h) + boff + n * 2048 + k * 1024); } while (0)
#define PG8_MMA(ai, bj, At, Bt) do { __builtin_amdgcn_s_setprio(1); _Pragma("unroll") for (int m = 0; m < 4; ++m) _Pragma("unroll") for (int n = 0; n < 2; ++n) _Pragma("unroll") for (int k = 0; k < 2; ++k) \
        acc[ai][bj][m][n] = __builtin_amdgcn_mfma_f32_16x16x32_bf16(Bt[n][k], At[m][k], acc[ai][bj][m][n], 0, 0, 0); __builtin_amdgcn_s_setprio(0); } while (0)
#define PG8_WAIT_V(n) asm volatile("s_waitcnt vmcnt(" #n ")" ::: "memory")
#define PG8_WAIT_L(n) asm volatile("s_waitcnt lgkmcnt(" #n ")" ::: "memory")
#define PG8_BAR __builtin_amdgcn_s_barrier()
#define PG8_SCHED __builtin_amdgcn_sched_barrier(0)
    Unit cur, nxt; int ui = 0;
    if (!S.next(0, cur)) return;
    Acc acc;
#pragma unroll
    for (int a = 0; a < 2; ++a)
#pragma unroll
        for (int b = 0; b < 2; ++b)
#pragma unroll
            for (int m = 0; m < 4; ++m)
#pragma unroll
                for (int n = 0; n < 2; ++n) acc[a][b][m][n] = (f32x4){0.f, 0.f, 0.f, 0.f};
    bf16x8 At[4][2], B0[2][2], B1[2][2];
    const char* cA = cur.a; const char* cB = cur.b;
    unsigned vc[2], vn[2], gc2 = 0;
    if constexpr (GATHER) { int R0, C0; stage_rc(tid * 16, R0, C0); gc2 = (unsigned)C0 * 2u;
#pragma unroll
        for (int h = 0; h < 2; ++h) { vc[h] = (unsigned)S.src_row(cur, 128 * h + R0) | ((unsigned)S.src_row(cur, 128 * h + R0 + 64) << 16); vn[h] = vc[h]; }
    }
    static_assert(SP2, "only the two-MFMA-blocks-per-barrier-pair loop is kept");
    {
        PG8_STAGE(PG8_SB(0, 0), cB, voffB); PG8_STAGE(PG8_SB(0, 1), cB + hstepB, voffB); PG8_STAGE_A(PG8_SA(0, 0), cA, 0, false); PG8_STAGE_A(PG8_SA(0, 1), cA, 1, false);
        if (wr == 1) PG8_BAR;
        PG8_WAIT_V(2); PG8_BAR;
        PG8_STAGE(PG8_SB(1, 0), cB + kstep, voffB); PG8_STAGE_A(PG8_SA(1, 0), cA + kstep, 0, false); PG8_STAGE(PG8_SB(1, 1), cB + hstepB + kstep, voffB);
        PG8_WAIT_V(6); PG8_BAR;
    }
    for (;;) {
        const bool has_next = S.next(ui + 1, nxt);
        const char* nA = has_next ? nxt.a : cA; const char* nB = has_next ? nxt.b : cB;
        if constexpr (GATHER) { if (has_next) { int R0, C0; stage_rc(tid * 16, R0, C0);
#pragma unroll
            for (int h = 0; h < 2; ++h) vn[h] = (unsigned)S.src_row(nxt, 128 * h + R0) | ((unsigned)S.src_row(nxt, 128 * h + R0 + 64) << 16); } }
#pragma nounroll
        for (int t = 0; t < nt; t += 2) {
            const bool last = (t == nt - 2);
            const char* a1 = cA + (size_t)(t + 1) * kstep;
            const char* a2 = last ? nA : cA + (size_t)(t + 2) * kstep; const char* b2 = last ? nB : cB + (size_t)(t + 2) * kstep;
            const char* a3 = a2 + kstep; const char* b3 = b2 + kstep;
            {
            PG8_LDB(B0, 0, 0); PG8_LDB(B1, 0, 1); PG8_SCHED; PG8_LDA(At, 0, 0); PG8_STAGE_A(PG8_SA(1, 1), a1, 1, false);
            PG8_WAIT_V(8); PG8_WAIT_L(0); PG8_BAR; PG8_MMA(0, 0, At, B0); PG8_MMA(0, 1, At, B1); PG8_BAR; PG8_SCHED;
            PG8_LDA(At, 0, 1); PG8_STAGE(PG8_SB(0, 0), b2, voffB); PG8_STAGE(PG8_SB(0, 1), b2 + hstepB, voffB); PG8_STAGE_A(PG8_SA(0, 0), a2, 0, last);
            PG8_WAIT_V(8); PG8_WAIT_L(0); PG8_BAR; PG8_MMA(1, 0, At, B0); PG8_MMA(1, 1, At, B1); PG8_BAR; PG8_SCHED;
            PG8_LDB(B0, 1, 0); PG8_LDB(B1, 1, 1); PG8_SCHED; PG8_LDA(At, 1, 0); PG8_STAGE_A(PG8_SA(0, 1), a2, 1, last);
            PG8_WAIT_V(8); PG8_WAIT_L(0); PG8_BAR; PG8_MMA(0, 0, At, B0); PG8_MMA(0, 1, At, B1); PG8_BAR; PG8_SCHED;
            PG8_LDA(At, 1, 1); PG8_STAGE(PG8_SB(1, 0), b3, voffB); PG8_STAGE(PG8_SB(1, 1), b3 + hstepB, voffB); PG8_STAGE_A(PG8_SA(1, 0), a3, 0, last);
            PG8_WAIT_V(8); PG8_WAIT_L(0); PG8_BAR; PG8_MMA(1, 0, At, B0); PG8_MMA(1, 1, At, B1); PG8_BAR; PG8_SCHED;
            }
        }
        if constexpr (ALIGN_EPI) { if (wr == 0) PG8_BAR; }
        E(acc, cur, wr, wc, fr, fq, lds);
        if (!has_next) break;
#pragma unroll
        for (int a = 0; a < 2; ++a)
#pragma unroll
            for (int b = 0; b < 2; ++b)
#pragma unroll
                for (int m = 0; m < 4; ++m)
#pragma unroll
                    for (int n = 0; n < 2; ++n) acc[a][b][m][n] = (f32x4){0.f, 0.f, 0.f, 0.f};
        cur = nxt; cA = nA; cB = nB; ++ui;
        if constexpr (GATHER) { vc[0] = vn[0]; vc[1] = vn[1]; }
        if constexpr (ALIGN_EPI) { if (wr == 1) PG8_BAR; }
    }
    PG8_WAIT_V(0);
    if constexpr (!ALIGN_EPI) { if (wr == 0) PG8_BAR; }
    PG8_BAR;
#undef PG8_SA
#undef PG8_SB
#undef PG8_STAGE
#undef PG8_STAGE_A
#undef PG8_LDA
#undef PG8_LDB
#undef PG8_MMA
#undef PG8_WAIT_V
#undef PG8_WAIT_L
#undef PG8_BAR
#undef PG8_SCHED
}

struct SchedDense {
    int nM, nN, nwg, G, c; const char* A; const char* B; size_t a_tile, b_tile; int pm_per_batch; size_t b_batch;
    __device__ __forceinline__ bool next(int i, Unit& u) const {
        const long L = (long)i * G + c; if (L >= nwg) return false;
        int wgid = (int)L; { const int q = nwg / NXCD, r = nwg % NXCD, xcd = wgid % NXCD, off = wgid / NXCD; wgid = (xcd < r ? xcd * (q + 1) : r * (q + 1) + (xcd - r) * q) + off; }
        const int nig = WGM * nN, gid = wgid / nig, fm = gid * WGM, gsz = (nM - fm) < WGM ? (nM - fm) : WGM;
        u.pm = fm + ((wgid % nig) % gsz); u.pn = (wgid % nig) / gsz; u.aux = 0;
        u.a = A + (size_t)u.pm * a_tile; u.b = B + (size_t)u.pn * b_tile + (size_t)(u.pm / pm_per_batch) * b_batch; return true;
    }
};
}
using pg8::Unit; using pg8::Acc;

struct EpiBf16 {
    static constexpr bool PERM = true;
    bf16_t* O; int ldc; size_t aux_stride; float scale;
    __device__ __forceinline__ void operator()(const Acc& acc, const Unit& u, int wr, int wc, int fr, int fq, LAS unsigned char*) const {
        bf16_t* base = O + (size_t)u.aux * aux_stride;
        const int row0 = u.pm * 256 + wr * 64 + fr, col0 = u.pn * 256 + wc * 32 + 8 * fq;
#pragma unroll
        for (int ai = 0; ai < 2; ++ai)
#pragma unroll
            for (int m = 0; m < 4; ++m) { bf16_t* rowp = base + (size_t)(row0 + ai * 128 + m * 16) * ldc + col0;
#pragma unroll
                for (int bj = 0; bj < 2; ++bj) { const f32x4 v0 = acc[ai][bj][m][0] * scale, v1 = acc[ai][bj][m][1] * scale;
                    u32x4 w; w.x = cvt_pk_bf16(v0[0], v0[1]); w.y = cvt_pk_bf16(v0[2], v0[3]); w.z = cvt_pk_bf16(v1[0], v1[1]); w.w = cvt_pk_bf16(v1[2], v1[3]);
                    *(u32x4*)(rowp + bj * 128) = w; } }
    }
};
struct EpiKV {
    static constexpr bool PERM = true;
    bf16_t* KB; bf16_t* VB;
    __device__ __forceinline__ void operator()(const Acc& acc, const Unit& u, int wr, int wc, int fr, int fq, LAS unsigned char*) const {
        bf16_t* base = (u.pn < 4 ? KB : VB) + (size_t)u.aux * MEMROWS * DM;
        const int row0 = u.pm * 256 + wr * 64 + fr, col0 = (u.pn & 3) * 256 + wc * 32 + 8 * fq;
#pragma unroll
        for (int ai = 0; ai < 2; ++ai)
#pragma unroll
            for (int m = 0; m < 4; ++m) { bf16_t* rowp = base + (size_t)(row0 + ai * 128 + m * 16) * DM + col0;
#pragma unroll
                for (int bj = 0; bj < 2; ++bj) { const f32x4 v0 = acc[ai][bj][m][0], v1 = acc[ai][bj][m][1];
                    u32x4 w; w.x = cvt_pk_bf16(v0[0], v0[1]); w.y = cvt_pk_bf16(v0[2], v0[3]); w.z = cvt_pk_bf16(v1[0], v1[1]); w.w = cvt_pk_bf16(v1[2], v1[3]);
                    *(u32x4*)(rowp + bj * 128) = w; } }
    }
};
struct EpiProj {
    static constexpr bool PERM = true;
    bf16_t* HG; bf16_t* QR; bf16_t* KF; bf16_t* V; const float* rstd; const f32x2* CS; unsigned* kmax;
    __device__ __forceinline__ void operator()(const Acc& acc, const Unit& u, int wr, int wc, int fr, int fq, LAS unsigned char*) const {
        const int row0 = u.pm * 256 + wr * 64 + fr;
        if (u.pn < 8 || u.pn >= 12) {
            bf16_t* base; int ldc, colt;
            if (u.pn < 8) { base = HG; ldc = 2048; colt = u.pn * 256; } else { base = V; ldc = 512; colt = (u.pn - 12) * 256; }
            const int col0 = colt + wc * 32 + 8 * fq;
#pragma unroll
            for (int ai = 0; ai < 2; ++ai)
#pragma unroll
                for (int m = 0; m < 4; ++m) { const int row = row0 + ai * 128 + m * 16; const float rs = rstd[row]; bf16_t* rowp = base + (size_t)row * ldc + col0;
#pragma unroll
                    for (int bj = 0; bj < 2; ++bj) { const f32x4 v0 = acc[ai][bj][m][0] * rs, v1 = acc[ai][bj][m][1] * rs;
                        u32x4 w; w.x = cvt_pk_bf16(v0[0], v0[1]); w.y = cvt_pk_bf16(v0[2], v0[3]); w.z = cvt_pk_bf16(v1[0], v1[1]); w.w = cvt_pk_bf16(v1[2], v1[3]);
                        *(u32x4*)(rowp + bj * 128) = w; } }
        } else {
            const bool isk = u.pn >= 10; const int head = 4 * (u.pn & 1) + wc;
            float kn2max = 0.f;
#pragma unroll
            for (int ai = 0; ai < 2; ++ai)
#pragma unroll
                for (int m = 0; m < 4; ++m) { const int row = row0 + ai * 128 + m * 16; const float rs = rstd[row] * (isk ? 1.f : 0.125f * LOG2E);
                    const f32x4* cs = (const f32x4*)(CS + (size_t)row * 32 + 8 * fq); const f32x4 c0 = cs[0], c1 = cs[1], c2 = cs[2], c3 = cs[3];
                    const float co[8] = {c0.x, c0.z, c1.x, c1.z, c2.x, c2.z, c3.x, c3.z}, si[8] = {c0.y, c0.w, c1.y, c1.w, c2.y, c2.w, c3.y, c3.w};
                    float lo[8], hi[8];
#pragma unroll
                    for (int n = 0; n < 2; ++n)
#pragma unroll
                        for (int e = 0; e < 4; ++e) { const int j = 4 * n + e; const float x1 = acc[ai][0][m][n][e] * rs, x2 = acc[ai][1][m][n][e] * rs; lo[j] = x1 * co[j] - x2 * si[j]; hi[j] = x2 * co[j] + x1 * si[j]; }
                    u32x4 wl, wh; wl.x = cvt_pk_bf16(lo[0], lo[1]); wl.y = cvt_pk_bf16(lo[2], lo[3]); wl.z = cvt_pk_bf16(lo[4], lo[5]); wl.w = cvt_pk_bf16(lo[6], lo[7]);
                    wh.x = cvt_pk_bf16(hi[0], hi[1]); wh.y = cvt_pk_bf16(hi[2], hi[3]); wh.z = cvt_pk_bf16(hi[4], hi[5]); wh.w = cvt_pk_bf16(hi[6], hi[7]);
                    if (!isk) { bf16_t* rowp = QR + (size_t)row * 512 + head * 64 + 8 * fq; *(u32x4*)rowp = wl; *(u32x4*)(rowp + 32) = wh; }
                    else { { float n2 = 0.f;
#pragma unroll
                          for (int j = 0; j < 8; ++j) n2 += lo[j] * lo[j] + hi[j] * hi[j];
                          n2 += __shfl_xor(n2, 16); n2 += __shfl_xor(n2, 32); kn2max = fmaxf(kn2max, n2); }
                        const int b = row >> 13, s = row & (SEQ - 1); const size_t bh = (size_t)(b * ATH + head) * (SEQ * 64);
#pragma unroll
                        for (int pat = 0; pat < 3; ++pat) { const int D = pat == 0 ? 1 : (pat == 1 ? 4 : 16), sh = pat * 2; const int r = s & (D - 1), p = s >> sh, T = p >> 5, k5 = p & 31;
                            const int rho = (k5 & 19) | ((k5 & 4) << 1) | ((k5 & 8) >> 1);
                            bf16_t* kf = KF + (size_t)pat * (MT * 512) + bh + ((size_t)(r * (SEQ / 32 >> sh) + T) * 4) * 512;
                            *(u32x4*)(kf + ((fq >> 1) * 64 + rho + 32 * (fq & 1)) * 8) = wl; *(u32x4*)(kf + ((2 + (fq >> 1)) * 64 + rho + 32 * (fq & 1)) * 8) = wh; }
                    } }
            if (isk) { kn2max = fmaxf(kn2max, __shfl_xor(kn2max, 1)); kn2max = fmaxf(kn2max, __shfl_xor(kn2max, 2)); kn2max = fmaxf(kn2max, __shfl_xor(kn2max, 4)); kn2max = fmaxf(kn2max, __shfl_xor(kn2max, 8));
                if (fr == 0 && fq == 0) __hip_atomic_fetch_max(kmax + ((u.pm >> 5) * ATH + head), __float_as_uint(kn2max), __ATOMIC_RELAXED, __HIP_MEMORY_SCOPE_AGENT); }
        }
    }
};
struct EpiResAdd {
    static constexpr bool PERM = false;
    const float* Xs; float* X; float dm;
    __device__ __forceinline__ void operator()(const Acc& acc, const Unit& u, int wr, int wc, int fr, int fq, LAS unsigned char*) const {
        const int row0 = u.pm * 256 + wr * 64 + fr, col0 = u.pn * 256 + wc * 32 + 4 * fq;
#pragma unroll
        for (int ai = 0; ai < 2; ++ai) {
            f32x4 xv[4][2][2];
#pragma unroll
            for (int m = 0; m < 4; ++m) { const size_t off = (size_t)(row0 + ai * 128 + m * 16) * DM + col0;
#pragma unroll
                for (int bj = 0; bj < 2; ++bj)
#pragma unroll
                    for (int n = 0; n < 2; ++n) xv[m][bj][n] = *(const f32x4*)(Xs + off + bj * 128 + n * 16); }
            asm volatile("" ::: "memory");
#pragma unroll
            for (int m = 0; m < 4; ++m) { const size_t off = (size_t)(row0 + ai * 128 + m * 16) * DM + col0;
#pragma unroll
                for (int bj = 0; bj < 2; ++bj)
#pragma unroll
                    for (int n = 0; n < 2; ++n) *(f32x4*)(X + off + bj * 128 + n * 16) = xv[m][bj][n] + acc[ai][bj][m][n] * dm; }
        }
    }
};
struct EpiResNorm {
    static constexpr bool PERM = false;
    const float* Xs; float* X; bf16_t* XB; float* SSQP;
    __device__ __forceinline__ void operator()(const Acc& acc, const Unit& u, int wr, int wc, int fr, int fq, LAS unsigned char* lds) const {
        LAS float* EX = (LAS float*)(lds + SPARE_OFF);
        const int row0 = u.pm * 256 + wr * 64 + fr, col0 = u.pn * 256 + wc * 32 + 4 * fq;
#pragma unroll
        for (int ai = 0; ai < 2; ++ai)
#pragma unroll
            for (int m = 0; m < 4; ++m) { const size_t off = (size_t)(row0 + ai * 128 + m * 16) * DM + col0; float s = 0.f;
#pragma unroll
                for (int bj = 0; bj < 2; ++bj)
#pragma unroll
                    for (int n = 0; n < 2; ++n) { const f32x4 v = *(const f32x4*)(Xs + off + bj * 128 + n * 16) + acc[ai][bj][m][n]; *(f32x4*)(X + off + bj * 128 + n * 16) = v;
                        u32x2 w; w.x = cvt_pk_bf16(v[0], v[1]); w.y = cvt_pk_bf16(v[2], v[3]); *(u32x2*)(XB + off + bj * 128 + n * 16) = w;
                        s += (v[0] * v[0] + v[1] * v[1]) + (v[2] * v[2] + v[3] * v[3]); }
                s += __shfl_xor(s, 16); s += __shfl_xor(s, 32);
                if (fq == 0) EX[(ai * 128 + wr * 64 + m * 16 + fr) * 4 + wc] = s; }
        asm volatile("s_waitcnt lgkmcnt(0)" ::: "memory"); __builtin_amdgcn_s_barrier(); asm volatile("" ::: "memory");
        { const int t = (wr * 4 + wc) * 64 + fq * 16 + fr; if (t < 256) { const f32x4 e = *(const LAS f32x4*)(EX + t * 4); SSQP[(size_t)(u.pm * 256 + t) * 4 + u.pn] = (e.x + e.y) + (e.z + e.w); } }
        asm volatile("s_waitcnt lgkmcnt(0)" ::: "memory"); __builtin_amdgcn_s_barrier(); asm volatile("" ::: "memory");
    }
};
struct EpiSoftmax {
    static constexpr bool PERM = false;
    bf16_t* P; const float* SSQP;
    __device__ __forceinline__ void operator()(Acc& acc, const Unit& u, int wr, int wc, int fr, int fq, LAS unsigned char* lds) const {
        LAS f32x2* EX = (LAS f32x2*)(lds + SPARE_OFF);
        const int row0 = u.pm * 256 + wr * 64 + fr;
        float mw[2][4];
#pragma unroll
        for (int ai = 0; ai < 2; ++ai)
#pragma unroll
            for (int m = 0; m < 4; ++m) {
                const f32x4 pq = *(const f32x4*)(SSQP + (size_t)(row0 + ai * 128 + m * 16) * 4); const float rs = __builtin_amdgcn_rsqf(((pq.x + pq.y) + (pq.z + pq.w)) * (1.f / DM) + EPS);
                float mx = -3.0e38f;
#pragma unroll
                for (int bj = 0; bj < 2; ++bj)
#pragma unroll
                    for (int n = 0; n < 2; ++n) { f32x4 v = acc[ai][bj][m][n] * rs; acc[ai][bj][m][n] = v; mx = fmaxf(mx, fmaxf(fmaxf(v[0], v[1]), fmaxf(v[2], v[3]))); }
                mx = fmaxf(mx, __shfl_xor(mx, 16)); mx = fmaxf(mx, __shfl_xor(mx, 32));
                float sm = 0.f;
#pragma unroll
                for (int bj = 0; bj < 2; ++bj)
#pragma unroll
                    for (int n = 0; n < 2; ++n) { f32x4 v = acc[ai][bj][m][n]; v[0] = __expf(v[0] - mx); v[1] = __expf(v[1] - mx); v[2] = __expf(v[2] - mx); v[3] = __expf(v[3] - mx);
                        acc[ai][bj][m][n] = v; sm += (v[0] + v[1]) + (v[2] + v[3]); }
                sm += __shfl_xor(sm, 16); sm += __shfl_xor(sm, 32);
                mw[ai][m] = mx;
                if (fq == 0) EX[(ai * 128 + wr * 64 + m * 16 + fr) * 4 + wc] = (f32x2){mx, sm};
            }
        asm volatile("s_waitcnt lgkmcnt(0)" ::: "memory"); __builtin_amdgcn_s_barrier(); asm volatile("" ::: "memory");
#pragma unroll
        for (int ai = 0; ai < 2; ++ai)
#pragma unroll
            for (int m = 0; m < 4; ++m) {
                const int rl = ai * 128 + wr * 64 + m * 16 + fr;
                const f32x2 e0 = EX[rl * 4 + 0], e1 = EX[rl * 4 + 1], e2 = EX[rl * 4 + 2], e3 = EX[rl * 4 + 3];
                const float M = fmaxf(fmaxf(e0.x, e1.x), fmaxf(e2.x, e3.x));
                const float Ls = e0.y * __expf(e0.x - M) + e1.y * __expf(e1.x - M) + e2.y * __expf(e2.x - M) + e3.y * __expf(e3.x - M);
                const float f = __expf(mw[ai][m] - M) / Ls;
                bf16_t* rowp = P + (size_t)(row0 + ai * 128 + m * 16) * DM + u.pn * 256 + wc * 32 + 4 * fq;
#pragma unroll
                for (int bj = 0; bj < 2; ++bj)
#pragma unroll
                    for (int n = 0; n < 2; ++n) { const f32x4 v = acc[ai][bj][m][n] * f; u32x2 w; w.x = cvt_pk_bf16(v[0], v[1]); w.y = cvt_pk_bf16(v[2], v[3]);
                        *(u32x2*)(rowp + bj * 128 + n * 16) = w; }
            }
        asm volatile("s_waitcnt lgkmcnt(0)" ::: "memory"); __builtin_amdgcn_s_barrier(); asm volatile("" ::: "memory");
    }
};
struct EpiMoe1 {
    static constexpr bool PERM = true;
    bf16_t* ACTB; const float* srs; const float* sgw;
    __device__ __forceinline__ void operator()(const Acc& acc, const Unit& u, int wr, int wc, int fr, int fq, LAS unsigned char*) const {
        const int row0 = u.pm * 256 + wr * 64 + fr, col0 = u.pn * 128 + wc * 32 + 8 * fq;
#pragma unroll
        for (int ai = 0; ai < 2; ++ai)
#pragma unroll
            for (int m = 0; m < 4; ++m) { const int row = row0 + ai * 128 + m * 16; const int lrow = u.aux * 16384 + u.lr + wr * 64 + fr + ai * 128 + m * 16; const float rs = srs[lrow], gw = sgw[lrow] * rs;
                float o[8];
#pragma unroll
                for (int n = 0; n < 2; ++n)
#pragma unroll
                    for (int j = 0; j < 4; ++j) { const float g = acc[ai][0][m][n][j] * rs, up = acc[ai][1][m][n][j]; o[n * 4 + j] = g * sigmoidf_(g) * up * gw; }
                u32x4 w; w.x = cvt_pk_bf16(o[0], o[1]); w.y = cvt_pk_bf16(o[2], o[3]); w.z = cvt_pk_bf16(o[4], o[5]); w.w = cvt_pk_bf16(o[6], o[7]);
                *(u32x4*)(ACTB + (size_t)row * EFF + col0) = w; }
    }
};

struct Args { const void* in[20]; float* out; unsigned char* ws; int ph_lo, ph_hi; };
struct Frame {
    LAS unsigned char* lds; volatile LAS unsigned* MISC; gu32* ctl;
    int tid, lane, wave, vcu, G;
    unsigned char* ws; float* out; size_t z; int dry;
};

__device__ __forceinline__ void transpose_item(const float* W, int N, const float* scale, bf16_t* WT, int ldt, int row_base, int k0, int n0, LAS float* scr, int lane) {
    f32x4 v[8];
#pragma unroll
    for (int i = 0; i < 8; ++i) v[i] = *(const GAS f32x4*)(W + (size_t)(k0 + 8 * i + (lane >> 3)) * N + n0 + 4 * (lane & 7));
#pragma unroll
    for (int i = 0; i < 8; ++i) { const int kk = 8 * i + (lane >> 3); f32x4 x = v[i]; if (scale) x = x * scale[k0 + kk]; LAS float* d = scr + kk * 33 + 4 * (lane & 7); d[0] = x.x; d[1] = x.y; d[2] = x.z; d[3] = x.w; }
    LDS_WAIT(); asm volatile("" ::: "memory");
    const int c = lane & 7;
#pragma unroll
    for (int j = 0; j < 4; ++j) { const int n = (lane >> 3) + 8 * j; const LAS float* s = scr + (8 * c) * 33 + n;
        u32x4 o; o.x = pk2(s[0 * 33], s[1 * 33]); o.y = pk2(s[2 * 33], s[3 * 33]); o.z = pk2(s[4 * 33], s[5 * 33]); o.w = pk2(s[6 * 33], s[7 * 33]);
        *(GAS u32x4*)(WT + (size_t)(row_base + n0 + n) * ldt + k0 + 8 * c) = o; }
    LDS_WAIT(); asm volatile("" ::: "memory");
}
__device__ __forceinline__ void transpose_mat_item(const float* W, int K, int N, const float* scale, bf16_t* WT, int mode, int it, LAS float* scr, int lane) {
    const int nblk = N / 32, kb = it / nblk, nb = it % nblk, k0 = 64 * kb, n0 = 32 * nb;
    int row_base = 0;
    if (mode == 1 || mode == 2) row_base = 256 * (n0 / 128) + (n0 % 128) + (mode == 2 ? 128 : 0) - n0;
    if (mode == 3 && n0 >= 2048 && n0 < 3072) {
        const int blk = (n0 - 2048) / 512, np = (n0 - 2048) % 512, head = np / 64, d = np % 64;
        row_base = 2048 + blk * 512 + (head / 4) * 256 + 128 * (d / 32) + 32 * (head % 4) + (d % 32) - n0; }
    transpose_item(W, N, scale, WT, K, row_base, k0, n0, scr, lane);
}

__device__ __forceinline__ float row_norm_prep(const float* xrow, bf16_t* xb_row, float* copy_row, int lane) {
    const GAS f32x4* xr = (const GAS f32x4*)xrow + lane;
    f32x4 v[4]; float s = 0.f;
#pragma unroll
    for (int j = 0; j < 4; ++j) { v[j] = xr[64 * j]; s += (v[j].x * v[j].x + v[j].y * v[j].y) + (v[j].z * v[j].z + v[j].w * v[j].w); }
    const float rstd = 1.f / sqrtf(wave_sum(s) * (1.f / DM) + EPS);
    GAS u32x2* o8 = (GAS u32x2*)xb_row + lane;
#pragma unroll
    for (int j = 0; j < 4; ++j) { u32x2 w; w.x = pk2(v[j].x, v[j].y); w.y = pk2(v[j].z, v[j].w); o8[64 * j] = w; }
    if (copy_row) { GAS f32x4* c = (GAS f32x4*)copy_row + lane;
#pragma unroll
        for (int j = 0; j < 4; ++j) c[64 * j] = v[j]; }
    return rstd;
}

__constant__ double INV_FREQ[32] = {1.0, 0.7498942093324559, 0.5623413251903491, 0.4216965034285822, 0.31622776601683794, 0.23713737056616552, 0.1778279410038923, 0.1333521432163324,
    0.1, 0.07498942093324558, 0.05623413251903491, 0.042169650342858224, 0.03162277660168379, 0.023713737056616554, 0.01778279410038923, 0.01333521432163324,
    0.01, 0.007498942093324558, 0.005623413251903491, 0.004216965034285823, 0.0031622776601683794, 0.0023713737056616554, 0.0017782794100389228, 0.001333521432163324,
    0.001, 0.0007498942093324559, 0.0005623413251903491, 0.00042169650342858224, 0.00031622776601683794, 0.00023713737056616554, 0.00017782794100389227, 0.0001333521432163324};


#define IN_F(i) ((const float*)((const char*)a.in[i] + F.z))
__device__ __forceinline__ float hg_lb(const Frame& F, const Args& a, int l, int c) { if (l == 0) return 0.f; const float* h = IN_F(5); return sigmoidf_(h[HGW + c] - h[c]); }
__device__ __forceinline__ void conv_small_item(Frame& F, const Args& a, int l, int r, LAS float* scr) {
    unsigned char* ws = F.ws; const int lane = F.lane;
    if (r < 1792) { transpose_mat_item(IN_F(4) + (size_t)l * DM * NIN, DM, NIN, IN_F(3) + l * DM, (bf16_t*)(ws + WS_WIN) + (size_t)l * NIN * DM, 3, r, scr, lane); return; } r -= 1792;
    if (r < 512) { transpose_mat_item(IN_F(7) + (size_t)l * DM * DM, DM, DM, nullptr, (bf16_t*)(ws + WS_WOUT) + (size_t)l * DM * DM, 0, r, scr, lane); return; } r -= 512;
    if (r < 1024) { transpose_mat_item(IN_F(11) + (size_t)l * DM * 2 * DM, DM, 2 * DM, nullptr, (bf16_t*)(ws + WS_WKVT) + (size_t)l * 2 * DM * DM, 0, r, scr, lane); return; } r -= 1024;
    transpose_mat_item(IN_F(12) + (size_t)l * DM * DM, DM, DM, nullptr, (bf16_t*)(ws + WS_WOT) + (size_t)l * DM * DM, 0, r, scr, lane);
}
__device__ __forceinline__ void conv_wq_row(Frame& F, const Args& a, int r) {
    const int lane = F.lane; const float sc = IN_F(8)[r] * 0.0625f;
    const GAS f32x4* src = (const GAS f32x4*)(IN_F(10) + (size_t)r * DM) + lane; GAS u32x2* dst = (GAS u32x2*)((bf16_t*)(F.ws + WS_WQS) + (size_t)r * DM) + lane;
#pragma unroll
    for (int j = 0; j < 4; ++j) { const f32x4 v = src[64 * j] * sc; u32x2 w; w.x = pk2(v.x, v.y); w.y = pk2(v.z, v.w); dst[64 * j] = w; }
}
__device__ __forceinline__ void conv_small_l1(Frame& F, const Args& a, int wi, int nw) {
    LAS float* scr = (LAS float*)(F.lds + F.wave * 16384);
    for (int it = wi; it < 2816; it += nw) conv_small_item(F, a, 1, it < 2304 ? it : it + 1024, scr);
    for (int r = wi; r < DM; r += nw) conv_wq_row(F, a, DM + r);
}
__device__ __forceinline__ void ph_init(Frame& F, const Args& a) {
    LAS float* scr = (LAS float*)(F.lds + F.wave * 16384);
    const int gw = F.vcu * NWAVES + F.wave, NGW = F.G * NWAVES, lane = F.lane;
    unsigned char* ws = F.ws;
    for (int it = gw; it < 3840 + 1024; it += NGW) {
        if (it < 3840) conv_small_item(F, a, 0, it, scr); else conv_small_item(F, a, 1, 2304 + (it - 3840), scr); }
    for (int r = gw; r < DM; r += NGW) conv_wq_row(F, a, r);
    for (int r = gw; r < MEMROWS; r += NGW) {
        const GAS f32x4* xr = (const GAS f32x4*)(IN_F(1) + (size_t)r * DM) + lane;
        f32x4 v[4]; float s = 0.f;
#pragma unroll
        for (int j = 0; j < 4; ++j) { v[j] = xr[64 * j]; s += (v[j].x * v[j].x + v[j].y * v[j].y) + (v[j].z * v[j].z + v[j].w * v[j].w); }
        const float rstd = 1.f / sqrtf(wave_sum(s) * (1.f / DM) + EPS);
        for (int l = 0; l < DEPTH; ++l) {
            const GAS f32x4* g = (const GAS f32x4*)(IN_F(9) + l * DM) + lane; GAS u32x2* dst = (GAS u32x2*)((bf16_t*)(ws + WS_MEMN) + ((size_t)l * MEMROWS + r) * DM) + lane;
#pragma unroll
            for (int j = 0; j < 4; ++j) { const f32x4 o = v[j] * rstd * g[64 * j]; u32x2 w; w.x = pk2(o.x, o.y); w.y = pk2(o.z, o.w); dst[64 * j] = w; }
        }
    }
    for (int r = gw; r < MT; r += NGW) {
        const float rs = row_norm_prep(IN_F(0) + (size_t)r * DM, (bf16_t*)(ws + WS_XB) + (size_t)r * DM, nullptr, lane);
        if (lane == 0) ((float*)(ws + WS_RSTD))[r] = rs;
    }
    for (int i = (F.vcu * NTHR + F.tid); i < DEPTH * HGW; i += F.G * NTHR) ((float*)(ws + WS_LBT))[i] = hg_lb(F, a, i / HGW, i % HGW);
    { const int* pos = (const int*)((const char*)a.in[2] + F.z);
      for (int i = (F.vcu * NTHR + F.tid); i < MT * 32; i += F.G * NTHR) { const double ang = (double)pos[i >> 5] * INV_FREQ[i & 31]; double rev = ang * 0.15915494309189535; rev = rev - __builtin_floor(rev);
          const float fr = (float)rev; ((f32x2*)(ws + WS_CS))[i] = (f32x2){__builtin_amdgcn_cosf(fr), __builtin_amdgcn_sinf(fr)}; } }
    for (int i = (F.vcu * NTHR + F.tid); i < DEPTH * 32 * DM; i += F.G * NTHR) {
        const int l = i / (32 * DM), n = (i / DM) % 32, k = i % DM;
        float w = 0.f;
        if (n < 4) w = IN_F(14)[((size_t)l * DM + k) * 4 + n]; else if (n < 20) w = IN_F(15)[((size_t)l * DM + k) * 16 + (n - 4)];
        w *= IN_F(13)[l * DM + k];
        const unsigned hi = f2bf(w); const float rem = w - bf2f((unsigned short)hi);
        ((bf16_t*)(ws + WS_WR))[i] = (bf16_t)hi; ((bf16_t*)(ws + WS_WR) + DEPTH * 32 * DM)[i] = (bf16_t)f2bf(rem);
    }
}

struct SchedKV {
    int G, c; const char* memn; const char* wkvt;
    __device__ __forceinline__ bool next(int i, Unit& u) const {
        const int L = i * G + c; if (L >= 32) return false;
        const int l = L >> 4; u.pm = (L >> 3) & 1; u.pn = L & 7; u.aux = l;
        u.a = memn + ((size_t)l * MEMROWS + u.pm * 256) * DM * 2; u.b = wkvt + ((size_t)l * 2 * DM + u.pn * 256) * DM * 2; return true;
    }
};
struct SchedFold {
    int G, c; const char* kb; const char* vb; const char* wqs; const char* wot;
    __device__ __forceinline__ bool next(int i, Unit& u) const {
        const int L = i * G + c; if (L >= 128) return false;
        const int ty = L >> 6, l = (L >> 5) & 1, b = (L >> 4) & 1, h = (L >> 2) & 3, t = L & 3; u.aux = ty * 4 + l * 2 + b;
        if (ty == 0) { u.pm = h; u.pn = t; u.a = kb + (((size_t)l * MEMROWS + b * 256) * DM + h * 256) * 2; u.b = wqs + (((size_t)l * DM + t * 256) * DM + h * 256) * 2; }
        else { u.pm = t; u.pn = h; u.a = wot + (((size_t)l * DM + t * 256) * DM + h * 256) * 2; u.b = vb + (((size_t)l * MEMROWS + b * 256) * DM + h * 256) * 2; }
        return true;
    }
};
struct SchedMoe {
    int G, c, kdim; volatile LAS unsigned* tb; const char* A; const char* B; const int* perm2; const unsigned* cnt; bool gather; int mode, early, rem; unsigned* done;
    __device__ __forceinline__ bool next(int i, Unit& u) const {
        const int total = __builtin_amdgcn_readfirstlane((int)tb[16]) * 4; int L;
        if (mode == 0) L = i * G + c;
        else if (mode == 1) { L = i * G + c; if (L >= early) return false; }
        else if (mode == 2) { if (i > 0 || c >= rem) return false; L = early + c; }
        else { const int cc = c >= rem ? c - rem : c - rem + G; L = c >= rem ? (i == 0 ? cc : (G - rem) + (i - 1) * G + cc) : (G - rem) + i * G + cc; }
        if (L >= total) return false;
        const int mt = L >> 2; u.pm = mt; u.pn = L & 3; int e = 0;
#pragma unroll
        for (int j = 1; j < 16; ++j) e += (mt >= __builtin_amdgcn_readfirstlane((int)tb[j])) ? 1 : 0;
        u.aux = e; u.lr = (mt - __builtin_amdgcn_readfirstlane((int)tb[e])) * 256; u.a = gather ? A : A + (size_t)mt * 256 * kdim * 2; u.b = B + ((size_t)e * 1024 + u.pn * 256) * kdim * 2;
        if (mode == 3 && L >= early) {
            unsigned spins = 0; while (__hip_atomic_load(done + mt, __ATOMIC_RELAXED, __HIP_MEMORY_SCOPE_AGENT) < 4u) { __builtin_amdgcn_s_sleep(8); if (++spins > (1u << 18)) break; }
            __builtin_amdgcn_fence(__ATOMIC_ACQUIRE, "agent"); asm volatile("s_waitcnt vmcnt(0)" ::: "memory"); }
        return true;
    }
    __device__ __forceinline__ int src_row(const Unit& u, int r) const { const int lrow = u.lr + r; const int n = __builtin_amdgcn_readfirstlane((int)tb[24 + u.aux]); return lrow < n ? perm2[u.aux * 16384 + lrow] : 0; }
};

__device__ __forceinline__ void vf_unit(Frame& F, int unit) {
    unsigned char* ws = F.ws; const int tid = F.tid;
    const int tb = unit >> 3, h = unit & 7, b = tb >> 4, s_base = (tb & 15) * 512;
    LAS unsigned short* Vl = (LAS unsigned short*)F.lds;
    const bf16_t* V = (const bf16_t*)(ws + A_V) + ((size_t)b * SEQ + s_base) * 512 + h * 64;
#pragma unroll
    for (int p = 0; p < 8; ++p) { const int c = p * 512 + tid, row = c >> 3, ch = c & 7; *(LAS u32x4*)(Vl + row * 72 + ch * 8) = *(const GAS u32x4*)(V + (size_t)row * 512 + ch * 8); }
    __syncthreads();
    const size_t bh = (size_t)(b * ATH + h) * (SEQ * 64);
    for (int it = 0; it < 24; ++it) { const int pc = it * 512 + tid, tile = pc >> 8, q = pc & 255, s = q >> 7, mt = (q >> 6) & 1, ln = q & 63, dim = (ln & 31) + 32 * mt, hi = ln >> 5;
        const int pat = tile >> 4, j16 = tile & 15, sh = pat * 2, D = 1 << sh;
        const int TPC = 16 >> sh, r = j16 / TPC, tl = j16 % TPC;
        const int pl = tl * 32 + 16 * s + 8 * hi;
        unsigned w[4];
#pragma unroll
        for (int jj = 0; jj < 4; ++jj) { const int t0 = ((pl + 2 * jj) << sh) + r, t1 = ((pl + 2 * jj + 1) << sh) + r; w[jj] = (unsigned)Vl[t0 * 72 + dim] | ((unsigned)Vl[t1 * 72 + dim] << 16); }
        const int T = (s_base >> sh >> 5) + tl;
        bf16_t* vf = (bf16_t*)(ws + A_VT1) + (size_t)pat * (MT * 512) + bh + ((size_t)(r * (SEQ / 32 >> sh) + T) * 4 + s * 2 + mt) * 512 + ln * 8;
        *(GAS u32x4*)vf = (u32x4){w[0], w[1], w[2], w[3]}; }
    __syncthreads();
}

__device__ __forceinline__ void hg_build_b(Frame& F, int l, int h, const u32x4 z0, const u32x4 z1, int k0, float (&bb)[16], float (&kk)[16]) {
    const int tid = F.tid, lane = F.lane, wave = F.wave, tl = lane >> 3;
    LAS float* WT = (LAS float*)F.lds; LAS float* REF = (LAS float*)(F.lds + 4096);
    const unsigned zz[8] = {z0.x, z0.y, z0.z, z0.w, z1.x, z1.y, z1.z, z1.w};
    float lbv[16];
#pragma unroll
    for (int i = 0; i < 16; i += 4) { const f32x4 t4 = *(const GAS f32x4*)((const float*)(F.ws + WS_LBT) + l * HGW + h * 128 + k0 + i); lbv[i] = t4.x; lbv[i + 1] = t4.y; lbv[i + 2] = t4.z; lbv[i + 3] = t4.w; }
#pragma unroll
    for (int i = 0; i < 16; ++i) { const float z = (i & 1) ? bfhi(zz[i >> 1]) : bflo(zz[i >> 1]); const float lb = lbv[i];
        const float e = ex2(-LOG2E * z), sg = __builtin_amdgcn_rcpf(1.f + e), f = lb + (1.f - lb) * sg; bb[i] = __builtin_amdgcn_logf(f); kk[i] = (1.f - lb) * (e * sg); }
#pragma unroll
    for (int i = 0; i < 16; ++i) { float x = bb[i]; float y;
        y = __shfl_up(x, 8); if (tl >= 1) x += y;
        y = __shfl_up(x, 16); if (tl >= 2) x += y;
        y = __shfl_up(x, 32); if (tl >= 4) x += y;
        bb[i] = x; }
    if (tl == 7) {
#pragma unroll
        for (int i = 0; i < 16; i += 4) *(LAS f32x4*)(WT + wave * 128 + k0 + i) = (f32x4){bb[i], bb[i + 1], bb[i + 2], bb[i + 3]}; }
    __syncthreads();
    for (int w = 0; w < wave; ++w) {
#pragma unroll
        for (int i = 0; i < 16; i += 4) { const f32x4 p = *(const LAS f32x4*)(WT + w * 128 + k0 + i); bb[i] += p.x; bb[i + 1] += p.y; bb[i + 2] += p.z; bb[i + 3] += p.w; } }
    if (tl == 7 && (wave & 1)) {
#pragma unroll
        for (int i = 0; i < 16; i += 4) *(LAS f32x4*)(REF + (wave >> 1) * 128 + k0 + i) = (f32x4){bb[i], bb[i + 1], bb[i + 2], bb[i + 3]}; }
    __syncthreads();
    (void)tid;
}
__device__ __forceinline__ void st_row16(LAS unsigned char* base, int byteoff, const float (&v)[16]) {
    u32x4 w0, w1; w0.x = cvt_pk_bf16(v[0], v[1]); w0.y = cvt_pk_bf16(v[2], v[3]); w0.z = cvt_pk_bf16(v[4], v[5]); w0.w = cvt_pk_bf16(v[6], v[7]); w1.x = cvt_pk_bf16(v[8], v[9]); w1.y = cvt_pk_bf16(v[10], v[11]); w1.z = cvt_pk_bf16(v[12], v[13]); w1.w = cvt_pk_bf16(v[14], v[15]);
    *(LAS u32x4*)(base + byteoff) = w0; *(LAS u32x4*)(base + byteoff + 16) = w1;
}
constexpr int HL_RED = 6144, HL_QD = 8192, HL_KD = 25600, HL_QE = 43008, HL_Q1 = 60416, HL_K1 = 69120, HL_Q2 = 77824, HL_K2 = 86528, HL_VT = 95232, HL_SC = 113664;
constexpr int RS_TR = 288;
typedef short s16x4 __attribute__((ext_vector_type(4)));
constexpr int HA_KT = 8192, HA_VT = 8192 + 64 * 288;
constexpr int RS128 = 272, RS64 = 144;

struct HgIn { u32x4 z0, z1, q0, q1, v0, v1; };
template <bool NEEDQ> __device__ __forceinline__ HgIn hg_load(Frame& F, int unit) {
    HgIn R;
    const int b = unit >> 9, h = (unit >> 7) & 3, c = unit & 127; const int row0 = b * SEQ + c * CHUNK, t = F.tid >> 3, k0 = (F.tid & 7) * 16;
    const bf16_t* rowp = (const bf16_t*)(F.ws + A_HG) + (size_t)(row0 + t) * 2048 + h * 128 + k0;
    R.z0 = *(const GAS u32x4*)(rowp + 512); R.z1 = *(const GAS u32x4*)(rowp + 512 + 8); R.v0 = *(const GAS u32x4*)(rowp + 1024); R.v1 = *(const GAS u32x4*)(rowp + 1024 + 8);
    if (NEEDQ) { R.q0 = *(const GAS u32x4*)(rowp); R.q1 = *(const GAS u32x4*)(rowp + 8); } else { R.q0 = R.z0; R.q1 = R.z1; }
    return R;
}
__device__ __forceinline__ void hg_a2_unit(Frame& F, const Args& a, int l, int unit, const HgIn& R) {
    unsigned char* ws = F.ws; const int tid = F.tid, lane = F.lane, wave = F.wave;
    const int h = (unit >> 7) & 3;
    const int t = tid >> 3, k0 = (tid & 7) * 16;
    const u32x4 v0 = R.v0, v1 = R.v1;
    float bb[16], kk[16];
    hg_build_b(F, l, h, R.z0, R.z1, k0, bb, kk);
    const LAS float* REF = (const LAS float*)(F.lds + 4096);
    { float tmp[16];
#pragma unroll
      for (int i = 0; i < 16; ++i) tmp[i] = kk[i] * ex2(REF[3 * 128 + k0 + i] - bb[i]);
      st_row16(F.lds, HA_KT + t * RS_TR + k0 * 2, tmp);
      *(LAS u32x4*)(F.lds + HA_VT + t * RS_TR + k0 * 2) = v0; *(LAS u32x4*)(F.lds + HA_VT + t * RS_TR + k0 * 2 + 16) = v1; }
    if (tid < 128) ((float*)(ws + A_DECAY))[(size_t)unit * 128 + tid] = ex2(REF[3 * 128 + tid]);
    __syncthreads();
    { const int fr = lane & 15, g = lane >> 4;
      const int q = fr >> 2, p = fr & 3;
      auto trfrag = [&](int base, int c0, int ks) -> bf16x8 {
          const LAS unsigned char* a0 = F.lds + base + (32 * ks + 8 * g + q) * RS_TR + (c0 + 4 * p) * 2;
          const s16x4 lo = __builtin_bit_cast(s16x4, __builtin_amdgcn_ds_read_tr16_b64_v4i16((LAS s16x4*)a0));
          const s16x4 hi = __builtin_bit_cast(s16x4, __builtin_amdgcn_ds_read_tr16_b64_v4i16((LAS s16x4*)(a0 + 4 * RS_TR)));
          return (bf16x8){lo[0], lo[1], lo[2], lo[3], hi[0], hi[1], hi[2], hi[3]}; };
      bf16x8 af[2];
#pragma unroll
      for (int ks = 0; ks < 2; ++ks) af[ks] = trfrag(HA_KT, wave * 16, ks);
      bf16_t* st = (bf16_t*)(ws + A_STATE) + (size_t)unit * 16384;
#pragma unroll
      for (int vt = 0; vt < 8; ++vt) { f32x4 acc = {0.f, 0.f, 0.f, 0.f};
#pragma unroll
          for (int ks = 0; ks < 2; ++ks) { const bf16x8 bf = trfrag(HA_VT, vt * 16, ks); acc = __builtin_amdgcn_mfma_f32_16x16x32_bf16(af[ks], bf, acc, 0, 0, 0); }
          u32x2 w; w.x = cvt_pk_bf16(acc[0], acc[1]); w.y = cvt_pk_bf16(acc[2], acc[3]);
          *(GAS u32x2*)(st + (vt * 16 + fr) * 128 + wave * 16 + 4 * g) = w; } }
    __syncthreads();
}

template <int STOP> __device__ __forceinline__ void hg_c2_unit(Frame& F, const Args& a, int l, int unit, const HgIn& R) {
    unsigned char* ws = F.ws; const int tid = F.tid, lane = F.lane, wave = F.wave;
    const int b = unit >> 9, h = (unit >> 7) & 3, c = unit & 127; const int row0 = b * SEQ + c * CHUNK;
    const int t = tid >> 3, k0 = (tid & 7) * 16;
    const int fr = lane & 15, g = lane >> 4;
    const bf16_t* HG = (const bf16_t*)(ws + A_HG);
    const u32x4 q0 = R.q0, q1 = R.q1, v0 = R.v0, v1 = R.v1;
    bf16x8 sf[4]; u32x2 gwv[4];
    { const bf16_t* st = (const bf16_t*)(ws + A_STATE) + (size_t)unit * 16384 + (wave * 16 + fr) * 128;
#pragma unroll
      for (int ks = 0; ks < 4; ++ks) sf[ks] = *(const GAS bf16x8*)(st + 32 * ks + 8 * g);
#pragma unroll
      for (int I = 0; I < 4; ++I) gwv[I] = *(const GAS u32x2*)(HG + (size_t)(row0 + 16 * I + fr) * 2048 + 1536 + h * 128 + wave * 16 + 4 * g); }
    const f32x4 gain = *(const GAS f32x4*)(IN_F(6) + l * HGW + h * 128 + wave * 16 + 4 * g);
    float bb[16], kk[16];
    hg_build_b(F, l, h, R.z0, R.z1, k0, bb, kk);
    if (STOP == 1) { asm volatile("" :: "v"(bb[0]), "v"(kk[0]), "v"(sf[0]), "v"(gwv[0]), "v"(gain)); return; }
    const LAS float* REF = (const LAS float*)(F.lds + 4096);
    { const unsigned qq[8] = {q0.x, q0.y, q0.z, q0.w, q1.x, q1.y, q1.z, q1.w}, vv[8] = {v0.x, v0.y, v0.z, v0.w, v1.x, v1.y, v1.z, v1.w};
      LAS unsigned short* VT = (LAS unsigned short*)(F.lds + HL_VT);
      float qv[16], tmp[16];
#pragma unroll
      for (int i = 0; i < 16; ++i) { qv[i] = (i & 1) ? bfhi(qq[i >> 1]) : bflo(qq[i >> 1]); VT[(k0 + i) * (RS64 / 2) + t] = (unsigned short)((i & 1) ? (vv[i >> 1] >> 16) : (vv[i >> 1] & 0xffffu)); }
      const int I = wave >> 1;
      float rf[16];
#pragma unroll
      for (int i = 0; i < 16; i += 4) { f32x4 r4 = {0.f, 0.f, 0.f, 0.f}; if (I) r4 = *(const LAS f32x4*)(REF + (I - 1) * 128 + k0 + i); rf[i] = r4.x; rf[i + 1] = r4.y; rf[i + 2] = r4.z; rf[i + 3] = r4.w; }
#pragma unroll
      for (int i = 0; i < 16; ++i) tmp[i] = qv[i] * ex2(bb[i] - rf[i]);
      st_row16(F.lds, HL_QD + t * RS128 + k0 * 2, tmp);
#pragma unroll
      for (int i = 0; i < 16; ++i) tmp[i] = kk[i] * ex2(fminf(rf[i] - bb[i], 86.f));
      st_row16(F.lds, HL_KD + t * RS128 + k0 * 2, tmp);
#pragma unroll
      for (int i = 0; i < 16; ++i) tmp[i] = qv[i] * ex2(bb[i]);
      st_row16(F.lds, HL_QE + t * RS128 + k0 * 2, tmp);
#pragma unroll
      for (int i = 0; i < 16; i += 4) { const f32x4 r4 = *(const LAS f32x4*)(REF + 1 * 128 + k0 + i); rf[i] = r4.x; rf[i + 1] = r4.y; rf[i + 2] = r4.z; rf[i + 3] = r4.w; }
      if (wave >= 4) {
#pragma unroll
          for (int i = 0; i < 16; ++i) tmp[i] = qv[i] * ex2(bb[i] - rf[i]);
          st_row16(F.lds, HL_Q1 + (t & 31) * RS128 + k0 * 2, tmp);
      } else {
#pragma unroll
          for (int i = 0; i < 16; ++i) tmp[i] = kk[i] * ex2(rf[i] - bb[i]);
          st_row16(F.lds, HL_K1 + (t & 31) * RS128 + k0 * 2, tmp);
      }
#pragma unroll
      for (int i = 0; i < 16; i += 4) { const f32x4 r4 = *(const LAS f32x4*)(REF + ((wave >= 4) ? 2 : 0) * 128 + k0 + i); rf[i] = r4.x; rf[i + 1] = r4.y; rf[i + 2] = r4.z; rf[i + 3] = r4.w; }
      if (wave & 2) {
#pragma unroll
          for (int i = 0; i < 16; ++i) tmp[i] = qv[i] * ex2(bb[i] - rf[i]);
          st_row16(F.lds, HL_Q2 + ((t & 15) + ((wave >= 4) ? 16 : 0)) * RS128 + k0 * 2, tmp);
      } else {
#pragma unroll
          for (int i = 0; i < 16; ++i) tmp[i] = kk[i] * ex2(rf[i] - bb[i]);
          st_row16(F.lds, HL_K2 + ((t & 15) + ((wave >= 4) ? 16 : 0)) * RS128 + k0 * 2, tmp);
      }
      for (int i = tid; i < 64 * RS64 / 16; i += NTHR) *(LAS u32x4*)(F.lds + HL_SC + i * 16) = (u32x4){0u, 0u, 0u, 0u};
    }
    __syncthreads();
    if (STOP == 2) { asm volatile("" :: "v"(sf[0]), "v"(gwv[0]), "v"(gain)); return; }
    for (int blk = wave; blk < 10; blk += 8) {
        int ko, qo, J, I; bool diag = false;
        if (blk < 4) { ko = HL_KD + blk * 16 * RS128; qo = HL_QD + blk * 16 * RS128; J = blk; I = blk; diag = true; }
        else if (blk == 4) { ko = HL_K2; qo = HL_Q2; J = 0; I = 1; }
        else if (blk == 5) { ko = HL_K2 + 16 * RS128; qo = HL_Q2 + 16 * RS128; J = 2; I = 3; }
        else { const int jj = (blk - 6) >> 1, ii = (blk - 6) & 1; ko = HL_K1 + jj * 16 * RS128; qo = HL_Q1 + ii * 16 * RS128; J = jj; I = 2 + ii; }
        f32x4 acc = {0.f, 0.f, 0.f, 0.f};
#pragma unroll
        for (int ks = 0; ks < 4; ++ks) { const bf16x8 af = *(const LAS bf16x8*)(F.lds + ko + fr * RS128 + (32 * ks + 8 * g) * 2), bf = *(const LAS bf16x8*)(F.lds + qo + fr * RS128 + (32 * ks + 8 * g) * 2);
            acc = __builtin_amdgcn_mfma_f32_16x16x32_bf16(af, bf, acc, 0, 0, 0); }
        if (diag) {
#pragma unroll
            for (int rg = 0; rg < 4; ++rg) if (4 * g + rg > fr) acc[rg] = 0.f; }
        u32x2 w; w.x = cvt_pk_bf16(acc[0], acc[1]); w.y = cvt_pk_bf16(acc[2], acc[3]);
        *(LAS u32x2*)(F.lds + HL_SC + (16 * I + fr) * RS64 + (16 * J + 4 * g) * 2) = w;
    }
    __syncthreads();
    if (STOP == 3) { asm volatile("" :: "v"(sf[0]), "v"(gwv[0]), "v"(gain)); return; }
    f32x4 o[4];
#pragma unroll
    for (int I = 0; I < 4; ++I) o[I] = (f32x4){0.f, 0.f, 0.f, 0.f};
    { bf16x8 af[2];
#pragma unroll
      for (int ks = 0; ks < 2; ++ks) af[ks] = *(const LAS bf16x8*)(F.lds + HL_VT + (wave * 16 + fr) * RS64 + (32 * ks + 8 * g) * 2);
#pragma unroll
      for (int I = 0; I < 4; ++I)
#pragma unroll
          for (int ks = 0; ks < 2; ++ks) { const bf16x8 bf = *(const LAS bf16x8*)(F.lds + HL_SC + (16 * I + fr) * RS64 + (32 * ks + 8 * g) * 2); o[I] = __builtin_amdgcn_mfma_f32_16x16x32_bf16(af[ks], bf, o[I], 0, 0, 0); }
#pragma unroll
      for (int I = 0; I < 4; ++I)
#pragma unroll
          for (int ks = 0; ks < 4; ++ks) { const bf16x8 bf = *(const LAS bf16x8*)(F.lds + HL_QE + (16 * I + fr) * RS128 + (32 * ks + 8 * g) * 2); o[I] = __builtin_amdgcn_mfma_f32_16x16x32_bf16(sf[ks], bf, o[I], 0, 0, 0); }
    }
    if (STOP == 4) { asm volatile("" :: "v"(o[0]), "v"(o[1]), "v"(o[2]), "v"(o[3]), "v"(gwv[0]), "v"(gain)); return; }
    LAS float* RED = (LAS float*)(F.lds + HL_RED);
#pragma unroll
    for (int I = 0; I < 4; ++I) { float q = (o[I][0] * o[I][0] + o[I][1] * o[I][1]) + (o[I][2] * o[I][2] + o[I][3] * o[I][3]); q += __shfl_xor(q, 16); q += __shfl_xor(q, 32); if (g == 0) RED[wave * 64 + 16 * I + fr] = q; }
    __syncthreads();
    { bf16_t* Y = (bf16_t*)(ws + WS_XB);
#pragma unroll
      for (int I = 0; I < 4; ++I) { const int tt = 16 * I + fr; float ssq = 0.f;
#pragma unroll
          for (int w = 0; w < 8; ++w) ssq += RED[w * 64 + tt];
          const float rs = __builtin_amdgcn_rsqf(ssq * (1.f / 128.f) + EPS);
          const u32x2 gw = gwv[I];
          const float g0 = bflo(gw.x), g1 = bfhi(gw.x), g2 = bflo(gw.y), g3 = bfhi(gw.y);
          u32x2 w; w.x = cvt_pk_bf16(o[I][0] * rs * gain.x * (g0 * sigmoidf_(g0)), o[I][1] * rs * gain.y * (g1 * sigmoidf_(g1)));
          w.y = cvt_pk_bf16(o[I][2] * rs * gain.z * (g2 * sigmoidf_(g2)), o[I][3] * rs * gain.w * (g3 * sigmoidf_(g3)));
          *(GAS u32x2*)(Y + (size_t)(row0 + tt) * DM + h * 128 + wave * 16 + 4 * g) = w; } }
    __syncthreads();
}

__device__ __forceinline__ void hg_scan(Frame& F) {
    unsigned char* ws = F.ws;
    for (int gid = F.vcu * NTHR + F.tid; gid < BATCH * HGH * 16384; gid += F.G * NTHR) {
        const int bh = gid >> 14, e = gid & 16383, k = e & 127;
        bf16_t* st = (bf16_t*)(ws + A_STATE) + (size_t)bh * NCHUNK * 16384 + e; const float* dc = (const float*)(ws + A_DECAY) + (size_t)bh * NCHUNK * 128 + k;
        float S = 0.f;
        for (int c0 = 0; c0 < NCHUNK; c0 += 8) { float kv[8], d[8];
#pragma unroll
            for (int i = 0; i < 8; ++i) { kv[i] = bf2f(st[(size_t)(c0 + i) * 16384]); d[i] = dc[(c0 + i) * 128]; }
#pragma unroll
            for (int i = 0; i < 8; ++i) { st[(size_t)(c0 + i) * 16384] = (bf16_t)f2bf(F.dry ? kv[i] : S); S = d[i] * S + kv[i]; } }
    }
}


typedef float f32x16 __attribute__((ext_vector_type(16)));
template <int D, int PAT>
__device__ __forceinline__ void att_pattern(Frame& F, int b, int h, int s_base, float kmax2, const bf16_t* QR, const bf16_t* KF, const bf16_t* VF) {
    const int lane = F.lane, wave = F.wave, r32 = lane & 31, hi = lane >> 5;
    LAS float* ACC = (LAS float*)F.lds; LAS float* LS = (LAS float*)(F.lds + 131072);
    constexpr int TPC = 16 / D, NT = SEQ / D / 32;
    const size_t bh = (size_t)(b * ATH + h) * (SEQ * 64);
    for (int jj = 0; jj < 2; ++jj) {
        const int j = wave + 8 * jj, r = j / TPC, tile = j % TPC, p0 = s_base / D + tile * 32;
        const size_t qrow = (size_t)b * SEQ + (size_t)(p0 + r32) * D + r;
        bf16x8 qf[4];
#pragma unroll
        for (int kk = 0; kk < 4; ++kk) qf[kk] = *(const GAS bf16x8*)(QR + qrow * 512 + h * 64 + 16 * kk + 8 * hi);
        float qn2 = 0.f;
#pragma unroll
        for (int kk = 0; kk < 4; ++kk)
#pragma unroll
            for (int e = 0; e < 8; ++e) { const float x = bf2f((unsigned short)qf[kk][e]); qn2 += x * x; }
        qn2 += __shfl_xor(qn2, 32);
        const float negM = -__builtin_amdgcn_sqrtf(qn2 * kmax2);
        f32x16 o[2] = {{}, {}}; float lsum = 0.f;
#pragma unroll
        for (int kt = 0; kt < 5; ++kt) {
            const float c0 = (p0 - 128 + 32 * kt) < 0 ? -1.0e30f : negM;
            bf16x8 vfr[2][2], kf[4];
            { const int kb = p0 - 128 + 32 * kt, kbc = kb < 0 ? 0 : kb;
              const bf16_t* kp = KF + bh + ((size_t)(r * NT + (kbc >> 5)) * 4) * 512 + lane * 8;
#pragma unroll
              for (int kk = 0; kk < 4; ++kk) kf[kk] = *(const GAS bf16x8*)(kp + kk * 512);
#pragma unroll
              for (int s = 0; s < 2; ++s)
#pragma unroll
                  for (int mt = 0; mt < 2; ++mt) vfr[s][mt] = *(const GAS bf16x8*)(VF + bh + ((size_t)(r * NT + (kbc >> 5)) * 4 + s * 2 + mt) * 512 + lane * 8); }
            f32x16 acc;
#pragma unroll
            for (int rg = 0; rg < 16; ++rg) acc[rg] = c0;
#pragma unroll
            for (int kk = 0; kk < 4; ++kk) acc = __builtin_amdgcn_mfma_f32_32x32x16_bf16(kf[kk], qf[kk], acc, 0, 0, 0);
            if (kt == 0 || kt == 4) {
#pragma unroll
                for (int rg = 0; rg < 16; ++rg) { const int kap = 16 * (rg >> 3) + 8 * hi + (rg & 7); if (kt == 0 ? (kap < r32) : (kap > r32)) acc[rg] = -1.0e30f; } }
#pragma unroll
            for (int rg = 0; rg < 16; ++rg) { acc[rg] = ex2(acc[rg]); lsum += acc[rg]; }
#pragma unroll
            for (int s = 0; s < 2; ++s) {
                u32x4 pw; pw.x = cvt_pk_bf16(acc[8 * s + 0], acc[8 * s + 1]); pw.y = cvt_pk_bf16(acc[8 * s + 2], acc[8 * s + 3]);
                pw.z = cvt_pk_bf16(acc[8 * s + 4], acc[8 * s + 5]); pw.w = cvt_pk_bf16(acc[8 * s + 6], acc[8 * s + 7]);
                const bf16x8 pf = __builtin_bit_cast(bf16x8, pw);
#pragma unroll
                for (int mt = 0; mt < 2; ++mt) o[mt] = __builtin_amdgcn_mfma_f32_32x32x16_bf16(vfr[s][mt], pf, o[mt], 0, 0, 0);
            }
        }
        lsum += __shfl_xor(lsum, 32);
        const int tau = (p0 + r32) * D + r - s_base, gsw = (tau ^ (tau >> 5)) & 31;
        LAS float* arow = ACC + tau * 64;
#pragma unroll
        for (int mt = 0; mt < 2; ++mt)
#pragma unroll
            for (int rg = 0; rg < 16; ++rg) { LAS float* p = arow + ((((rg & 3) + 8 * (rg >> 2) + 4 * hi) ^ gsw) + 32 * mt); if (PAT == 0) *p = o[mt][rg]; else *p += o[mt][rg]; }
        if (hi == 0) { if (PAT == 0) LS[tau] = lsum; else LS[tau] += lsum; }
    }
}
__device__ __forceinline__ void att_unit(Frame& F, int l, int unit) {
    const int tb = unit >> 3, h = unit & 7, b = tb >> 4, s_base = (tb & 15) * 512;
    const bf16_t* QR = (const bf16_t*)(F.ws + A_QR);
    LAS float* ACC = (LAS float*)F.lds; LAS float* LS = (LAS float*)(F.lds + 131072);
    const float kmax2 = __uint_as_float(__hip_atomic_load((unsigned*)(F.ctl + CW_KMAX + l * 16) + b * ATH + h, RLX_AGENT)) * 1.02f;
    att_pattern<1, 0>(F, b, h, s_base, kmax2, QR, (const bf16_t*)(F.ws + A_KF1), (const bf16_t*)(F.ws + A_VT1));
    __syncthreads();
    att_pattern<4, 1>(F, b, h, s_base, kmax2, QR, (const bf16_t*)(F.ws + A_KF4), (const bf16_t*)(F.ws + A_VT4));
    __syncthreads();
    att_pattern<16, 2>(F, b, h, s_base, kmax2, QR, (const bf16_t*)(F.ws + A_KF16), (const bf16_t*)(F.ws + A_VT16));
    __syncthreads();
    { const int tau = F.tid, gsw = (tau ^ (tau >> 5)) & 31; const LAS float* arow = ACC + tau * 64; const float inv = __builtin_amdgcn_rcpf(LS[tau]);
      bf16_t* yrow = (bf16_t*)(F.ws + WS_XB) + ((size_t)b * SEQ + s_base + tau) * DM + 512 + h * 64;
#pragma unroll
      for (int c = 0; c < 8; ++c) { float v[8];
#pragma unroll
          for (int e = 0; e < 8; ++e) v[e] = arow[((8 * c + e) & 32) + (((8 * c + e) & 31) ^ gsw)] * inv;
          u32x4 w; w.x = cvt_pk_bf16(v[0], v[1]); w.y = cvt_pk_bf16(v[2], v[3]); w.z = cvt_pk_bf16(v[4], v[5]); w.w = cvt_pk_bf16(v[6], v[7]); *(GAS u32x4*)(yrow + 8 * c) = w; } }
    __syncthreads();
}

__device__ __forceinline__ void ph_norm(Frame& F, const Args& a) {
    const int gw = F.vcu * NWAVES + F.wave, NGW = F.G * NWAVES;
    for (int r = gw; r < MT; r += NGW) { const float rs = row_norm_prep(F.out + (size_t)r * DM, (bf16_t*)(F.ws + WS_XB) + (size_t)r * DM, nullptr, F.lane); if (F.lane == 0) ((float*)(F.ws + WS_RSTD))[r] = rs; }
}

__device__ __forceinline__ void ph_router(Frame& F, const Args& a, int l) {
    unsigned char* ws = F.ws; const int lane = F.lane;
    const int gw = F.vcu * NWAVES + F.wave, NGW = F.G * NWAVES;
    { LAS float* scr = (LAS float*)(F.lds + F.wave * 16384);
      for (int it = gw; it < 3 * 4096; it += NGW) { const int ty = it >> 12, e = (it >> 8) & 15, r = it & 255;
          if (ty == 0) transpose_mat_item(IN_F(16) + ((size_t)l * NEXP + e) * DM * EFF, DM, EFF, IN_F(13) + l * DM, (bf16_t*)(ws + A_WGU) + (size_t)e * DM * DM, 1, r, scr, lane);
          else if (ty == 1) transpose_mat_item(IN_F(17) + ((size_t)l * NEXP + e) * DM * EFF, DM, EFF, IN_F(13) + l * DM, (bf16_t*)(ws + A_WGU) + (size_t)e * DM * DM, 2, r, scr, lane);
          else transpose_mat_item(IN_F(18) + ((size_t)l * NEXP + e) * EFF * DM, EFF, DM, nullptr, (bf16_t*)(ws + A_WD) + (size_t)e * DM * EFF, 0, r, scr, lane); } }
    __syncthreads();
    unsigned* cnt = (unsigned*)(F.ctl + CW_CNT + l * 16 * 64);
    LAS unsigned* LCNT = (LAS unsigned*)(F.lds + 81920); LAS unsigned* LBASE = (LAS unsigned*)(F.lds + 81984);
    LAS float* LG = (LAS float*)F.lds;
    LAS float* SS = (LAS float*)(F.lds + 16384);
    if (F.tid < 16) LCNT[F.tid] = 0u;
    const bf16_t* WH = (const bf16_t*)(ws + WS_WR) + (size_t)l * 32 * DM; const bf16_t* WL = WH + DEPTH * 32 * DM;
    const int fr = lane & 15, g = lane >> 4, tile = F.wave & 3, kh = F.wave >> 2;
    for (int rt = F.vcu; rt < MT / 64; rt += F.G) {
        const int row = rt * 64 + tile * 16 + fr;
        const float* xrow = F.out + (size_t)row * DM + kh * 512 + 8 * g; bf16_t* xbrow = (bf16_t*)(ws + WS_XB) + (size_t)row * DM + kh * 512 + 8 * g;
        f32x4 acc[2] = {{0.f, 0.f, 0.f, 0.f}, {0.f, 0.f, 0.f, 0.f}}; float ssq = 0.f;
#pragma unroll 4
        for (int ks = 0; ks < 16; ++ks) {
            const f32x4 x0 = *(const GAS f32x4*)(xrow + 32 * ks), x1 = *(const GAS f32x4*)(xrow + 32 * ks + 4);
            ssq += ((x0.x * x0.x + x0.y * x0.y) + (x0.z * x0.z + x0.w * x0.w)) + ((x1.x * x1.x + x1.y * x1.y) + (x1.z * x1.z + x1.w * x1.w));
            u32x4 hw; hw.x = cvt_pk_bf16(x0.x, x0.y); hw.y = cvt_pk_bf16(x0.z, x0.w); hw.z = cvt_pk_bf16(x1.x, x1.y); hw.w = cvt_pk_bf16(x1.z, x1.w);
            u32x4 lw; lw.x = cvt_pk_bf16(x0.x - bflo(hw.x), x0.y - bfhi(hw.x)); lw.y = cvt_pk_bf16(x0.z - bflo(hw.y), x0.w - bfhi(hw.y)); lw.z = cvt_pk_bf16(x1.x - bflo(hw.z), x1.y - bfhi(hw.z)); lw.w = cvt_pk_bf16(x1.z - bflo(hw.w), x1.w - bfhi(hw.w));
            *(GAS u32x4*)(xbrow + 32 * ks) = hw;
            const bf16x8 ah = __builtin_bit_cast(bf16x8, hw), al = __builtin_bit_cast(bf16x8, lw);
#pragma unroll
            for (int ct = 0; ct < 2; ++ct) { const size_t wo = (size_t)(16 * ct + fr) * DM + kh * 512 + 32 * ks + 8 * g;
                const bf16x8 bh = *(const GAS bf16x8*)(WH + wo), bl = *(const GAS bf16x8*)(WL + wo);
                acc[ct] = __builtin_amdgcn_mfma_f32_16x16x32_bf16(ah, bh, acc[ct], 0, 0, 0); acc[ct] = __builtin_amdgcn_mfma_f32_16x16x32_bf16(ah, bl, acc[ct], 0, 0, 0); acc[ct] = __builtin_amdgcn_mfma_f32_16x16x32_bf16(al, bh, acc[ct], 0, 0, 0); }
        }
        ssq += __shfl_xor(ssq, 16); ssq += __shfl_xor(ssq, 32);
        if (g == 0) SS[kh * 64 + tile * 16 + fr] = ssq;
#pragma unroll
        for (int ct = 0; ct < 2; ++ct)
#pragma unroll
            for (int rg = 0; rg < 4; ++rg) LG[(kh * 64 + tile * 16 + 4 * g + rg) * 32 + 16 * ct + fr] = acc[ct][rg];
        __syncthreads();
        if (F.tid < 64) { const int rl = F.tid, r = rt * 64 + rl;
            const float rstd = __builtin_amdgcn_rsqf((SS[rl] + SS[64 + rl]) * (1.f / DM) + EPS);
            float lg[20];
#pragma unroll
            for (int q = 0; q < 20; q += 4) { const f32x4 p0 = *(const LAS f32x4*)(LG + rl * 32 + q), p1 = *(const LAS f32x4*)(LG + (64 + rl) * 32 + q); lg[q] = (p0.x + p1.x) * rstd; lg[q + 1] = (p0.y + p1.y) * rstd; lg[q + 2] = (p0.z + p1.z) * rstd; lg[q + 3] = (p0.w + p1.w) * rstd; }
            ((float*)(ws + WS_RSTD))[r] = rstd;
            int gs = 0; float gm = lg[0];
#pragma unroll
            for (int q = 1; q < 4; ++q) if (lg[q] > gm) { gm = lg[q]; gs = q; }
            float den = 0.f;
#pragma unroll
            for (int q = 0; q < 4; ++q) den += __expf(lg[q] - gm);
            const float gwt = __builtin_amdgcn_rcpf(den);
            float e4[4];
#pragma unroll
            for (int q = 0; q < 4; ++q) e4[q] = gs == 0 ? lg[4 + q] : (gs == 1 ? lg[8 + q] : (gs == 2 ? lg[12 + q] : lg[16 + q]));
            int i1 = 0; float v1 = e4[0];
#pragma unroll
            for (int q = 1; q < 4; ++q) if (e4[q] > v1) { v1 = e4[q]; i1 = q; }
            int i2 = -1; float v2 = -3.0e38f;
#pragma unroll
            for (int q = 0; q < 4; ++q) if (q != i1 && e4[q] > v2) { v2 = e4[q]; i2 = q; }
            const float ex = __expf(v2 - v1), w1 = __builtin_amdgcn_rcpf(1.f + ex), w2 = ex * w1;
            const int id1 = gs * 4 + i1, id2 = gs * 4 + i2;
            int* te = (int*)(ws + WS_TOKE) + 2 * r; float* tw = (float*)(ws + WS_TOKW) + 2 * r; int* tl = (int*)(ws + WS_TOKL) + 2 * r;
            te[0] = id1; te[1] = id2; tw[0] = w1 * gwt; tw[1] = w2 * gwt;
            tl[0] = (int)__hip_atomic_fetch_add(LCNT + id1, 1u, __ATOMIC_RELAXED, __HIP_MEMORY_SCOPE_WORKGROUP); tl[1] = (int)__hip_atomic_fetch_add(LCNT + id2, 1u, __ATOMIC_RELAXED, __HIP_MEMORY_SCOPE_WORKGROUP);
        }
        __syncthreads();
    }
    __syncthreads();
    if (F.tid < 16) LBASE[F.tid] = __hip_atomic_fetch_add(cnt + 64 * F.tid, F.dry ? 0u : LCNT[F.tid], RLX_AGENT);
    __syncthreads();
    for (int rt = F.vcu; rt < MT / 64; rt += F.G) {
        if (F.tid < 128) { const int r = rt * 64 + (F.tid >> 1), k = F.tid & 1;
            const int e = ((const int*)(ws + WS_TOKE))[2 * r + k]; const int li = ((const int*)(ws + WS_TOKL))[2 * r + k] + (int)LBASE[e];
            ((int*)(ws + WS_TOKL))[2 * r + k] = li; ((int*)(ws + A_PERM2))[e * 16384 + li] = r; ((float*)(ws + A_SRS2))[e * 16384 + li] = ((const float*)(ws + WS_RSTD))[r]; ((float*)(ws + A_SGW2))[e * 16384 + li] = ((const float*)(ws + WS_TOKW))[2 * r + k]; } }
}

__device__ __forceinline__ void moe_prefix(Frame& F, int l) {
    if (F.tid == 0) { unsigned acc = 0; for (int e = 0; e < 16; ++e) { F.MISC[16 + e] = acc; const unsigned n = __hip_atomic_load((unsigned*)(F.ctl + CW_CNT + l * 16 * 64) + 64 * e, RLX_AGENT); F.MISC[40 + e] = n; acc += (n + 255u) >> 8; } F.MISC[32] = acc; }
    __syncthreads();
}

__device__ __forceinline__ void ph_combine(Frame& F, const Args& a, int l) {
    unsigned char* ws = F.ws; const int lane = F.lane;
    const int gw = F.vcu * NWAVES + F.wave, NGW = F.G * NWAVES;
    moe_prefix(F, l);
    const int* tlr = (const int*)(ws + WS_TOKL); const int* te = (const int*)(ws + WS_TOKE); const bf16_t* Y = (const bf16_t*)(ws + A_Y);
    auto slot_of = [&](int p) { return (int)F.MISC[16 + te[p]] * 256 + tlr[p]; };
    auto clampr = [&](int r) { return r < MT ? r : MT - 1; };
    int r = gw; if (r >= MT) return;
    int s0 = slot_of(2 * r), s1 = slot_of(2 * r + 1);
    int rn = clampr(r + NGW); int sn0 = slot_of(2 * rn), sn1 = slot_of(2 * rn + 1);
    f32x4 xv[4]; u32x2 ya[4], yb[4];
#pragma unroll
    for (int j = 0; j < 4; ++j) { xv[j] = ((const GAS f32x4*)(F.out + (size_t)r * DM) + lane)[64 * j]; ya[j] = ((const GAS u32x2*)(Y + (size_t)s0 * DM) + lane)[64 * j]; yb[j] = ((const GAS u32x2*)(Y + (size_t)s1 * DM) + lane)[64 * j]; }
    for (; r < MT; r += NGW) {
        const int rnn = clampr(r + 2 * NGW); const int snn0 = slot_of(2 * rnn), snn1 = slot_of(2 * rnn + 1);
        f32x4 xn[4]; u32x2 yan[4], ybn[4];
#pragma unroll
        for (int j = 0; j < 4; ++j) { xn[j] = ((const GAS f32x4*)(F.out + (size_t)rn * DM) + lane)[64 * j]; yan[j] = ((const GAS u32x2*)(Y + (size_t)sn0 * DM) + lane)[64 * j]; ybn[j] = ((const GAS u32x2*)(Y + (size_t)sn1 * DM) + lane)[64 * j]; }
        GAS f32x4* xr = (GAS f32x4*)(F.out + (size_t)r * DM) + lane;
        f32x4 v[4]; float s = 0.f;
#pragma unroll
        for (int j = 0; j < 4; ++j) { const u32x2 p0 = ya[j], p1 = yb[j]; f32x4 x = xv[j];
            const float dm = F.dry ? 0.f : 1.f; x.x += dm * (bflo(p0.x) + bflo(p1.x)); x.y += dm * (bfhi(p0.x) + bfhi(p1.x)); x.z += dm * (bflo(p0.y) + bflo(p1.y)); x.w += dm * (bfhi(p0.y) + bfhi(p1.y));
            v[j] = x; s += (x.x * x.x + x.y * x.y) + (x.z * x.z + x.w * x.w); }
        const float rstd = __builtin_amdgcn_rsqf(wave_sum(s) * (1.f / DM) + EPS);
        if (l == DEPTH - 1) { const GAS f32x4* g = (const GAS f32x4*)IN_F(19) + lane;
#pragma unroll
            for (int j = 0; j < 4; ++j) xr[64 * j] = v[j] * rstd * g[64 * j];
        } else {
            GAS u32x2* o8 = (GAS u32x2*)((bf16_t*)(ws + WS_XB) + (size_t)r * DM) + lane;
#pragma unroll
            for (int j = 0; j < 4; ++j) { xr[64 * j] = v[j]; u32x2 w; w.x = cvt_pk_bf16(v[j].x, v[j].y); w.y = cvt_pk_bf16(v[j].z, v[j].w); o8[64 * j] = w; }
            if (lane == 0) ((float*)(ws + WS_RSTD))[r] = rstd;
        }
#pragma unroll
        for (int j = 0; j < 4; ++j) { xv[j] = xn[j]; ya[j] = yan[j]; yb[j] = ybn[j]; }
        rn = rnn; sn0 = snn0; sn1 = snn1;
    }
}

constexpr int NPHASE = 1 + 11 * DEPTH + (PROBE_P >= 0 ? PROBE_N - 1 : 0);
__global__ void __launch_bounds__(NTHR, 2) fwd(Args a) {
    extern __shared__ __attribute__((aligned(16))) unsigned char lds_raw[];
    Frame F;
    F.lds = (LAS unsigned char*)lds_raw; F.MISC = (volatile LAS unsigned*)(F.lds + MISC_OFF);
    F.tid = threadIdx.x; F.lane = F.tid & 63; F.wave = __builtin_amdgcn_readfirstlane(F.tid >> 6);
    F.G = gridDim.x; { const int bx = blockIdx.x; F.vcu = (F.G % 8 == 0) ? (bx % 8) * (F.G / 8) + bx / 8 : bx; }
    F.ws = a.ws; F.ctl = (gu32*)(a.ws + WS_CTL); F.out = a.out; F.z = 0;
    for (int u = F.tid; u < (LDS_BYTES - LDSCTL_OFF) / 4; u += NTHR) ((LAS unsigned*)(F.lds + LDSCTL_OFF))[u] = 0u;
    __syncthreads();
    XcdBarrier bar; bar.bar = (unsigned*)(F.ctl + CW_BAR); bar.x = 0; bar.st = nullptr;
    const bool one_launch = (a.ph_hi - a.ph_lo) > 1;
    if (one_launch) bar = xcd_barrier_post((unsigned*)(F.ctl + CW_BAR), F.MISC + 8);
    for (int pp = a.ph_lo; pp < a.ph_hi; ++pp) {
        int ph = pp;
        F.dry = 0;
        if (PROBE_P >= 0) { constexpr int P = PROBE_P; if (pp > P) ph = (pp - (PROBE_N - 1) > P) ? pp - (PROBE_N - 1) : P; if (ph == P && pp < P + PROBE_N - 1) F.dry = 1; }
        { int t_ = threadIdx.x; asm volatile("" : "+v"(t_)); F.tid = t_; F.lane = t_ & 63; F.wave = __builtin_amdgcn_readfirstlane(t_ >> 6); }
        size_t z_ = 0; asm volatile("" : "+s"(z_)); F.z = z_; F.ws = a.ws + z_; F.out = (float*)((char*)a.out + z_); F.ctl = (gu32*)(a.ws + z_ + WS_CTL);
        unsigned char* ws = F.ws; int bx = (int)blockIdx.x; asm volatile("" : "+s"(bx));
        if (ph == 0) { if (PHSEL(0)) ph_init(F, a); }
        else {
            const int l = (ph - 1) / 11, qq = (ph - 1) % 11, q = qq < 5 ? qq : (qq < 8 ? qq + 1 : qq + 2);
            if (q == 0 && PHSEL(3)) {
                pg8::SchedDense S{64, 14, 896, F.G, bx, (const char*)(ws + WS_XB), (const char*)(ws + WS_WIN) + (size_t)l * NIN * DM * 2, (size_t)256 * DM * 2, (size_t)256 * DM * 2, 64, 0};
                EpiProj E{(bf16_t*)(ws + A_HG), (bf16_t*)(ws + A_QR), (bf16_t*)(ws + A_KF1), (bf16_t*)(ws + A_V), (const float*)(ws + WS_RSTD), (const f32x2*)(ws + WS_CS), (unsigned*)(F.ctl + CW_KMAX + l * 16)};
                pg8::gemm_phase<EpiProj, pg8::SchedDense, true, true, DM, DM>(F.lds, F.tid, S, E);
                if (l == 0) {
                    const bool part = (F.G == 256);
                    { size_t z2 = 0; asm volatile("" : "+s"(z2)); ws = F.ws + z2; F.ws = ws; int t2 = F.tid; asm volatile("" : "+v"(t2)); F.tid = t2; F.lane = t2 & 63; }
                    if (!part || (bx >= 128 && bx < 160)) { SchedKV SK{part ? 32 : F.G, part ? bx - 128 : bx, (const char*)(ws + WS_MEMN), (const char*)(ws + WS_WKVT)};
                        EpiKV EK{(bf16_t*)(ws + WS_KV), (bf16_t*)(ws + WS_KV) + (size_t)DEPTH * MEMROWS * DM};
                        pg8::gemm_phase<EpiKV, SchedKV, true, true, DM, DM>(F.lds, F.tid, SK, EK); }
                    if (!part || bx >= 160) conv_small_l1(F, a, part ? (bx - 160) * NWAVES + F.wave : F.vcu * NWAVES + F.wave, part ? 96 * NWAVES : F.G * NWAVES);
                }
            } else if (q == 1 && PHSEL(4)) {
                for (int rep = 0; rep < PROBE_PREP_N; ++rep) for (int u = F.vcu; u < (MT / 512) * ATH; u += F.G) vf_unit(F, u);
                for (int rep = 0; rep < PROBE_HGA_N; ++rep) { constexpr int NU = BATCH * HGH * NCHUNK; HgIn R = hg_load<false>(F, F.vcu < NU ? F.vcu : NU - 1);
                    for (int u = F.vcu; u < NU; u += F.G) { const HgIn Rn = hg_load<false>(F, u + F.G < NU ? u + F.G : NU - 1); hg_a2_unit(F, a, l, u, R); R = Rn; } }
                if (l == 0) {
                    { size_t z2 = 0; asm volatile("" : "+s"(z2)); ws = F.ws + z2; F.ws = ws; int t2 = F.tid; asm volatile("" : "+v"(t2)); F.tid = t2; F.lane = t2 & 63; }
                    SchedFold SF{F.G, bx, (const char*)(ws + WS_KV), (const char*)(ws + WS_KV) + (size_t)DEPTH * MEMROWS * DM * 2, (const char*)(ws + WS_WQS), (const char*)(ws + WS_WOT)};
                    EpiBf16 EF{(bf16_t*)(ws + WS_WQK), DM, (size_t)DM * DM, 1.f};
                    pg8::gemm_phase<EpiBf16, SchedFold, true, true, DM, 256>(F.lds, F.tid, SF, EF); }
            } else if (q == 2 && PHSEL(5)) hg_scan(F);
            else if (q == 3 && PHSEL(6)) {
                for (int rep = 0; rep < PROBE_HGC_N; ++rep) { constexpr int NU = BATCH * HGH * NCHUNK; HgIn R = hg_load<true>(F, F.vcu < NU ? F.vcu : NU - 1);
                    for (int u = F.vcu; u < NU; u += F.G) { const HgIn Rn = hg_load<true>(F, u + F.G < NU ? u + F.G : NU - 1); if (rep + 1 < PROBE_HGC_N) hg_c2_unit<PROBE_HGC_STOP>(F, a, l, u, R); else hg_c2_unit<0>(F, a, l, u, R); R = Rn; } }
#if ATT_GOLDEN
                for (int t = F.vcu * NWAVES + F.wave; t < (MT / 64) * ATH; t += F.G * NWAVES) att_task(F, t);
#else
                for (int rep = 0; rep < PROBE_ATT_N; ++rep) for (int u = F.vcu; u < (MT / 512) * ATH; u += F.G) att_unit(F, l, u);
#endif
            } else if (q == 4 && PHSEL(7)) {
                pg8::SchedDense S{64, 4, 256, F.G, bx, (const char*)(ws + WS_XB), (const char*)(ws + WS_WOUT) + (size_t)l * DM * DM * 2, (size_t)256 * DM * 2, (size_t)256 * DM * 2, 64, 0};
                EpiResNorm E{l == 0 ? IN_F(0) : (const float*)F.out, F.out, (bf16_t*)(ws + A_XB2), (float*)(ws + WS_SSQP)};
                pg8::gemm_phase<EpiResNorm, pg8::SchedDense, true, true, DM, DM>(F.lds, F.tid, S, E);
            } else if (q == 5 && PHSEL(8)) ph_norm(F, a);
            else if (q == 6 && PHSEL(9)) {
                pg8::SchedDense S{64, 4, 256, F.G, bx, (const char*)(ws + A_XB2), (const char*)(ws + WS_WQK) + (size_t)l * 2 * DM * DM * 2, (size_t)256 * DM * 2, (size_t)256 * DM * 2, 32, (size_t)DM * DM * 2};
                EpiSoftmax E{(bf16_t*)(ws + A_P), (const float*)(ws + WS_SSQP)};
                pg8::gemm_phase<EpiSoftmax, pg8::SchedDense, true, true, DM, DM>(F.lds, F.tid, S, E);
            } else if (q == 7 && PHSEL(10)) {
                pg8::SchedDense S{64, 4, 256, F.G, bx, (const char*)(ws + A_P), (const char*)(ws + WS_WVO) + (size_t)l * 2 * DM * DM * 2, (size_t)256 * DM * 2, (size_t)256 * DM * 2, 32, (size_t)DM * DM * 2};
                EpiResAdd E{(const float*)F.out, F.out, F.dry ? 0.f : 1.f};
                pg8::gemm_phase<EpiResAdd, pg8::SchedDense, true, true, DM, DM>(F.lds, F.tid, S, E);
            } else if (q == 8 && PHSEL(11)) ph_router(F, a, l);
            else if (q == 10 && PHSEL(13)) {
                moe_prefix(F, l);
                const int total = __builtin_amdgcn_readfirstlane((int)F.MISC[32]) * 4, early = (total / F.G) * F.G;
                SchedMoe S{F.G, bx, DM, F.MISC + 16, (const char*)(ws + WS_XB), (const char*)(ws + A_WGU), (const int*)(ws + A_PERM2), (const unsigned*)(F.ctl + CW_CNT + l * 16 * 64), true, 1, early, total - early, nullptr};
                EpiMoe1 E{(bf16_t*)(ws + A_ACTB), (const float*)(ws + A_SRS2), (const float*)(ws + A_SGW2)};
                pg8::gemm_phase<EpiMoe1, SchedMoe, true, true, DM, DM, true>(F.lds, F.tid, S, E);
            } else if (q == 11 && PHSEL(14)) {
                moe_prefix(F, l);
                const int total = __builtin_amdgcn_readfirstlane((int)F.MISC[32]) * 4, early = (total / F.G) * F.G, rem = total - early;
                unsigned* done = (unsigned*)(F.ctl + CW_DONE + l * 256);
                if (bx < rem) {
                    SchedMoe S{F.G, bx, DM, F.MISC + 16, (const char*)(ws + WS_XB), (const char*)(ws + A_WGU), (const int*)(ws + A_PERM2), (const unsigned*)(F.ctl + CW_CNT + l * 16 * 64), true, 2, early, rem, nullptr};
                    EpiMoe1 E{(bf16_t*)(ws + A_ACTB), (const float*)(ws + A_SRS2), (const float*)(ws + A_SGW2)};
                    pg8::gemm_phase<EpiMoe1, SchedMoe, true, true, DM, DM, true>(F.lds, F.tid, S, E);
                    if (F.tid == 0) { __builtin_amdgcn_fence(__ATOMIC_RELEASE, "agent"); asm volatile("s_waitcnt vmcnt(0)" ::: "memory"); __hip_atomic_fetch_add(done + ((early + bx) >> 2), 1u, __ATOMIC_RELAXED, __HIP_MEMORY_SCOPE_AGENT); }
                }
                { size_t z2 = 0; asm volatile("" : "+s"(z2)); ws = F.ws + z2; F.ws = ws; int t2 = F.tid; asm volatile("" : "+v"(t2)); F.tid = t2; F.lane = t2 & 63; }
                SchedMoe S{F.G, bx, EFF, F.MISC + 16, (const char*)(ws + A_ACTB), (const char*)(ws + A_WD), nullptr, nullptr, false, 3, early, rem, done};
                EpiBf16 E{(bf16_t*)(ws + A_Y), DM, 0, 1.f};
                pg8::gemm_phase<EpiBf16, SchedMoe, true, true, EFF, EFF>(F.lds, F.tid, S, E);
            } else if (q == 12 && PHSEL(15)) ph_combine(F, a, l);
        }
        if (pp + 1 < a.ph_hi) xcd_barrier(bar);
    }
}

extern "C" void kernel_launch(void* const* d_in, const int* in_sizes, int n_in, void* d_out, int out_size, void* d_ws, size_t ws_size, hipStream_t stream) {
    static int grid = 0;
    if (grid == 0) {
        if (n_in != 20 || in_sizes[0] != MT * DM || out_size != MT * DM || ws_size < WS_END) { fprintf(stderr, "kernel_launch: unexpected shapes / workspace (%d inputs, ws %zu)\n", n_in, ws_size); grid = -1; return; }
        int dev = 0, cus = 0, per_cu = 0;
        if (hipGetDevice(&dev) != hipSuccess || hipDeviceGetAttribute(&cus, hipDeviceAttributeMultiprocessorCount, dev) != hipSuccess) { grid = -1; return; }
        if (hipFuncSetAttribute((const void*)fwd, hipFuncAttributeMaxDynamicSharedMemorySize, LDS_BYTES) != hipSuccess) { grid = -1; return; }
        if (hipOccupancyMaxActiveBlocksPerMultiprocessor(&per_cu, (const void*)fwd, NTHR, LDS_BYTES) != hipSuccess || per_cu < 1) { fprintf(stderr, "kernel_launch: occupancy query says %d\n", per_cu); per_cu = 1; }
        (void)hipGetLastError();
        grid = cus * 1;
    }
    if (grid < 0) return;
    (void)hipMemsetAsync((char*)d_ws + WS_CTL, 0, CTL_ZERO_BYTES, stream);
    Args a{};
    for (int i = 0; i < 20; ++i) a.in[i] = d_in[i];
    a.out = (float*)d_out; a.ws = (unsigned char*)d_ws;
#if MK_PER_PHASE
    for (int ph = 0; ph < NPHASE; ++ph) { a.ph_lo = ph; a.ph_hi = ph + 1; hipLaunchKernelGGL(fwd, dim3(grid), dim3(NTHR), LDS_BYTES, stream, a); }
#else
    a.ph_lo = 0; a.ph_hi = NPHASE;
    void* kargs[] = {&a};
    hipError_t e = hipLaunchCooperativeKernel((const void*)fwd, dim3(grid), dim3(NTHR), kargs, LDS_BYTES, stream);
    if (e != hipSuccess) fprintf(stderr, "cooperative launch failed: %s (grid %d)\n", hipGetErrorString(e), grid);
#endif
}
```

```cpp
#include <hip/hip_runtime.h>
#include <cstdio>
#include <cstdint>

#ifndef PH_MASK
#define PH_MASK 0xFFFFFFFFu
#endif
#define PHSEL(n) ((PH_MASK >> (n)) & 1u)
#ifndef PROBE_ATT_N
#define PROBE_ATT_N 1
#endif
#ifndef PROBE_HGC_N
#define PROBE_HGC_N 1
#endif
#ifndef PROBE_HGA_N
#define PROBE_HGA_N 1
#endif
#ifndef PROBE_PREP_N
#define PROBE_PREP_N 1
#endif
#ifndef PROBE_HGC_STOP
#define PROBE_HGC_STOP 0
#endif
#ifndef PROBE_P
#define PROBE_P -1
#endif
#ifndef PROBE_N
#define PROBE_N 1
#endif
#ifndef HG_A_GOLDEN
#define HG_A_GOLDEN 0
#endif
#ifndef HG_C_GOLDEN
#define HG_C_GOLDEN 0
#endif
#ifndef ATT_GOLDEN
#define ATT_GOLDEN 0
#endif
#ifndef MK_PER_PHASE
#define MK_PER_PHASE 0
#endif

#define LAS __attribute__((address_space(3)))
#define GAS __attribute__((address_space(1)))
typedef unsigned short bf16_t;
typedef short bf16x8 __attribute__((ext_vector_type(8)));
typedef float f32x4 __attribute__((ext_vector_type(4)));
typedef float f32x2 __attribute__((ext_vector_type(2)));
typedef unsigned u32x4 __attribute__((ext_vector_type(4)));
typedef unsigned u32x2 __attribute__((ext_vector_type(2)));
typedef GAS unsigned gu32;

constexpr int BATCH = 2, SEQ = 8192, DM = 1024, MT = BATCH * SEQ, DEPTH = 2;
constexpr int MEM_LEN = 256, MEMROWS = BATCH * MEM_LEN;
constexpr int NIN = 3584, HGW = 512, HGH = 4, HGD = 128, CHUNK = 64, NCHUNK = SEQ / CHUNK;
constexpr int ATW = 512, ATH = 8, ATD = 64;
constexpr int NEXP = 16, EFF = 512;
constexpr float EPS = 1e-6f;
constexpr int NWAVES = 8, NTHR = 512;

constexpr size_t MiB = 1u << 20;
constexpr size_t WS_CTL = 0, CTL_ZERO_BYTES = 1 * MiB;
constexpr size_t WS_RSTD = 1 * MiB;
constexpr size_t WS_TOKE = WS_RSTD + 64 * 1024;
constexpr size_t WS_TOKW = WS_TOKE + 128 * 1024;
constexpr size_t WS_TOKL = WS_TOKW + 128 * 1024;
constexpr size_t WS_SLOTRS = WS_TOKL + 128 * 1024;
constexpr size_t WS_SLOTGW = WS_SLOTRS + 160 * 1024;
constexpr size_t WS_PERM = WS_SLOTGW + 160 * 1024;
constexpr size_t WS_WR = 3 * MiB;
constexpr size_t WS_LBT = 3 * MiB + 256 * 1024;
constexpr size_t WS_SSQP = 3 * MiB + 512 * 1024;
constexpr size_t WS_XB = 4 * MiB;
constexpr size_t WS_WIN = 36 * MiB;
constexpr size_t WS_WOUT = 50 * MiB;
constexpr size_t WS_WQS = 54 * MiB;
constexpr size_t WS_WKVT = 58 * MiB;
constexpr size_t WS_WOT = 66 * MiB;
constexpr size_t WS_MEMN = 70 * MiB;
constexpr size_t WS_KV = 72 * MiB;
constexpr size_t WS_WQK = 76 * MiB;
constexpr size_t WS_WVO = 84 * MiB;
constexpr size_t WS_ACT = 92 * MiB;
constexpr size_t WS_CS = 320 * MiB;
constexpr size_t WS_END = 324 * MiB;
constexpr size_t A_HG = WS_ACT + 0 * MiB;
constexpr size_t A_KF1 = WS_ACT + 64 * MiB;
constexpr size_t A_KF4 = WS_ACT + 80 * MiB;
constexpr size_t A_KF16 = WS_ACT + 96 * MiB;
constexpr size_t A_QR = WS_ACT + 112 * MiB;
constexpr size_t A_V = WS_ACT + 128 * MiB;
constexpr size_t A_VT1 = WS_ACT + 144 * MiB;
constexpr size_t A_VT4 = WS_ACT + 160 * MiB;
constexpr size_t A_VT16 = WS_ACT + 176 * MiB;
constexpr size_t A_STATE = WS_ACT + 192 * MiB;
constexpr size_t A_DECAY = WS_ACT + 224 * MiB;
constexpr size_t A_XB2 = WS_ACT + 0 * MiB;
constexpr size_t A_P = WS_ACT + 32 * MiB;
constexpr size_t A_WGU = WS_ACT + 0 * MiB;
constexpr size_t A_WD = WS_ACT + 32 * MiB;
constexpr size_t A_PERM2 = WS_ACT + 48 * MiB;
constexpr size_t A_SRS2 = WS_ACT + 49 * MiB;
constexpr size_t A_SGW2 = WS_ACT + 50 * MiB;
constexpr size_t A_ACTB = WS_ACT + 120 * MiB;
constexpr size_t A_Y = WS_ACT + 156 * MiB;
constexpr int MAXSLOT = 2 * MT + NEXP * 256;
static_assert(A_Y + (size_t)MAXSLOT * 1024 * 2 <= WS_END, "ws map");
constexpr int CW_BAR = 4096;
constexpr int CW_KMAX = 12288;
constexpr int CW_DONE = 24576;
constexpr int CW_CNT = 16384;
constexpr int RING_BYTES = 131072;
constexpr int SPARE_OFF = RING_BYTES;
constexpr int LDSCTL_OFF = RING_BYTES + 8192, MISC_OFF = LDSCTL_OFF + 64;
constexpr int LDS_BYTES = 147456;

#define RLX_AGENT __ATOMIC_RELAXED, __HIP_MEMORY_SCOPE_AGENT
#define LDS_WAIT() asm volatile("s_waitcnt lgkmcnt(0)" ::: "memory")
#define VM_WAIT() asm volatile("s_waitcnt vmcnt(0)" ::: "memory")

__device__ __forceinline__ unsigned f2bf(float f) { unsigned u = __builtin_bit_cast(unsigned, f); return (u + 0x7fffu + ((u >> 16) & 1u)) >> 16; }
__device__ __forceinline__ unsigned pk2(float lo, float hi) { return f2bf(lo) | (f2bf(hi) << 16); }
__device__ __forceinline__ float bf2f(unsigned short h) { return __builtin_bit_cast(float, (unsigned)h << 16); }
__device__ __forceinline__ float bflo(unsigned w) { return __builtin_bit_cast(float, w << 16); }
__device__ __forceinline__ float bfhi(unsigned w) { return __builtin_bit_cast(float, w & 0xffff0000u); }
typedef __bf16 bf16x2_t __attribute__((ext_vector_type(2)));
__device__ __forceinline__ unsigned cvt_pk_bf16(float lo, float hi) { f32x2 v = {lo, hi}; bf16x2_t b = __builtin_convertvector(v, bf16x2_t); return __builtin_bit_cast(unsigned, b); }
__device__ __forceinline__ float wave_sum(float v) {
#pragma unroll
    for (int o = 1; o < 64; o <<= 1) v += __shfl_xor(v, o);
    return v;
}
__device__ __forceinline__ float sigmoidf_(float z) { return __builtin_amdgcn_rcpf(1.f + __builtin_amdgcn_exp2f(-1.4426950408889634f * z)); }
__device__ __forceinline__ float ex2(float x) { return __builtin_amdgcn_exp2f(x); }
constexpr float LOG2E = 1.4426950408889634f;

#define XB_TMO      128
#define XB_XCNT(j)  (256  + 64 * (j))
#define XB_XSUB(j)  (1280 + 64 * (j))
#define XB_XGEN(j)  (2304 + 64 * (j))
#define XB_TOP      3328
#define XB_TOPGEN   3392
#define XCD_BAR_WORDS 3456
#define XB_SPIN_CAP (1u << 18)
__device__ __forceinline__ unsigned xb_ld(unsigned* p)              { return __hip_atomic_load(p, __ATOMIC_RELAXED, __HIP_MEMORY_SCOPE_AGENT); }
__device__ __forceinline__ unsigned xb_add(unsigned* p, unsigned v) { return __hip_atomic_fetch_add(p, v, __ATOMIC_RELAXED, __HIP_MEMORY_SCOPE_AGENT); }
__device__ __forceinline__ unsigned xb_xcc_id() { return (unsigned)__builtin_amdgcn_s_getreg((3 << 11) | 20) & 0xFu; }
#define XB_SPIN(cond, bar) do { unsigned _sp = 0; while (cond) { __builtin_amdgcn_s_sleep(1); \
    if ((++_sp & 255u) == 0u) { if (xb_ld(&(bar)[XB_TMO])) break; if (_sp > XB_SPIN_CAP) { atomicAdd(&(bar)[XB_TMO], 1u); break; } } } } while (0)
struct XcdBarrier { unsigned* bar; unsigned x; volatile LAS unsigned* st; };
__device__ __forceinline__ XcdBarrier xcd_barrier_post(unsigned* bar, volatile LAS unsigned* st) {
    XcdBarrier b; b.bar = bar; b.x = xb_xcc_id(); b.st = st;
    if (threadIdx.x == 0) (void)xb_add(&bar[XB_XCNT(b.x)], 1u);
    return b;
}
__device__ __forceinline__ void xcd_barrier_complete(unsigned* bar, unsigned x, unsigned& nloc, unsigned& nx) {
    const unsigned G = gridDim.x * gridDim.y * gridDim.z;
    unsigned sum, cnt, mine, sp = 0u;
    for (;;) {
        sum = 0u; cnt = 0u; mine = 0u;
        unsigned cv[16];
#pragma unroll
        for (unsigned j = 0; j < 16; ++j) cv[j] = xb_ld(&bar[XB_XCNT(j)]);
#pragma unroll
        for (unsigned j = 0; j < 16; ++j) { const unsigned c = cv[j]; sum += c; cnt += (c > 0u) ? 1u : 0u; mine = (j == x) ? c : mine; }
        if (sum == G) break;
        __builtin_amdgcn_s_sleep(1);
        if ((++sp & 255u) == 0u) { if (xb_ld(&bar[XB_TMO])) break; if (sp > XB_SPIN_CAP) { atomicAdd(&bar[XB_TMO], 1u); break; } }
    }
    nloc = mine > 0u ? mine : 1u; nx = cnt > 0u ? cnt : 1u;
}
__device__ __forceinline__ void xcd_barrier(const XcdBarrier& b) {
    asm volatile("s_waitcnt vmcnt(0)" ::: "memory");
    __syncthreads();
    if (threadIdx.x == 0) {
        unsigned* bar = b.bar;
        __builtin_amdgcn_s_waitcnt(0);
        unsigned nloc = b.st[0], nx = b.st[1];
        if (nloc == 0u) { xcd_barrier_complete(bar, b.x, nloc, nx); b.st[0] = nloc; b.st[1] = nx; }
        const unsigned old = xb_add(&bar[XB_XSUB(b.x)], 1u);
        const unsigned gen = old / nloc;
        if (old + 1u == (gen + 1u) * nloc) {
            __builtin_amdgcn_fence(__ATOMIC_RELEASE, "agent");
            asm volatile("s_waitcnt vmcnt(0)" ::: "memory");
            const unsigned og = xb_add(&bar[XB_TOP], 1u);
            const unsigned tg = og / nx;
            if (og + 1u == (tg + 1u) * nx) xb_add(&bar[XB_TOPGEN], 1u);
            else XB_SPIN(xb_ld(&bar[XB_TOPGEN]) == tg, bar);
            __builtin_amdgcn_fence(__ATOMIC_ACQUIRE, "agent");
            xb_add(&bar[XB_XGEN(b.x)], 1u);
            asm volatile("s_waitcnt vmcnt(0)" ::: "memory");
        } else {
            XB_SPIN(xb_ld(&bar[XB_XGEN(b.x)]) == gen, bar);
            __builtin_amdgcn_fence(__ATOMIC_ACQUIRE, "agent");
            asm volatile("s_waitcnt vmcnt(0)" ::: "memory");
        }
    }
    __syncthreads();
}

namespace pg8 {
constexpr int BM = 256, BK = 64, HALF = 128, HTB = HALF * BK * 2, STAGE_BYTES = 8 * HTB, NXCD = 8, WGM = 8;
__host__ __device__ __forceinline__ int lds_byte(int r, int c) { const int st = (r >> 4) * 2 + (c >> 5), rr = r & 15, cc = c & 31, ob = rr * 64 + cc * 2; return st * 1024 + (ob ^ (((ob >> 9) & 1) << 5)); }
__host__ __device__ __forceinline__ void stage_rc(int b, int& R, int& C) { const int st = b / 1024, sb = b % 1024, swz = sb ^ (((sb >> 9) & 1) << 5); R = (st >> 1) * 16 + swz / 64; C = (st & 1) * 32 + (swz % 64) / 2; }
__host__ __device__ __forceinline__ int perm32(int rho) { const int n = rho >> 4, i = rho & 15; return 8 * (i >> 2) + 4 * n + (i & 3); }

struct Unit { int pm, pn, aux, lr; const char* a; const char* b; };
typedef f32x4 Acc[2][2][4][2];

template <class Epi, class Sched, bool ALIGN_EPI, bool SP2, int LD, int K, bool GATHER = false>
__device__ __forceinline__ void gemm_phase(LAS unsigned char* lds, const int tid, const Sched& S, const Epi& E) {
    constexpr int lda = LD, ldb = LD;
    const int wid = __builtin_amdgcn_readfirstlane(tid >> 6), lane = tid & 63, wr = wid >> 2, wc = wid & 3, fr = lane & 15, fq = lane >> 4;
    constexpr int nt = K / BK;
    unsigned voffA[2], voffB[2];
#pragma unroll
    for (int i = 0; i < 2; ++i) { int R, C; stage_rc(tid * 16 + i * 8192, R, C); const int Rb = Epi::PERM ? ((R & ~31) + perm32(R & 31)) : R;
        voffA[i] = (unsigned)(R * lda + C) * 2u; voffB[i] = (unsigned)(Rb * ldb + C) * 2u; }
    const size_t kstep = (size_t)(BK * 2);
    const size_t hstepA = (size_t)HALF * lda * 2, hstepB = (size_t)HALF * ldb * 2;
    const unsigned ldsw = (unsigned)wid * 1024u;
    const int aoff = lds_byte(wr * 64 + fr, fq * 8), boff = lds_byte(wc * 32 + fr, fq * 8);
#define PG8_SA(b, h) (((b) * 2 + (h)) * HTB)
#define PG8_SB(b, h) ((4 + (b) * 2 + (h)) * HTB)
#define PG8_STAGE(bufoff, gbase, voff) do { _Pragma("unroll") for (int _i = 0; _i < 2; ++_i) \
        __builtin_amdgcn_global_load_lds((const unsigned*)((const char*)(gbase) + (voff)[_i]), (LAS unsigned*)(lds + (bufoff) + ldsw + _i * 8192), 16, 0, 0); } while (0)
#define PG8_STAGE_A(bufoff, gbase, half, usenext) do { if constexpr (GATHER) { const unsigned _p = (usenext) ? vn[half] : vc[half]; unsigned _v[2]; _v[0] = (_p & 0xffffu) * (unsigned)(lda * 2) + gc2; _v[1] = (_p >> 16) * (unsigned)(lda * 2) + gc2; PG8_STAGE(bufoff, gbase, _v); } \
        else { PG8_STAGE(bufoff, (gbase) + (half) * hstepA, voffA); } } while (0)
#define PG8_LDA(dst, b, h) do { _Pragma("unroll") for (int m = 0; m < 4; ++m) _Pragma("unroll") for (int k = 0; k < 2; ++k) dst[m][k] = *(const LAS bf16x8*)(lds + PG8_SA(b, h) + aoff + m * 2048 + k * 1024); } while (0)
#define PG8_LDB(dst, b, h) do { _Pragma("unroll") for (int n = 0; n < 2; ++n) _Pragma("unroll") for (int k = 0; k < 2; ++k) dst[n][k] = *(const LAS bf16x8*)(lds + PG8_SB(b, h) + boff + n * 2048 + k * 1024); } while (0)
#define PG8_MMA(ai, bj, At, Bt) do { __builtin_amdgcn_s_setprio(1); _Pragma("unroll") for (int m = 0; m < 4; ++m) _Pragma("unroll") for (int n = 0; n < 2; ++n) _Pragma("unroll") for (int k = 0; k < 2; ++k) \
        acc[ai][bj][m][n] = __builtin_amdgcn_mfma_f32_16x16x32_bf16(Bt[n][k], At[m][k], acc[ai][bj][m][n], 0, 0, 0); __builtin_amdgcn_s_setprio(0); } while (0)
#define PG8_WAIT_V(n) asm volatile("s_waitcnt vmcnt(" #n ")" ::: "memory")
#define PG8_WAIT_L(n) asm volatile("s_waitcnt lgkmcnt(" #n ")" ::: "memory")
#define PG8_BAR __builtin_amdgcn_s_barrier()
#define PG8_SCHED __builtin_amdgcn_sched_barrier(0)
    Unit cur, nxt; int ui = 0;
    if (!S.next(0, cur)) return;
    Acc acc;
#pragma unroll
    for (int a = 0; a < 2; ++a)
#pragma unroll
        for (int b = 0; b < 2; ++b)
#pragma unroll
            for (int m = 0; m < 4; ++m)
#pragma unroll
                for (int n = 0; n < 2; ++n) acc[a][b][m][n] = (f32x4){0.f, 0.f, 0.f, 0.f};
    bf16x8 At[4][2], B0[2][2], B1[2][2];
    const char* cA = cur.a; const char* cB = cur.b;
    unsigned vc[2], vn[2], gc2 = 0;
    if constexpr (GATHER) { int R0, C0; stage_rc(tid * 16, R0, C0); gc2 = (unsigned)C0 * 2u;
#pragma unroll
        for (int h = 0; h < 2; ++h) { vc[h] = (unsigned)S.src_row(cur, 128 * h + R0) | ((unsigned)S.src_row(cur, 128 * h + R0 + 64) << 16); vn[h] = vc[h]; }
    }
    static_assert(SP2, "only the two-MFMA-blocks-per-barrier-pair loop is kept");
    {
        PG8_STAGE(PG8_SB(0, 0), cB, voffB); PG8_STAGE(PG8_SB(0, 1), cB + hstepB, voffB); PG8_STAGE_A(PG8_SA(0, 0), cA, 0, false); PG8_STAGE_A(PG8_SA(0, 1), cA, 1, false);
        if (wr == 1) PG8_BAR;
        PG8_WAIT_V(2); PG8_BAR;
        PG8_STAGE(PG8_SB(1, 0), cB + kstep, voffB); PG8_STAGE_A(PG8_SA(1, 0), cA + kstep, 0, false); PG8_STAGE(PG8_SB(1, 1), cB + hstepB + kstep, voffB);
        PG8_WAIT_V(6); PG8_BAR;
    }
    for (;;) {
        const bool has_next = S.next(ui + 1, nxt);
        const char* nA = has_next ? nxt.a : cA; const char* nB = has_next ? nxt.b : cB;
        if constexpr (GATHER) { if (has_next) { int R0, C0; stage_rc(tid * 16, R0, C0);
#pragma unroll
            for (int h = 0; h < 2; ++h) vn[h] = (unsigned)S.src_row(nxt, 128 * h + R0) | ((unsigned)S.src_row(nxt, 128 * h + R0 + 64) << 16); } }
#pragma nounroll
        for (int t = 0; t < nt; t += 2) {
            const bool last = (t == nt - 2);
            const char* a1 = cA + (size_t)(t + 1) * kstep;
            const char* a2 = last ? nA : cA + (size_t)(t + 2) * kstep; const char* b2 = last ? nB : cB + (size_t)(t + 2) * kstep;
            const char* a3 = a2 + kstep; const char* b3 = b2 + kstep;
            {
            PG8_LDB(B0, 0, 0); PG8_LDB(B1, 0, 1); PG8_SCHED; PG8_LDA(At, 0, 0); PG8_STAGE_A(PG8_SA(1, 1), a1, 1, false);
            PG8_WAIT_V(8); PG8_WAIT_L(0); PG8_BAR; PG8_MMA(0, 0, At, B0); PG8_MMA(0, 1, At, B1); PG8_BAR; PG8_SCHED;
            PG8_LDA(At, 0, 1); PG8_STAGE(PG8_SB(0, 0), b2, voffB); PG8_STAGE(PG8_SB(0, 1), b2 + hstepB, voffB); PG8_STAGE_A(PG8_SA(0, 0), a2, 0, last);
            PG8_WAIT_V(8); PG8_WAIT_L(0); PG8_BAR; PG8_MMA(1, 0, At, B0); PG8_MMA(1, 1, At, B1); PG8_BAR; PG8_SCHED;
            PG8_LDB(B0, 1, 0); PG8_LDB(B1, 1, 1); PG8_SCHED; PG8_LDA(At, 1, 0); PG8_STAGE_A(PG8_SA(0, 1), a2, 1, last);
            PG8_WAIT_V(8); PG8_WAIT_L(0); PG8_BAR; PG8_MMA(0, 0, At, B0); PG8_MMA(0, 1, At, B1); PG8_BAR; PG8_SCHED;
            PG8_LDA(At, 1, 1); PG8_STAGE(PG8_SB(1, 0), b3, voffB); PG8_STAGE(PG8_SB(1, 1), b3 + hstepB, voffB); PG8_STAGE_A(PG8_SA(1, 0), a3, 0, last);
            PG8_WAIT_V(8); PG8_WAIT_L(0); PG8_BAR; PG8_MMA(1, 0, At, B0); PG8_MMA(1, 1, At, B1); PG8_BAR; PG8_SCHED;
            }
        }
        if constexpr (ALIGN_EPI) { if (wr == 0) PG8_BAR; }
        E(acc, cur, wr, wc, fr, fq, lds);
        if (!has_next) break;
#pragma unroll
        for (int a = 0; a < 2; ++a)
#pragma unroll
            for (int b = 0; b < 2; ++b)
#pragma unroll
                for (int m = 0; m < 4; ++m)
#pragma unroll
                    for (int n = 0; n < 2; ++n) acc[a][b][m][n] = (f32x4){0.f, 0.f, 0.f, 0.f};
        cur = nxt; cA = nA; cB = nB; ++ui;
        if constexpr (GATHER) { vc[0] = vn[0]; vc[1] = vn[1]; }
        if constexpr (ALIGN_EPI) { if (wr == 1) PG8_BAR; }
    }
    PG8_WAIT_V(0);
    if constexpr (!ALIGN_EPI) { if (wr == 0) PG8_BAR; }
    PG8_BAR;
#undef PG8_SA
#undef PG8_SB
#undef PG8_STAGE
#undef PG8_STAGE_A
#undef PG8_LDA
#undef PG8_LDB
#undef PG8_MMA
#undef PG8_WAIT_V
#undef PG8_WAIT_L
#undef PG8_BAR
#undef PG8_SCHED
}

struct SchedDense {
    int nM, nN, nwg, G, c; const char* A; const char* B; size_t a_tile, b_tile; int pm_per_batch; size_t b_batch;
    __device__ __forceinline__ bool next(int i, Unit& u) const {
        const long L = (long)i * G + c; if (L >= nwg) return false;
        int wgid = (int)L; { const int q = nwg / NXCD, r = nwg % NXCD, xcd = wgid % NXCD, off = wgid / NXCD; wgid = (xcd < r ? xcd * (q + 1) : r * (q + 1) + (xcd - r) * q) + off; }
        const int nig = WGM * nN, gid = wgid / nig, fm = gid * WGM, gsz = (nM - fm) < WGM ? (nM - fm) : WGM;
        u.pm = fm + ((wgid % nig) % gsz); u.pn = (wgid % nig) / gsz; u.aux = 0;
        u.a = A + (size_t)u.pm * a_tile; u.b = B + (size_t)u.pn * b_tile + (size_t)(u.pm / pm_per_batch) * b_batch; return true;
    }
};
}
using pg8::Unit; using pg8::Acc;

struct EpiBf16 {
    static constexpr bool PERM = true;
    bf16_t* O; int ldc; size_t aux_stride; float scale;
    __device__ __forceinline__ void operator()(const Acc& acc, const Unit& u, int wr, int wc, int fr, int fq, LAS unsigned char*) const {
        bf16_t* base = O + (size_t)u.aux * aux_stride;
        const int row0 = u.pm * 256 + wr * 64 + fr, col0 = u.pn * 256 + wc * 32 + 8 * fq;
#pragma unroll
        for (int ai = 0; ai < 2; ++ai)
#pragma unroll
            for (int m = 0; m < 4; ++m) { bf16_t* rowp = base + (size_t)(row0 + ai * 128 + m * 16) * ldc + col0;
#pragma unroll
                for (int bj = 0; bj < 2; ++bj) { const f32x4 v0 = acc[ai][bj][m][0] * scale, v1 = acc[ai][bj][m][1] * scale;
                    u32x4 w; w.x = cvt_pk_bf16(v0[0], v0[1]); w.y = cvt_pk_bf16(v0[2], v0[3]); w.z = cvt_pk_bf16(v1[0], v1[1]); w.w = cvt_pk_bf16(v1[2], v1[3]);
                    *(u32x4*)(rowp + bj * 128) = w; } }
    }
};
struct EpiKV {
    static constexpr bool PERM = true;
    bf16_t* KB; bf16_t* VB;
    __device__ __forceinline__ void operator()(const Acc& acc, const Unit& u, int wr, int wc, int fr, int fq, LAS unsigned char*) const {
        bf16_t* base = (u.pn < 4 ? KB : VB) + (size_t)u.aux * MEMROWS * DM;
        const int row0 = u.pm * 256 + wr * 64 + fr, col0 = (u.pn & 3) * 256 + wc * 32 + 8 * fq;
#pragma unroll
        for (int ai = 0; ai < 2; ++ai)
#pragma unroll
            for (int m = 0; m < 4; ++m) { bf16_t* rowp = base + (size_t)(row0 + ai * 128 + m * 16) * DM + col0;
#pragma unroll
                for (int bj = 0; bj < 2; ++bj) { const f32x4 v0 = acc[ai][bj][m][0], v1 = acc[ai][bj][m][1];
                    u32x4 w; w.x = cvt_pk_bf16(v0[0], v0[1]); w.y = cvt_pk_bf16(v0[2], v0[3]); w.z = cvt_pk_bf16(v1[0], v1[1]); w.w = cvt_pk_bf16(v1[2], v1[3]);
                    *(u32x4*)(rowp + bj * 128) = w; } }
    }
};
struct EpiProj {
    static constexpr bool PERM = true;
    bf16_t* HG; bf16_t* QR; bf16_t* KF; bf16_t* V; const float* rstd; const f32x2* CS; unsigned* kmax;
    __device__ __forceinline__ void operator()(const Acc& acc, const Unit& u, int wr, int wc, int fr, int fq, LAS unsigned char*) const {
        const int row0 = u.pm * 256 + wr * 64 + fr;
        float rsv[2][4];
#pragma unroll
        for (int ai = 0; ai < 2; ++ai)
#pragma unroll
            for (int m = 0; m < 4; ++m) rsv[ai][m] = rstd[row0 + ai * 128 + m * 16];
        if (u.pn < 8 || u.pn >= 12) {
            bf16_t* base; int ldc, colt;
            if (u.pn < 8) { base = HG; ldc = 2048; colt = u.pn * 256; } else { base = V; ldc = 512; colt = (u.pn - 12) * 256; }
            const int col0 = colt + wc * 32 + 8 * fq;
#pragma unroll
            for (int ai = 0; ai < 2; ++ai)
#pragma unroll
                for (int m = 0; m < 4; ++m) { const int row = row0 + ai * 128 + m * 16; const float rs = rsv[ai][m]; bf16_t* rowp = base + (size_t)row * ldc + col0;
#pragma unroll
                    for (int bj = 0; bj < 2; ++bj) { const f32x4 v0 = acc[ai][bj][m][0] * rs, v1 = acc[ai][bj][m][1] * rs;
                        u32x4 w; w.x = cvt_pk_bf16(v0[0], v0[1]); w.y = cvt_pk_bf16(v0[2], v0[3]); w.z = cvt_pk_bf16(v1[0], v1[1]); w.w = cvt_pk_bf16(v1[2], v1[3]);
                        *(u32x4*)(rowp + bj * 128) = w; } }
        } else {
            const bool isk = u.pn >= 10; const int head = 4 * (u.pn & 1) + wc;
            float kn2max = 0.f;
#pragma unroll
            for (int am = 0; am < 4; ++am) { const int ai = am >> 1;
                f32x4 csv[2][4];
#pragma unroll
                for (int mm = 0; mm < 2; ++mm) { const int m = 2 * (am & 1) + mm; const f32x4* cs = (const f32x4*)(CS + (size_t)(row0 + ai * 128 + m * 16) * 32 + 8 * fq); csv[mm][0] = cs[0]; csv[mm][1] = cs[1]; csv[mm][2] = cs[2]; csv[mm][3] = cs[3]; }
#pragma unroll
                for (int mm = 0; mm < 2; ++mm) { const int m = 2 * (am & 1) + mm; const int row = row0 + ai * 128 + m * 16; const float rs = rsv[ai][m] * (isk ? 1.f : 0.125f * LOG2E);
                    const f32x4 c0 = csv[mm][0], c1 = csv[mm][1], c2 = csv[mm][2], c3 = csv[mm][3];
                    const float co[8] = {c0.x, c0.z, c1.x, c1.z, c2.x, c2.z, c3.x, c3.z}, si[8] = {c0.y, c0.w, c1.y, c1.w, c2.y, c2.w, c3.y, c3.w};
                    float lo[8], hi[8];
#pragma unroll
                    for (int n = 0; n < 2; ++n)
#pragma unroll
                        for (int e = 0; e < 4; ++e) { const int j = 4 * n + e; const float x1 = acc[ai][0][m][n][e] * rs, x2 = acc[ai][1][m][n][e] * rs; lo[j] = x1 * co[j] - x2 * si[j]; hi[j] = x2 * co[j] + x1 * si[j]; }
                    u32x4 wl, wh; wl.x = cvt_pk_bf16(lo[0], lo[1]); wl.y = cvt_pk_bf16(lo[2], lo[3]); wl.z = cvt_pk_bf16(lo[4], lo[5]); wl.w = cvt_pk_bf16(lo[6], lo[7]);
                    wh.x = cvt_pk_bf16(hi[0], hi[1]); wh.y = cvt_pk_bf16(hi[2], hi[3]); wh.z = cvt_pk_bf16(hi[4], hi[5]); wh.w = cvt_pk_bf16(hi[6], hi[7]);
                    if (!isk) { bf16_t* rowp = QR + (size_t)row * 512 + head * 64 + 8 * fq; *(u32x4*)rowp = wl; *(u32x4*)(rowp + 32) = wh; }
                    else { { float n2 = 0.f;
#pragma unroll
                          for (int j = 0; j < 8; ++j) n2 += lo[j] * lo[j] + hi[j] * hi[j];
                          n2 += __shfl_xor(n2, 16); n2 += __shfl_xor(n2, 32); kn2max = fmaxf(kn2max, n2); }
                        const int b = row >> 13, s = row & (SEQ - 1); const size_t bh = (size_t)(b * ATH + head) * (SEQ * 64);
#pragma unroll
                        for (int pat = 0; pat < 3; ++pat) { const int D = pat == 0 ? 1 : (pat == 1 ? 4 : 16), sh = pat * 2; const int r = s & (D - 1), p = s >> sh, T = p >> 5, k5 = p & 31;
                            const int rho = (k5 & 19) | ((k5 & 4) << 1) | ((k5 & 8) >> 1);
                            bf16_t* kf = KF + (size_t)pat * (MT * 512) + bh + ((size_t)(r * (SEQ / 32 >> sh) + T) * 4) * 512;
                            *(u32x4*)(kf + ((fq >> 1) * 64 + rho + 32 * (fq & 1)) * 8) = wl; *(u32x4*)(kf + ((2 + (fq >> 1)) * 64 + rho + 32 * (fq & 1)) * 8) = wh; }
                    } } }
            if (isk) { kn2max = fmaxf(kn2max, __shfl_xor(kn2max, 1)); kn2max = fmaxf(kn2max, __shfl_xor(kn2max, 2)); kn2max = fmaxf(kn2max, __shfl_xor(kn2max, 4)); kn2max = fmaxf(kn2max, __shfl_xor(kn2max, 8));
                if (fr == 0 && fq == 0) __hip_atomic_fetch_max(kmax + ((u.pm >> 5) * ATH + head), __float_as_uint(kn2max), __ATOMIC_RELAXED, __HIP_MEMORY_SCOPE_AGENT); }
        }
    }
};
struct EpiResAdd {
    static constexpr bool PERM = false;
    const float* Xs; float* X; float dm;
    __device__ __forceinline__ void operator()(const Acc& acc, const Unit& u, int wr, int wc, int fr, int fq, LAS unsigned char*) const {
        const int row0 = u.pm * 256 + wr * 64 + fr, col0 = u.pn * 256 + wc * 32 + 4 * fq;
#pragma unroll
        for (int ai = 0; ai < 2; ++ai) {
            f32x4 xv[4][2][2];
#pragma unroll
            for (int m = 0; m < 4; ++m) { const size_t off = (size_t)(row0 + ai * 128 + m * 16) * DM + col0;
#pragma unroll
                for (int bj = 0; bj < 2; ++bj)
#pragma unroll
                    for (int n = 0; n < 2; ++n) xv[m][bj][n] = *(const f32x4*)(Xs + off + bj * 128 + n * 16); }
            asm volatile("" ::: "memory");
#pragma unroll
            for (int m = 0; m < 4; ++m) { const size_t off = (size_t)(row0 + ai * 128 + m * 16) * DM + col0;
#pragma unroll
                for (int bj = 0; bj < 2; ++bj)
#pragma unroll
                    for (int n = 0; n < 2; ++n) *(f32x4*)(X + off + bj * 128 + n * 16) = xv[m][bj][n] + acc[ai][bj][m][n] * dm; }
        }
    }
};
struct EpiResAddB {
    static constexpr bool PERM = false;
    const bf16_t* XBs; bf16_t* XBo;
    __device__ __forceinline__ void operator()(const Acc& acc, const Unit& u, int wr, int wc, int fr, int fq, LAS unsigned char*) const {
        const int row0 = u.pm * 256 + wr * 64 + fr, col0 = u.pn * 256 + wc * 32 + 4 * fq;
#pragma unroll
        for (int ai = 0; ai < 2; ++ai) {
            u32x2 xv[4][2][2];
#pragma unroll
            for (int m = 0; m < 4; ++m) { const size_t off = (size_t)(row0 + ai * 128 + m * 16) * DM + col0;
#pragma unroll
                for (int bj = 0; bj < 2; ++bj)
#pragma unroll
                    for (int n = 0; n < 2; ++n) xv[m][bj][n] = *(const u32x2*)(XBs + off + bj * 128 + n * 16); }
            asm volatile("" ::: "memory");
#pragma unroll
            for (int m = 0; m < 4; ++m) { const size_t off = (size_t)(row0 + ai * 128 + m * 16) * DM + col0;
#pragma unroll
                for (int bj = 0; bj < 2; ++bj)
#pragma unroll
                    for (int n = 0; n < 2; ++n) { const u32x2 w = xv[m][bj][n]; const f32x4 a4 = acc[ai][bj][m][n];
                        u32x2 o; o.x = cvt_pk_bf16(bflo(w.x) + a4[0], bfhi(w.x) + a4[1]); o.y = cvt_pk_bf16(bflo(w.y) + a4[2], bfhi(w.y) + a4[3]);
                        *(u32x2*)(XBo + off + bj * 128 + n * 16) = o; } }
        }
    }
};
struct EpiResNorm {
    static constexpr bool PERM = false;
    const float* Xs; bf16_t* XB; float* SSQP;
    __device__ __forceinline__ void operator()(const Acc& acc, const Unit& u, int wr, int wc, int fr, int fq, LAS unsigned char* lds) const {
        LAS float* EX = (LAS float*)(lds + SPARE_OFF);
        const int row0 = u.pm * 256 + wr * 64 + fr, col0 = u.pn * 256 + wc * 32 + 4 * fq;
#pragma unroll
        for (int ai = 0; ai < 2; ++ai)
#pragma unroll
            for (int m = 0; m < 4; ++m) { const size_t off = (size_t)(row0 + ai * 128 + m * 16) * DM + col0; float s = 0.f;
#pragma unroll
                for (int bj = 0; bj < 2; ++bj)
#pragma unroll
                    for (int n = 0; n < 2; ++n) { const f32x4 v = *(const f32x4*)(Xs + off + bj * 128 + n * 16) + acc[ai][bj][m][n];
                        u32x2 w; w.x = cvt_pk_bf16(v[0], v[1]); w.y = cvt_pk_bf16(v[2], v[3]); *(u32x2*)(XB + off + bj * 128 + n * 16) = w;
                        s += (v[0] * v[0] + v[1] * v[1]) + (v[2] * v[2] + v[3] * v[3]); }
                s += __shfl_xor(s, 16); s += __shfl_xor(s, 32);
                if (fq == 0) EX[(ai * 128 + wr * 64 + m * 16 + fr) * 4 + wc] = s; }
        asm volatile("s_waitcnt lgkmcnt(0)" ::: "memory"); __builtin_amdgcn_s_barrier(); asm volatile("" ::: "memory");
        { const int t = (wr * 4 + wc) * 64 + fq * 16 + fr; if (t < 256) { const f32x4 e = *(const LAS f32x4*)(EX + t * 4); SSQP[(size_t)(u.pm * 256 + t) * 4 + u.pn] = (e.x + e.y) + (e.z + e.w); } }
        asm volatile("s_waitcnt lgkmcnt(0)" ::: "memory"); __builtin_amdgcn_s_barrier(); asm volatile("" ::: "memory");
    }
};
struct EpiSoftmax {
    static constexpr bool PERM = false;
    bf16_t* P; const float* SSQP;
    __device__ __forceinline__ void operator()(Acc& acc, const Unit& u, int wr, int wc, int fr, int fq, LAS unsigned char* lds) const {
        LAS f32x2* EX = (LAS f32x2*)(lds + SPARE_OFF);
        const int row0 = u.pm * 256 + wr * 64 + fr;
        f32x4 pqv[2][4];
#pragma unroll
        for (int ai = 0; ai < 2; ++ai)
#pragma unroll
            for (int m = 0; m < 4; ++m) pqv[ai][m] = *(const f32x4*)(SSQP + (size_t)(row0 + ai * 128 + m * 16) * 4);
        float mw[2][4];
#pragma unroll
        for (int ai = 0; ai < 2; ++ai)
#pragma unroll
            for (int m = 0; m < 4; ++m) {
                const f32x4 pq = pqv[ai][m]; const float rs = __builtin_amdgcn_rsqf(((pq.x + pq.y) + (pq.z + pq.w)) * (1.f / DM) + EPS);
                float mx = -3.0e38f;
#pragma unroll
                for (int bj = 0; bj < 2; ++bj)
#pragma unroll
                    for (int n = 0; n < 2; ++n) { f32x4 v = acc[ai][bj][m][n] * rs; acc[ai][bj][m][n] = v; mx = fmaxf(mx, fmaxf(fmaxf(v[0], v[1]), fmaxf(v[2], v[3]))); }
                mx = fmaxf(mx, __shfl_xor(mx, 16)); mx = fmaxf(mx, __shfl_xor(mx, 32));
                float sm = 0.f;
#pragma unroll
                for (int bj = 0; bj < 2; ++bj)
#pragma unroll
                    for (int n = 0; n < 2; ++n) { f32x4 v = acc[ai][bj][m][n]; v[0] = __expf(v[0] - mx); v[1] = __expf(v[1] - mx); v[2] = __expf(v[2] - mx); v[3] = __expf(v[3] - mx);
                        acc[ai][bj][m][n] = v; sm += (v[0] + v[1]) + (v[2] + v[3]); }
                sm += __shfl_xor(sm, 16); sm += __shfl_xor(sm, 32);
                mw[ai][m] = mx;
                if (fq == 0) EX[(ai * 128 + wr * 64 + m * 16 + fr) * 4 + wc] = (f32x2){mx, sm};
            }
        asm volatile("s_waitcnt lgkmcnt(0)" ::: "memory"); __builtin_amdgcn_s_barrier(); asm volatile("" ::: "memory");
#pragma unroll
        for (int ai = 0; ai < 2; ++ai)
#pragma unroll
            for (int m = 0; m < 4; ++m) {
                const int rl = ai * 128 + wr * 64 + m * 16 + fr;
                const f32x2 e0 = EX[rl * 4 + 0], e1 = EX[rl * 4 + 1], e2 = EX[rl * 4 + 2], e3 = EX[rl * 4 + 3];
                const float M = fmaxf(fmaxf(e0.x, e1.x), fmaxf(e2.x, e3.x));
                const float Ls = e0.y * __expf(e0.x - M) + e1.y * __expf(e1.x - M) + e2.y * __expf(e2.x - M) + e3.y * __expf(e3.x - M);
                const float f = __expf(mw[ai][m] - M) / Ls;
                bf16_t* rowp = P + (size_t)(row0 + ai * 128 + m * 16) * DM + u.pn * 256 + wc * 32 + 4 * fq;
#pragma unroll
                for (int bj = 0; bj < 2; ++bj)
#pragma unroll
                    for (int n = 0; n < 2; ++n) { const f32x4 v = acc[ai][bj][m][n] * f; u32x2 w; w.x = cvt_pk_bf16(v[0], v[1]); w.y = cvt_pk_bf16(v[2], v[3]);
                        *(u32x2*)(rowp + bj * 128 + n * 16) = w; }
            }
        asm volatile("s_waitcnt lgkmcnt(0)" ::: "memory"); __builtin_amdgcn_s_barrier(); asm volatile("" ::: "memory");
    }
};
struct EpiMoe1 {
    static constexpr bool PERM = true;
    bf16_t* ACTB; const float* srs; const float* sgw;
    __device__ __forceinline__ void operator()(const Acc& acc, const Unit& u, int wr, int wc, int fr, int fq, LAS unsigned char*) const {
        const int row0 = u.pm * 256 + wr * 64 + fr, col0 = u.pn * 128 + wc * 32 + 8 * fq;
        float rsv[2][4], gwv[2][4];
#pragma unroll
        for (int ai = 0; ai < 2; ++ai)
#pragma unroll
            for (int m = 0; m < 4; ++m) { const int lrow = u.aux * 16384 + u.lr + wr * 64 + fr + ai * 128 + m * 16; rsv[ai][m] = srs[lrow]; gwv[ai][m] = sgw[lrow]; }
#pragma unroll
        for (int ai = 0; ai < 2; ++ai)
#pragma unroll
            for (int m = 0; m < 4; ++m) { const int row = row0 + ai * 128 + m * 16; const float rs = rsv[ai][m], gw = gwv[ai][m] * rs;
                float o[8];
#pragma unroll
                for (int n = 0; n < 2; ++n)
#pragma unroll
                    for (int j = 0; j < 4; ++j) { const float g = acc[ai][0][m][n][j] * rs, up = acc[ai][1][m][n][j]; o[n * 4 + j] = g * sigmoidf_(g) * up * gw; }
                u32x4 w; w.x = cvt_pk_bf16(o[0], o[1]); w.y = cvt_pk_bf16(o[2], o[3]); w.z = cvt_pk_bf16(o[4], o[5]); w.w = cvt_pk_bf16(o[6], o[7]);
                *(u32x4*)(ACTB + (size_t)row * EFF + col0) = w; }
    }
};

struct Args { const void* in[20]; float* out; unsigned char* ws; int ph_lo, ph_hi; };
struct Frame {
    LAS unsigned char* lds; volatile LAS unsigned* MISC; gu32* ctl;
    int tid, lane, wave, vcu, G;
    unsigned char* ws; float* out; size_t z; int dry;
};

__device__ __forceinline__ void transpose_item(const float* W, int N, const float* scale, bf16_t* WT, int ldt, int row_base, int k0, int n0, LAS float* scr, int lane) {
    f32x4 v[8];
#pragma unroll
    for (int i = 0; i < 8; ++i) v[i] = *(const GAS f32x4*)(W + (size_t)(k0 + 8 * i + (lane >> 3)) * N + n0 + 4 * (lane & 7));
#pragma unroll
    for (int i = 0; i < 8; ++i) { const int kk = 8 * i + (lane >> 3); f32x4 x = v[i]; if (scale) x = x * scale[k0 + kk]; LAS float* d = scr + kk * 33 + 4 * (lane & 7); d[0] = x.x; d[1] = x.y; d[2] = x.z; d[3] = x.w; }
    LDS_WAIT(); asm volatile("" ::: "memory");
    const int c = lane & 7;
#pragma unroll
    for (int j = 0; j < 4; ++j) { const int n = (lane >> 3) + 8 * j; const LAS float* s = scr + (8 * c) * 33 + n;
        u32x4 o; o.x = pk2(s[0 * 33], s[1 * 33]); o.y = pk2(s[2 * 33], s[3 * 33]); o.z = pk2(s[4 * 33], s[5 * 33]); o.w = pk2(s[6 * 33], s[7 * 33]);
        *(GAS u32x4*)(WT + (size_t)(row_base + n0 + n) * ldt + k0 + 8 * c) = o; }
    LDS_WAIT(); asm volatile("" ::: "memory");
}
__device__ __forceinline__ void transpose_mat_item(const float* W, int K, int N, const float* scale, bf16_t* WT, int mode, int it, LAS float* scr, int lane) {
    const int nblk = N / 32, kb = it / nblk, nb = it % nblk, k0 = 64 * kb, n0 = 32 * nb;
    int row_base = 0;
    if (mode == 1 || mode == 2) row_base = 256 * (n0 / 128) + (n0 % 128) + (mode == 2 ? 128 : 0) - n0;
    if (mode == 3 && n0 >= 2048 && n0 < 3072) {
        const int blk = (n0 - 2048) / 512, np = (n0 - 2048) % 512, head = np / 64, d = np % 64;
        row_base = 2048 + blk * 512 + (head / 4) * 256 + 128 * (d / 32) + 32 * (head % 4) + (d % 32) - n0; }
    transpose_item(W, N, scale, WT, K, row_base, k0, n0, scr, lane);
}

__device__ __forceinline__ float row_norm_prep(const float* xrow, bf16_t* xb_row, float* copy_row, int lane) {
    const GAS f32x4* xr = (const GAS f32x4*)xrow + lane;
    f32x4 v[4]; float s = 0.f;
#pragma unroll
    for (int j = 0; j < 4; ++j) { v[j] = xr[64 * j]; s += (v[j].x * v[j].x + v[j].y * v[j].y) + (v[j].z * v[j].z + v[j].w * v[j].w); }
    const float rstd = 1.f / sqrtf(wave_sum(s) * (1.f / DM) + EPS);
    GAS u32x2* o8 = (GAS u32x2*)xb_row + lane;
#pragma unroll
    for (int j = 0; j < 4; ++j) { u32x2 w; w.x = pk2(v[j].x, v[j].y); w.y = pk2(v[j].z, v[j].w); o8[64 * j] = w; }
    if (copy_row) { GAS f32x4* c = (GAS f32x4*)copy_row + lane;
#pragma unroll
        for (int j = 0; j < 4; ++j) c[64 * j] = v[j]; }
    return rstd;
}

__constant__ double INV_FREQ[32] = {1.0, 0.7498942093324559, 0.5623413251903491, 0.4216965034285822, 0.31622776601683794, 0.23713737056616552, 0.1778279410038923, 0.1333521432163324,
    0.1, 0.07498942093324558, 0.05623413251903491, 0.042169650342858224, 0.03162277660168379, 0.023713737056616554, 0.01778279410038923, 0.01333521432163324,
    0.01, 0.007498942093324558, 0.005623413251903491, 0.004216965034285823, 0.0031622776601683794, 0.0023713737056616554, 0.0017782794100389228, 0.001333521432163324,
    0.001, 0.0007498942093324559, 0.0005623413251903491, 0.00042169650342858224, 0.00031622776601683794, 0.00023713737056616554, 0.00017782794100389227, 0.0001333521432163324};


#define IN_F(i) ((const float*)((const char*)a.in[i] + F.z))
__device__ __forceinline__ float hg_lb(const Frame& F, const Args& a, int l, int c) { if (l == 0) return 0.f; const float* h = IN_F(5); return sigmoidf_(h[HGW + c] - h[c]); }
__device__ __forceinline__ void conv_small_item(Frame& F, const Args& a, int l, int r, LAS float* scr) {
    unsigned char* ws = F.ws; const int lane = F.lane;
    if (r < 1792) { transpose_mat_item(IN_F(4) + (size_t)l * DM * NIN, DM, NIN, IN_F(3) + l * DM, (bf16_t*)(ws + WS_WIN) + (size_t)l * NIN * DM, 3, r, scr, lane); return; } r -= 1792;
    if (r < 512) { transpose_mat_item(IN_F(7) + (size_t)l * DM * DM, DM, DM, nullptr, (bf16_t*)(ws + WS_WOUT) + (size_t)l * DM * DM, 0, r, scr, lane); return; } r -= 512;
    if (r < 1024) { transpose_mat_item(IN_F(11) + (size_t)l * DM * 2 * DM, DM, 2 * DM, nullptr, (bf16_t*)(ws + WS_WKVT) + (size_t)l * 2 * DM * DM, 0, r, scr, lane); return; } r -= 1024;
    transpose_mat_item(IN_F(12) + (size_t)l * DM * DM, DM, DM, nullptr, (bf16_t*)(ws + WS_WOT) + (size_t)l * DM * DM, 0, r, scr, lane);
}
__device__ __forceinline__ void conv_wq_row(Frame& F, const Args& a, int r) {
    const int lane = F.lane; const float sc = IN_F(8)[r] * 0.0625f;
    const GAS f32x4* src = (const GAS f32x4*)(IN_F(10) + (size_t)r * DM) + lane; GAS u32x2* dst = (GAS u32x2*)((bf16_t*)(F.ws + WS_WQS) + (size_t)r * DM) + lane;
#pragma unroll
    for (int j = 0; j < 4; ++j) { const f32x4 v = src[64 * j] * sc; u32x2 w; w.x = pk2(v.x, v.y); w.y = pk2(v.z, v.w); dst[64 * j] = w; }
}
__device__ __forceinline__ void conv_small_l1(Frame& F, const Args& a, int wi, int nw) {
    LAS float* scr = (LAS float*)(F.lds + F.wave * 16384);
    for (int it = wi; it < 2816; it += nw) conv_small_item(F, a, 1, it < 2304 ? it : it + 1024, scr);
    for (int r = wi; r < DM; r += nw) conv_wq_row(F, a, DM + r);
}
__device__ __forceinline__ void ph_init(Frame& F, const Args& a) {
    LAS float* scr = (LAS float*)(F.lds + F.wave * 16384);
    const int gw = F.vcu * NWAVES + F.wave, NGW = F.G * NWAVES, lane = F.lane;
    unsigned char* ws = F.ws;
    for (int it = gw; it < 3840 + 1024; it += NGW) {
        if (it < 3840) conv_small_item(F, a, 0, it, scr); else conv_small_item(F, a, 1, 2304 + (it - 3840), scr); }
    for (int r = gw; r < DM; r += NGW) conv_wq_row(F, a, r);
    for (int r = gw; r < MEMROWS; r += NGW) {
        const GAS f32x4* xr = (const GAS f32x4*)(IN_F(1) + (size_t)r * DM) + lane;
        f32x4 v[4]; float s = 0.f;
#pragma unroll
        for (int j = 0; j < 4; ++j) { v[j] = xr[64 * j]; s += (v[j].x * v[j].x + v[j].y * v[j].y) + (v[j].z * v[j].z + v[j].w * v[j].w); }
        const float rstd = 1.f / sqrtf(wave_sum(s) * (1.f / DM) + EPS);
        for (int l = 0; l < DEPTH; ++l) {
            const GAS f32x4* g = (const GAS f32x4*)(IN_F(9) + l * DM) + lane; GAS u32x2* dst = (GAS u32x2*)((bf16_t*)(ws + WS_MEMN) + ((size_t)l * MEMROWS + r) * DM) + lane;
#pragma unroll
            for (int j = 0; j < 4; ++j) { const f32x4 o = v[j] * rstd * g[64 * j]; u32x2 w; w.x = pk2(o.x, o.y); w.y = pk2(o.z, o.w); dst[64 * j] = w; }
        }
    }
    for (int r = gw; r < MT; r += NGW) {
        const float rs = row_norm_prep(IN_F(0) + (size_t)r * DM, (bf16_t*)(ws + WS_XB) + (size_t)r * DM, nullptr, lane);
        if (lane == 0) ((float*)(ws + WS_RSTD))[r] = rs;
    }
    for (int i = (F.vcu * NTHR + F.tid); i < DEPTH * HGW; i += F.G * NTHR) ((float*)(ws + WS_LBT))[i] = hg_lb(F, a, i / HGW, i % HGW);
    { const int* pos = (const int*)((const char*)a.in[2] + F.z);
      for (int i = (F.vcu * NTHR + F.tid); i < MT * 32; i += F.G * NTHR) { const double ang = (double)pos[i >> 5] * INV_FREQ[i & 31]; double rev = ang * 0.15915494309189535; rev = rev - __builtin_floor(rev);
          const float fr = (float)rev; ((f32x2*)(ws + WS_CS))[i] = (f32x2){__builtin_amdgcn_cosf(fr), __builtin_amdgcn_sinf(fr)}; } }
    for (int i = (F.vcu * NTHR + F.tid); i < DEPTH * 32 * DM; i += F.G * NTHR) {
        const int l = i / (32 * DM), n = (i / DM) % 32, k = i % DM;
        float w = 0.f;
        if (n < 4) w = IN_F(14)[((size_t)l * DM + k) * 4 + n]; else if (n < 20) w = IN_F(15)[((size_t)l * DM + k) * 16 + (n - 4)];
        w *= IN_F(13)[l * DM + k];
        const unsigned hi = f2bf(w); const float rem = w - bf2f((unsigned short)hi);
        ((bf16_t*)(ws + WS_WR))[i] = (bf16_t)hi; ((bf16_t*)(ws + WS_WR) + DEPTH * 32 * DM)[i] = (bf16_t)f2bf(rem);
    }
}

struct SchedKV {
    int G, c; const char* memn; const char* wkvt;
    __device__ __forceinline__ bool next(int i, Unit& u) const {
        const int L = i * G + c; if (L >= 32) return false;
        const int l = L >> 4; u.pm = (L >> 3) & 1; u.pn = L & 7; u.aux = l;
        u.a = memn + ((size_t)l * MEMROWS + u.pm * 256) * DM * 2; u.b = wkvt + ((size_t)l * 2 * DM + u.pn * 256) * DM * 2; return true;
    }
};
struct SchedFold {
    int G, c; const char* kb; const char* vb; const char* wqs; const char* wot;
    __device__ __forceinline__ bool next(int i, Unit& u) const {
        const int L = i * G + c; if (L >= 128) return false;
        const int ty = L >> 6, l = (L >> 5) & 1, b = (L >> 4) & 1, h = (L >> 2) & 3, t = L & 3; u.aux = ty * 4 + l * 2 + b;
        if (ty == 0) { u.pm = h; u.pn = t; u.a = kb + (((size_t)l * MEMROWS + b * 256) * DM + h * 256) * 2; u.b = wqs + (((size_t)l * DM + t * 256) * DM + h * 256) * 2; }
        else { u.pm = t; u.pn = h; u.a = wot + (((size_t)l * DM + t * 256) * DM + h * 256) * 2; u.b = vb + (((size_t)l * MEMROWS + b * 256) * DM + h * 256) * 2; }
        return true;
    }
};
struct SchedMoe {
    int G, c, kdim; volatile LAS unsigned* tb; const char* A; const char* B; const int* perm2; const unsigned* cnt; bool gather; int mode, early, rem; unsigned* done;
    __device__ __forceinline__ bool next(int i, Unit& u) const {
        const int total = __builtin_amdgcn_readfirstlane((int)tb[16]) * 4; int L;
        if (mode == 0) L = i * G + c;
        else if (mode == 1) { L = i * G + c; if (L >= early) return false; }
        else if (mode == 2) { if (i > 0 || c >= rem) return false; L = early + c; }
        else { const int cc = c >= rem ? c - rem : c - rem + G; L = c >= rem ? (i == 0 ? cc : (G - rem) + (i - 1) * G + cc) : (G - rem) + i * G + cc; }
        if (L >= total) return false;
        if (G == 256 && L < (mode == 1 || mode == 3 ? early : (total / 256) * 256)) { const int rd = L >> 8, idx = L & 255, xcd = idx & 7, q = idx >> 3; L = ((rd * 64 + xcd * 8 + (q >> 2)) << 2) + (q & 3); }
        const int mt = L >> 2; u.pm = mt; u.pn = L & 3; int e = 0;
#pragma unroll
        for (int j = 1; j < 16; ++j) e += (mt >= __builtin_amdgcn_readfirstlane((int)tb[j])) ? 1 : 0;
        u.aux = e; u.lr = (mt - __builtin_amdgcn_readfirstlane((int)tb[e])) * 256; u.a = gather ? A : A + (size_t)mt * 256 * kdim * 2; u.b = B + ((size_t)e * 1024 + u.pn * 256) * kdim * 2;
        if (mode == 3 && L >= early) {
            unsigned spins = 0; while (__hip_atomic_load(done + mt, __ATOMIC_RELAXED, __HIP_MEMORY_SCOPE_AGENT) < 4u) { __builtin_amdgcn_s_sleep(8); if (++spins > (1u << 18)) break; }
            __builtin_amdgcn_fence(__ATOMIC_ACQUIRE, "agent"); asm volatile("s_waitcnt vmcnt(0)" ::: "memory"); }
        return true;
    }
    __device__ __forceinline__ int src_row(const Unit& u, int r) const { const int lrow = u.lr + r; const int n = __builtin_amdgcn_readfirstlane((int)tb[24 + u.aux]); const int v = perm2[u.aux * 16384 + lrow]; return lrow < n ? v : 0; }
};

__device__ __forceinline__ void vf_unit(Frame& F, int unit) {
    unsigned char* ws = F.ws; const int tid = F.tid;
    const int tb = unit >> 3, h = unit & 7, b = tb >> 4, s_base = (tb & 15) * 512;
    LAS unsigned short* Vl = (LAS unsigned short*)F.lds;
    const bf16_t* V = (const bf16_t*)(ws + A_V) + ((size_t)b * SEQ + s_base) * 512 + h * 64;
#pragma unroll
    for (int p = 0; p < 8; ++p) { const int c = p * 512 + tid, row = c >> 3, ch = c & 7; *(LAS u32x4*)(Vl + row * 72 + ch * 8) = *(const GAS u32x4*)(V + (size_t)row * 512 + ch * 8); }
    __syncthreads();
    const size_t bh = (size_t)(b * ATH + h) * (SEQ * 64);
    for (int it = 0; it < 24; ++it) { const int pc = it * 512 + tid, tile = pc >> 8, q = pc & 255, s = q >> 7, mt = (q >> 6) & 1, ln = q & 63, dim = (ln & 31) + 32 * mt, hi = ln >> 5;
        const int pat = tile >> 4, j16 = tile & 15, sh = pat * 2, D = 1 << sh;
        const int TPC = 16 >> sh, r = j16 / TPC, tl = j16 % TPC;
        const int pl = tl * 32 + 16 * s + 8 * hi;
        unsigned w[4];
#pragma unroll
        for (int jj = 0; jj < 4; ++jj) { const int t0 = ((pl + 2 * jj) << sh) + r, t1 = ((pl + 2 * jj + 1) << sh) + r; w[jj] = (unsigned)Vl[t0 * 72 + dim] | ((unsigned)Vl[t1 * 72 + dim] << 16); }
        const int T = (s_base >> sh >> 5) + tl;
        bf16_t* vf = (bf16_t*)(ws + A_VT1) + (size_t)pat * (MT * 512) + bh + ((size_t)(r * (SEQ / 32 >> sh) + T) * 4 + s * 2 + mt) * 512 + ln * 8;
        *(GAS u32x4*)vf = (u32x4){w[0], w[1], w[2], w[3]}; }
    __syncthreads();
}

__device__ __forceinline__ void hg_build_b(Frame& F, int l, int h, const u32x4 z0, const u32x4 z1, int k0, float (&bb)[16], float (&kk)[16]) {
    const int tid = F.tid, lane = F.lane, wave = F.wave, tl = lane >> 3;
    LAS float* WT = (LAS float*)F.lds; LAS float* REF = (LAS float*)(F.lds + 4096);
    const unsigned zz[8] = {z0.x, z0.y, z0.z, z0.w, z1.x, z1.y, z1.z, z1.w};
    float lbv[16];
#pragma unroll
    for (int i = 0; i < 16; i += 4) { const f32x4 t4 = *(const GAS f32x4*)((const float*)(F.ws + WS_LBT) + l * HGW + h * 128 + k0 + i); lbv[i] = t4.x; lbv[i + 1] = t4.y; lbv[i + 2] = t4.z; lbv[i + 3] = t4.w; }
#pragma unroll
    for (int i = 0; i < 16; ++i) { const float z = (i & 1) ? bfhi(zz[i >> 1]) : bflo(zz[i >> 1]); const float lb = lbv[i];
        const float e = ex2(-LOG2E * z), sg = __builtin_amdgcn_rcpf(1.f + e), f = lb + (1.f - lb) * sg; bb[i] = __builtin_amdgcn_logf(f); kk[i] = (1.f - lb) * (e * sg); }
#pragma unroll
    for (int i = 0; i < 16; ++i) { float x = bb[i]; float y;
        y = __shfl_up(x, 8); if (tl >= 1) x += y;
        y = __shfl_up(x, 16); if (tl >= 2) x += y;
        y = __shfl_up(x, 32); if (tl >= 4) x += y;
        bb[i] = x; }
    if (tl == 7) {
#pragma unroll
        for (int i = 0; i < 16; i += 4) *(LAS f32x4*)(WT + wave * 128 + k0 + i) = (f32x4){bb[i], bb[i + 1], bb[i + 2], bb[i + 3]}; }
    __syncthreads();
    for (int w = 0; w < wave; ++w) {
#pragma unroll
        for (int i = 0; i < 16; i += 4) { const f32x4 p = *(const LAS f32x4*)(WT + w * 128 + k0 + i); bb[i] += p.x; bb[i + 1] += p.y; bb[i + 2] += p.z; bb[i + 3] += p.w; } }
    if (tl == 7 && (wave & 1)) {
#pragma unroll
        for (int i = 0; i < 16; i += 4) *(LAS f32x4*)(REF + (wave >> 1) * 128 + k0 + i) = (f32x4){bb[i], bb[i + 1], bb[i + 2], bb[i + 3]}; }
    __syncthreads();
    (void)tid;
}
__device__ __forceinline__ void st_row16(LAS unsigned char* base, int byteoff, const float (&v)[16]) {
    u32x4 w0, w1; w0.x = cvt_pk_bf16(v[0], v[1]); w0.y = cvt_pk_bf16(v[2], v[3]); w0.z = cvt_pk_bf16(v[4], v[5]); w0.w = cvt_pk_bf16(v[6], v[7]); w1.x = cvt_pk_bf16(v[8], v[9]); w1.y = cvt_pk_bf16(v[10], v[11]); w1.z = cvt_pk_bf16(v[12], v[13]); w1.w = cvt_pk_bf16(v[14], v[15]);
    *(LAS u32x4*)(base + byteoff) = w0; *(LAS u32x4*)(base + byteoff + 16) = w1;
}
constexpr int HL_RED = 6144, HL_QD = 8192, HL_KD = 25600, HL_QE = 43008, HL_Q1 = 60416, HL_K1 = 69120, HL_Q2 = 77824, HL_K2 = 86528, HL_VT = 95232, HL_SC = 113664;
constexpr int RS_TR = 288;
typedef short s16x4 __attribute__((ext_vector_type(4)));
constexpr int HA_KT = 8192, HA_VT = 8192 + 64 * 288;
constexpr int RS128 = 272, RS64 = 144;

struct HgIn { u32x4 z0, z1, q0, q1, v0, v1; };
template <bool NEEDQ> __device__ __forceinline__ HgIn hg_load(Frame& F, int unit) {
    HgIn R;
    const int b = unit >> 9, h = (unit >> 7) & 3, c = unit & 127; const int row0 = b * SEQ + c * CHUNK, t = F.tid >> 3, k0 = (F.tid & 7) * 16;
    const bf16_t* rowp = (const bf16_t*)(F.ws + A_HG) + (size_t)(row0 + t) * 2048 + h * 128 + k0;
    R.z0 = *(const GAS u32x4*)(rowp + 512); R.z1 = *(const GAS u32x4*)(rowp + 512 + 8); R.v0 = *(const GAS u32x4*)(rowp + 1024); R.v1 = *(const GAS u32x4*)(rowp + 1024 + 8);
    if (NEEDQ) { R.q0 = *(const GAS u32x4*)(rowp); R.q1 = *(const GAS u32x4*)(rowp + 8); } else { R.q0 = R.z0; R.q1 = R.z1; }
    return R;
}
__device__ __forceinline__ void hg_a2_unit(Frame& F, const Args& a, int l, int unit, const HgIn& R) {
    unsigned char* ws = F.ws; const int tid = F.tid, lane = F.lane, wave = F.wave;
    const int h = (unit >> 7) & 3;
    const int t = tid >> 3, k0 = (tid & 7) * 16;
    const u32x4 v0 = R.v0, v1 = R.v1;
    float bb[16], kk[16];
    hg_build_b(F, l, h, R.z0, R.z1, k0, bb, kk);
    const LAS float* REF = (const LAS float*)(F.lds + 4096);
    { float tmp[16];
#pragma unroll
      for (int i = 0; i < 16; ++i) tmp[i] = kk[i] * ex2(REF[3 * 128 + k0 + i] - bb[i]);
      st_row16(F.lds, HA_KT + t * RS_TR + k0 * 2, tmp);
      *(LAS u32x4*)(F.lds + HA_VT + t * RS_TR + k0 * 2) = v0; *(LAS u32x4*)(F.lds + HA_VT + t * RS_TR + k0 * 2 + 16) = v1; }
    if (tid < 128) ((float*)(ws + A_DECAY))[(size_t)unit * 128 + tid] = ex2(REF[3 * 128 + tid]);
    __syncthreads();
    { const int fr = lane & 15, g = lane >> 4;
      const int q = fr >> 2, p = fr & 3;
      auto trfrag = [&](int base, int c0, int ks) -> bf16x8 {
          const LAS unsigned char* a0 = F.lds + base + (32 * ks + 8 * g + q) * RS_TR + (c0 + 4 * p) * 2;
          const s16x4 lo = __builtin_bit_cast(s16x4, __builtin_amdgcn_ds_read_tr16_b64_v4i16((LAS s16x4*)a0));
          const s16x4 hi = __builtin_bit_cast(s16x4, __builtin_amdgcn_ds_read_tr16_b64_v4i16((LAS s16x4*)(a0 + 4 * RS_TR)));
          return (bf16x8){lo[0], lo[1], lo[2], lo[3], hi[0], hi[1], hi[2], hi[3]}; };
      bf16x8 af[2];
#pragma unroll
      for (int ks = 0; ks < 2; ++ks) af[ks] = trfrag(HA_KT, wave * 16, ks);
      bf16_t* st = (bf16_t*)(ws + A_STATE) + (size_t)unit * 16384;
#pragma unroll
      for (int vt = 0; vt < 8; ++vt) { f32x4 acc = {0.f, 0.f, 0.f, 0.f};
#pragma unroll
          for (int ks = 0; ks < 2; ++ks) { const bf16x8 bf = trfrag(HA_VT, vt * 16, ks); acc = __builtin_amdgcn_mfma_f32_16x16x32_bf16(af[ks], bf, acc, 0, 0, 0); }
          u32x2 w; w.x = cvt_pk_bf16(acc[0], acc[1]); w.y = cvt_pk_bf16(acc[2], acc[3]);
          *(GAS u32x2*)(st + (vt * 16 + fr) * 128 + wave * 16 + 4 * g) = w; } }
    __syncthreads();
}

template <int STOP> __device__ __forceinline__ void hg_c2_unit(Frame& F, const Args& a, int l, int unit, const HgIn& R) {
    unsigned char* ws = F.ws; const int tid = F.tid, lane = F.lane, wave = F.wave;
    const int b = unit >> 9, h = (unit >> 7) & 3, c = unit & 127; const int row0 = b * SEQ + c * CHUNK;
    const int t = tid >> 3, k0 = (tid & 7) * 16;
    const int fr = lane & 15, g = lane >> 4;
    const bf16_t* HG = (const bf16_t*)(ws + A_HG);
    const u32x4 q0 = R.q0, q1 = R.q1, v0 = R.v0, v1 = R.v1;
    bf16x8 sf[4]; u32x2 gwv[4];
    { const bf16_t* st = (const bf16_t*)(ws + A_STATE) + (size_t)unit * 16384 + (wave * 16 + fr) * 128;
#pragma unroll
      for (int ks = 0; ks < 4; ++ks) sf[ks] = *(const GAS bf16x8*)(st + 32 * ks + 8 * g);
#pragma unroll
      for (int I = 0; I < 4; ++I) gwv[I] = *(const GAS u32x2*)(HG + (size_t)(row0 + 16 * I + fr) * 2048 + 1536 + h * 128 + wave * 16 + 4 * g); }
    const f32x4 gain = *(const GAS f32x4*)(IN_F(6) + l * HGW + h * 128 + wave * 16 + 4 * g);
    float bb[16], kk[16];
    hg_build_b(F, l, h, R.z0, R.z1, k0, bb, kk);
    if (STOP == 1) { asm volatile("" :: "v"(bb[0]), "v"(kk[0]), "v"(sf[0]), "v"(gwv[0]), "v"(gain)); return; }
    const LAS float* REF = (const LAS float*)(F.lds + 4096);
    { const unsigned qq[8] = {q0.x, q0.y, q0.z, q0.w, q1.x, q1.y, q1.z, q1.w}, vv[8] = {v0.x, v0.y, v0.z, v0.w, v1.x, v1.y, v1.z, v1.w};
      LAS unsigned short* VT = (LAS unsigned short*)(F.lds + HL_VT);
      float qv[16], tmp[16];
#pragma unroll
      for (int i = 0; i < 16; ++i) { qv[i] = (i & 1) ? bfhi(qq[i >> 1]) : bflo(qq[i >> 1]); VT[(k0 + i) * (RS64 / 2) + t] = (unsigned short)((i & 1) ? (vv[i >> 1] >> 16) : (vv[i >> 1] & 0xffffu)); }
      const int I = wave >> 1;
      float rf[16];
#pragma unroll
      for (int i = 0; i < 16; i += 4) { f32x4 r4 = {0.f, 0.f, 0.f, 0.f}; if (I) r4 = *(const LAS f32x4*)(REF + (I - 1) * 128 + k0 + i); rf[i] = r4.x; rf[i + 1] = r4.y; rf[i + 2] = r4.z; rf[i + 3] = r4.w; }
#pragma unroll
      for (int i = 0; i < 16; ++i) tmp[i] = qv[i] * ex2(bb[i] - rf[i]);
      st_row16(F.lds, HL_QD + t * RS128 + k0 * 2, tmp);
#pragma unroll
      for (int i = 0; i < 16; ++i) tmp[i] = kk[i] * ex2(fminf(rf[i] - bb[i], 86.f));
      st_row16(F.lds, HL_KD + t * RS128 + k0 * 2, tmp);
#pragma unroll
      for (int i = 0; i < 16; ++i) tmp[i] = qv[i] * ex2(bb[i]);
      st_row16(F.lds, HL_QE + t * RS128 + k0 * 2, tmp);
#pragma unroll
      for (int i = 0; i < 16; i += 4) { const f32x4 r4 = *(const LAS f32x4*)(REF + 1 * 128 + k0 + i); rf[i] = r4.x; rf[i + 1] = r4.y; rf[i + 2] = r4.z; rf[i + 3] = r4.w; }
      if (wave >= 4) {
#pragma unroll
          for (int i = 0; i < 16; ++i) tmp[i] = qv[i] * ex2(bb[i] - rf[i]);
          st_row16(F.lds, HL_Q1 + (t & 31) * RS128 + k0 * 2, tmp);
      } else {
#pragma unroll
          for (int i = 0; i < 16; ++i) tmp[i] = kk[i] * ex2(rf[i] - bb[i]);
          st_row16(F.lds, HL_K1 + (t & 31) * RS128 + k0 * 2, tmp);
      }
#pragma unroll
      for (int i = 0; i < 16; i += 4) { const f32x4 r4 = *(const LAS f32x4*)(REF + ((wave >= 4) ? 2 : 0) * 128 + k0 + i); rf[i] = r4.x; rf[i + 1] = r4.y; rf[i + 2] = r4.z; rf[i + 3] = r4.w; }
      if (wave & 2) {
#pragma unroll
          for (int i = 0; i < 16; ++i) tmp[i] = qv[i] * ex2(bb[i] - rf[i]);
          st_row16(F.lds, HL_Q2 + ((t & 15) + ((wave >= 4) ? 16 : 0)) * RS128 + k0 * 2, tmp);
      } else {
#pragma unroll
          for (int i = 0; i < 16; ++i) tmp[i] = kk[i] * ex2(rf[i] - bb[i]);
          st_row16(F.lds, HL_K2 + ((t & 15) + ((wave >= 4) ? 16 : 0)) * RS128 + k0 * 2, tmp);
      }
      for (int i = tid; i < 64 * RS64 / 16; i += NTHR) *(LAS u32x4*)(F.lds + HL_SC + i * 16) = (u32x4){0u, 0u, 0u, 0u};
    }
    __syncthreads();
    if (STOP == 2) { asm volatile("" :: "v"(sf[0]), "v"(gwv[0]), "v"(gain)); return; }
    for (int blk = wave; blk < 10; blk += 8) {
        int ko, qo, J, I; bool diag = false;
        if (blk < 4) { ko = HL_KD + blk * 16 * RS128; qo = HL_QD + blk * 16 * RS128; J = blk; I = blk; diag = true; }
        else if (blk == 4) { ko = HL_K2; qo = HL_Q2; J = 0; I = 1; }
        else if (blk == 5) { ko = HL_K2 + 16 * RS128; qo = HL_Q2 + 16 * RS128; J = 2; I = 3; }
        else { const int jj = (blk - 6) >> 1, ii = (blk - 6) & 1; ko = HL_K1 + jj * 16 * RS128; qo = HL_Q1 + ii * 16 * RS128; J = jj; I = 2 + ii; }
        f32x4 acc = {0.f, 0.f, 0.f, 0.f};
#pragma unroll
        for (int ks = 0; ks < 4; ++ks) { const bf16x8 af = *(const LAS bf16x8*)(F.lds + ko + fr * RS128 + (32 * ks + 8 * g) * 2), bf = *(const LAS bf16x8*)(F.lds + qo + fr * RS128 + (32 * ks + 8 * g) * 2);
            acc = __builtin_amdgcn_mfma_f32_16x16x32_bf16(af, bf, acc, 0, 0, 0); }
        if (diag) {
#pragma unroll
            for (int rg = 0; rg < 4; ++rg) if (4 * g + rg > fr) acc[rg] = 0.f; }
        u32x2 w; w.x = cvt_pk_bf16(acc[0], acc[1]); w.y = cvt_pk_bf16(acc[2], acc[3]);
        *(LAS u32x2*)(F.lds + HL_SC + (16 * I + fr) * RS64 + (16 * J + 4 * g) * 2) = w;
    }
    __syncthreads();
    if (STOP == 3) { asm volatile("" :: "v"(sf[0]), "v"(gwv[0]), "v"(gain)); return; }
    f32x4 o[4];
#pragma unroll
    for (int I = 0; I < 4; ++I) o[I] = (f32x4){0.f, 0.f, 0.f, 0.f};
    { bf16x8 af[2];
#pragma unroll
      for (int ks = 0; ks < 2; ++ks) af[ks] = *(const LAS bf16x8*)(F.lds + HL_VT + (wave * 16 + fr) * RS64 + (32 * ks + 8 * g) * 2);
#pragma unroll
      for (int I = 0; I < 4; ++I)
#pragma unroll
          for (int ks = 0; ks < 2; ++ks) { const bf16x8 bf = *(const LAS bf16x8*)(F.lds + HL_SC + (16 * I + fr) * RS64 + (32 * ks + 8 * g) * 2); o[I] = __builtin_amdgcn_mfma_f32_16x16x32_bf16(af[ks], bf, o[I], 0, 0, 0); }
#pragma unroll
      for (int I = 0; I < 4; ++I)
#pragma unroll
          for (int ks = 0; ks < 4; ++ks) { const bf16x8 bf = *(const LAS bf16x8*)(F.lds + HL_QE + (16 * I + fr) * RS128 + (32 * ks + 8 * g) * 2); o[I] = __builtin_amdgcn_mfma_f32_16x16x32_bf16(sf[ks], bf, o[I], 0, 0, 0); }
    }
    if (STOP == 4) { asm volatile("" :: "v"(o[0]), "v"(o[1]), "v"(o[2]), "v"(o[3]), "v"(gwv[0]), "v"(gain)); return; }
    LAS float* RED = (LAS float*)(F.lds + HL_RED);
#pragma unroll
    for (int I = 0; I < 4; ++I) { float q = (o[I][0] * o[I][0] + o[I][1] * o[I][1]) + (o[I][2] * o[I][2] + o[I][3] * o[I][3]); q += __shfl_xor(q, 16); q += __shfl_xor(q, 32); if (g == 0) RED[wave * 64 + 16 * I + fr] = q; }
    __syncthreads();
    { bf16_t* Y = (bf16_t*)(ws + WS_XB);
#pragma unroll
      for (int I = 0; I < 4; ++I) { const int tt = 16 * I + fr; float ssq = 0.f;
#pragma unroll
          for (int w = 0; w < 8; ++w) ssq += RED[w * 64 + tt];
          const float rs = __builtin_amdgcn_rsqf(ssq * (1.f / 128.f) + EPS);
          const u32x2 gw = gwv[I];
          const float g0 = bflo(gw.x), g1 = bfhi(gw.x), g2 = bflo(gw.y), g3 = bfhi(gw.y);
          u32x2 w; w.x = cvt_pk_bf16(o[I][0] * rs * gain.x * (g0 * sigmoidf_(g0)), o[I][1] * rs * gain.y * (g1 * sigmoidf_(g1)));
          w.y = cvt_pk_bf16(o[I][2] * rs * gain.z * (g2 * sigmoidf_(g2)), o[I][3] * rs * gain.w * (g3 * sigmoidf_(g3)));
          *(GAS u32x2*)(Y + (size_t)(row0 + tt) * DM + h * 128 + wave * 16 + 4 * g) = w; } }
    __syncthreads();
}

__device__ __forceinline__ void hg_scan(Frame& F) {
    unsigned char* ws = F.ws;
    for (int gid = F.vcu * NTHR + F.tid; gid < BATCH * HGH * 16384; gid += F.G * NTHR) {
        const int bh = gid >> 14, e = gid & 16383, k = e & 127;
        bf16_t* st = (bf16_t*)(ws + A_STATE) + (size_t)bh * NCHUNK * 16384 + e; const float* dc = (const float*)(ws + A_DECAY) + (size_t)bh * NCHUNK * 128 + k;
        float S = 0.f;
        for (int c0 = 0; c0 < NCHUNK; c0 += 8) { float kv[8], d[8];
#pragma unroll
            for (int i = 0; i < 8; ++i) { kv[i] = bf2f(st[(size_t)(c0 + i) * 16384]); d[i] = dc[(c0 + i) * 128]; }
#pragma unroll
            for (int i = 0; i < 8; ++i) { st[(size_t)(c0 + i) * 16384] = (bf16_t)f2bf(F.dry ? kv[i] : S); S = d[i] * S + kv[i]; } }
    }
}


typedef float f32x16 __attribute__((ext_vector_type(16)));
template <int D, int PAT>
__device__ __forceinline__ void att_pattern(Frame& F, int b, int h, int s_base, float kmax2, const bf16_t* QR, const bf16_t* KF, const bf16_t* VF) {
    const int lane = F.lane, wave = F.wave, r32 = lane & 31, hi = lane >> 5;
    LAS float* ACC = (LAS float*)F.lds; LAS float* LS = (LAS float*)(F.lds + 131072);
    constexpr int TPC = 16 / D, NT = SEQ / D / 32;
    const size_t bh = (size_t)(b * ATH + h) * (SEQ * 64);
    for (int jj = 0; jj < 2; ++jj) {
        const int j = wave + 8 * jj, r = j / TPC, tile = j % TPC, p0 = s_base / D + tile * 32;
        const size_t qrow = (size_t)b * SEQ + (size_t)(p0 + r32) * D + r;
        bf16x8 qf[4];
#pragma unroll
        for (int kk = 0; kk < 4; ++kk) qf[kk] = *(const GAS bf16x8*)(QR + qrow * 512 + h * 64 + 16 * kk + 8 * hi);
        float qn2 = 0.f;
#pragma unroll
        for (int kk = 0; kk < 4; ++kk)
#pragma unroll
            for (int e = 0; e < 8; ++e) { const float x = bf2f((unsigned short)qf[kk][e]); qn2 += x * x; }
        qn2 += __shfl_xor(qn2, 32);
        const float negM = -__builtin_amdgcn_sqrtf(qn2 * kmax2);
        f32x16 o[2] = {{}, {}}; float lsum = 0.f;
#pragma unroll
        for (int kt = 0; kt < 5; ++kt) {
            const float c0 = (p0 - 128 + 32 * kt) < 0 ? -1.0e30f : negM;
            bf16x8 vfr[2][2], kf[4];
            { const int kb = p0 - 128 + 32 * kt, kbc = kb < 0 ? 0 : kb;
              const bf16_t* kp = KF + bh + ((size_t)(r * NT + (kbc >> 5)) * 4) * 512 + lane * 8;
#pragma unroll
              for (int kk = 0; kk < 4; ++kk) kf[kk] = *(const GAS bf16x8*)(kp + kk * 512);
#pragma unroll
              for (int s = 0; s < 2; ++s)
#pragma unroll
                  for (int mt = 0; mt < 2; ++mt) vfr[s][mt] = *(const GAS bf16x8*)(VF + bh + ((size_t)(r * NT + (kbc >> 5)) * 4 + s * 2 + mt) * 512 + lane * 8); }
            f32x16 acc;
#pragma unroll
            for (int rg = 0; rg < 16; ++rg) acc[rg] = c0;
#pragma unroll
            for (int kk = 0; kk < 4; ++kk) acc = __builtin_amdgcn_mfma_f32_32x32x16_bf16(kf[kk], qf[kk], acc, 0, 0, 0);
            if (kt == 0 || kt == 4) {
#pragma unroll
                for (int rg = 0; rg < 16; ++rg) { const int kap = 16 * (rg >> 3) + 8 * hi + (rg & 7); if (kt == 0 ? (kap < r32) : (kap > r32)) acc[rg] = -1.0e30f; } }
#pragma unroll
            for (int rg = 0; rg < 16; ++rg) { acc[rg] = ex2(acc[rg]); lsum += acc[rg]; }
#pragma unroll
            for (int s = 0; s < 2; ++s) {
                u32x4 pw; pw.x = cvt_pk_bf16(acc[8 * s + 0], acc[8 * s + 1]); pw.y = cvt_pk_bf16(acc[8 * s + 2], acc[8 * s + 3]);
                pw.z = cvt_pk_bf16(acc[8 * s + 4], acc[8 * s + 5]); pw.w = cvt_pk_bf16(acc[8 * s + 6], acc[8 * s + 7]);
                const bf16x8 pf = __builtin_bit_cast(bf16x8, pw);
#pragma unroll
                for (int mt = 0; mt < 2; ++mt) o[mt] = __builtin_amdgcn_mfma_f32_32x32x16_bf16(vfr[s][mt], pf, o[mt], 0, 0, 0);
            }
        }
        lsum += __shfl_xor(lsum, 32);
        const int tau = (p0 + r32) * D + r - s_base, gsw = (tau ^ (tau >> 5)) & 31;
        LAS float* arow = ACC + tau * 64;
#pragma unroll
        for (int mt = 0; mt < 2; ++mt)
#pragma unroll
            for (int rg = 0; rg < 16; ++rg) { LAS float* p = arow + ((((rg & 3) + 8 * (rg >> 2) + 4 * hi) ^ gsw) + 32 * mt); if (PAT == 0) *p = o[mt][rg]; else *p += o[mt][rg]; }
        if (hi == 0) { if (PAT == 0) LS[tau] = lsum; else LS[tau] += lsum; }
    }
}
__device__ __forceinline__ void att_unit(Frame& F, int l, int unit) {
    const int tb = unit >> 3, h = unit & 7, b = tb >> 4, s_base = (tb & 15) * 512;
    const bf16_t* QR = (const bf16_t*)(F.ws + A_QR);
    LAS float* ACC = (LAS float*)F.lds; LAS float* LS = (LAS float*)(F.lds + 131072);
    const float kmax2 = __uint_as_float(__hip_atomic_load((unsigned*)(F.ctl + CW_KMAX + l * 16) + b * ATH + h, RLX_AGENT)) * 1.02f;
    att_pattern<1, 0>(F, b, h, s_base, kmax2, QR, (const bf16_t*)(F.ws + A_KF1), (const bf16_t*)(F.ws + A_VT1));
    __syncthreads();
    att_pattern<4, 1>(F, b, h, s_base, kmax2, QR, (const bf16_t*)(F.ws + A_KF4), (const bf16_t*)(F.ws + A_VT4));
    __syncthreads();
    att_pattern<16, 2>(F, b, h, s_base, kmax2, QR, (const bf16_t*)(F.ws + A_KF16), (const bf16_t*)(F.ws + A_VT16));
    __syncthreads();
    { const int tau = F.tid, gsw = (tau ^ (tau >> 5)) & 31; const LAS float* arow = ACC + tau * 64; const float inv = __builtin_amdgcn_rcpf(LS[tau]);
      bf16_t* yrow = (bf16_t*)(F.ws + WS_XB) + ((size_t)b * SEQ + s_base + tau) * DM + 512 + h * 64;
#pragma unroll
      for (int c = 0; c < 8; ++c) { float v[8];
#pragma unroll
          for (int e = 0; e < 8; ++e) v[e] = arow[((8 * c + e) & 32) + (((8 * c + e) & 31) ^ gsw)] * inv;
          u32x4 w; w.x = cvt_pk_bf16(v[0], v[1]); w.y = cvt_pk_bf16(v[2], v[3]); w.z = cvt_pk_bf16(v[4], v[5]); w.w = cvt_pk_bf16(v[6], v[7]); *(GAS u32x4*)(yrow + 8 * c) = w; } }
    __syncthreads();
}

__device__ __forceinline__ void ph_norm(Frame& F, const Args& a) {
    const int gw = F.vcu * NWAVES + F.wave, NGW = F.G * NWAVES;
    for (int r = gw; r < MT; r += NGW) { const float rs = row_norm_prep(F.out + (size_t)r * DM, (bf16_t*)(F.ws + WS_XB) + (size_t)r * DM, nullptr, F.lane); if (F.lane == 0) ((float*)(F.ws + WS_RSTD))[r] = rs; }
}

__device__ __forceinline__ void ph_router(Frame& F, const Args& a, int l) {
    unsigned char* ws = F.ws; const int lane = F.lane;
    const int gw = F.vcu * NWAVES + F.wave, NGW = F.G * NWAVES;
    { LAS float* scr = (LAS float*)(F.lds + F.wave * 16384);
      for (int it = gw; it < 3 * 4096; it += NGW) { const int ty = it >> 12, e = (it >> 8) & 15, r = it & 255;
          if (ty == 0) transpose_mat_item(IN_F(16) + ((size_t)l * NEXP + e) * DM * EFF, DM, EFF, IN_F(13) + l * DM, (bf16_t*)(ws + A_WGU) + (size_t)e * DM * DM, 1, r, scr, lane);
          else if (ty == 1) transpose_mat_item(IN_F(17) + ((size_t)l * NEXP + e) * DM * EFF, DM, EFF, IN_F(13) + l * DM, (bf16_t*)(ws + A_WGU) + (size_t)e * DM * DM, 2, r, scr, lane);
          else transpose_mat_item(IN_F(18) + ((size_t)l * NEXP + e) * EFF * DM, EFF, DM, nullptr, (bf16_t*)(ws + A_WD) + (size_t)e * DM * EFF, 0, r, scr, lane); } }
    __syncthreads();
    unsigned* cnt = (unsigned*)(F.ctl + CW_CNT + l * 16 * 64);
    LAS unsigned* LCNT = (LAS unsigned*)(F.lds + 81920); LAS unsigned* LBASE = (LAS unsigned*)(F.lds + 81984);
    LAS float* LG = (LAS float*)F.lds;
    LAS float* SS = (LAS float*)(F.lds + 16384);
    if (F.tid < 16) LCNT[F.tid] = 0u;
    const bf16_t* WH = (const bf16_t*)(ws + WS_WR) + (size_t)l * 32 * DM; const bf16_t* WL = WH + DEPTH * 32 * DM;
    const int fr = lane & 15, g = lane >> 4, tile = F.wave & 3, kh = F.wave >> 2;
    for (int rt = F.vcu; rt < MT / 64; rt += F.G) {
        const int row = rt * 64 + tile * 16 + fr;
        const bf16_t* xbrow = (const bf16_t*)(ws + WS_XB) + (size_t)row * DM + kh * 512 + 8 * g;
        f32x4 acc[2] = {{0.f, 0.f, 0.f, 0.f}, {0.f, 0.f, 0.f, 0.f}}; float ssq = 0.f;
#pragma unroll 4
        for (int ks = 0; ks < 16; ++ks) {
            const u32x4 hw = *(const GAS u32x4*)(xbrow + 32 * ks);
            { const float x0 = bflo(hw.x), x1 = bfhi(hw.x), x2 = bflo(hw.y), x3 = bfhi(hw.y), x4 = bflo(hw.z), x5 = bfhi(hw.z), x6 = bflo(hw.w), x7 = bfhi(hw.w);
              ssq += ((x0 * x0 + x1 * x1) + (x2 * x2 + x3 * x3)) + ((x4 * x4 + x5 * x5) + (x6 * x6 + x7 * x7)); }
            const bf16x8 ah = __builtin_bit_cast(bf16x8, hw);
#pragma unroll
            for (int ct = 0; ct < 2; ++ct) { const size_t wo = (size_t)(16 * ct + fr) * DM + kh * 512 + 32 * ks + 8 * g;
                const bf16x8 bh = *(const GAS bf16x8*)(WH + wo), bl = *(const GAS bf16x8*)(WL + wo);
                acc[ct] = __builtin_amdgcn_mfma_f32_16x16x32_bf16(ah, bh, acc[ct], 0, 0, 0); acc[ct] = __builtin_amdgcn_mfma_f32_16x16x32_bf16(ah, bl, acc[ct], 0, 0, 0); }
        }
        ssq += __shfl_xor(ssq, 16); ssq += __shfl_xor(ssq, 32);
        if (g == 0) SS[kh * 64 + tile * 16 + fr] = ssq;
#pragma unroll
        for (int ct = 0; ct < 2; ++ct)
#pragma unroll
            for (int rg = 0; rg < 4; ++rg) LG[(kh * 64 + tile * 16 + 4 * g + rg) * 32 + 16 * ct + fr] = acc[ct][rg];
        __syncthreads();
        if (F.tid < 64) { const int rl = F.tid, r = rt * 64 + rl;
            const float rstd = __builtin_amdgcn_rsqf((SS[rl] + SS[64 + rl]) * (1.f / DM) + EPS);
            float lg[20];
#pragma unroll
            for (int q = 0; q < 20; q += 4) { const f32x4 p0 = *(const LAS f32x4*)(LG + rl * 32 + q), p1 = *(const LAS f32x4*)(LG + (64 + rl) * 32 + q); lg[q] = (p0.x + p1.x) * rstd; lg[q + 1] = (p0.y + p1.y) * rstd; lg[q + 2] = (p0.z + p1.z) * rstd; lg[q + 3] = (p0.w + p1.w) * rstd; }
            ((float*)(ws + WS_RSTD))[r] = rstd;
            int gs = 0; float gm = lg[0];
#pragma unroll
            for (int q = 1; q < 4; ++q) if (lg[q] > gm) { gm = lg[q]; gs = q; }
            float den = 0.f;
#pragma unroll
            for (int q = 0; q < 4; ++q) den += __expf(lg[q] - gm);
            const float gwt = __builtin_amdgcn_rcpf(den);
            float e4[4];
#pragma unroll
            for (int q = 0; q < 4; ++q) e4[q] = gs == 0 ? lg[4 + q] : (gs == 1 ? lg[8 + q] : (gs == 2 ? lg[12 + q] : lg[16 + q]));
            int i1 = 0; float v1 = e4[0];
#pragma unroll
            for (int q = 1; q < 4; ++q) if (e4[q] > v1) { v1 = e4[q]; i1 = q; }
            int i2 = -1; float v2 = -3.0e38f;
#pragma unroll
            for (int q = 0; q < 4; ++q) if (q != i1 && e4[q] > v2) { v2 = e4[q]; i2 = q; }
            const float ex = __expf(v2 - v1), w1 = __builtin_amdgcn_rcpf(1.f + ex), w2 = ex * w1;
            const int id1 = gs * 4 + i1, id2 = gs * 4 + i2;
            int* te = (int*)(ws + WS_TOKE) + 2 * r; float* tw = (float*)(ws + WS_TOKW) + 2 * r; int* tl = (int*)(ws + WS_TOKL) + 2 * r;
            te[0] = id1; te[1] = id2; tw[0] = w1 * gwt; tw[1] = w2 * gwt;
            tl[0] = (int)__hip_atomic_fetch_add(LCNT + id1, 1u, __ATOMIC_RELAXED, __HIP_MEMORY_SCOPE_WORKGROUP); tl[1] = (int)__hip_atomic_fetch_add(LCNT + id2, 1u, __ATOMIC_RELAXED, __HIP_MEMORY_SCOPE_WORKGROUP);
        }
        __syncthreads();
    }
    __syncthreads();
    if (F.tid < 16) LBASE[F.tid] = __hip_atomic_fetch_add(cnt + 64 * F.tid, F.dry ? 0u : LCNT[F.tid], RLX_AGENT);
    __syncthreads();
    for (int rt = F.vcu; rt < MT / 64; rt += F.G) {
        if (F.tid < 128) { const int r = rt * 64 + (F.tid >> 1), k = F.tid & 1;
            const int e = ((const int*)(ws + WS_TOKE))[2 * r + k]; const int li = ((const int*)(ws + WS_TOKL))[2 * r + k] + (int)LBASE[e];
            ((int*)(ws + WS_TOKL))[2 * r + k] = li; ((int*)(ws + A_PERM2))[e * 16384 + li] = r; ((float*)(ws + A_SRS2))[e * 16384 + li] = ((const float*)(ws + WS_RSTD))[r]; ((float*)(ws + A_SGW2))[e * 16384 + li] = ((const float*)(ws + WS_TOKW))[2 * r + k]; } }
}

__device__ __forceinline__ void moe_prefix(Frame& F, int l) {
    if (F.tid == 0) { unsigned n[16];
#pragma unroll
        for (int e = 0; e < 16; ++e) n[e] = __hip_atomic_load((unsigned*)(F.ctl + CW_CNT + l * 16 * 64) + 64 * e, RLX_AGENT);
        unsigned acc = 0;
#pragma unroll
        for (int e = 0; e < 16; ++e) { F.MISC[16 + e] = acc; F.MISC[40 + e] = n[e]; acc += (n[e] + 255u) >> 8; }
        F.MISC[32] = acc; }
    __syncthreads();
}

__device__ __forceinline__ void ph_combine(Frame& F, const Args& a, int l) {
    unsigned char* ws = F.ws; const int lane = F.lane;
    const int gw = F.vcu * NWAVES + F.wave, NGW = F.G * NWAVES;
    moe_prefix(F, l);
    const int* tlr = (const int*)(ws + WS_TOKL); const int* te = (const int*)(ws + WS_TOKE); const bf16_t* Y = (const bf16_t*)(ws + A_Y);
    auto slot_of = [&](int p) { return (int)F.MISC[16 + te[p]] * 256 + tlr[p]; };
    auto clampr = [&](int r) { return r < MT ? r : MT - 1; };
    int r = gw; if (r >= MT) return;
    int s0 = slot_of(2 * r), s1 = slot_of(2 * r + 1);
    int rn = clampr(r + NGW); int sn0 = slot_of(2 * rn), sn1 = slot_of(2 * rn + 1);
    const bf16_t* XBp = (const bf16_t*)(ws + WS_XB);
    u32x2 xv[4]; u32x2 ya[4], yb[4];
#pragma unroll
    for (int j = 0; j < 4; ++j) { xv[j] = ((const GAS u32x2*)(XBp + (size_t)r * DM) + lane)[64 * j]; ya[j] = ((const GAS u32x2*)(Y + (size_t)s0 * DM) + lane)[64 * j]; yb[j] = ((const GAS u32x2*)(Y + (size_t)s1 * DM) + lane)[64 * j]; }
    for (; r < MT; r += NGW) {
        const int rnn = clampr(r + 2 * NGW); const int snn0 = slot_of(2 * rnn), snn1 = slot_of(2 * rnn + 1);
        u32x2 xn[4]; u32x2 yan[4], ybn[4];
#pragma unroll
        for (int j = 0; j < 4; ++j) { xn[j] = ((const GAS u32x2*)(XBp + (size_t)rn * DM) + lane)[64 * j]; yan[j] = ((const GAS u32x2*)(Y + (size_t)sn0 * DM) + lane)[64 * j]; ybn[j] = ((const GAS u32x2*)(Y + (size_t)sn1 * DM) + lane)[64 * j]; }
        GAS f32x4* xr = (GAS f32x4*)(F.out + (size_t)r * DM) + lane;
        f32x4 v[4]; float s = 0.f;
#pragma unroll
        for (int j = 0; j < 4; ++j) { const u32x2 p0 = ya[j], p1 = yb[j]; f32x4 x = {bflo(xv[j].x), bfhi(xv[j].x), bflo(xv[j].y), bfhi(xv[j].y)};
            const float dm = F.dry ? 0.f : 1.f; x.x += dm * (bflo(p0.x) + bflo(p1.x)); x.y += dm * (bfhi(p0.x) + bfhi(p1.x)); x.z += dm * (bflo(p0.y) + bflo(p1.y)); x.w += dm * (bfhi(p0.y) + bfhi(p1.y));
            v[j] = x; s += (x.x * x.x + x.y * x.y) + (x.z * x.z + x.w * x.w); }
        const float rstd = __builtin_amdgcn_rsqf(wave_sum(s) * (1.f / DM) + EPS);
        if (l == DEPTH - 1) { const GAS f32x4* g = (const GAS f32x4*)IN_F(19) + lane;
#pragma unroll
            for (int j = 0; j < 4; ++j) xr[64 * j] = v[j] * rstd * g[64 * j];
        } else {
            GAS u32x2* o8 = (GAS u32x2*)((bf16_t*)(ws + WS_XB) + (size_t)r * DM) + lane;
#pragma unroll
            for (int j = 0; j < 4; ++j) { xr[64 * j] = v[j]; u32x2 w; w.x = cvt_pk_bf16(v[j].x, v[j].y); w.y = cvt_pk_bf16(v[j].z, v[j].w); o8[64 * j] = w; }
            if (lane == 0) ((float*)(ws + WS_RSTD))[r] = rstd;
        }
#pragma unroll
        for (int j = 0; j < 4; ++j) { xv[j] = xn[j]; ya[j] = yan[j]; yb[j] = ybn[j]; }
        rn = rnn; sn0 = snn0; sn1 = snn1;
    }
}

constexpr int NPHASE = 1 + 11 * DEPTH + (PROBE_P >= 0 ? PROBE_N - 1 : 0);
__global__ void __launch_bounds__(NTHR, 2) fwd(Args a) {
    extern __shared__ __attribute__((aligned(16))) unsigned char lds_raw[];
    Frame F;
    F.lds = (LAS unsigned char*)lds_raw; F.MISC = (volatile LAS unsigned*)(F.lds + MISC_OFF);
    F.tid = threadIdx.x; F.lane = F.tid & 63; F.wave = __builtin_amdgcn_readfirstlane(F.tid >> 6);
    F.G = gridDim.x; { const int bx = blockIdx.x; F.vcu = (F.G % 8 == 0) ? (bx % 8) * (F.G / 8) + bx / 8 : bx; }
    F.ws = a.ws; F.ctl = (gu32*)(a.ws + WS_CTL); F.out = a.out; F.z = 0;
    for (int u = F.tid; u < (LDS_BYTES - LDSCTL_OFF) / 4; u += NTHR) ((LAS unsigned*)(F.lds + LDSCTL_OFF))[u] = 0u;
    __syncthreads();
    XcdBarrier bar; bar.bar = (unsigned*)(F.ctl + CW_BAR); bar.x = 0; bar.st = nullptr;
    const bool one_launch = (a.ph_hi - a.ph_lo) > 1;
    if (one_launch) bar = xcd_barrier_post((unsigned*)(F.ctl + CW_BAR), F.MISC + 8);
    for (int pp = a.ph_lo; pp < a.ph_hi; ++pp) {
        int ph = pp;
        F.dry = 0;
        if (PROBE_P >= 0) { constexpr int P = PROBE_P; if (pp > P) ph = (pp - (PROBE_N - 1) > P) ? pp - (PROBE_N - 1) : P; if (ph == P && pp < P + PROBE_N - 1) F.dry = 1; }
        { int t_ = threadIdx.x; asm volatile("" : "+v"(t_)); F.tid = t_; F.lane = t_ & 63; F.wave = __builtin_amdgcn_readfirstlane(t_ >> 6); }
        size_t z_ = 0; asm volatile("" : "+s"(z_)); F.z = z_; F.ws = a.ws + z_; F.out = (float*)((char*)a.out + z_); F.ctl = (gu32*)(a.ws + z_ + WS_CTL);
        unsigned char* ws = F.ws; int bx = (int)blockIdx.x; asm volatile("" : "+s"(bx));
        if (ph == 0) { if (PHSEL(0)) ph_init(F, a); }
        else {
            const int l = (ph - 1) / 11, qq = (ph - 1) % 11, q = qq < 5 ? qq : (qq < 8 ? qq + 1 : qq + 2);
            if (q == 0 && PHSEL(3)) {
                pg8::SchedDense S{64, 14, 896, F.G, bx, (const char*)(ws + WS_XB), (const char*)(ws + WS_WIN) + (size_t)l * NIN * DM * 2, (size_t)256 * DM * 2, (size_t)256 * DM * 2, 64, 0};
                EpiProj E{(bf16_t*)(ws + A_HG), (bf16_t*)(ws + A_QR), (bf16_t*)(ws + A_KF1), (bf16_t*)(ws + A_V), (const float*)(ws + WS_RSTD), (const f32x2*)(ws + WS_CS), (unsigned*)(F.ctl + CW_KMAX + l * 16)};
                pg8::gemm_phase<EpiProj, pg8::SchedDense, true, true, DM, DM>(F.lds, F.tid, S, E);
                if (l == 0) {
                    const bool part = (F.G == 256);
                    { size_t z2 = 0; asm volatile("" : "+s"(z2)); ws = F.ws + z2; F.ws = ws; int t2 = F.tid; asm volatile("" : "+v"(t2)); F.tid = t2; F.lane = t2 & 63; }
                    if (!part || (bx >= 128 && bx < 160)) { SchedKV SK{part ? 32 : F.G, part ? bx - 128 : bx, (const char*)(ws + WS_MEMN), (const char*)(ws + WS_WKVT)};
                        EpiKV EK{(bf16_t*)(ws + WS_KV), (bf16_t*)(ws + WS_KV) + (size_t)DEPTH * MEMROWS * DM};
                        pg8::gemm_phase<EpiKV, SchedKV, true, true, DM, DM>(F.lds, F.tid, SK, EK); }
                    if (!part || bx >= 160) conv_small_l1(F, a, part ? (bx - 160) * NWAVES + F.wave : F.vcu * NWAVES + F.wave, part ? 96 * NWAVES : F.G * NWAVES);
                }
            } else if (q == 1 && PHSEL(4)) {
                for (int rep = 0; rep < PROBE_PREP_N; ++rep) for (int u = F.vcu; u < (MT / 512) * ATH; u += F.G) vf_unit(F, u);
                for (int rep = 0; rep < PROBE_HGA_N; ++rep) { constexpr int NU = BATCH * HGH * NCHUNK; HgIn R = hg_load<false>(F, F.vcu < NU ? F.vcu : NU - 1);
                    for (int u = F.vcu; u < NU; u += F.G) { const HgIn Rn = hg_load<false>(F, u + F.G < NU ? u + F.G : NU - 1); hg_a2_unit(F, a, l, u, R); R = Rn; } }
                if (l == 0) {
                    { size_t z2 = 0; asm volatile("" : "+s"(z2)); ws = F.ws + z2; F.ws = ws; int t2 = F.tid; asm volatile("" : "+v"(t2)); F.tid = t2; F.lane = t2 & 63; }
                    SchedFold SF{F.G, bx, (const char*)(ws + WS_KV), (const char*)(ws + WS_KV) + (size_t)DEPTH * MEMROWS * DM * 2, (const char*)(ws + WS_WQS), (const char*)(ws + WS_WOT)};
                    EpiBf16 EF{(bf16_t*)(ws + WS_WQK), DM, (size_t)DM * DM, 1.f};
                    pg8::gemm_phase<EpiBf16, SchedFold, true, true, DM, 256>(F.lds, F.tid, SF, EF); }
            } else if (q == 2 && PHSEL(5)) hg_scan(F);
            else if (q == 3 && PHSEL(6)) {
                for (int rep = 0; rep < PROBE_HGC_N; ++rep) { constexpr int NU = BATCH * HGH * NCHUNK; HgIn R = hg_load<true>(F, F.vcu < NU ? F.vcu : NU - 1);
                    for (int u = F.vcu; u < NU; u += F.G) { const HgIn Rn = hg_load<true>(F, u + F.G < NU ? u + F.G : NU - 1); if (rep + 1 < PROBE_HGC_N) hg_c2_unit<PROBE_HGC_STOP>(F, a, l, u, R); else hg_c2_unit<0>(F, a, l, u, R); R = Rn; } }
#if ATT_GOLDEN
                for (int t = F.vcu * NWAVES + F.wave; t < (MT / 64) * ATH; t += F.G * NWAVES) att_task(F, t);
#else
                for (int rep = 0; rep < PROBE_ATT_N; ++rep) for (int u = F.vcu; u < (MT / 512) * ATH; u += F.G) att_unit(F, l, u);
#endif
            } else if (q == 4 && PHSEL(7)) {
                pg8::SchedDense S{64, 4, 256, F.G, bx, (const char*)(ws + WS_XB), (const char*)(ws + WS_WOUT) + (size_t)l * DM * DM * 2, (size_t)256 * DM * 2, (size_t)256 * DM * 2, 64, 0};
                EpiResNorm E{l == 0 ? IN_F(0) : (const float*)F.out, (bf16_t*)(ws + A_XB2), (float*)(ws + WS_SSQP)};
                pg8::gemm_phase<EpiResNorm, pg8::SchedDense, true, true, DM, DM>(F.lds, F.tid, S, E);
            } else if (q == 5 && PHSEL(8)) ph_norm(F, a);
            else if (q == 6 && PHSEL(9)) {
                pg8::SchedDense S{64, 4, 256, F.G, bx, (const char*)(ws + A_XB2), (const char*)(ws + WS_WQK) + (size_t)l * 2 * DM * DM * 2, (size_t)256 * DM * 2, (size_t)256 * DM * 2, 32, (size_t)DM * DM * 2};
                EpiSoftmax E{(bf16_t*)(ws + A_P), (const float*)(ws + WS_SSQP)};
                pg8::gemm_phase<EpiSoftmax, pg8::SchedDense, true, true, DM, DM>(F.lds, F.tid, S, E);
            } else if (q == 7 && PHSEL(10)) {
                pg8::SchedDense S{64, 4, 256, F.G, bx, (const char*)(ws + A_P), (const char*)(ws + WS_WVO) + (size_t)l * 2 * DM * DM * 2, (size_t)256 * DM * 2, (size_t)256 * DM * 2, 32, (size_t)DM * DM * 2};
                EpiResAddB E{(const bf16_t*)(ws + A_XB2), (bf16_t*)(ws + WS_XB)};
                pg8::gemm_phase<EpiResAddB, pg8::SchedDense, true, true, DM, DM>(F.lds, F.tid, S, E);
            } else if (q == 8 && PHSEL(11)) ph_router(F, a, l);
            else if (q == 10 && PHSEL(13)) {
                moe_prefix(F, l);
                const int total = __builtin_amdgcn_readfirstlane((int)F.MISC[32]) * 4, early = (total / F.G) * F.G;
                SchedMoe S{F.G, bx, DM, F.MISC + 16, (const char*)(ws + WS_XB), (const char*)(ws + A_WGU), (const int*)(ws + A_PERM2), (const unsigned*)(F.ctl + CW_CNT + l * 16 * 64), true, 1, early, total - early, nullptr};
                EpiMoe1 E{(bf16_t*)(ws + A_ACTB), (const float*)(ws + A_SRS2), (const float*)(ws + A_SGW2)};
                pg8::gemm_phase<EpiMoe1, SchedMoe, true, true, DM, DM, true>(F.lds, F.tid, S, E);
            } else if (q == 11 && PHSEL(14)) {
                moe_prefix(F, l);
                const int total = __builtin_amdgcn_readfirstlane((int)F.MISC[32]) * 4, early = (total / F.G) * F.G, rem = total - early;
                unsigned* done = (unsigned*)(F.ctl + CW_DONE + l * 256);
                if (bx < rem) {
                    SchedMoe S{F.G, bx, DM, F.MISC + 16, (const char*)(ws + WS_XB), (const char*)(ws + A_WGU), (const int*)(ws + A_PERM2), (const unsigned*)(F.ctl + CW_CNT + l * 16 * 64), true, 2, early, rem, nullptr};
                    EpiMoe1 E{(bf16_t*)(ws + A_ACTB), (const float*)(ws + A_SRS2), (const float*)(ws + A_SGW2)};
                    pg8::gemm_phase<EpiMoe1, SchedMoe, true, true, DM, DM, true>(F.lds, F.tid, S, E);
                    if (F.tid == 0) { __builtin_amdgcn_fence(__ATOMIC_RELEASE, "agent"); asm volatile("s_waitcnt vmcnt(0)" ::: "memory"); __hip_atomic_fetch_add(done + ((early + bx) >> 2), 1u, __ATOMIC_RELAXED, __HIP_MEMORY_SCOPE_AGENT); }
                }
                { size_t z2 = 0; asm volatile("" : "+s"(z2)); ws = F.ws + z2; F.ws = ws; int t2 = F.tid; asm volatile("" : "+v"(t2)); F.tid = t2; F.lane = t2 & 63; }
                SchedMoe S{F.G, bx, EFF, F.MISC + 16, (const char*)(ws + A_ACTB), (const char*)(ws + A_WD), nullptr, nullptr, false, 3, early, rem, done};
                EpiBf16 E{(bf16_t*)(ws + A_Y), DM, 0, 1.f};
                pg8::gemm_phase<EpiBf16, SchedMoe, true, true, EFF, EFF>(F.lds, F.tid, S, E);
            } else if (q == 12 && PHSEL(15)) ph_combine(F, a, l);
        }
        if (pp + 1 < a.ph_hi) xcd_barrier(bar);
    }
}

extern "C" void kernel_launch(void* const* d_in, const int* in_sizes, int n_in, void* d_out, int out_size, void* d_ws, size_t ws_size, hipStream_t stream) {
    static int grid = 0;
    if (grid == 0) {
        if (n_in != 20 || in_sizes[0] != MT * DM || out_size != MT * DM || ws_size < WS_END) { fprintf(stderr, "kernel_launch: unexpected shapes / workspace (%d inputs, ws %zu)\n", n_in, ws_size); grid = -1; return; }
        int dev = 0, cus = 0, per_cu = 0;
        if (hipGetDevice(&dev) != hipSuccess || hipDeviceGetAttribute(&cus, hipDeviceAttributeMultiprocessorCount, dev) != hipSuccess) { grid = -1; return; }
        if (hipFuncSetAttribute((const void*)fwd, hipFuncAttributeMaxDynamicSharedMemorySize, LDS_BYTES) != hipSuccess) { grid = -1; return; }
        if (hipOccupancyMaxActiveBlocksPerMultiprocessor(&per_cu, (const void*)fwd, NTHR, LDS_BYTES) != hipSuccess || per_cu < 1) { fprintf(stderr, "kernel_launch: occupancy query says %d\n", per_cu); per_cu = 1; }
        (void)hipGetLastError();
        grid = cus * 1;
    }
    if (grid < 0) return;
    (void)hipMemsetAsync((char*)d_ws + WS_CTL, 0, CTL_ZERO_BYTES, stream);
    Args a{};
    for (int i = 0; i < 20; ++i) a.in[i] = d_in[i];
    a.out = (float*)d_out; a.ws = (unsigned char*)d_ws;
#if MK_PER_PHASE
    for (int ph = 0; ph < NPHASE; ++ph) { a.ph_lo = ph; a.ph_hi = ph + 1; hipLaunchKernelGGL(fwd, dim3(grid), dim3(NTHR), LDS_BYTES, stream, a); }
#else
    a.ph_lo = 0; a.ph_hi = NPHASE;
    void* kargs[] = {&a};
    hipError_t e = hipLaunchCooperativeKernel((const void*)fwd, dim3(grid), dim3(NTHR), kargs, LDS_BYTES, stream);
    if (e != hipSuccess) fprintf(stderr, "cooperative launch failed: %s (grid %d)\n", hipGetErrorString(e), grid);
#endif
}
```

```cpp
#include <hip/hip_runtime.h>
#include <cstdio>
#include <cstdint>

#ifndef PH_MASK
#define PH_MASK 0xFFFFFFFFu
#endif
#define PHSEL(n) ((PH_MASK >> (n)) & 1u)
#ifndef PROBE_ATT_N
#define PROBE_ATT_N 1
#endif
#ifndef PROBE_HGC_N
#define PROBE_HGC_N 1
#endif
#ifndef PROBE_HGA_N
#define PROBE_HGA_N 1
#endif
#ifndef PROBE_PREP_N
#define PROBE_PREP_N 1
#endif
#ifndef PROBE_HGC_STOP
#define PROBE_HGC_STOP 0
#endif
#ifndef PROBE_P
#define PROBE_P -1
#endif
#ifndef PROBE_N
#define PROBE_N 1
#endif
#ifndef HG_A_GOLDEN
#define HG_A_GOLDEN 0
#endif
#ifndef HG_C_GOLDEN
#define HG_C_GOLDEN 0
#endif
#ifndef ATT_GOLDEN
#define ATT_GOLDEN 0
#endif
#ifndef MK_PER_PHASE
#define MK_PER_PHASE 0
#endif

#define LAS __attribute__((address_space(3)))
#define GAS __attribute__((address_space(1)))
typedef unsigned short bf16_t;
typedef short bf16x8 __attribute__((ext_vector_type(8)));
typedef float f32x4 __attribute__((ext_vector_type(4)));
typedef float f32x2 __attribute__((ext_vector_type(2)));
typedef unsigned u32x4 __attribute__((ext_vector_type(4)));
typedef unsigned u32x2 __attribute__((ext_vector_type(2)));
typedef GAS unsigned gu32;

constexpr int BATCH = 2, SEQ = 8192, DM = 1024, MT = BATCH * SEQ, DEPTH = 2;
constexpr int MEM_LEN = 256, MEMROWS = BATCH * MEM_LEN;
constexpr int NIN = 3584, HGW = 512, HGH = 4, HGD = 128, CHUNK = 64, NCHUNK = SEQ / CHUNK;
constexpr int ATW = 512, ATH = 8, ATD = 64;
constexpr int NEXP = 16, EFF = 512;
constexpr float EPS = 1e-6f;
constexpr int NWAVES = 8, NTHR = 512;

constexpr size_t MiB = 1u << 20;
constexpr size_t WS_CTL = 0, CTL_ZERO_BYTES = 1 * MiB;
constexpr size_t WS_RSTD = 1 * MiB;
constexpr size_t WS_TOKE = WS_RSTD + 64 * 1024;
constexpr size_t WS_TOKW = WS_TOKE + 128 * 1024;
constexpr size_t WS_TOKL = WS_TOKW + 128 * 1024;
constexpr size_t WS_SLOTRS = WS_TOKL + 128 * 1024;
constexpr size_t WS_SLOTGW = WS_SLOTRS + 160 * 1024;
constexpr size_t WS_PERM = WS_SLOTGW + 160 * 1024;
constexpr size_t WS_WR = 3 * MiB;
constexpr size_t WS_LBT = 3 * MiB + 256 * 1024;
constexpr size_t WS_SSQP = 3 * MiB + 512 * 1024;
constexpr size_t WS_XB = 4 * MiB;
constexpr size_t WS_WIN = 36 * MiB;
constexpr size_t WS_WOUT = 50 * MiB;
constexpr size_t WS_WQS = 54 * MiB;
constexpr size_t WS_WKVT = 58 * MiB;
constexpr size_t WS_WOT = 66 * MiB;
constexpr size_t WS_MEMN = 70 * MiB;
constexpr size_t WS_KV = 72 * MiB;
constexpr size_t WS_WQK = 76 * MiB;
constexpr size_t WS_WVO = 84 * MiB;
constexpr size_t WS_ACT = 92 * MiB;
constexpr size_t WS_CS = 320 * MiB;
constexpr size_t WS_END = 324 * MiB;
constexpr size_t A_HG = WS_ACT + 0 * MiB;
constexpr size_t A_KF1 = WS_ACT + 64 * MiB;
constexpr size_t A_KF4 = WS_ACT + 80 * MiB;
constexpr size_t A_KF16 = WS_ACT + 96 * MiB;
constexpr size_t A_QR = WS_ACT + 112 * MiB;
constexpr size_t A_V = WS_ACT + 128 * MiB;
constexpr size_t A_VT1 = WS_ACT + 144 * MiB;
constexpr size_t A_VT4 = WS_ACT + 160 * MiB;
constexpr size_t A_VT16 = WS_ACT + 176 * MiB;
constexpr size_t A_STATE = WS_ACT + 192 * MiB;
constexpr size_t A_DECAY = WS_ACT + 224 * MiB;
constexpr size_t A_XB2 = WS_ACT + 0 * MiB;
constexpr size_t A_P = WS_ACT + 32 * MiB;
constexpr size_t A_WGU = WS_ACT + 0 * MiB;
constexpr size_t A_WD = WS_ACT + 32 * MiB;
constexpr size_t A_PERM2 = WS_ACT + 48 * MiB;
constexpr size_t A_SRS2 = WS_ACT + 49 * MiB;
constexpr size_t A_SGW2 = WS_ACT + 50 * MiB;
constexpr size_t A_ACTB = WS_ACT + 120 * MiB;
constexpr size_t A_Y = WS_ACT + 156 * MiB;
constexpr int MAXSLOT = 2 * MT + NEXP * 256;
static_assert(A_Y + (size_t)MAXSLOT * 1024 * 2 <= WS_END, "ws map");
constexpr int CW_BAR = 4096;
constexpr int CW_KMAX = 12288;
constexpr int CW_DONE = 24576;
constexpr int CW_CNT = 16384;
constexpr int RING_BYTES = 131072;
constexpr int SPARE_OFF = RING_BYTES;
constexpr int LDSCTL_OFF = RING_BYTES + 8192, MISC_OFF = LDSCTL_OFF + 64;
constexpr int LDS_BYTES = 147456;

#define RLX_AGENT __ATOMIC_RELAXED, __HIP_MEMORY_SCOPE_AGENT
#define LDS_WAIT() asm volatile("s_waitcnt lgkmcnt(0)" ::: "memory")
#define VM_WAIT() asm volatile("s_waitcnt vmcnt(0)" ::: "memory")

__device__ __forceinline__ unsigned f2bf(float f) { unsigned u = __builtin_bit_cast(unsigned, f); return (u + 0x7fffu + ((u >> 16) & 1u)) >> 16; }
__device__ __forceinline__ unsigned pk2(float lo, float hi) { return f2bf(lo) | (f2bf(hi) << 16); }
__device__ __forceinline__ float bf2f(unsigned short h) { return __builtin_bit_cast(float, (unsigned)h << 16); }
__device__ __forceinline__ float bflo(unsigned w) { return __builtin_bit_cast(float, w << 16); }
__device__ __forceinline__ float bfhi(unsigned w) { return __builtin_bit_cast(float, w & 0xffff0000u); }
typedef __bf16 bf16x2_t __attribute__((ext_vector_type(2)));
__device__ __forceinline__ unsigned cvt_pk_bf16(float lo, float hi) { f32x2 v = {lo, hi}; bf16x2_t b = __builtin_convertvector(v, bf16x2_t); return __builtin_bit_cast(unsigned, b); }
__device__ __forceinline__ float wave_sum(float v) {
#pragma unroll
    for (int o = 1; o < 64; o <<= 1) v += __shfl_xor(v, o);
    return v;
}
__device__ __forceinline__ float sigmoidf_(float z) { return __builtin_amdgcn_rcpf(1.f + __builtin_amdgcn_exp2f(-1.4426950408889634f * z)); }
__device__ __forceinline__ float ex2(float x) { return __builtin_amdgcn_exp2f(x); }
constexpr float LOG2E = 1.4426950408889634f;

#define XB_TMO      128
#define XB_XCNT(j)  (256  + 64 * (j))
#define XB_XSUB(j)  (1280 + 64 * (j))
#define XB_XGEN(j)  (2304 + 64 * (j))
#define XB_TOP      3328
#define XB_TOPGEN   3392
#define XCD_BAR_WORDS 3456
#define XB_SPIN_CAP (1u << 18)
__device__ __forceinline__ unsigned xb_ld(unsigned* p)              { return __hip_atomic_load(p, __ATOMIC_RELAXED, __HIP_MEMORY_SCOPE_AGENT); }
__device__ __forceinline__ unsigned xb_add(unsigned* p, unsigned v) { return __hip_atomic_fetch_add(p, v, __ATOMIC_RELAXED, __HIP_MEMORY_SCOPE_AGENT); }
__device__ __forceinline__ unsigned xb_xcc_id() { return (unsigned)__builtin_amdgcn_s_getreg((3 << 11) | 20) & 0xFu; }
#define XB_SPIN(cond, bar) do { unsigned _sp = 0; while (cond) { __builtin_amdgcn_s_sleep(1); \
    if ((++_sp & 255u) == 0u) { if (xb_ld(&(bar)[XB_TMO])) break; if (_sp > XB_SPIN_CAP) { atomicAdd(&(bar)[XB_TMO], 1u); break; } } } } while (0)
struct XcdBarrier { unsigned* bar; unsigned x; volatile LAS unsigned* st; };
__device__ __forceinline__ XcdBarrier xcd_barrier_post(unsigned* bar, volatile LAS unsigned* st) {
    XcdBarrier b; b.bar = bar; b.x = xb_xcc_id(); b.st = st;
    if (threadIdx.x == 0) (void)xb_add(&bar[XB_XCNT(b.x)], 1u);
    return b;
}
__device__ __forceinline__ void xcd_barrier_complete(unsigned* bar, unsigned x, unsigned& nloc, unsigned& nx) {
    const unsigned G = gridDim.x * gridDim.y * gridDim.z;
    unsigned sum, cnt, mine, sp = 0u;
    for (;;) {
        sum = 0u; cnt = 0u; mine = 0u;
        unsigned cv[16];
#pragma unroll
        for (unsigned j = 0; j < 16; ++j) cv[j] = xb_ld(&bar[XB_XCNT(j)]);
#pragma unroll
        for (unsigned j = 0; j < 16; ++j) { const unsigned c = cv[j]; sum += c; cnt += (c > 0u) ? 1u : 0u; mine = (j == x) ? c : mine; }
        if (sum == G) break;
        __builtin_amdgcn_s_sleep(1);
        if ((++sp & 255u) == 0u) { if (xb_ld(&bar[XB_TMO])) break; if (sp > XB_SPIN_CAP) { atomicAdd(&bar[XB_TMO], 1u); break; } }
    }
    nloc = mine > 0u ? mine : 1u; nx = cnt > 0u ? cnt : 1u;
}
__device__ __forceinline__ void xcd_barrier(const XcdBarrier& b) {
    asm volatile("s_waitcnt vmcnt(0)" ::: "memory");
    __syncthreads();
    if (threadIdx.x == 0) {
        unsigned* bar = b.bar;
        __builtin_amdgcn_s_waitcnt(0);
        unsigned nloc = b.st[0], nx = b.st[1];
        if (nloc == 0u) { xcd_barrier_complete(bar, b.x, nloc, nx); b.st[0] = nloc; b.st[1] = nx; }
        const unsigned old = xb_add(&bar[XB_XSUB(b.x)], 1u);
        const unsigned gen = old / nloc;
        if (old + 1u == (gen + 1u) * nloc) {
            __builtin_amdgcn_fence(__ATOMIC_RELEASE, "agent");
            asm volatile("s_waitcnt vmcnt(0)" ::: "memory");
            const unsigned og = xb_add(&bar[XB_TOP], 1u);
            const unsigned tg = og / nx;
            if (og + 1u == (tg + 1u) * nx) xb_add(&bar[XB_TOPGEN], 1u);
            else XB_SPIN(xb_ld(&bar[XB_TOPGEN]) == tg, bar);
            __builtin_amdgcn_fence(__ATOMIC_ACQUIRE, "agent");
            xb_add(&bar[XB_XGEN(b.x)], 1u);
            asm volatile("s_waitcnt vmcnt(0)" ::: "memory");
        } else {
            XB_SPIN(xb_ld(&bar[XB_XGEN(b.x)]) == gen, bar);
            __builtin_amdgcn_fence(__ATOMIC_ACQUIRE, "agent");
            asm volatile("s_waitcnt vmcnt(0)" ::: "memory");
        }
    }
    __syncthreads();
}

namespace pg8 {
constexpr int BM = 256, BK = 64, HALF = 128, HTB = HALF * BK * 2, STAGE_BYTES = 8 * HTB, NXCD = 8, WGM = 8;
__host__ __device__ __forceinline__ int lds_byte(int r, int c) { const int st = (r >> 4) * 2 + (c >> 5), rr = r & 15, cc = c & 31, ob = rr * 64 + cc * 2; return st * 1024 + (ob ^ (((ob >> 9) & 1) << 5)); }
__host__ __device__ __forceinline__ void stage_rc(int b, int& R, int& C) { const int st = b / 1024, sb = b % 1024, swz = sb ^ (((sb >> 9) & 1) << 5); R = (st >> 1) * 16 + swz / 64; C = (st & 1) * 32 + (swz % 64) / 2; }
__host__ __device__ __forceinline__ int perm32(int rho) { const int n = rho >> 4, i = rho & 15; return 8 * (i >> 2) + 4 * n + (i & 3); }

struct Unit { int pm, pn, aux, lr; const char* a; const char* b; };
typedef f32x4 Acc[2][2][4][2];

template <class Epi, class Sched, bool ALIGN_EPI, bool SP2, int LD, int K, bool GATHER = false>
__device__ __forceinline__ void gemm_phase(LAS unsigned char* lds, const int tid, const Sched& S, const Epi& E) {
    constexpr int lda = LD, ldb = LD;
    const int wid = __builtin_amdgcn_readfirstlane(tid >> 6), lane = tid & 63, wr = wid >> 2, wc = wid & 3, fr = lane & 15, fq = lane >> 4;
    constexpr int nt = K / BK;
    unsigned voffA[2], voffB[2];
#pragma unroll
    for (int i = 0; i < 2; ++i) { int R, C; stage_rc(tid * 16 + i * 8192, R, C); const int Rb = Epi::PERM ? ((R & ~31) + perm32(R & 31)) : R;
        voffA[i] = (unsigned)(R * lda + C) * 2u; voffB[i] = (unsigned)(Rb * ldb + C) * 2u; }
    const size_t kstep = (size_t)(BK * 2);
    const size_t hstepA = (size_t)HALF * lda * 2, hstepB = (size_t)HALF * ldb * 2;
    const unsigned ldsw = (unsigned)wid * 1024u;
    const int aoff = lds_byte(wr * 64 + fr, fq * 8), boff = lds_byte(wc * 32 + fr, fq * 8);
#define PG8_SA(b, h) (((b) * 2 + (h)) * HTB)
#define PG8_SB(b, h) ((4 + (b) * 2 + (h)) * HTB)
#define PG8_STAGE(bufoff, gbase, voff) do { _Pragma("unroll") for (int _i = 0; _i < 2; ++_i) \
        __builtin_amdgcn_global_load_lds((const unsigned*)((const char*)(gbase) + (voff)[_i]), (LAS unsigned*)(lds + (bufoff) + ldsw + _i * 8192), 16, 0, 0); } while (0)
#define PG8_STAGE_A(bufoff, gbase, half, usenext) do { if constexpr (GATHER) { const unsigned _p = (usenext) ? vn[half] : vc[half]; unsigned _v[2]; _v[0] = (_p & 0xffffu) * (unsigned)(lda * 2) + gc2; _v[1] = (_p >> 16) * (unsigned)(lda * 2) + gc2; PG8_STAGE(bufoff, gbase, _v); } \
        else { PG8_STAGE(bufoff, (gbase) + (half) * hstepA, voffA); } } while (0)
#define PG8_LDA(dst, b, h) do { _Pragma("unroll") for (int m = 0; m < 4; ++m) _Pragma("unroll") for (int k = 0; k < 2; ++k) dst[m][k] = *(const LAS bf16x8*)(lds + PG8_SA(b, h) + aoff + m * 2048 + k * 1024); } while (0)
#define PG8_LDB(dst, b, h) do { _Pragma("unroll") for (int n = 0; n < 2; ++n) _Pragma("unroll") for (int k = 0; k < 2; ++k) dst[n][k] = *(const LAS bf16x8*)(lds + PG8_SB(b, h) + boff + n * 2048 + k * 1024); } while (0)
#define PG8_MMA(ai, bj, At, Bt) do { __builtin_amdgcn_s_setprio(1); _Pragma("unroll") for (int m = 0; m < 4; ++m) _Pragma("unroll") for (int n = 0; n < 2; ++n) _Pragma("unroll") for (int k = 0; k < 2; ++k) \
        acc[ai][bj][m][n] = __builtin_amdgcn_mfma_f32_16x16x32_bf16(Bt[n][k], At[m][k], acc[ai][bj][m][n], 0, 0, 0); __builtin_amdgcn_s_setprio(0); } while (0)
#define PG8_WAIT_V(n) asm volatile("s_waitcnt vmcnt(" #n ")" ::: "memory")
#define PG8_WAIT_L(n) asm volatile("s_waitcnt lgkmcnt(" #n ")" ::: "memory")
#define PG8_BAR __builtin_amdgcn_s_barrier()
#define PG8_SCHED __builtin_amdgcn_sched_barrier(0)
    Unit cur, nxt; int ui = 0;
    if (!S.next(0, cur)) return;
    Acc acc;
#pragma unroll
    for (int a = 0; a < 2; ++a)
#pragma unroll
        for (int b = 0; b < 2; ++b)
#pragma unroll
            for (int m = 0; m < 4; ++m)
#pragma unroll
                for (int n = 0; n < 2; ++n) acc[a][b][m][n] = (f32x4){0.f, 0.f, 0.f, 0.f};
    bf16x8 At[4][2], B0[2][2], B1[2][2];
    const char* cA = cur.a; const char* cB = cur.b;
    unsigned vc[2], vn[2], gc2 = 0;
    if constexpr (GATHER) { int R0, C0; stage_rc(tid * 16, R0, C0); gc2 = (unsigned)C0 * 2u;
#pragma unroll
        for (int h = 0; h < 2; ++h) { vc[h] = (unsigned)S.src_row(cur, 128 * h + R0) | ((unsigned)S.src_row(cur, 128 * h + R0 + 64) << 16); vn[h] = vc[h]; }
    }
    static_assert(SP2, "only the two-MFMA-blocks-per-barrier-pair loop is kept");
    {
        PG8_STAGE(PG8_SB(0, 0), cB, voffB); PG8_STAGE(PG8_SB(0, 1), cB + hstepB, voffB); PG8_STAGE_A(PG8_SA(0, 0), cA, 0, false); PG8_STAGE_A(PG8_SA(0, 1), cA, 1, false);
        if (wr == 1) PG8_BAR;
        PG8_WAIT_V(2); PG8_BAR;
        PG8_STAGE(PG8_SB(1, 0), cB + kstep, voffB); PG8_STAGE_A(PG8_SA(1, 0), cA + kstep, 0, false); PG8_STAGE(PG8_SB(1, 1), cB + hstepB + kstep, voffB);
        PG8_WAIT_V(6); PG8_BAR;
    }
    for (;;) {
        const bool has_next = S.next(ui + 1, nxt);
        const char* nA = has_next ? nxt.a : cA; const char* nB = has_next ? nxt.b : cB;
        if constexpr (GATHER) { if (has_next) { int R0, C0; stage_rc(tid * 16, R0, C0);
#pragma unroll
            for (int h = 0; h < 2; ++h) vn[h] = (unsigned)S.src_row(nxt, 128 * h + R0) | ((unsigned)S.src_row(nxt, 128 * h + R0 + 64) << 16); } }
#pragma nounroll
        for (int t = 0; t < nt; t += 2) {
            const bool last = (t == nt - 2);
            const char* a1 = cA + (size_t)(t + 1) * kstep;
            const char* a2 = last ? nA : cA + (size_t)(t + 2) * kstep; const char* b2 = last ? nB : cB + (size_t)(t + 2) * kstep;
            const char* a3 = a2 + kstep; const char* b3 = b2 + kstep;
            {
            PG8_LDB(B0, 0, 0); PG8_LDB(B1, 0, 1); PG8_SCHED; PG8_LDA(At, 0, 0); PG8_STAGE_A(PG8_SA(1, 1), a1, 1, false);
            PG8_WAIT_V(8); PG8_WAIT_L(0); PG8_BAR; PG8_MMA(0, 0, At, B0); PG8_MMA(0, 1, At, B1); PG8_BAR; PG8_SCHED;
            PG8_LDA(At, 0, 1); PG8_STAGE(PG8_SB(0, 0), b2, voffB); PG8_STAGE(PG8_SB(0, 1), b2 + hstepB, voffB); PG8_STAGE_A(PG8_SA(0, 0), a2, 0, last);
            PG8_WAIT_V(8); PG8_WAIT_L(0); PG8_BAR; PG8_MMA(1, 0, At, B0); PG8_MMA(1, 1, At, B1); PG8_BAR; PG8_SCHED;
            PG8_LDB(B0, 1, 0); PG8_LDB(B1, 1, 1); PG8_SCHED; PG8_LDA(At, 1, 0); PG8_STAGE_A(PG8_SA(0, 1), a2, 1, last);
            PG8_WAIT_V(8); PG8_WAIT_L(0); PG8_BAR; PG8_MMA(0, 0, At, B0); PG8_MMA(0, 1, At, B1); PG8_BAR; PG8_SCHED;
            PG8_LDA(At, 1, 1); PG8_STAGE(PG8_SB(1, 0), b3, voffB); PG8_STAGE(PG8_SB(1, 1), b3 + hstepB, voffB); PG8_STAGE_A(PG8_SA(1, 0), a3, 0, last);
            PG8_WAIT_V(8); PG8_WAIT_L(0); PG8_BAR; PG8_MMA(1, 0, At, B0); PG8_MMA(1, 1, At, B1); PG8_BAR; PG8_SCHED;
            }
        }
        if constexpr (ALIGN_EPI) { if (wr == 0) PG8_BAR; }
        E(acc, cur, wr, wc, fr, fq, lds);
        if (!has_next) break;
#pragma unroll
        for (int a = 0; a < 2; ++a)
#pragma unroll
            for (int b = 0; b < 2; ++b)
#pragma unroll
                for (int m = 0; m < 4; ++m)
#pragma unroll
                    for (int n = 0; n < 2; ++n) acc[a][b][m][n] = (f32x4){0.f, 0.f, 0.f, 0.f};
        cur = nxt; cA = nA; cB = nB; ++ui;
        if constexpr (GATHER) { vc[0] = vn[0]; vc[1] = vn[1]; }
        if constexpr (ALIGN_EPI) { if (wr == 1) PG8_BAR; }
    }
    PG8_WAIT_V(0);
    if constexpr (!ALIGN_EPI) { if (wr == 0) PG8_BAR; }
    PG8_BAR;
#undef PG8_SA
#undef PG8_SB
#undef PG8_STAGE
#undef PG8_STAGE_A
#undef PG8_LDA
#undef PG8_LDB
#undef PG8_MMA
#undef PG8_WAIT_V
#undef PG8_WAIT_L
#undef PG8_BAR
#undef PG8_SCHED
}

struct SchedDense {
    int nM, nN, nwg, G, c; const char* A; const char* B; size_t a_tile, b_tile; int pm_per_batch; size_t b_batch;
    __device__ __forceinline__ bool next(int i, Unit& u) const {
        const long L = (long)i * G + c; if (L >= nwg) return false;
        int wgid = (int)L; { const int q = nwg / NXCD, r = nwg % NXCD, xcd = wgid % NXCD, off = wgid / NXCD; wgid = (xcd < r ? xcd * (q + 1) : r * (q + 1) + (xcd - r) * q) + off; }
        const int nig = WGM * nN, gid = wgid / nig, fm = gid * WGM, gsz = (nM - fm) < WGM ? (nM - fm) : WGM;
        u.pm = fm + ((wgid % nig) % gsz); u.pn = (wgid % nig) / gsz; u.aux = 0;
        u.a = A + (size_t)u.pm * a_tile; u.b = B + (size_t)u.pn * b_tile + (size_t)(u.pm / pm_per_batch) * b_batch; return true;
    }
};
}
using pg8::Unit; using pg8::Acc;

struct EpiBf16 {
    static constexpr bool PERM = true;
    bf16_t* O; int ldc; size_t aux_stride; float scale;
    __device__ __forceinline__ void operator()(const Acc& acc, const Unit& u, int wr, int wc, int fr, int fq, LAS unsigned char*) const {
        bf16_t* base = O + (size_t)u.aux * aux_stride;
        const int row0 = u.pm * 256 + wr * 64 + fr, col0 = u.pn * 256 + wc * 32 + 8 * fq;
#pragma unroll
        for (int ai = 0; ai < 2; ++ai)
#pragma unroll
            for (int m = 0; m < 4; ++m) { bf16_t* rowp = base + (size_t)(row0 + ai * 128 + m * 16) * ldc + col0;
#pragma unroll
                for (int bj = 0; bj < 2; ++bj) { const f32x4 v0 = acc[ai][bj][m][0] * scale, v1 = acc[ai][bj][m][1] * scale;
                    u32x4 w; w.x = cvt_pk_bf16(v0[0], v0[1]); w.y = cvt_pk_bf16(v0[2], v0[3]); w.z = cvt_pk_bf16(v1[0], v1[1]); w.w = cvt_pk_bf16(v1[2], v1[3]);
                    *(u32x4*)(rowp + bj * 128) = w; } }
    }
};
struct EpiKV {
    static constexpr bool PERM = true;
    bf16_t* KB; bf16_t* VB;
    __device__ __forceinline__ void operator()(const Acc& acc, const Unit& u, int wr, int wc, int fr, int fq, LAS unsigned char*) const {
        bf16_t* base = (u.pn < 4 ? KB : VB) + (size_t)u.aux * MEMROWS * DM;
        const int row0 = u.pm * 256 + wr * 64 + fr, col0 = (u.pn & 3) * 256 + wc * 32 + 8 * fq;
#pragma unroll
        for (int ai = 0; ai < 2; ++ai)
#pragma unroll
            for (int m = 0; m < 4; ++m) { bf16_t* rowp = base + (size_t)(row0 + ai * 128 + m * 16) * DM + col0;
#pragma unroll
                for (int bj = 0; bj < 2; ++bj) { const f32x4 v0 = acc[ai][bj][m][0], v1 = acc[ai][bj][m][1];
                    u32x4 w; w.x = cvt_pk_bf16(v0[0], v0[1]); w.y = cvt_pk_bf16(v0[2], v0[3]); w.z = cvt_pk_bf16(v1[0], v1[1]); w.w = cvt_pk_bf16(v1[2], v1[3]);
                    *(u32x4*)(rowp + bj * 128) = w; } }
    }
};
struct EpiProj {
    static constexpr bool PERM = true;
    bf16_t* HG; bf16_t* QR; bf16_t* KF; bf16_t* V; const float* rstd; const f32x2* CS; unsigned* kmax;
    __device__ __forceinline__ void operator()(const Acc& acc, const Unit& u, int wr, int wc, int fr, int fq, LAS unsigned char*) const {
        const int row0 = u.pm * 256 + wr * 64 + fr;
        float rsv[2][4];
#pragma unroll
        for (int ai = 0; ai < 2; ++ai)
#pragma unroll
            for (int m = 0; m < 4; ++m) rsv[ai][m] = rstd[row0 + ai * 128 + m * 16];
        if (u.pn < 8 || u.pn >= 12) {
            bf16_t* base; int ldc, colt;
            if (u.pn < 8) { base = HG; ldc = 2048; colt = u.pn * 256; } else { base = V; ldc = 512; colt = (u.pn - 12) * 256; }
            const int col0 = colt + wc * 32 + 8 * fq;
#pragma unroll
            for (int ai = 0; ai < 2; ++ai)
#pragma unroll
                for (int m = 0; m < 4; ++m) { const int row = row0 + ai * 128 + m * 16; const float rs = rsv[ai][m]; bf16_t* rowp = base + (size_t)row * ldc + col0;
#pragma unroll
                    for (int bj = 0; bj < 2; ++bj) { const f32x4 v0 = acc[ai][bj][m][0] * rs, v1 = acc[ai][bj][m][1] * rs;
                        u32x4 w; w.x = cvt_pk_bf16(v0[0], v0[1]); w.y = cvt_pk_bf16(v0[2], v0[3]); w.z = cvt_pk_bf16(v1[0], v1[1]); w.w = cvt_pk_bf16(v1[2], v1[3]);
                        *(u32x4*)(rowp + bj * 128) = w; } }
        } else {
            const bool isk = u.pn >= 10; const int head = 4 * (u.pn & 1) + wc;
            float kn2max = 0.f;
#pragma unroll
            for (int am = 0; am < 4; ++am) { const int ai = am >> 1;
                f32x4 csv[2][4];
#pragma unroll
                for (int mm = 0; mm < 2; ++mm) { const int m = 2 * (am & 1) + mm; const f32x4* cs = (const f32x4*)(CS + (size_t)(row0 + ai * 128 + m * 16) * 32 + 8 * fq); csv[mm][0] = cs[0]; csv[mm][1] = cs[1]; csv[mm][2] = cs[2]; csv[mm][3] = cs[3]; }
#pragma unroll
                for (int mm = 0; mm < 2; ++mm) { const int m = 2 * (am & 1) + mm; const int row = row0 + ai * 128 + m * 16; const float rs = rsv[ai][m] * (isk ? 1.f : 0.125f * LOG2E);
                    const f32x4 c0 = csv[mm][0], c1 = csv[mm][1], c2 = csv[mm][2], c3 = csv[mm][3];
                    const float co[8] = {c0.x, c0.z, c1.x, c1.z, c2.x, c2.z, c3.x, c3.z}, si[8] = {c0.y, c0.w, c1.y, c1.w, c2.y, c2.w, c3.y, c3.w};
                    float lo[8], hi[8];
#pragma unroll
                    for (int n = 0; n < 2; ++n)
#pragma unroll
                        for (int e = 0; e < 4; ++e) { const int j = 4 * n + e; const float x1 = acc[ai][0][m][n][e] * rs, x2 = acc[ai][1][m][n][e] * rs; lo[j] = x1 * co[j] - x2 * si[j]; hi[j] = x2 * co[j] + x1 * si[j]; }
                    u32x4 wl, wh; wl.x = cvt_pk_bf16(lo[0], lo[1]); wl.y = cvt_pk_bf16(lo[2], lo[3]); wl.z = cvt_pk_bf16(lo[4], lo[5]); wl.w = cvt_pk_bf16(lo[6], lo[7]);
                    wh.x = cvt_pk_bf16(hi[0], hi[1]); wh.y = cvt_pk_bf16(hi[2], hi[3]); wh.z = cvt_pk_bf16(hi[4], hi[5]); wh.w = cvt_pk_bf16(hi[6], hi[7]);
                    if (!isk) { bf16_t* rowp = QR + (size_t)row * 512 + head * 64 + 8 * fq; *(u32x4*)rowp = wl; *(u32x4*)(rowp + 32) = wh; }
                    else { { float n2 = 0.f;
#pragma unroll
                          for (int j = 0; j < 8; ++j) n2 += lo[j] * lo[j] + hi[j] * hi[j];
                          n2 += __shfl_xor(n2, 16); n2 += __shfl_xor(n2, 32); kn2max = fmaxf(kn2max, n2); }
                        const int b = row >> 13, s = row & (SEQ - 1); const size_t bh = (size_t)(b * ATH + head) * (SEQ * 64);
#pragma unroll
                        for (int pat = 0; pat < 3; ++pat) { const int D = pat == 0 ? 1 : (pat == 1 ? 4 : 16), sh = pat * 2; const int r = s & (D - 1), p = s >> sh, T = p >> 5, k5 = p & 31;
                            const int rho = (k5 & 19) | ((k5 & 4) << 1) | ((k5 & 8) >> 1);
                            bf16_t* kf = KF + (size_t)pat * (MT * 512) + bh + ((size_t)(r * (SEQ / 32 >> sh) + T) * 4) * 512;
                            *(u32x4*)(kf + ((fq >> 1) * 64 + rho + 32 * (fq & 1)) * 8) = wl; *(u32x4*)(kf + ((2 + (fq >> 1)) * 64 + rho + 32 * (fq & 1)) * 8) = wh; }
                    } } }
            if (isk) { kn2max = fmaxf(kn2max, __shfl_xor(kn2max, 1)); kn2max = fmaxf(kn2max, __shfl_xor(kn2max, 2)); kn2max = fmaxf(kn2max, __shfl_xor(kn2max, 4)); kn2max = fmaxf(kn2max, __shfl_xor(kn2max, 8));
                if (fr == 0 && fq == 0) __hip_atomic_fetch_max(kmax + ((u.pm >> 5) * ATH + head), __float_as_uint(kn2max), __ATOMIC_RELAXED, __HIP_MEMORY_SCOPE_AGENT); }
        }
    }
};
struct EpiResAdd {
    static constexpr bool PERM = false;
    const float* Xs; float* X; float dm;
    __device__ __forceinline__ void operator()(const Acc& acc, const Unit& u, int wr, int wc, int fr, int fq, LAS unsigned char*) const {
        const int row0 = u.pm * 256 + wr * 64 + fr, col0 = u.pn * 256 + wc * 32 + 4 * fq;
#pragma unroll
        for (int ai = 0; ai < 2; ++ai) {
            f32x4 xv[4][2][2];
#pragma unroll
            for (int m = 0; m < 4; ++m) { const size_t off = (size_t)(row0 + ai * 128 + m * 16) * DM + col0;
#pragma unroll
                for (int bj = 0; bj < 2; ++bj)
#pragma unroll
                    for (int n = 0; n < 2; ++n) xv[m][bj][n] = *(const f32x4*)(Xs + off + bj * 128 + n * 16); }
            asm volatile("" ::: "memory");
#pragma unroll
            for (int m = 0; m < 4; ++m) { const size_t off = (size_t)(row0 + ai * 128 + m * 16) * DM + col0;
#pragma unroll
                for (int bj = 0; bj < 2; ++bj)
#pragma unroll
                    for (int n = 0; n < 2; ++n) *(f32x4*)(X + off + bj * 128 + n * 16) = xv[m][bj][n] + acc[ai][bj][m][n] * dm; }
        }
    }
};
struct EpiResAddB {
    static constexpr bool PERM = false;
    const bf16_t* XBs; bf16_t* XBo;
    __device__ __forceinline__ void operator()(const Acc& acc, const Unit& u, int wr, int wc, int fr, int fq, LAS unsigned char*) const {
        const int row0 = u.pm * 256 + wr * 64 + fr, col0 = u.pn * 256 + wc * 32 + 4 * fq;
#pragma unroll
        for (int ai = 0; ai < 2; ++ai) {
            u32x2 xv[4][2][2];
#pragma unroll
            for (int m = 0; m < 4; ++m) { const size_t off = (size_t)(row0 + ai * 128 + m * 16) * DM + col0;
#pragma unroll
                for (int bj = 0; bj < 2; ++bj)
#pragma unroll
                    for (int n = 0; n < 2; ++n) xv[m][bj][n] = *(const u32x2*)(XBs + off + bj * 128 + n * 16); }
            asm volatile("" ::: "memory");
#pragma unroll
            for (int m = 0; m < 4; ++m) { const size_t off = (size_t)(row0 + ai * 128 + m * 16) * DM + col0;
#pragma unroll
                for (int bj = 0; bj < 2; ++bj)
#pragma unroll
                    for (int n = 0; n < 2; ++n) { const u32x2 w = xv[m][bj][n]; const f32x4 a4 = acc[ai][bj][m][n];
                        u32x2 o; o.x = cvt_pk_bf16(bflo(w.x) + a4[0], bfhi(w.x) + a4[1]); o.y = cvt_pk_bf16(bflo(w.y) + a4[2], bfhi(w.y) + a4[3]);
                        *(u32x2*)(XBo + off + bj * 128 + n * 16) = o; } }
        }
    }
};
struct EpiResNorm {
    static constexpr bool PERM = false;
    const float* Xs; const bf16_t* XsB; bf16_t* XB; float* SSQP;
    __device__ __forceinline__ void operator()(const Acc& acc, const Unit& u, int wr, int wc, int fr, int fq, LAS unsigned char* lds) const {
        LAS float* EX = (LAS float*)(lds + SPARE_OFF);
        const int row0 = u.pm * 256 + wr * 64 + fr, col0 = u.pn * 256 + wc * 32 + 4 * fq;
#pragma unroll
        for (int ai = 0; ai < 2; ++ai)
#pragma unroll
            for (int m = 0; m < 4; ++m) { const size_t off = (size_t)(row0 + ai * 128 + m * 16) * DM + col0; float s = 0.f;
#pragma unroll
                for (int bj = 0; bj < 2; ++bj)
#pragma unroll
                    for (int n = 0; n < 2; ++n) { f32x4 xs; if (XsB) { const u32x2 w = *(const u32x2*)(XsB + off + bj * 128 + n * 16); xs = (f32x4){bflo(w.x), bfhi(w.x), bflo(w.y), bfhi(w.y)}; } else xs = *(const f32x4*)(Xs + off + bj * 128 + n * 16);
                        const f32x4 v = xs + acc[ai][bj][m][n];
                        u32x2 w; w.x = cvt_pk_bf16(v[0], v[1]); w.y = cvt_pk_bf16(v[2], v[3]); *(u32x2*)(XB + off + bj * 128 + n * 16) = w;
                        s += (v[0] * v[0] + v[1] * v[1]) + (v[2] * v[2] + v[3] * v[3]); }
                s += __shfl_xor(s, 16); s += __shfl_xor(s, 32);
                if (fq == 0) EX[(ai * 128 + wr * 64 + m * 16 + fr) * 4 + wc] = s; }
        asm volatile("s_waitcnt lgkmcnt(0)" ::: "memory"); __builtin_amdgcn_s_barrier(); asm volatile("" ::: "memory");
        { const int t = (wr * 4 + wc) * 64 + fq * 16 + fr; if (t < 256) { const f32x4 e = *(const LAS f32x4*)(EX + t * 4); SSQP[(size_t)(u.pm * 256 + t) * 4 + u.pn] = (e.x + e.y) + (e.z + e.w); } }
        asm volatile("s_waitcnt lgkmcnt(0)" ::: "memory"); __builtin_amdgcn_s_barrier(); asm volatile("" ::: "memory");
    }
};
struct EpiSoftmax {
    static constexpr bool PERM = false;
    bf16_t* P; const float* SSQP;
    __device__ __forceinline__ void operator()(Acc& acc, const Unit& u, int wr, int wc, int fr, int fq, LAS unsigned char* lds) const {
        LAS f32x2* EX = (LAS f32x2*)(lds + SPARE_OFF);
        const int row0 = u.pm * 256 + wr * 64 + fr;
        f32x4 pqv[2][4];
#pragma unroll
        for (int ai = 0; ai < 2; ++ai)
#pragma unroll
            for (int m = 0; m < 4; ++m) pqv[ai][m] = *(const f32x4*)(SSQP + (size_t)(row0 + ai * 128 + m * 16) * 4);
        float mw[2][4];
#pragma unroll
        for (int ai = 0; ai < 2; ++ai)
#pragma unroll
            for (int m = 0; m < 4; ++m) {
                const f32x4 pq = pqv[ai][m]; const float rs = __builtin_amdgcn_rsqf(((pq.x + pq.y) + (pq.z + pq.w)) * (1.f / DM) + EPS);
                float mx = -3.0e38f;
#pragma unroll
                for (int bj = 0; bj < 2; ++bj)
#pragma unroll
                    for (int n = 0; n < 2; ++n) { f32x4 v = acc[ai][bj][m][n] * rs; acc[ai][bj][m][n] = v; mx = fmaxf(mx, fmaxf(fmaxf(v[0], v[1]), fmaxf(v[2], v[3]))); }
                mx = fmaxf(mx, __shfl_xor(mx, 16)); mx = fmaxf(mx, __shfl_xor(mx, 32));
                float sm = 0.f;
#pragma unroll
                for (int bj = 0; bj < 2; ++bj)
#pragma unroll
                    for (int n = 0; n < 2; ++n) { f32x4 v = acc[ai][bj][m][n]; v[0] = __expf(v[0] - mx); v[1] = __expf(v[1] - mx); v[2] = __expf(v[2] - mx); v[3] = __expf(v[3] - mx);
                        acc[ai][bj][m][n] = v; sm += (v[0] + v[1]) + (v[2] + v[3]); }
                sm += __shfl_xor(sm, 16); sm += __shfl_xor(sm, 32);
                mw[ai][m] = mx;
                if (fq == 0) EX[(ai * 128 + wr * 64 + m * 16 + fr) * 4 + wc] = (f32x2){mx, sm};
            }
        asm volatile("s_waitcnt lgkmcnt(0)" ::: "memory"); __builtin_amdgcn_s_barrier(); asm volatile("" ::: "memory");
#pragma unroll
        for (int ai = 0; ai < 2; ++ai)
#pragma unroll
            for (int m = 0; m < 4; ++m) {
                const int rl = ai * 128 + wr * 64 + m * 16 + fr;
                const f32x2 e0 = EX[rl * 4 + 0], e1 = EX[rl * 4 + 1], e2 = EX[rl * 4 + 2], e3 = EX[rl * 4 + 3];
                const float M = fmaxf(fmaxf(e0.x, e1.x), fmaxf(e2.x, e3.x));
                const float Ls = e0.y * __expf(e0.x - M) + e1.y * __expf(e1.x - M) + e2.y * __expf(e2.x - M) + e3.y * __expf(e3.x - M);
                const float f = __expf(mw[ai][m] - M) / Ls;
                bf16_t* rowp = P + (size_t)(row0 + ai * 128 + m * 16) * DM + u.pn * 256 + wc * 32 + 4 * fq;
#pragma unroll
                for (int bj = 0; bj < 2; ++bj)
#pragma unroll
                    for (int n = 0; n < 2; ++n) { const f32x4 v = acc[ai][bj][m][n] * f; u32x2 w; w.x = cvt_pk_bf16(v[0], v[1]); w.y = cvt_pk_bf16(v[2], v[3]);
                        *(u32x2*)(rowp + bj * 128 + n * 16) = w; }
            }
        asm volatile("s_waitcnt lgkmcnt(0)" ::: "memory"); __builtin_amdgcn_s_barrier(); asm volatile("" ::: "memory");
    }
};
struct EpiMoe1 {
    static constexpr bool PERM = true;
    bf16_t* ACTB; const float* srs; const float* sgw;
    __device__ __forceinline__ void operator()(const Acc& acc, const Unit& u, int wr, int wc, int fr, int fq, LAS unsigned char*) const {
        const int row0 = u.pm * 256 + wr * 64 + fr, col0 = u.pn * 128 + wc * 32 + 8 * fq;
        float rsv[2][4], gwv[2][4];
#pragma unroll
        for (int ai = 0; ai < 2; ++ai)
#pragma unroll
            for (int m = 0; m < 4; ++m) { const int lrow = u.aux * 16384 + u.lr + wr * 64 + fr + ai * 128 + m * 16; rsv[ai][m] = srs[lrow]; gwv[ai][m] = sgw[lrow]; }
#pragma unroll
        for (int ai = 0; ai < 2; ++ai)
#pragma unroll
            for (int m = 0; m < 4; ++m) { const int row = row0 + ai * 128 + m * 16; const float rs = rsv[ai][m], gw = gwv[ai][m] * rs;
                float o[8];
#pragma unroll
                for (int n = 0; n < 2; ++n)
#pragma unroll
                    for (int j = 0; j < 4; ++j) { const float g = acc[ai][0][m][n][j] * rs, up = acc[ai][1][m][n][j]; o[n * 4 + j] = g * sigmoidf_(g) * up * gw; }
                u32x4 w; w.x = cvt_pk_bf16(o[0], o[1]); w.y = cvt_pk_bf16(o[2], o[3]); w.z = cvt_pk_bf16(o[4], o[5]); w.w = cvt_pk_bf16(o[6], o[7]);
                *(u32x4*)(ACTB + (size_t)row * EFF + col0) = w; }
    }
};

struct Args { const void* in[20]; float* out; unsigned char* ws; int ph_lo, ph_hi; };
struct Frame {
    LAS unsigned char* lds; volatile LAS unsigned* MISC; gu32* ctl;
    int tid, lane, wave, vcu, G;
    unsigned char* ws; float* out; size_t z; int dry;
};

__device__ __forceinline__ void transpose_item(const float* W, int N, const float* scale, bf16_t* WT, int ldt, int row_base, int k0, int n0, LAS float* scr, int lane) {
    f32x4 v[8];
#pragma unroll
    for (int i = 0; i < 8; ++i) v[i] = *(const GAS f32x4*)(W + (size_t)(k0 + 8 * i + (lane >> 3)) * N + n0 + 4 * (lane & 7));
#pragma unroll
    for (int i = 0; i < 8; ++i) { const int kk = 8 * i + (lane >> 3); f32x4 x = v[i]; if (scale) x = x * scale[k0 + kk]; LAS float* d = scr + kk * 33 + 4 * (lane & 7); d[0] = x.x; d[1] = x.y; d[2] = x.z; d[3] = x.w; }
    LDS_WAIT(); asm volatile("" ::: "memory");
    const int c = lane & 7;
#pragma unroll
    for (int j = 0; j < 4; ++j) { const int n = (lane >> 3) + 8 * j; const LAS float* s = scr + (8 * c) * 33 + n;
        u32x4 o; o.x = pk2(s[0 * 33], s[1 * 33]); o.y = pk2(s[2 * 33], s[3 * 33]); o.z = pk2(s[4 * 33], s[5 * 33]); o.w = pk2(s[6 * 33], s[7 * 33]);
        *(GAS u32x4*)(WT + (size_t)(row_base + n0 + n) * ldt + k0 + 8 * c) = o; }
    LDS_WAIT(); asm volatile("" ::: "memory");
}
__device__ __forceinline__ void transpose_mat_item(const float* W, int K, int N, const float* scale, bf16_t* WT, int mode, int it, LAS float* scr, int lane) {
    const int nblk = N / 32, kb = it / nblk, nb = it % nblk, k0 = 64 * kb, n0 = 32 * nb;
    int row_base = 0;
    if (mode == 1 || mode == 2) row_base = 256 * (n0 / 128) + (n0 % 128) + (mode == 2 ? 128 : 0) - n0;
    if (mode == 3 && n0 >= 2048 && n0 < 3072) {
        const int blk = (n0 - 2048) / 512, np = (n0 - 2048) % 512, head = np / 64, d = np % 64;
        row_base = 2048 + blk * 512 + (head / 4) * 256 + 128 * (d / 32) + 32 * (head % 4) + (d % 32) - n0; }
    transpose_item(W, N, scale, WT, K, row_base, k0, n0, scr, lane);
}

__device__ __forceinline__ float row_norm_prep(const float* xrow, bf16_t* xb_row, float* copy_row, int lane) {
    const GAS f32x4* xr = (const GAS f32x4*)xrow + lane;
    f32x4 v[4]; float s = 0.f;
#pragma unroll
    for (int j = 0; j < 4; ++j) { v[j] = xr[64 * j]; s += (v[j].x * v[j].x + v[j].y * v[j].y) + (v[j].z * v[j].z + v[j].w * v[j].w); }
    const float rstd = 1.f / sqrtf(wave_sum(s) * (1.f / DM) + EPS);
    GAS u32x2* o8 = (GAS u32x2*)xb_row + lane;
#pragma unroll
    for (int j = 0; j < 4; ++j) { u32x2 w; w.x = pk2(v[j].x, v[j].y); w.y = pk2(v[j].z, v[j].w); o8[64 * j] = w; }
    if (copy_row) { GAS f32x4* c = (GAS f32x4*)copy_row + lane;
#pragma unroll
        for (int j = 0; j < 4; ++j) c[64 * j] = v[j]; }
    return rstd;
}

__constant__ double INV_FREQ[32] = {1.0, 0.7498942093324559, 0.5623413251903491, 0.4216965034285822, 0.31622776601683794, 0.23713737056616552, 0.1778279410038923, 0.1333521432163324,
    0.1, 0.07498942093324558, 0.05623413251903491, 0.042169650342858224, 0.03162277660168379, 0.023713737056616554, 0.01778279410038923, 0.01333521432163324,
    0.01, 0.007498942093324558, 0.005623413251903491, 0.004216965034285823, 0.0031622776601683794, 0.0023713737056616554, 0.0017782794100389228, 0.001333521432163324,
    0.001, 0.0007498942093324559, 0.0005623413251903491, 0.00042169650342858224, 0.00031622776601683794, 0.00023713737056616554, 0.00017782794100389227, 0.0001333521432163324};


#define IN_F(i) ((const float*)((const char*)a.in[i] + F.z))
#define YMIX_PTR(l) ((l) == 0 ? (bf16_t*)(F.ws + WS_XB) : (bf16_t*)F.out)
__device__ __forceinline__ float hg_lb(const Frame& F, const Args& a, int l, int c) { if (l == 0) return 0.f; const float* h = IN_F(5); return sigmoidf_(h[HGW + c] - h[c]); }
__device__ __forceinline__ void conv_small_item(Frame& F, const Args& a, int l, int r, LAS float* scr) {
    unsigned char* ws = F.ws; const int lane = F.lane;
    if (r < 1792) { transpose_mat_item(IN_F(4) + (size_t)l * DM * NIN, DM, NIN, IN_F(3) + l * DM, (bf16_t*)(ws + WS_WIN) + (size_t)l * NIN * DM, 3, r, scr, lane); return; } r -= 1792;
    if (r < 512) { transpose_mat_item(IN_F(7) + (size_t)l * DM * DM, DM, DM, nullptr, (bf16_t*)(ws + WS_WOUT) + (size_t)l * DM * DM, 0, r, scr, lane); return; } r -= 512;
    if (r < 1024) { transpose_mat_item(IN_F(11) + (size_t)l * DM * 2 * DM, DM, 2 * DM, nullptr, (bf16_t*)(ws + WS_WKVT) + (size_t)l * 2 * DM * DM, 0, r, scr, lane); return; } r -= 1024;
    transpose_mat_item(IN_F(12) + (size_t)l * DM * DM, DM, DM, nullptr, (bf16_t*)(ws + WS_WOT) + (size_t)l * DM * DM, 0, r, scr, lane);
}
__device__ __forceinline__ void conv_wq_row(Frame& F, const Args& a, int r) {
    const int lane = F.lane; const float sc = IN_F(8)[r] * 0.0625f;
    const GAS f32x4* src = (const GAS f32x4*)(IN_F(10) + (size_t)r * DM) + lane; GAS u32x2* dst = (GAS u32x2*)((bf16_t*)(F.ws + WS_WQS) + (size_t)r * DM) + lane;
#pragma unroll
    for (int j = 0; j < 4; ++j) { const f32x4 v = src[64 * j] * sc; u32x2 w; w.x = pk2(v.x, v.y); w.y = pk2(v.z, v.w); dst[64 * j] = w; }
}
__device__ __forceinline__ void conv_small_l1(Frame& F, const Args& a, int wi, int nw) {
    LAS float* scr = (LAS float*)(F.lds + F.wave * 16384);
    for (int it = wi; it < 2816; it += nw) conv_small_item(F, a, 1, it < 2304 ? it : it + 1024, scr);
    for (int r = wi; r < DM; r += nw) conv_wq_row(F, a, DM + r);
}
__device__ __forceinline__ void ph_init(Frame& F, const Args& a) {
    LAS float* scr = (LAS float*)(F.lds + F.wave * 16384);
    const int gw = F.vcu * NWAVES + F.wave, NGW = F.G * NWAVES, lane = F.lane;
    unsigned char* ws = F.ws;
    for (int it = gw; it < 3840 + 1024; it += NGW) {
        if (it < 3840) conv_small_item(F, a, 0, it, scr); else conv_small_item(F, a, 1, 2304 + (it - 3840), scr); }
    for (int r = gw; r < DM; r += NGW) conv_wq_row(F, a, r);
    for (int r = gw; r < MEMROWS; r += NGW) {
        const GAS f32x4* xr = (const GAS f32x4*)(IN_F(1) + (size_t)r * DM) + lane;
        f32x4 v[4]; float s = 0.f;
#pragma unroll
        for (int j = 0; j < 4; ++j) { v[j] = xr[64 * j]; s += (v[j].x * v[j].x + v[j].y * v[j].y) + (v[j].z * v[j].z + v[j].w * v[j].w); }
        const float rstd = 1.f / sqrtf(wave_sum(s) * (1.f / DM) + EPS);
        for (int l = 0; l < DEPTH; ++l) {
            const GAS f32x4* g = (const GAS f32x4*)(IN_F(9) + l * DM) + lane; GAS u32x2* dst = (GAS u32x2*)((bf16_t*)(ws + WS_MEMN) + ((size_t)l * MEMROWS + r) * DM) + lane;
#pragma unroll
            for (int j = 0; j < 4; ++j) { const f32x4 o = v[j] * rstd * g[64 * j]; u32x2 w; w.x = pk2(o.x, o.y); w.y = pk2(o.z, o.w); dst[64 * j] = w; }
        }
    }
    for (int r = gw; r < MT; r += NGW) {
        const float rs = row_norm_prep(IN_F(0) + (size_t)r * DM, (bf16_t*)(ws + WS_XB) + (size_t)r * DM, nullptr, lane);
        if (lane == 0) ((float*)(ws + WS_RSTD))[r] = rs;
    }
    for (int i = (F.vcu * NTHR + F.tid); i < DEPTH * HGW; i += F.G * NTHR) ((float*)(ws + WS_LBT))[i] = hg_lb(F, a, i / HGW, i % HGW);
    { const int* pos = (const int*)((const char*)a.in[2] + F.z);
      for (int i = (F.vcu * NTHR + F.tid); i < MT * 32; i += F.G * NTHR) { const double ang = (double)pos[i >> 5] * INV_FREQ[i & 31]; double rev = ang * 0.15915494309189535; rev = rev - __builtin_floor(rev);
          const float fr = (float)rev; ((f32x2*)(ws + WS_CS))[i] = (f32x2){__builtin_amdgcn_cosf(fr), __builtin_amdgcn_sinf(fr)}; } }
    for (int i = (F.vcu * NTHR + F.tid); i < DEPTH * 32 * DM; i += F.G * NTHR) {
        const int l = i / (32 * DM), n = (i / DM) % 32, k = i % DM;
        float w = 0.f;
        if (n < 4) w = IN_F(14)[((size_t)l * DM + k) * 4 + n]; else if (n < 20) w = IN_F(15)[((size_t)l * DM + k) * 16 + (n - 4)];
        w *= IN_F(13)[l * DM + k];
        const unsigned hi = f2bf(w); const float rem = w - bf2f((unsigned short)hi);
        ((bf16_t*)(ws + WS_WR))[i] = (bf16_t)hi; ((bf16_t*)(ws + WS_WR) + DEPTH * 32 * DM)[i] = (bf16_t)f2bf(rem);
    }
}

struct SchedKV {
    int G, c; const char* memn; const char* wkvt;
    __device__ __forceinline__ bool next(int i, Unit& u) const {
        const int L = i * G + c; if (L >= 32) return false;
        const int l = L >> 4; u.pm = (L >> 3) & 1; u.pn = L & 7; u.aux = l;
        u.a = memn + ((size_t)l * MEMROWS + u.pm * 256) * DM * 2; u.b = wkvt + ((size_t)l * 2 * DM + u.pn * 256) * DM * 2; return true;
    }
};
struct SchedFold {
    int G, c; const char* kb; const char* vb; const char* wqs; const char* wot;
    __device__ __forceinline__ bool next(int i, Unit& u) const {
        const int L = i * G + c; if (L >= 128) return false;
        const int ty = L >> 6, l = (L >> 5) & 1, b = (L >> 4) & 1, h = (L >> 2) & 3, t = L & 3; u.aux = ty * 4 + l * 2 + b;
        if (ty == 0) { u.pm = h; u.pn = t; u.a = kb + (((size_t)l * MEMROWS + b * 256) * DM + h * 256) * 2; u.b = wqs + (((size_t)l * DM + t * 256) * DM + h * 256) * 2; }
        else { u.pm = t; u.pn = h; u.a = wot + (((size_t)l * DM + t * 256) * DM + h * 256) * 2; u.b = vb + (((size_t)l * MEMROWS + b * 256) * DM + h * 256) * 2; }
        return true;
    }
};
struct SchedMoe {
    int G, c, kdim; volatile LAS unsigned* tb; const char* A; const char* B; const int* perm2; const unsigned* cnt; bool gather; int mode, early, rem; unsigned* done;
    __device__ __forceinline__ bool next(int i, Unit& u) const {
        const int total = __builtin_amdgcn_readfirstlane((int)tb[16]) * 4; int L;
        if (mode == 0) L = i * G + c;
        else if (mode == 1) { L = i * G + c; if (L >= early) return false; }
        else if (mode == 2) { if (i > 0 || c >= rem) return false; L = early + c; }
        else { const int cc = c >= rem ? c - rem : c - rem + G; L = c >= rem ? (i == 0 ? cc : (G - rem) + (i - 1) * G + cc) : (G - rem) + i * G + cc; }
        if (L >= total) return false;
        if (G == 256 && L < (mode == 1 || mode == 3 ? early : (total / 256) * 256)) { const int rd = L >> 8, idx = L & 255, xcd = idx & 7, q = idx >> 3; L = ((rd * 64 + xcd * 8 + (q >> 2)) << 2) + (q & 3); }
        const int mt = L >> 2; u.pm = mt; u.pn = L & 3; int e = 0;
#pragma unroll
        for (int j = 1; j < 16; ++j) e += (mt >= __builtin_amdgcn_readfirstlane((int)tb[j])) ? 1 : 0;
        u.aux = e; u.lr = (mt - __builtin_amdgcn_readfirstlane((int)tb[e])) * 256; u.a = gather ? A : A + (size_t)mt * 256 * kdim * 2; u.b = B + ((size_t)e * 1024 + u.pn * 256) * kdim * 2;
        if (mode == 3 && L >= early) {
            unsigned spins = 0; while (__hip_atomic_load(done + mt, __ATOMIC_RELAXED, __HIP_MEMORY_SCOPE_AGENT) < 4u) { __builtin_amdgcn_s_sleep(8); if (++spins > (1u << 18)) break; }
            __builtin_amdgcn_fence(__ATOMIC_ACQUIRE, "agent"); asm volatile("s_waitcnt vmcnt(0)" ::: "memory"); }
        return true;
    }
    __device__ __forceinline__ int src_row(const Unit& u, int r) const { const int lrow = u.lr + r; const int n = __builtin_amdgcn_readfirstlane((int)tb[24 + u.aux]); const int v = perm2[u.aux * 16384 + lrow]; return lrow < n ? v : 0; }
};

__device__ __forceinline__ void vf_unit(Frame& F, int unit) {
    unsigned char* ws = F.ws; const int tid = F.tid;
    const int tb = unit >> 3, h = unit & 7, b = tb >> 4, s_base = (tb & 15) * 512;
    LAS unsigned short* Vl = (LAS unsigned short*)F.lds;
    const bf16_t* V = (const bf16_t*)(ws + A_V) + ((size_t)b * SEQ + s_base) * 512 + h * 64;
#pragma unroll
    for (int p = 0; p < 8; ++p) { const int c = p * 512 + tid, row = c >> 3, ch = c & 7; *(LAS u32x4*)(Vl + row * 72 + ch * 8) = *(const GAS u32x4*)(V + (size_t)row * 512 + ch * 8); }
    __syncthreads();
    const size_t bh = (size_t)(b * ATH + h) * (SEQ * 64);
    for (int it = 0; it < 24; ++it) { const int pc = it * 512 + tid, tile = pc >> 8, q = pc & 255, s = q >> 7, mt = (q >> 6) & 1, ln = q & 63, dim = (ln & 31) + 32 * mt, hi = ln >> 5;
        const int pat = tile >> 4, j16 = tile & 15, sh = pat * 2, D = 1 << sh;
        const int TPC = 16 >> sh, r = j16 / TPC, tl = j16 % TPC;
        const int pl = tl * 32 + 16 * s + 8 * hi;
        unsigned w[4];
#pragma unroll
        for (int jj = 0; jj < 4; ++jj) { const int t0 = ((pl + 2 * jj) << sh) + r, t1 = ((pl + 2 * jj + 1) << sh) + r; w[jj] = (unsigned)Vl[t0 * 72 + dim] | ((unsigned)Vl[t1 * 72 + dim] << 16); }
        const int T = (s_base >> sh >> 5) + tl;
        bf16_t* vf = (bf16_t*)(ws + A_VT1) + (size_t)pat * (MT * 512) + bh + ((size_t)(r * (SEQ / 32 >> sh) + T) * 4 + s * 2 + mt) * 512 + ln * 8;
        *(GAS u32x4*)vf = (u32x4){w[0], w[1], w[2], w[3]}; }
    __syncthreads();
}

__device__ __forceinline__ void hg_build_b(Frame& F, int l, int h, const u32x4 z0, const u32x4 z1, int k0, float (&bb)[16], float (&kk)[16]) {
    const int tid = F.tid, lane = F.lane, wave = F.wave, tl = lane >> 3;
    LAS float* WT = (LAS float*)F.lds; LAS float* REF = (LAS float*)(F.lds + 4096);
    const unsigned zz[8] = {z0.x, z0.y, z0.z, z0.w, z1.x, z1.y, z1.z, z1.w};
    float lbv[16];
#pragma unroll
    for (int i = 0; i < 16; i += 4) { const f32x4 t4 = *(const GAS f32x4*)((const float*)(F.ws + WS_LBT) + l * HGW + h * 128 + k0 + i); lbv[i] = t4.x; lbv[i + 1] = t4.y; lbv[i + 2] = t4.z; lbv[i + 3] = t4.w; }
#pragma unroll
    for (int i = 0; i < 16; ++i) { const float z = (i & 1) ? bfhi(zz[i >> 1]) : bflo(zz[i >> 1]); const float lb = lbv[i];
        const float e = ex2(-LOG2E * z), sg = __builtin_amdgcn_rcpf(1.f + e), f = lb + (1.f - lb) * sg; bb[i] = __builtin_amdgcn_logf(f); kk[i] = (1.f - lb) * (e * sg); }
#pragma unroll
    for (int i = 0; i < 16; ++i) { float x = bb[i]; float y;
        y = __shfl_up(x, 8); if (tl >= 1) x += y;
        y = __shfl_up(x, 16); if (tl >= 2) x += y;
        y = __shfl_up(x, 32); if (tl >= 4) x += y;
        bb[i] = x; }
    if (tl == 7) {
#pragma unroll
        for (int i = 0; i < 16; i += 4) *(LAS f32x4*)(WT + wave * 128 + k0 + i) = (f32x4){bb[i], bb[i + 1], bb[i + 2], bb[i + 3]}; }
    __syncthreads();
    for (int w = 0; w < wave; ++w) {
#pragma unroll
        for (int i = 0; i < 16; i += 4) { const f32x4 p = *(const LAS f32x4*)(WT + w * 128 + k0 + i); bb[i] += p.x; bb[i + 1] += p.y; bb[i + 2] += p.z; bb[i + 3] += p.w; } }
    if (tl == 7 && (wave & 1)) {
#pragma unroll
        for (int i = 0; i < 16; i += 4) *(LAS f32x4*)(REF + (wave >> 1) * 128 + k0 + i) = (f32x4){bb[i], bb[i + 1], bb[i + 2], bb[i + 3]}; }
    __syncthreads();
    (void)tid;
}
__device__ __forceinline__ void st_row16(LAS unsigned char* base, int byteoff, const float (&v)[16]) {
    u32x4 w0, w1; w0.x = cvt_pk_bf16(v[0], v[1]); w0.y = cvt_pk_bf16(v[2], v[3]); w0.z = cvt_pk_bf16(v[4], v[5]); w0.w = cvt_pk_bf16(v[6], v[7]); w1.x = cvt_pk_bf16(v[8], v[9]); w1.y = cvt_pk_bf16(v[10], v[11]); w1.z = cvt_pk_bf16(v[12], v[13]); w1.w = cvt_pk_bf16(v[14], v[15]);
    *(LAS u32x4*)(base + byteoff) = w0; *(LAS u32x4*)(base + byteoff + 16) = w1;
}
constexpr int HL_RED = 6144, HL_QD = 8192, HL_KD = 25600, HL_QE = 43008, HL_Q1 = 60416, HL_K1 = 69120, HL_Q2 = 77824, HL_K2 = 86528, HL_VT = 95232, HL_SC = 113664;
constexpr int RS_TR = 288;
typedef short s16x4 __attribute__((ext_vector_type(4)));
constexpr int HA_KT = 8192, HA_VT = 8192 + 64 * 288;
constexpr int RS128 = 272, RS64 = 144;

struct HgIn { u32x4 z0, z1, q0, q1, v0, v1; };
template <bool NEEDQ> __device__ __forceinline__ HgIn hg_load(Frame& F, int unit) {
    HgIn R;
    const int b = unit >> 9, h = (unit >> 7) & 3, c = unit & 127; const int row0 = b * SEQ + c * CHUNK, t = F.tid >> 3, k0 = (F.tid & 7) * 16;
    const bf16_t* rowp = (const bf16_t*)(F.ws + A_HG) + (size_t)(row0 + t) * 2048 + h * 128 + k0;
    R.z0 = *(const GAS u32x4*)(rowp + 512); R.z1 = *(const GAS u32x4*)(rowp + 512 + 8); R.v0 = *(const GAS u32x4*)(rowp + 1024); R.v1 = *(const GAS u32x4*)(rowp + 1024 + 8);
    if (NEEDQ) { R.q0 = *(const GAS u32x4*)(rowp); R.q1 = *(const GAS u32x4*)(rowp + 8); } else { R.q0 = R.z0; R.q1 = R.z1; }
    return R;
}
__device__ __forceinline__ void hg_a2_unit(Frame& F, const Args& a, int l, int unit, const HgIn& R) {
    unsigned char* ws = F.ws; const int tid = F.tid, lane = F.lane, wave = F.wave;
    const int h = (unit >> 7) & 3;
    const int t = tid >> 3, k0 = (tid & 7) * 16;
    const u32x4 v0 = R.v0, v1 = R.v1;
    float bb[16], kk[16];
    hg_build_b(F, l, h, R.z0, R.z1, k0, bb, kk);
    const LAS float* REF = (const LAS float*)(F.lds + 4096);
    { float tmp[16];
#pragma unroll
      for (int i = 0; i < 16; ++i) tmp[i] = kk[i] * ex2(REF[3 * 128 + k0 + i] - bb[i]);
      st_row16(F.lds, HA_KT + t * RS_TR + k0 * 2, tmp);
      *(LAS u32x4*)(F.lds + HA_VT + t * RS_TR + k0 * 2) = v0; *(LAS u32x4*)(F.lds + HA_VT + t * RS_TR + k0 * 2 + 16) = v1; }
    if (tid < 128) ((float*)(ws + A_DECAY))[(size_t)unit * 128 + tid] = ex2(REF[3 * 128 + tid]);
    __syncthreads();
    { const int fr = lane & 15, g = lane >> 4;
      const int q = fr >> 2, p = fr & 3;
      auto trfrag = [&](int base, int c0, int ks) -> bf16x8 {
          const LAS unsigned char* a0 = F.lds + base + (32 * ks + 8 * g + q) * RS_TR + (c0 + 4 * p) * 2;
          const s16x4 lo = __builtin_bit_cast(s16x4, __builtin_amdgcn_ds_read_tr16_b64_v4i16((LAS s16x4*)a0));
          const s16x4 hi = __builtin_bit_cast(s16x4, __builtin_amdgcn_ds_read_tr16_b64_v4i16((LAS s16x4*)(a0 + 4 * RS_TR)));
          return (bf16x8){lo[0], lo[1], lo[2], lo[3], hi[0], hi[1], hi[2], hi[3]}; };
      bf16x8 af[2];
#pragma unroll
      for (int ks = 0; ks < 2; ++ks) af[ks] = trfrag(HA_KT, wave * 16, ks);
      bf16_t* st = (bf16_t*)(ws + A_STATE) + (size_t)unit * 16384;
#pragma unroll
      for (int vt = 0; vt < 8; ++vt) { f32x4 acc = {0.f, 0.f, 0.f, 0.f};
#pragma unroll
          for (int ks = 0; ks < 2; ++ks) { const bf16x8 bf = trfrag(HA_VT, vt * 16, ks); acc = __builtin_amdgcn_mfma_f32_16x16x32_bf16(af[ks], bf, acc, 0, 0, 0); }
          u32x2 w; w.x = cvt_pk_bf16(acc[0], acc[1]); w.y = cvt_pk_bf16(acc[2], acc[3]);
          *(GAS u32x2*)(st + (vt * 16 + fr) * 128 + wave * 16 + 4 * g) = w; } }
    __syncthreads();
}

template <int STOP> __device__ __forceinline__ void hg_c2_unit(Frame& F, const Args& a, int l, int unit, const HgIn& R) {
    unsigned char* ws = F.ws; const int tid = F.tid, lane = F.lane, wave = F.wave;
    const int b = unit >> 9, h = (unit >> 7) & 3, c = unit & 127; const int row0 = b * SEQ + c * CHUNK;
    const int t = tid >> 3, k0 = (tid & 7) * 16;
    const int fr = lane & 15, g = lane >> 4;
    const bf16_t* HG = (const bf16_t*)(ws + A_HG);
    const u32x4 q0 = R.q0, q1 = R.q1, v0 = R.v0, v1 = R.v1;
    bf16x8 sf[4]; u32x2 gwv[4];
    { const bf16_t* st = (const bf16_t*)(ws + A_STATE) + (size_t)unit * 16384 + (wave * 16 + fr) * 128;
#pragma unroll
      for (int ks = 0; ks < 4; ++ks) sf[ks] = *(const GAS bf16x8*)(st + 32 * ks + 8 * g);
#pragma unroll
      for (int I = 0; I < 4; ++I) gwv[I] = *(const GAS u32x2*)(HG + (size_t)(row0 + 16 * I + fr) * 2048 + 1536 + h * 128 + wave * 16 + 4 * g); }
    const f32x4 gain = *(const GAS f32x4*)(IN_F(6) + l * HGW + h * 128 + wave * 16 + 4 * g);
    float bb[16], kk[16];
    hg_build_b(F, l, h, R.z0, R.z1, k0, bb, kk);
    if (STOP == 1) { asm volatile("" :: "v"(bb[0]), "v"(kk[0]), "v"(sf[0]), "v"(gwv[0]), "v"(gain)); return; }
    const LAS float* REF = (const LAS float*)(F.lds + 4096);
    { const unsigned qq[8] = {q0.x, q0.y, q0.z, q0.w, q1.x, q1.y, q1.z, q1.w}, vv[8] = {v0.x, v0.y, v0.z, v0.w, v1.x, v1.y, v1.z, v1.w};
      LAS unsigned short* VT = (LAS unsigned short*)(F.lds + HL_VT);
      float qv[16], tmp[16];
#pragma unroll
      for (int i = 0; i < 16; ++i) { qv[i] = (i & 1) ? bfhi(qq[i >> 1]) : bflo(qq[i >> 1]); VT[(k0 + i) * (RS64 / 2) + t] = (unsigned short)((i & 1) ? (vv[i >> 1] >> 16) : (vv[i >> 1] & 0xffffu)); }
      const int I = wave >> 1;
      float rf[16];
#pragma unroll
      for (int i = 0; i < 16; i += 4) { f32x4 r4 = {0.f, 0.f, 0.f, 0.f}; if (I) r4 = *(const LAS f32x4*)(REF + (I - 1) * 128 + k0 + i); rf[i] = r4.x; rf[i + 1] = r4.y; rf[i + 2] = r4.z; rf[i + 3] = r4.w; }
#pragma unroll
      for (int i = 0; i < 16; ++i) tmp[i] = qv[i] * ex2(bb[i] - rf[i]);
      st_row16(F.lds, HL_QD + t * RS128 + k0 * 2, tmp);
#pragma unroll
      for (int i = 0; i < 16; ++i) tmp[i] = kk[i] * ex2(fminf(rf[i] - bb[i], 86.f));
      st_row16(F.lds, HL_KD + t * RS128 + k0 * 2, tmp);
#pragma unroll
      for (int i = 0; i < 16; ++i) tmp[i] = qv[i] * ex2(bb[i]);
      st_row16(F.lds, HL_QE + t * RS128 + k0 * 2, tmp);
#pragma unroll
      for (int i = 0; i < 16; i += 4) { const f32x4 r4 = *(const LAS f32x4*)(REF + 1 * 128 + k0 + i); rf[i] = r4.x; rf[i + 1] = r4.y; rf[i + 2] = r4.z; rf[i + 3] = r4.w; }
      if (wave >= 4) {
#pragma unroll
          for (int i = 0; i < 16; ++i) tmp[i] = qv[i] * ex2(bb[i] - rf[i]);
          st_row16(F.lds, HL_Q1 + (t & 31) * RS128 + k0 * 2, tmp);
      } else {
#pragma unroll
          for (int i = 0; i < 16; ++i) tmp[i] = kk[i] * ex2(rf[i] - bb[i]);
          st_row16(F.lds, HL_K1 + (t & 31) * RS128 + k0 * 2, tmp);
      }
#pragma unroll
      for (int i = 0; i < 16; i += 4) { const f32x4 r4 = *(const LAS f32x4*)(REF + ((wave >= 4) ? 2 : 0) * 128 + k0 + i); rf[i] = r4.x; rf[i + 1] = r4.y; rf[i + 2] = r4.z; rf[i + 3] = r4.w; }
      if (wave & 2) {
#pragma unroll
          for (int i = 0; i < 16; ++i) tmp[i] = qv[i] * ex2(bb[i] - rf[i]);
          st_row16(F.lds, HL_Q2 + ((t & 15) + ((wave >= 4) ? 16 : 0)) * RS128 + k0 * 2, tmp);
      } else {
#pragma unroll
          for (int i = 0; i < 16; ++i) tmp[i] = kk[i] * ex2(rf[i] - bb[i]);
          st_row16(F.lds, HL_K2 + ((t & 15) + ((wave >= 4) ? 16 : 0)) * RS128 + k0 * 2, tmp);
      }
      for (int i = tid; i < 64 * RS64 / 16; i += NTHR) *(LAS u32x4*)(F.lds + HL_SC + i * 16) = (u32x4){0u, 0u, 0u, 0u};
    }
    __syncthreads();
    if (STOP == 2) { asm volatile("" :: "v"(sf[0]), "v"(gwv[0]), "v"(gain)); return; }
    for (int blk = wave; blk < 10; blk += 8) {
        int ko, qo, J, I; bool diag = false;
        if (blk < 4) { ko = HL_KD + blk * 16 * RS128; qo = HL_QD + blk * 16 * RS128; J = blk; I = blk; diag = true; }
        else if (blk == 4) { ko = HL_K2; qo = HL_Q2; J = 0; I = 1; }
        else if (blk == 5) { ko = HL_K2 + 16 * RS128; qo = HL_Q2 + 16 * RS128; J = 2; I = 3; }
        else { const int jj = (blk - 6) >> 1, ii = (blk - 6) & 1; ko = HL_K1 + jj * 16 * RS128; qo = HL_Q1 + ii * 16 * RS128; J = jj; I = 2 + ii; }
        f32x4 acc = {0.f, 0.f, 0.f, 0.f};
#pragma unroll
        for (int ks = 0; ks < 4; ++ks) { const bf16x8 af = *(const LAS bf16x8*)(F.lds + ko + fr * RS128 + (32 * ks + 8 * g) * 2), bf = *(const LAS bf16x8*)(F.lds + qo + fr * RS128 + (32 * ks + 8 * g) * 2);
            acc = __builtin_amdgcn_mfma_f32_16x16x32_bf16(af, bf, acc, 0, 0, 0); }
        if (diag) {
#pragma unroll
            for (int rg = 0; rg < 4; ++rg) if (4 * g + rg > fr) acc[rg] = 0.f; }
        u32x2 w; w.x = cvt_pk_bf16(acc[0], acc[1]); w.y = cvt_pk_bf16(acc[2], acc[3]);
        *(LAS u32x2*)(F.lds + HL_SC + (16 * I + fr) * RS64 + (16 * J + 4 * g) * 2) = w;
    }
    __syncthreads();
    if (STOP == 3) { asm volatile("" :: "v"(sf[0]), "v"(gwv[0]), "v"(gain)); return; }
    f32x4 o[4];
#pragma unroll
    for (int I = 0; I < 4; ++I) o[I] = (f32x4){0.f, 0.f, 0.f, 0.f};
    { bf16x8 af[2];
#pragma unroll
      for (int ks = 0; ks < 2; ++ks) af[ks] = *(const LAS bf16x8*)(F.lds + HL_VT + (wave * 16 + fr) * RS64 + (32 * ks + 8 * g) * 2);
#pragma unroll
      for (int I = 0; I < 4; ++I)
#pragma unroll
          for (int ks = 0; ks < 2; ++ks) { const bf16x8 bf = *(const LAS bf16x8*)(F.lds + HL_SC + (16 * I + fr) * RS64 + (32 * ks + 8 * g) * 2); o[I] = __builtin_amdgcn_mfma_f32_16x16x32_bf16(af[ks], bf, o[I], 0, 0, 0); }
#pragma unroll
      for (int I = 0; I < 4; ++I)
#pragma unroll
          for (int ks = 0; ks < 4; ++ks) { const bf16x8 bf = *(const LAS bf16x8*)(F.lds + HL_QE + (16 * I + fr) * RS128 + (32 * ks + 8 * g) * 2); o[I] = __builtin_amdgcn_mfma_f32_16x16x32_bf16(sf[ks], bf, o[I], 0, 0, 0); }
    }
    if (STOP == 4) { asm volatile("" :: "v"(o[0]), "v"(o[1]), "v"(o[2]), "v"(o[3]), "v"(gwv[0]), "v"(gain)); return; }
    LAS float* RED = (LAS float*)(F.lds + HL_RED);
#pragma unroll
    for (int I = 0; I < 4; ++I) { float q = (o[I][0] * o[I][0] + o[I][1] * o[I][1]) + (o[I][2] * o[I][2] + o[I][3] * o[I][3]); q += __shfl_xor(q, 16); q += __shfl_xor(q, 32); if (g == 0) RED[wave * 64 + 16 * I + fr] = q; }
    __syncthreads();
    { bf16_t* Y = YMIX_PTR(l);
#pragma unroll
      for (int I = 0; I < 4; ++I) { const int tt = 16 * I + fr; float ssq = 0.f;
#pragma unroll
          for (int w = 0; w < 8; ++w) ssq += RED[w * 64 + tt];
          const float rs = __builtin_amdgcn_rsqf(ssq * (1.f / 128.f) + EPS);
          const u32x2 gw = gwv[I];
          const float g0 = bflo(gw.x), g1 = bfhi(gw.x), g2 = bflo(gw.y), g3 = bfhi(gw.y);
          u32x2 w; w.x = cvt_pk_bf16(o[I][0] * rs * gain.x * (g0 * sigmoidf_(g0)), o[I][1] * rs * gain.y * (g1 * sigmoidf_(g1)));
          w.y = cvt_pk_bf16(o[I][2] * rs * gain.z * (g2 * sigmoidf_(g2)), o[I][3] * rs * gain.w * (g3 * sigmoidf_(g3)));
          *(GAS u32x2*)(Y + (size_t)(row0 + tt) * DM + h * 128 + wave * 16 + 4 * g) = w; } }
    __syncthreads();
}

__device__ __forceinline__ void hg_scan(Frame& F) {
    unsigned char* ws = F.ws;
    for (int gid = F.vcu * NTHR + F.tid; gid < BATCH * HGH * 16384; gid += F.G * NTHR) {
        const int bh = gid >> 14, e = gid & 16383, k = e & 127;
        bf16_t* st = (bf16_t*)(ws + A_STATE) + (size_t)bh * NCHUNK * 16384 + e; const float* dc = (const float*)(ws + A_DECAY) + (size_t)bh * NCHUNK * 128 + k;
        float S = 0.f;
        for (int c0 = 0; c0 < NCHUNK; c0 += 8) { float kv[8], d[8];
#pragma unroll
            for (int i = 0; i < 8; ++i) { kv[i] = bf2f(st[(size_t)(c0 + i) * 16384]); d[i] = dc[(c0 + i) * 128]; }
#pragma unroll
            for (int i = 0; i < 8; ++i) { st[(size_t)(c0 + i) * 16384] = (bf16_t)f2bf(F.dry ? kv[i] : S); S = d[i] * S + kv[i]; } }
    }
}


typedef float f32x16 __attribute__((ext_vector_type(16)));
template <int D, int PAT>
__device__ __forceinline__ void att_pattern(Frame& F, int b, int h, int s_base, float kmax2, const bf16_t* QR, const bf16_t* KF, const bf16_t* VF) {
    const int lane = F.lane, wave = F.wave, r32 = lane & 31, hi = lane >> 5;
    LAS float* ACC = (LAS float*)F.lds; LAS float* LS = (LAS float*)(F.lds + 131072);
    constexpr int TPC = 16 / D, NT = SEQ / D / 32;
    const size_t bh = (size_t)(b * ATH + h) * (SEQ * 64);
    for (int jj = 0; jj < 2; ++jj) {
        const int j = wave + 8 * jj, r = j / TPC, tile = j % TPC, p0 = s_base / D + tile * 32;
        const size_t qrow = (size_t)b * SEQ + (size_t)(p0 + r32) * D + r;
        bf16x8 qf[4];
#pragma unroll
        for (int kk = 0; kk < 4; ++kk) qf[kk] = *(const GAS bf16x8*)(QR + qrow * 512 + h * 64 + 16 * kk + 8 * hi);
        float qn2 = 0.f;
#pragma unroll
        for (int kk = 0; kk < 4; ++kk)
#pragma unroll
            for (int e = 0; e < 8; ++e) { const float x = bf2f((unsigned short)qf[kk][e]); qn2 += x * x; }
        qn2 += __shfl_xor(qn2, 32);
        const float negM = -__builtin_amdgcn_sqrtf(qn2 * kmax2);
        f32x16 o[2] = {{}, {}}; float lsum = 0.f;
#pragma unroll
        for (int kt = 0; kt < 5; ++kt) {
            const float c0 = (p0 - 128 + 32 * kt) < 0 ? -1.0e30f : negM;
            bf16x8 vfr[2][2], kf[4];
            { const int kb = p0 - 128 + 32 * kt, kbc = kb < 0 ? 0 : kb;
              const bf16_t* kp = KF + bh + ((size_t)(r * NT + (kbc >> 5)) * 4) * 512 + lane * 8;
#pragma unroll
              for (int kk = 0; kk < 4; ++kk) kf[kk] = *(const GAS bf16x8*)(kp + kk * 512);
#pragma unroll
              for (int s = 0; s < 2; ++s)
#pragma unroll
                  for (int mt = 0; mt < 2; ++mt) vfr[s][mt] = *(const GAS bf16x8*)(VF + bh + ((size_t)(r * NT + (kbc >> 5)) * 4 + s * 2 + mt) * 512 + lane * 8); }
            f32x16 acc;
#pragma unroll
            for (int rg = 0; rg < 16; ++rg) acc[rg] = c0;
#pragma unroll
            for (int kk = 0; kk < 4; ++kk) acc = __builtin_amdgcn_mfma_f32_32x32x16_bf16(kf[kk], qf[kk], acc, 0, 0, 0);
            if (kt == 0 || kt == 4) {
#pragma unroll
                for (int rg = 0; rg < 16; ++rg) { const int kap = 16 * (rg >> 3) + 8 * hi + (rg & 7); if (kt == 0 ? (kap < r32) : (kap > r32)) acc[rg] = -1.0e30f; } }
#pragma unroll
            for (int rg = 0; rg < 16; ++rg) { acc[rg] = ex2(acc[rg]); lsum += acc[rg]; }
#pragma unroll
            for (int s = 0; s < 2; ++s) {
                u32x4 pw; pw.x = cvt_pk_bf16(acc[8 * s + 0], acc[8 * s + 1]); pw.y = cvt_pk_bf16(acc[8 * s + 2], acc[8 * s + 3]);
                pw.z = cvt_pk_bf16(acc[8 * s + 4], acc[8 * s + 5]); pw.w = cvt_pk_bf16(acc[8 * s + 6], acc[8 * s + 7]);
                const bf16x8 pf = __builtin_bit_cast(bf16x8, pw);
#pragma unroll
                for (int mt = 0; mt < 2; ++mt) o[mt] = __builtin_amdgcn_mfma_f32_32x32x16_bf16(vfr[s][mt], pf, o[mt], 0, 0, 0);
            }
        }
        lsum += __shfl_xor(lsum, 32);
        const int tau = (p0 + r32) * D + r - s_base, gsw = (tau ^ (tau >> 5)) & 31;
        LAS float* arow = ACC + tau * 64;
#pragma unroll
        for (int mt = 0; mt < 2; ++mt)
#pragma unroll
            for (int rg = 0; rg < 16; ++rg) { LAS float* p = arow + ((((rg & 3) + 8 * (rg >> 2) + 4 * hi) ^ gsw) + 32 * mt); if (PAT == 0) *p = o[mt][rg]; else *p += o[mt][rg]; }
        if (hi == 0) { if (PAT == 0) LS[tau] = lsum; else LS[tau] += lsum; }
    }
}
__device__ __forceinline__ void att_unit(Frame& F, int l, int unit) {
    const int tb = unit >> 3, h = unit & 7, b = tb >> 4, s_base = (tb & 15) * 512;
    const bf16_t* QR = (const bf16_t*)(F.ws + A_QR);
    LAS float* ACC = (LAS float*)F.lds; LAS float* LS = (LAS float*)(F.lds + 131072);
    const float kmax2 = __uint_as_float(__hip_atomic_load((unsigned*)(F.ctl + CW_KMAX + l * 16) + b * ATH + h, RLX_AGENT)) * 1.02f;
    att_pattern<1, 0>(F, b, h, s_base, kmax2, QR, (const bf16_t*)(F.ws + A_KF1), (const bf16_t*)(F.ws + A_VT1));
    __syncthreads();
    att_pattern<4, 1>(F, b, h, s_base, kmax2, QR, (const bf16_t*)(F.ws + A_KF4), (const bf16_t*)(F.ws + A_VT4));
    __syncthreads();
    att_pattern<16, 2>(F, b, h, s_base, kmax2, QR, (const bf16_t*)(F.ws + A_KF16), (const bf16_t*)(F.ws + A_VT16));
    __syncthreads();
    { const int tau = F.tid, gsw = (tau ^ (tau >> 5)) & 31; const LAS float* arow = ACC + tau * 64; const float inv = __builtin_amdgcn_rcpf(LS[tau]);
      bf16_t* yrow = YMIX_PTR(l) + ((size_t)b * SEQ + s_base + tau) * DM + 512 + h * 64;
#pragma unroll
      for (int c = 0; c < 8; ++c) { float v[8];
#pragma unroll
          for (int e = 0; e < 8; ++e) v[e] = arow[((8 * c + e) & 32) + (((8 * c + e) & 31) ^ gsw)] * inv;
          u32x4 w; w.x = cvt_pk_bf16(v[0], v[1]); w.y = cvt_pk_bf16(v[2], v[3]); w.z = cvt_pk_bf16(v[4], v[5]); w.w = cvt_pk_bf16(v[6], v[7]); *(GAS u32x4*)(yrow + 8 * c) = w; } }
    __syncthreads();
}

__device__ __forceinline__ void ph_norm(Frame& F, const Args& a) {
    const int gw = F.vcu * NWAVES + F.wave, NGW = F.G * NWAVES;
    for (int r = gw; r < MT; r += NGW) { const float rs = row_norm_prep(F.out + (size_t)r * DM, (bf16_t*)(F.ws + WS_XB) + (size_t)r * DM, nullptr, F.lane); if (F.lane == 0) ((float*)(F.ws + WS_RSTD))[r] = rs; }
}

__device__ __forceinline__ void ph_router(Frame& F, const Args& a, int l) {
    unsigned char* ws = F.ws; const int lane = F.lane;
    const int gw = F.vcu * NWAVES + F.wave, NGW = F.G * NWAVES;
    { LAS float* scr = (LAS float*)(F.lds + F.wave * 16384);
      for (int it = gw; it < 3 * 4096; it += NGW) { const int ty = it >> 12, e = (it >> 8) & 15, r = it & 255;
          if (ty == 0) transpose_mat_item(IN_F(16) + ((size_t)l * NEXP + e) * DM * EFF, DM, EFF, IN_F(13) + l * DM, (bf16_t*)(ws + A_WGU) + (size_t)e * DM * DM, 1, r, scr, lane);
          else if (ty == 1) transpose_mat_item(IN_F(17) + ((size_t)l * NEXP + e) * DM * EFF, DM, EFF, IN_F(13) + l * DM, (bf16_t*)(ws + A_WGU) + (size_t)e * DM * DM, 2, r, scr, lane);
          else transpose_mat_item(IN_F(18) + ((size_t)l * NEXP + e) * EFF * DM, EFF, DM, nullptr, (bf16_t*)(ws + A_WD) + (size_t)e * DM * EFF, 0, r, scr, lane); } }
    __syncthreads();
    unsigned* cnt = (unsigned*)(F.ctl + CW_CNT + l * 16 * 64);
    LAS unsigned* LCNT = (LAS unsigned*)(F.lds + 81920); LAS unsigned* LBASE = (LAS unsigned*)(F.lds + 81984);
    LAS float* LG = (LAS float*)F.lds;
    LAS float* SS = (LAS float*)(F.lds + 16384);
    if (F.tid < 16) LCNT[F.tid] = 0u;
    const bf16_t* WH = (const bf16_t*)(ws + WS_WR) + (size_t)l * 32 * DM; const bf16_t* WL = WH + DEPTH * 32 * DM;
    const int fr = lane & 15, g = lane >> 4, tile = F.wave & 3, kh = F.wave >> 2;
    for (int rt = F.vcu; rt < MT / 64; rt += F.G) {
        const int row = rt * 64 + tile * 16 + fr;
        const bf16_t* xbrow = (const bf16_t*)(ws + WS_XB) + (size_t)row * DM + kh * 512 + 8 * g;
        f32x4 acc[2] = {{0.f, 0.f, 0.f, 0.f}, {0.f, 0.f, 0.f, 0.f}}; float ssq = 0.f;
#pragma unroll 4
        for (int ks = 0; ks < 16; ++ks) {
            const u32x4 hw = *(const GAS u32x4*)(xbrow + 32 * ks);
            { const float x0 = bflo(hw.x), x1 = bfhi(hw.x), x2 = bflo(hw.y), x3 = bfhi(hw.y), x4 = bflo(hw.z), x5 = bfhi(hw.z), x6 = bflo(hw.w), x7 = bfhi(hw.w);
              ssq += ((x0 * x0 + x1 * x1) + (x2 * x2 + x3 * x3)) + ((x4 * x4 + x5 * x5) + (x6 * x6 + x7 * x7)); }
            const bf16x8 ah = __builtin_bit_cast(bf16x8, hw);
#pragma unroll
            for (int ct = 0; ct < 2; ++ct) { const size_t wo = (size_t)(16 * ct + fr) * DM + kh * 512 + 32 * ks + 8 * g;
                const bf16x8 bh = *(const GAS bf16x8*)(WH + wo), bl = *(const GAS bf16x8*)(WL + wo);
                acc[ct] = __builtin_amdgcn_mfma_f32_16x16x32_bf16(ah, bh, acc[ct], 0, 0, 0); acc[ct] = __builtin_amdgcn_mfma_f32_16x16x32_bf16(ah, bl, acc[ct], 0, 0, 0); }
        }
        ssq += __shfl_xor(ssq, 16); ssq += __shfl_xor(ssq, 32);
        if (g == 0) SS[kh * 64 + tile * 16 + fr] = ssq;
#pragma unroll
        for (int ct = 0; ct < 2; ++ct)
#pragma unroll
            for (int rg = 0; rg < 4; ++rg) LG[(kh * 64 + tile * 16 + 4 * g + rg) * 32 + 16 * ct + fr] = acc[ct][rg];
        __syncthreads();
        if (F.tid < 64) { const int rl = F.tid, r = rt * 64 + rl;
            const float rstd = __builtin_amdgcn_rsqf((SS[rl] + SS[64 + rl]) * (1.f / DM) + EPS);
            float lg[20];
#pragma unroll
            for (int q = 0; q < 20; q += 4) { const f32x4 p0 = *(const LAS f32x4*)(LG + rl * 32 + q), p1 = *(const LAS f32x4*)(LG + (64 + rl) * 32 + q); lg[q] = (p0.x + p1.x) * rstd; lg[q + 1] = (p0.y + p1.y) * rstd; lg[q + 2] = (p0.z + p1.z) * rstd; lg[q + 3] = (p0.w + p1.w) * rstd; }
            ((float*)(ws + WS_RSTD))[r] = rstd;
            int gs = 0; float gm = lg[0];
#pragma unroll
            for (int q = 1; q < 4; ++q) if (lg[q] > gm) { gm = lg[q]; gs = q; }
            float den = 0.f;
#pragma unroll
            for (int q = 0; q < 4; ++q) den += __expf(lg[q] - gm);
            const float gwt = __builtin_amdgcn_rcpf(den);
            float e4[4];
#pragma unroll
            for (int q = 0; q < 4; ++q) e4[q] = gs == 0 ? lg[4 + q] : (gs == 1 ? lg[8 + q] : (gs == 2 ? lg[12 + q] : lg[16 + q]));
            int i1 = 0; float v1 = e4[0];
#pragma unroll
            for (int q = 1; q < 4; ++q) if (e4[q] > v1) { v1 = e4[q]; i1 = q; }
            int i2 = -1; float v2 = -3.0e38f;
#pragma unroll
            for (int q = 0; q < 4; ++q) if (q != i1 && e4[q] > v2) { v2 = e4[q]; i2 = q; }
            const float ex = __expf(v2 - v1), w1 = __builtin_amdgcn_rcpf(1.f + ex), w2 = ex * w1;
            const int id1 = gs * 4 + i1, id2 = gs * 4 + i2;
            int* te = (int*)(ws + WS_TOKE) + 2 * r; float* tw = (float*)(ws + WS_TOKW) + 2 * r; int* tl = (int*)(ws + WS_TOKL) + 2 * r;
            te[0] = id1; te[1] = id2; tw[0] = w1 * gwt; tw[1] = w2 * gwt;
            tl[0] = (int)__hip_atomic_fetch_add(LCNT + id1, 1u, __ATOMIC_RELAXED, __HIP_MEMORY_SCOPE_WORKGROUP); tl[1] = (int)__hip_atomic_fetch_add(LCNT + id2, 1u, __ATOMIC_RELAXED, __HIP_MEMORY_SCOPE_WORKGROUP);
        }
        __syncthreads();
    }
    __syncthreads();
    if (F.tid < 16) LBASE[F.tid] = __hip_atomic_fetch_add(cnt + 64 * F.tid, F.dry ? 0u : LCNT[F.tid], RLX_AGENT);
    __syncthreads();
    for (int rt = F.vcu; rt < MT / 64; rt += F.G) {
        if (F.tid < 128) { const int r = rt * 64 + (F.tid >> 1), k = F.tid & 1;
            const int e = ((const int*)(ws + WS_TOKE))[2 * r + k]; const int li = ((const int*)(ws + WS_TOKL))[2 * r + k] + (int)LBASE[e];
            ((int*)(ws + WS_TOKL))[2 * r + k] = li; ((int*)(ws + A_PERM2))[e * 16384 + li] = r; ((float*)(ws + A_SRS2))[e * 16384 + li] = ((const float*)(ws + WS_RSTD))[r]; ((float*)(ws + A_SGW2))[e * 16384 + li] = ((const float*)(ws + WS_TOKW))[2 * r + k]; } }
}

__device__ __forceinline__ void moe_prefix(Frame& F, int l) {
    if (F.tid == 0) { unsigned n[16];
#pragma unroll
        for (int e = 0; e < 16; ++e) n[e] = __hip_atomic_load((unsigned*)(F.ctl + CW_CNT + l * 16 * 64) + 64 * e, RLX_AGENT);
        unsigned acc = 0;
#pragma unroll
        for (int e = 0; e < 16; ++e) { F.MISC[16 + e] = acc; F.MISC[40 + e] = n[e]; acc += (n[e] + 255u) >> 8; }
        F.MISC[32] = acc; }
    __syncthreads();
}

__device__ __forceinline__ void ph_combine(Frame& F, const Args& a, int l) {
    unsigned char* ws = F.ws; const int lane = F.lane;
    const int gw = F.vcu * NWAVES + F.wave, NGW = F.G * NWAVES;
    moe_prefix(F, l);
    const int* tlr = (const int*)(ws + WS_TOKL); const int* te = (const int*)(ws + WS_TOKE); const bf16_t* Y = (const bf16_t*)(ws + A_Y);
    auto slot_of = [&](int p) { return (int)F.MISC[16 + te[p]] * 256 + tlr[p]; };
    auto clampr = [&](int r) { return r < MT ? r : MT - 1; };
    int r = gw; if (r >= MT) return;
    int s0 = slot_of(2 * r), s1 = slot_of(2 * r + 1);
    int rn = clampr(r + NGW); int sn0 = slot_of(2 * rn), sn1 = slot_of(2 * rn + 1);
    const bf16_t* XBp = (const bf16_t*)(ws + WS_XB);
    u32x2 xv[4]; u32x2 ya[4], yb[4];
#pragma unroll
    for (int j = 0; j < 4; ++j) { xv[j] = ((const GAS u32x2*)(XBp + (size_t)r * DM) + lane)[64 * j]; ya[j] = ((const GAS u32x2*)(Y + (size_t)s0 * DM) + lane)[64 * j]; yb[j] = ((const GAS u32x2*)(Y + (size_t)s1 * DM) + lane)[64 * j]; }
    for (; r < MT; r += NGW) {
        const int rnn = clampr(r + 2 * NGW); const int snn0 = slot_of(2 * rnn), snn1 = slot_of(2 * rnn + 1);
        u32x2 xn[4]; u32x2 yan[4], ybn[4];
#pragma unroll
        for (int j = 0; j < 4; ++j) { xn[j] = ((const GAS u32x2*)(XBp + (size_t)rn * DM) + lane)[64 * j]; yan[j] = ((const GAS u32x2*)(Y + (size_t)sn0 * DM) + lane)[64 * j]; ybn[j] = ((const GAS u32x2*)(Y + (size_t)sn1 * DM) + lane)[64 * j]; }
        GAS f32x4* xr = (GAS f32x4*)(F.out + (size_t)r * DM) + lane;
        f32x4 v[4]; float s = 0.f;
#pragma unroll
        for (int j = 0; j < 4; ++j) { const u32x2 p0 = ya[j], p1 = yb[j]; f32x4 x = {bflo(xv[j].x), bfhi(xv[j].x), bflo(xv[j].y), bfhi(xv[j].y)};
            const float dm = F.dry ? 0.f : 1.f; x.x += dm * (bflo(p0.x) + bflo(p1.x)); x.y += dm * (bfhi(p0.x) + bfhi(p1.x)); x.z += dm * (bflo(p0.y) + bflo(p1.y)); x.w += dm * (bfhi(p0.y) + bfhi(p1.y));
            v[j] = x; s += (x.x * x.x + x.y * x.y) + (x.z * x.z + x.w * x.w); }
        const float rstd = __builtin_amdgcn_rsqf(wave_sum(s) * (1.f / DM) + EPS);
        if (l == DEPTH - 1) { const GAS f32x4* g = (const GAS f32x4*)IN_F(19) + lane;
#pragma unroll
            for (int j = 0; j < 4; ++j) xr[64 * j] = v[j] * rstd * g[64 * j];
        } else {
            GAS u32x2* o8 = (GAS u32x2*)((bf16_t*)(ws + WS_XB) + (size_t)r * DM) + lane;
#pragma unroll
            for (int j = 0; j < 4; ++j) { u32x2 w; w.x = cvt_pk_bf16(v[j].x, v[j].y); w.y = cvt_pk_bf16(v[j].z, v[j].w); o8[64 * j] = w; }
            if (lane == 0) ((float*)(ws + WS_RSTD))[r] = rstd;
        }
#pragma unroll
        for (int j = 0; j < 4; ++j) { xv[j] = xn[j]; ya[j] = yan[j]; yb[j] = ybn[j]; }
        rn = rnn; sn0 = snn0; sn1 = snn1;
    }
}

constexpr int NPHASE = 1 + 11 * DEPTH + (PROBE_P >= 0 ? PROBE_N - 1 : 0);
__global__ void __launch_bounds__(NTHR, 2) fwd(Args a) {
    extern __shared__ __attribute__((aligned(16))) unsigned char lds_raw[];
    Frame F;
    F.lds = (LAS unsigned char*)lds_raw; F.MISC = (volatile LAS unsigned*)(F.lds + MISC_OFF);
    F.tid = threadIdx.x; F.lane = F.tid & 63; F.wave = __builtin_amdgcn_readfirstlane(F.tid >> 6);
    F.G = gridDim.x; { const int bx = blockIdx.x; F.vcu = (F.G % 8 == 0) ? (bx % 8) * (F.G / 8) + bx / 8 : bx; }
    F.ws = a.ws; F.ctl = (gu32*)(a.ws + WS_CTL); F.out = a.out; F.z = 0;
    for (int u = F.tid; u < (LDS_BYTES - LDSCTL_OFF) / 4; u += NTHR) ((LAS unsigned*)(F.lds + LDSCTL_OFF))[u] = 0u;
    __syncthreads();
    XcdBarrier bar; bar.bar = (unsigned*)(F.ctl + CW_BAR); bar.x = 0; bar.st = nullptr;
    const bool one_launch = (a.ph_hi - a.ph_lo) > 1;
    if (one_launch) bar = xcd_barrier_post((unsigned*)(F.ctl + CW_BAR), F.MISC + 8);
    for (int pp = a.ph_lo; pp < a.ph_hi; ++pp) {
        int ph = pp;
        F.dry = 0;
        if (PROBE_P >= 0) { constexpr int P = PROBE_P; if (pp > P) ph = (pp - (PROBE_N - 1) > P) ? pp - (PROBE_N - 1) : P; if (ph == P && pp < P + PROBE_N - 1) F.dry = 1; }
        { int t_ = threadIdx.x; asm volatile("" : "+v"(t_)); F.tid = t_; F.lane = t_ & 63; F.wave = __builtin_amdgcn_readfirstlane(t_ >> 6); }
        size_t z_ = 0; asm volatile("" : "+s"(z_)); F.z = z_; F.ws = a.ws + z_; F.out = (float*)((char*)a.out + z_); F.ctl = (gu32*)(a.ws + z_ + WS_CTL);
        unsigned char* ws = F.ws; int bx = (int)blockIdx.x; asm volatile("" : "+s"(bx));
        if (ph == 0) { if (PHSEL(0)) ph_init(F, a); }
        else {
            const int l = (ph - 1) / 11, qq = (ph - 1) % 11, q = qq < 5 ? qq : (qq < 8 ? qq + 1 : qq + 2);
            if (q == 0 && PHSEL(3)) {
                pg8::SchedDense S{64, 14, 896, F.G, bx, (const char*)(ws + WS_XB), (const char*)(ws + WS_WIN) + (size_t)l * NIN * DM * 2, (size_t)256 * DM * 2, (size_t)256 * DM * 2, 64, 0};
                EpiProj E{(bf16_t*)(ws + A_HG), (bf16_t*)(ws + A_QR), (bf16_t*)(ws + A_KF1), (bf16_t*)(ws + A_V), (const float*)(ws + WS_RSTD), (const f32x2*)(ws + WS_CS), (unsigned*)(F.ctl + CW_KMAX + l * 16)};
                pg8::gemm_phase<EpiProj, pg8::SchedDense, true, true, DM, DM>(F.lds, F.tid, S, E);
                if (l == 0) {
                    const bool part = (F.G == 256);
                    { size_t z2 = 0; asm volatile("" : "+s"(z2)); ws = F.ws + z2; F.ws = ws; int t2 = F.tid; asm volatile("" : "+v"(t2)); F.tid = t2; F.lane = t2 & 63; }
                    if (!part || (bx >= 128 && bx < 160)) { SchedKV SK{part ? 32 : F.G, part ? bx - 128 : bx, (const char*)(ws + WS_MEMN), (const char*)(ws + WS_WKVT)};
                        EpiKV EK{(bf16_t*)(ws + WS_KV), (bf16_t*)(ws + WS_KV) + (size_t)DEPTH * MEMROWS * DM};
                        pg8::gemm_phase<EpiKV, SchedKV, true, true, DM, DM>(F.lds, F.tid, SK, EK); }
                    if (!part || bx >= 160) conv_small_l1(F, a, part ? (bx - 160) * NWAVES + F.wave : F.vcu * NWAVES + F.wave, part ? 96 * NWAVES : F.G * NWAVES);
                }
            } else if (q == 1 && PHSEL(4)) {
                for (int rep = 0; rep < PROBE_PREP_N; ++rep) for (int u = F.vcu; u < (MT / 512) * ATH; u += F.G) vf_unit(F, u);
                for (int rep = 0; rep < PROBE_HGA_N; ++rep) { constexpr int NU = BATCH * HGH * NCHUNK; HgIn R = hg_load<false>(F, F.vcu < NU ? F.vcu : NU - 1);
                    for (int u = F.vcu; u < NU; u += F.G) { const HgIn Rn = hg_load<false>(F, u + F.G < NU ? u + F.G : NU - 1); hg_a2_unit(F, a, l, u, R); R = Rn; } }
                if (l == 0) {
                    { size_t z2 = 0; asm volatile("" : "+s"(z2)); ws = F.ws + z2; F.ws = ws; int t2 = F.tid; asm volatile("" : "+v"(t2)); F.tid = t2; F.lane = t2 & 63; }
                    SchedFold SF{F.G, bx, (const char*)(ws + WS_KV), (const char*)(ws + WS_KV) + (size_t)DEPTH * MEMROWS * DM * 2, (const char*)(ws + WS_WQS), (const char*)(ws + WS_WOT)};
                    EpiBf16 EF{(bf16_t*)(ws + WS_WQK), DM, (size_t)DM * DM, 1.f};
                    pg8::gemm_phase<EpiBf16, SchedFold, true, true, DM, 256>(F.lds, F.tid, SF, EF); }
            } else if (q == 2 && PHSEL(5)) hg_scan(F);
            else if (q == 3 && PHSEL(6)) {
                for (int rep = 0; rep < PROBE_HGC_N; ++rep) { constexpr int NU = BATCH * HGH * NCHUNK; HgIn R = hg_load<true>(F, F.vcu < NU ? F.vcu : NU - 1);
                    for (int u = F.vcu; u < NU; u += F.G) { const HgIn Rn = hg_load<true>(F, u + F.G < NU ? u + F.G : NU - 1); if (rep + 1 < PROBE_HGC_N) hg_c2_unit<PROBE_HGC_STOP>(F, a, l, u, R); else hg_c2_unit<0>(F, a, l, u, R); R = Rn; } }
#if ATT_GOLDEN
                for (int t = F.vcu * NWAVES + F.wave; t < (MT / 64) * ATH; t += F.G * NWAVES) att_task(F, t);
#else
                for (int rep = 0; rep < PROBE_ATT_N; ++rep) for (int u = F.vcu; u < (MT / 512) * ATH; u += F.G) att_unit(F, l, u);
#endif
            } else if (q == 4 && PHSEL(7)) {
                pg8::SchedDense S{64, 4, 256, F.G, bx, (const char*)YMIX_PTR(l), (const char*)(ws + WS_WOUT) + (size_t)l * DM * DM * 2, (size_t)256 * DM * 2, (size_t)256 * DM * 2, 64, 0};
                EpiResNorm E{IN_F(0), l == 0 ? nullptr : (const bf16_t*)(ws + WS_XB), (bf16_t*)(ws + A_XB2), (float*)(ws + WS_SSQP)};
                pg8::gemm_phase<EpiResNorm, pg8::SchedDense, true, true, DM, DM>(F.lds, F.tid, S, E);
            } else if (q == 5 && PHSEL(8)) ph_norm(F, a);
            else if (q == 6 && PHSEL(9)) {
                pg8::SchedDense S{64, 4, 256, F.G, bx, (const char*)(ws + A_XB2), (const char*)(ws + WS_WQK) + (size_t)l * 2 * DM * DM * 2, (size_t)256 * DM * 2, (size_t)256 * DM * 2, 32, (size_t)DM * DM * 2};
                EpiSoftmax E{(bf16_t*)(ws + A_P), (const float*)(ws + WS_SSQP)};
                pg8::gemm_phase<EpiSoftmax, pg8::SchedDense, true, true, DM, DM>(F.lds, F.tid, S, E);
            } else if (q == 7 && PHSEL(10)) {
                pg8::SchedDense S{64, 4, 256, F.G, bx, (const char*)(ws + A_P), (const char*)(ws + WS_WVO) + (size_t)l * 2 * DM * DM * 2, (size_t)256 * DM * 2, (size_t)256 * DM * 2, 32, (size_t)DM * DM * 2};
                EpiResAddB E{(const bf16_t*)(ws + A_XB2), (bf16_t*)(ws + WS_XB)};
                pg8::gemm_phase<EpiResAddB, pg8::SchedDense, true, true, DM, DM>(F.lds, F.tid, S, E);
            } else if (q == 8 && PHSEL(11)) ph_router(F, a, l);
            else if (q == 10 && PHSEL(13)) {
                moe_prefix(F, l);
                const int total = __builtin_amdgcn_readfirstlane((int)F.MISC[32]) * 4, early = (total / F.G) * F.G;
                SchedMoe S{F.G, bx, DM, F.MISC + 16, (const char*)(ws + WS_XB), (const char*)(ws + A_WGU), (const int*)(ws + A_PERM2), (const unsigned*)(F.ctl + CW_CNT + l * 16 * 64), true, 1, early, total - early, nullptr};
                EpiMoe1 E{(bf16_t*)(ws + A_ACTB), (const float*)(ws + A_SRS2), (const float*)(ws + A_SGW2)};
                pg8::gemm_phase<EpiMoe1, SchedMoe, true, true, DM, DM, true>(F.lds, F.tid, S, E);
            } else if (q == 11 && PHSEL(14)) {
                moe_prefix(F, l);
                const int total = __builtin_amdgcn_readfirstlane((int)F.MISC[32]) * 4, early = (total / F.G) * F.G, rem = total - early;
                unsigned* done = (unsigned*)(F.ctl + CW_DONE + l * 256);
                if (bx < rem) {
                    SchedMoe S{F.G, bx, DM, F.MISC + 16, (const char*)(ws + WS_XB), (const char*)(ws + A_WGU), (const int*)(ws + A_PERM2), (const unsigned*)(F.ctl + CW_CNT + l * 16 * 64), true, 2, early, rem, nullptr};
                    EpiMoe1 E{(bf16_t*)(ws + A_ACTB), (const float*)(ws + A_SRS2), (const float*)(ws + A_SGW2)};
                    pg8::gemm_phase<EpiMoe1, SchedMoe, true, true, DM, DM, true>(F.lds, F.tid, S, E);
                    if (F.tid == 0) { __builtin_amdgcn_fence(__ATOMIC_RELEASE, "agent"); asm volatile("s_waitcnt vmcnt(0)" ::: "memory"); __hip_atomic_fetch_add(done + ((early + bx) >> 2), 1u, __ATOMIC_RELAXED, __HIP_MEMORY_SCOPE_AGENT); }
                }
                { size_t z2 = 0; asm volatile("" : "+s"(z2)); ws = F.ws + z2; F.ws = ws; int t2 = F.tid; asm volatile("" : "+v"(t2)); F.tid = t2; F.lane = t2 & 63; }
                SchedMoe S{F.G, bx, EFF, F.MISC + 16, (const char*)(ws + A_ACTB), (const char*)(ws + A_WD), nullptr, nullptr, false, 3, early, rem, done};
                EpiBf16 E{(bf16_t*)(ws + A_Y), DM, 0, 1.f};
                pg8::gemm_phase<EpiBf16, SchedMoe, true, true, EFF, EFF>(F.lds, F.tid, S, E);
            } else if (q == 12 && PHSEL(15)) ph_combine(F, a, l);
        }
        if (pp + 1 < a.ph_hi) xcd_barrier(bar);
    }
}

extern "C" void kernel_launch(void* const* d_in, const int* in_sizes, int n_in, void* d_out, int out_size, void* d_ws, size_t ws_size, hipStream_t stream) {
    static int grid = 0;
    if (grid == 0) {
        if (n_in != 20 || in_sizes[0] != MT * DM || out_size != MT * DM || ws_size < WS_END) { fprintf(stderr, "kernel_launch: unexpected shapes / workspace (%d inputs, ws %zu)\n", n_in, ws_size); grid = -1; return; }
        int dev = 0, cus = 0, per_cu = 0;
        if (hipGetDevice(&dev) != hipSuccess || hipDeviceGetAttribute(&cus, hipDeviceAttributeMultiprocessorCount, dev) != hipSuccess) { grid = -1; return; }
        if (hipFuncSetAttribute((const void*)fwd, hipFuncAttributeMaxDynamicSharedMemorySize, LDS_BYTES) != hipSuccess) { grid = -1; return; }
        if (hipOccupancyMaxActiveBlocksPerMultiprocessor(&per_cu, (const void*)fwd, NTHR, LDS_BYTES) != hipSuccess || per_cu < 1) { fprintf(stderr, "kernel_launch: occupancy query says %d\n", per_cu); per_cu = 1; }
        (void)hipGetLastError();
        grid = cus * 1;
    }
    if (grid < 0) return;
    (void)hipMemsetAsync((char*)d_ws + WS_CTL, 0, CTL_ZERO_BYTES, stream);
    Args a{};
    for (int i = 0; i < 20; ++i) a.in[i] = d_in[i];
    a.out = (float*)d_out; a.ws = (unsigned char*)d_ws;
#if MK_PER_PHASE
    for (int ph = 0; ph < NPHASE; ++ph) { a.ph_lo = ph; a.ph_hi = ph + 1; hipLaunchKernelGGL(fwd, dim3(grid), dim3(NTHR), LDS_BYTES, stream, a); }
#else
    a.ph_lo = 0; a.ph_hi = NPHASE;
    void* kargs[] = {&a};
    hipError_t e = hipLaunchCooperativeKernel((const void*)fwd, dim3(grid), dim3(NTHR), kargs, LDS_BYTES, stream);
    if (e != hipSuccess) fprintf(stderr, "cooperative launch failed: %s (grid %d)\n", hipGetErrorString(e), grid);
#endif
}
```

```cpp
#include <hip/hip_runtime.h>
#include <cstdio>
#include <cstdint>

#ifndef PH_MASK
#define PH_MASK 0xFFFFFFFFu
#endif
#define PHSEL(n) ((PH_MASK >> (n)) & 1u)
#ifndef PROBE_ATT_N
#define PROBE_ATT_N 1
#endif
#ifndef PROBE_HGC_N
#define PROBE_HGC_N 1
#endif
#ifndef PROBE_HGA_N
#define PROBE_HGA_N 1
#endif
#ifndef PROBE_PREP_N
#define PROBE_PREP_N 1
#endif
#ifndef PROBE_HGC_STOP
#define PROBE_HGC_STOP 0
#endif
#ifndef PROBE_P
#define PROBE_P -1
#endif
#ifndef PROBE_N
#define PROBE_N 1
#endif
#ifndef HG_A_GOLDEN
#define HG_A_GOLDEN 0
#endif
#ifndef HG_C_GOLDEN
#define HG_C_GOLDEN 0
#endif
#ifndef ATT_GOLDEN
#define ATT_GOLDEN 0
#endif
#ifndef MK_PER_PHASE
#define MK_PER_PHASE 0
#endif

#define LAS __attribute__((address_space(3)))
#define GAS __attribute__((address_space(1)))
typedef unsigned short bf16_t;
typedef short bf16x8 __attribute__((ext_vector_type(8)));
typedef float f32x4 __attribute__((ext_vector_type(4)));
typedef float f32x2 __attribute__((ext_vector_type(2)));
typedef unsigned u32x4 __attribute__((ext_vector_type(4)));
typedef unsigned u32x2 __attribute__((ext_vector_type(2)));
typedef GAS unsigned gu32;

constexpr int BATCH = 2, SEQ = 8192, DM = 1024, MT = BATCH * SEQ, DEPTH = 2;
constexpr int MEM_LEN = 256, MEMROWS = BATCH * MEM_LEN;
constexpr int NIN = 3584, HGW = 512, HGH = 4, HGD = 128, CHUNK = 64, NCHUNK = SEQ / CHUNK;
constexpr int ATW = 512, ATH = 8, ATD = 64;
constexpr int NEXP = 16, EFF = 512;
constexpr float EPS = 1e-6f;
constexpr int NWAVES = 8, NTHR = 512;

constexpr size_t MiB = 1u << 20;
constexpr size_t WS_CTL = 0, CTL_ZERO_BYTES = 1 * MiB;
constexpr size_t WS_RSTD = 1 * MiB;
constexpr size_t WS_TOKE = WS_RSTD + 64 * 1024;
constexpr size_t WS_TOKW = WS_TOKE + 128 * 1024;
constexpr size_t WS_TOKL = WS_TOKW + 128 * 1024;
constexpr size_t WS_SLOTRS = WS_TOKL + 128 * 1024;
constexpr size_t WS_SLOTGW = WS_SLOTRS + 160 * 1024;
constexpr size_t WS_PERM = WS_SLOTGW + 160 * 1024;
constexpr size_t WS_WR = 3 * MiB;
constexpr size_t WS_LBT = 3 * MiB + 256 * 1024;
constexpr size_t WS_SSQP = 3 * MiB + 512 * 1024;
constexpr size_t WS_XB = 4 * MiB;
constexpr size_t WS_WIN = 36 * MiB;
constexpr size_t WS_WOUT = 50 * MiB;
constexpr size_t WS_WQS = 54 * MiB;
constexpr size_t WS_WKVT = 58 * MiB;
constexpr size_t WS_WOT = 66 * MiB;
constexpr size_t WS_MEMN = 70 * MiB;
constexpr size_t WS_KV = 72 * MiB;
constexpr size_t WS_WQK = 76 * MiB;
constexpr size_t WS_WVO = 84 * MiB;
constexpr size_t WS_ACT = 92 * MiB;
constexpr size_t WS_CS = 320 * MiB;
constexpr size_t WS_END = 324 * MiB;
constexpr size_t A_HG = WS_ACT + 0 * MiB;
constexpr size_t A_KF1 = WS_ACT + 64 * MiB;
constexpr size_t A_KF4 = WS_ACT + 80 * MiB;
constexpr size_t A_KF16 = WS_ACT + 96 * MiB;
constexpr size_t A_QR = WS_ACT + 112 * MiB;
constexpr size_t A_V = WS_ACT + 128 * MiB;
constexpr size_t A_VT1 = WS_ACT + 144 * MiB;
constexpr size_t A_VT4 = WS_ACT + 160 * MiB;
constexpr size_t A_VT16 = WS_ACT + 176 * MiB;
constexpr size_t A_STATE = WS_ACT + 192 * MiB;
constexpr size_t A_DECAY = WS_ACT + 224 * MiB;
constexpr size_t A_XB2 = WS_ACT + 0 * MiB;
constexpr size_t A_P = WS_ACT + 32 * MiB;
constexpr size_t A_WGU = WS_ACT + 0 * MiB;
constexpr size_t A_WD = WS_ACT + 32 * MiB;
constexpr size_t A_PERM2 = WS_ACT + 48 * MiB;
constexpr size_t A_SRS2 = WS_ACT + 49 * MiB;
constexpr size_t A_SGW2 = WS_ACT + 50 * MiB;
constexpr size_t A_ACTB = WS_ACT + 120 * MiB;
constexpr size_t A_Y = WS_ACT + 156 * MiB;
constexpr int MAXSLOT = 2 * MT + NEXP * 256;
static_assert(A_Y + (size_t)MAXSLOT * 1024 * 2 <= WS_END, "ws map");
constexpr int CW_BAR = 4096;
constexpr int CW_KMAX = 12288;
constexpr int CW_DONE = 24576;
constexpr int CW_CNT = 16384;
constexpr int RING_BYTES = 131072;
constexpr int SPARE_OFF = RING_BYTES;
constexpr int LDSCTL_OFF = RING_BYTES + 8192, MISC_OFF = LDSCTL_OFF + 64;
constexpr int LDS_BYTES = 147456;

#define RLX_AGENT __ATOMIC_RELAXED, __HIP_MEMORY_SCOPE_AGENT
#define LDS_WAIT() asm volatile("s_waitcnt lgkmcnt(0)" ::: "memory")
#define VM_WAIT() asm volatile("s_waitcnt vmcnt(0)" ::: "memory")

__device__ __forceinline__ unsigned f2bf(float f) { unsigned u = __builtin_bit_cast(unsigned, f); return (u + 0x7fffu + ((u >> 16) & 1u)) >> 16; }
__device__ __forceinline__ unsigned pk2(float lo, float hi) { return f2bf(lo) | (f2bf(hi) << 16); }
__device__ __forceinline__ float bf2f(unsigned short h) { return __builtin_bit_cast(float, (unsigned)h << 16); }
__device__ __forceinline__ float bflo(unsigned w) { return __builtin_bit_cast(float, w << 16); }
__device__ __forceinline__ float bfhi(unsigned w) { return __builtin_bit_cast(float, w & 0xffff0000u); }
typedef __bf16 bf16x2_t __attribute__((ext_vector_type(2)));
__device__ __forceinline__ unsigned cvt_pk_bf16(float lo, float hi) { f32x2 v = {lo, hi}; bf16x2_t b = __builtin_convertvector(v, bf16x2_t); return __builtin_bit_cast(unsigned, b); }
__device__ __forceinline__ float wave_sum(float v) {
#pragma unroll
    for (int o = 1; o < 64; o <<= 1) v += __shfl_xor(v, o);
    return v;
}
__device__ __forceinline__ float sigmoidf_(float z) { return __builtin_amdgcn_rcpf(1.f + __builtin_amdgcn_exp2f(-1.4426950408889634f * z)); }
__device__ __forceinline__ float ex2(float x) { return __builtin_amdgcn_exp2f(x); }
constexpr float LOG2E = 1.4426950408889634f;

#define XB_TMO      128
#define XB_XCNT(j)  (256  + 64 * (j))
#define XB_XSUB(j)  (1280 + 64 * (j))
#define XB_XGEN(j)  (2304 + 64 * (j))
#define XB_TOP      3328
#define XB_TOPGEN   3392
#define XCD_BAR_WORDS 3456
#define XB_SPIN_CAP (1u << 18)
__device__ __forceinline__ unsigned xb_ld(unsigned* p)              { return __hip_atomic_load(p, __ATOMIC_RELAXED, __HIP_MEMORY_SCOPE_AGENT); }
__device__ __forceinline__ unsigned xb_add(unsigned* p, unsigned v) { return __hip_atomic_fetch_add(p, v, __ATOMIC_RELAXED, __HIP_MEMORY_SCOPE_AGENT); }
__device__ __forceinline__ unsigned xb_xcc_id() { return (unsigned)__builtin_amdgcn_s_getreg((3 << 11) | 20) & 0xFu; }
#define XB_SPIN(cond, bar) do { unsigned _sp = 0; while (cond) { __builtin_amdgcn_s_sleep(1); \
    if ((++_sp & 255u) == 0u) { if (xb_ld(&(bar)[XB_TMO])) break; if (_sp > XB_SPIN_CAP) { atomicAdd(&(bar)[XB_TMO], 1u); break; } } } } while (0)
struct XcdBarrier { unsigned* bar; unsigned x; volatile LAS unsigned* st; };
__device__ __forceinline__ XcdBarrier xcd_barrier_post(unsigned* bar, volatile LAS unsigned* st) {
    XcdBarrier b; b.bar = bar; b.x = xb_xcc_id(); b.st = st;
    if (threadIdx.x == 0) (void)xb_add(&bar[XB_XCNT(b.x)], 1u);
    return b;
}
__device__ __forceinline__ void xcd_barrier_complete(unsigned* bar, unsigned x, unsigned& nloc, unsigned& nx) {
    const unsigned G = gridDim.x * gridDim.y * gridDim.z;
    unsigned sum, cnt, mine, sp = 0u;
    for (;;) {
        sum = 0u; cnt = 0u; mine = 0u;
        unsigned cv[16];
#pragma unroll
        for (unsigned j = 0; j < 16; ++j) cv[j] = xb_ld(&bar[XB_XCNT(j)]);
#pragma unroll
        for (unsigned j = 0; j < 16; ++j) { const unsigned c = cv[j]; sum += c; cnt += (c > 0u) ? 1u : 0u; mine = (j == x) ? c : mine; }
        if (sum == G) break;
        __builtin_amdgcn_s_sleep(1);
        if ((++sp & 255u) == 0u) { if (xb_ld(&bar[XB_TMO])) break; if (sp > XB_SPIN_CAP) { atomicAdd(&bar[XB_TMO], 1u); break; } }
    }
    nloc = mine > 0u ? mine : 1u; nx = cnt > 0u ? cnt : 1u;
}
__device__ __forceinline__ void xcd_barrier(const XcdBarrier& b) {
    asm volatile("s_waitcnt vmcnt(0)" ::: "memory");
    __syncthreads();
    if (threadIdx.x == 0) {
        unsigned* bar = b.bar;
        __builtin_amdgcn_s_waitcnt(0);
        unsigned nloc = b.st[0], nx = b.st[1];
        if (nloc == 0u) { xcd_barrier_complete(bar, b.x, nloc, nx); b.st[0] = nloc; b.st[1] = nx; }
        const unsigned old = xb_add(&bar[XB_XSUB(b.x)], 1u);
        const unsigned gen = old / nloc;
        if (old + 1u == (gen + 1u) * nloc) {
            __builtin_amdgcn_fence(__ATOMIC_RELEASE, "agent");
            asm volatile("s_waitcnt vmcnt(0)" ::: "memory");
            const unsigned og = xb_add(&bar[XB_TOP], 1u);
            const unsigned tg = og / nx;
            if (og + 1u == (tg + 1u) * nx) xb_add(&bar[XB_TOPGEN], 1u);
            else XB_SPIN(xb_ld(&bar[XB_TOPGEN]) == tg, bar);
            __builtin_amdgcn_fence(__ATOMIC_ACQUIRE, "agent");
            xb_add(&bar[XB_XGEN(b.x)], 1u);
            asm volatile("s_waitcnt vmcnt(0)" ::: "memory");
        } else {
            XB_SPIN(xb_ld(&bar[XB_XGEN(b.x)]) == gen, bar);
            __builtin_amdgcn_fence(__ATOMIC_ACQUIRE, "agent");
            asm volatile("s_waitcnt vmcnt(0)" ::: "memory");
        }
    }
    __syncthreads();
}

namespace pg8 {
constexpr int BM = 256, BK = 64, HALF = 128, HTB = HALF * BK * 2, STAGE_BYTES = 8 * HTB, NXCD = 8, WGM = 8;
__host__ __device__ __forceinline__ int lds_byte(int r, int c) { const int st = (r >> 4) * 2 + (c >> 5), rr = r & 15, cc = c & 31, ob = rr * 64 + cc * 2; return st * 1024 + (ob ^ (((ob >> 9) & 1) << 5)); }
__host__ __device__ __forceinline__ void stage_rc(int b, int& R, int& C) { const int st = b / 1024, sb = b % 1024, swz = sb ^ (((sb >> 9) & 1) << 5); R = (st >> 1) * 16 + swz / 64; C = (st & 1) * 32 + (swz % 64) / 2; }
__host__ __device__ __forceinline__ int perm32(int rho) { const int n = rho >> 4, i = rho & 15; return 8 * (i >> 2) + 4 * n + (i & 3); }

struct Unit { int pm, pn, aux, lr; const char* a; const char* b; };
typedef f32x4 Acc[2][2][4][2];

template <class Epi, class Sched, bool ALIGN_EPI, bool SP2, int LD, int K, bool GATHER = false>
__device__ __forceinline__ void gemm_phase(LAS unsigned char* lds, const int tid, const Sched& S, const Epi& E) {
    constexpr int lda = LD, ldb = LD;
    const int wid = __builtin_amdgcn_readfirstlane(tid >> 6), lane = tid & 63, wr = wid >> 2, wc = wid & 3, fr = lane & 15, fq = lane >> 4;
    constexpr int nt = K / BK;
    unsigned voffA[2], voffB[2];
#pragma unroll
    for (int i = 0; i < 2; ++i) { int R, C; stage_rc(tid * 16 + i * 8192, R, C); const int Rb = Epi::PERM ? ((R & ~31) + perm32(R & 31)) : R;
        voffA[i] = (unsigned)(R * lda + C) * 2u; voffB[i] = (unsigned)(Rb * ldb + C) * 2u; }
    const size_t kstep = (size_t)(BK * 2);
    const size_t hstepA = (size_t)HALF * lda * 2, hstepB = (size_t)HALF * ldb * 2;
    const unsigned ldsw = (unsigned)wid * 1024u;
    const int aoff = lds_byte(wr * 64 + fr, fq * 8), boff = lds_byte(wc * 32 + fr, fq * 8);
#define PG8_SA(b, h) (((b) * 2 + (h)) * HTB)
#define PG8_SB(b, h) ((4 + (b) * 2 + (h)) * HTB)
#define PG8_STAGE(bufoff, gbase, voff) do { _Pragma("unroll") for (int _i = 0; _i < 2; ++_i) \
        __builtin_amdgcn_global_load_lds((const unsigned*)((const char*)(gbase) + (voff)[_i]), (LAS unsigned*)(lds + (bufoff) + ldsw + _i * 8192), 16, 0, 0); } while (0)
#define PG8_STAGE_A(bufoff, gbase, half, usenext) do { if constexpr (GATHER) { const unsigned _p = (usenext) ? vn[half] : vc[half]; unsigned _v[2]; _v[0] = (_p & 0xffffu) * (unsigned)(lda * 2) + gc2; _v[1] = (_p >> 16) * (unsigned)(lda * 2) + gc2; PG8_STAGE(bufoff, gbase, _v); } \
        else { PG8_STAGE(bufoff, (gbase) + (half) * hstepA, voffA); } } while (0)
#define PG8_LDA(dst, b, h) do { _Pragma("unroll") for (int m = 0; m < 4; ++m) _Pragma("unroll") for (int k = 0; k < 2; ++k) dst[m][k] = *(const LAS bf16x8*)(lds + PG8_SA(b, h) + aoff + m * 2048 + k * 1024); } while (0)
#define PG8_LDB(dst, b, h) do { _Pragma("unroll") for (int n = 0; n < 2; ++n) _Pragma("unroll") for (int k = 0; k < 2; ++k) dst[n][k] = *(const LAS bf16x8*)(lds + PG8_SB(b, h) + boff + n * 2048 + k * 1024); } while (0)
#define PG8_MMA(ai, bj, At, Bt) do { __builtin_amdgcn_s_setprio(1); _Pragma("unroll") for (int m = 0; m < 4; ++m) _Pragma("unroll") for (int n = 0; n < 2; ++n) _Pragma("unroll") for (int k = 0; k < 2; ++k) \
        acc[ai][bj][m][n] = __builtin_amdgcn_mfma_f32_16x16x32_bf16(Bt[n][k], At[m][k], acc[ai][bj][m][n], 0, 0, 0); __builtin_amdgcn_s_setprio(0); } while (0)
#define PG8_WAIT_V(n) asm volatile("s_waitcnt vmcnt(" #n ")" ::: "memory")
#define PG8_WAIT_L(n) asm volatile("s_waitcnt lgkmcnt(" #n ")" ::: "memory")
#define PG8_BAR __builtin_amdgcn_s_barrier()
#define PG8_SCHED __builtin_amdgcn_sched_barrier(0)
    Unit cur, nxt; int ui = 0;
    if (!S.next(0, cur)) return;
    Acc acc;
#pragma unroll
    for (int a = 0; a < 2; ++a)
#pragma unroll
        for (int b = 0; b < 2; ++b)
#pragma unroll
            for (int m = 0; m < 4; ++m)
#pragma unroll
                for (int n = 0; n < 2; ++n) acc[a][b][m][n] = (f32x4){0.f, 0.f, 0.f, 0.f};
    bf16x8 At[4][2], B0[2][2], B1[2][2];
    const char* cA = cur.a; const char* cB = cur.b;
    unsigned vc[2], vn[2], gc2 = 0;
    if constexpr (GATHER) { int R0, C0; stage_rc(tid * 16, R0, C0); gc2 = (unsigned)C0 * 2u;
#pragma unroll
        for (int h = 0; h < 2; ++h) { vc[h] = (unsigned)S.src_row(cur, 128 * h + R0) | ((unsigned)S.src_row(cur, 128 * h + R0 + 64) << 16); vn[h] = vc[h]; }
    }
    static_assert(SP2, "only the two-MFMA-blocks-per-barrier-pair loop is kept");
    {
        PG8_STAGE(PG8_SB(0, 0), cB, voffB); PG8_STAGE(PG8_SB(0, 1), cB + hstepB, voffB); PG8_STAGE_A(PG8_SA(0, 0), cA, 0, false); PG8_STAGE_A(PG8_SA(0, 1), cA, 1, false);
        if (wr == 1) PG8_BAR;
        PG8_WAIT_V(2); PG8_BAR;
        PG8_STAGE(PG8_SB(1, 0), cB + kstep, voffB); PG8_STAGE_A(PG8_SA(1, 0), cA + kstep, 0, false); PG8_STAGE(PG8_SB(1, 1), cB + hstepB + kstep, voffB);
        PG8_WAIT_V(6); PG8_BAR;
    }
    for (;;) {
        const bool has_next = S.next(ui + 1, nxt);
        const char* nA = has_next ? nxt.a : cA; const char* nB = has_next ? nxt.b : cB;
        if constexpr (GATHER) { if (has_next) { int R0, C0; stage_rc(tid * 16, R0, C0);
#pragma unroll
            for (int h = 0; h < 2; ++h) vn[h] = (unsigned)S.src_row(nxt, 128 * h + R0) | ((unsigned)S.src_row(nxt, 128 * h + R0 + 64) << 16); } }
#pragma nounroll
        for (int t = 0; t < nt; t += 2) {
            const bool last = (t == nt - 2);
            const char* a1 = cA + (size_t)(t + 1) * kstep;
            const char* a2 = last ? nA : cA + (size_t)(t + 2) * kstep; const char* b2 = last ? nB : cB + (size_t)(t + 2) * kstep;
            const char* a3 = a2 + kstep; const char* b3 = b2 + kstep;
            {
            PG8_LDB(B0, 0, 0); PG8_LDB(B1, 0, 1); PG8_SCHED; PG8_LDA(At, 0, 0); PG8_STAGE_A(PG8_SA(1, 1), a1, 1, false);
            PG8_WAIT_V(8); PG8_WAIT_L(0); PG8_BAR; PG8_MMA(0, 0, At, B0); PG8_MMA(0, 1, At, B1); PG8_BAR; PG8_SCHED;
            PG8_LDA(At, 0, 1); PG8_STAGE(PG8_SB(0, 0), b2, voffB); PG8_STAGE(PG8_SB(0, 1), b2 + hstepB, voffB); PG8_STAGE_A(PG8_SA(0, 0), a2, 0, last);
            PG8_WAIT_V(8); PG8_WAIT_L(0); PG8_BAR; PG8_MMA(1, 0, At, B0); PG8_MMA(1, 1, At, B1); PG8_BAR; PG8_SCHED;
            PG8_LDB(B0, 1, 0); PG8_LDB(B1, 1, 1); PG8_SCHED; PG8_LDA(At, 1, 0); PG8_STAGE_A(PG8_SA(0, 1), a2, 1, last);
            PG8_WAIT_V(8); PG8_WAIT_L(0); PG8_BAR; PG8_MMA(0, 0, At, B0); PG8_MMA(0, 1, At, B1); PG8_BAR; PG8_SCHED;
            PG8_LDA(At, 1, 1); PG8_STAGE(PG8_SB(1, 0), b3, voffB); PG8_STAGE(PG8_SB(1, 1), b3 + hstepB, voffB); PG8_STAGE_A(PG8_SA(1, 0), a3, 0, last);
            PG8_WAIT_V(8); PG8_WAIT_L(0); PG8_BAR; PG8_MMA(1, 0, At, B0); PG8_MMA(1, 1, At, B1); PG8_BAR; PG8_SCHED;
            }
        }
        if constexpr (ALIGN_EPI) { if (wr == 0) PG8_BAR; }
        E(acc, cur, wr, wc, fr, fq, lds);
        if (!has_next) break;
#pragma unroll
        for (int a = 0; a < 2; ++a)
#pragma unroll
            for (int b = 0; b < 2; ++b)
#pragma unroll
                for (int m = 0; m < 4; ++m)
#pragma unroll
                    for (int n = 0; n < 2; ++n) acc[a][b][m][n] = (f32x4){0.f, 0.f, 0.f, 0.f};
        cur = nxt; cA = nA; cB = nB; ++ui;
        if constexpr (GATHER) { vc[0] = vn[0]; vc[1] = vn[1]; }
        if constexpr (ALIGN_EPI) { if (wr == 1) PG8_BAR; }
    }
    PG8_WAIT_V(0);
    if constexpr (!ALIGN_EPI) { if (wr == 0) PG8_BAR; }
    PG8_BAR;
#undef PG8_SA
#undef PG8_SB
#undef PG8_STAGE
#undef PG8_STAGE_A
#undef PG8_LDA
#undef PG8_LDB
#undef PG8_MMA
#undef PG8_WAIT_V
#undef PG8_WAIT_L
#undef PG8_BAR
#undef PG8_SCHED
}

struct SchedDense {
    int nM, nN, nwg, G, c; const char* A; const char* B; size_t a_tile, b_tile; int pm_per_batch; size_t b_batch;
    __device__ __forceinline__ bool next(int i, Unit& u) const {
        const long L = (long)i * G + c; if (L >= nwg) return false;
        int wgid = (int)L; { const int q = nwg / NXCD, r = nwg % NXCD, xcd = wgid % NXCD, off = wgid / NXCD; wgid = (xcd < r ? xcd * (q + 1) : r * (q + 1) + (xcd - r) * q) + off; }
        const int nig = WGM * nN, gid = wgid / nig, fm = gid * WGM, gsz = (nM - fm) < WGM ? (nM - fm) : WGM;
        u.pm = fm + ((wgid % nig) % gsz); u.pn = (wgid % nig) / gsz; u.aux = 0;
        u.a = A + (size_t)u.pm * a_tile; u.b = B + (size_t)u.pn * b_tile + (size_t)(u.pm / pm_per_batch) * b_batch; return true;
    }
};
}
using pg8::Unit; using pg8::Acc;

struct EpiBf16 {
    static constexpr bool PERM = true;
    bf16_t* O; int ldc; size_t aux_stride; float scale;
    __device__ __forceinline__ void operator()(const Acc& acc, const Unit& u, int wr, int wc, int fr, int fq, LAS unsigned char*) const {
        bf16_t* base = O + (size_t)u.aux * aux_stride;
        const int row0 = u.pm * 256 + wr * 64 + fr, col0 = u.pn * 256 + wc * 32 + 8 * fq;
#pragma unroll
        for (int ai = 0; ai < 2; ++ai)
#pragma unroll
            for (int m = 0; m < 4; ++m) { bf16_t* rowp = base + (size_t)(row0 + ai * 128 + m * 16) * ldc + col0;
#pragma unroll
                for (int bj = 0; bj < 2; ++bj) { const f32x4 v0 = acc[ai][bj][m][0] * scale, v1 = acc[ai][bj][m][1] * scale;
                    u32x4 w; w.x = cvt_pk_bf16(v0[0], v0[1]); w.y = cvt_pk_bf16(v0[2], v0[3]); w.z = cvt_pk_bf16(v1[0], v1[1]); w.w = cvt_pk_bf16(v1[2], v1[3]);
                    *(u32x4*)(rowp + bj * 128) = w; } }
    }
};
struct EpiKV {
    static constexpr bool PERM = true;
    bf16_t* KB; bf16_t* VB;
    __device__ __forceinline__ void operator()(const Acc& acc, const Unit& u, int wr, int wc, int fr, int fq, LAS unsigned char*) const {
        bf16_t* base = (u.pn < 4 ? KB : VB) + (size_t)u.aux * MEMROWS * DM;
        const int row0 = u.pm * 256 + wr * 64 + fr, col0 = (u.pn & 3) * 256 + wc * 32 + 8 * fq;
#pragma unroll
        for (int ai = 0; ai < 2; ++ai)
#pragma unroll
            for (int m = 0; m < 4; ++m) { bf16_t* rowp = base + (size_t)(row0 + ai * 128 + m * 16) * DM + col0;
#pragma unroll
                for (int bj = 0; bj < 2; ++bj) { const f32x4 v0 = acc[ai][bj][m][0], v1 = acc[ai][bj][m][1];
                    u32x4 w; w.x = cvt_pk_bf16(v0[0], v0[1]); w.y = cvt_pk_bf16(v0[2], v0[3]); w.z = cvt_pk_bf16(v1[0], v1[1]); w.w = cvt_pk_bf16(v1[2], v1[3]);
                    *(u32x4*)(rowp + bj * 128) = w; } }
    }
};
struct EpiProj {
    static constexpr bool PERM = true;
    bf16_t* HG; bf16_t* QR; bf16_t* KF; bf16_t* V; const float* rstd; const f32x2* CS; unsigned* kmax;
    __device__ __forceinline__ void operator()(const Acc& acc, const Unit& u, int wr, int wc, int fr, int fq, LAS unsigned char*) const {
        const int row0 = u.pm * 256 + wr * 64 + fr;
        float rsv[2][4];
#pragma unroll
        for (int ai = 0; ai < 2; ++ai)
#pragma unroll
            for (int m = 0; m < 4; ++m) rsv[ai][m] = rstd[row0 + ai * 128 + m * 16];
        if (u.pn < 8 || u.pn >= 12) {
            bf16_t* base; int ldc, colt;
            if (u.pn < 8) { base = HG; ldc = 2048; colt = u.pn * 256; } else { base = V; ldc = 512; colt = (u.pn - 12) * 256; }
            const int col0 = colt + wc * 32 + 8 * fq;
#pragma unroll
            for (int ai = 0; ai < 2; ++ai)
#pragma unroll
                for (int m = 0; m < 4; ++m) { const int row = row0 + ai * 128 + m * 16; const float rs = rsv[ai][m]; bf16_t* rowp = base + (size_t)row * ldc + col0;
#pragma unroll
                    for (int bj = 0; bj < 2; ++bj) { const f32x4 v0 = acc[ai][bj][m][0] * rs, v1 = acc[ai][bj][m][1] * rs;
                        u32x4 w; w.x = cvt_pk_bf16(v0[0], v0[1]); w.y = cvt_pk_bf16(v0[2], v0[3]); w.z = cvt_pk_bf16(v1[0], v1[1]); w.w = cvt_pk_bf16(v1[2], v1[3]);
                        *(u32x4*)(rowp + bj * 128) = w; } }
        } else {
            const bool isk = u.pn >= 10; const int head = 4 * (u.pn & 1) + wc;
            float kn2max = 0.f;
#pragma unroll
            for (int am = 0; am < 4; ++am) { const int ai = am >> 1;
                f32x4 csv[2][4];
#pragma unroll
                for (int mm = 0; mm < 2; ++mm) { const int m = 2 * (am & 1) + mm; const f32x4* cs = (const f32x4*)(CS + (size_t)(row0 + ai * 128 + m * 16) * 32 + 8 * fq); csv[mm][0] = cs[0]; csv[mm][1] = cs[1]; csv[mm][2] = cs[2]; csv[mm][3] = cs[3]; }
#pragma unroll
                for (int mm = 0; mm < 2; ++mm) { const int m = 2 * (am & 1) + mm; const int row = row0 + ai * 128 + m * 16; const float rs = rsv[ai][m] * (isk ? 1.f : 0.125f * LOG2E);
                    const f32x4 c0 = csv[mm][0], c1 = csv[mm][1], c2 = csv[mm][2], c3 = csv[mm][3];
                    const float co[8] = {c0.x, c0.z, c1.x, c1.z, c2.x, c2.z, c3.x, c3.z}, si[8] = {c0.y, c0.w, c1.y, c1.w, c2.y, c2.w, c3.y, c3.w};
                    float lo[8], hi[8];
#pragma unroll
                    for (int n = 0; n < 2; ++n)
#pragma unroll
                        for (int e = 0; e < 4; ++e) { const int j = 4 * n + e; const float x1 = acc[ai][0][m][n][e] * rs, x2 = acc[ai][1][m][n][e] * rs; lo[j] = x1 * co[j] - x2 * si[j]; hi[j] = x2 * co[j] + x1 * si[j]; }
                    u32x4 wl, wh; wl.x = cvt_pk_bf16(lo[0], lo[1]); wl.y = cvt_pk_bf16(lo[2], lo[3]); wl.z = cvt_pk_bf16(lo[4], lo[5]); wl.w = cvt_pk_bf16(lo[6], lo[7]);
                    wh.x = cvt_pk_bf16(hi[0], hi[1]); wh.y = cvt_pk_bf16(hi[2], hi[3]); wh.z = cvt_pk_bf16(hi[4], hi[5]); wh.w = cvt_pk_bf16(hi[6], hi[7]);
                    if (!isk) { bf16_t* rowp = QR + (size_t)row * 512 + head * 64 + 8 * fq; *(u32x4*)rowp = wl; *(u32x4*)(rowp + 32) = wh; }
                    else { { float n2 = 0.f;
#pragma unroll
                          for (int j = 0; j < 8; ++j) n2 += lo[j] * lo[j] + hi[j] * hi[j];
                          n2 += __shfl_xor(n2, 16); n2 += __shfl_xor(n2, 32); kn2max = fmaxf(kn2max, n2); }
                        const int b = row >> 13, s = row & (SEQ - 1); const size_t bh = (size_t)(b * ATH + head) * (SEQ * 64);
#pragma unroll
                        for (int pat = 0; pat < 3; ++pat) { const int D = pat == 0 ? 1 : (pat == 1 ? 4 : 16), sh = pat * 2; const int r = s & (D - 1), p = s >> sh, T = p >> 5, k5 = p & 31;
                            const int rho = (k5 & 19) | ((k5 & 4) << 1) | ((k5 & 8) >> 1);
                            bf16_t* kf = KF + (size_t)pat * (MT * 512) + bh + ((size_t)(r * (SEQ / 32 >> sh) + T) * 4) * 512;
                            *(u32x4*)(kf + ((fq >> 1) * 64 + rho + 32 * (fq & 1)) * 8) = wl; *(u32x4*)(kf + ((2 + (fq >> 1)) * 64 + rho + 32 * (fq & 1)) * 8) = wh; }
                    } } }
            if (isk) { kn2max = fmaxf(kn2max, __shfl_xor(kn2max, 1)); kn2max = fmaxf(kn2max, __shfl_xor(kn2max, 2)); kn2max = fmaxf(kn2max, __shfl_xor(kn2max, 4)); kn2max = fmaxf(kn2max, __shfl_xor(kn2max, 8));
                if (fr == 0 && fq == 0) __hip_atomic_fetch_max(kmax + ((u.pm >> 5) * ATH + head), __float_as_uint(kn2max), __ATOMIC_RELAXED, __HIP_MEMORY_SCOPE_AGENT); }
        }
    }
};
struct EpiResAdd {
    static constexpr bool PERM = false;
    const float* Xs; float* X; float dm;
    __device__ __forceinline__ void operator()(const Acc& acc, const Unit& u, int wr, int wc, int fr, int fq, LAS unsigned char*) const {
        const int row0 = u.pm * 256 + wr * 64 + fr, col0 = u.pn * 256 + wc * 32 + 4 * fq;
#pragma unroll
        for (int ai = 0; ai < 2; ++ai) {
            f32x4 xv[4][2][2];
#pragma unroll
            for (int m = 0; m < 4; ++m) { const size_t off = (size_t)(row0 + ai * 128 + m * 16) * DM + col0;
#pragma unroll
                for (int bj = 0; bj < 2; ++bj)
#pragma unroll
                    for (int n = 0; n < 2; ++n) xv[m][bj][n] = *(const f32x4*)(Xs + off + bj * 128 + n * 16); }
            asm volatile("" ::: "memory");
#pragma unroll
            for (int m = 0; m < 4; ++m) { const size_t off = (size_t)(row0 + ai * 128 + m * 16) * DM + col0;
#pragma unroll
                for (int bj = 0; bj < 2; ++bj)
#pragma unroll
                    for (int n = 0; n < 2; ++n) *(f32x4*)(X + off + bj * 128 + n * 16) = xv[m][bj][n] + acc[ai][bj][m][n] * dm; }
        }
    }
};
struct EpiResAddB {
    static constexpr bool PERM = false;
    const bf16_t* XBs; bf16_t* XBo;
    __device__ __forceinline__ void operator()(const Acc& acc, const Unit& u, int wr, int wc, int fr, int fq, LAS unsigned char*) const {
        const int row0 = u.pm * 256 + wr * 64 + fr, col0 = u.pn * 256 + wc * 32 + 4 * fq;
#pragma unroll
        for (int ai = 0; ai < 2; ++ai) {
            u32x2 xv[4][2][2];
#pragma unroll
            for (int m = 0; m < 4; ++m) { const size_t off = (size_t)(row0 + ai * 128 + m * 16) * DM + col0;
#pragma unroll
                for (int bj = 0; bj < 2; ++bj)
#pragma unroll
                    for (int n = 0; n < 2; ++n) xv[m][bj][n] = *(const u32x2*)(XBs + off + bj * 128 + n * 16); }
            asm volatile("" ::: "memory");
#pragma unroll
            for (int m = 0; m < 4; ++m) { const size_t off = (size_t)(row0 + ai * 128 + m * 16) * DM + col0;
#pragma unroll
                for (int bj = 0; bj < 2; ++bj)
#pragma unroll
                    for (int n = 0; n < 2; ++n) { const u32x2 w = xv[m][bj][n]; const f32x4 a4 = acc[ai][bj][m][n];
                        u32x2 o; o.x = cvt_pk_bf16(bflo(w.x) + a4[0], bfhi(w.x) + a4[1]); o.y = cvt_pk_bf16(bflo(w.y) + a4[2], bfhi(w.y) + a4[3]);
                        *(u32x2*)(XBo + off + bj * 128 + n * 16) = o; } }
        }
    }
};
struct EpiResNorm {
    static constexpr bool PERM = false;
    const float* Xs; const bf16_t* XsB; bf16_t* XB; float* SSQP;
    __device__ __forceinline__ void operator()(const Acc& acc, const Unit& u, int wr, int wc, int fr, int fq, LAS unsigned char* lds) const {
        LAS float* EX = (LAS float*)(lds + SPARE_OFF);
        const int row0 = u.pm * 256 + wr * 64 + fr, col0 = u.pn * 256 + wc * 32 + 4 * fq;
#pragma unroll
        for (int ai = 0; ai < 2; ++ai)
#pragma unroll
            for (int m = 0; m < 4; ++m) { const size_t off = (size_t)(row0 + ai * 128 + m * 16) * DM + col0; float s = 0.f;
#pragma unroll
                for (int bj = 0; bj < 2; ++bj)
#pragma unroll
                    for (int n = 0; n < 2; ++n) { f32x4 xs; if (XsB) { const u32x2 w = *(const u32x2*)(XsB + off + bj * 128 + n * 16); xs = (f32x4){bflo(w.x), bfhi(w.x), bflo(w.y), bfhi(w.y)}; } else xs = *(const f32x4*)(Xs + off + bj * 128 + n * 16);
                        const f32x4 v = xs + acc[ai][bj][m][n];
                        u32x2 w; w.x = cvt_pk_bf16(v[0], v[1]); w.y = cvt_pk_bf16(v[2], v[3]); *(u32x2*)(XB + off + bj * 128 + n * 16) = w;
                        s += (v[0] * v[0] + v[1] * v[1]) + (v[2] * v[2] + v[3] * v[3]); }
                s += __shfl_xor(s, 16); s += __shfl_xor(s, 32);
                if (fq == 0) EX[(ai * 128 + wr * 64 + m * 16 + fr) * 4 + wc] = s; }
        asm volatile("s_waitcnt lgkmcnt(0)" ::: "memory"); __builtin_amdgcn_s_barrier(); asm volatile("" ::: "memory");
        { const int t = (wr * 4 + wc) * 64 + fq * 16 + fr; if (t < 256) { const f32x4 e = *(const LAS f32x4*)(EX + t * 4); SSQP[(size_t)(u.pm * 256 + t) * 4 + u.pn] = (e.x + e.y) + (e.z + e.w); } }
        asm volatile("s_waitcnt lgkmcnt(0)" ::: "memory"); __builtin_amdgcn_s_barrier(); asm volatile("" ::: "memory");
    }
};
struct EpiSoftmax {
    static constexpr bool PERM = false;
    bf16_t* P; const float* SSQP;
    __device__ __forceinline__ void operator()(Acc& acc, const Unit& u, int wr, int wc, int fr, int fq, LAS unsigned char* lds) const {
        LAS f32x2* EX = (LAS f32x2*)(lds + SPARE_OFF);
        const int row0 = u.pm * 256 + wr * 64 + fr;
        f32x4 pqv[2][4];
#pragma unroll
        for (int ai = 0; ai < 2; ++ai)
#pragma unroll
            for (int m = 0; m < 4; ++m) pqv[ai][m] = *(const f32x4*)(SSQP + (size_t)(row0 + ai * 128 + m * 16) * 4);
        float mw[2][4];
#pragma unroll
        for (int ai = 0; ai < 2; ++ai)
#pragma unroll
            for (int m = 0; m < 4; ++m) {
                const f32x4 pq = pqv[ai][m]; const float rs = __builtin_amdgcn_rsqf(((pq.x + pq.y) + (pq.z + pq.w)) * (1.f / DM) + EPS);
                float mx = -3.0e38f;
#pragma unroll
                for (int bj = 0; bj < 2; ++bj)
#pragma unroll
                    for (int n = 0; n < 2; ++n) { f32x4 v = acc[ai][bj][m][n] * rs; acc[ai][bj][m][n] = v; mx = fmaxf(mx, fmaxf(fmaxf(v[0], v[1]), fmaxf(v[2], v[3]))); }
                mx = fmaxf(mx, __shfl_xor(mx, 16)); mx = fmaxf(mx, __shfl_xor(mx, 32));
                float sm = 0.f;
#pragma unroll
                for (int bj = 0; bj < 2; ++bj)
#pragma unroll
                    for (int n = 0; n < 2; ++n) { f32x4 v = acc[ai][bj][m][n]; v[0] = __expf(v[0] - mx); v[1] = __expf(v[1] - mx); v[2] = __expf(v[2] - mx); v[3] = __expf(v[3] - mx);
                        acc[ai][bj][m][n] = v; sm += (v[0] + v[1]) + (v[2] + v[3]); }
                sm += __shfl_xor(sm, 16); sm += __shfl_xor(sm, 32);
                mw[ai][m] = mx;
                if (fq == 0) EX[(ai * 128 + wr * 64 + m * 16 + fr) * 4 + wc] = (f32x2){mx, sm};
            }
        asm volatile("s_waitcnt lgkmcnt(0)" ::: "memory"); __builtin_amdgcn_s_barrier(); asm volatile("" ::: "memory");
#pragma unroll
        for (int ai = 0; ai < 2; ++ai)
#pragma unroll
            for (int m = 0; m < 4; ++m) {
                const int rl = ai * 128 + wr * 64 + m * 16 + fr;
                const f32x2 e0 = EX[rl * 4 + 0], e1 = EX[rl * 4 + 1], e2 = EX[rl * 4 + 2], e3 = EX[rl * 4 + 3];
                const float M = fmaxf(fmaxf(e0.x, e1.x), fmaxf(e2.x, e3.x));
                const float Ls = e0.y * __expf(e0.x - M) + e1.y * __expf(e1.x - M) + e2.y * __expf(e2.x - M) + e3.y * __expf(e3.x - M);
                const float f = __expf(mw[ai][m] - M) / Ls;
                bf16_t* rowp = P + (size_t)(row0 + ai * 128 + m * 16) * DM + u.pn * 256 + wc * 32 + 4 * fq;
#pragma unroll
                for (int bj = 0; bj < 2; ++bj)
#pragma unroll
                    for (int n = 0; n < 2; ++n) { const f32x4 v = acc[ai][bj][m][n] * f; u32x2 w; w.x = cvt_pk_bf16(v[0], v[1]); w.y = cvt_pk_bf16(v[2], v[3]);
                        *(u32x2*)(rowp + bj * 128 + n * 16) = w; }
            }
        asm volatile("s_waitcnt lgkmcnt(0)" ::: "memory"); __builtin_amdgcn_s_barrier(); asm volatile("" ::: "memory");
    }
};
struct EpiMoe1 {
    static constexpr bool PERM = true;
    bf16_t* ACTB; const float* srs; const float* sgw;
    __device__ __forceinline__ void operator()(const Acc& acc, const Unit& u, int wr, int wc, int fr, int fq, LAS unsigned char*) const {
        const int row0 = u.pm * 256 + wr * 64 + fr, col0 = u.pn * 128 + wc * 32 + 8 * fq;
        float rsv[2][4], gwv[2][4];
#pragma unroll
        for (int ai = 0; ai < 2; ++ai)
#pragma unroll
            for (int m = 0; m < 4; ++m) { const int lrow = u.aux * 16384 + u.lr + wr * 64 + fr + ai * 128 + m * 16; rsv[ai][m] = srs[lrow]; gwv[ai][m] = sgw[lrow]; }
#pragma unroll
        for (int ai = 0; ai < 2; ++ai)
#pragma unroll
            for (int m = 0; m < 4; ++m) { const int row = row0 + ai * 128 + m * 16; const float rs = rsv[ai][m], gw = gwv[ai][m] * rs;
                float o[8];
#pragma unroll
                for (int n = 0; n < 2; ++n)
#pragma unroll
                    for (int j = 0; j < 4; ++j) { const float g = acc[ai][0][m][n][j] * rs, up = acc[ai][1][m][n][j]; o[n * 4 + j] = g * sigmoidf_(g) * up * gw; }
                u32x4 w; w.x = cvt_pk_bf16(o[0], o[1]); w.y = cvt_pk_bf16(o[2], o[3]); w.z = cvt_pk_bf16(o[4], o[5]); w.w = cvt_pk_bf16(o[6], o[7]);
                *(u32x4*)(ACTB + (size_t)row * EFF + col0) = w; }
    }
};

struct Args { const void* in[20]; float* out; unsigned char* ws; int ph_lo, ph_hi; };
struct Frame {
    LAS unsigned char* lds; volatile LAS unsigned* MISC; gu32* ctl;
    int tid, lane, wave, vcu, G;
    unsigned char* ws; float* out; size_t z; int dry;
};

__device__ __forceinline__ void transpose_item(const float* W, int N, const float* scale, bf16_t* WT, int ldt, int row_base, int k0, int n0, LAS float* scr, int lane) {
    f32x4 v[8];
#pragma unroll
    for (int i = 0; i < 8; ++i) v[i] = *(const GAS f32x4*)(W + (size_t)(k0 + 8 * i + (lane >> 3)) * N + n0 + 4 * (lane & 7));
#pragma unroll
    for (int i = 0; i < 8; ++i) { const int kk = 8 * i + (lane >> 3); f32x4 x = v[i]; if (scale) x = x * scale[k0 + kk]; LAS float* d = scr + kk * 33 + 4 * (lane & 7); d[0] = x.x; d[1] = x.y; d[2] = x.z; d[3] = x.w; }
    LDS_WAIT(); asm volatile("" ::: "memory");
    const int c = lane & 7;
#pragma unroll
    for (int j = 0; j < 4; ++j) { const int n = (lane >> 3) + 8 * j; const LAS float* s = scr + (8 * c) * 33 + n;
        u32x4 o; o.x = pk2(s[0 * 33], s[1 * 33]); o.y = pk2(s[2 * 33], s[3 * 33]); o.z = pk2(s[4 * 33], s[5 * 33]); o.w = pk2(s[6 * 33], s[7 * 33]);
        *(GAS u32x4*)(WT + (size_t)(row_base + n0 + n) * ldt + k0 + 8 * c) = o; }
    LDS_WAIT(); asm volatile("" ::: "memory");
}
__device__ __forceinline__ void transpose_mat_item(const float* W, int K, int N, const float* scale, bf16_t* WT, int mode, int it, LAS float* scr, int lane) {
    const int nblk = N / 32, kb = it / nblk, nb = it % nblk, k0 = 64 * kb, n0 = 32 * nb;
    int row_base = 0;
    if (mode == 1 || mode == 2) row_base = 256 * (n0 / 128) + (n0 % 128) + (mode == 2 ? 128 : 0) - n0;
    if (mode == 3 && n0 >= 2048 && n0 < 3072) {
        const int blk = (n0 - 2048) / 512, np = (n0 - 2048) % 512, head = np / 64, d = np % 64;
        row_base = 2048 + blk * 512 + (head / 4) * 256 + 128 * (d / 32) + 32 * (head % 4) + (d % 32) - n0; }
    transpose_item(W, N, scale, WT, K, row_base, k0, n0, scr, lane);
}

__device__ __forceinline__ float row_norm_prep(const float* xrow, bf16_t* xb_row, float* copy_row, int lane) {
    const GAS f32x4* xr = (const GAS f32x4*)xrow + lane;
    f32x4 v[4]; float s = 0.f;
#pragma unroll
    for (int j = 0; j < 4; ++j) { v[j] = xr[64 * j]; s += (v[j].x * v[j].x + v[j].y * v[j].y) + (v[j].z * v[j].z + v[j].w * v[j].w); }
    const float rstd = 1.f / sqrtf(wave_sum(s) * (1.f / DM) + EPS);
    GAS u32x2* o8 = (GAS u32x2*)xb_row + lane;
#pragma unroll
    for (int j = 0; j < 4; ++j) { u32x2 w; w.x = pk2(v[j].x, v[j].y); w.y = pk2(v[j].z, v[j].w); o8[64 * j] = w; }
    if (copy_row) { GAS f32x4* c = (GAS f32x4*)copy_row + lane;
#pragma unroll
        for (int j = 0; j < 4; ++j) c[64 * j] = v[j]; }
    return rstd;
}

__constant__ double INV_FREQ[32] = {1.0, 0.7498942093324559, 0.5623413251903491, 0.4216965034285822, 0.31622776601683794, 0.23713737056616552, 0.1778279410038923, 0.1333521432163324,
    0.1, 0.07498942093324558, 0.05623413251903491, 0.042169650342858224, 0.03162277660168379, 0.023713737056616554, 0.01778279410038923, 0.01333521432163324,
    0.01, 0.007498942093324558, 0.005623413251903491, 0.004216965034285823, 0.0031622776601683794, 0.0023713737056616554, 0.0017782794100389228, 0.001333521432163324,
    0.001, 0.0007498942093324559, 0.0005623413251903491, 0.00042169650342858224, 0.00031622776601683794, 0.00023713737056616554, 0.00017782794100389227, 0.0001333521432163324};


#define IN_F(i) ((const float*)((const char*)a.in[i] + F.z))
#define YMIX_PTR(l) ((l) == 0 ? (bf16_t*)(F.ws + WS_XB) : (bf16_t*)F.out)
__device__ __forceinline__ float hg_lb(const Frame& F, const Args& a, int l, int c) { if (l == 0) return 0.f; const float* h = IN_F(5); return sigmoidf_(h[HGW + c] - h[c]); }
__device__ __forceinline__ void conv_small_item(Frame& F, const Args& a, int l, int r, LAS float* scr) {
    unsigned char* ws = F.ws; const int lane = F.lane;
    if (r < 1792) { transpose_mat_item(IN_F(4) + (size_t)l * DM * NIN, DM, NIN, IN_F(3) + l * DM, (bf16_t*)(ws + WS_WIN) + (size_t)l * NIN * DM, 3, r, scr, lane); return; } r -= 1792;
    if (r < 512) { transpose_mat_item(IN_F(7) + (size_t)l * DM * DM, DM, DM, nullptr, (bf16_t*)(ws + WS_WOUT) + (size_t)l * DM * DM, 0, r, scr, lane); return; } r -= 512;
    if (r < 1024) { transpose_mat_item(IN_F(11) + (size_t)l * DM * 2 * DM, DM, 2 * DM, nullptr, (bf16_t*)(ws + WS_WKVT) + (size_t)l * 2 * DM * DM, 0, r, scr, lane); return; } r -= 1024;
    transpose_mat_item(IN_F(12) + (size_t)l * DM * DM, DM, DM, nullptr, (bf16_t*)(ws + WS_WOT) + (size_t)l * DM * DM, 0, r, scr, lane);
}
__device__ __forceinline__ void conv_wq_row(Frame& F, const Args& a, int r) {
    const int lane = F.lane; const float sc = IN_F(8)[r] * 0.0625f;
    const GAS f32x4* src = (const GAS f32x4*)(IN_F(10) + (size_t)r * DM) + lane; GAS u32x2* dst = (GAS u32x2*)((bf16_t*)(F.ws + WS_WQS) + (size_t)r * DM) + lane;
#pragma unroll
    for (int j = 0; j < 4; ++j) { const f32x4 v = src[64 * j] * sc; u32x2 w; w.x = pk2(v.x, v.y); w.y = pk2(v.z, v.w); dst[64 * j] = w; }
}
__device__ __forceinline__ void conv_small_l1(Frame& F, const Args& a, int wi, int nw) {
    LAS float* scr = (LAS float*)(F.lds + F.wave * 16384);
    for (int it = wi; it < 2816; it += nw) conv_small_item(F, a, 1, it < 2304 ? it : it + 1024, scr);
    for (int r = wi; r < DM; r += nw) conv_wq_row(F, a, DM + r);
}
__device__ __forceinline__ void ph_init(Frame& F, const Args& a) {
    LAS float* scr = (LAS float*)(F.lds + F.wave * 16384);
    const int gw = F.vcu * NWAVES + F.wave, NGW = F.G * NWAVES, lane = F.lane;
    unsigned char* ws = F.ws;
    for (int it = gw; it < 3840 + 1024; it += NGW) {
        if (it < 3840) conv_small_item(F, a, 0, it, scr); else conv_small_item(F, a, 1, 2304 + (it - 3840), scr); }
    for (int r = gw; r < DM; r += NGW) conv_wq_row(F, a, r);
    for (int r = gw; r < MEMROWS; r += NGW) {
        const GAS f32x4* xr = (const GAS f32x4*)(IN_F(1) + (size_t)r * DM) + lane;
        f32x4 v[4]; float s = 0.f;
#pragma unroll
        for (int j = 0; j < 4; ++j) { v[j] = xr[64 * j]; s += (v[j].x * v[j].x + v[j].y * v[j].y) + (v[j].z * v[j].z + v[j].w * v[j].w); }
        const float rstd = 1.f / sqrtf(wave_sum(s) * (1.f / DM) + EPS);
        for (int l = 0; l < DEPTH; ++l) {
            const GAS f32x4* g = (const GAS f32x4*)(IN_F(9) + l * DM) + lane; GAS u32x2* dst = (GAS u32x2*)((bf16_t*)(ws + WS_MEMN) + ((size_t)l * MEMROWS + r) * DM) + lane;
#pragma unroll
            for (int j = 0; j < 4; ++j) { const f32x4 o = v[j] * rstd * g[64 * j]; u32x2 w; w.x = pk2(o.x, o.y); w.y = pk2(o.z, o.w); dst[64 * j] = w; }
        }
    }
    for (int r = gw; r < MT; r += NGW) {
        const float rs = row_norm_prep(IN_F(0) + (size_t)r * DM, (bf16_t*)(ws + WS_XB) + (size_t)r * DM, nullptr, lane);
        if (lane == 0) ((float*)(ws + WS_RSTD))[r] = rs;
    }
    for (int i = (F.vcu * NTHR + F.tid); i < DEPTH * HGW; i += F.G * NTHR) ((float*)(ws + WS_LBT))[i] = hg_lb(F, a, i / HGW, i % HGW);
    { const int* pos = (const int*)((const char*)a.in[2] + F.z);
      for (int i = (F.vcu * NTHR + F.tid); i < MT * 32; i += F.G * NTHR) { const double ang = (double)pos[i >> 5] * INV_FREQ[i & 31]; double rev = ang * 0.15915494309189535; rev = rev - __builtin_floor(rev);
          const float fr = (float)rev; ((f32x2*)(ws + WS_CS))[i] = (f32x2){__builtin_amdgcn_cosf(fr), __builtin_amdgcn_sinf(fr)}; } }
    for (int i = (F.vcu * NTHR + F.tid); i < DEPTH * 32 * DM; i += F.G * NTHR) {
        const int l = i / (32 * DM), n = (i / DM) % 32, k = i % DM;
        float w = 0.f;
        if (n < 4) w = IN_F(14)[((size_t)l * DM + k) * 4 + n]; else if (n < 20) w = IN_F(15)[((size_t)l * DM + k) * 16 + (n - 4)];
        w *= IN_F(13)[l * DM + k];
        const unsigned hi = f2bf(w); const float rem = w - bf2f((unsigned short)hi);
        ((bf16_t*)(ws + WS_WR))[i] = (bf16_t)hi; ((bf16_t*)(ws + WS_WR) + DEPTH * 32 * DM)[i] = (bf16_t)f2bf(rem);
    }
}

struct SchedKV {
    int G, c; const char* memn; const char* wkvt;
    __device__ __forceinline__ bool next(int i, Unit& u) const {
        const int L = i * G + c; if (L >= 32) return false;
        const int l = L >> 4; u.pm = (L >> 3) & 1; u.pn = L & 7; u.aux = l;
        u.a = memn + ((size_t)l * MEMROWS + u.pm * 256) * DM * 2; u.b = wkvt + ((size_t)l * 2 * DM + u.pn * 256) * DM * 2; return true;
    }
};
struct SchedFold {
    int G, c; const char* kb; const char* vb; const char* wqs; const char* wot;
    __device__ __forceinline__ bool next(int i, Unit& u) const {
        const int L = i * G + c; if (L >= 128) return false;
        const int ty = L >> 6, l = (L >> 5) & 1, b = (L >> 4) & 1, h = (L >> 2) & 3, t = L & 3; u.aux = ty * 4 + l * 2 + b;
        if (ty == 0) { u.pm = h; u.pn = t; u.a = kb + (((size_t)l * MEMROWS + b * 256) * DM + h * 256) * 2; u.b = wqs + (((size_t)l * DM + t * 256) * DM + h * 256) * 2; }
        else { u.pm = t; u.pn = h; u.a = wot + (((size_t)l * DM + t * 256) * DM + h * 256) * 2; u.b = vb + (((size_t)l * MEMROWS + b * 256) * DM + h * 256) * 2; }
        return true;
    }
};
struct SchedMoe {
    int G, c, kdim; volatile LAS unsigned* tb; const char* A; const char* B; const int* perm2; const unsigned* cnt; bool gather; int mode, early, rem; unsigned* done;
    __device__ __forceinline__ bool next(int i, Unit& u) const {
        const int total = __builtin_amdgcn_readfirstlane((int)tb[16]) * 4; int L;
        if (mode == 0) L = i * G + c;
        else if (mode == 1) { L = i * G + c; if (L >= early) return false; }
        else if (mode == 2) { if (i > 0 || c >= rem) return false; L = early + c; }
        else { const int cc = c >= rem ? c - rem : c - rem + G; L = c >= rem ? (i == 0 ? cc : (G - rem) + (i - 1) * G + cc) : (G - rem) + i * G + cc; }
        if (L >= total) return false;
        if (G == 256 && L < (mode == 1 || mode == 3 ? early : (total / 256) * 256)) { const int rd = L >> 8, idx = L & 255, xcd = idx & 7, q = idx >> 3; L = ((rd * 64 + xcd * 8 + (q >> 2)) << 2) + (q & 3); }
        const int mt = L >> 2; u.pm = mt; u.pn = L & 3; int e = 0;
#pragma unroll
        for (int j = 1; j < 16; ++j) e += (mt >= __builtin_amdgcn_readfirstlane((int)tb[j])) ? 1 : 0;
        u.aux = e; u.lr = (mt - __builtin_amdgcn_readfirstlane((int)tb[e])) * 256; u.a = gather ? A : A + (size_t)mt * 256 * kdim * 2; u.b = B + ((size_t)e * 1024 + u.pn * 256) * kdim * 2;
        if (mode == 3 && L >= early) {
            unsigned spins = 0; while (__hip_atomic_load(done + mt, __ATOMIC_RELAXED, __HIP_MEMORY_SCOPE_AGENT) < 4u) { __builtin_amdgcn_s_sleep(8); if (++spins > (1u << 18)) break; }
            __builtin_amdgcn_fence(__ATOMIC_ACQUIRE, "agent"); asm volatile("s_waitcnt vmcnt(0)" ::: "memory"); }
        return true;
    }
    __device__ __forceinline__ int src_row(const Unit& u, int r) const { const int lrow = u.lr + r; const int n = __builtin_amdgcn_readfirstlane((int)tb[24 + u.aux]); const int v = perm2[u.aux * 16384 + lrow]; return lrow < n ? v : 0; }
};

__device__ __forceinline__ void vf_unit(Frame& F, int unit) {
    unsigned char* ws = F.ws; const int tid = F.tid;
    const int tb = unit >> 3, h = unit & 7, b = tb >> 4, s_base = (tb & 15) * 512;
    LAS unsigned short* Vl = (LAS unsigned short*)F.lds;
    const bf16_t* V = (const bf16_t*)(ws + A_V) + ((size_t)b * SEQ + s_base) * 512 + h * 64;
#pragma unroll
    for (int p = 0; p < 8; ++p) { const int c = p * 512 + tid, row = c >> 3, ch = c & 7; *(LAS u32x4*)(Vl + row * 72 + ch * 8) = *(const GAS u32x4*)(V + (size_t)row * 512 + ch * 8); }
    __syncthreads();
    const size_t bh = (size_t)(b * ATH + h) * (SEQ * 64);
    for (int it = 0; it < 24; ++it) { const int pc = it * 512 + tid, tile = pc >> 8, q = pc & 255, s = q >> 7, mt = (q >> 6) & 1, ln = q & 63, dim = (ln & 31) + 32 * mt, hi = ln >> 5;
        const int pat = tile >> 4, j16 = tile & 15, sh = pat * 2, D = 1 << sh;
        const int TPC = 16 >> sh, r = j16 / TPC, tl = j16 % TPC;
        const int pl = tl * 32 + 16 * s + 8 * hi;
        unsigned w[4];
#pragma unroll
        for (int jj = 0; jj < 4; ++jj) { const int t0 = ((pl + 2 * jj) << sh) + r, t1 = ((pl + 2 * jj + 1) << sh) + r; w[jj] = (unsigned)Vl[t0 * 72 + dim] | ((unsigned)Vl[t1 * 72 + dim] << 16); }
        const int T = (s_base >> sh >> 5) + tl;
        bf16_t* vf = (bf16_t*)(ws + A_VT1) + (size_t)pat * (MT * 512) + bh + ((size_t)(r * (SEQ / 32 >> sh) + T) * 4 + s * 2 + mt) * 512 + ln * 8;
        *(GAS u32x4*)vf = (u32x4){w[0], w[1], w[2], w[3]}; }
    __syncthreads();
}

constexpr int HG_LBT_OFF = 122880;
__device__ __forceinline__ void hg_build_b(Frame& F, int l, int h, const u32x4 z0, const u32x4 z1, int k0, float (&bb)[16], float (&kk)[16]) {
    const int tid = F.tid, lane = F.lane, wave = F.wave, tl = lane & 7;
    LAS float* WT = (LAS float*)F.lds; LAS float* REF = (LAS float*)(F.lds + 4096);
    const unsigned zz[8] = {z0.x, z0.y, z0.z, z0.w, z1.x, z1.y, z1.z, z1.w};
    float lbv[16];
#pragma unroll
    for (int i = 0; i < 16; i += 4) { const f32x4 t4 = *(const LAS f32x4*)(F.lds + HG_LBT_OFF + (h * 128 + k0 + i) * 4); lbv[i] = t4.x; lbv[i + 1] = t4.y; lbv[i + 2] = t4.z; lbv[i + 3] = t4.w; }
#pragma unroll
    for (int i = 0; i < 16; ++i) { const float z = (i & 1) ? bfhi(zz[i >> 1]) : bflo(zz[i >> 1]); const float lb = lbv[i];
        const float e = ex2(-LOG2E * z), sg = __builtin_amdgcn_rcpf(1.f + e), f = lb + (1.f - lb) * sg; bb[i] = __builtin_amdgcn_logf(f); kk[i] = (1.f - lb) * (e * sg); }
#pragma unroll
    for (int i = 0; i < 16; ++i) { float x = bb[i]; float y;
        y = __builtin_bit_cast(float, __builtin_amdgcn_update_dpp(0, __builtin_bit_cast(int, x), 0x111, 0xf, 0xf, true)); if (tl >= 1) x += y;
        y = __builtin_bit_cast(float, __builtin_amdgcn_update_dpp(0, __builtin_bit_cast(int, x), 0x112, 0xf, 0xf, true)); if (tl >= 2) x += y;
        y = __builtin_bit_cast(float, __builtin_amdgcn_update_dpp(0, __builtin_bit_cast(int, x), 0x114, 0xf, 0xf, true)); if (tl >= 4) x += y;
        bb[i] = x; }
    if (tl == 7) {
#pragma unroll
        for (int i = 0; i < 16; i += 4) *(LAS f32x4*)(WT + wave * 128 + k0 + i) = (f32x4){bb[i], bb[i + 1], bb[i + 2], bb[i + 3]}; }
    __syncthreads();
    for (int w = 0; w < wave; ++w) {
#pragma unroll
        for (int i = 0; i < 16; i += 4) { const f32x4 p = *(const LAS f32x4*)(WT + w * 128 + k0 + i); bb[i] += p.x; bb[i + 1] += p.y; bb[i + 2] += p.z; bb[i + 3] += p.w; } }
    if (tl == 7 && (wave & 1)) {
#pragma unroll
        for (int i = 0; i < 16; i += 4) *(LAS f32x4*)(REF + (wave >> 1) * 128 + k0 + i) = (f32x4){bb[i], bb[i + 1], bb[i + 2], bb[i + 3]}; }
    __syncthreads();
    (void)tid;
}
__device__ __forceinline__ void st_row16(LAS unsigned char* base, int byteoff, const float (&v)[16]) {
    u32x4 w0, w1; w0.x = cvt_pk_bf16(v[0], v[1]); w0.y = cvt_pk_bf16(v[2], v[3]); w0.z = cvt_pk_bf16(v[4], v[5]); w0.w = cvt_pk_bf16(v[6], v[7]); w1.x = cvt_pk_bf16(v[8], v[9]); w1.y = cvt_pk_bf16(v[10], v[11]); w1.z = cvt_pk_bf16(v[12], v[13]); w1.w = cvt_pk_bf16(v[14], v[15]);
    *(LAS u32x4*)(base + byteoff) = w0; *(LAS u32x4*)(base + byteoff + 16) = w1;
}
constexpr int HL_RED = 6144, HL_QD = 8192, HL_KD = 25600, HL_QE = 43008, HL_Q1 = 60416, HL_K1 = 69120, HL_Q2 = 77824, HL_K2 = 86528, HL_VT = 95232, HL_SC = 113664;
constexpr int RS_TR = 288;
typedef short s16x4 __attribute__((ext_vector_type(4)));
constexpr int HA_KT = 8192, HA_VT = 8192 + 64 * 288;
constexpr int RS128 = 272, RS64 = 144;

__device__ __forceinline__ void hg_lbt_to_lds(Frame& F, int l) { if (F.tid < 128) *(LAS f32x4*)(F.lds + HG_LBT_OFF + F.tid * 16) = *(const GAS f32x4*)((const float*)(F.ws + WS_LBT) + l * HGW + F.tid * 4); __syncthreads(); }
struct HgIn { u32x4 z0, z1, q0, q1, v0, v1; };
template <bool NEEDQ> __device__ __forceinline__ HgIn hg_load(Frame& F, int unit) {
    HgIn R;
    const int b = unit >> 9, h = (unit >> 7) & 3, c = unit & 127; const int row0 = b * SEQ + c * CHUNK, t = (F.tid >> 6) * 8 + (F.tid & 7), k0 = ((F.tid >> 3) & 7) * 16;
    const bf16_t* rowp = (const bf16_t*)(F.ws + A_HG) + (size_t)(row0 + t) * 2048 + h * 128 + k0;
    R.z0 = *(const GAS u32x4*)(rowp + 512); R.z1 = *(const GAS u32x4*)(rowp + 512 + 8); R.v0 = *(const GAS u32x4*)(rowp + 1024); R.v1 = *(const GAS u32x4*)(rowp + 1024 + 8);
    if (NEEDQ) { R.q0 = *(const GAS u32x4*)(rowp); R.q1 = *(const GAS u32x4*)(rowp + 8); } else { R.q0 = R.z0; R.q1 = R.z1; }
    return R;
}
__device__ __forceinline__ void hg_a2_unit(Frame& F, const Args& a, int l, int unit, const HgIn& R) {
    unsigned char* ws = F.ws; const int tid = F.tid, lane = F.lane, wave = F.wave;
    const int h = (unit >> 7) & 3;
    const int t = (tid >> 6) * 8 + (tid & 7), k0 = ((tid >> 3) & 7) * 16;
    const u32x4 v0 = R.v0, v1 = R.v1;
    float bb[16], kk[16];
    hg_build_b(F, l, h, R.z0, R.z1, k0, bb, kk);
    const LAS float* REF = (const LAS float*)(F.lds + 4096);
    { float tmp[16];
#pragma unroll
      for (int i = 0; i < 16; ++i) tmp[i] = kk[i] * ex2(REF[3 * 128 + k0 + i] - bb[i]);
      st_row16(F.lds, HA_KT + t * RS_TR + k0 * 2, tmp);
      *(LAS u32x4*)(F.lds + HA_VT + t * RS_TR + k0 * 2) = v0; *(LAS u32x4*)(F.lds + HA_VT + t * RS_TR + k0 * 2 + 16) = v1; }
    if (tid < 128) ((float*)(ws + A_DECAY))[(size_t)unit * 128 + tid] = ex2(REF[3 * 128 + tid]);
    __syncthreads();
    { const int fr = lane & 15, g = lane >> 4;
      const int q = fr >> 2, p = fr & 3;
      auto trfrag = [&](int base, int c0, int ks) -> bf16x8 {
          const LAS unsigned char* a0 = F.lds + base + (32 * ks + 8 * g + q) * RS_TR + (c0 + 4 * p) * 2;
          const s16x4 lo = __builtin_bit_cast(s16x4, __builtin_amdgcn_ds_read_tr16_b64_v4i16((LAS s16x4*)a0));
          const s16x4 hi = __builtin_bit_cast(s16x4, __builtin_amdgcn_ds_read_tr16_b64_v4i16((LAS s16x4*)(a0 + 4 * RS_TR)));
          return (bf16x8){lo[0], lo[1], lo[2], lo[3], hi[0], hi[1], hi[2], hi[3]}; };
      bf16x8 af[2];
#pragma unroll
      for (int ks = 0; ks < 2; ++ks) af[ks] = trfrag(HA_KT, wave * 16, ks);
      bf16_t* st = (bf16_t*)(ws + A_STATE) + (size_t)unit * 16384;
#pragma unroll
      for (int vt = 0; vt < 8; ++vt) { f32x4 acc = {0.f, 0.f, 0.f, 0.f};
#pragma unroll
          for (int ks = 0; ks < 2; ++ks) { const bf16x8 bf = trfrag(HA_VT, vt * 16, ks); acc = __builtin_amdgcn_mfma_f32_16x16x32_bf16(af[ks], bf, acc, 0, 0, 0); }
          u32x2 w; w.x = cvt_pk_bf16(acc[0], acc[1]); w.y = cvt_pk_bf16(acc[2], acc[3]);
          *(GAS u32x2*)(st + (vt * 16 + fr) * 128 + wave * 16 + 4 * g) = w; } }
}

template <int STOP> __device__ __forceinline__ void hg_c2_unit(Frame& F, const Args& a, int l, int unit, const HgIn& R) {
    unsigned char* ws = F.ws; const int tid = F.tid, lane = F.lane, wave = F.wave;
    const int b = unit >> 9, h = (unit >> 7) & 3, c = unit & 127; const int row0 = b * SEQ + c * CHUNK;
    const int t = (tid >> 6) * 8 + (tid & 7), k0 = ((tid >> 3) & 7) * 16;
    const int fr = lane & 15, g = lane >> 4;
    const bf16_t* HG = (const bf16_t*)(ws + A_HG);
    const u32x4 q0 = R.q0, q1 = R.q1, v0 = R.v0, v1 = R.v1;
    bf16x8 sf[4]; u32x2 gwv[4];
    { const bf16_t* st = (const bf16_t*)(ws + A_STATE) + (size_t)unit * 16384 + (wave * 16 + fr) * 128;
#pragma unroll
      for (int ks = 0; ks < 4; ++ks) sf[ks] = *(const GAS bf16x8*)(st + 32 * ks + 8 * g);
#pragma unroll
      for (int I = 0; I < 4; ++I) gwv[I] = *(const GAS u32x2*)(HG + (size_t)(row0 + 16 * I + fr) * 2048 + 1536 + h * 128 + wave * 16 + 4 * g); }
    const f32x4 gain = *(const GAS f32x4*)(IN_F(6) + l * HGW + h * 128 + wave * 16 + 4 * g);
    float bb[16], kk[16];
    hg_build_b(F, l, h, R.z0, R.z1, k0, bb, kk);
    if (STOP == 1) { asm volatile("" :: "v"(bb[0]), "v"(kk[0]), "v"(sf[0]), "v"(gwv[0]), "v"(gain)); return; }
    const LAS float* REF = (const LAS float*)(F.lds + 4096);
    { const unsigned qq[8] = {q0.x, q0.y, q0.z, q0.w, q1.x, q1.y, q1.z, q1.w}, vv[8] = {v0.x, v0.y, v0.z, v0.w, v1.x, v1.y, v1.z, v1.w};
      LAS unsigned short* VT = (LAS unsigned short*)(F.lds + HL_VT);
      float qv[16], tmp[16];
#pragma unroll
      for (int i = 0; i < 16; ++i) { qv[i] = (i & 1) ? bfhi(qq[i >> 1]) : bflo(qq[i >> 1]); VT[(k0 + i) * (RS64 / 2) + t] = (unsigned short)((i & 1) ? (vv[i >> 1] >> 16) : (vv[i >> 1] & 0xffffu)); }
      const int I = wave >> 1;
      float rf[16];
#pragma unroll
      for (int i = 0; i < 16; i += 4) { f32x4 r4 = {0.f, 0.f, 0.f, 0.f}; if (I) r4 = *(const LAS f32x4*)(REF + (I - 1) * 128 + k0 + i); rf[i] = r4.x; rf[i + 1] = r4.y; rf[i + 2] = r4.z; rf[i + 3] = r4.w; }
#pragma unroll
      for (int i = 0; i < 16; ++i) tmp[i] = qv[i] * ex2(bb[i] - rf[i]);
      st_row16(F.lds, HL_QD + t * RS128 + k0 * 2, tmp);
#pragma unroll
      for (int i = 0; i < 16; ++i) tmp[i] = kk[i] * ex2(fminf(rf[i] - bb[i], 86.f));
      st_row16(F.lds, HL_KD + t * RS128 + k0 * 2, tmp);
#pragma unroll
      for (int i = 0; i < 16; ++i) tmp[i] = qv[i] * ex2(bb[i]);
      st_row16(F.lds, HL_QE + t * RS128 + k0 * 2, tmp);
#pragma unroll
      for (int i = 0; i < 16; i += 4) { const f32x4 r4 = *(const LAS f32x4*)(REF + 1 * 128 + k0 + i); rf[i] = r4.x; rf[i + 1] = r4.y; rf[i + 2] = r4.z; rf[i + 3] = r4.w; }
      if (wave >= 4) {
#pragma unroll
          for (int i = 0; i < 16; ++i) tmp[i] = qv[i] * ex2(bb[i] - rf[i]);
          st_row16(F.lds, HL_Q1 + (t & 31) * RS128 + k0 * 2, tmp);
      } else {
#pragma unroll
          for (int i = 0; i < 16; ++i) tmp[i] = kk[i] * ex2(rf[i] - bb[i]);
          st_row16(F.lds, HL_K1 + (t & 31) * RS128 + k0 * 2, tmp);
      }
#pragma unroll
      for (int i = 0; i < 16; i += 4) { const f32x4 r4 = *(const LAS f32x4*)(REF + ((wave >= 4) ? 2 : 0) * 128 + k0 + i); rf[i] = r4.x; rf[i + 1] = r4.y; rf[i + 2] = r4.z; rf[i + 3] = r4.w; }
      if (wave & 2) {
#pragma unroll
          for (int i = 0; i < 16; ++i) tmp[i] = qv[i] * ex2(bb[i] - rf[i]);
          st_row16(F.lds, HL_Q2 + ((t & 15) + ((wave >= 4) ? 16 : 0)) * RS128 + k0 * 2, tmp);
      } else {
#pragma unroll
          for (int i = 0; i < 16; ++i) tmp[i] = kk[i] * ex2(rf[i] - bb[i]);
          st_row16(F.lds, HL_K2 + ((t & 15) + ((wave >= 4) ? 16 : 0)) * RS128 + k0 * 2, tmp);
      }
      for (int i = tid; i < 64 * RS64 / 16; i += NTHR) *(LAS u32x4*)(F.lds + HL_SC + i * 16) = (u32x4){0u, 0u, 0u, 0u};
    }
    __syncthreads();
    if (STOP == 2) { asm volatile("" :: "v"(sf[0]), "v"(gwv[0]), "v"(gain)); return; }
    for (int blk = wave; blk < 10; blk += 8) {
        int ko, qo, J, I; bool diag = false;
        if (blk < 4) { ko = HL_KD + blk * 16 * RS128; qo = HL_QD + blk * 16 * RS128; J = blk; I = blk; diag = true; }
        else if (blk == 4) { ko = HL_K2; qo = HL_Q2; J = 0; I = 1; }
        else if (blk == 5) { ko = HL_K2 + 16 * RS128; qo = HL_Q2 + 16 * RS128; J = 2; I = 3; }
        else { const int jj = (blk - 6) >> 1, ii = (blk - 6) & 1; ko = HL_K1 + jj * 16 * RS128; qo = HL_Q1 + ii * 16 * RS128; J = jj; I = 2 + ii; }
        f32x4 acc = {0.f, 0.f, 0.f, 0.f};
#pragma unroll
        for (int ks = 0; ks < 4; ++ks) { const bf16x8 af = *(const LAS bf16x8*)(F.lds + ko + fr * RS128 + (32 * ks + 8 * g) * 2), bf = *(const LAS bf16x8*)(F.lds + qo + fr * RS128 + (32 * ks + 8 * g) * 2);
            acc = __builtin_amdgcn_mfma_f32_16x16x32_bf16(af, bf, acc, 0, 0, 0); }
        if (diag) {
#pragma unroll
            for (int rg = 0; rg < 4; ++rg) if (4 * g + rg > fr) acc[rg] = 0.f; }
        u32x2 w; w.x = cvt_pk_bf16(acc[0], acc[1]); w.y = cvt_pk_bf16(acc[2], acc[3]);
        *(LAS u32x2*)(F.lds + HL_SC + (16 * I + fr) * RS64 + (16 * J + 4 * g) * 2) = w;
    }
    __syncthreads();
    if (STOP == 3) { asm volatile("" :: "v"(sf[0]), "v"(gwv[0]), "v"(gain)); return; }
    f32x4 o[4];
#pragma unroll
    for (int I = 0; I < 4; ++I) o[I] = (f32x4){0.f, 0.f, 0.f, 0.f};
    { bf16x8 af[2];
#pragma unroll
      for (int ks = 0; ks < 2; ++ks) af[ks] = *(const LAS bf16x8*)(F.lds + HL_VT + (wave * 16 + fr) * RS64 + (32 * ks + 8 * g) * 2);
#pragma unroll
      for (int I = 0; I < 4; ++I)
#pragma unroll
          for (int ks = 0; ks < 2; ++ks) { const bf16x8 bf = *(const LAS bf16x8*)(F.lds + HL_SC + (16 * I + fr) * RS64 + (32 * ks + 8 * g) * 2); o[I] = __builtin_amdgcn_mfma_f32_16x16x32_bf16(af[ks], bf, o[I], 0, 0, 0); }
#pragma unroll
      for (int I = 0; I < 4; ++I)
#pragma unroll
          for (int ks = 0; ks < 4; ++ks) { const bf16x8 bf = *(const LAS bf16x8*)(F.lds + HL_QE + (16 * I + fr) * RS128 + (32 * ks + 8 * g) * 2); o[I] = __builtin_amdgcn_mfma_f32_16x16x32_bf16(sf[ks], bf, o[I], 0, 0, 0); }
    }
    if (STOP == 4) { asm volatile("" :: "v"(o[0]), "v"(o[1]), "v"(o[2]), "v"(o[3]), "v"(gwv[0]), "v"(gain)); return; }
    LAS float* RED = (LAS float*)(F.lds + HL_RED);
#pragma unroll
    for (int I = 0; I < 4; ++I) { float q = (o[I][0] * o[I][0] + o[I][1] * o[I][1]) + (o[I][2] * o[I][2] + o[I][3] * o[I][3]); q += __shfl_xor(q, 16); q += __shfl_xor(q, 32); if (g == 0) RED[wave * 64 + 16 * I + fr] = q; }
    __syncthreads();
    { bf16_t* Y = YMIX_PTR(l);
#pragma unroll
      for (int I = 0; I < 4; ++I) { const int tt = 16 * I + fr; float ssq = 0.f;
#pragma unroll
          for (int w = 0; w < 8; ++w) ssq += RED[w * 64 + tt];
          const float rs = __builtin_amdgcn_rsqf(ssq * (1.f / 128.f) + EPS);
          const u32x2 gw = gwv[I];
          const float g0 = bflo(gw.x), g1 = bfhi(gw.x), g2 = bflo(gw.y), g3 = bfhi(gw.y);
          u32x2 w; w.x = cvt_pk_bf16(o[I][0] * rs * gain.x * (g0 * sigmoidf_(g0)), o[I][1] * rs * gain.y * (g1 * sigmoidf_(g1)));
          w.y = cvt_pk_bf16(o[I][2] * rs * gain.z * (g2 * sigmoidf_(g2)), o[I][3] * rs * gain.w * (g3 * sigmoidf_(g3)));
          *(GAS u32x2*)(Y + (size_t)(row0 + tt) * DM + h * 128 + wave * 16 + 4 * g) = w; } }
}

__device__ __forceinline__ void hg_scan(Frame& F) {
    unsigned char* ws = F.ws;
    for (int gid = F.vcu * NTHR + F.tid; gid < BATCH * HGH * 16384; gid += F.G * NTHR) {
        const int bh = gid >> 14, e = gid & 16383, k = e & 127;
        bf16_t* st = (bf16_t*)(ws + A_STATE) + (size_t)bh * NCHUNK * 16384 + e; const float* dc = (const float*)(ws + A_DECAY) + (size_t)bh * NCHUNK * 128 + k;
        float S = 0.f;
        for (int c0 = 0; c0 < NCHUNK; c0 += 8) { float kv[8], d[8];
#pragma unroll
            for (int i = 0; i < 8; ++i) { kv[i] = bf2f(st[(size_t)(c0 + i) * 16384]); d[i] = dc[(c0 + i) * 128]; }
#pragma unroll
            for (int i = 0; i < 8; ++i) { st[(size_t)(c0 + i) * 16384] = (bf16_t)f2bf(F.dry ? kv[i] : S); S = d[i] * S + kv[i]; } }
    }
}


typedef float f32x16 __attribute__((ext_vector_type(16)));
template <int D, int PAT>
__device__ __forceinline__ void att_pattern(Frame& F, int b, int h, int s_base, float kmax2, const bf16_t* QR, const bf16_t* KF, const bf16_t* VF) {
    const int lane = F.lane, wave = F.wave, r32 = lane & 31, hi = lane >> 5;
    LAS float* ACC = (LAS float*)F.lds; LAS float* LS = (LAS float*)(F.lds + 131072);
    constexpr int TPC = 16 / D, NT = SEQ / D / 32;
    const size_t bh = (size_t)(b * ATH + h) * (SEQ * 64);
    for (int jj = 0; jj < 2; ++jj) {
        const int j = wave + 8 * jj, r = j / TPC, tile = j % TPC, p0 = s_base / D + tile * 32;
        const size_t qrow = (size_t)b * SEQ + (size_t)(p0 + r32) * D + r;
        bf16x8 qf[4];
#pragma unroll
        for (int kk = 0; kk < 4; ++kk) qf[kk] = *(const GAS bf16x8*)(QR + qrow * 512 + h * 64 + 16 * kk + 8 * hi);
        float qn2 = 0.f;
#pragma unroll
        for (int kk = 0; kk < 4; ++kk)
#pragma unroll
            for (int e = 0; e < 8; ++e) { const float x = bf2f((unsigned short)qf[kk][e]); qn2 += x * x; }
        qn2 += __shfl_xor(qn2, 32);
        const float negM = -__builtin_amdgcn_sqrtf(qn2 * kmax2);
        f32x16 o[2] = {{}, {}}; float lsum = 0.f;
#pragma unroll
        for (int kt = 0; kt < 5; ++kt) {
            const float c0 = (p0 - 128 + 32 * kt) < 0 ? -1.0e30f : negM;
            bf16x8 vfr[2][2], kf[4];
            { const int kb = p0 - 128 + 32 * kt, kbc = kb < 0 ? 0 : kb;
              const bf16_t* kp = KF + bh + ((size_t)(r * NT + (kbc >> 5)) * 4) * 512 + lane * 8;
#pragma unroll
              for (int kk = 0; kk < 4; ++kk) kf[kk] = *(const GAS bf16x8*)(kp + kk * 512);
#pragma unroll
              for (int s = 0; s < 2; ++s)
#pragma unroll
                  for (int mt = 0; mt < 2; ++mt) vfr[s][mt] = *(const GAS bf16x8*)(VF + bh + ((size_t)(r * NT + (kbc >> 5)) * 4 + s * 2 + mt) * 512 + lane * 8); }
            f32x16 acc;
#pragma unroll
            for (int rg = 0; rg < 16; ++rg) acc[rg] = c0;
#pragma unroll
            for (int kk = 0; kk < 4; ++kk) acc = __builtin_amdgcn_mfma_f32_32x32x16_bf16(kf[kk], qf[kk], acc, 0, 0, 0);
            if (kt == 0 || kt == 4) {
#pragma unroll
                for (int rg = 0; rg < 16; ++rg) { const int kap = 16 * (rg >> 3) + 8 * hi + (rg & 7); if (kt == 0 ? (kap < r32) : (kap > r32)) acc[rg] = -1.0e30f; } }
#pragma unroll
            for (int rg = 0; rg < 16; ++rg) { acc[rg] = ex2(acc[rg]); lsum += acc[rg]; }
#pragma unroll
            for (int s = 0; s < 2; ++s) {
                u32x4 pw; pw.x = cvt_pk_bf16(acc[8 * s + 0], acc[8 * s + 1]); pw.y = cvt_pk_bf16(acc[8 * s + 2], acc[8 * s + 3]);
                pw.z = cvt_pk_bf16(acc[8 * s + 4], acc[8 * s + 5]); pw.w = cvt_pk_bf16(acc[8 * s + 6], acc[8 * s + 7]);
                const bf16x8 pf = __builtin_bit_cast(bf16x8, pw);
#pragma unroll
                for (int mt = 0; mt < 2; ++mt) o[mt] = __builtin_amdgcn_mfma_f32_32x32x16_bf16(vfr[s][mt], pf, o[mt], 0, 0, 0);
            }
        }
        lsum += __shfl_xor(lsum, 32);
        const int tau = (p0 + r32) * D + r - s_base, gsw = (tau ^ (tau >> 5)) & 31;
        LAS float* arow = ACC + tau * 64;
#pragma unroll
        for (int mt = 0; mt < 2; ++mt)
#pragma unroll
            for (int rg = 0; rg < 16; ++rg) { LAS float* p = arow + ((((rg & 3) + 8 * (rg >> 2) + 4 * hi) ^ gsw) + 32 * mt); if (PAT == 0) *p = o[mt][rg]; else *p += o[mt][rg]; }
        if (hi == 0) { if (PAT == 0) LS[tau] = lsum; else LS[tau] += lsum; }
    }
}
__device__ __forceinline__ void att_unit(Frame& F, int l, int unit) {
    const int tb = unit >> 3, h = unit & 7, b = tb >> 4, s_base = (tb & 15) * 512;
    const bf16_t* QR = (const bf16_t*)(F.ws + A_QR);
    LAS float* ACC = (LAS float*)F.lds; LAS float* LS = (LAS float*)(F.lds + 131072);
    const float kmax2 = __uint_as_float(__hip_atomic_load((unsigned*)(F.ctl + CW_KMAX + l * 16) + b * ATH + h, RLX_AGENT)) * 1.02f;
    att_pattern<1, 0>(F, b, h, s_base, kmax2, QR, (const bf16_t*)(F.ws + A_KF1), (const bf16_t*)(F.ws + A_VT1));
    __syncthreads();
    att_pattern<4, 1>(F, b, h, s_base, kmax2, QR, (const bf16_t*)(F.ws + A_KF4), (const bf16_t*)(F.ws + A_VT4));
    __syncthreads();
    att_pattern<16, 2>(F, b, h, s_base, kmax2, QR, (const bf16_t*)(F.ws + A_KF16), (const bf16_t*)(F.ws + A_VT16));
    __syncthreads();
    { const int tau = F.tid, gsw = (tau ^ (tau >> 5)) & 31; const LAS float* arow = ACC + tau * 64; const float inv = __builtin_amdgcn_rcpf(LS[tau]);
      bf16_t* yrow = YMIX_PTR(l) + ((size_t)b * SEQ + s_base + tau) * DM + 512 + h * 64;
#pragma unroll
      for (int c = 0; c < 8; ++c) { float v[8];
#pragma unroll
          for (int e = 0; e < 8; ++e) v[e] = arow[((8 * c + e) & 32) + (((8 * c + e) & 31) ^ gsw)] * inv;
          u32x4 w; w.x = cvt_pk_bf16(v[0], v[1]); w.y = cvt_pk_bf16(v[2], v[3]); w.z = cvt_pk_bf16(v[4], v[5]); w.w = cvt_pk_bf16(v[6], v[7]); *(GAS u32x4*)(yrow + 8 * c) = w; } }
    __syncthreads();
}

__device__ __forceinline__ void ph_norm(Frame& F, const Args& a) {
    const int gw = F.vcu * NWAVES + F.wave, NGW = F.G * NWAVES;
    for (int r = gw; r < MT; r += NGW) { const float rs = row_norm_prep(F.out + (size_t)r * DM, (bf16_t*)(F.ws + WS_XB) + (size_t)r * DM, nullptr, F.lane); if (F.lane == 0) ((float*)(F.ws + WS_RSTD))[r] = rs; }
}

__device__ __forceinline__ void ph_router(Frame& F, const Args& a, int l) {
    unsigned char* ws = F.ws; const int lane = F.lane;
    const int gw = F.vcu * NWAVES + F.wave, NGW = F.G * NWAVES;
    { LAS float* scr = (LAS float*)(F.lds + F.wave * 16384);
      for (int it = gw; it < 3 * 4096; it += NGW) { const int ty = it >> 12, e = (it >> 8) & 15, r = it & 255;
          if (ty == 0) transpose_mat_item(IN_F(16) + ((size_t)l * NEXP + e) * DM * EFF, DM, EFF, IN_F(13) + l * DM, (bf16_t*)(ws + A_WGU) + (size_t)e * DM * DM, 1, r, scr, lane);
          else if (ty == 1) transpose_mat_item(IN_F(17) + ((size_t)l * NEXP + e) * DM * EFF, DM, EFF, IN_F(13) + l * DM, (bf16_t*)(ws + A_WGU) + (size_t)e * DM * DM, 2, r, scr, lane);
          else transpose_mat_item(IN_F(18) + ((size_t)l * NEXP + e) * EFF * DM, EFF, DM, nullptr, (bf16_t*)(ws + A_WD) + (size_t)e * DM * EFF, 0, r, scr, lane); } }
    __syncthreads();
    unsigned* cnt = (unsigned*)(F.ctl + CW_CNT + l * 16 * 64);
    LAS unsigned* LCNT = (LAS unsigned*)(F.lds + 81920); LAS unsigned* LBASE = (LAS unsigned*)(F.lds + 81984);
    LAS float* LG = (LAS float*)F.lds;
    LAS float* SS = (LAS float*)(F.lds + 16384);
    if (F.tid < 16) LCNT[F.tid] = 0u;
    const bf16_t* WH = (const bf16_t*)(ws + WS_WR) + (size_t)l * 32 * DM; const bf16_t* WL = WH + DEPTH * 32 * DM;
    const int fr = lane & 15, g = lane >> 4, tile = F.wave & 3, kh = F.wave >> 2;
    for (int rt = F.vcu; rt < MT / 64; rt += F.G) {
        const int row = rt * 64 + tile * 16 + fr;
        const bf16_t* xbrow = (const bf16_t*)(ws + WS_XB) + (size_t)row * DM + kh * 512 + 8 * g;
        f32x4 acc[2] = {{0.f, 0.f, 0.f, 0.f}, {0.f, 0.f, 0.f, 0.f}}; float ssq = 0.f;
#pragma unroll 4
        for (int ks = 0; ks < 16; ++ks) {
            const u32x4 hw = *(const GAS u32x4*)(xbrow + 32 * ks);
            { const float x0 = bflo(hw.x), x1 = bfhi(hw.x), x2 = bflo(hw.y), x3 = bfhi(hw.y), x4 = bflo(hw.z), x5 = bfhi(hw.z), x6 = bflo(hw.w), x7 = bfhi(hw.w);
              ssq += ((x0 * x0 + x1 * x1) + (x2 * x2 + x3 * x3)) + ((x4 * x4 + x5 * x5) + (x6 * x6 + x7 * x7)); }
            const bf16x8 ah = __builtin_bit_cast(bf16x8, hw);
#pragma unroll
            for (int ct = 0; ct < 2; ++ct) { const size_t wo = (size_t)(16 * ct + fr) * DM + kh * 512 + 32 * ks + 8 * g;
                const bf16x8 bh = *(const GAS bf16x8*)(WH + wo), bl = *(const GAS bf16x8*)(WL + wo);
                acc[ct] = __builtin_amdgcn_mfma_f32_16x16x32_bf16(ah, bh, acc[ct], 0, 0, 0); acc[ct] = __builtin_amdgcn_mfma_f32_16x16x32_bf16(ah, bl, acc[ct], 0, 0, 0); }
        }
        ssq += __shfl_xor(ssq, 16); ssq += __shfl_xor(ssq, 32);
        if (g == 0) SS[kh * 64 + tile * 16 + fr] = ssq;
#pragma unroll
        for (int ct = 0; ct < 2; ++ct)
#pragma unroll
            for (int rg = 0; rg < 4; ++rg) LG[(kh * 64 + tile * 16 + 4 * g + rg) * 32 + 16 * ct + fr] = acc[ct][rg];
        __syncthreads();
        if (F.tid < 64) { const int rl = F.tid, r = rt * 64 + rl;
            const float rstd = __builtin_amdgcn_rsqf((SS[rl] + SS[64 + rl]) * (1.f / DM) + EPS);
            float lg[20];
#pragma unroll
            for (int q = 0; q < 20; q += 4) { const f32x4 p0 = *(const LAS f32x4*)(LG + rl * 32 + q), p1 = *(const LAS f32x4*)(LG + (64 + rl) * 32 + q); lg[q] = (p0.x + p1.x) * rstd; lg[q + 1] = (p0.y + p1.y) * rstd; lg[q + 2] = (p0.z + p1.z) * rstd; lg[q + 3] = (p0.w + p1.w) * rstd; }
            ((float*)(ws + WS_RSTD))[r] = rstd;
            int gs = 0; float gm = lg[0];
#pragma unroll
            for (int q = 1; q < 4; ++q) if (lg[q] > gm) { gm = lg[q]; gs = q; }
            float den = 0.f;
#pragma unroll
            for (int q = 0; q < 4; ++q) den += __expf(lg[q] - gm);
            const float gwt = __builtin_amdgcn_rcpf(den);
            float e4[4];
#pragma unroll
            for (int q = 0; q < 4; ++q) e4[q] = gs == 0 ? lg[4 + q] : (gs == 1 ? lg[8 + q] : (gs == 2 ? lg[12 + q] : lg[16 + q]));
            int i1 = 0; float v1 = e4[0];
#pragma unroll
            for (int q = 1; q < 4; ++q) if (e4[q] > v1) { v1 = e4[q]; i1 = q; }
            int i2 = -1; float v2 = -3.0e38f;
#pragma unroll
            for (int q = 0; q < 4; ++q) if (q != i1 && e4[q] > v2) { v2 = e4[q]; i2 = q; }
            const float ex = __expf(v2 - v1), w1 = __builtin_amdgcn_rcpf(1.f + ex), w2 = ex * w1;
            const int id1 = gs * 4 + i1, id2 = gs * 4 + i2;
            int* te = (int*)(ws + WS_TOKE) + 2 * r; float* tw = (float*)(ws + WS_TOKW) + 2 * r; int* tl = (int*)(ws + WS_TOKL) + 2 * r;
            te[0] = id1; te[1] = id2; tw[0] = w1 * gwt; tw[1] = w2 * gwt;
            tl[0] = (int)__hip_atomic_fetch_add(LCNT + id1, 1u, __ATOMIC_RELAXED, __HIP_MEMORY_SCOPE_WORKGROUP); tl[1] = (int)__hip_atomic_fetch_add(LCNT + id2, 1u, __ATOMIC_RELAXED, __HIP_MEMORY_SCOPE_WORKGROUP);
        }
        __syncthreads();
    }
    __syncthreads();
    if (F.tid < 16) LBASE[F.tid] = __hip_atomic_fetch_add(cnt + 64 * F.tid, F.dry ? 0u : LCNT[F.tid], RLX_AGENT);
    __syncthreads();
    for (int rt = F.vcu; rt < MT / 64; rt += F.G) {
        if (F.tid < 128) { const int r = rt * 64 + (F.tid >> 1), k = F.tid & 1;
            const int e = ((const int*)(ws + WS_TOKE))[2 * r + k]; const int li = ((const int*)(ws + WS_TOKL))[2 * r + k] + (int)LBASE[e];
            ((int*)(ws + WS_TOKL))[2 * r + k] = li; ((int*)(ws + A_PERM2))[e * 16384 + li] = r; ((float*)(ws + A_SRS2))[e * 16384 + li] = ((const float*)(ws + WS_RSTD))[r]; ((float*)(ws + A_SGW2))[e * 16384 + li] = ((const float*)(ws + WS_TOKW))[2 * r + k]; } }
}

__device__ __forceinline__ void moe_prefix(Frame& F, int l) {
    if (F.tid == 0) { unsigned n[16];
#pragma unroll
        for (int e = 0; e < 16; ++e) n[e] = __hip_atomic_load((unsigned*)(F.ctl + CW_CNT + l * 16 * 64) + 64 * e, RLX_AGENT);
        unsigned acc = 0;
#pragma unroll
        for (int e = 0; e < 16; ++e) { F.MISC[16 + e] = acc; F.MISC[40 + e] = n[e]; acc += (n[e] + 255u) >> 8; }
        F.MISC[32] = acc; }
    __syncthreads();
}

__device__ __forceinline__ void ph_combine(Frame& F, const Args& a, int l) {
    unsigned char* ws = F.ws; const int lane = F.lane;
    const int gw = F.vcu * NWAVES + F.wave, NGW = F.G * NWAVES;
    moe_prefix(F, l);
    const int* tlr = (const int*)(ws + WS_TOKL); const int* te = (const int*)(ws + WS_TOKE); const bf16_t* Y = (const bf16_t*)(ws + A_Y);
    auto slot_of = [&](int p) { return (int)F.MISC[16 + te[p]] * 256 + tlr[p]; };
    auto clampr = [&](int r) { return r < MT ? r : MT - 1; };
    int r = gw; if (r >= MT) return;
    int s0 = slot_of(2 * r), s1 = slot_of(2 * r + 1);
    int rn = clampr(r + NGW); int sn0 = slot_of(2 * rn), sn1 = slot_of(2 * rn + 1);
    const bf16_t* XBp = (const bf16_t*)(ws + WS_XB);
    u32x2 xv[4]; u32x2 ya[4], yb[4];
#pragma unroll
    for (int j = 0; j < 4; ++j) { xv[j] = ((const GAS u32x2*)(XBp + (size_t)r * DM) + lane)[64 * j]; ya[j] = ((const GAS u32x2*)(Y + (size_t)s0 * DM) + lane)[64 * j]; yb[j] = ((const GAS u32x2*)(Y + (size_t)s1 * DM) + lane)[64 * j]; }
    for (; r < MT; r += NGW) {
        const int rnn = clampr(r + 2 * NGW); const int snn0 = slot_of(2 * rnn), snn1 = slot_of(2 * rnn + 1);
        u32x2 xn[4]; u32x2 yan[4], ybn[4];
#pragma unroll
        for (int j = 0; j < 4; ++j) { xn[j] = ((const GAS u32x2*)(XBp + (size_t)rn * DM) + lane)[64 * j]; yan[j] = ((const GAS u32x2*)(Y + (size_t)sn0 * DM) + lane)[64 * j]; ybn[j] = ((const GAS u32x2*)(Y + (size_t)sn1 * DM) + lane)[64 * j]; }
        GAS f32x4* xr = (GAS f32x4*)(F.out + (size_t)r * DM) + lane;
        f32x4 v[4]; float s = 0.f;
#pragma unroll
        for (int j = 0; j < 4; ++j) { const u32x2 p0 = ya[j], p1 = yb[j]; f32x4 x = {bflo(xv[j].x), bfhi(xv[j].x), bflo(xv[j].y), bfhi(xv[j].y)};
            const float dm = F.dry ? 0.f : 1.f; x.x += dm * (bflo(p0.x) + bflo(p1.x)); x.y += dm * (bfhi(p0.x) + bfhi(p1.x)); x.z += dm * (bflo(p0.y) + bflo(p1.y)); x.w += dm * (bfhi(p0.y) + bfhi(p1.y));
            v[j] = x; s += (x.x * x.x + x.y * x.y) + (x.z * x.z + x.w * x.w); }
        const float rstd = __builtin_amdgcn_rsqf(wave_sum(s) * (1.f / DM) + EPS);
        if (l == DEPTH - 1) { const GAS f32x4* g = (const GAS f32x4*)IN_F(19) + lane;
#pragma unroll
            for (int j = 0; j < 4; ++j) xr[64 * j] = v[j] * rstd * g[64 * j];
        } else {
            GAS u32x2* o8 = (GAS u32x2*)((bf16_t*)(ws + WS_XB) + (size_t)r * DM) + lane;
#pragma unroll
            for (int j = 0; j < 4; ++j) { u32x2 w; w.x = cvt_pk_bf16(v[j].x, v[j].y); w.y = cvt_pk_bf16(v[j].z, v[j].w); o8[64 * j] = w; }
            if (lane == 0) ((float*)(ws + WS_RSTD))[r] = rstd;
        }
#pragma unroll
        for (int j = 0; j < 4; ++j) { xv[j] = xn[j]; ya[j] = yan[j]; yb[j] = ybn[j]; }
        rn = rnn; sn0 = snn0; sn1 = snn1;
    }
}

constexpr int NPHASE = 1 + 11 * DEPTH + (PROBE_P >= 0 ? PROBE_N - 1 : 0);
__global__ void __launch_bounds__(NTHR, 2) fwd(Args a) {
    extern __shared__ __attribute__((aligned(16))) unsigned char lds_raw[];
    Frame F;
    F.lds = (LAS unsigned char*)lds_raw; F.MISC = (volatile LAS unsigned*)(F.lds + MISC_OFF);
    F.tid = threadIdx.x; F.lane = F.tid & 63; F.wave = __builtin_amdgcn_readfirstlane(F.tid >> 6);
    F.G = gridDim.x; { const int bx = blockIdx.x; F.vcu = (F.G % 8 == 0) ? (bx % 8) * (F.G / 8) + bx / 8 : bx; }
    F.ws = a.ws; F.ctl = (gu32*)(a.ws + WS_CTL); F.out = a.out; F.z = 0;
    for (int u = F.tid; u < (LDS_BYTES - LDSCTL_OFF) / 4; u += NTHR) ((LAS unsigned*)(F.lds + LDSCTL_OFF))[u] = 0u;
    __syncthreads();
    XcdBarrier bar; bar.bar = (unsigned*)(F.ctl + CW_BAR); bar.x = 0; bar.st = nullptr;
    const bool one_launch = (a.ph_hi - a.ph_lo) > 1;
    if (one_launch) bar = xcd_barrier_post((unsigned*)(F.ctl + CW_BAR), F.MISC + 8);
    for (int pp = a.ph_lo; pp < a.ph_hi; ++pp) {
        int ph = pp;
        F.dry = 0;
        if (PROBE_P >= 0) { constexpr int P = PROBE_P; if (pp > P) ph = (pp - (PROBE_N - 1) > P) ? pp - (PROBE_N - 1) : P; if (ph == P && pp < P + PROBE_N - 1) F.dry = 1; }
        { int t_ = threadIdx.x; asm volatile("" : "+v"(t_)); F.tid = t_; F.lane = t_ & 63; F.wave = __builtin_amdgcn_readfirstlane(t_ >> 6); }
        size_t z_ = 0; asm volatile("" : "+s"(z_)); F.z = z_; F.ws = a.ws + z_; F.out = (float*)((char*)a.out + z_); F.ctl = (gu32*)(a.ws + z_ + WS_CTL);
        unsigned char* ws = F.ws; int bx = (int)blockIdx.x; asm volatile("" : "+s"(bx));
        if (ph == 0) { if (PHSEL(0)) ph_init(F, a); }
        else {
            const int l = (ph - 1) / 11, qq = (ph - 1) % 11, q = qq < 5 ? qq : (qq < 8 ? qq + 1 : qq + 2);
            if (q == 0 && PHSEL(3)) {
                pg8::SchedDense S{64, 14, 896, F.G, bx, (const char*)(ws + WS_XB), (const char*)(ws + WS_WIN) + (size_t)l * NIN * DM * 2, (size_t)256 * DM * 2, (size_t)256 * DM * 2, 64, 0};
                EpiProj E{(bf16_t*)(ws + A_HG), (bf16_t*)(ws + A_QR), (bf16_t*)(ws + A_KF1), (bf16_t*)(ws + A_V), (const float*)(ws + WS_RSTD), (const f32x2*)(ws + WS_CS), (unsigned*)(F.ctl + CW_KMAX + l * 16)};
                pg8::gemm_phase<EpiProj, pg8::SchedDense, true, true, DM, DM>(F.lds, F.tid, S, E);
                if (l == 0) {
                    const bool part = (F.G == 256);
                    { size_t z2 = 0; asm volatile("" : "+s"(z2)); ws = F.ws + z2; F.ws = ws; int t2 = F.tid; asm volatile("" : "+v"(t2)); F.tid = t2; F.lane = t2 & 63; }
                    if (!part || (bx >= 128 && bx < 160)) { SchedKV SK{part ? 32 : F.G, part ? bx - 128 : bx, (const char*)(ws + WS_MEMN), (const char*)(ws + WS_WKVT)};
                        EpiKV EK{(bf16_t*)(ws + WS_KV), (bf16_t*)(ws + WS_KV) + (size_t)DEPTH * MEMROWS * DM};
                        pg8::gemm_phase<EpiKV, SchedKV, true, true, DM, DM>(F.lds, F.tid, SK, EK); }
                    if (!part || bx >= 160) conv_small_l1(F, a, part ? (bx - 160) * NWAVES + F.wave : F.vcu * NWAVES + F.wave, part ? 96 * NWAVES : F.G * NWAVES);
                }
            } else if (q == 1 && PHSEL(4)) {
                hg_lbt_to_lds(F, l);
                for (int rep = 0; rep < PROBE_PREP_N; ++rep) for (int u = F.vcu; u < (MT / 512) * ATH; u += F.G) vf_unit(F, u);
                for (int rep = 0; rep < PROBE_HGA_N; ++rep) { constexpr int NU = BATCH * HGH * NCHUNK; HgIn R = hg_load<false>(F, F.vcu < NU ? F.vcu : NU - 1);
                    for (int u = F.vcu; u < NU; u += F.G) { const HgIn Rn = hg_load<false>(F, u + F.G < NU ? u + F.G : NU - 1); hg_a2_unit(F, a, l, u, R); R = Rn; } __syncthreads(); }
                if (l == 0) {
                    { size_t z2 = 0; asm volatile("" : "+s"(z2)); ws = F.ws + z2; F.ws = ws; int t2 = F.tid; asm volatile("" : "+v"(t2)); F.tid = t2; F.lane = t2 & 63; }
                    SchedFold SF{F.G, bx, (const char*)(ws + WS_KV), (const char*)(ws + WS_KV) + (size_t)DEPTH * MEMROWS * DM * 2, (const char*)(ws + WS_WQS), (const char*)(ws + WS_WOT)};
                    EpiBf16 EF{(bf16_t*)(ws + WS_WQK), DM, (size_t)DM * DM, 1.f};
                    pg8::gemm_phase<EpiBf16, SchedFold, true, true, DM, 256>(F.lds, F.tid, SF, EF); }
            } else if (q == 2 && PHSEL(5)) hg_scan(F);
            else if (q == 3 && PHSEL(6)) {
                hg_lbt_to_lds(F, l);
                for (int rep = 0; rep < PROBE_HGC_N; ++rep) { constexpr int NU = BATCH * HGH * NCHUNK; HgIn R = hg_load<true>(F, F.vcu < NU ? F.vcu : NU - 1);
                    for (int u = F.vcu; u < NU; u += F.G) { const HgIn Rn = hg_load<true>(F, u + F.G < NU ? u + F.G : NU - 1); if (rep + 1 < PROBE_HGC_N) hg_c2_unit<PROBE_HGC_STOP>(F, a, l, u, R); else hg_c2_unit<0>(F, a, l, u, R); R = Rn; } __syncthreads(); }
#if ATT_GOLDEN
                for (int t = F.vcu * NWAVES + F.wave; t < (MT / 64) * ATH; t += F.G * NWAVES) att_task(F, t);
#else
                for (int rep = 0; rep < PROBE_ATT_N; ++rep) for (int u = F.vcu; u < (MT / 512) * ATH; u += F.G) att_unit(F, l, u);
#endif
            } else if (q == 4 && PHSEL(7)) {
                pg8::SchedDense S{64, 4, 256, F.G, bx, (const char*)YMIX_PTR(l), (const char*)(ws + WS_WOUT) + (size_t)l * DM * DM * 2, (size_t)256 * DM * 2, (size_t)256 * DM * 2, 64, 0};
                EpiResNorm E{IN_F(0), l == 0 ? nullptr : (const bf16_t*)(ws + WS_XB), (bf16_t*)(ws + A_XB2), (float*)(ws + WS_SSQP)};
                pg8::gemm_phase<EpiResNorm, pg8::SchedDense, true, true, DM, DM>(F.lds, F.tid, S, E);
            } else if (q == 5 && PHSEL(8)) ph_norm(F, a);
            else if (q == 6 && PHSEL(9)) {
                pg8::SchedDense S{64, 4, 256, F.G, bx, (const char*)(ws + A_XB2), (const char*)(ws + WS_WQK) + (size_t)l * 2 * DM * DM * 2, (size_t)256 * DM * 2, (size_t)256 * DM * 2, 32, (size_t)DM * DM * 2};
                EpiSoftmax E{(bf16_t*)(ws + A_P), (const float*)(ws + WS_SSQP)};
                pg8::gemm_phase<EpiSoftmax, pg8::SchedDense, true, true, DM, DM>(F.lds, F.tid, S, E);
            } else if (q == 7 && PHSEL(10)) {
                pg8::SchedDense S{64, 4, 256, F.G, bx, (const char*)(ws + A_P), (const char*)(ws + WS_WVO) + (size_t)l * 2 * DM * DM * 2, (size_t)256 * DM * 2, (size_t)256 * DM * 2, 32, (size_t)DM * DM * 2};
                EpiResAddB E{(const bf16_t*)(ws + A_XB2), (bf16_t*)(ws + WS_XB)};
                pg8::gemm_phase<EpiResAddB, pg8::SchedDense, true, true, DM, DM>(F.lds, F.tid, S, E);
            } else if (q == 8 && PHSEL(11)) ph_router(F, a, l);
            else if (q == 10 && PHSEL(13)) {
                moe_prefix(F, l);
                const int total = __builtin_amdgcn_readfirstlane((int)F.MISC[32]) * 4, early = (total / F.G) * F.G;
                SchedMoe S{F.G, bx, DM, F.MISC + 16, (const char*)(ws + WS_XB), (const char*)(ws + A_WGU), (const int*)(ws + A_PERM2), (const unsigned*)(F.ctl + CW_CNT + l * 16 * 64), true, 1, early, total - early, nullptr};
                EpiMoe1 E{(bf16_t*)(ws + A_ACTB), (const float*)(ws + A_SRS2), (const float*)(ws + A_SGW2)};
                pg8::gemm_phase<EpiMoe1, SchedMoe, true, true, DM, DM, true>(F.lds, F.tid, S, E);
            } else if (q == 11 && PHSEL(14)) {
                moe_prefix(F, l);
                const int total = __builtin_amdgcn_readfirstlane((int)F.MISC[32]) * 4, early = (total / F.G) * F.G, rem = total - early;
                unsigned* done = (unsigned*)(F.ctl + CW_DONE + l * 256);
                if (bx < rem) {
                    SchedMoe S{F.G, bx, DM, F.MISC + 16, (const char*)(ws + WS_XB), (const char*)(ws + A_WGU), (const int*)(ws + A_PERM2), (const unsigned*)(F.ctl + CW_CNT + l * 16 * 64), true, 2, early, rem, nullptr};
                    EpiMoe1 E{(bf16_t*)(ws + A_ACTB), (const float*)(ws + A_SRS2), (const float*)(ws + A_SGW2)};
                    pg8::gemm_phase<EpiMoe1, SchedMoe, true, true, DM, DM, true>(F.lds, F.tid, S, E);
                    if (F.tid == 0) { __builtin_amdgcn_fence(__ATOMIC_RELEASE, "agent"); asm volatile("s_waitcnt vmcnt(0)" ::: "memory"); __hip_atomic_fetch_add(done + ((early + bx) >> 2), 1u, __ATOMIC_RELAXED, __HIP_MEMORY_SCOPE_AGENT); }
                }
                { size_t z2 = 0; asm volatile("" : "+s"(z2)); ws = F.ws + z2; F.ws = ws; int t2 = F.tid; asm volatile("" : "+v"(t2)); F.tid = t2; F.lane = t2 & 63; }
                SchedMoe S{F.G, bx, EFF, F.MISC + 16, (const char*)(ws + A_ACTB), (const char*)(ws + A_WD), nullptr, nullptr, false, 3, early, rem, done};
                EpiBf16 E{(bf16_t*)(ws + A_Y), DM, 0, 1.f};
                pg8::gemm_phase<EpiBf16, SchedMoe, true, true, EFF, EFF>(F.lds, F.tid, S, E);
            } else if (q == 12 && PHSEL(15)) ph_combine(F, a, l);
        }
        if (pp + 1 < a.ph_hi) xcd_barrier(bar);
    }
}

extern "C" void kernel_launch(void* const* d_in, const int* in_sizes, int n_in, void* d_out, int out_size, void* d_ws, size_t ws_size, hipStream_t stream) {
    static int grid = 0;
    if (grid == 0) {
        if (n_in != 20 || in_sizes[0] != MT * DM || out_size != MT * DM || ws_size < WS_END) { fprintf(stderr, "kernel_launch: unexpected shapes / workspace (%d inputs, ws %zu)\n", n_in, ws_size); grid = -1; return; }
        int dev = 0, cus = 0, per_cu = 0;
        if (hipGetDevice(&dev) != hipSuccess || hipDeviceGetAttribute(&cus, hipDeviceAttributeMultiprocessorCount, dev) != hipSuccess) { grid = -1; return; }
        if (hipFuncSetAttribute((const void*)fwd, hipFuncAttributeMaxDynamicSharedMemorySize, LDS_BYTES) != hipSuccess) { grid = -1; return; }
        if (hipOccupancyMaxActiveBlocksPerMultiprocessor(&per_cu, (const void*)fwd, NTHR, LDS_BYTES) != hipSuccess || per_cu < 1) { fprintf(stderr, "kernel_launch: occupancy query says %d\n", per_cu); per_cu = 1; }
        (void)hipGetLastError();
        grid = cus * 1;
    }
    if (grid < 0) return;
    (void)hipMemsetAsync((char*)d_ws + WS_CTL, 0, CTL_ZERO_BYTES, stream);
    Args a{};
    for (int i = 0; i < 20; ++i) a.in[i] = d_in[i];
    a.out = (float*)d_out; a.ws = (unsigned char*)d_ws;
#if MK_PER_PHASE
    for (int ph = 0; ph < NPHASE; ++ph) { a.ph_lo = ph; a.ph_hi = ph + 1; hipLaunchKernelGGL(fwd, dim3(grid), dim3(NTHR), LDS_BYTES, stream, a); }
#else
    a.ph_lo = 0; a.ph_hi = NPHASE;
    void* kargs[] = {&a};
    hipError_t e = hipLaunchCooperativeKernel((const void*)fwd, dim3(grid), dim3(NTHR), kargs, LDS_BYTES, stream);
    if (e != hipSuccess) fprintf(stderr, "cooperative launch failed: %s (grid %d)\n", hipGetErrorString(e), grid);
#endif
}
```

```cpp
#include <hip/hip_runtime.h>
#include <cstdio>
#include <cstdint>

#ifndef PH_MASK
#define PH_MASK 0xFFFFFFFFu
#endif
#define PHSEL(n) ((PH_MASK >> (n)) & 1u)
#ifndef PROBE_ATT_N
#define PROBE_ATT_N 1
#endif
#ifndef PROBE_HGC_N
#define PROBE_HGC_N 1
#endif
#ifndef PROBE_HGA_N
#define PROBE_HGA_N 1
#endif
#ifndef PROBE_PREP_N
#define PROBE_PREP_N 1
#endif
#ifndef PROBE_HGC_STOP
#define PROBE_HGC_STOP 0
#endif
#ifndef PROBE_P
#define PROBE_P -1
#endif
#ifndef PROBE_N
#define PROBE_N 1
#endif
#ifndef HG_A_GOLDEN
#define HG_A_GOLDEN 0
#endif
#ifndef HG_C_GOLDEN
#define HG_C_GOLDEN 0
#endif
#ifndef ATT_GOLDEN
#define ATT_GOLDEN 0
#endif
#ifndef MK_PER_PHASE
#define MK_PER_PHASE 0
#endif

#define LAS __attribute__((address_space(3)))
#define GAS __attribute__((address_space(1)))
typedef unsigned short bf16_t;
typedef short bf16x8 __attribute__((ext_vector_type(8)));
typedef float f32x4 __attribute__((ext_vector_type(4)));
typedef float f32x2 __attribute__((ext_vector_type(2)));
typedef unsigned u32x4 __attribute__((ext_vector_type(4)));
typedef unsigned u32x2 __attribute__((ext_vector_type(2)));
typedef GAS unsigned gu32;

constexpr int BATCH = 2, SEQ = 8192, DM = 1024, MT = BATCH * SEQ, DEPTH = 2;
constexpr int MEM_LEN = 256, MEMROWS = BATCH * MEM_LEN;
constexpr int NIN = 3584, HGW = 512, HGH = 4, HGD = 128, CHUNK = 64, NCHUNK = SEQ / CHUNK;
constexpr int ATW = 512, ATH = 8, ATD = 64;
constexpr int NEXP = 16, EFF = 512;
constexpr float EPS = 1e-6f;
constexpr int NWAVES = 8, NTHR = 512;

constexpr size_t MiB = 1u << 20;
constexpr size_t WS_CTL = 0, CTL_ZERO_BYTES = 1 * MiB;
constexpr size_t WS_RSTD = 1 * MiB;
constexpr size_t WS_TOKE = WS_RSTD + 64 * 1024;
constexpr size_t WS_TOKW = WS_TOKE + 128 * 1024;
constexpr size_t WS_TOKL = WS_TOKW + 128 * 1024;
constexpr size_t WS_SLOTRS = WS_TOKL + 128 * 1024;
constexpr size_t WS_SLOTGW = WS_SLOTRS + 160 * 1024;
constexpr size_t WS_PERM = WS_SLOTGW + 160 * 1024;
constexpr size_t WS_WR = 3 * MiB;
constexpr size_t WS_LBT = 3 * MiB + 256 * 1024;
constexpr size_t WS_SSQP = 3 * MiB + 512 * 1024;
constexpr size_t WS_XB = 4 * MiB;
constexpr size_t WS_WIN = 36 * MiB;
constexpr size_t WS_WOUT = 50 * MiB;
constexpr size_t WS_WQS = 54 * MiB;
constexpr size_t WS_WKVT = 58 * MiB;
constexpr size_t WS_WOT = 66 * MiB;
constexpr size_t WS_MEMN = 70 * MiB;
constexpr size_t WS_KV = 72 * MiB;
constexpr size_t WS_WQK = 76 * MiB;
constexpr size_t WS_WVO = 84 * MiB;
constexpr size_t WS_ACT = 92 * MiB;
constexpr size_t WS_CS = 320 * MiB;
constexpr size_t WS_END = 324 * MiB;
constexpr size_t A_HG = WS_ACT + 0 * MiB;
constexpr size_t A_KF1 = WS_ACT + 64 * MiB;
constexpr size_t A_KF4 = WS_ACT + 80 * MiB;
constexpr size_t A_KF16 = WS_ACT + 96 * MiB;
constexpr size_t A_QR = WS_ACT + 112 * MiB;
constexpr size_t A_V = WS_ACT + 128 * MiB;
constexpr size_t A_VT1 = WS_ACT + 144 * MiB;
constexpr size_t A_VT4 = WS_ACT + 160 * MiB;
constexpr size_t A_VT16 = WS_ACT + 176 * MiB;
constexpr size_t A_STATE = WS_ACT + 192 * MiB;
constexpr size_t A_DECAY = WS_ACT + 224 * MiB;
constexpr size_t A_XB2 = WS_ACT + 0 * MiB;
constexpr size_t A_P = WS_ACT + 32 * MiB;
constexpr size_t A_WGU = WS_ACT + 0 * MiB;
constexpr size_t A_WD = WS_ACT + 32 * MiB;
constexpr size_t A_PERM2 = WS_ACT + 48 * MiB;
constexpr size_t A_SRS2 = WS_ACT + 49 * MiB;
constexpr size_t A_SGW2 = WS_ACT + 50 * MiB;
constexpr size_t A_ACTB = WS_ACT + 120 * MiB;
constexpr size_t A_Y = WS_ACT + 156 * MiB;
constexpr int MAXSLOT = 2 * MT + NEXP * 256;
static_assert(A_Y + (size_t)MAXSLOT * 1024 * 2 <= WS_END, "ws map");
constexpr int CW_BAR = 4096;
constexpr int CW_KMAX = 12288;
constexpr int CW_DONE = 24576;
constexpr int CW_CHAIN = 32768;
constexpr int CW_CNT = 16384;
constexpr int RING_BYTES = 131072;
constexpr int SPARE_OFF = RING_BYTES;
constexpr int LDSCTL_OFF = RING_BYTES + 8192, MISC_OFF = LDSCTL_OFF + 64;
constexpr int LDS_BYTES = 147456;

#define RLX_AGENT __ATOMIC_RELAXED, __HIP_MEMORY_SCOPE_AGENT
#define LDS_WAIT() asm volatile("s_waitcnt lgkmcnt(0)" ::: "memory")
#define VM_WAIT() asm volatile("s_waitcnt vmcnt(0)" ::: "memory")

__device__ __forceinline__ unsigned f2bf(float f) { unsigned u = __builtin_bit_cast(unsigned, f); return (u + 0x7fffu + ((u >> 16) & 1u)) >> 16; }
__device__ __forceinline__ unsigned pk2(float lo, float hi) { return f2bf(lo) | (f2bf(hi) << 16); }
__device__ __forceinline__ float bf2f(unsigned short h) { return __builtin_bit_cast(float, (unsigned)h << 16); }
__device__ __forceinline__ float bflo(unsigned w) { return __builtin_bit_cast(float, w << 16); }
__device__ __forceinline__ float bfhi(unsigned w) { return __builtin_bit_cast(float, w & 0xffff0000u); }
typedef __bf16 bf16x2_t __attribute__((ext_vector_type(2)));
__device__ __forceinline__ unsigned cvt_pk_bf16(float lo, float hi) { f32x2 v = {lo, hi}; bf16x2_t b = __builtin_convertvector(v, bf16x2_t); return __builtin_bit_cast(unsigned, b); }
__device__ __forceinline__ float wave_sum(float v) {
#pragma unroll
    for (int o = 1; o < 64; o <<= 1) v += __shfl_xor(v, o);
    return v;
}
__device__ __forceinline__ float sigmoidf_(float z) { return __builtin_amdgcn_rcpf(1.f + __builtin_amdgcn_exp2f(-1.4426950408889634f * z)); }
__device__ __forceinline__ float ex2(float x) { return __builtin_amdgcn_exp2f(x); }
constexpr float LOG2E = 1.4426950408889634f;

#define XB_TMO      128
#define XB_XCNT(j)  (256  + 64 * (j))
#define XB_XSUB(j)  (1280 + 64 * (j))
#define XB_XGEN(j)  (2304 + 64 * (j))
#define XB_TOP      3328
#define XB_TOPGEN   3392
#define XCD_BAR_WORDS 3456
#define XB_SPIN_CAP (1u << 18)
__device__ __forceinline__ unsigned xb_ld(unsigned* p)              { return __hip_atomic_load(p, __ATOMIC_RELAXED, __HIP_MEMORY_SCOPE_AGENT); }
__device__ __forceinline__ unsigned xb_add(unsigned* p, unsigned v) { return __hip_atomic_fetch_add(p, v, __ATOMIC_RELAXED, __HIP_MEMORY_SCOPE_AGENT); }
__device__ __forceinline__ unsigned xb_xcc_id() { return (unsigned)__builtin_amdgcn_s_getreg((3 << 11) | 20) & 0xFu; }
#define XB_SPIN(cond, bar) do { unsigned _sp = 0; while (cond) { __builtin_amdgcn_s_sleep(1); \
    if ((++_sp & 255u) == 0u) { if (xb_ld(&(bar)[XB_TMO])) break; if (_sp > XB_SPIN_CAP) { atomicAdd(&(bar)[XB_TMO], 1u); break; } } } } while (0)
struct XcdBarrier { unsigned* bar; unsigned x; volatile LAS unsigned* st; };
__device__ __forceinline__ XcdBarrier xcd_barrier_post(unsigned* bar, volatile LAS unsigned* st) {
    XcdBarrier b; b.bar = bar; b.x = xb_xcc_id(); b.st = st;
    if (threadIdx.x == 0) st[3] = xb_add(&bar[XB_XCNT(b.x)], 1u);
    return b;
}
__device__ __forceinline__ void xcd_barrier_complete(unsigned* bar, unsigned x, unsigned& nloc, unsigned& nx, unsigned& uni) {
    const unsigned G = gridDim.x * gridDim.y * gridDim.z;
    unsigned sum, cnt, mine, sp = 0u;
    for (;;) {
        sum = 0u; cnt = 0u; mine = 0u;
        unsigned cv[16];
#pragma unroll
        for (unsigned j = 0; j < 16; ++j) cv[j] = xb_ld(&bar[XB_XCNT(j)]);
#pragma unroll
        for (unsigned j = 0; j < 16; ++j) { const unsigned c = cv[j]; sum += c; cnt += (c > 0u) ? 1u : 0u; mine = (j == x) ? c : mine; }
        if (sum == G) break;
        __builtin_amdgcn_s_sleep(1);
        if ((++sp & 255u) == 0u) { if (xb_ld(&bar[XB_TMO])) break; if (sp > XB_SPIN_CAP) { atomicAdd(&bar[XB_TMO], 1u); break; } }
    }
    nloc = mine > 0u ? mine : 1u; nx = cnt > 0u ? cnt : 1u;
    unsigned u8 = (sum == 256u && G == 256u) ? 1u : 0u;
#pragma unroll
    for (unsigned j = 0; j < 8; ++j) u8 &= (xb_ld(&bar[XB_XCNT(j)]) == 32u) ? 1u : 0u;
    uni = u8;
}
__device__ __forceinline__ void xcd_barrier(const XcdBarrier& b) {
    asm volatile("s_waitcnt vmcnt(0)" ::: "memory");
    __syncthreads();
    if (threadIdx.x == 0) {
        unsigned* bar = b.bar;
        __builtin_amdgcn_s_waitcnt(0);
        unsigned nloc = b.st[0], nx = b.st[1];
        if (nloc == 0u) { unsigned uni; xcd_barrier_complete(bar, b.x, nloc, nx, uni); b.st[0] = nloc; b.st[1] = nx; b.st[2] = uni; }
        const unsigned old = xb_add(&bar[XB_XSUB(b.x)], 1u);
        const unsigned gen = old / nloc;
        if (old + 1u == (gen + 1u) * nloc) {
            __builtin_amdgcn_fence(__ATOMIC_RELEASE, "agent");
            asm volatile("s_waitcnt vmcnt(0)" ::: "memory");
            const unsigned og = xb_add(&bar[XB_TOP], 1u);
            const unsigned tg = og / nx;
            if (og + 1u == (tg + 1u) * nx) xb_add(&bar[XB_TOPGEN], 1u);
            else XB_SPIN(xb_ld(&bar[XB_TOPGEN]) == tg, bar);
            __builtin_amdgcn_fence(__ATOMIC_ACQUIRE, "agent");
            xb_add(&bar[XB_XGEN(b.x)], 1u);
            asm volatile("s_waitcnt vmcnt(0)" ::: "memory");
        } else {
            XB_SPIN(xb_ld(&bar[XB_XGEN(b.x)]) == gen, bar);
            __builtin_amdgcn_fence(__ATOMIC_ACQUIRE, "agent");
            asm volatile("s_waitcnt vmcnt(0)" ::: "memory");
        }
    }
    __syncthreads();
}

namespace pg8 {
constexpr int BM = 256, BK = 64, HALF = 128, HTB = HALF * BK * 2, STAGE_BYTES = 8 * HTB, NXCD = 8, WGM = 8;
__host__ __device__ __forceinline__ int lds_byte(int r, int c) { const int st = (r >> 4) * 2 + (c >> 5), rr = r & 15, cc = c & 31, ob = rr * 64 + cc * 2; return st * 1024 + (ob ^ (((ob >> 9) & 1) << 5)); }
__host__ __device__ __forceinline__ void stage_rc(int b, int& R, int& C) { const int st = b / 1024, sb = b % 1024, swz = sb ^ (((sb >> 9) & 1) << 5); R = (st >> 1) * 16 + swz / 64; C = (st & 1) * 32 + (swz % 64) / 2; }
__host__ __device__ __forceinline__ int perm32(int rho) { const int n = rho >> 4, i = rho & 15; return 8 * (i >> 2) + 4 * n + (i & 3); }

struct Unit { int pm, pn, aux, lr; const char* a; const char* b; };
typedef f32x4 Acc[2][2][4][2];

template <class S> __device__ __forceinline__ auto pre_a_call(const S& s, const Unit& u, int) -> decltype(s.pre_a(u), void()) { s.pre_a(u); }
template <class S> __device__ __forceinline__ void pre_a_call(const S&, const Unit&, long) {}
template <class Epi, class Sched, bool ALIGN_EPI, bool SP2, int LD, int K, bool GATHER = false>
__device__ __forceinline__ void gemm_phase(LAS unsigned char* lds, const int tid, const Sched& S, const Epi& E) {
    constexpr int lda = LD, ldb = LD;
    const int wid = __builtin_amdgcn_readfirstlane(tid >> 6), lane = tid & 63, wr = wid >> 2, wc = wid & 3, fr = lane & 15, fq = lane >> 4;
    constexpr int nt = K / BK;
    unsigned voffA[2], voffB[2];
#pragma unroll
    for (int i = 0; i < 2; ++i) { int R, C; stage_rc(tid * 16 + i * 8192, R, C); const int Rb = Epi::PERM ? ((R & ~31) + perm32(R & 31)) : R;
        voffA[i] = (unsigned)(R * lda + C) * 2u; voffB[i] = (unsigned)(Rb * ldb + C) * 2u; }
    const size_t kstep = (size_t)(BK * 2);
    const size_t hstepA = (size_t)HALF * lda * 2, hstepB = (size_t)HALF * ldb * 2;
    const unsigned ldsw = (unsigned)wid * 1024u;
    const int aoff = lds_byte(wr * 64 + fr, fq * 8), boff = lds_byte(wc * 32 + fr, fq * 8);
#define PG8_SA(b, h) (((b) * 2 + (h)) * HTB)
#define PG8_SB(b, h) ((4 + (b) * 2 + (h)) * HTB)
#define PG8_STAGE(bufoff, gbase, voff) do { _Pragma("unroll") for (int _i = 0; _i < 2; ++_i) \
        __builtin_amdgcn_global_load_lds((const unsigned*)((const char*)(gbase) + (voff)[_i]), (LAS unsigned*)(lds + (bufoff) + ldsw + _i * 8192), 16, 0, 0); } while (0)
#define PG8_STAGE_A(bufoff, gbase, half, usenext) do { if constexpr (GATHER) { const unsigned _p = (usenext) ? vn[half] : vc[half]; unsigned _v[2]; _v[0] = (_p & 0xffffu) * (unsigned)(lda * 2) + gc2; _v[1] = (_p >> 16) * (unsigned)(lda * 2) + gc2; PG8_STAGE(bufoff, gbase, _v); } \
        else { PG8_STAGE(bufoff, (gbase) + (half) * hstepA, voffA); } } while (0)
#define PG8_LDA(dst, b, h) do { _Pragma("unroll") for (int m = 0; m < 4; ++m) _Pragma("unroll") for (int k = 0; k < 2; ++k) dst[m][k] = *(const LAS bf16x8*)(lds + PG8_SA(b, h) + aoff + m * 2048 + k * 1024); } while (0)
#define PG8_LDB(dst, b, h) do { _Pragma("unroll") for (int n = 0; n < 2; ++n) _Pragma("unroll") for (int k = 0; k < 2; ++k) dst[n][k] = *(const LAS bf16x8*)(lds + PG8_SB(b, h) + boff + n * 2048 + k * 1024); } while (0)
#define PG8_MMA(ai, bj, At, Bt) do { __builtin_amdgcn_s_setprio(1); _Pragma("unroll") for (int m = 0; m < 4; ++m) _Pragma("unroll") for (int n = 0; n < 2; ++n) _Pragma("unroll") for (int k = 0; k < 2; ++k) \
        acc[ai][bj][m][n] = __builtin_amdgcn_mfma_f32_16x16x32_bf16(Bt[n][k], At[m][k], acc[ai][bj][m][n], 0, 0, 0); __builtin_amdgcn_s_setprio(0); } while (0)
#define PG8_WAIT_V(n) asm volatile("s_waitcnt vmcnt(" #n ")" ::: "memory")
#define PG8_WAIT_L(n) asm volatile("s_waitcnt lgkmcnt(" #n ")" ::: "memory")
#define PG8_BAR __builtin_amdgcn_s_barrier()
#define PG8_SCHED __builtin_amdgcn_sched_barrier(0)
    Unit cur, nxt; int ui = 0;
    if (!S.next(0, cur)) return;
    Acc acc;
#pragma unroll
    for (int a = 0; a < 2; ++a)
#pragma unroll
        for (int b = 0; b < 2; ++b)
#pragma unroll
            for (int m = 0; m < 4; ++m)
#pragma unroll
                for (int n = 0; n < 2; ++n) acc[a][b][m][n] = (f32x4){0.f, 0.f, 0.f, 0.f};
    bf16x8 At[4][2], B0[2][2], B1[2][2];
    const char* cA = cur.a; const char* cB = cur.b;
    unsigned vc[2], vn[2], gc2 = 0;
    if constexpr (GATHER) { int R0, C0; stage_rc(tid * 16, R0, C0); gc2 = (unsigned)C0 * 2u;
#pragma unroll
        for (int h = 0; h < 2; ++h) { vc[h] = (unsigned)S.src_row(cur, 128 * h + R0) | ((unsigned)S.src_row(cur, 128 * h + R0 + 64) << 16); vn[h] = vc[h]; }
    }
    static_assert(SP2, "only the two-MFMA-blocks-per-barrier-pair loop is kept");
    {
        PG8_STAGE(PG8_SB(0, 0), cB, voffB); PG8_STAGE(PG8_SB(0, 1), cB + hstepB, voffB); pre_a_call(S, cur, 0);
        PG8_STAGE_A(PG8_SA(0, 0), cA, 0, false); PG8_STAGE_A(PG8_SA(0, 1), cA, 1, false);
        if (wr == 1) PG8_BAR;
        PG8_WAIT_V(2); PG8_BAR;
        PG8_STAGE(PG8_SB(1, 0), cB + kstep, voffB); PG8_STAGE_A(PG8_SA(1, 0), cA + kstep, 0, false); PG8_STAGE(PG8_SB(1, 1), cB + hstepB + kstep, voffB);
        PG8_WAIT_V(6); PG8_BAR;
    }
    for (;;) {
        const bool has_next = S.next(ui + 1, nxt);
        const char* nA = has_next ? nxt.a : cA; const char* nB = has_next ? nxt.b : cB;
        if constexpr (GATHER) { if (has_next) { int R0, C0; stage_rc(tid * 16, R0, C0);
#pragma unroll
            for (int h = 0; h < 2; ++h) vn[h] = (unsigned)S.src_row(nxt, 128 * h + R0) | ((unsigned)S.src_row(nxt, 128 * h + R0 + 64) << 16); } }
#pragma nounroll
        for (int t = 0; t < nt; t += 2) {
            const bool last = (t == nt - 2);
            const char* a1 = cA + (size_t)(t + 1) * kstep;
            const char* a2 = last ? nA : cA + (size_t)(t + 2) * kstep; const char* b2 = last ? nB : cB + (size_t)(t + 2) * kstep;
            const char* a3 = a2 + kstep; const char* b3 = b2 + kstep;
            {
            PG8_LDB(B0, 0, 0); PG8_LDB(B1, 0, 1); PG8_SCHED; PG8_LDA(At, 0, 0); PG8_STAGE_A(PG8_SA(1, 1), a1, 1, false);
            PG8_WAIT_V(8); PG8_WAIT_L(0); PG8_BAR; PG8_MMA(0, 0, At, B0); PG8_MMA(0, 1, At, B1); PG8_BAR; PG8_SCHED;
            PG8_LDA(At, 0, 1); PG8_STAGE(PG8_SB(0, 0), b2, voffB); PG8_STAGE(PG8_SB(0, 1), b2 + hstepB, voffB); PG8_STAGE_A(PG8_SA(0, 0), a2, 0, last);
            PG8_WAIT_V(8); PG8_WAIT_L(0); PG8_BAR; PG8_MMA(1, 0, At, B0); PG8_MMA(1, 1, At, B1); PG8_BAR; PG8_SCHED;
            PG8_LDB(B0, 1, 0); PG8_LDB(B1, 1, 1); PG8_SCHED; PG8_LDA(At, 1, 0); PG8_STAGE_A(PG8_SA(0, 1), a2, 1, last);
            PG8_WAIT_V(8); PG8_WAIT_L(0); PG8_BAR; PG8_MMA(0, 0, At, B0); PG8_MMA(0, 1, At, B1); PG8_BAR; PG8_SCHED;
            PG8_LDA(At, 1, 1); PG8_STAGE(PG8_SB(1, 0), b3, voffB); PG8_STAGE(PG8_SB(1, 1), b3 + hstepB, voffB); PG8_STAGE_A(PG8_SA(1, 0), a3, 0, last);
            PG8_WAIT_V(8); PG8_WAIT_L(0); PG8_BAR; PG8_MMA(1, 0, At, B0); PG8_MMA(1, 1, At, B1); PG8_BAR; PG8_SCHED;
            }
        }
        if constexpr (ALIGN_EPI) { if (wr == 0) PG8_BAR; }
        E(acc, cur, wr, wc, fr, fq, lds);
        if (!has_next) break;
#pragma unroll
        for (int a = 0; a < 2; ++a)
#pragma unroll
            for (int b = 0; b < 2; ++b)
#pragma unroll
                for (int m = 0; m < 4; ++m)
#pragma unroll
                    for (int n = 0; n < 2; ++n) acc[a][b][m][n] = (f32x4){0.f, 0.f, 0.f, 0.f};
        cur = nxt; cA = nA; cB = nB; ++ui;
        if constexpr (GATHER) { vc[0] = vn[0]; vc[1] = vn[1]; }
        if constexpr (ALIGN_EPI) { if (wr == 1) PG8_BAR; }
    }
    PG8_WAIT_V(0);
    if constexpr (!ALIGN_EPI) { if (wr == 0) PG8_BAR; }
    PG8_BAR;
#undef PG8_SA
#undef PG8_SB
#undef PG8_STAGE
#undef PG8_STAGE_A
#undef PG8_LDA
#undef PG8_LDB
#undef PG8_MMA
#undef PG8_WAIT_V
#undef PG8_WAIT_L
#undef PG8_BAR
#undef PG8_SCHED
}

struct SchedDense {
    int nM, nN, nwg, G, c; const char* A; const char* B; size_t a_tile, b_tile; int pm_per_batch; size_t b_batch;
    __device__ __forceinline__ bool next(int i, Unit& u) const {
        const long L = (long)i * G + c; if (L >= nwg) return false;
        int wgid = (int)L; { const int q = nwg / NXCD, r = nwg % NXCD, xcd = wgid % NXCD, off = wgid / NXCD; wgid = (xcd < r ? xcd * (q + 1) : r * (q + 1) + (xcd - r) * q) + off; }
        const int nig = WGM * nN, gid = wgid / nig, fm = gid * WGM, gsz = (nM - fm) < WGM ? (nM - fm) : WGM;
        u.pm = fm + ((wgid % nig) % gsz); u.pn = (wgid % nig) / gsz; u.aux = 0;
        u.a = A + (size_t)u.pm * a_tile; u.b = B + (size_t)u.pn * b_tile + (size_t)(u.pm / pm_per_batch) * b_batch; return true;
    }
};
struct SchedChain {
    SchedDense D; const unsigned* wait; int tid; bool same_xcd;
    __device__ __forceinline__ void dep(const Unit& u) const { if (wait) {
            if (tid == 0) { unsigned spins = 0; while (__hip_atomic_load(wait + u.pm * 32, __ATOMIC_RELAXED, __HIP_MEMORY_SCOPE_AGENT) < 4u) { __builtin_amdgcn_s_sleep(4); if (++spins > (1u << 20)) break; }
                __builtin_amdgcn_fence(__ATOMIC_ACQUIRE, "agent"); asm volatile("s_waitcnt vmcnt(0)" ::: "memory"); }
            __builtin_amdgcn_s_barrier(); asm volatile("" ::: "memory"); } }
    __device__ __forceinline__ bool next(int i, Unit& u) const { if (!D.next(i, u)) return false; if (i > 0) dep(u); return true; }
    __device__ __forceinline__ void pre_a(const Unit& u) const { dep(u); }
    __device__ __forceinline__ void signal(unsigned* sig) const { if (tid == 0) { if (!same_xcd) { __builtin_amdgcn_fence(__ATOMIC_RELEASE, "agent"); asm volatile("s_waitcnt vmcnt(0)" ::: "memory"); }
            Unit u; for (int i = 0; D.next(i, u); ++i) __hip_atomic_fetch_add(sig + u.pm * 32, 1u, __ATOMIC_RELAXED, __HIP_MEMORY_SCOPE_AGENT); } }
};
}
using pg8::Unit; using pg8::Acc;

struct EpiBf16 {
    static constexpr bool PERM = true;
    bf16_t* O; int ldc; size_t aux_stride; float scale;
    __device__ __forceinline__ void operator()(const Acc& acc, const Unit& u, int wr, int wc, int fr, int fq, LAS unsigned char*) const {
        bf16_t* base = O + (size_t)u.aux * aux_stride;
        const int row0 = u.pm * 256 + wr * 64 + fr, col0 = u.pn * 256 + wc * 32 + 8 * fq;
#pragma unroll
        for (int ai = 0; ai < 2; ++ai)
#pragma unroll
            for (int m = 0; m < 4; ++m) { bf16_t* rowp = base + (size_t)(row0 + ai * 128 + m * 16) * ldc + col0;
#pragma unroll
                for (int bj = 0; bj < 2; ++bj) { const f32x4 v0 = acc[ai][bj][m][0] * scale, v1 = acc[ai][bj][m][1] * scale;
                    u32x4 w; w.x = cvt_pk_bf16(v0[0], v0[1]); w.y = cvt_pk_bf16(v0[2], v0[3]); w.z = cvt_pk_bf16(v1[0], v1[1]); w.w = cvt_pk_bf16(v1[2], v1[3]);
                    *(u32x4*)(rowp + bj * 128) = w; } }
    }
};
struct EpiKV {
    static constexpr bool PERM = true;
    bf16_t* KB; bf16_t* VB;
    __device__ __forceinline__ void operator()(const Acc& acc, const Unit& u, int wr, int wc, int fr, int fq, LAS unsigned char*) const {
        bf16_t* base = (u.pn < 4 ? KB : VB) + (size_t)u.aux * MEMROWS * DM;
        const int row0 = u.pm * 256 + wr * 64 + fr, col0 = (u.pn & 3) * 256 + wc * 32 + 8 * fq;
#pragma unroll
        for (int ai = 0; ai < 2; ++ai)
#pragma unroll
            for (int m = 0; m < 4; ++m) { bf16_t* rowp = base + (size_t)(row0 + ai * 128 + m * 16) * DM + col0;
#pragma unroll
                for (int bj = 0; bj < 2; ++bj) { const f32x4 v0 = acc[ai][bj][m][0], v1 = acc[ai][bj][m][1];
                    u32x4 w; w.x = cvt_pk_bf16(v0[0], v0[1]); w.y = cvt_pk_bf16(v0[2], v0[3]); w.z = cvt_pk_bf16(v1[0], v1[1]); w.w = cvt_pk_bf16(v1[2], v1[3]);
                    *(u32x4*)(rowp + bj * 128) = w; } }
    }
};
struct EpiProj {
    static constexpr bool PERM = true;
    bf16_t* HG; bf16_t* QR; bf16_t* KF; bf16_t* V; const float* rstd; const f32x2* CS; unsigned* kmax;
    __device__ __forceinline__ void operator()(const Acc& acc, const Unit& u, int wr, int wc, int fr, int fq, LAS unsigned char*) const {
        const int row0 = u.pm * 256 + wr * 64 + fr;
        float rsv[2][4];
#pragma unroll
        for (int ai = 0; ai < 2; ++ai)
#pragma unroll
            for (int m = 0; m < 4; ++m) rsv[ai][m] = rstd[row0 + ai * 128 + m * 16];
        if (u.pn < 8 || u.pn >= 12) {
            bf16_t* base; int ldc, colt;
            if (u.pn < 8) { base = HG; ldc = 2048; colt = u.pn * 256; } else { base = V; ldc = 512; colt = (u.pn - 12) * 256; }
            const int col0 = colt + wc * 32 + 8 * fq;
#pragma unroll
            for (int ai = 0; ai < 2; ++ai)
#pragma unroll
                for (int m = 0; m < 4; ++m) { const int row = row0 + ai * 128 + m * 16; const float rs = rsv[ai][m]; bf16_t* rowp = base + (size_t)row * ldc + col0;
#pragma unroll
                    for (int bj = 0; bj < 2; ++bj) { const f32x4 v0 = acc[ai][bj][m][0] * rs, v1 = acc[ai][bj][m][1] * rs;
                        u32x4 w; w.x = cvt_pk_bf16(v0[0], v0[1]); w.y = cvt_pk_bf16(v0[2], v0[3]); w.z = cvt_pk_bf16(v1[0], v1[1]); w.w = cvt_pk_bf16(v1[2], v1[3]);
                        *(u32x4*)(rowp + bj * 128) = w; } }
        } else {
            const bool isk = u.pn >= 10; const int head = 4 * (u.pn & 1) + wc;
            float kn2max = 0.f;
#pragma unroll
            for (int am = 0; am < 4; ++am) { const int ai = am >> 1;
                f32x4 csv[2][4];
#pragma unroll
                for (int mm = 0; mm < 2; ++mm) { const int m = 2 * (am & 1) + mm; const f32x4* cs = (const f32x4*)(CS + (size_t)(row0 + ai * 128 + m * 16) * 32 + 8 * fq); csv[mm][0] = cs[0]; csv[mm][1] = cs[1]; csv[mm][2] = cs[2]; csv[mm][3] = cs[3]; }
#pragma unroll
                for (int mm = 0; mm < 2; ++mm) { const int m = 2 * (am & 1) + mm; const int row = row0 + ai * 128 + m * 16; const float rs = rsv[ai][m] * (isk ? 1.f : 0.125f * LOG2E);
                    const f32x4 c0 = csv[mm][0], c1 = csv[mm][1], c2 = csv[mm][2], c3 = csv[mm][3];
                    const float co[8] = {c0.x, c0.z, c1.x, c1.z, c2.x, c2.z, c3.x, c3.z}, si[8] = {c0.y, c0.w, c1.y, c1.w, c2.y, c2.w, c3.y, c3.w};
                    float lo[8], hi[8];
#pragma unroll
                    for (int n = 0; n < 2; ++n)
#pragma unroll
                        for (int e = 0; e < 4; ++e) { const int j = 4 * n + e; const float x1 = acc[ai][0][m][n][e] * rs, x2 = acc[ai][1][m][n][e] * rs; lo[j] = x1 * co[j] - x2 * si[j]; hi[j] = x2 * co[j] + x1 * si[j]; }
                    u32x4 wl, wh; wl.x = cvt_pk_bf16(lo[0], lo[1]); wl.y = cvt_pk_bf16(lo[2], lo[3]); wl.z = cvt_pk_bf16(lo[4], lo[5]); wl.w = cvt_pk_bf16(lo[6], lo[7]);
                    wh.x = cvt_pk_bf16(hi[0], hi[1]); wh.y = cvt_pk_bf16(hi[2], hi[3]); wh.z = cvt_pk_bf16(hi[4], hi[5]); wh.w = cvt_pk_bf16(hi[6], hi[7]);
                    if (!isk) { bf16_t* rowp = QR + (size_t)row * 512 + head * 64 + 8 * fq; *(u32x4*)rowp = wl; *(u32x4*)(rowp + 32) = wh; }
                    else { { float n2 = 0.f;
#pragma unroll
                          for (int j = 0; j < 8; ++j) n2 += lo[j] * lo[j] + hi[j] * hi[j];
                          n2 += __shfl_xor(n2, 16); n2 += __shfl_xor(n2, 32); kn2max = fmaxf(kn2max, n2); }
                        const int b = row >> 13, s = row & (SEQ - 1); const size_t bh = (size_t)(b * ATH + head) * (SEQ * 64);
#pragma unroll
                        for (int pat = 0; pat < 3; ++pat) { const int D = pat == 0 ? 1 : (pat == 1 ? 4 : 16), sh = pat * 2; const int r = s & (D - 1), p = s >> sh, T = p >> 5, k5 = p & 31;
                            const int rho = (k5 & 19) | ((k5 & 4) << 1) | ((k5 & 8) >> 1);
                            bf16_t* kf = KF + (size_t)pat * (MT * 512) + bh + ((size_t)(r * (SEQ / 32 >> sh) + T) * 4) * 512;
                            *(u32x4*)(kf + ((fq >> 1) * 64 + rho + 32 * (fq & 1)) * 8) = wl; *(u32x4*)(kf + ((2 + (fq >> 1)) * 64 + rho + 32 * (fq & 1)) * 8) = wh; }
                    } } }
            if (isk) { kn2max = fmaxf(kn2max, __shfl_xor(kn2max, 1)); kn2max = fmaxf(kn2max, __shfl_xor(kn2max, 2)); kn2max = fmaxf(kn2max, __shfl_xor(kn2max, 4)); kn2max = fmaxf(kn2max, __shfl_xor(kn2max, 8));
                if (fr == 0 && fq == 0) __hip_atomic_fetch_max(kmax + ((u.pm >> 5) * ATH + head), __float_as_uint(kn2max), __ATOMIC_RELAXED, __HIP_MEMORY_SCOPE_AGENT); }
        }
    }
};
struct EpiResAdd {
    static constexpr bool PERM = false;
    const float* Xs; float* X; float dm;
    __device__ __forceinline__ void operator()(const Acc& acc, const Unit& u, int wr, int wc, int fr, int fq, LAS unsigned char*) const {
        const int row0 = u.pm * 256 + wr * 64 + fr, col0 = u.pn * 256 + wc * 32 + 4 * fq;
#pragma unroll
        for (int ai = 0; ai < 2; ++ai) {
            f32x4 xv[4][2][2];
#pragma unroll
            for (int m = 0; m < 4; ++m) { const size_t off = (size_t)(row0 + ai * 128 + m * 16) * DM + col0;
#pragma unroll
                for (int bj = 0; bj < 2; ++bj)
#pragma unroll
                    for (int n = 0; n < 2; ++n) xv[m][bj][n] = *(const f32x4*)(Xs + off + bj * 128 + n * 16); }
            asm volatile("" ::: "memory");
#pragma unroll
            for (int m = 0; m < 4; ++m) { const size_t off = (size_t)(row0 + ai * 128 + m * 16) * DM + col0;
#pragma unroll
                for (int bj = 0; bj < 2; ++bj)
#pragma unroll
                    for (int n = 0; n < 2; ++n) *(f32x4*)(X + off + bj * 128 + n * 16) = xv[m][bj][n] + acc[ai][bj][m][n] * dm; }
        }
    }
};
struct EpiResAddB {
    static constexpr bool PERM = false;
    const bf16_t* XBs; bf16_t* XBo;
    __device__ __forceinline__ void operator()(const Acc& acc, const Unit& u, int wr, int wc, int fr, int fq, LAS unsigned char*) const {
        const int row0 = u.pm * 256 + wr * 64 + fr, col0 = u.pn * 256 + wc * 32 + 4 * fq;
#pragma unroll
        for (int ai = 0; ai < 2; ++ai) {
            u32x2 xv[4][2][2];
#pragma unroll
            for (int m = 0; m < 4; ++m) { const size_t off = (size_t)(row0 + ai * 128 + m * 16) * DM + col0;
#pragma unroll
                for (int bj = 0; bj < 2; ++bj)
#pragma unroll
                    for (int n = 0; n < 2; ++n) xv[m][bj][n] = *(const u32x2*)(XBs + off + bj * 128 + n * 16); }
            asm volatile("" ::: "memory");
#pragma unroll
            for (int m = 0; m < 4; ++m) { const size_t off = (size_t)(row0 + ai * 128 + m * 16) * DM + col0;
#pragma unroll
                for (int bj = 0; bj < 2; ++bj)
#pragma unroll
                    for (int n = 0; n < 2; ++n) { const u32x2 w = xv[m][bj][n]; const f32x4 a4 = acc[ai][bj][m][n];
                        u32x2 o; o.x = cvt_pk_bf16(bflo(w.x) + a4[0], bfhi(w.x) + a4[1]); o.y = cvt_pk_bf16(bflo(w.y) + a4[2], bfhi(w.y) + a4[3]);
                        *(u32x2*)(XBo + off + bj * 128 + n * 16) = o; } }
        }
    }
};
struct EpiResNorm {
    static constexpr bool PERM = false;
    const float* Xs; const bf16_t* XsB; bf16_t* XB; float* SSQP;
    __device__ __forceinline__ void operator()(const Acc& acc, const Unit& u, int wr, int wc, int fr, int fq, LAS unsigned char* lds) const {
        LAS float* EX = (LAS float*)(lds + SPARE_OFF);
        const int row0 = u.pm * 256 + wr * 64 + fr, col0 = u.pn * 256 + wc * 32 + 4 * fq;
#pragma unroll
        for (int ai = 0; ai < 2; ++ai)
#pragma unroll
            for (int m = 0; m < 4; ++m) { const size_t off = (size_t)(row0 + ai * 128 + m * 16) * DM + col0; float s = 0.f;
#pragma unroll
                for (int bj = 0; bj < 2; ++bj)
#pragma unroll
                    for (int n = 0; n < 2; ++n) { f32x4 xs; if (XsB) { const u32x2 w = *(const u32x2*)(XsB + off + bj * 128 + n * 16); xs = (f32x4){bflo(w.x), bfhi(w.x), bflo(w.y), bfhi(w.y)}; } else xs = *(const f32x4*)(Xs + off + bj * 128 + n * 16);
                        const f32x4 v = xs + acc[ai][bj][m][n];
                        u32x2 w; w.x = cvt_pk_bf16(v[0], v[1]); w.y = cvt_pk_bf16(v[2], v[3]); *(u32x2*)(XB + off + bj * 128 + n * 16) = w;
                        s += (v[0] * v[0] + v[1] * v[1]) + (v[2] * v[2] + v[3] * v[3]); }
                s += __shfl_xor(s, 16); s += __shfl_xor(s, 32);
                if (fq == 0) EX[(ai * 128 + wr * 64 + m * 16 + fr) * 4 + wc] = s; }
        asm volatile("s_waitcnt lgkmcnt(0)" ::: "memory"); __builtin_amdgcn_s_barrier(); asm volatile("" ::: "memory");
        { const int t = (wr * 4 + wc) * 64 + fq * 16 + fr; if (t < 256) { const f32x4 e = *(const LAS f32x4*)(EX + t * 4); SSQP[(size_t)(u.pm * 256 + t) * 4 + u.pn] = (e.x + e.y) + (e.z + e.w); } }
        asm volatile("s_waitcnt lgkmcnt(0)" ::: "memory"); __builtin_amdgcn_s_barrier(); asm volatile("" ::: "memory");
    }
};
struct EpiSoftmax {
    static constexpr bool PERM = false;
    bf16_t* P; const float* SSQP;
    __device__ __forceinline__ void operator()(Acc& acc, const Unit& u, int wr, int wc, int fr, int fq, LAS unsigned char* lds) const {
        LAS f32x2* EX = (LAS f32x2*)(lds + SPARE_OFF);
        const int row0 = u.pm * 256 + wr * 64 + fr;
        f32x4 pqv[2][4];
#pragma unroll
        for (int ai = 0; ai < 2; ++ai)
#pragma unroll
            for (int m = 0; m < 4; ++m) pqv[ai][m] = *(const f32x4*)(SSQP + (size_t)(row0 + ai * 128 + m * 16) * 4);
        float mw[2][4];
#pragma unroll
        for (int ai = 0; ai < 2; ++ai)
#pragma unroll
            for (int m = 0; m < 4; ++m) {
                const f32x4 pq = pqv[ai][m]; const float rs = __builtin_amdgcn_rsqf(((pq.x + pq.y) + (pq.z + pq.w)) * (1.f / DM) + EPS);
                float mx = -3.0e38f;
#pragma unroll
                for (int bj = 0; bj < 2; ++bj)
#pragma unroll
                    for (int n = 0; n < 2; ++n) { f32x4 v = acc[ai][bj][m][n] * rs; acc[ai][bj][m][n] = v; mx = fmaxf(mx, fmaxf(fmaxf(v[0], v[1]), fmaxf(v[2], v[3]))); }
                mx = fmaxf(mx, __shfl_xor(mx, 16)); mx = fmaxf(mx, __shfl_xor(mx, 32));
                float sm = 0.f;
#pragma unroll
                for (int bj = 0; bj < 2; ++bj)
#pragma unroll
                    for (int n = 0; n < 2; ++n) { f32x4 v = acc[ai][bj][m][n]; v[0] = __expf(v[0] - mx); v[1] = __expf(v[1] - mx); v[2] = __expf(v[2] - mx); v[3] = __expf(v[3] - mx);
                        acc[ai][bj][m][n] = v; sm += (v[0] + v[1]) + (v[2] + v[3]); }
                sm += __shfl_xor(sm, 16); sm += __shfl_xor(sm, 32);
                mw[ai][m] = mx;
                if (fq == 0) EX[(ai * 128 + wr * 64 + m * 16 + fr) * 4 + wc] = (f32x2){mx, sm};
            }
        asm volatile("s_waitcnt lgkmcnt(0)" ::: "memory"); __builtin_amdgcn_s_barrier(); asm volatile("" ::: "memory");
#pragma unroll
        for (int ai = 0; ai < 2; ++ai)
#pragma unroll
            for (int m = 0; m < 4; ++m) {
                const int rl = ai * 128 + wr * 64 + m * 16 + fr;
                const f32x2 e0 = EX[rl * 4 + 0], e1 = EX[rl * 4 + 1], e2 = EX[rl * 4 + 2], e3 = EX[rl * 4 + 3];
                const float M = fmaxf(fmaxf(e0.x, e1.x), fmaxf(e2.x, e3.x));
                const float Ls = e0.y * __expf(e0.x - M) + e1.y * __expf(e1.x - M) + e2.y * __expf(e2.x - M) + e3.y * __expf(e3.x - M);
                const float f = __expf(mw[ai][m] - M) / Ls;
                bf16_t* rowp = P + (size_t)(row0 + ai * 128 + m * 16) * DM + u.pn * 256 + wc * 32 + 4 * fq;
#pragma unroll
                for (int bj = 0; bj < 2; ++bj)
#pragma unroll
                    for (int n = 0; n < 2; ++n) { const f32x4 v = acc[ai][bj][m][n] * f; u32x2 w; w.x = cvt_pk_bf16(v[0], v[1]); w.y = cvt_pk_bf16(v[2], v[3]);
                        *(u32x2*)(rowp + bj * 128 + n * 16) = w; }
            }
        asm volatile("s_waitcnt lgkmcnt(0)" ::: "memory"); __builtin_amdgcn_s_barrier(); asm volatile("" ::: "memory");
    }
};
struct EpiMoe1 {
    static constexpr bool PERM = true;
    bf16_t* ACTB; const float* srs; const float* sgw;
    __device__ __forceinline__ void operator()(const Acc& acc, const Unit& u, int wr, int wc, int fr, int fq, LAS unsigned char*) const {
        const int row0 = u.pm * 256 + wr * 64 + fr, col0 = u.pn * 128 + wc * 32 + 8 * fq;
        float rsv[2][4], gwv[2][4];
#pragma unroll
        for (int ai = 0; ai < 2; ++ai)
#pragma unroll
            for (int m = 0; m < 4; ++m) { const int lrow = u.aux * 16384 + u.lr + wr * 64 + fr + ai * 128 + m * 16; rsv[ai][m] = srs[lrow]; gwv[ai][m] = sgw[lrow]; }
#pragma unroll
        for (int ai = 0; ai < 2; ++ai)
#pragma unroll
            for (int m = 0; m < 4; ++m) { const int row = row0 + ai * 128 + m * 16; const float rs = rsv[ai][m], gw = gwv[ai][m] * rs;
                float o[8];
#pragma unroll
                for (int n = 0; n < 2; ++n)
#pragma unroll
                    for (int j = 0; j < 4; ++j) { const float g = acc[ai][0][m][n][j] * rs, up = acc[ai][1][m][n][j]; o[n * 4 + j] = g * sigmoidf_(g) * up * gw; }
                u32x4 w; w.x = cvt_pk_bf16(o[0], o[1]); w.y = cvt_pk_bf16(o[2], o[3]); w.z = cvt_pk_bf16(o[4], o[5]); w.w = cvt_pk_bf16(o[6], o[7]);
                *(u32x4*)(ACTB + (size_t)row * EFF + col0) = w; }
    }
};

struct Args { const void* in[20]; float* out; unsigned char* ws; int ph_lo, ph_hi; };
struct Frame {
    LAS unsigned char* lds; volatile LAS unsigned* MISC; gu32* ctl;
    int tid, lane, wave, vcu, G;
    unsigned char* ws; float* out; size_t z; int dry;
};

__device__ __forceinline__ void transpose_item(const float* W, int N, const float* scale, bf16_t* WT, int ldt, int row_base, int k0, int n0, LAS float* scr, int lane) {
    f32x4 v[8];
#pragma unroll
    for (int i = 0; i < 8; ++i) v[i] = *(const GAS f32x4*)(W + (size_t)(k0 + 8 * i + (lane >> 3)) * N + n0 + 4 * (lane & 7));
#pragma unroll
    for (int i = 0; i < 8; ++i) { const int kk = 8 * i + (lane >> 3); f32x4 x = v[i]; if (scale) x = x * scale[k0 + kk]; LAS float* d = scr + kk * 33 + 4 * (lane & 7); d[0] = x.x; d[1] = x.y; d[2] = x.z; d[3] = x.w; }
    LDS_WAIT(); asm volatile("" ::: "memory");
    const int c = lane & 7;
#pragma unroll
    for (int j = 0; j < 4; ++j) { const int n = (lane >> 3) + 8 * j; const LAS float* s = scr + (8 * c) * 33 + n;
        u32x4 o; o.x = pk2(s[0 * 33], s[1 * 33]); o.y = pk2(s[2 * 33], s[3 * 33]); o.z = pk2(s[4 * 33], s[5 * 33]); o.w = pk2(s[6 * 33], s[7 * 33]);
        *(GAS u32x4*)(WT + (size_t)(row_base + n0 + n) * ldt + k0 + 8 * c) = o; }
    LDS_WAIT(); asm volatile("" ::: "memory");
}
__device__ __forceinline__ void transpose_mat_item(const float* W, int K, int N, const float* scale, bf16_t* WT, int mode, int it, LAS float* scr, int lane) {
    const int nblk = N / 32, kb = it / nblk, nb = it % nblk, k0 = 64 * kb, n0 = 32 * nb;
    int row_base = 0;
    if (mode == 1 || mode == 2) row_base = 256 * (n0 / 128) + (n0 % 128) + (mode == 2 ? 128 : 0) - n0;
    if (mode == 3 && n0 >= 2048 && n0 < 3072) {
        const int blk = (n0 - 2048) / 512, np = (n0 - 2048) % 512, head = np / 64, d = np % 64;
        row_base = 2048 + blk * 512 + (head / 4) * 256 + 128 * (d / 32) + 32 * (head % 4) + (d % 32) - n0; }
    transpose_item(W, N, scale, WT, K, row_base, k0, n0, scr, lane);
}

__device__ __forceinline__ float row_norm_prep(const float* xrow, bf16_t* xb_row, float* copy_row, int lane) {
    const GAS f32x4* xr = (const GAS f32x4*)xrow + lane;
    f32x4 v[4]; float s = 0.f;
#pragma unroll
    for (int j = 0; j < 4; ++j) { v[j] = xr[64 * j]; s += (v[j].x * v[j].x + v[j].y * v[j].y) + (v[j].z * v[j].z + v[j].w * v[j].w); }
    const float rstd = 1.f / sqrtf(wave_sum(s) * (1.f / DM) + EPS);
    GAS u32x2* o8 = (GAS u32x2*)xb_row + lane;
#pragma unroll
    for (int j = 0; j < 4; ++j) { u32x2 w; w.x = pk2(v[j].x, v[j].y); w.y = pk2(v[j].z, v[j].w); o8[64 * j] = w; }
    if (copy_row) { GAS f32x4* c = (GAS f32x4*)copy_row + lane;
#pragma unroll
        for (int j = 0; j < 4; ++j) c[64 * j] = v[j]; }
    return rstd;
}

__constant__ double INV_FREQ[32] = {1.0, 0.7498942093324559, 0.5623413251903491, 0.4216965034285822, 0.31622776601683794, 0.23713737056616552, 0.1778279410038923, 0.1333521432163324,
    0.1, 0.07498942093324558, 0.05623413251903491, 0.042169650342858224, 0.03162277660168379, 0.023713737056616554, 0.01778279410038923, 0.01333521432163324,
    0.01, 0.007498942093324558, 0.005623413251903491, 0.004216965034285823, 0.0031622776601683794, 0.0023713737056616554, 0.0017782794100389228, 0.001333521432163324,
    0.001, 0.0007498942093324559, 0.0005623413251903491, 0.00042169650342858224, 0.00031622776601683794, 0.00023713737056616554, 0.00017782794100389227, 0.0001333521432163324};


#define IN_F(i) ((const float*)((const char*)a.in[i] + F.z))
#define YMIX_PTR(l) ((l) == 0 ? (bf16_t*)(F.ws + WS_XB) : (bf16_t*)F.out)
__device__ __forceinline__ float hg_lb(const Frame& F, const Args& a, int l, int c) { if (l == 0) return 0.f; const float* h = IN_F(5); return sigmoidf_(h[HGW + c] - h[c]); }
__device__ __forceinline__ void conv_small_item(Frame& F, const Args& a, int l, int r, LAS float* scr) {
    unsigned char* ws = F.ws; const int lane = F.lane;
    if (r < 1792) { transpose_mat_item(IN_F(4) + (size_t)l * DM * NIN, DM, NIN, IN_F(3) + l * DM, (bf16_t*)(ws + WS_WIN) + (size_t)l * NIN * DM, 3, r, scr, lane); return; } r -= 1792;
    if (r < 512) { transpose_mat_item(IN_F(7) + (size_t)l * DM * DM, DM, DM, nullptr, (bf16_t*)(ws + WS_WOUT) + (size_t)l * DM * DM, 0, r, scr, lane); return; } r -= 512;
    if (r < 1024) { transpose_mat_item(IN_F(11) + (size_t)l * DM * 2 * DM, DM, 2 * DM, nullptr, (bf16_t*)(ws + WS_WKVT) + (size_t)l * 2 * DM * DM, 0, r, scr, lane); return; } r -= 1024;
    transpose_mat_item(IN_F(12) + (size_t)l * DM * DM, DM, DM, nullptr, (bf16_t*)(ws + WS_WOT) + (size_t)l * DM * DM, 0, r, scr, lane);
}
__device__ __forceinline__ void conv_wq_row(Frame& F, const Args& a, int r) {
    const int lane = F.lane; const float sc = IN_F(8)[r] * 0.0625f;
    const GAS f32x4* src = (const GAS f32x4*)(IN_F(10) + (size_t)r * DM) + lane; GAS u32x2* dst = (GAS u32x2*)((bf16_t*)(F.ws + WS_WQS) + (size_t)r * DM) + lane;
#pragma unroll
    for (int j = 0; j < 4; ++j) { const f32x4 v = src[64 * j] * sc; u32x2 w; w.x = pk2(v.x, v.y); w.y = pk2(v.z, v.w); dst[64 * j] = w; }
}
__device__ __forceinline__ void conv_small_l1(Frame& F, const Args& a, int wi, int nw) {
    LAS float* scr = (LAS float*)(F.lds + F.wave * 16384);
    for (int it = wi; it < 2816; it += nw) conv_small_item(F, a, 1, it < 2304 ? it : it + 1024, scr);
    for (int r = wi; r < DM; r += nw) conv_wq_row(F, a, DM + r);
}
__device__ __forceinline__ void ph_init(Frame& F, const Args& a) {
    LAS float* scr = (LAS float*)(F.lds + F.wave * 16384);
    const int gw = F.vcu * NWAVES + F.wave, NGW = F.G * NWAVES, lane = F.lane;
    unsigned char* ws = F.ws;
    for (int it = gw; it < 3840 + 1024; it += NGW) {
        if (it < 3840) conv_small_item(F, a, 0, it, scr); else conv_small_item(F, a, 1, 2304 + (it - 3840), scr); }
    for (int r = gw; r < DM; r += NGW) conv_wq_row(F, a, r);
    for (int r = gw; r < MEMROWS; r += NGW) {
        const GAS f32x4* xr = (const GAS f32x4*)(IN_F(1) + (size_t)r * DM) + lane;
        f32x4 v[4]; float s = 0.f;
#pragma unroll
        for (int j = 0; j < 4; ++j) { v[j] = xr[64 * j]; s += (v[j].x * v[j].x + v[j].y * v[j].y) + (v[j].z * v[j].z + v[j].w * v[j].w); }
        const float rstd = 1.f / sqrtf(wave_sum(s) * (1.f / DM) + EPS);
        for (int l = 0; l < DEPTH; ++l) {
            const GAS f32x4* g = (const GAS f32x4*)(IN_F(9) + l * DM) + lane; GAS u32x2* dst = (GAS u32x2*)((bf16_t*)(ws + WS_MEMN) + ((size_t)l * MEMROWS + r) * DM) + lane;
#pragma unroll
            for (int j = 0; j < 4; ++j) { const f32x4 o = v[j] * rstd * g[64 * j]; u32x2 w; w.x = pk2(o.x, o.y); w.y = pk2(o.z, o.w); dst[64 * j] = w; }
        }
    }
    for (int r = gw; r < MT; r += NGW) {
        const float rs = row_norm_prep(IN_F(0) + (size_t)r * DM, (bf16_t*)(ws + WS_XB) + (size_t)r * DM, nullptr, lane);
        if (lane == 0) ((float*)(ws + WS_RSTD))[r] = rs;
    }
    for (int i = (F.vcu * NTHR + F.tid); i < DEPTH * HGW; i += F.G * NTHR) ((float*)(ws + WS_LBT))[i] = hg_lb(F, a, i / HGW, i % HGW);
    { const int* pos = (const int*)((const char*)a.in[2] + F.z);
      for (int i = (F.vcu * NTHR + F.tid); i < MT * 32; i += F.G * NTHR) { const double ang = (double)pos[i >> 5] * INV_FREQ[i & 31]; double rev = ang * 0.15915494309189535; rev = rev - __builtin_floor(rev);
          const float fr = (float)rev; ((f32x2*)(ws + WS_CS))[i] = (f32x2){__builtin_amdgcn_cosf(fr), __builtin_amdgcn_sinf(fr)}; } }
    for (int i = (F.vcu * NTHR + F.tid); i < DEPTH * 32 * DM; i += F.G * NTHR) {
        const int l = i / (32 * DM), n = (i / DM) % 32, k = i % DM;
        float w = 0.f;
        if (n < 4) w = IN_F(14)[((size_t)l * DM + k) * 4 + n]; else if (n < 20) w = IN_F(15)[((size_t)l * DM + k) * 16 + (n - 4)];
        w *= IN_F(13)[l * DM + k];
        const unsigned hi = f2bf(w); const float rem = w - bf2f((unsigned short)hi);
        ((bf16_t*)(ws + WS_WR))[i] = (bf16_t)hi; ((bf16_t*)(ws + WS_WR) + DEPTH * 32 * DM)[i] = (bf16_t)f2bf(rem);
    }
}

struct SchedKV {
    int G, c; const char* memn; const char* wkvt;
    __device__ __forceinline__ bool next(int i, Unit& u) const {
        const int L = i * G + c; if (L >= 32) return false;
        const int l = L >> 4; u.pm = (L >> 3) & 1; u.pn = L & 7; u.aux = l;
        u.a = memn + ((size_t)l * MEMROWS + u.pm * 256) * DM * 2; u.b = wkvt + ((size_t)l * 2 * DM + u.pn * 256) * DM * 2; return true;
    }
};
struct SchedFold {
    int G, c; const char* kb; const char* vb; const char* wqs; const char* wot;
    __device__ __forceinline__ bool next(int i, Unit& u) const {
        const int L = i * G + c; if (L >= 128) return false;
        const int ty = L >> 6, l = (L >> 5) & 1, b = (L >> 4) & 1, h = (L >> 2) & 3, t = L & 3; u.aux = ty * 4 + l * 2 + b;
        if (ty == 0) { u.pm = h; u.pn = t; u.a = kb + (((size_t)l * MEMROWS + b * 256) * DM + h * 256) * 2; u.b = wqs + (((size_t)l * DM + t * 256) * DM + h * 256) * 2; }
        else { u.pm = t; u.pn = h; u.a = wot + (((size_t)l * DM + t * 256) * DM + h * 256) * 2; u.b = vb + (((size_t)l * MEMROWS + b * 256) * DM + h * 256) * 2; }
        return true;
    }
};
struct SchedMoe {
    int G, c, kdim; volatile LAS unsigned* tb; const char* A; const char* B; const int* perm2; const unsigned* cnt; bool gather; int mode, early, rem; unsigned* done;
    __device__ __forceinline__ bool next(int i, Unit& u) const {
        const int total = __builtin_amdgcn_readfirstlane((int)tb[16]) * 4; int L;
        if (mode == 0) L = i * G + c;
        else if (mode == 1) { L = i * G + c; if (L >= early) return false; }
        else if (mode == 2) { if (i > 0 || c >= rem) return false; L = early + c; }
        else { const int cc = c >= rem ? c - rem : c - rem + G; L = c >= rem ? (i == 0 ? cc : (G - rem) + (i - 1) * G + cc) : (G - rem) + i * G + cc; }
        if (L >= total) return false;
        if (G == 256 && L < (mode == 1 || mode == 3 ? early : (total / 256) * 256)) { const int rd = L >> 8, idx = L & 255, xcd = idx & 7, q = idx >> 3; L = ((rd * 64 + xcd * 8 + (q >> 2)) << 2) + (q & 3); }
        const int mt = L >> 2; u.pm = mt; u.pn = L & 3; int e = 0;
#pragma unroll
        for (int j = 1; j < 16; ++j) e += (mt >= __builtin_amdgcn_readfirstlane((int)tb[j])) ? 1 : 0;
        u.aux = e; u.lr = (mt - __builtin_amdgcn_readfirstlane((int)tb[e])) * 256; u.a = gather ? A : A + (size_t)mt * 256 * kdim * 2; u.b = B + ((size_t)e * 1024 + u.pn * 256) * kdim * 2;
        if (mode == 3 && L >= early) {
            unsigned spins = 0; while (__hip_atomic_load(done + mt, __ATOMIC_RELAXED, __HIP_MEMORY_SCOPE_AGENT) < 4u) { __builtin_amdgcn_s_sleep(8); if (++spins > (1u << 18)) break; }
            __builtin_amdgcn_fence(__ATOMIC_ACQUIRE, "agent"); asm volatile("s_waitcnt vmcnt(0)" ::: "memory"); }
        return true;
    }
    __device__ __forceinline__ int src_row(const Unit& u, int r) const { const int lrow = u.lr + r; const int n = __builtin_amdgcn_readfirstlane((int)tb[24 + u.aux]); const int v = perm2[u.aux * 16384 + lrow]; return lrow < n ? v : 0; }
};

__device__ __forceinline__ void vf_unit(Frame& F, int unit) {
    unsigned char* ws = F.ws; const int tid = F.tid;
    const int tb = unit >> 3, h = unit & 7, b = tb >> 4, s_base = (tb & 15) * 512;
    LAS unsigned short* Vl = (LAS unsigned short*)F.lds;
    const bf16_t* V = (const bf16_t*)(ws + A_V) + ((size_t)b * SEQ + s_base) * 512 + h * 64;
#pragma unroll
    for (int p = 0; p < 8; ++p) { const int c = p * 512 + tid, row = c >> 3, ch = c & 7; *(LAS u32x4*)(Vl + row * 72 + ch * 8) = *(const GAS u32x4*)(V + (size_t)row * 512 + ch * 8); }
    __syncthreads();
    const size_t bh = (size_t)(b * ATH + h) * (SEQ * 64);
    for (int it = 0; it < 24; ++it) { const int pc = it * 512 + tid, tile = pc >> 8, q = pc & 255, s = q >> 7, mt = (q >> 6) & 1, ln = q & 63, dim = (ln & 31) + 32 * mt, hi = ln >> 5;
        const int pat = tile >> 4, j16 = tile & 15, sh = pat * 2, D = 1 << sh;
        const int TPC = 16 >> sh, r = j16 / TPC, tl = j16 % TPC;
        const int pl = tl * 32 + 16 * s + 8 * hi;
        unsigned w[4];
#pragma unroll
        for (int jj = 0; jj < 4; ++jj) { const int t0 = ((pl + 2 * jj) << sh) + r, t1 = ((pl + 2 * jj + 1) << sh) + r; w[jj] = (unsigned)Vl[t0 * 72 + dim] | ((unsigned)Vl[t1 * 72 + dim] << 16); }
        const int T = (s_base >> sh >> 5) + tl;
        bf16_t* vf = (bf16_t*)(ws + A_VT1) + (size_t)pat * (MT * 512) + bh + ((size_t)(r * (SEQ / 32 >> sh) + T) * 4 + s * 2 + mt) * 512 + ln * 8;
        *(GAS u32x4*)vf = (u32x4){w[0], w[1], w[2], w[3]}; }
    __syncthreads();
}

constexpr int HG_LBT_OFF = 122880;
__device__ __forceinline__ void hg_build_b(Frame& F, int l, int h, const u32x4 z0, const u32x4 z1, int k0, float (&bb)[16], float (&kk)[16]) {
    const int tid = F.tid, lane = F.lane, wave = F.wave, tl = lane & 7;
    LAS float* WT = (LAS float*)F.lds; LAS float* REF = (LAS float*)(F.lds + 4096);
    const unsigned zz[8] = {z0.x, z0.y, z0.z, z0.w, z1.x, z1.y, z1.z, z1.w};
    float lbv[16];
#pragma unroll
    for (int i = 0; i < 16; i += 4) { const f32x4 t4 = *(const LAS f32x4*)(F.lds + HG_LBT_OFF + (h * 128 + k0 + i) * 4); lbv[i] = t4.x; lbv[i + 1] = t4.y; lbv[i + 2] = t4.z; lbv[i + 3] = t4.w; }
#pragma unroll
    for (int i = 0; i < 16; ++i) { const float z = (i & 1) ? bfhi(zz[i >> 1]) : bflo(zz[i >> 1]); const float lb = lbv[i];
        const float e = ex2(-LOG2E * z), sg = __builtin_amdgcn_rcpf(1.f + e), f = lb + (1.f - lb) * sg; bb[i] = __builtin_amdgcn_logf(f); kk[i] = (1.f - lb) * (e * sg); }
#pragma unroll
    for (int i = 0; i < 16; ++i) { float x = bb[i]; float y;
        y = __builtin_bit_cast(float, __builtin_amdgcn_update_dpp(0, __builtin_bit_cast(int, x), 0x111, 0xf, 0xf, true)); if (tl >= 1) x += y;
        y = __builtin_bit_cast(float, __builtin_amdgcn_update_dpp(0, __builtin_bit_cast(int, x), 0x112, 0xf, 0xf, true)); if (tl >= 2) x += y;
        y = __builtin_bit_cast(float, __builtin_amdgcn_update_dpp(0, __builtin_bit_cast(int, x), 0x114, 0xf, 0xf, true)); if (tl >= 4) x += y;
        bb[i] = x; }
    if (tl == 7) {
#pragma unroll
        for (int i = 0; i < 16; i += 4) *(LAS f32x4*)(WT + wave * 128 + k0 + i) = (f32x4){bb[i], bb[i + 1], bb[i + 2], bb[i + 3]}; }
    __syncthreads();
    for (int w = 0; w < wave; ++w) {
#pragma unroll
        for (int i = 0; i < 16; i += 4) { const f32x4 p = *(const LAS f32x4*)(WT + w * 128 + k0 + i); bb[i] += p.x; bb[i + 1] += p.y; bb[i + 2] += p.z; bb[i + 3] += p.w; } }
    if (tl == 7 && (wave & 1)) {
#pragma unroll
        for (int i = 0; i < 16; i += 4) *(LAS f32x4*)(REF + (wave >> 1) * 128 + k0 + i) = (f32x4){bb[i], bb[i + 1], bb[i + 2], bb[i + 3]}; }
    __syncthreads();
    (void)tid;
}
__device__ __forceinline__ void st_row16(LAS unsigned char* base, int byteoff, const float (&v)[16]) {
    u32x4 w0, w1; w0.x = cvt_pk_bf16(v[0], v[1]); w0.y = cvt_pk_bf16(v[2], v[3]); w0.z = cvt_pk_bf16(v[4], v[5]); w0.w = cvt_pk_bf16(v[6], v[7]); w1.x = cvt_pk_bf16(v[8], v[9]); w1.y = cvt_pk_bf16(v[10], v[11]); w1.z = cvt_pk_bf16(v[12], v[13]); w1.w = cvt_pk_bf16(v[14], v[15]);
    *(LAS u32x4*)(base + byteoff) = w0; *(LAS u32x4*)(base + byteoff + 16) = w1;
}
constexpr int HL_RED = 6144, HL_QD = 8192, HL_KD = 25600, HL_QE = 43008, HL_Q1 = 60416, HL_K1 = 69120, HL_Q2 = 77824, HL_K2 = 86528, HL_VT = 95232, HL_SC = 113664;
constexpr int RS_TR = 288;
typedef short s16x4 __attribute__((ext_vector_type(4)));
constexpr int HA_KT = 8192, HA_VT = 8192 + 64 * 288;
constexpr int RS128 = 272, RS64 = 144;

__device__ __forceinline__ void hg_lbt_to_lds(Frame& F, int l) { if (F.tid < 128) *(LAS f32x4*)(F.lds + HG_LBT_OFF + F.tid * 16) = *(const GAS f32x4*)((const float*)(F.ws + WS_LBT) + l * HGW + F.tid * 4); __syncthreads(); }
struct HgIn { u32x4 z0, z1, q0, q1, v0, v1; };
template <bool NEEDQ> __device__ __forceinline__ HgIn hg_load(Frame& F, int unit) {
    HgIn R;
    const int b = unit >> 9, h = (unit >> 7) & 3, c = unit & 127; const int row0 = b * SEQ + c * CHUNK, t = (F.tid >> 6) * 8 + (F.tid & 7), k0 = ((F.tid >> 3) & 7) * 16;
    const bf16_t* rowp = (const bf16_t*)(F.ws + A_HG) + (size_t)(row0 + t) * 2048 + h * 128 + k0;
    R.z0 = *(const GAS u32x4*)(rowp + 512); R.z1 = *(const GAS u32x4*)(rowp + 512 + 8); R.v0 = *(const GAS u32x4*)(rowp + 1024); R.v1 = *(const GAS u32x4*)(rowp + 1024 + 8);
    if (NEEDQ) { R.q0 = *(const GAS u32x4*)(rowp); R.q1 = *(const GAS u32x4*)(rowp + 8); } else { R.q0 = R.z0; R.q1 = R.z1; }
    return R;
}
__device__ __forceinline__ void hg_a2_unit(Frame& F, const Args& a, int l, int unit, const HgIn& R) {
    unsigned char* ws = F.ws; const int tid = F.tid, lane = F.lane, wave = F.wave;
    const int h = (unit >> 7) & 3;
    const int t = (tid >> 6) * 8 + (tid & 7), k0 = ((tid >> 3) & 7) * 16;
    const u32x4 v0 = R.v0, v1 = R.v1;
    float bb[16], kk[16];
    hg_build_b(F, l, h, R.z0, R.z1, k0, bb, kk);
    const LAS float* REF = (const LAS float*)(F.lds + 4096);
    { float tmp[16];
#pragma unroll
      for (int i = 0; i < 16; ++i) tmp[i] = kk[i] * ex2(REF[3 * 128 + k0 + i] - bb[i]);
      st_row16(F.lds, HA_KT + t * RS_TR + k0 * 2, tmp);
      *(LAS u32x4*)(F.lds + HA_VT + t * RS_TR + k0 * 2) = v0; *(LAS u32x4*)(F.lds + HA_VT + t * RS_TR + k0 * 2 + 16) = v1; }
    if (tid < 128) ((float*)(ws + A_DECAY))[(size_t)unit * 128 + tid] = ex2(REF[3 * 128 + tid]);
    __syncthreads();
    { const int fr = lane & 15, g = lane >> 4;
      const int q = fr >> 2, p = fr & 3;
      auto trfrag = [&](int base, int c0, int ks) -> bf16x8 {
          const LAS unsigned char* a0 = F.lds + base + (32 * ks + 8 * g + q) * RS_TR + (c0 + 4 * p) * 2;
          const s16x4 lo = __builtin_bit_cast(s16x4, __builtin_amdgcn_ds_read_tr16_b64_v4i16((LAS s16x4*)a0));
          const s16x4 hi = __builtin_bit_cast(s16x4, __builtin_amdgcn_ds_read_tr16_b64_v4i16((LAS s16x4*)(a0 + 4 * RS_TR)));
          return (bf16x8){lo[0], lo[1], lo[2], lo[3], hi[0], hi[1], hi[2], hi[3]}; };
      bf16x8 af[2];
#pragma unroll
      for (int ks = 0; ks < 2; ++ks) af[ks] = trfrag(HA_KT, wave * 16, ks);
      bf16_t* st = (bf16_t*)(ws + A_STATE) + (size_t)unit * 16384;
#pragma unroll
      for (int vt = 0; vt < 8; ++vt) { f32x4 acc = {0.f, 0.f, 0.f, 0.f};
#pragma unroll
          for (int ks = 0; ks < 2; ++ks) { const bf16x8 bf = trfrag(HA_VT, vt * 16, ks); acc = __builtin_amdgcn_mfma_f32_16x16x32_bf16(af[ks], bf, acc, 0, 0, 0); }
          u32x2 w; w.x = cvt_pk_bf16(acc[0], acc[1]); w.y = cvt_pk_bf16(acc[2], acc[3]);
          *(GAS u32x2*)(st + (vt * 16 + fr) * 128 + wave * 16 + 4 * g) = w; } }
}

template <int STOP> __device__ __forceinline__ void hg_c2_unit(Frame& F, const Args& a, int l, int unit, const HgIn& R) {
    unsigned char* ws = F.ws; const int tid = F.tid, lane = F.lane, wave = F.wave;
    const int b = unit >> 9, h = (unit >> 7) & 3, c = unit & 127; const int row0 = b * SEQ + c * CHUNK;
    const int t = (tid >> 6) * 8 + (tid & 7), k0 = ((tid >> 3) & 7) * 16;
    const int fr = lane & 15, g = lane >> 4;
    const bf16_t* HG = (const bf16_t*)(ws + A_HG);
    const u32x4 q0 = R.q0, q1 = R.q1, v0 = R.v0, v1 = R.v1;
    bf16x8 sf[4]; u32x2 gwv[4];
    { const bf16_t* st = (const bf16_t*)(ws + A_STATE) + (size_t)unit * 16384 + (wave * 16 + fr) * 128;
#pragma unroll
      for (int ks = 0; ks < 4; ++ks) sf[ks] = *(const GAS bf16x8*)(st + 32 * ks + 8 * g);
#pragma unroll
      for (int I = 0; I < 4; ++I) gwv[I] = *(const GAS u32x2*)(HG + (size_t)(row0 + 16 * I + fr) * 2048 + 1536 + h * 128 + wave * 16 + 4 * g); }
    const f32x4 gain = *(const GAS f32x4*)(IN_F(6) + l * HGW + h * 128 + wave * 16 + 4 * g);
    float bb[16], kk[16];
    hg_build_b(F, l, h, R.z0, R.z1, k0, bb, kk);
    if (STOP == 1) { asm volatile("" :: "v"(bb[0]), "v"(kk[0]), "v"(sf[0]), "v"(gwv[0]), "v"(gain)); return; }
    const LAS float* REF = (const LAS float*)(F.lds + 4096);
    { const unsigned qq[8] = {q0.x, q0.y, q0.z, q0.w, q1.x, q1.y, q1.z, q1.w}, vv[8] = {v0.x, v0.y, v0.z, v0.w, v1.x, v1.y, v1.z, v1.w};
      LAS unsigned short* VT = (LAS unsigned short*)(F.lds + HL_VT);
      float qv[16], tmp[16];
#pragma unroll
      for (int i = 0; i < 16; ++i) { qv[i] = (i & 1) ? bfhi(qq[i >> 1]) : bflo(qq[i >> 1]); VT[(k0 + i) * (RS64 / 2) + t] = (unsigned short)((i & 1) ? (vv[i >> 1] >> 16) : (vv[i >> 1] & 0xffffu)); }
      const int I = wave >> 1;
      float rf[16];
#pragma unroll
      for (int i = 0; i < 16; i += 4) { f32x4 r4 = {0.f, 0.f, 0.f, 0.f}; if (I) r4 = *(const LAS f32x4*)(REF + (I - 1) * 128 + k0 + i); rf[i] = r4.x; rf[i + 1] = r4.y; rf[i + 2] = r4.z; rf[i + 3] = r4.w; }
#pragma unroll
      for (int i = 0; i < 16; ++i) tmp[i] = qv[i] * ex2(bb[i] - rf[i]);
      st_row16(F.lds, HL_QD + t * RS128 + k0 * 2, tmp);
#pragma unroll
      for (int i = 0; i < 16; ++i) tmp[i] = kk[i] * ex2(fminf(rf[i] - bb[i], 86.f));
      st_row16(F.lds, HL_KD + t * RS128 + k0 * 2, tmp);
#pragma unroll
      for (int i = 0; i < 16; ++i) tmp[i] = qv[i] * ex2(bb[i]);
      st_row16(F.lds, HL_QE + t * RS128 + k0 * 2, tmp);
#pragma unroll
      for (int i = 0; i < 16; i += 4) { const f32x4 r4 = *(const LAS f32x4*)(REF + 1 * 128 + k0 + i); rf[i] = r4.x; rf[i + 1] = r4.y; rf[i + 2] = r4.z; rf[i + 3] = r4.w; }
      if (wave >= 4) {
#pragma unroll
          for (int i = 0; i < 16; ++i) tmp[i] = qv[i] * ex2(bb[i] - rf[i]);
          st_row16(F.lds, HL_Q1 + (t & 31) * RS128 + k0 * 2, tmp);
      } else {
#pragma unroll
          for (int i = 0; i < 16; ++i) tmp[i] = kk[i] * ex2(rf[i] - bb[i]);
          st_row16(F.lds, HL_K1 + (t & 31) * RS128 + k0 * 2, tmp);
      }
#pragma unroll
      for (int i = 0; i < 16; i += 4) { const f32x4 r4 = *(const LAS f32x4*)(REF + ((wave >= 4) ? 2 : 0) * 128 + k0 + i); rf[i] = r4.x; rf[i + 1] = r4.y; rf[i + 2] = r4.z; rf[i + 3] = r4.w; }
      if (wave & 2) {
#pragma unroll
          for (int i = 0; i < 16; ++i) tmp[i] = qv[i] * ex2(bb[i] - rf[i]);
          st_row16(F.lds, HL_Q2 + ((t & 15) + ((wave >= 4) ? 16 : 0)) * RS128 + k0 * 2, tmp);
      } else {
#pragma unroll
          for (int i = 0; i < 16; ++i) tmp[i] = kk[i] * ex2(rf[i] - bb[i]);
          st_row16(F.lds, HL_K2 + ((t & 15) + ((wave >= 4) ? 16 : 0)) * RS128 + k0 * 2, tmp);
      }
      for (int i = tid; i < 64 * RS64 / 16; i += NTHR) *(LAS u32x4*)(F.lds + HL_SC + i * 16) = (u32x4){0u, 0u, 0u, 0u};
    }
    __syncthreads();
    if (STOP == 2) { asm volatile("" :: "v"(sf[0]), "v"(gwv[0]), "v"(gain)); return; }
    for (int blk = wave; blk < 10; blk += 8) {
        int ko, qo, J, I; bool diag = false;
        if (blk < 4) { ko = HL_KD + blk * 16 * RS128; qo = HL_QD + blk * 16 * RS128; J = blk; I = blk; diag = true; }
        else if (blk == 4) { ko = HL_K2; qo = HL_Q2; J = 0; I = 1; }
        else if (blk == 5) { ko = HL_K2 + 16 * RS128; qo = HL_Q2 + 16 * RS128; J = 2; I = 3; }
        else { const int jj = (blk - 6) >> 1, ii = (blk - 6) & 1; ko = HL_K1 + jj * 16 * RS128; qo = HL_Q1 + ii * 16 * RS128; J = jj; I = 2 + ii; }
        f32x4 acc = {0.f, 0.f, 0.f, 0.f};
#pragma unroll
        for (int ks = 0; ks < 4; ++ks) { const bf16x8 af = *(const LAS bf16x8*)(F.lds + ko + fr * RS128 + (32 * ks + 8 * g) * 2), bf = *(const LAS bf16x8*)(F.lds + qo + fr * RS128 + (32 * ks + 8 * g) * 2);
            acc = __builtin_amdgcn_mfma_f32_16x16x32_bf16(af, bf, acc, 0, 0, 0); }
        if (diag) {
#pragma unroll
            for (int rg = 0; rg < 4; ++rg) if (4 * g + rg > fr) acc[rg] = 0.f; }
        u32x2 w; w.x = cvt_pk_bf16(acc[0], acc[1]); w.y = cvt_pk_bf16(acc[2], acc[3]);
        *(LAS u32x2*)(F.lds + HL_SC + (16 * I + fr) * RS64 + (16 * J + 4 * g) * 2) = w;
    }
    __syncthreads();
    if (STOP == 3) { asm volatile("" :: "v"(sf[0]), "v"(gwv[0]), "v"(gain)); return; }
    f32x4 o[4];
#pragma unroll
    for (int I = 0; I < 4; ++I) o[I] = (f32x4){0.f, 0.f, 0.f, 0.f};
    { bf16x8 af[2];
#pragma unroll
      for (int ks = 0; ks < 2; ++ks) af[ks] = *(const LAS bf16x8*)(F.lds + HL_VT + (wave * 16 + fr) * RS64 + (32 * ks + 8 * g) * 2);
#pragma unroll
      for (int I = 0; I < 4; ++I)
#pragma unroll
          for (int ks = 0; ks < 2; ++ks) { const bf16x8 bf = *(const LAS bf16x8*)(F.lds + HL_SC + (16 * I + fr) * RS64 + (32 * ks + 8 * g) * 2); o[I] = __builtin_amdgcn_mfma_f32_16x16x32_bf16(af[ks], bf, o[I], 0, 0, 0); }
#pragma unroll
      for (int I = 0; I < 4; ++I)
#pragma unroll
          for (int ks = 0; ks < 4; ++ks) { const bf16x8 bf = *(const LAS bf16x8*)(F.lds + HL_QE + (16 * I + fr) * RS128 + (32 * ks + 8 * g) * 2); o[I] = __builtin_amdgcn_mfma_f32_16x16x32_bf16(sf[ks], bf, o[I], 0, 0, 0); }
    }
    if (STOP == 4) { asm volatile("" :: "v"(o[0]), "v"(o[1]), "v"(o[2]), "v"(o[3]), "v"(gwv[0]), "v"(gain)); return; }
    LAS float* RED = (LAS float*)(F.lds + HL_RED);
#pragma unroll
    for (int I = 0; I < 4; ++I) { float q = (o[I][0] * o[I][0] + o[I][1] * o[I][1]) + (o[I][2] * o[I][2] + o[I][3] * o[I][3]); q += __shfl_xor(q, 16); q += __shfl_xor(q, 32); if (g == 0) RED[wave * 64 + 16 * I + fr] = q; }
    __syncthreads();
    { bf16_t* Y = YMIX_PTR(l);
#pragma unroll
      for (int I = 0; I < 4; ++I) { const int tt = 16 * I + fr; float ssq = 0.f;
#pragma unroll
          for (int w = 0; w < 8; ++w) ssq += RED[w * 64 + tt];
          const float rs = __builtin_amdgcn_rsqf(ssq * (1.f / 128.f) + EPS);
          const u32x2 gw = gwv[I];
          const float g0 = bflo(gw.x), g1 = bfhi(gw.x), g2 = bflo(gw.y), g3 = bfhi(gw.y);
          u32x2 w; w.x = cvt_pk_bf16(o[I][0] * rs * gain.x * (g0 * sigmoidf_(g0)), o[I][1] * rs * gain.y * (g1 * sigmoidf_(g1)));
          w.y = cvt_pk_bf16(o[I][2] * rs * gain.z * (g2 * sigmoidf_(g2)), o[I][3] * rs * gain.w * (g3 * sigmoidf_(g3)));
          *(GAS u32x2*)(Y + (size_t)(row0 + tt) * DM + h * 128 + wave * 16 + 4 * g) = w; } }
}

__device__ __forceinline__ void hg_scan(Frame& F) {
    unsigned char* ws = F.ws;
    for (int gid = F.vcu * NTHR + F.tid; gid < BATCH * HGH * 16384; gid += F.G * NTHR) {
        const int bh = gid >> 14, e = gid & 16383, k = e & 127;
        bf16_t* st = (bf16_t*)(ws + A_STATE) + (size_t)bh * NCHUNK * 16384 + e; const float* dc = (const float*)(ws + A_DECAY) + (size_t)bh * NCHUNK * 128 + k;
        float S = 0.f;
        for (int c0 = 0; c0 < NCHUNK; c0 += 8) { float kv[8], d[8];
#pragma unroll
            for (int i = 0; i < 8; ++i) { kv[i] = bf2f(st[(size_t)(c0 + i) * 16384]); d[i] = dc[(c0 + i) * 128]; }
#pragma unroll
            for (int i = 0; i < 8; ++i) { st[(size_t)(c0 + i) * 16384] = (bf16_t)f2bf(F.dry ? kv[i] : S); S = d[i] * S + kv[i]; } }
    }
}


typedef float f32x16 __attribute__((ext_vector_type(16)));
template <int D, int PAT>
__device__ __forceinline__ void att_pattern(Frame& F, int b, int h, int s_base, float kmax2, const bf16_t* QR, const bf16_t* KF, const bf16_t* VF) {
    const int lane = F.lane, wave = F.wave, r32 = lane & 31, hi = lane >> 5;
    LAS float* ACC = (LAS float*)F.lds; LAS float* LS = (LAS float*)(F.lds + 131072);
    constexpr int TPC = 16 / D, NT = SEQ / D / 32;
    const size_t bh = (size_t)(b * ATH + h) * (SEQ * 64);
    for (int jj = 0; jj < 2; ++jj) {
        const int j = wave + 8 * jj, r = j / TPC, tile = j % TPC, p0 = s_base / D + tile * 32;
        const size_t qrow = (size_t)b * SEQ + (size_t)(p0 + r32) * D + r;
        bf16x8 qf[4];
#pragma unroll
        for (int kk = 0; kk < 4; ++kk) qf[kk] = *(const GAS bf16x8*)(QR + qrow * 512 + h * 64 + 16 * kk + 8 * hi);
        float qn2 = 0.f;
#pragma unroll
        for (int kk = 0; kk < 4; ++kk)
#pragma unroll
            for (int e = 0; e < 8; ++e) { const float x = bf2f((unsigned short)qf[kk][e]); qn2 += x * x; }
        qn2 += __shfl_xor(qn2, 32);
        const float negM = -__builtin_amdgcn_sqrtf(qn2 * kmax2);
        f32x16 o[2] = {{}, {}}; float lsum = 0.f;
#pragma unroll
        for (int kt = 0; kt < 5; ++kt) {
            const float c0 = (p0 - 128 + 32 * kt) < 0 ? -1.0e30f : negM;
            bf16x8 vfr[2][2], kf[4];
            { const int kb = p0 - 128 + 32 * kt, kbc = kb < 0 ? 0 : kb;
              const bf16_t* kp = KF + bh + ((size_t)(r * NT + (kbc >> 5)) * 4) * 512 + lane * 8;
#pragma unroll
              for (int kk = 0; kk < 4; ++kk) kf[kk] = *(const GAS bf16x8*)(kp + kk * 512);
#pragma unroll
              for (int s = 0; s < 2; ++s)
#pragma unroll
                  for (int mt = 0; mt < 2; ++mt) vfr[s][mt] = *(const GAS bf16x8*)(VF + bh + ((size_t)(r * NT + (kbc >> 5)) * 4 + s * 2 + mt) * 512 + lane * 8); }
            f32x16 acc;
#pragma unroll
            for (int rg = 0; rg < 16; ++rg) acc[rg] = c0;
#pragma unroll
            for (int kk = 0; kk < 4; ++kk) acc = __builtin_amdgcn_mfma_f32_32x32x16_bf16(kf[kk], qf[kk], acc, 0, 0, 0);
            if (kt == 0 || kt == 4) {
#pragma unroll
                for (int rg = 0; rg < 16; ++rg) { const int kap = 16 * (rg >> 3) + 8 * hi + (rg & 7); if (kt == 0 ? (kap < r32) : (kap > r32)) acc[rg] = -1.0e30f; } }
#pragma unroll
            for (int rg = 0; rg < 16; ++rg) { acc[rg] = ex2(acc[rg]); lsum += acc[rg]; }
#pragma unroll
            for (int s = 0; s < 2; ++s) {
                u32x4 pw; pw.x = cvt_pk_bf16(acc[8 * s + 0], acc[8 * s + 1]); pw.y = cvt_pk_bf16(acc[8 * s + 2], acc[8 * s + 3]);
                pw.z = cvt_pk_bf16(acc[8 * s + 4], acc[8 * s + 5]); pw.w = cvt_pk_bf16(acc[8 * s + 6], acc[8 * s + 7]);
                const bf16x8 pf = __builtin_bit_cast(bf16x8, pw);
#pragma unroll
                for (int mt = 0; mt < 2; ++mt) o[mt] = __builtin_amdgcn_mfma_f32_32x32x16_bf16(vfr[s][mt], pf, o[mt], 0, 0, 0);
            }
        }
        lsum += __shfl_xor(lsum, 32);
        const int tau = (p0 + r32) * D + r - s_base, gsw = (tau ^ (tau >> 5)) & 31;
        LAS float* arow = ACC + tau * 64;
#pragma unroll
        for (int mt = 0; mt < 2; ++mt)
#pragma unroll
            for (int rg = 0; rg < 16; ++rg) { LAS float* p = arow + ((((rg & 3) + 8 * (rg >> 2) + 4 * hi) ^ gsw) + 32 * mt); if (PAT == 0) *p = o[mt][rg]; else *p += o[mt][rg]; }
        if (hi == 0) { if (PAT == 0) LS[tau] = lsum; else LS[tau] += lsum; }
    }
}
__device__ __forceinline__ void att_unit(Frame& F, int l, int unit) {
    const int tb = unit >> 3, h = unit & 7, b = tb >> 4, s_base = (tb & 15) * 512;
    const bf16_t* QR = (const bf16_t*)(F.ws + A_QR);
    LAS float* ACC = (LAS float*)F.lds; LAS float* LS = (LAS float*)(F.lds + 131072);
    const float kmax2 = __uint_as_float(__hip_atomic_load((unsigned*)(F.ctl + CW_KMAX + l * 16) + b * ATH + h, RLX_AGENT)) * 1.02f;
    att_pattern<1, 0>(F, b, h, s_base, kmax2, QR, (const bf16_t*)(F.ws + A_KF1), (const bf16_t*)(F.ws + A_VT1));
    __syncthreads();
    att_pattern<4, 1>(F, b, h, s_base, kmax2, QR, (const bf16_t*)(F.ws + A_KF4), (const bf16_t*)(F.ws + A_VT4));
    __syncthreads();
    att_pattern<16, 2>(F, b, h, s_base, kmax2, QR, (const bf16_t*)(F.ws + A_KF16), (const bf16_t*)(F.ws + A_VT16));
    __syncthreads();
    { const int tau = F.tid, gsw = (tau ^ (tau >> 5)) & 31; const LAS float* arow = ACC + tau * 64; const float inv = __builtin_amdgcn_rcpf(LS[tau]);
      bf16_t* yrow = YMIX_PTR(l) + ((size_t)b * SEQ + s_base + tau) * DM + 512 + h * 64;
#pragma unroll
      for (int c = 0; c < 8; ++c) { float v[8];
#pragma unroll
          for (int e = 0; e < 8; ++e) v[e] = arow[((8 * c + e) & 32) + (((8 * c + e) & 31) ^ gsw)] * inv;
          u32x4 w; w.x = cvt_pk_bf16(v[0], v[1]); w.y = cvt_pk_bf16(v[2], v[3]); w.z = cvt_pk_bf16(v[4], v[5]); w.w = cvt_pk_bf16(v[6], v[7]); *(GAS u32x4*)(yrow + 8 * c) = w; } }
    __syncthreads();
}

__device__ __forceinline__ void ph_norm(Frame& F, const Args& a) {
    const int gw = F.vcu * NWAVES + F.wave, NGW = F.G * NWAVES;
    for (int r = gw; r < MT; r += NGW) { const float rs = row_norm_prep(F.out + (size_t)r * DM, (bf16_t*)(F.ws + WS_XB) + (size_t)r * DM, nullptr, F.lane); if (F.lane == 0) ((float*)(F.ws + WS_RSTD))[r] = rs; }
}

__device__ __forceinline__ void ph_router(Frame& F, const Args& a, int l) {
    unsigned char* ws = F.ws; const int lane = F.lane;
    const int gw = F.vcu * NWAVES + F.wave, NGW = F.G * NWAVES;
    { LAS float* scr = (LAS float*)(F.lds + F.wave * 16384);
      for (int it = gw; it < 3 * 4096; it += NGW) { const int ty = it >> 12, e = (it >> 8) & 15, r = it & 255;
          if (ty == 0) transpose_mat_item(IN_F(16) + ((size_t)l * NEXP + e) * DM * EFF, DM, EFF, IN_F(13) + l * DM, (bf16_t*)(ws + A_WGU) + (size_t)e * DM * DM, 1, r, scr, lane);
          else if (ty == 1) transpose_mat_item(IN_F(17) + ((size_t)l * NEXP + e) * DM * EFF, DM, EFF, IN_F(13) + l * DM, (bf16_t*)(ws + A_WGU) + (size_t)e * DM * DM, 2, r, scr, lane);
          else transpose_mat_item(IN_F(18) + ((size_t)l * NEXP + e) * EFF * DM, EFF, DM, nullptr, (bf16_t*)(ws + A_WD) + (size_t)e * DM * EFF, 0, r, scr, lane); } }
    __syncthreads();
    unsigned* cnt = (unsigned*)(F.ctl + CW_CNT + l * 16 * 64);
    LAS unsigned* LCNT = (LAS unsigned*)(F.lds + 81920); LAS unsigned* LBASE = (LAS unsigned*)(F.lds + 81984);
    LAS float* LG = (LAS float*)F.lds;
    LAS float* SS = (LAS float*)(F.lds + 16384);
    if (F.tid < 16) LCNT[F.tid] = 0u;
    const bf16_t* WH = (const bf16_t*)(ws + WS_WR) + (size_t)l * 32 * DM; const bf16_t* WL = WH + DEPTH * 32 * DM;
    const int fr = lane & 15, g = lane >> 4, tile = F.wave & 3, kh = F.wave >> 2;
    for (int rt = F.vcu; rt < MT / 64; rt += F.G) {
        const int row = rt * 64 + tile * 16 + fr;
        const bf16_t* xbrow = (const bf16_t*)(ws + WS_XB) + (size_t)row * DM + kh * 512 + 8 * g;
        f32x4 acc[2] = {{0.f, 0.f, 0.f, 0.f}, {0.f, 0.f, 0.f, 0.f}}; float ssq = 0.f;
#pragma unroll 4
        for (int ks = 0; ks < 16; ++ks) {
            const u32x4 hw = *(const GAS u32x4*)(xbrow + 32 * ks);
            { const float x0 = bflo(hw.x), x1 = bfhi(hw.x), x2 = bflo(hw.y), x3 = bfhi(hw.y), x4 = bflo(hw.z), x5 = bfhi(hw.z), x6 = bflo(hw.w), x7 = bfhi(hw.w);
              ssq += ((x0 * x0 + x1 * x1) + (x2 * x2 + x3 * x3)) + ((x4 * x4 + x5 * x5) + (x6 * x6 + x7 * x7)); }
            const bf16x8 ah = __builtin_bit_cast(bf16x8, hw);
#pragma unroll
            for (int ct = 0; ct < 2; ++ct) { const size_t wo = (size_t)(16 * ct + fr) * DM + kh * 512 + 32 * ks + 8 * g;
                const bf16x8 bh = *(const GAS bf16x8*)(WH + wo), bl = *(const GAS bf16x8*)(WL + wo);
                acc[ct] = __builtin_amdgcn_mfma_f32_16x16x32_bf16(ah, bh, acc[ct], 0, 0, 0); acc[ct] = __builtin_amdgcn_mfma_f32_16x16x32_bf16(ah, bl, acc[ct], 0, 0, 0); }
        }
        ssq += __shfl_xor(ssq, 16); ssq += __shfl_xor(ssq, 32);
        if (g == 0) SS[kh * 64 + tile * 16 + fr] = ssq;
#pragma unroll
        for (int ct = 0; ct < 2; ++ct)
#pragma unroll
            for (int rg = 0; rg < 4; ++rg) LG[(kh * 64 + tile * 16 + 4 * g + rg) * 32 + 16 * ct + fr] = acc[ct][rg];
        __syncthreads();
        if (F.tid < 64) { const int rl = F.tid, r = rt * 64 + rl;
            const float rstd = __builtin_amdgcn_rsqf((SS[rl] + SS[64 + rl]) * (1.f / DM) + EPS);
            float lg[20];
#pragma unroll
            for (int q = 0; q < 20; q += 4) { const f32x4 p0 = *(const LAS f32x4*)(LG + rl * 32 + q), p1 = *(const LAS f32x4*)(LG + (64 + rl) * 32 + q); lg[q] = (p0.x + p1.x) * rstd; lg[q + 1] = (p0.y + p1.y) * rstd; lg[q + 2] = (p0.z + p1.z) * rstd; lg[q + 3] = (p0.w + p1.w) * rstd; }
            ((float*)(ws + WS_RSTD))[r] = rstd;
            int gs = 0; float gm = lg[0];
#pragma unroll
            for (int q = 1; q < 4; ++q) if (lg[q] > gm) { gm = lg[q]; gs = q; }
            float den = 0.f;
#pragma unroll
            for (int q = 0; q < 4; ++q) den += __expf(lg[q] - gm);
            const float gwt = __builtin_amdgcn_rcpf(den);
            float e4[4];
#pragma unroll
            for (int q = 0; q < 4; ++q) e4[q] = gs == 0 ? lg[4 + q] : (gs == 1 ? lg[8 + q] : (gs == 2 ? lg[12 + q] : lg[16 + q]));
            int i1 = 0; float v1 = e4[0];
#pragma unroll
            for (int q = 1; q < 4; ++q) if (e4[q] > v1) { v1 = e4[q]; i1 = q; }
            int i2 = -1; float v2 = -3.0e38f;
#pragma unroll
            for (int q = 0; q < 4; ++q) if (q != i1 && e4[q] > v2) { v2 = e4[q]; i2 = q; }
            const float ex = __expf(v2 - v1), w1 = __builtin_amdgcn_rcpf(1.f + ex), w2 = ex * w1;
            const int id1 = gs * 4 + i1, id2 = gs * 4 + i2;
            int* te = (int*)(ws + WS_TOKE) + 2 * r; float* tw = (float*)(ws + WS_TOKW) + 2 * r; int* tl = (int*)(ws + WS_TOKL) + 2 * r;
            te[0] = id1; te[1] = id2; tw[0] = w1 * gwt; tw[1] = w2 * gwt;
            tl[0] = (int)__hip_atomic_fetch_add(LCNT + id1, 1u, __ATOMIC_RELAXED, __HIP_MEMORY_SCOPE_WORKGROUP); tl[1] = (int)__hip_atomic_fetch_add(LCNT + id2, 1u, __ATOMIC_RELAXED, __HIP_MEMORY_SCOPE_WORKGROUP);
        }
        __syncthreads();
    }
    __syncthreads();
    if (F.tid < 16) LBASE[F.tid] = __hip_atomic_fetch_add(cnt + 64 * F.tid, F.dry ? 0u : LCNT[F.tid], RLX_AGENT);
    __syncthreads();
    for (int rt = F.vcu; rt < MT / 64; rt += F.G) {
        if (F.tid < 128) { const int r = rt * 64 + (F.tid >> 1), k = F.tid & 1;
            const int e = ((const int*)(ws + WS_TOKE))[2 * r + k]; const int li = ((const int*)(ws + WS_TOKL))[2 * r + k] + (int)LBASE[e];
            ((int*)(ws + WS_TOKL))[2 * r + k] = li; ((int*)(ws + A_PERM2))[e * 16384 + li] = r; ((float*)(ws + A_SRS2))[e * 16384 + li] = ((const float*)(ws + WS_RSTD))[r]; ((float*)(ws + A_SGW2))[e * 16384 + li] = ((const float*)(ws + WS_TOKW))[2 * r + k]; } }
}

__device__ __forceinline__ void moe_prefix(Frame& F, int l) {
    if (F.tid == 0) { unsigned n[16];
#pragma unroll
        for (int e = 0; e < 16; ++e) n[e] = __hip_atomic_load((unsigned*)(F.ctl + CW_CNT + l * 16 * 64) + 64 * e, RLX_AGENT);
        unsigned acc = 0;
#pragma unroll
        for (int e = 0; e < 16; ++e) { F.MISC[16 + e] = acc; F.MISC[40 + e] = n[e]; acc += (n[e] + 255u) >> 8; }
        F.MISC[32] = acc; }
    __syncthreads();
}

__device__ __forceinline__ void ph_combine(Frame& F, const Args& a, int l) {
    unsigned char* ws = F.ws; const int lane = F.lane;
    const int gw = F.vcu * NWAVES + F.wave, NGW = F.G * NWAVES;
    moe_prefix(F, l);
    const int* tlr = (const int*)(ws + WS_TOKL); const int* te = (const int*)(ws + WS_TOKE); const bf16_t* Y = (const bf16_t*)(ws + A_Y);
    auto slot_of = [&](int p) { return (int)F.MISC[16 + te[p]] * 256 + tlr[p]; };
    auto clampr = [&](int r) { return r < MT ? r : MT - 1; };
    int r = gw; if (r >= MT) return;
    int s0 = slot_of(2 * r), s1 = slot_of(2 * r + 1);
    int rn = clampr(r + NGW); int sn0 = slot_of(2 * rn), sn1 = slot_of(2 * rn + 1);
    const bf16_t* XBp = (const bf16_t*)(ws + WS_XB);
    u32x2 xv[4]; u32x2 ya[4], yb[4];
#pragma unroll
    for (int j = 0; j < 4; ++j) { xv[j] = ((const GAS u32x2*)(XBp + (size_t)r * DM) + lane)[64 * j]; ya[j] = ((const GAS u32x2*)(Y + (size_t)s0 * DM) + lane)[64 * j]; yb[j] = ((const GAS u32x2*)(Y + (size_t)s1 * DM) + lane)[64 * j]; }
    for (; r < MT; r += NGW) {
        const int rnn = clampr(r + 2 * NGW); const int snn0 = slot_of(2 * rnn), snn1 = slot_of(2 * rnn + 1);
        u32x2 xn[4]; u32x2 yan[4], ybn[4];
#pragma unroll
        for (int j = 0; j < 4; ++j) { xn[j] = ((const GAS u32x2*)(XBp + (size_t)rn * DM) + lane)[64 * j]; yan[j] = ((const GAS u32x2*)(Y + (size_t)sn0 * DM) + lane)[64 * j]; ybn[j] = ((const GAS u32x2*)(Y + (size_t)sn1 * DM) + lane)[64 * j]; }
        GAS f32x4* xr = (GAS f32x4*)(F.out + (size_t)r * DM) + lane;
        f32x4 v[4]; float s = 0.f;
#pragma unroll
        for (int j = 0; j < 4; ++j) { const u32x2 p0 = ya[j], p1 = yb[j]; f32x4 x = {bflo(xv[j].x), bfhi(xv[j].x), bflo(xv[j].y), bfhi(xv[j].y)};
            const float dm = F.dry ? 0.f : 1.f; x.x += dm * (bflo(p0.x) + bflo(p1.x)); x.y += dm * (bfhi(p0.x) + bfhi(p1.x)); x.z += dm * (bflo(p0.y) + bflo(p1.y)); x.w += dm * (bfhi(p0.y) + bfhi(p1.y));
            v[j] = x; s += (x.x * x.x + x.y * x.y) + (x.z * x.z + x.w * x.w); }
        const float rstd = __builtin_amdgcn_rsqf(wave_sum(s) * (1.f / DM) + EPS);
        if (l == DEPTH - 1) { const GAS f32x4* g = (const GAS f32x4*)IN_F(19) + lane;
#pragma unroll
            for (int j = 0; j < 4; ++j) xr[64 * j] = v[j] * rstd * g[64 * j];
        } else {
            GAS u32x2* o8 = (GAS u32x2*)((bf16_t*)(ws + WS_XB) + (size_t)r * DM) + lane;
#pragma unroll
            for (int j = 0; j < 4; ++j) { u32x2 w; w.x = cvt_pk_bf16(v[j].x, v[j].y); w.y = cvt_pk_bf16(v[j].z, v[j].w); o8[64 * j] = w; }
            if (lane == 0) ((float*)(ws + WS_RSTD))[r] = rstd;
        }
#pragma unroll
        for (int j = 0; j < 4; ++j) { xv[j] = xn[j]; ya[j] = yan[j]; yb[j] = ybn[j]; }
        rn = rnn; sn0 = snn0; sn1 = snn1;
    }
}

constexpr int NPHASE = 1 + 9 * DEPTH + (PROBE_P >= 0 ? PROBE_N - 1 : 0);
__global__ void __launch_bounds__(NTHR, 2) fwd(Args a) {
    extern __shared__ __attribute__((aligned(16))) unsigned char lds_raw[];
    Frame F;
    F.lds = (LAS unsigned char*)lds_raw; F.MISC = (volatile LAS unsigned*)(F.lds + MISC_OFF);
    F.tid = threadIdx.x; F.lane = F.tid & 63; F.wave = __builtin_amdgcn_readfirstlane(F.tid >> 6);
    F.G = gridDim.x; { const int bx = blockIdx.x; F.vcu = (F.G % 8 == 0) ? (bx % 8) * (F.G / 8) + bx / 8 : bx; }
    F.ws = a.ws; F.ctl = (gu32*)(a.ws + WS_CTL); F.out = a.out; F.z = 0;
    for (int u = F.tid; u < (LDS_BYTES - LDSCTL_OFF) / 4; u += NTHR) ((LAS unsigned*)(F.lds + LDSCTL_OFF))[u] = 0u;
    __syncthreads();
    XcdBarrier bar; bar.bar = (unsigned*)(F.ctl + CW_BAR); bar.x = 0; bar.st = nullptr;
    const bool one_launch = (a.ph_hi - a.ph_lo) > 1;
    if (one_launch) bar = xcd_barrier_post((unsigned*)(F.ctl + CW_BAR), F.MISC + 8);
    for (int pp = a.ph_lo; pp < a.ph_hi; ++pp) {
        int ph = pp;
        F.dry = 0;
        if (PROBE_P >= 0) { constexpr int P = PROBE_P; if (pp > P) ph = (pp - (PROBE_N - 1) > P) ? pp - (PROBE_N - 1) : P; if (ph == P && pp < P + PROBE_N - 1) F.dry = 1; }
        { int t_ = threadIdx.x; asm volatile("" : "+v"(t_)); F.tid = t_; F.lane = t_ & 63; F.wave = __builtin_amdgcn_readfirstlane(t_ >> 6); }
        size_t z_ = 0; asm volatile("" : "+s"(z_)); F.z = z_; F.ws = a.ws + z_; F.out = (float*)((char*)a.out + z_); F.ctl = (gu32*)(a.ws + z_ + WS_CTL);
        unsigned char* ws = F.ws; int bx = (int)blockIdx.x; asm volatile("" : "+s"(bx));
        if (ph == 0) { if (PHSEL(0)) ph_init(F, a); }
        else {
            const int l = (ph - 1) / 9, qq = (ph - 1) % 9, q = qq < 5 ? qq : (qq == 5 ? 8 : qq + 4);
            if (q == 0 && PHSEL(3)) {
                pg8::SchedDense S{64, 14, 896, F.G, bx, (const char*)(ws + WS_XB), (const char*)(ws + WS_WIN) + (size_t)l * NIN * DM * 2, (size_t)256 * DM * 2, (size_t)256 * DM * 2, 64, 0};
                EpiProj E{(bf16_t*)(ws + A_HG), (bf16_t*)(ws + A_QR), (bf16_t*)(ws + A_KF1), (bf16_t*)(ws + A_V), (const float*)(ws + WS_RSTD), (const f32x2*)(ws + WS_CS), (unsigned*)(F.ctl + CW_KMAX + l * 16)};
                pg8::gemm_phase<EpiProj, pg8::SchedDense, true, true, DM, DM>(F.lds, F.tid, S, E);
                if (l == 0) {
                    const bool part = (F.G == 256);
                    { size_t z2 = 0; asm volatile("" : "+s"(z2)); ws = F.ws + z2; F.ws = ws; int t2 = F.tid; asm volatile("" : "+v"(t2)); F.tid = t2; F.lane = t2 & 63; }
                    if (!part || (bx >= 128 && bx < 160)) { SchedKV SK{part ? 32 : F.G, part ? bx - 128 : bx, (const char*)(ws + WS_MEMN), (const char*)(ws + WS_WKVT)};
                        EpiKV EK{(bf16_t*)(ws + WS_KV), (bf16_t*)(ws + WS_KV) + (size_t)DEPTH * MEMROWS * DM};
                        pg8::gemm_phase<EpiKV, SchedKV, true, true, DM, DM>(F.lds, F.tid, SK, EK); }
                    if (!part || bx >= 160) conv_small_l1(F, a, part ? (bx - 160) * NWAVES + F.wave : F.vcu * NWAVES + F.wave, part ? 96 * NWAVES : F.G * NWAVES);
                }
            } else if (q == 1 && PHSEL(4)) {
                hg_lbt_to_lds(F, l);
                for (int rep = 0; rep < PROBE_PREP_N; ++rep) for (int u = F.vcu; u < (MT / 512) * ATH; u += F.G) vf_unit(F, u);
                for (int rep = 0; rep < PROBE_HGA_N; ++rep) { constexpr int NU = BATCH * HGH * NCHUNK; HgIn R = hg_load<false>(F, F.vcu < NU ? F.vcu : NU - 1);
                    for (int u = F.vcu; u < NU; u += F.G) { const HgIn Rn = hg_load<false>(F, u + F.G < NU ? u + F.G : NU - 1); hg_a2_unit(F, a, l, u, R); R = Rn; } __syncthreads(); }
                if (l == 0) {
                    { size_t z2 = 0; asm volatile("" : "+s"(z2)); ws = F.ws + z2; F.ws = ws; int t2 = F.tid; asm volatile("" : "+v"(t2)); F.tid = t2; F.lane = t2 & 63; }
                    SchedFold SF{F.G, bx, (const char*)(ws + WS_KV), (const char*)(ws + WS_KV) + (size_t)DEPTH * MEMROWS * DM * 2, (const char*)(ws + WS_WQS), (const char*)(ws + WS_WOT)};
                    EpiBf16 EF{(bf16_t*)(ws + WS_WQK), DM, (size_t)DM * DM, 1.f};
                    pg8::gemm_phase<EpiBf16, SchedFold, true, true, DM, 256>(F.lds, F.tid, SF, EF); }
            } else if (q == 2 && PHSEL(5)) hg_scan(F);
            else if (q == 3 && PHSEL(6)) {
                hg_lbt_to_lds(F, l);
                for (int rep = 0; rep < PROBE_HGC_N; ++rep) { constexpr int NU = BATCH * HGH * NCHUNK; HgIn R = hg_load<true>(F, F.vcu < NU ? F.vcu : NU - 1);
                    for (int u = F.vcu; u < NU; u += F.G) { const HgIn Rn = hg_load<true>(F, u + F.G < NU ? u + F.G : NU - 1); if (rep + 1 < PROBE_HGC_N) hg_c2_unit<PROBE_HGC_STOP>(F, a, l, u, R); else hg_c2_unit<0>(F, a, l, u, R); R = Rn; } __syncthreads(); }
#if ATT_GOLDEN
                for (int t = F.vcu * NWAVES + F.wave; t < (MT / 64) * ATH; t += F.G * NWAVES) att_task(F, t);
#else
                for (int rep = 0; rep < PROBE_ATT_N; ++rep) for (int u = F.vcu; u < (MT / 512) * ATH; u += F.G) att_unit(F, l, u);
#endif
            } else if (q == 4 && PHSEL(7)) {
                unsigned* ch = (unsigned*)(F.ctl + CW_CHAIN + l * 4096);
                const bool uni = __builtin_amdgcn_readfirstlane((int)F.MISC[10]) != 0; const int cb = uni ? (int)bar.x + 8 * __builtin_amdgcn_readfirstlane((int)F.MISC[11]) : bx;
                { pg8::SchedChain S{{64, 4, 256, F.G, cb, (const char*)YMIX_PTR(l), (const char*)(ws + WS_WOUT) + (size_t)l * DM * DM * 2, (size_t)256 * DM * 2, (size_t)256 * DM * 2, 64, 0}, nullptr, F.tid, uni};
                  EpiResNorm E{IN_F(0), l == 0 ? nullptr : (const bf16_t*)(ws + WS_XB), (bf16_t*)(ws + A_XB2), (float*)(ws + WS_SSQP)};
                  pg8::gemm_phase<EpiResNorm, pg8::SchedChain, true, true, DM, DM>(F.lds, F.tid, S, E); S.signal(ch); }
                { size_t z2 = 0; asm volatile("" : "+s"(z2)); ws = F.ws + z2; F.ws = ws; int t2 = F.tid; asm volatile("" : "+v"(t2)); F.tid = t2; F.lane = t2 & 63; }
                { pg8::SchedChain S{{64, 4, 256, F.G, cb, (const char*)(ws + A_XB2), (const char*)(ws + WS_WQK) + (size_t)l * 2 * DM * DM * 2, (size_t)256 * DM * 2, (size_t)256 * DM * 2, 32, (size_t)DM * DM * 2}, ch, F.tid, uni};
                  EpiSoftmax E{(bf16_t*)(ws + A_P), (const float*)(ws + WS_SSQP)};
                  pg8::gemm_phase<EpiSoftmax, pg8::SchedChain, true, true, DM, DM>(F.lds, F.tid, S, E); S.signal(ch + 2048); }
                { size_t z2 = 0; asm volatile("" : "+s"(z2)); ws = F.ws + z2; F.ws = ws; int t2 = F.tid; asm volatile("" : "+v"(t2)); F.tid = t2; F.lane = t2 & 63; }
                { pg8::SchedChain S{{64, 4, 256, F.G, cb, (const char*)(ws + A_P), (const char*)(ws + WS_WVO) + (size_t)l * 2 * DM * DM * 2, (size_t)256 * DM * 2, (size_t)256 * DM * 2, 32, (size_t)DM * DM * 2}, ch + 2048, F.tid, uni};
                  EpiResAddB E{(const bf16_t*)(ws + A_XB2), (bf16_t*)(ws + WS_XB)};
                  pg8::gemm_phase<EpiResAddB, pg8::SchedChain, true, true, DM, DM>(F.lds, F.tid, S, E); }
            } else if (q == 8 && PHSEL(11)) ph_router(F, a, l);
            else if (q == 10 && PHSEL(13)) {
                moe_prefix(F, l);
                const int total = __builtin_amdgcn_readfirstlane((int)F.MISC[32]) * 4, early = (total / F.G) * F.G;
                SchedMoe S{F.G, bx, DM, F.MISC + 16, (const char*)(ws + WS_XB), (const char*)(ws + A_WGU), (const int*)(ws + A_PERM2), (const unsigned*)(F.ctl + CW_CNT + l * 16 * 64), true, 1, early, total - early, nullptr};
                EpiMoe1 E{(bf16_t*)(ws + A_ACTB), (const float*)(ws + A_SRS2), (const float*)(ws + A_SGW2)};
                pg8::gemm_phase<EpiMoe1, SchedMoe, true, true, DM, DM, true>(F.lds, F.tid, S, E);
            } else if (q == 11 && PHSEL(14)) {
                moe_prefix(F, l);
                const int total = __builtin_amdgcn_readfirstlane((int)F.MISC[32]) * 4, early = (total / F.G) * F.G, rem = total - early;
                unsigned* done = (unsigned*)(F.ctl + CW_DONE + l * 256);
                if (bx < rem) {
                    SchedMoe S{F.G, bx, DM, F.MISC + 16, (const char*)(ws + WS_XB), (const char*)(ws + A_WGU), (const int*)(ws + A_PERM2), (const unsigned*)(F.ctl + CW_CNT + l * 16 * 64), true, 2, early, rem, nullptr};
                    EpiMoe1 E{(bf16_t*)(ws + A_ACTB), (const float*)(ws + A_SRS2), (const float*)(ws + A_SGW2)};
                    pg8::gemm_phase<EpiMoe1, SchedMoe, true, true, DM, DM, true>(F.lds, F.tid, S, E);
                    if (F.tid == 0) { __builtin_amdgcn_fence(__ATOMIC_RELEASE, "agent"); asm volatile("s_waitcnt vmcnt(0)" ::: "memory"); __hip_atomic_fetch_add(done + ((early + bx) >> 2), 1u, __ATOMIC_RELAXED, __HIP_MEMORY_SCOPE_AGENT); }
                }
                { size_t z2 = 0; asm volatile("" : "+s"(z2)); ws = F.ws + z2; F.ws = ws; int t2 = F.tid; asm volatile("" : "+v"(t2)); F.tid = t2; F.lane = t2 & 63; }
                SchedMoe S{F.G, bx, EFF, F.MISC + 16, (const char*)(ws + A_ACTB), (const char*)(ws + A_WD), nullptr, nullptr, false, 3, early, rem, done};
                EpiBf16 E{(bf16_t*)(ws + A_Y), DM, 0, 1.f};
                pg8::gemm_phase<EpiBf16, SchedMoe, true, true, EFF, EFF>(F.lds, F.tid, S, E);
            } else if (q == 12 && PHSEL(15)) ph_combine(F, a, l);
        }
        if (pp + 1 < a.ph_hi) xcd_barrier(bar);
    }
}

extern "C" void kernel_launch(void* const* d_in, const int* in_sizes, int n_in, void* d_out, int out_size, void* d_ws, size_t ws_size, hipStream_t stream) {
    static int grid = 0;
    if (grid == 0) {
        if (n_in != 20 || in_sizes[0] != MT * DM || out_size != MT * DM || ws_size < WS_END) { fprintf(stderr, "kernel_launch: unexpected shapes / workspace (%d inputs, ws %zu)\n", n_in, ws_size); grid = -1; return; }
        int dev = 0, cus = 0, per_cu = 0;
        if (hipGetDevice(&dev) != hipSuccess || hipDeviceGetAttribute(&cus, hipDeviceAttributeMultiprocessorCount, dev) != hipSuccess) { grid = -1; return; }
        if (hipFuncSetAttribute((const void*)fwd, hipFuncAttributeMaxDynamicSharedMemorySize, LDS_BYTES) != hipSuccess) { grid = -1; return; }
        if (hipOccupancyMaxActiveBlocksPerMultiprocessor(&per_cu, (const void*)fwd, NTHR, LDS_BYTES) != hipSuccess || per_cu < 1) { fprintf(stderr, "kernel_launch: occupancy query says %d\n", per_cu); per_cu = 1; }
        (void)hipGetLastError();
        grid = cus * 1;
    }
    if (grid < 0) return;
    (void)hipMemsetAsync((char*)d_ws + WS_CTL, 0, CTL_ZERO_BYTES, stream);
    Args a{};
    for (int i = 0; i < 20; ++i) a.in[i] = d_in[i];
    a.out = (float*)d_out; a.ws = (unsigned char*)d_ws;
#if MK_PER_PHASE
    for (int ph = 0; ph < NPHASE; ++ph) { a.ph_lo = ph; a.ph_hi = ph + 1; hipLaunchKernelGGL(fwd, dim3(grid), dim3(NTHR), LDS_BYTES, stream, a); }
#else
    a.ph_lo = 0; a.ph_hi = NPHASE;
    void* kargs[] = {&a};
    hipError_t e = hipLaunchCooperativeKernel((const void*)fwd, dim3(grid), dim3(NTHR), kargs, LDS_BYTES, stream);
    if (e != hipSuccess) fprintf(stderr, "cooperative launch failed: %s (grid %d)\n", hipGetErrorString(e), grid);
#endif
}
```

```cpp
#include <hip/hip_runtime.h>
#include <cstdio>
#include <cstdint>

#ifndef PH_MASK
#define PH_MASK 0xFFFFFFFFu
#endif
#define PHSEL(n) ((PH_MASK >> (n)) & 1u)
#ifndef PROBE_ATT_N
#define PROBE_ATT_N 1
#endif
#ifndef PROBE_HGC_N
#define PROBE_HGC_N 1
#endif
#ifndef PROBE_HGA_N
#define PROBE_HGA_N 1
#endif
#ifndef PROBE_PREP_N
#define PROBE_PREP_N 1
#endif
#ifndef PROBE_HGC_STOP
#define PROBE_HGC_STOP 0
#endif
#ifndef HGA_EARLY
#define HGA_EARLY 6
#endif
#ifndef PROBE_P
#define PROBE_P -1
#endif
#ifndef PROBE_N
#define PROBE_N 1
#endif
#ifndef HG_A_GOLDEN
#define HG_A_GOLDEN 0
#endif
#ifndef HG_C_GOLDEN
#define HG_C_GOLDEN 0
#endif
#ifndef ATT_GOLDEN
#define ATT_GOLDEN 0
#endif
#ifndef MK_PER_PHASE
#define MK_PER_PHASE 0
#endif

#define LAS __attribute__((address_space(3)))
#define GAS __attribute__((address_space(1)))
typedef unsigned short bf16_t;
typedef short bf16x8 __attribute__((ext_vector_type(8)));
typedef float f32x4 __attribute__((ext_vector_type(4)));
typedef float f32x2 __attribute__((ext_vector_type(2)));
typedef unsigned u32x4 __attribute__((ext_vector_type(4)));
typedef unsigned u32x2 __attribute__((ext_vector_type(2)));
typedef GAS unsigned gu32;

constexpr int BATCH = 2, SEQ = 8192, DM = 1024, MT = BATCH * SEQ, DEPTH = 2;
constexpr int MEM_LEN = 256, MEMROWS = BATCH * MEM_LEN;
constexpr int NIN = 3584, HGW = 512, HGH = 4, HGD = 128, CHUNK = 64, NCHUNK = SEQ / CHUNK;
constexpr int ATW = 512, ATH = 8, ATD = 64;
constexpr int NEXP = 16, EFF = 512;
constexpr float EPS = 1e-6f;
constexpr int NWAVES = 8, NTHR = 512;

constexpr size_t MiB = 1u << 20;
constexpr size_t WS_CTL = 0, CTL_ZERO_BYTES = 1 * MiB;
constexpr size_t WS_RSTD = 1 * MiB;
constexpr size_t WS_TOKE = WS_RSTD + 64 * 1024;
constexpr size_t WS_TOKW = WS_TOKE + 128 * 1024;
constexpr size_t WS_TOKL = WS_TOKW + 128 * 1024;
constexpr size_t WS_SLOTRS = WS_TOKL + 128 * 1024;
constexpr size_t WS_SLOTGW = WS_SLOTRS + 160 * 1024;
constexpr size_t WS_PERM = WS_SLOTGW + 160 * 1024;
constexpr size_t WS_WR = 3 * MiB;
constexpr size_t WS_LBT = 3 * MiB + 256 * 1024;
constexpr size_t WS_SSQP = 3 * MiB + 512 * 1024;
constexpr size_t WS_XB = 4 * MiB;
constexpr size_t WS_WIN = 36 * MiB;
constexpr size_t WS_WOUT = 50 * MiB;
constexpr size_t WS_WQS = 54 * MiB;
constexpr size_t WS_WKVT = 58 * MiB;
constexpr size_t WS_WOT = 66 * MiB;
constexpr size_t WS_MEMN = 70 * MiB;
constexpr size_t WS_KV = 72 * MiB;
constexpr size_t WS_WQK = 76 * MiB;
constexpr size_t WS_WVO = 84 * MiB;
constexpr size_t WS_ACT = 92 * MiB;
constexpr size_t WS_CS = 320 * MiB;
constexpr size_t WS_END = 324 * MiB;
constexpr size_t A_HG = WS_ACT + 0 * MiB;
constexpr size_t A_KF1 = WS_ACT + 64 * MiB;
constexpr size_t A_KF4 = WS_ACT + 80 * MiB;
constexpr size_t A_KF16 = WS_ACT + 96 * MiB;
constexpr size_t A_QR = WS_ACT + 112 * MiB;
constexpr size_t A_V = WS_ACT + 128 * MiB;
constexpr size_t A_VT1 = WS_ACT + 144 * MiB;
constexpr size_t A_VT4 = WS_ACT + 160 * MiB;
constexpr size_t A_VT16 = WS_ACT + 176 * MiB;
constexpr size_t A_STATE = WS_ACT + 192 * MiB;
constexpr size_t A_DECAY = WS_ACT + 224 * MiB;
constexpr size_t A_XB2 = WS_ACT + 0 * MiB;
constexpr size_t A_P = WS_ACT + 32 * MiB;
constexpr size_t A_WGU = WS_ACT + 64 * MiB;
constexpr size_t A_WD = WS_ACT + 96 * MiB;
constexpr size_t A_PERM2 = WS_ACT + 112 * MiB;
constexpr size_t A_SRS2 = WS_ACT + 113 * MiB;
constexpr size_t A_SGW2 = WS_ACT + 114 * MiB;
constexpr size_t A_ACTB = WS_ACT + 120 * MiB;
constexpr size_t A_Y = WS_ACT + 156 * MiB;
constexpr int MAXSLOT = 2 * MT + NEXP * 256;
static_assert(A_Y + (size_t)MAXSLOT * 1024 * 2 <= WS_END, "ws map");
constexpr int CW_BAR = 4096;
constexpr int CW_KMAX = 12288;
constexpr int CW_DONE = 24576;
constexpr int CW_CHAIN = 32768;
constexpr int CW_PROJ = 49152;
constexpr int CW_CNT = 16384;
constexpr int RING_BYTES = 131072;
constexpr int SPARE_OFF = RING_BYTES;
constexpr int LDSCTL_OFF = RING_BYTES + 8192, MISC_OFF = LDSCTL_OFF + 64;
constexpr int LDS_BYTES = 147456;

#define RLX_AGENT __ATOMIC_RELAXED, __HIP_MEMORY_SCOPE_AGENT
#define LDS_WAIT() asm volatile("s_waitcnt lgkmcnt(0)" ::: "memory")
#define VM_WAIT() asm volatile("s_waitcnt vmcnt(0)" ::: "memory")

__device__ __forceinline__ unsigned f2bf(float f) { unsigned u = __builtin_bit_cast(unsigned, f); return (u + 0x7fffu + ((u >> 16) & 1u)) >> 16; }
__device__ __forceinline__ unsigned pk2(float lo, float hi) { return f2bf(lo) | (f2bf(hi) << 16); }
__device__ __forceinline__ float bf2f(unsigned short h) { return __builtin_bit_cast(float, (unsigned)h << 16); }
__device__ __forceinline__ float bflo(unsigned w) { return __builtin_bit_cast(float, w << 16); }
__device__ __forceinline__ float bfhi(unsigned w) { return __builtin_bit_cast(float, w & 0xffff0000u); }
typedef __bf16 bf16x2_t __attribute__((ext_vector_type(2)));
__device__ __forceinline__ unsigned cvt_pk_bf16(float lo, float hi) { f32x2 v = {lo, hi}; bf16x2_t b = __builtin_convertvector(v, bf16x2_t); return __builtin_bit_cast(unsigned, b); }
__device__ __forceinline__ float wave_sum(float v) {
#pragma unroll
    for (int o = 1; o < 64; o <<= 1) v += __shfl_xor(v, o);
    return v;
}
__device__ __forceinline__ float sigmoidf_(float z) { return __builtin_amdgcn_rcpf(1.f + __builtin_amdgcn_exp2f(-1.4426950408889634f * z)); }
__device__ __forceinline__ float ex2(float x) { return __builtin_amdgcn_exp2f(x); }
constexpr float LOG2E = 1.4426950408889634f;

#define XB_TMO      128
#define XB_XCNT(j)  (256  + 64 * (j))
#define XB_XSUB(j)  (1280 + 64 * (j))
#define XB_XGEN(j)  (2304 + 64 * (j))
#define XB_TOP      3328
#define XB_TOPGEN   3392
#define XCD_BAR_WORDS 3456
#define XB_SPIN_CAP (1u << 18)
__device__ __forceinline__ unsigned xb_ld(unsigned* p)              { return __hip_atomic_load(p, __ATOMIC_RELAXED, __HIP_MEMORY_SCOPE_AGENT); }
__device__ __forceinline__ unsigned xb_add(unsigned* p, unsigned v) { return __hip_atomic_fetch_add(p, v, __ATOMIC_RELAXED, __HIP_MEMORY_SCOPE_AGENT); }
__device__ __forceinline__ unsigned xb_xcc_id() { return (unsigned)__builtin_amdgcn_s_getreg((3 << 11) | 20) & 0xFu; }
__device__ __forceinline__ void poll_ge(const unsigned* p, unsigned need) { unsigned sp = 0; while (__hip_atomic_load(p, __ATOMIC_RELAXED, __HIP_MEMORY_SCOPE_AGENT) < need) { __builtin_amdgcn_s_sleep(4); if (++sp > (1u << 20)) break; } }
#define XB_SPIN(cond, bar) do { unsigned _sp = 0; while (cond) { __builtin_amdgcn_s_sleep(1); \
    if ((++_sp & 255u) == 0u) { if (xb_ld(&(bar)[XB_TMO])) break; if (_sp > XB_SPIN_CAP) { atomicAdd(&(bar)[XB_TMO], 1u); break; } } } } while (0)
struct XcdBarrier { unsigned* bar; unsigned x; volatile LAS unsigned* st; };
__device__ __forceinline__ XcdBarrier xcd_barrier_post(unsigned* bar, volatile LAS unsigned* st) {
    XcdBarrier b; b.bar = bar; b.x = xb_xcc_id(); b.st = st;
    if (threadIdx.x == 0) st[3] = xb_add(&bar[XB_XCNT(b.x)], 1u);
    return b;
}
__device__ __forceinline__ void xcd_barrier_complete(unsigned* bar, unsigned x, unsigned& nloc, unsigned& nx, unsigned& uni) {
    const unsigned G = gridDim.x * gridDim.y * gridDim.z;
    unsigned sum, cnt, mine, sp = 0u;
    for (;;) {
        sum = 0u; cnt = 0u; mine = 0u;
        unsigned cv[16];
#pragma unroll
        for (unsigned j = 0; j < 16; ++j) cv[j] = xb_ld(&bar[XB_XCNT(j)]);
#pragma unroll
        for (unsigned j = 0; j < 16; ++j) { const unsigned c = cv[j]; sum += c; cnt += (c > 0u) ? 1u : 0u; mine = (j == x) ? c : mine; }
        if (sum == G) break;
        __builtin_amdgcn_s_sleep(1);
        if ((++sp & 255u) == 0u) { if (xb_ld(&bar[XB_TMO])) break; if (sp > XB_SPIN_CAP) { atomicAdd(&bar[XB_TMO], 1u); break; } }
    }
    nloc = mine > 0u ? mine : 1u; nx = cnt > 0u ? cnt : 1u;
    unsigned u8 = (sum == 256u && G == 256u) ? 1u : 0u;
#pragma unroll
    for (unsigned j = 0; j < 8; ++j) u8 &= (xb_ld(&bar[XB_XCNT(j)]) == 32u) ? 1u : 0u;
    uni = u8;
}
__device__ __forceinline__ void xcd_barrier(const XcdBarrier& b, int tid) {
    asm volatile("s_waitcnt vmcnt(0)" ::: "memory");
    __syncthreads();
    if (tid == 0) {
        unsigned* bar = b.bar;
        __builtin_amdgcn_s_waitcnt(0);
        unsigned nloc = b.st[0], nx = b.st[1];
        if (nloc == 0u) { unsigned uni; xcd_barrier_complete(bar, b.x, nloc, nx, uni); b.st[0] = nloc; b.st[1] = nx; b.st[2] = uni; }
        const unsigned old = xb_add(&bar[XB_XSUB(b.x)], 1u);
        const unsigned gen = old / nloc;
        if (old + 1u == (gen + 1u) * nloc) {
            __builtin_amdgcn_fence(__ATOMIC_RELEASE, "agent");
            asm volatile("s_waitcnt vmcnt(0)" ::: "memory");
            const unsigned og = xb_add(&bar[XB_TOP], 1u);
            const unsigned tg = og / nx;
            if (og + 1u == (tg + 1u) * nx) xb_add(&bar[XB_TOPGEN], 1u);
            else XB_SPIN(xb_ld(&bar[XB_TOPGEN]) == tg, bar);
            __builtin_amdgcn_fence(__ATOMIC_ACQUIRE, "agent");
            xb_add(&bar[XB_XGEN(b.x)], 1u);
            asm volatile("s_waitcnt vmcnt(0)" ::: "memory");
        } else {
            XB_SPIN(xb_ld(&bar[XB_XGEN(b.x)]) == gen, bar);
            __builtin_amdgcn_fence(__ATOMIC_ACQUIRE, "agent");
            asm volatile("s_waitcnt vmcnt(0)" ::: "memory");
        }
    }
    __syncthreads();
}

namespace pg8 {
constexpr int BM = 256, BK = 64, HALF = 128, HTB = HALF * BK * 2, STAGE_BYTES = 8 * HTB, NXCD = 8, WGM = 8;
__host__ __device__ __forceinline__ int lds_byte(int r, int c) { const int st = (r >> 4) * 2 + (c >> 5), rr = r & 15, cc = c & 31, ob = rr * 64 + cc * 2; return st * 1024 + (ob ^ (((ob >> 9) & 1) << 5)); }
__host__ __device__ __forceinline__ void stage_rc(int b, int& R, int& C) { const int st = b / 1024, sb = b % 1024, swz = sb ^ (((sb >> 9) & 1) << 5); R = (st >> 1) * 16 + swz / 64; C = (st & 1) * 32 + (swz % 64) / 2; }
__host__ __device__ __forceinline__ int perm32(int rho) { const int n = rho >> 4, i = rho & 15; return 8 * (i >> 2) + 4 * n + (i & 3); }

struct Unit { int pm, pn, aux, lr; const char* a; const char* b; };
typedef f32x4 Acc[2][2][4][2];

template <class S> __device__ __forceinline__ auto pre_a_call(const S& s, const Unit& u, int) -> decltype(s.pre_a(u), void()) { s.pre_a(u); }
template <class S> __device__ __forceinline__ void pre_a_call(const S&, const Unit&, long) {}
template <class S> __device__ __forceinline__ auto unit_done_call(const S& s, const Unit& u, int) -> decltype(s.unit_done(u), void()) { s.unit_done(u); }
template <class S> __device__ __forceinline__ void unit_done_call(const S&, const Unit&, long) {}
template <class S> constexpr auto has_unit_done(int) -> decltype(&S::unit_done, true) { return true; }
template <class S> constexpr bool has_unit_done(long) { return false; }
template <class Epi, class Sched, bool ALIGN_EPI, bool SP2, int LD, int K, bool GATHER = false>
__device__ __forceinline__ void gemm_phase(LAS unsigned char* lds, const int tid, const Sched& S, const Epi& E) {
    constexpr int lda = LD, ldb = LD;
    const int wid = __builtin_amdgcn_readfirstlane(tid >> 6), lane = tid & 63, wr = wid >> 2, wc = wid & 3, fr = lane & 15, fq = lane >> 4;
    constexpr int nt = K / BK;
    unsigned voffA[2], voffB[2];
#pragma unroll
    for (int i = 0; i < 2; ++i) { int R, C; stage_rc(tid * 16 + i * 8192, R, C); const int Rb = Epi::PERM ? ((R & ~31) + perm32(R & 31)) : R;
        voffA[i] = (unsigned)(R * lda + C) * 2u; voffB[i] = (unsigned)(Rb * ldb + C) * 2u; }
    const size_t kstep = (size_t)(BK * 2);
    const size_t hstepA = (size_t)HALF * lda * 2, hstepB = (size_t)HALF * ldb * 2;
    const unsigned ldsw = (unsigned)wid * 1024u;
    const int aoff = lds_byte(wr * 64 + fr, fq * 8), boff = lds_byte(wc * 32 + fr, fq * 8);
#define PG8_SA(b, h) (((b) * 2 + (h)) * HTB)
#define PG8_SB(b, h) ((4 + (b) * 2 + (h)) * HTB)
#define PG8_STAGE(bufoff, gbase, voff) do { _Pragma("unroll") for (int _i = 0; _i < 2; ++_i) \
        __builtin_amdgcn_global_load_lds((const unsigned*)((const char*)(gbase) + (voff)[_i]), (LAS unsigned*)(lds + (bufoff) + ldsw + _i * 8192), 16, 0, 0); } while (0)
#define PG8_STAGE_A(bufoff, gbase, half, usenext) do { if constexpr (GATHER) { const unsigned _p = (usenext) ? vn[half] : vc[half]; unsigned _v[2]; _v[0] = (_p & 0xffffu) * (unsigned)(lda * 2) + gc2; _v[1] = (_p >> 16) * (unsigned)(lda * 2) + gc2; PG8_STAGE(bufoff, gbase, _v); } \
        else { PG8_STAGE(bufoff, (gbase) + (half) * hstepA, voffA); } } while (0)
#define PG8_LDA(dst, b, h) do { _Pragma("unroll") for (int m = 0; m < 4; ++m) _Pragma("unroll") for (int k = 0; k < 2; ++k) dst[m][k] = *(const LAS bf16x8*)(lds + PG8_SA(b, h) + aoff + m * 2048 + k * 1024); } while (0)
#define PG8_LDB(dst, b, h) do { _Pragma("unroll") for (int n = 0; n < 2; ++n) _Pragma("unroll") for (int k = 0; k < 2; ++k) dst[n][k] = *(const LAS bf16x8*)(lds + PG8_SB(b, h) + boff + n * 2048 + k * 1024); } while (0)
#define PG8_MMA(ai, bj, At, Bt) do { __builtin_amdgcn_s_setprio(1); _Pragma("unroll") for (int m = 0; m < 4; ++m) _Pragma("unroll") for (int n = 0; n < 2; ++n) _Pragma("unroll") for (int k = 0; k < 2; ++k) \
        acc[ai][bj][m][n] = __builtin_amdgcn_mfma_f32_16x16x32_bf16(Bt[n][k], At[m][k], acc[ai][bj][m][n], 0, 0, 0); __builtin_amdgcn_s_setprio(0); } while (0)
#define PG8_WAIT_V(n) asm volatile("s_waitcnt vmcnt(" #n ")" ::: "memory")
#define PG8_WAIT_L(n) asm volatile("s_waitcnt lgkmcnt(" #n ")" ::: "memory")
#define PG8_BAR __builtin_amdgcn_s_barrier()
#define PG8_SCHED __builtin_amdgcn_sched_barrier(0)
    Unit cur, nxt; int ui = 0;
    if (!S.next(0, cur)) return;
    Acc acc;
#pragma unroll
    for (int a = 0; a < 2; ++a)
#pragma unroll
        for (int b = 0; b < 2; ++b)
#pragma unroll
            for (int m = 0; m < 4; ++m)
#pragma unroll
                for (int n = 0; n < 2; ++n) acc[a][b][m][n] = (f32x4){0.f, 0.f, 0.f, 0.f};
    bf16x8 At[4][2], B0[2][2], B1[2][2];
    const char* cA = cur.a; const char* cB = cur.b;
    unsigned vc[2], vn[2], gc2 = 0;
    if constexpr (GATHER) { int R0, C0; stage_rc(tid * 16, R0, C0); gc2 = (unsigned)C0 * 2u;
#pragma unroll
        for (int h = 0; h < 2; ++h) { vc[h] = (unsigned)S.src_row(cur, 128 * h + R0) | ((unsigned)S.src_row(cur, 128 * h + R0 + 64) << 16); vn[h] = vc[h]; }
    }
    static_assert(SP2, "only the two-MFMA-blocks-per-barrier-pair loop is kept");
    {
        PG8_STAGE(PG8_SB(0, 0), cB, voffB); PG8_STAGE(PG8_SB(0, 1), cB + hstepB, voffB); pre_a_call(S, cur, 0);
        PG8_STAGE_A(PG8_SA(0, 0), cA, 0, false); PG8_STAGE_A(PG8_SA(0, 1), cA, 1, false);
        if (wr == 1) PG8_BAR;
        PG8_WAIT_V(2); PG8_BAR;
        PG8_STAGE(PG8_SB(1, 0), cB + kstep, voffB); PG8_STAGE_A(PG8_SA(1, 0), cA + kstep, 0, false); PG8_STAGE(PG8_SB(1, 1), cB + hstepB + kstep, voffB);
        PG8_WAIT_V(6); PG8_BAR;
    }
    for (;;) {
        const bool has_next = S.next(ui + 1, nxt);
        const char* nA = has_next ? nxt.a : cA; const char* nB = has_next ? nxt.b : cB;
        if constexpr (GATHER) { if (has_next) { int R0, C0; stage_rc(tid * 16, R0, C0);
#pragma unroll
            for (int h = 0; h < 2; ++h) vn[h] = (unsigned)S.src_row(nxt, 128 * h + R0) | ((unsigned)S.src_row(nxt, 128 * h + R0 + 64) << 16); } }
#pragma nounroll
        for (int t = 0; t < nt; t += 2) {
            const bool last = (t == nt - 2);
            const char* a1 = cA + (size_t)(t + 1) * kstep;
            const char* a2 = last ? nA : cA + (size_t)(t + 2) * kstep; const char* b2 = last ? nB : cB + (size_t)(t + 2) * kstep;
            const char* a3 = a2 + kstep; const char* b3 = b2 + kstep;
            {
            PG8_LDB(B0, 0, 0); PG8_LDB(B1, 0, 1); PG8_SCHED; PG8_LDA(At, 0, 0); PG8_STAGE_A(PG8_SA(1, 1), a1, 1, false);
            PG8_WAIT_V(8); PG8_WAIT_L(0); PG8_BAR; PG8_MMA(0, 0, At, B0); PG8_MMA(0, 1, At, B1); PG8_BAR; PG8_SCHED;
            PG8_LDA(At, 0, 1); PG8_STAGE(PG8_SB(0, 0), b2, voffB); PG8_STAGE(PG8_SB(0, 1), b2 + hstepB, voffB); PG8_STAGE_A(PG8_SA(0, 0), a2, 0, last);
            PG8_WAIT_V(8); PG8_WAIT_L(0); PG8_BAR; PG8_MMA(1, 0, At, B0); PG8_MMA(1, 1, At, B1); PG8_BAR; PG8_SCHED;
            PG8_LDB(B0, 1, 0); PG8_LDB(B1, 1, 1); PG8_SCHED; PG8_LDA(At, 1, 0); PG8_STAGE_A(PG8_SA(0, 1), a2, 1, last);
            PG8_WAIT_V(8); PG8_WAIT_L(0); PG8_BAR; PG8_MMA(0, 0, At, B0); PG8_MMA(0, 1, At, B1); PG8_BAR; PG8_SCHED;
            PG8_LDA(At, 1, 1); PG8_STAGE(PG8_SB(1, 0), b3, voffB); PG8_STAGE(PG8_SB(1, 1), b3 + hstepB, voffB); PG8_STAGE_A(PG8_SA(1, 0), a3, 0, last);
            PG8_WAIT_V(8); PG8_WAIT_L(0); PG8_BAR; PG8_MMA(1, 0, At, B0); PG8_MMA(1, 1, At, B1); PG8_BAR; PG8_SCHED;
            }
        }
        if constexpr (ALIGN_EPI) { if (wr == 0) PG8_BAR; }
        { int fr_e = lane & 15, fq_e = lane >> 4; asm volatile("" : "+v"(fr_e), "+v"(fq_e)); E(acc, cur, wr, wc, fr_e, fq_e, lds); }
        if (!has_next) break;
        if constexpr (has_unit_done<Sched>(0)) { if (S.wants(cur)) { PG8_WAIT_V(0); PG8_BAR; S.unit_done(cur); } }
#pragma unroll
        for (int a = 0; a < 2; ++a)
#pragma unroll
            for (int b = 0; b < 2; ++b)
#pragma unroll
                for (int m = 0; m < 4; ++m)
#pragma unroll
                    for (int n = 0; n < 2; ++n) acc[a][b][m][n] = (f32x4){0.f, 0.f, 0.f, 0.f};
        cur = nxt; cA = nA; cB = nB; ++ui;
        if constexpr (GATHER) { vc[0] = vn[0]; vc[1] = vn[1]; }
        if constexpr (ALIGN_EPI) { if (wr == 1) PG8_BAR; }
    }
    PG8_WAIT_V(0);
    if constexpr (!ALIGN_EPI) { if (wr == 0) PG8_BAR; }
    PG8_BAR;
    unit_done_call(S, cur, 0);
#undef PG8_SA
#undef PG8_SB
#undef PG8_STAGE
#undef PG8_STAGE_A
#undef PG8_LDA
#undef PG8_LDB
#undef PG8_MMA
#undef PG8_WAIT_V
#undef PG8_WAIT_L
#undef PG8_BAR
#undef PG8_SCHED
}

struct SchedDense {
    int nM, nN, nwg, G, c; const char* A; const char* B; size_t a_tile, b_tile; int pm_per_batch; size_t b_batch;
    __device__ __forceinline__ bool next(int i, Unit& u) const {
        const long L = (long)i * G + c; if (L >= nwg) return false;
        int wgid = (int)L; { const int q = nwg / NXCD, r = nwg % NXCD, xcd = wgid % NXCD, off = wgid / NXCD; wgid = (xcd < r ? xcd * (q + 1) : r * (q + 1) + (xcd - r) * q) + off; }
        const int nig = WGM * nN, gid = wgid / nig, fm = gid * WGM, gsz = (nM - fm) < WGM ? (nM - fm) : WGM;
        u.pm = fm + ((wgid % nig) % gsz); u.pn = (wgid % nig) / gsz; u.aux = 0;
        u.a = A + (size_t)u.pm * a_tile; u.b = B + (size_t)u.pn * b_tile + (size_t)(u.pm / pm_per_batch) * b_batch; return true;
    }
};
struct SchedChain {
    SchedDense D; const unsigned* wait; int tid; bool same_xcd;
    __device__ __forceinline__ void dep(const Unit& u) const { if (wait) {
            if (tid == 0) { unsigned spins = 0; while (__hip_atomic_load(wait + u.pm * 32, __ATOMIC_RELAXED, __HIP_MEMORY_SCOPE_AGENT) < 4u) { __builtin_amdgcn_s_sleep(4); if (++spins > (1u << 20)) break; }
                __builtin_amdgcn_fence(__ATOMIC_ACQUIRE, "agent"); asm volatile("s_waitcnt vmcnt(0)" ::: "memory"); }
            __builtin_amdgcn_s_barrier(); asm volatile("" ::: "memory"); } }
    __device__ __forceinline__ bool next(int i, Unit& u) const { if (!D.next(i, u)) return false; if (i > 0) dep(u); return true; }
    __device__ __forceinline__ void pre_a(const Unit& u) const { dep(u); }
    __device__ __forceinline__ void signal(unsigned* sig) const { if (tid == 0) { if (!same_xcd) { __builtin_amdgcn_fence(__ATOMIC_RELEASE, "agent"); asm volatile("s_waitcnt vmcnt(0)" ::: "memory"); }
            Unit u; for (int i = 0; D.next(i, u); ++i) __hip_atomic_fetch_add(sig + u.pm * 32, 1u, __ATOMIC_RELAXED, __HIP_MEMORY_SCOPE_AGENT); } }
};
struct SchedProj {
    SchedDense D; unsigned* cntA; unsigned* cntV; int tid; bool same_xcd;
    __device__ __forceinline__ bool next(int i, Unit& u) const { return D.next(i, u); }
    __device__ __forceinline__ bool wants(const Unit& u) const { return (u.pn >= 2 && u.pn < 6) || u.pn >= 12; }
    __device__ __forceinline__ void unit_done(const Unit& u) const { if (tid == 0) { unsigned* c = (u.pn >= 2 && u.pn < 6) ? cntA : (u.pn >= 12 ? cntV : nullptr);
            if (c) { if (!same_xcd) { __builtin_amdgcn_fence(__ATOMIC_RELEASE, "agent"); asm volatile("s_waitcnt vmcnt(0)" ::: "memory"); } __hip_atomic_fetch_add(c + u.pm * 32, 1u, __ATOMIC_RELAXED, __HIP_MEMORY_SCOPE_AGENT); } } }
};
}
using pg8::Unit; using pg8::Acc;

struct EpiBf16 {
    static constexpr bool PERM = true;
    bf16_t* O; int ldc; size_t aux_stride; float scale;
    __device__ __forceinline__ void operator()(const Acc& acc, const Unit& u, int wr, int wc, int fr, int fq, LAS unsigned char*) const {
        bf16_t* base = O + (size_t)u.aux * aux_stride;
        const int row0 = u.pm * 256 + wr * 64 + fr, col0 = u.pn * 256 + wc * 32 + 8 * fq;
#pragma unroll
        for (int ai = 0; ai < 2; ++ai)
#pragma unroll
            for (int m = 0; m < 4; ++m) { bf16_t* rowp = base + (size_t)(row0 + ai * 128 + m * 16) * ldc + col0;
#pragma unroll
                for (int bj = 0; bj < 2; ++bj) { const f32x4 v0 = acc[ai][bj][m][0] * scale, v1 = acc[ai][bj][m][1] * scale;
                    u32x4 w; w.x = cvt_pk_bf16(v0[0], v0[1]); w.y = cvt_pk_bf16(v0[2], v0[3]); w.z = cvt_pk_bf16(v1[0], v1[1]); w.w = cvt_pk_bf16(v1[2], v1[3]);
                    *(u32x4*)(rowp + bj * 128) = w; } }
    }
};
struct EpiKV {
    static constexpr bool PERM = true;
    bf16_t* KB; bf16_t* VB;
    __device__ __forceinline__ void operator()(const Acc& acc, const Unit& u, int wr, int wc, int fr, int fq, LAS unsigned char*) const {
        bf16_t* base = (u.pn < 4 ? KB : VB) + (size_t)u.aux * MEMROWS * DM;
        const int row0 = u.pm * 256 + wr * 64 + fr, col0 = (u.pn & 3) * 256 + wc * 32 + 8 * fq;
#pragma unroll
        for (int ai = 0; ai < 2; ++ai)
#pragma unroll
            for (int m = 0; m < 4; ++m) { bf16_t* rowp = base + (size_t)(row0 + ai * 128 + m * 16) * DM + col0;
#pragma unroll
                for (int bj = 0; bj < 2; ++bj) { const f32x4 v0 = acc[ai][bj][m][0], v1 = acc[ai][bj][m][1];
                    u32x4 w; w.x = cvt_pk_bf16(v0[0], v0[1]); w.y = cvt_pk_bf16(v0[2], v0[3]); w.z = cvt_pk_bf16(v1[0], v1[1]); w.w = cvt_pk_bf16(v1[2], v1[3]);
                    *(u32x4*)(rowp + bj * 128) = w; } }
    }
};
struct EpiProj {
    static constexpr bool PERM = true;
    bf16_t* HG; bf16_t* QR; bf16_t* KF; bf16_t* V; const float* rstd; const f32x2* CS; unsigned* kmax;
    __device__ __forceinline__ void operator()(const Acc& acc, const Unit& u, int wr, int wc, int fr, int fq, LAS unsigned char*) const {
        const int row0 = u.pm * 256 + wr * 64 + fr;
        float rsv[2][4];
#pragma unroll
        for (int ai = 0; ai < 2; ++ai)
#pragma unroll
            for (int m = 0; m < 4; ++m) rsv[ai][m] = rstd[row0 + ai * 128 + m * 16];
        if (u.pn < 8 || u.pn >= 12) {
            bf16_t* base; int ldc, colt;
            if (u.pn < 8) { base = HG; ldc = 2048; colt = u.pn * 256; } else { base = V; ldc = 512; colt = (u.pn - 12) * 256; }
            const int col0 = colt + wc * 32 + 8 * fq;
#pragma unroll
            for (int ai = 0; ai < 2; ++ai)
#pragma unroll
                for (int m = 0; m < 4; ++m) { const int row = row0 + ai * 128 + m * 16; const float rs = rsv[ai][m]; bf16_t* rowp = base + (size_t)row * ldc + col0;
#pragma unroll
                    for (int bj = 0; bj < 2; ++bj) { const f32x4 v0 = acc[ai][bj][m][0] * rs, v1 = acc[ai][bj][m][1] * rs;
                        u32x4 w; w.x = cvt_pk_bf16(v0[0], v0[1]); w.y = cvt_pk_bf16(v0[2], v0[3]); w.z = cvt_pk_bf16(v1[0], v1[1]); w.w = cvt_pk_bf16(v1[2], v1[3]);
                        *(u32x4*)(rowp + bj * 128) = w; } }
        } else {
            const bool isk = u.pn >= 10; const int head = 4 * (u.pn & 1) + wc;
            float kn2max = 0.f;
#pragma unroll
            for (int am = 0; am < 4; ++am) { const int ai = am >> 1;
                f32x4 csv[2][4];
#pragma unroll
                for (int mm = 0; mm < 2; ++mm) { const int m = 2 * (am & 1) + mm; const f32x4* cs = (const f32x4*)(CS + (size_t)(row0 + ai * 128 + m * 16) * 32 + 8 * fq); csv[mm][0] = cs[0]; csv[mm][1] = cs[1]; csv[mm][2] = cs[2]; csv[mm][3] = cs[3]; }
#pragma unroll
                for (int mm = 0; mm < 2; ++mm) { const int m = 2 * (am & 1) + mm; const int row = row0 + ai * 128 + m * 16; const float rs = rsv[ai][m] * (isk ? 1.f : 0.125f * LOG2E);
                    const f32x4 c0 = csv[mm][0], c1 = csv[mm][1], c2 = csv[mm][2], c3 = csv[mm][3];
                    const float co[8] = {c0.x, c0.z, c1.x, c1.z, c2.x, c2.z, c3.x, c3.z}, si[8] = {c0.y, c0.w, c1.y, c1.w, c2.y, c2.w, c3.y, c3.w};
                    float lo[8], hi[8];
#pragma unroll
                    for (int n = 0; n < 2; ++n)
#pragma unroll
                        for (int e = 0; e < 4; ++e) { const int j = 4 * n + e; const float x1 = acc[ai][0][m][n][e] * rs, x2 = acc[ai][1][m][n][e] * rs; lo[j] = x1 * co[j] - x2 * si[j]; hi[j] = x2 * co[j] + x1 * si[j]; }
                    u32x4 wl, wh; wl.x = cvt_pk_bf16(lo[0], lo[1]); wl.y = cvt_pk_bf16(lo[2], lo[3]); wl.z = cvt_pk_bf16(lo[4], lo[5]); wl.w = cvt_pk_bf16(lo[6], lo[7]);
                    wh.x = cvt_pk_bf16(hi[0], hi[1]); wh.y = cvt_pk_bf16(hi[2], hi[3]); wh.z = cvt_pk_bf16(hi[4], hi[5]); wh.w = cvt_pk_bf16(hi[6], hi[7]);
                    if (!isk) { bf16_t* rowp = QR + (size_t)row * 512 + head * 64 + 8 * fq; *(u32x4*)rowp = wl; *(u32x4*)(rowp + 32) = wh; }
                    else { { float n2 = 0.f;
#pragma unroll
                          for (int j = 0; j < 8; ++j) n2 += lo[j] * lo[j] + hi[j] * hi[j];
                          n2 += __shfl_xor(n2, 16); n2 += __shfl_xor(n2, 32); kn2max = fmaxf(kn2max, n2); }
                        const int b = row >> 13, s = row & (SEQ - 1); const size_t bh = (size_t)(b * ATH + head) * (SEQ * 64);
#pragma unroll
                        for (int pat = 0; pat < 3; ++pat) { const int D = pat == 0 ? 1 : (pat == 1 ? 4 : 16), sh = pat * 2; const int r = s & (D - 1), p = s >> sh, T = p >> 5, k5 = p & 31;
                            const int rho = (k5 & 19) | ((k5 & 4) << 1) | ((k5 & 8) >> 1);
                            bf16_t* kf = KF + (size_t)pat * (MT * 512) + bh + ((size_t)(r * (SEQ / 32 >> sh) + T) * 4) * 512;
                            *(u32x4*)(kf + ((fq >> 1) * 64 + rho + 32 * (fq & 1)) * 8) = wl; *(u32x4*)(kf + ((2 + (fq >> 1)) * 64 + rho + 32 * (fq & 1)) * 8) = wh; }
                    } } }
            if (isk) { kn2max = fmaxf(kn2max, __shfl_xor(kn2max, 1)); kn2max = fmaxf(kn2max, __shfl_xor(kn2max, 2)); kn2max = fmaxf(kn2max, __shfl_xor(kn2max, 4)); kn2max = fmaxf(kn2max, __shfl_xor(kn2max, 8));
                if (fr == 0 && fq == 0) __hip_atomic_fetch_max(kmax + ((u.pm >> 5) * ATH + head), __float_as_uint(kn2max), __ATOMIC_RELAXED, __HIP_MEMORY_SCOPE_AGENT); }
        }
    }
};
struct EpiResAdd {
    static constexpr bool PERM = false;
    const float* Xs; float* X; float dm;
    __device__ __forceinline__ void operator()(const Acc& acc, const Unit& u, int wr, int wc, int fr, int fq, LAS unsigned char*) const {
        const int row0 = u.pm * 256 + wr * 64 + fr, col0 = u.pn * 256 + wc * 32 + 4 * fq;
#pragma unroll
        for (int ai = 0; ai < 2; ++ai) {
            f32x4 xv[4][2][2];
#pragma unroll
            for (int m = 0; m < 4; ++m) { const size_t off = (size_t)(row0 + ai * 128 + m * 16) * DM + col0;
#pragma unroll
                for (int bj = 0; bj < 2; ++bj)
#pragma unroll
                    for (int n = 0; n < 2; ++n) xv[m][bj][n] = *(const f32x4*)(Xs + off + bj * 128 + n * 16); }
            asm volatile("" ::: "memory");
#pragma unroll
            for (int m = 0; m < 4; ++m) { const size_t off = (size_t)(row0 + ai * 128 + m * 16) * DM + col0;
#pragma unroll
                for (int bj = 0; bj < 2; ++bj)
#pragma unroll
                    for (int n = 0; n < 2; ++n) *(f32x4*)(X + off + bj * 128 + n * 16) = xv[m][bj][n] + acc[ai][bj][m][n] * dm; }
        }
    }
};
struct EpiResAddB {
    static constexpr bool PERM = false;
    const bf16_t* XBs; bf16_t* XBo;
    __device__ __forceinline__ void operator()(const Acc& acc, const Unit& u, int wr, int wc, int fr, int fq, LAS unsigned char*) const {
        const int row0 = u.pm * 256 + wr * 64 + fr, col0 = u.pn * 256 + wc * 32 + 4 * fq;
#pragma unroll
        for (int ai = 0; ai < 2; ++ai) {
            u32x2 xv[4][2][2];
#pragma unroll
            for (int m = 0; m < 4; ++m) { const size_t off = (size_t)(row0 + ai * 128 + m * 16) * DM + col0;
#pragma unroll
                for (int bj = 0; bj < 2; ++bj)
#pragma unroll
                    for (int n = 0; n < 2; ++n) xv[m][bj][n] = *(const u32x2*)(XBs + off + bj * 128 + n * 16); }
            asm volatile("" ::: "memory");
#pragma unroll
            for (int m = 0; m < 4; ++m) { const size_t off = (size_t)(row0 + ai * 128 + m * 16) * DM + col0;
#pragma unroll
                for (int bj = 0; bj < 2; ++bj)
#pragma unroll
                    for (int n = 0; n < 2; ++n) { const u32x2 w = xv[m][bj][n]; const f32x4 a4 = acc[ai][bj][m][n];
                        u32x2 o; o.x = cvt_pk_bf16(bflo(w.x) + a4[0], bfhi(w.x) + a4[1]); o.y = cvt_pk_bf16(bflo(w.y) + a4[2], bfhi(w.y) + a4[3]);
                        *(u32x2*)(XBo + off + bj * 128 + n * 16) = o; } }
        }
    }
};
struct EpiResNorm {
    static constexpr bool PERM = false;
    const float* Xs; const bf16_t* XsB; bf16_t* XB; float* SSQP;
    __device__ __forceinline__ void operator()(const Acc& acc, const Unit& u, int wr, int wc, int fr, int fq, LAS unsigned char* lds) const {
        LAS float* EX = (LAS float*)(lds + SPARE_OFF);
        const int row0 = u.pm * 256 + wr * 64 + fr, col0 = u.pn * 256 + wc * 32 + 4 * fq;
#pragma unroll
        for (int ai = 0; ai < 2; ++ai)
#pragma unroll
            for (int m = 0; m < 4; ++m) { const size_t off = (size_t)(row0 + ai * 128 + m * 16) * DM + col0; float s = 0.f;
#pragma unroll
                for (int bj = 0; bj < 2; ++bj)
#pragma unroll
                    for (int n = 0; n < 2; ++n) { f32x4 xs; if (XsB) { const u32x2 w = *(const u32x2*)(XsB + off + bj * 128 + n * 16); xs = (f32x4){bflo(w.x), bfhi(w.x), bflo(w.y), bfhi(w.y)}; } else xs = *(const f32x4*)(Xs + off + bj * 128 + n * 16);
                        const f32x4 v = xs + acc[ai][bj][m][n];
                        u32x2 w; w.x = cvt_pk_bf16(v[0], v[1]); w.y = cvt_pk_bf16(v[2], v[3]); *(u32x2*)(XB + off + bj * 128 + n * 16) = w;
                        s += (v[0] * v[0] + v[1] * v[1]) + (v[2] * v[2] + v[3] * v[3]); }
                s += __shfl_xor(s, 16); s += __shfl_xor(s, 32);
                if (fq == 0) EX[(ai * 128 + wr * 64 + m * 16 + fr) * 4 + wc] = s; }
        asm volatile("s_waitcnt lgkmcnt(0)" ::: "memory"); __builtin_amdgcn_s_barrier(); asm volatile("" ::: "memory");
        { const int t = (wr * 4 + wc) * 64 + fq * 16 + fr; if (t < 256) { const f32x4 e = *(const LAS f32x4*)(EX + t * 4); SSQP[(size_t)(u.pm * 256 + t) * 4 + u.pn] = (e.x + e.y) + (e.z + e.w); } }
        asm volatile("s_waitcnt lgkmcnt(0)" ::: "memory"); __builtin_amdgcn_s_barrier(); asm volatile("" ::: "memory");
    }
};
struct EpiSoftmax {
    static constexpr bool PERM = false;
    bf16_t* P; const float* SSQP;
    __device__ __forceinline__ void operator()(Acc& acc, const Unit& u, int wr, int wc, int fr, int fq, LAS unsigned char* lds) const {
        LAS f32x2* EX = (LAS f32x2*)(lds + SPARE_OFF);
        const int row0 = u.pm * 256 + wr * 64 + fr;
        f32x4 pqv[2][4];
#pragma unroll
        for (int ai = 0; ai < 2; ++ai)
#pragma unroll
            for (int m = 0; m < 4; ++m) pqv[ai][m] = *(const f32x4*)(SSQP + (size_t)(row0 + ai * 128 + m * 16) * 4);
        float mw[2][4];
#pragma unroll
        for (int ai = 0; ai < 2; ++ai)
#pragma unroll
            for (int m = 0; m < 4; ++m) {
                const f32x4 pq = pqv[ai][m]; const float rs = __builtin_amdgcn_rsqf(((pq.x + pq.y) + (pq.z + pq.w)) * (1.f / DM) + EPS);
                float mx = -3.0e38f;
#pragma unroll
                for (int bj = 0; bj < 2; ++bj)
#pragma unroll
                    for (int n = 0; n < 2; ++n) { f32x4 v = acc[ai][bj][m][n] * rs; acc[ai][bj][m][n] = v; mx = fmaxf(mx, fmaxf(fmaxf(v[0], v[1]), fmaxf(v[2], v[3]))); }
                mx = fmaxf(mx, __shfl_xor(mx, 16)); mx = fmaxf(mx, __shfl_xor(mx, 32));
                float sm = 0.f;
#pragma unroll
                for (int bj = 0; bj < 2; ++bj)
#pragma unroll
                    for (int n = 0; n < 2; ++n) { f32x4 v = acc[ai][bj][m][n]; v[0] = __expf(v[0] - mx); v[1] = __expf(v[1] - mx); v[2] = __expf(v[2] - mx); v[3] = __expf(v[3] - mx);
                        acc[ai][bj][m][n] = v; sm += (v[0] + v[1]) + (v[2] + v[3]); }
                sm += __shfl_xor(sm, 16); sm += __shfl_xor(sm, 32);
                mw[ai][m] = mx;
                if (fq == 0) EX[(ai * 128 + wr * 64 + m * 16 + fr) * 4 + wc] = (f32x2){mx, sm};
            }
        asm volatile("s_waitcnt lgkmcnt(0)" ::: "memory"); __builtin_amdgcn_s_barrier(); asm volatile("" ::: "memory");
#pragma unroll
        for (int ai = 0; ai < 2; ++ai)
#pragma unroll
            for (int m = 0; m < 4; ++m) {
                const int rl = ai * 128 + wr * 64 + m * 16 + fr;
                const f32x2 e0 = EX[rl * 4 + 0], e1 = EX[rl * 4 + 1], e2 = EX[rl * 4 + 2], e3 = EX[rl * 4 + 3];
                const float M = fmaxf(fmaxf(e0.x, e1.x), fmaxf(e2.x, e3.x));
                const float Ls = e0.y * __expf(e0.x - M) + e1.y * __expf(e1.x - M) + e2.y * __expf(e2.x - M) + e3.y * __expf(e3.x - M);
                const float f = __expf(mw[ai][m] - M) / Ls;
                bf16_t* rowp = P + (size_t)(row0 + ai * 128 + m * 16) * DM + u.pn * 256 + wc * 32 + 4 * fq;
#pragma unroll
                for (int bj = 0; bj < 2; ++bj)
#pragma unroll
                    for (int n = 0; n < 2; ++n) { const f32x4 v = acc[ai][bj][m][n] * f; u32x2 w; w.x = cvt_pk_bf16(v[0], v[1]); w.y = cvt_pk_bf16(v[2], v[3]);
                        *(u32x2*)(rowp + bj * 128 + n * 16) = w; }
            }
        asm volatile("s_waitcnt lgkmcnt(0)" ::: "memory"); __builtin_amdgcn_s_barrier(); asm volatile("" ::: "memory");
    }
};
struct EpiMoe1 {
    static constexpr bool PERM = true;
    bf16_t* ACTB; const float* srs; const float* sgw;
    __device__ __forceinline__ void operator()(const Acc& acc, const Unit& u, int wr, int wc, int fr, int fq, LAS unsigned char*) const {
        const int row0 = u.pm * 256 + wr * 64 + fr, col0 = u.pn * 128 + wc * 32 + 8 * fq;
        float rsv[2][4], gwv[2][4];
#pragma unroll
        for (int ai = 0; ai < 2; ++ai)
#pragma unroll
            for (int m = 0; m < 4; ++m) { const int lrow = u.aux * 16384 + u.lr + wr * 64 + fr + ai * 128 + m * 16; rsv[ai][m] = srs[lrow]; gwv[ai][m] = sgw[lrow]; }
#pragma unroll
        for (int ai = 0; ai < 2; ++ai)
#pragma unroll
            for (int m = 0; m < 4; ++m) { const int row = row0 + ai * 128 + m * 16; const float rs = rsv[ai][m], gw = gwv[ai][m] * rs;
                float o[8];
#pragma unroll
                for (int n = 0; n < 2; ++n)
#pragma unroll
                    for (int j = 0; j < 4; ++j) { const float g = acc[ai][0][m][n][j] * rs, up = acc[ai][1][m][n][j]; o[n * 4 + j] = g * sigmoidf_(g) * up * gw; }
                u32x4 w; w.x = cvt_pk_bf16(o[0], o[1]); w.y = cvt_pk_bf16(o[2], o[3]); w.z = cvt_pk_bf16(o[4], o[5]); w.w = cvt_pk_bf16(o[6], o[7]);
                *(u32x4*)(ACTB + (size_t)row * EFF + col0) = w; }
    }
};

struct Args { const void* in[20]; float* out; unsigned char* ws; int ph_lo, ph_hi; };
struct Frame {
    LAS unsigned char* lds; volatile LAS unsigned* MISC; gu32* ctl;
    int tid, lane, wave, vcu, G;
    unsigned char* ws; float* out; size_t z; int dry;
};

__device__ __forceinline__ void transpose_item(const float* W, int N, const float* scale, bf16_t* WT, int ldt, int row_base, int k0, int n0, LAS float* scr, int lane) {
    f32x4 v[8];
#pragma unroll
    for (int i = 0; i < 8; ++i) v[i] = *(const GAS f32x4*)(W + (size_t)(k0 + 8 * i + (lane >> 3)) * N + n0 + 4 * (lane & 7));
#pragma unroll
    for (int i = 0; i < 8; ++i) { const int kk = 8 * i + (lane >> 3); f32x4 x = v[i]; if (scale) x = x * scale[k0 + kk]; LAS float* d = scr + kk * 33 + 4 * (lane & 7); d[0] = x.x; d[1] = x.y; d[2] = x.z; d[3] = x.w; }
    LDS_WAIT(); asm volatile("" ::: "memory");
    const int c = lane & 7;
#pragma unroll
    for (int j = 0; j < 4; ++j) { const int n = (lane >> 3) + 8 * j; const LAS float* s = scr + (8 * c) * 33 + n;
        u32x4 o; o.x = pk2(s[0 * 33], s[1 * 33]); o.y = pk2(s[2 * 33], s[3 * 33]); o.z = pk2(s[4 * 33], s[5 * 33]); o.w = pk2(s[6 * 33], s[7 * 33]);
        *(GAS u32x4*)(WT + (size_t)(row_base + n0 + n) * ldt + k0 + 8 * c) = o; }
    LDS_WAIT(); asm volatile("" ::: "memory");
}
__device__ __forceinline__ void transpose_mat_item(const float* W, int K, int N, const float* scale, bf16_t* WT, int mode, int it, LAS float* scr, int lane) {
    const int nblk = N / 32, kb = it / nblk, nb = it % nblk, k0 = 64 * kb, n0 = 32 * nb;
    int row_base = 0;
    if (mode == 1 || mode == 2) row_base = 256 * (n0 / 128) + (n0 % 128) + (mode == 2 ? 128 : 0) - n0;
    if (mode == 3 && n0 >= 2048 && n0 < 3072) {
        const int blk = (n0 - 2048) / 512, np = (n0 - 2048) % 512, head = np / 64, d = np % 64;
        row_base = 2048 + blk * 512 + (head / 4) * 256 + 128 * (d / 32) + 32 * (head % 4) + (d % 32) - n0; }
    transpose_item(W, N, scale, WT, K, row_base, k0, n0, scr, lane);
}

__device__ __forceinline__ float row_norm_prep(const float* xrow, bf16_t* xb_row, float* copy_row, int lane) {
    const GAS f32x4* xr = (const GAS f32x4*)xrow + lane;
    f32x4 v[4]; float s = 0.f;
#pragma unroll
    for (int j = 0; j < 4; ++j) { v[j] = xr[64 * j]; s += (v[j].x * v[j].x + v[j].y * v[j].y) + (v[j].z * v[j].z + v[j].w * v[j].w); }
    const float rstd = 1.f / sqrtf(wave_sum(s) * (1.f / DM) + EPS);
    GAS u32x2* o8 = (GAS u32x2*)xb_row + lane;
#pragma unroll
    for (int j = 0; j < 4; ++j) { u32x2 w; w.x = pk2(v[j].x, v[j].y); w.y = pk2(v[j].z, v[j].w); o8[64 * j] = w; }
    if (copy_row) { GAS f32x4* c = (GAS f32x4*)copy_row + lane;
#pragma unroll
        for (int j = 0; j < 4; ++j) c[64 * j] = v[j]; }
    return rstd;
}

__constant__ double INV_FREQ[32] = {1.0, 0.7498942093324559, 0.5623413251903491, 0.4216965034285822, 0.31622776601683794, 0.23713737056616552, 0.1778279410038923, 0.1333521432163324,
    0.1, 0.07498942093324558, 0.05623413251903491, 0.042169650342858224, 0.03162277660168379, 0.023713737056616554, 0.01778279410038923, 0.01333521432163324,
    0.01, 0.007498942093324558, 0.005623413251903491, 0.004216965034285823, 0.0031622776601683794, 0.0023713737056616554, 0.0017782794100389228, 0.001333521432163324,
    0.001, 0.0007498942093324559, 0.0005623413251903491, 0.00042169650342858224, 0.00031622776601683794, 0.00023713737056616554, 0.00017782794100389227, 0.0001333521432163324};


#define IN_F(i) ((const float*)((const char*)a.in[i] + F.z))
#define YMIX_PTR(l) ((l) == 0 ? (bf16_t*)(F.ws + WS_XB) : (bf16_t*)F.out)
__device__ __forceinline__ float hg_lb(const Frame& F, const Args& a, int l, int c) { if (l == 0) return 0.f; const float* h = IN_F(5); return sigmoidf_(h[HGW + c] - h[c]); }
__device__ __forceinline__ void conv_small_item(Frame& F, const Args& a, int l, int r, LAS float* scr) {
    unsigned char* ws = F.ws; const int lane = F.lane;
    if (r < 1792) { transpose_mat_item(IN_F(4) + (size_t)l * DM * NIN, DM, NIN, IN_F(3) + l * DM, (bf16_t*)(ws + WS_WIN) + (size_t)l * NIN * DM, 3, r, scr, lane); return; } r -= 1792;
    if (r < 512) { transpose_mat_item(IN_F(7) + (size_t)l * DM * DM, DM, DM, nullptr, (bf16_t*)(ws + WS_WOUT) + (size_t)l * DM * DM, 0, r, scr, lane); return; } r -= 512;
    if (r < 1024) { transpose_mat_item(IN_F(11) + (size_t)l * DM * 2 * DM, DM, 2 * DM, nullptr, (bf16_t*)(ws + WS_WKVT) + (size_t)l * 2 * DM * DM, 0, r, scr, lane); return; } r -= 1024;
    transpose_mat_item(IN_F(12) + (size_t)l * DM * DM, DM, DM, nullptr, (bf16_t*)(ws + WS_WOT) + (size_t)l * DM * DM, 0, r, scr, lane);
}
__device__ __forceinline__ void conv_wq_row(Frame& F, const Args& a, int r) {
    const int lane = F.lane; const float sc = IN_F(8)[r] * 0.0625f;
    const GAS f32x4* src = (const GAS f32x4*)(IN_F(10) + (size_t)r * DM) + lane; GAS u32x2* dst = (GAS u32x2*)((bf16_t*)(F.ws + WS_WQS) + (size_t)r * DM) + lane;
#pragma unroll
    for (int j = 0; j < 4; ++j) { const f32x4 v = src[64 * j] * sc; u32x2 w; w.x = pk2(v.x, v.y); w.y = pk2(v.z, v.w); dst[64 * j] = w; }
}
__device__ __forceinline__ void conv_small_l1(Frame& F, const Args& a, int wi, int nw) {
    LAS float* scr = (LAS float*)(F.lds + F.wave * 16384);
    for (int it = wi; it < 2816; it += nw) conv_small_item(F, a, 1, it < 2304 ? it : it + 1024, scr);
    for (int r = wi; r < DM; r += nw) conv_wq_row(F, a, DM + r);
}
__device__ __forceinline__ void ph_init(Frame& F, const Args& a) {
    { int t9 = F.tid; asm volatile("" : "+v"(t9)); F.tid = t9; F.lane = t9 & 63; }
    LAS float* scr = (LAS float*)(F.lds + F.wave * 16384);
    const int gw = F.vcu * NWAVES + F.wave, NGW = F.G * NWAVES, lane = F.lane;
    unsigned char* ws = F.ws;
    for (int it = gw; it < 3840 + 1024; it += NGW) {
        if (it < 3840) conv_small_item(F, a, 0, it, scr); else conv_small_item(F, a, 1, 2304 + (it - 3840), scr); }
    for (int r = gw; r < DM; r += NGW) conv_wq_row(F, a, r);
    for (int r = gw; r < MEMROWS; r += NGW) {
        const GAS f32x4* xr = (const GAS f32x4*)(IN_F(1) + (size_t)r * DM) + lane;
        f32x4 v[4]; float s = 0.f;
#pragma unroll
        for (int j = 0; j < 4; ++j) { v[j] = xr[64 * j]; s += (v[j].x * v[j].x + v[j].y * v[j].y) + (v[j].z * v[j].z + v[j].w * v[j].w); }
        const float rstd = 1.f / sqrtf(wave_sum(s) * (1.f / DM) + EPS);
        for (int l = 0; l < DEPTH; ++l) {
            const GAS f32x4* g = (const GAS f32x4*)(IN_F(9) + l * DM) + lane; GAS u32x2* dst = (GAS u32x2*)((bf16_t*)(ws + WS_MEMN) + ((size_t)l * MEMROWS + r) * DM) + lane;
#pragma unroll
            for (int j = 0; j < 4; ++j) { const f32x4 o = v[j] * rstd * g[64 * j]; u32x2 w; w.x = pk2(o.x, o.y); w.y = pk2(o.z, o.w); dst[64 * j] = w; }
        }
    }
    for (int r = gw; r < MT; r += NGW) {
        const float rs = row_norm_prep(IN_F(0) + (size_t)r * DM, (bf16_t*)(ws + WS_XB) + (size_t)r * DM, nullptr, lane);
        if (lane == 0) ((float*)(ws + WS_RSTD))[r] = rs;
    }
    for (int i = (F.vcu * NTHR + F.tid); i < DEPTH * HGW; i += F.G * NTHR) ((float*)(ws + WS_LBT))[i] = hg_lb(F, a, i / HGW, i % HGW);
    { const int* pos = (const int*)((const char*)a.in[2] + F.z);
      for (int i = (F.vcu * NTHR + F.tid); i < MT * 32; i += F.G * NTHR) { const double ang = (double)pos[i >> 5] * INV_FREQ[i & 31]; double rev = ang * 0.15915494309189535; rev = rev - __builtin_floor(rev);
          const float fr = (float)rev; ((f32x2*)(ws + WS_CS))[i] = (f32x2){__builtin_amdgcn_cosf(fr), __builtin_amdgcn_sinf(fr)}; } }
    for (int i = (F.vcu * NTHR + F.tid); i < DEPTH * 32 * DM; i += F.G * NTHR) {
        const int l = i / (32 * DM), n = (i / DM) % 32, k = i % DM;
        float w = 0.f;
        if (n < 4) w = IN_F(14)[((size_t)l * DM + k) * 4 + n]; else if (n < 20) w = IN_F(15)[((size_t)l * DM + k) * 16 + (n - 4)];
        w *= IN_F(13)[l * DM + k];
        const unsigned hi = f2bf(w); const float rem = w - bf2f((unsigned short)hi);
        ((bf16_t*)(ws + WS_WR))[i] = (bf16_t)hi; ((bf16_t*)(ws + WS_WR) + DEPTH * 32 * DM)[i] = (bf16_t)f2bf(rem);
    }
}

struct SchedKV {
    int G, c; const char* memn; const char* wkvt;
    __device__ __forceinline__ bool next(int i, Unit& u) const {
        const int L = i * G + c; if (L >= 32) return false;
        const int l = L >> 4; u.pm = (L >> 3) & 1; u.pn = L & 7; u.aux = l;
        u.a = memn + ((size_t)l * MEMROWS + u.pm * 256) * DM * 2; u.b = wkvt + ((size_t)l * 2 * DM + u.pn * 256) * DM * 2; return true;
    }
};
struct SchedFold {
    int G, c; const char* kb; const char* vb; const char* wqs; const char* wot;
    __device__ __forceinline__ bool next(int i, Unit& u) const {
        const int L = i * G + c; if (L >= 128) return false;
        const int ty = L >> 6, l = (L >> 5) & 1, b = (L >> 4) & 1, h = (L >> 2) & 3, t = L & 3; u.aux = ty * 4 + l * 2 + b;
        if (ty == 0) { u.pm = h; u.pn = t; u.a = kb + (((size_t)l * MEMROWS + b * 256) * DM + h * 256) * 2; u.b = wqs + (((size_t)l * DM + t * 256) * DM + h * 256) * 2; }
        else { u.pm = t; u.pn = h; u.a = wot + (((size_t)l * DM + t * 256) * DM + h * 256) * 2; u.b = vb + (((size_t)l * MEMROWS + b * 256) * DM + h * 256) * 2; }
        return true;
    }
};
struct SchedMoe {
    int G, c, kdim; volatile LAS unsigned* tb; const char* A; const char* B; const int* perm2; const unsigned* cnt; bool gather; int mode, early, rem; unsigned* done;
    __device__ __forceinline__ bool next(int i, Unit& u) const {
        const int total = __builtin_amdgcn_readfirstlane((int)tb[16]) * 4; int L;
        if (mode == 0) L = i * G + c;
        else if (mode == 1) { L = i * G + c; if (L >= early) return false; }
        else if (mode == 2) { if (i > 0 || c >= rem) return false; L = early + c; }
        else { const int cc = c >= rem ? c - rem : c - rem + G; L = c >= rem ? (i == 0 ? cc : (G - rem) + (i - 1) * G + cc) : (G - rem) + i * G + cc; }
        if (L >= total) return false;
        if (G == 256 && L < (mode == 1 || mode == 3 ? early : (total / 256) * 256)) { const int rd = L >> 8, idx = L & 255, xcd = idx & 7, q = idx >> 3; L = ((rd * 64 + xcd * 8 + (q >> 2)) << 2) + (q & 3); }
        const int mt = L >> 2; u.pm = mt; u.pn = L & 3; int e = 0;
#pragma unroll
        for (int j = 1; j < 16; ++j) e += (mt >= __builtin_amdgcn_readfirstlane((int)tb[j])) ? 1 : 0;
        u.aux = e; u.lr = (mt - __builtin_amdgcn_readfirstlane((int)tb[e])) * 256; u.a = gather ? A : A + (size_t)mt * 256 * kdim * 2; u.b = B + ((size_t)e * 1024 + u.pn * 256) * kdim * 2;
        if (mode == 3 && L >= early) {
            unsigned spins = 0; while (__hip_atomic_load(done + mt, __ATOMIC_RELAXED, __HIP_MEMORY_SCOPE_AGENT) < 4u) { __builtin_amdgcn_s_sleep(8); if (++spins > (1u << 18)) break; }
            __builtin_amdgcn_fence(__ATOMIC_ACQUIRE, "agent"); asm volatile("s_waitcnt vmcnt(0)" ::: "memory"); }
        return true;
    }
    __device__ __forceinline__ int src_row(const Unit& u, int r) const { const int lrow = u.lr + r; const int n = __builtin_amdgcn_readfirstlane((int)tb[24 + u.aux]); const int v = perm2[u.aux * 16384 + lrow]; return lrow < n ? v : 0; }
};

__device__ __forceinline__ void vf_unit(Frame& F, int unit) {
    unsigned char* ws = F.ws; const int tid = F.tid;
    const int tb = unit >> 3, h = unit & 7, b = tb >> 4, s_base = (tb & 15) * 512;
    LAS unsigned short* Vl = (LAS unsigned short*)F.lds;
    const bf16_t* V = (const bf16_t*)(ws + A_V) + ((size_t)b * SEQ + s_base) * 512 + h * 64;
#pragma unroll
    for (int p = 0; p < 8; ++p) { const int c = p * 512 + tid, row = c >> 3, ch = c & 7; *(LAS u32x4*)(Vl + row * 72 + ch * 8) = *(const GAS u32x4*)(V + (size_t)row * 512 + ch * 8); }
    __syncthreads();
    const size_t bh = (size_t)(b * ATH + h) * (SEQ * 64);
    for (int it = 0; it < 24; ++it) { const int pc = it * 512 + tid, tile = pc >> 8, q = pc & 255, s = q >> 7, mt = (q >> 6) & 1, ln = q & 63, dim = (ln & 31) + 32 * mt, hi = ln >> 5;
        const int pat = tile >> 4, j16 = tile & 15, sh = pat * 2, D = 1 << sh;
        const int TPC = 16 >> sh, r = j16 / TPC, tl = j16 % TPC;
        const int pl = tl * 32 + 16 * s + 8 * hi;
        unsigned w[4];
#pragma unroll
        for (int jj = 0; jj < 4; ++jj) { const int t0 = ((pl + 2 * jj) << sh) + r, t1 = ((pl + 2 * jj + 1) << sh) + r; w[jj] = (unsigned)Vl[t0 * 72 + dim] | ((unsigned)Vl[t1 * 72 + dim] << 16); }
        const int T = (s_base >> sh >> 5) + tl;
        bf16_t* vf = (bf16_t*)(ws + A_VT1) + (size_t)pat * (MT * 512) + bh + ((size_t)(r * (SEQ / 32 >> sh) + T) * 4 + s * 2 + mt) * 512 + ln * 8;
        *(GAS u32x4*)vf = (u32x4){w[0], w[1], w[2], w[3]}; }
    __syncthreads();
}

constexpr int HG_LBT_OFF = 122880;
__device__ __forceinline__ void hg_build_b(Frame& F, int l, int h, const u32x4 z0, const u32x4 z1, int k0, float (&bb)[16], float (&kk)[16]) {
    const int tid = F.tid, lane = F.lane, wave = F.wave, tl = lane & 7;
    LAS float* WT = (LAS float*)F.lds; LAS float* REF = (LAS float*)(F.lds + 4096);
    const unsigned zz[8] = {z0.x, z0.y, z0.z, z0.w, z1.x, z1.y, z1.z, z1.w};
    float lbv[16];
#pragma unroll
    for (int i = 0; i < 16; i += 4) { const f32x4 t4 = *(const LAS f32x4*)(F.lds + HG_LBT_OFF + (h * 128 + k0 + i) * 4); lbv[i] = t4.x; lbv[i + 1] = t4.y; lbv[i + 2] = t4.z; lbv[i + 3] = t4.w; }
#pragma unroll
    for (int i = 0; i < 16; ++i) { const float z = (i & 1) ? bfhi(zz[i >> 1]) : bflo(zz[i >> 1]); const float lb = lbv[i];
        const float e = ex2(-LOG2E * z), sg = __builtin_amdgcn_rcpf(1.f + e), f = lb + (1.f - lb) * sg; bb[i] = __builtin_amdgcn_logf(f); kk[i] = (1.f - lb) * (e * sg); }
#pragma unroll
    for (int i = 0; i < 16; ++i) { float x = bb[i]; float y;
        y = __builtin_bit_cast(float, __builtin_amdgcn_update_dpp(0, __builtin_bit_cast(int, x), 0x111, 0xf, 0xf, true)); if (tl >= 1) x += y;
        y = __builtin_bit_cast(float, __builtin_amdgcn_update_dpp(0, __builtin_bit_cast(int, x), 0x112, 0xf, 0xf, true)); if (tl >= 2) x += y;
        y = __builtin_bit_cast(float, __builtin_amdgcn_update_dpp(0, __builtin_bit_cast(int, x), 0x114, 0xf, 0xf, true)); if (tl >= 4) x += y;
        bb[i] = x; }
    if (tl == 7) {
#pragma unroll
        for (int i = 0; i < 16; i += 4) *(LAS f32x4*)(WT + wave * 128 + k0 + i) = (f32x4){bb[i], bb[i + 1], bb[i + 2], bb[i + 3]}; }
    __syncthreads();
    for (int w = 0; w < wave; ++w) {
#pragma unroll
        for (int i = 0; i < 16; i += 4) { const f32x4 p = *(const LAS f32x4*)(WT + w * 128 + k0 + i); bb[i] += p.x; bb[i + 1] += p.y; bb[i + 2] += p.z; bb[i + 3] += p.w; } }
    if (tl == 7 && (wave & 1)) {
#pragma unroll
        for (int i = 0; i < 16; i += 4) *(LAS f32x4*)(REF + (wave >> 1) * 128 + k0 + i) = (f32x4){bb[i], bb[i + 1], bb[i + 2], bb[i + 3]}; }
    __syncthreads();
    (void)tid;
}
__device__ __forceinline__ void st_row16(LAS unsigned char* base, int byteoff, const float (&v)[16]) {
    u32x4 w0, w1; w0.x = cvt_pk_bf16(v[0], v[1]); w0.y = cvt_pk_bf16(v[2], v[3]); w0.z = cvt_pk_bf16(v[4], v[5]); w0.w = cvt_pk_bf16(v[6], v[7]); w1.x = cvt_pk_bf16(v[8], v[9]); w1.y = cvt_pk_bf16(v[10], v[11]); w1.z = cvt_pk_bf16(v[12], v[13]); w1.w = cvt_pk_bf16(v[14], v[15]);
    *(LAS u32x4*)(base + byteoff) = w0; *(LAS u32x4*)(base + byteoff + 16) = w1;
}
constexpr int HL_RED = 6144, HL_QD = 8192, HL_KD = 25600, HL_QE = 43008, HL_Q1 = 60416, HL_K1 = 69120, HL_Q2 = 77824, HL_K2 = 86528, HL_VT = 95232, HL_SC = 113664;
constexpr int RS_TR = 288;
typedef short s16x4 __attribute__((ext_vector_type(4)));
constexpr int HA_KT = 8192, HA_VT = 8192 + 64 * 288;
constexpr int RS128 = 272, RS64 = 144;

__device__ __forceinline__ void hg_lbt_to_lds(Frame& F, int l) { if (F.tid < 128) *(LAS f32x4*)(F.lds + HG_LBT_OFF + F.tid * 16) = *(const GAS f32x4*)((const float*)(F.ws + WS_LBT) + l * HGW + F.tid * 4); __syncthreads(); }
struct HgIn { u32x4 z0, z1, q0, q1, v0, v1; };
template <bool NEEDQ> __device__ __forceinline__ HgIn hg_load(Frame& F, int unit) {
    HgIn R;
    const int b = unit >> 9, h = (unit >> 7) & 3, c = unit & 127; const int row0 = b * SEQ + c * CHUNK, t = (F.tid >> 6) * 8 + (F.tid & 7), k0 = ((F.tid >> 3) & 7) * 16;
    const bf16_t* rowp = (const bf16_t*)(F.ws + A_HG) + (size_t)(row0 + t) * 2048 + h * 128 + k0;
    R.z0 = *(const GAS u32x4*)(rowp + 512); R.z1 = *(const GAS u32x4*)(rowp + 512 + 8); R.v0 = *(const GAS u32x4*)(rowp + 1024); R.v1 = *(const GAS u32x4*)(rowp + 1024 + 8);
    if (NEEDQ) { R.q0 = *(const GAS u32x4*)(rowp); R.q1 = *(const GAS u32x4*)(rowp + 8); } else { R.q0 = R.z0; R.q1 = R.z1; }
    return R;
}
__device__ __forceinline__ void hg_a2_unit(Frame& F, const Args& a, int l, int unit, const HgIn& R) {
    unsigned char* ws = F.ws; const int tid = F.tid, lane = F.lane, wave = F.wave;
    const int h = (unit >> 7) & 3;
    const int t = (tid >> 6) * 8 + (tid & 7), k0 = ((tid >> 3) & 7) * 16;
    const u32x4 v0 = R.v0, v1 = R.v1;
    float bb[16], kk[16];
    hg_build_b(F, l, h, R.z0, R.z1, k0, bb, kk);
    const LAS float* REF = (const LAS float*)(F.lds + 4096);
    { float tmp[16];
#pragma unroll
      for (int i = 0; i < 16; ++i) tmp[i] = kk[i] * ex2(REF[3 * 128 + k0 + i] - bb[i]);
      st_row16(F.lds, HA_KT + t * RS_TR + k0 * 2, tmp);
      *(LAS u32x4*)(F.lds + HA_VT + t * RS_TR + k0 * 2) = v0; *(LAS u32x4*)(F.lds + HA_VT + t * RS_TR + k0 * 2 + 16) = v1; }
    if (tid < 128) ((float*)(ws + A_DECAY))[(size_t)unit * 128 + tid] = ex2(REF[3 * 128 + tid]);
    __syncthreads();
    { const int fr = lane & 15, g = lane >> 4;
      const int q = fr >> 2, p = fr & 3;
      auto trfrag = [&](int base, int c0, int ks) -> bf16x8 {
          const LAS unsigned char* a0 = F.lds + base + (32 * ks + 8 * g + q) * RS_TR + (c0 + 4 * p) * 2;
          const s16x4 lo = __builtin_bit_cast(s16x4, __builtin_amdgcn_ds_read_tr16_b64_v4i16((LAS s16x4*)a0));
          const s16x4 hi = __builtin_bit_cast(s16x4, __builtin_amdgcn_ds_read_tr16_b64_v4i16((LAS s16x4*)(a0 + 4 * RS_TR)));
          return (bf16x8){lo[0], lo[1], lo[2], lo[3], hi[0], hi[1], hi[2], hi[3]}; };
      bf16x8 af[2];
#pragma unroll
      for (int ks = 0; ks < 2; ++ks) af[ks] = trfrag(HA_KT, wave * 16, ks);
      bf16_t* st = (bf16_t*)(ws + A_STATE) + (size_t)unit * 16384;
#pragma unroll
      for (int vt = 0; vt < 8; ++vt) { f32x4 acc = {0.f, 0.f, 0.f, 0.f};
#pragma unroll
          for (int ks = 0; ks < 2; ++ks) { const bf16x8 bf = trfrag(HA_VT, vt * 16, ks); acc = __builtin_amdgcn_mfma_f32_16x16x32_bf16(af[ks], bf, acc, 0, 0, 0); }
          u32x2 w; w.x = cvt_pk_bf16(acc[0], acc[1]); w.y = cvt_pk_bf16(acc[2], acc[3]);
          *(GAS u32x2*)(st + (vt * 16 + fr) * 128 + wave * 16 + 4 * g) = w; } }
}

template <int STOP> __device__ __forceinline__ void hg_c2_unit(Frame& F, const Args& a, int l, int unit, const HgIn& R) {
    unsigned char* ws = F.ws; const int tid = F.tid, lane = F.lane, wave = F.wave;
    const int b = unit >> 9, h = (unit >> 7) & 3, c = unit & 127; const int row0 = b * SEQ + c * CHUNK;
    const int t = (tid >> 6) * 8 + (tid & 7), k0 = ((tid >> 3) & 7) * 16;
    const int fr = lane & 15, g = lane >> 4;
    const bf16_t* HG = (const bf16_t*)(ws + A_HG);
    const u32x4 q0 = R.q0, q1 = R.q1, v0 = R.v0, v1 = R.v1;
    bf16x8 sf[4]; u32x2 gwv[4];
    { const bf16_t* st = (const bf16_t*)(ws + A_STATE) + (size_t)unit * 16384 + (wave * 16 + fr) * 128;
#pragma unroll
      for (int ks = 0; ks < 4; ++ks) sf[ks] = *(const GAS bf16x8*)(st + 32 * ks + 8 * g);
#pragma unroll
      for (int I = 0; I < 4; ++I) gwv[I] = *(const GAS u32x2*)(HG + (size_t)(row0 + 16 * I + fr) * 2048 + 1536 + h * 128 + wave * 16 + 4 * g); }
    const f32x4 gain = *(const GAS f32x4*)(IN_F(6) + l * HGW + h * 128 + wave * 16 + 4 * g);
    float bb[16], kk[16];
    hg_build_b(F, l, h, R.z0, R.z1, k0, bb, kk);
    if (STOP == 1) { asm volatile("" :: "v"(bb[0]), "v"(kk[0]), "v"(sf[0]), "v"(gwv[0]), "v"(gain)); return; }
    const LAS float* REF = (const LAS float*)(F.lds + 4096);
    { const unsigned qq[8] = {q0.x, q0.y, q0.z, q0.w, q1.x, q1.y, q1.z, q1.w}, vv[8] = {v0.x, v0.y, v0.z, v0.w, v1.x, v1.y, v1.z, v1.w};
      LAS unsigned short* VT = (LAS unsigned short*)(F.lds + HL_VT);
      float qv[16], tmp[16];
#pragma unroll
      for (int i = 0; i < 16; ++i) { qv[i] = (i & 1) ? bfhi(qq[i >> 1]) : bflo(qq[i >> 1]); VT[(k0 + i) * (RS64 / 2) + t] = (unsigned short)((i & 1) ? (vv[i >> 1] >> 16) : (vv[i >> 1] & 0xffffu)); }
      const int I = wave >> 1;
      float rf[16];
#pragma unroll
      for (int i = 0; i < 16; i += 4) { f32x4 r4 = {0.f, 0.f, 0.f, 0.f}; if (I) r4 = *(const LAS f32x4*)(REF + (I - 1) * 128 + k0 + i); rf[i] = r4.x; rf[i + 1] = r4.y; rf[i + 2] = r4.z; rf[i + 3] = r4.w; }
#pragma unroll
      for (int i = 0; i < 16; ++i) tmp[i] = qv[i] * ex2(bb[i] - rf[i]);
      st_row16(F.lds, HL_QD + t * RS128 + k0 * 2, tmp);
#pragma unroll
      for (int i = 0; i < 16; ++i) tmp[i] = kk[i] * ex2(fminf(rf[i] - bb[i], 86.f));
      st_row16(F.lds, HL_KD + t * RS128 + k0 * 2, tmp);
#pragma unroll
      for (int i = 0; i < 16; ++i) tmp[i] = qv[i] * ex2(bb[i]);
      st_row16(F.lds, HL_QE + t * RS128 + k0 * 2, tmp);
#pragma unroll
      for (int i = 0; i < 16; i += 4) { const f32x4 r4 = *(const LAS f32x4*)(REF + 1 * 128 + k0 + i); rf[i] = r4.x; rf[i + 1] = r4.y; rf[i + 2] = r4.z; rf[i + 3] = r4.w; }
      if (wave >= 4) {
#pragma unroll
          for (int i = 0; i < 16; ++i) tmp[i] = qv[i] * ex2(bb[i] - rf[i]);
          st_row16(F.lds, HL_Q1 + (t & 31) * RS128 + k0 * 2, tmp);
      } else {
#pragma unroll
          for (int i = 0; i < 16; ++i) tmp[i] = kk[i] * ex2(rf[i] - bb[i]);
          st_row16(F.lds, HL_K1 + (t & 31) * RS128 + k0 * 2, tmp);
      }
#pragma unroll
      for (int i = 0; i < 16; i += 4) { const f32x4 r4 = *(const LAS f32x4*)(REF + ((wave >= 4) ? 2 : 0) * 128 + k0 + i); rf[i] = r4.x; rf[i + 1] = r4.y; rf[i + 2] = r4.z; rf[i + 3] = r4.w; }
      if (wave & 2) {
#pragma unroll
          for (int i = 0; i < 16; ++i) tmp[i] = qv[i] * ex2(bb[i] - rf[i]);
          st_row16(F.lds, HL_Q2 + ((t & 15) + ((wave >= 4) ? 16 : 0)) * RS128 + k0 * 2, tmp);
      } else {
#pragma unroll
          for (int i = 0; i < 16; ++i) tmp[i] = kk[i] * ex2(rf[i] - bb[i]);
          st_row16(F.lds, HL_K2 + ((t & 15) + ((wave >= 4) ? 16 : 0)) * RS128 + k0 * 2, tmp);
      }
      for (int i = tid; i < 64 * RS64 / 16; i += NTHR) *(LAS u32x4*)(F.lds + HL_SC + i * 16) = (u32x4){0u, 0u, 0u, 0u};
    }
    __syncthreads();
    if (STOP == 2) { asm volatile("" :: "v"(sf[0]), "v"(gwv[0]), "v"(gain)); return; }
    for (int blk = wave; blk < 10; blk += 8) {
        int ko, qo, J, I; bool diag = false;
        if (blk < 4) { ko = HL_KD + blk * 16 * RS128; qo = HL_QD + blk * 16 * RS128; J = blk; I = blk; diag = true; }
        else if (blk == 4) { ko = HL_K2; qo = HL_Q2; J = 0; I = 1; }
        else if (blk == 5) { ko = HL_K2 + 16 * RS128; qo = HL_Q2 + 16 * RS128; J = 2; I = 3; }
        else { const int jj = (blk - 6) >> 1, ii = (blk - 6) & 1; ko = HL_K1 + jj * 16 * RS128; qo = HL_Q1 + ii * 16 * RS128; J = jj; I = 2 + ii; }
        f32x4 acc = {0.f, 0.f, 0.f, 0.f};
#pragma unroll
        for (int ks = 0; ks < 4; ++ks) { const bf16x8 af = *(const LAS bf16x8*)(F.lds + ko + fr * RS128 + (32 * ks + 8 * g) * 2), bf = *(const LAS bf16x8*)(F.lds + qo + fr * RS128 + (32 * ks + 8 * g) * 2);
            acc = __builtin_amdgcn_mfma_f32_16x16x32_bf16(af, bf, acc, 0, 0, 0); }
        if (diag) {
#pragma unroll
            for (int rg = 0; rg < 4; ++rg) if (4 * g + rg > fr) acc[rg] = 0.f; }
        u32x2 w; w.x = cvt_pk_bf16(acc[0], acc[1]); w.y = cvt_pk_bf16(acc[2], acc[3]);
        *(LAS u32x2*)(F.lds + HL_SC + (16 * I + fr) * RS64 + (16 * J + 4 * g) * 2) = w;
    }
    __syncthreads();
    if (STOP == 3) { asm volatile("" :: "v"(sf[0]), "v"(gwv[0]), "v"(gain)); return; }
    f32x4 o[4];
#pragma unroll
    for (int I = 0; I < 4; ++I) o[I] = (f32x4){0.f, 0.f, 0.f, 0.f};
    { bf16x8 af[2];
#pragma unroll
      for (int ks = 0; ks < 2; ++ks) af[ks] = *(const LAS bf16x8*)(F.lds + HL_VT + (wave * 16 + fr) * RS64 + (32 * ks + 8 * g) * 2);
#pragma unroll
      for (int I = 0; I < 4; ++I)
#pragma unroll
          for (int ks = 0; ks < 2; ++ks) { const bf16x8 bf = *(const LAS bf16x8*)(F.lds + HL_SC + (16 * I + fr) * RS64 + (32 * ks + 8 * g) * 2); o[I] = __builtin_amdgcn_mfma_f32_16x16x32_bf16(af[ks], bf, o[I], 0, 0, 0); }
#pragma unroll
      for (int I = 0; I < 4; ++I)
#pragma unroll
          for (int ks = 0; ks < 4; ++ks) { const bf16x8 bf = *(const LAS bf16x8*)(F.lds + HL_QE + (16 * I + fr) * RS128 + (32 * ks + 8 * g) * 2); o[I] = __builtin_amdgcn_mfma_f32_16x16x32_bf16(sf[ks], bf, o[I], 0, 0, 0); }
    }
    if (STOP == 4) { asm volatile("" :: "v"(o[0]), "v"(o[1]), "v"(o[2]), "v"(o[3]), "v"(gwv[0]), "v"(gain)); return; }
    LAS float* RED = (LAS float*)(F.lds + HL_RED);
#pragma unroll
    for (int I = 0; I < 4; ++I) { float q = (o[I][0] * o[I][0] + o[I][1] * o[I][1]) + (o[I][2] * o[I][2] + o[I][3] * o[I][3]); q += __shfl_xor(q, 16); q += __shfl_xor(q, 32); if (g == 0) RED[wave * 64 + 16 * I + fr] = q; }
    __syncthreads();
    { bf16_t* Y = YMIX_PTR(l);
#pragma unroll
      for (int I = 0; I < 4; ++I) { const int tt = 16 * I + fr; float ssq = 0.f;
#pragma unroll
          for (int w = 0; w < 8; ++w) ssq += RED[w * 64 + tt];
          const float rs = __builtin_amdgcn_rsqf(ssq * (1.f / 128.f) + EPS);
          const u32x2 gw = gwv[I];
          const float g0 = bflo(gw.x), g1 = bfhi(gw.x), g2 = bflo(gw.y), g3 = bfhi(gw.y);
          u32x2 w; w.x = cvt_pk_bf16(o[I][0] * rs * gain.x * (g0 * sigmoidf_(g0)), o[I][1] * rs * gain.y * (g1 * sigmoidf_(g1)));
          w.y = cvt_pk_bf16(o[I][2] * rs * gain.z * (g2 * sigmoidf_(g2)), o[I][3] * rs * gain.w * (g3 * sigmoidf_(g3)));
          *(GAS u32x2*)(Y + (size_t)(row0 + tt) * DM + h * 128 + wave * 16 + 4 * g) = w; } }
}

__device__ __forceinline__ void hg_scan(Frame& F) {
    { int t9 = F.tid; asm volatile("" : "+v"(t9)); F.tid = t9; F.lane = t9 & 63; }
    unsigned char* ws = F.ws;
    for (int gid = F.vcu * NTHR + F.tid; gid < BATCH * HGH * 16384; gid += F.G * NTHR) {
        const int bh = gid >> 14, e = gid & 16383, k = e & 127;
        bf16_t* st = (bf16_t*)(ws + A_STATE) + (size_t)bh * NCHUNK * 16384 + e; const float* dc = (const float*)(ws + A_DECAY) + (size_t)bh * NCHUNK * 128 + k;
        float S = 0.f;
        for (int c0 = 0; c0 < NCHUNK; c0 += 8) { float kv[8], d[8];
#pragma unroll
            for (int i = 0; i < 8; ++i) { kv[i] = bf2f(st[(size_t)(c0 + i) * 16384]); d[i] = dc[(c0 + i) * 128]; }
#pragma unroll
            for (int i = 0; i < 8; ++i) { st[(size_t)(c0 + i) * 16384] = (bf16_t)f2bf(F.dry ? kv[i] : S); S = d[i] * S + kv[i]; } }
    }
}


typedef float f32x16 __attribute__((ext_vector_type(16)));
template <int D, int PAT>
__device__ __forceinline__ void att_pattern(Frame& F, int b, int h, int s_base, float kmax2, const bf16_t* QR, const bf16_t* KF, const bf16_t* VF) {
    const int lane = F.lane, wave = F.wave, r32 = lane & 31, hi = lane >> 5;
    LAS float* ACC = (LAS float*)F.lds; LAS float* LS = (LAS float*)(F.lds + 131072);
    constexpr int TPC = 16 / D, NT = SEQ / D / 32;
    const size_t bh = (size_t)(b * ATH + h) * (SEQ * 64);
    for (int jj = 0; jj < 2; ++jj) {
        const int j = wave + 8 * jj, r = j / TPC, tile = j % TPC, p0 = s_base / D + tile * 32;
        const size_t qrow = (size_t)b * SEQ + (size_t)(p0 + r32) * D + r;
        bf16x8 qf[4];
#pragma unroll
        for (int kk = 0; kk < 4; ++kk) qf[kk] = *(const GAS bf16x8*)(QR + qrow * 512 + h * 64 + 16 * kk + 8 * hi);
        float qn2 = 0.f;
#pragma unroll
        for (int kk = 0; kk < 4; ++kk)
#pragma unroll
            for (int e = 0; e < 8; ++e) { const float x = bf2f((unsigned short)qf[kk][e]); qn2 += x * x; }
        qn2 += __shfl_xor(qn2, 32);
        const float negM = -__builtin_amdgcn_sqrtf(qn2 * kmax2);
        f32x16 o[2] = {{}, {}}; float lsum = 0.f;
#pragma unroll
        for (int kt = 0; kt < 5; ++kt) {
            const float c0 = (p0 - 128 + 32 * kt) < 0 ? -1.0e30f : negM;
            bf16x8 vfr[2][2], kf[4];
            { const int kb = p0 - 128 + 32 * kt, kbc = kb < 0 ? 0 : kb;
              const bf16_t* kp = KF + bh + ((size_t)(r * NT + (kbc >> 5)) * 4) * 512 + lane * 8;
#pragma unroll
              for (int kk = 0; kk < 4; ++kk) kf[kk] = *(const GAS bf16x8*)(kp + kk * 512);
#pragma unroll
              for (int s = 0; s < 2; ++s)
#pragma unroll
                  for (int mt = 0; mt < 2; ++mt) vfr[s][mt] = *(const GAS bf16x8*)(VF + bh + ((size_t)(r * NT + (kbc >> 5)) * 4 + s * 2 + mt) * 512 + lane * 8); }
            f32x16 acc;
#pragma unroll
            for (int rg = 0; rg < 16; ++rg) acc[rg] = c0;
#pragma unroll
            for (int kk = 0; kk < 4; ++kk) acc = __builtin_amdgcn_mfma_f32_32x32x16_bf16(kf[kk], qf[kk], acc, 0, 0, 0);
            if (kt == 0 || kt == 4) {
#pragma unroll
                for (int rg = 0; rg < 16; ++rg) { const int kap = 16 * (rg >> 3) + 8 * hi + (rg & 7); if (kt == 0 ? (kap < r32) : (kap > r32)) acc[rg] = -1.0e30f; } }
#pragma unroll
            for (int rg = 0; rg < 16; ++rg) { acc[rg] = ex2(acc[rg]); lsum += acc[rg]; }
#pragma unroll
            for (int s = 0; s < 2; ++s) {
                u32x4 pw; pw.x = cvt_pk_bf16(acc[8 * s + 0], acc[8 * s + 1]); pw.y = cvt_pk_bf16(acc[8 * s + 2], acc[8 * s + 3]);
                pw.z = cvt_pk_bf16(acc[8 * s + 4], acc[8 * s + 5]); pw.w = cvt_pk_bf16(acc[8 * s + 6], acc[8 * s + 7]);
                const bf16x8 pf = __builtin_bit_cast(bf16x8, pw);
#pragma unroll
                for (int mt = 0; mt < 2; ++mt) o[mt] = __builtin_amdgcn_mfma_f32_32x32x16_bf16(vfr[s][mt], pf, o[mt], 0, 0, 0);
            }
        }
        lsum += __shfl_xor(lsum, 32);
        const int tau = (p0 + r32) * D + r - s_base, gsw = (tau ^ (tau >> 5)) & 31;
        LAS float* arow = ACC + tau * 64;
#pragma unroll
        for (int mt = 0; mt < 2; ++mt)
#pragma unroll
            for (int rg = 0; rg < 16; ++rg) { LAS float* p = arow + ((((rg & 3) + 8 * (rg >> 2) + 4 * hi) ^ gsw) + 32 * mt); if (PAT == 0) *p = o[mt][rg]; else *p += o[mt][rg]; }
        if (hi == 0) { if (PAT == 0) LS[tau] = lsum; else LS[tau] += lsum; }
    }
}
__device__ __forceinline__ void att_unit(Frame& F, int l, int unit) {
    const int tb = unit >> 3, h = unit & 7, b = tb >> 4, s_base = (tb & 15) * 512;
    const bf16_t* QR = (const bf16_t*)(F.ws + A_QR);
    LAS float* ACC = (LAS float*)F.lds; LAS float* LS = (LAS float*)(F.lds + 131072);
    const float kmax2 = __uint_as_float(__hip_atomic_load((unsigned*)(F.ctl + CW_KMAX + l * 16) + b * ATH + h, RLX_AGENT)) * 1.02f;
    att_pattern<1, 0>(F, b, h, s_base, kmax2, QR, (const bf16_t*)(F.ws + A_KF1), (const bf16_t*)(F.ws + A_VT1));
    __syncthreads();
    att_pattern<4, 1>(F, b, h, s_base, kmax2, QR, (const bf16_t*)(F.ws + A_KF4), (const bf16_t*)(F.ws + A_VT4));
    __syncthreads();
    att_pattern<16, 2>(F, b, h, s_base, kmax2, QR, (const bf16_t*)(F.ws + A_KF16), (const bf16_t*)(F.ws + A_VT16));
    __syncthreads();
    { const int tau = F.tid, gsw = (tau ^ (tau >> 5)) & 31; const LAS float* arow = ACC + tau * 64; const float inv = __builtin_amdgcn_rcpf(LS[tau]);
      bf16_t* yrow = YMIX_PTR(l) + ((size_t)b * SEQ + s_base + tau) * DM + 512 + h * 64;
#pragma unroll
      for (int c = 0; c < 8; ++c) { float v[8];
#pragma unroll
          for (int e = 0; e < 8; ++e) v[e] = arow[((8 * c + e) & 32) + (((8 * c + e) & 31) ^ gsw)] * inv;
          u32x4 w; w.x = cvt_pk_bf16(v[0], v[1]); w.y = cvt_pk_bf16(v[2], v[3]); w.z = cvt_pk_bf16(v[4], v[5]); w.w = cvt_pk_bf16(v[6], v[7]); *(GAS u32x4*)(yrow + 8 * c) = w; } }
    __syncthreads();
}

__device__ __forceinline__ void ph_norm(Frame& F, const Args& a) {
    const int gw = F.vcu * NWAVES + F.wave, NGW = F.G * NWAVES;
    for (int r = gw; r < MT; r += NGW) { const float rs = row_norm_prep(F.out + (size_t)r * DM, (bf16_t*)(F.ws + WS_XB) + (size_t)r * DM, nullptr, F.lane); if (F.lane == 0) ((float*)(F.ws + WS_RSTD))[r] = rs; }
}

__device__ __forceinline__ void ph_router(Frame& F, const Args& a, int l, const unsigned* wait, int rt0) {
    { int t9 = F.tid; asm volatile("" : "+v"(t9)); F.tid = t9; F.lane = t9 & 63; }
    unsigned char* ws = F.ws; const int lane = F.lane;
    const int gw = F.vcu * NWAVES + F.wave, NGW = F.G * NWAVES;
    { LAS float* scr = (LAS float*)(F.lds + F.wave * 16384);
      for (int it = gw; it < 3 * 4096; it += NGW) { const int ty = it >> 12, e = (it >> 8) & 15, r = it & 255;
          if (ty == 0) transpose_mat_item(IN_F(16) + ((size_t)l * NEXP + e) * DM * EFF, DM, EFF, IN_F(13) + l * DM, (bf16_t*)(ws + A_WGU) + (size_t)e * DM * DM, 1, r, scr, lane);
          else if (ty == 1) transpose_mat_item(IN_F(17) + ((size_t)l * NEXP + e) * DM * EFF, DM, EFF, IN_F(13) + l * DM, (bf16_t*)(ws + A_WGU) + (size_t)e * DM * DM, 2, r, scr, lane);
          else transpose_mat_item(IN_F(18) + ((size_t)l * NEXP + e) * EFF * DM, EFF, DM, nullptr, (bf16_t*)(ws + A_WD) + (size_t)e * DM * EFF, 0, r, scr, lane); } }
    if (wait && F.tid == 0) { if (rt0 >= 0) poll_ge(wait + (rt0 >> 2) * 32, 4u); else for (int p = 0; p < 64; ++p) poll_ge(wait + p * 32, 4u);
        __builtin_amdgcn_fence(__ATOMIC_ACQUIRE, "agent"); asm volatile("s_waitcnt vmcnt(0)" ::: "memory"); }
    __syncthreads();
    const int rt_first = rt0 >= 0 ? rt0 : F.vcu, rt_step = rt0 >= 0 ? MT / 64 : F.G;
    unsigned* cnt = (unsigned*)(F.ctl + CW_CNT + l * 16 * 64);
    LAS unsigned* LCNT = (LAS unsigned*)(F.lds + 81920); LAS unsigned* LBASE = (LAS unsigned*)(F.lds + 81984);
    LAS float* LG = (LAS float*)F.lds;
    LAS float* SS = (LAS float*)(F.lds + 16384);
    if (F.tid < 16) LCNT[F.tid] = 0u;
    const bf16_t* WH = (const bf16_t*)(ws + WS_WR) + (size_t)l * 32 * DM; const bf16_t* WL = WH + DEPTH * 32 * DM;
    const int fr = lane & 15, g = lane >> 4, tile = F.wave & 3, kh = F.wave >> 2;
    for (int rt = rt_first; rt < MT / 64; rt += rt_step) {
        const int row = rt * 64 + tile * 16 + fr;
        const bf16_t* xbrow = (const bf16_t*)(ws + WS_XB) + (size_t)row * DM + kh * 512 + 8 * g;
        f32x4 acc[2] = {{0.f, 0.f, 0.f, 0.f}, {0.f, 0.f, 0.f, 0.f}}; float ssq = 0.f;
#pragma unroll 4
        for (int ks = 0; ks < 16; ++ks) {
            const u32x4 hw = *(const GAS u32x4*)(xbrow + 32 * ks);
            { const float x0 = bflo(hw.x), x1 = bfhi(hw.x), x2 = bflo(hw.y), x3 = bfhi(hw.y), x4 = bflo(hw.z), x5 = bfhi(hw.z), x6 = bflo(hw.w), x7 = bfhi(hw.w);
              ssq += ((x0 * x0 + x1 * x1) + (x2 * x2 + x3 * x3)) + ((x4 * x4 + x5 * x5) + (x6 * x6 + x7 * x7)); }
            const bf16x8 ah = __builtin_bit_cast(bf16x8, hw);
#pragma unroll
            for (int ct = 0; ct < 2; ++ct) { const size_t wo = (size_t)(16 * ct + fr) * DM + kh * 512 + 32 * ks + 8 * g;
                const bf16x8 bh = *(const GAS bf16x8*)(WH + wo), bl = *(const GAS bf16x8*)(WL + wo);
                acc[ct] = __builtin_amdgcn_mfma_f32_16x16x32_bf16(ah, bh, acc[ct], 0, 0, 0); acc[ct] = __builtin_amdgcn_mfma_f32_16x16x32_bf16(ah, bl, acc[ct], 0, 0, 0); }
        }
        ssq += __shfl_xor(ssq, 16); ssq += __shfl_xor(ssq, 32);
        if (g == 0) SS[kh * 64 + tile * 16 + fr] = ssq;
#pragma unroll
        for (int ct = 0; ct < 2; ++ct)
#pragma unroll
            for (int rg = 0; rg < 4; ++rg) LG[(kh * 64 + tile * 16 + 4 * g + rg) * 32 + 16 * ct + fr] = acc[ct][rg];
        __syncthreads();
        if (F.tid < 64) { const int rl = F.tid, r = rt * 64 + rl;
            const float rstd = __builtin_amdgcn_rsqf((SS[rl] + SS[64 + rl]) * (1.f / DM) + EPS);
            float lg[20];
#pragma unroll
            for (int q = 0; q < 20; q += 4) { const f32x4 p0 = *(const LAS f32x4*)(LG + rl * 32 + q), p1 = *(const LAS f32x4*)(LG + (64 + rl) * 32 + q); lg[q] = (p0.x + p1.x) * rstd; lg[q + 1] = (p0.y + p1.y) * rstd; lg[q + 2] = (p0.z + p1.z) * rstd; lg[q + 3] = (p0.w + p1.w) * rstd; }
            ((float*)(ws + WS_RSTD))[r] = rstd;
            int gs = 0; float gm = lg[0];
#pragma unroll
            for (int q = 1; q < 4; ++q) if (lg[q] > gm) { gm = lg[q]; gs = q; }
            float den = 0.f;
#pragma unroll
            for (int q = 0; q < 4; ++q) den += __expf(lg[q] - gm);
            const float gwt = __builtin_amdgcn_rcpf(den);
            float e4[4];
#pragma unroll
            for (int q = 0; q < 4; ++q) e4[q] = gs == 0 ? lg[4 + q] : (gs == 1 ? lg[8 + q] : (gs == 2 ? lg[12 + q] : lg[16 + q]));
            int i1 = 0; float v1 = e4[0];
#pragma unroll
            for (int q = 1; q < 4; ++q) if (e4[q] > v1) { v1 = e4[q]; i1 = q; }
            int i2 = -1; float v2 = -3.0e38f;
#pragma unroll
            for (int q = 0; q < 4; ++q) if (q != i1 && e4[q] > v2) { v2 = e4[q]; i2 = q; }
            const float ex = __expf(v2 - v1), w1 = __builtin_amdgcn_rcpf(1.f + ex), w2 = ex * w1;
            const int id1 = gs * 4 + i1, id2 = gs * 4 + i2;
            int* te = (int*)(ws + WS_TOKE) + 2 * r; float* tw = (float*)(ws + WS_TOKW) + 2 * r; int* tl = (int*)(ws + WS_TOKL) + 2 * r;
            te[0] = id1; te[1] = id2; tw[0] = w1 * gwt; tw[1] = w2 * gwt;
            tl[0] = (int)__hip_atomic_fetch_add(LCNT + id1, 1u, __ATOMIC_RELAXED, __HIP_MEMORY_SCOPE_WORKGROUP); tl[1] = (int)__hip_atomic_fetch_add(LCNT + id2, 1u, __ATOMIC_RELAXED, __HIP_MEMORY_SCOPE_WORKGROUP);
        }
        __syncthreads();
    }
    __syncthreads();
    if (F.tid < 16) LBASE[F.tid] = __hip_atomic_fetch_add(cnt + 64 * F.tid, F.dry ? 0u : LCNT[F.tid], RLX_AGENT);
    __syncthreads();
    for (int rt = rt_first; rt < MT / 64; rt += rt_step) {
        if (F.tid < 128) { const int r = rt * 64 + (F.tid >> 1), k = F.tid & 1;
            const int e = ((const int*)(ws + WS_TOKE))[2 * r + k]; const int li = ((const int*)(ws + WS_TOKL))[2 * r + k] + (int)LBASE[e];
            ((int*)(ws + WS_TOKL))[2 * r + k] = li; ((int*)(ws + A_PERM2))[e * 16384 + li] = r; ((float*)(ws + A_SRS2))[e * 16384 + li] = ((const float*)(ws + WS_RSTD))[r]; ((float*)(ws + A_SGW2))[e * 16384 + li] = ((const float*)(ws + WS_TOKW))[2 * r + k]; } }
}

__device__ __forceinline__ void moe_prefix(Frame& F, int l) {
    if (F.tid == 0) { unsigned n[16];
#pragma unroll
        for (int e = 0; e < 16; ++e) n[e] = __hip_atomic_load((unsigned*)(F.ctl + CW_CNT + l * 16 * 64) + 64 * e, RLX_AGENT);
        unsigned acc = 0;
#pragma unroll
        for (int e = 0; e < 16; ++e) { F.MISC[16 + e] = acc; F.MISC[40 + e] = n[e]; acc += (n[e] + 255u) >> 8; }
        F.MISC[32] = acc; }
    __syncthreads();
}

__device__ __forceinline__ void ph_combine(Frame& F, const Args& a, int l) {
    { int t9 = F.tid; asm volatile("" : "+v"(t9)); F.tid = t9; F.lane = t9 & 63; }
    unsigned char* ws = F.ws; const int lane = F.lane;
    const int gw = F.vcu * NWAVES + F.wave, NGW = F.G * NWAVES;
    moe_prefix(F, l);
    const int* tlr = (const int*)(ws + WS_TOKL); const int* te = (const int*)(ws + WS_TOKE); const bf16_t* Y = (const bf16_t*)(ws + A_Y);
    auto slot_of = [&](int p) { return (int)F.MISC[16 + te[p]] * 256 + tlr[p]; };
    auto clampr = [&](int r) { return r < MT ? r : MT - 1; };
    int r = gw; if (r >= MT) return;
    int s0 = slot_of(2 * r), s1 = slot_of(2 * r + 1);
    int rn = clampr(r + NGW); int sn0 = slot_of(2 * rn), sn1 = slot_of(2 * rn + 1);
    const bf16_t* XBp = (const bf16_t*)(ws + WS_XB);
    u32x2 xv[4]; u32x2 ya[4], yb[4];
#pragma unroll
    for (int j = 0; j < 4; ++j) { xv[j] = ((const GAS u32x2*)(XBp + (size_t)r * DM) + lane)[64 * j]; ya[j] = ((const GAS u32x2*)(Y + (size_t)s0 * DM) + lane)[64 * j]; yb[j] = ((const GAS u32x2*)(Y + (size_t)s1 * DM) + lane)[64 * j]; }
    for (; r < MT; r += NGW) {
        const int rnn = clampr(r + 2 * NGW); const int snn0 = slot_of(2 * rnn), snn1 = slot_of(2 * rnn + 1);
        u32x2 xn[4]; u32x2 yan[4], ybn[4];
#pragma unroll
        for (int j = 0; j < 4; ++j) { xn[j] = ((const GAS u32x2*)(XBp + (size_t)rn * DM) + lane)[64 * j]; yan[j] = ((const GAS u32x2*)(Y + (size_t)sn0 * DM) + lane)[64 * j]; ybn[j] = ((const GAS u32x2*)(Y + (size_t)sn1 * DM) + lane)[64 * j]; }
        GAS f32x4* xr = (GAS f32x4*)(F.out + (size_t)r * DM) + lane;
        f32x4 v[4]; float s = 0.f;
#pragma unroll
        for (int j = 0; j < 4; ++j) { const u32x2 p0 = ya[j], p1 = yb[j]; f32x4 x = {bflo(xv[j].x), bfhi(xv[j].x), bflo(xv[j].y), bfhi(xv[j].y)};
            const float dm = F.dry ? 0.f : 1.f; x.x += dm * (bflo(p0.x) + bflo(p1.x)); x.y += dm * (bfhi(p0.x) + bfhi(p1.x)); x.z += dm * (bflo(p0.y) + bflo(p1.y)); x.w += dm * (bfhi(p0.y) + bfhi(p1.y));
            v[j] = x; s += (x.x * x.x + x.y * x.y) + (x.z * x.z + x.w * x.w); }
        const float rstd = __builtin_amdgcn_rsqf(wave_sum(s) * (1.f / DM) + EPS);
        if (l == DEPTH - 1) { const GAS f32x4* g = (const GAS f32x4*)IN_F(19) + lane;
#pragma unroll
            for (int j = 0; j < 4; ++j) xr[64 * j] = v[j] * rstd * g[64 * j];
        } else {
            GAS u32x2* o8 = (GAS u32x2*)((bf16_t*)(ws + WS_XB) + (size_t)r * DM) + lane;
#pragma unroll
            for (int j = 0; j < 4; ++j) { u32x2 w; w.x = cvt_pk_bf16(v[j].x, v[j].y); w.y = cvt_pk_bf16(v[j].z, v[j].w); o8[64 * j] = w; }
            if (lane == 0) ((float*)(ws + WS_RSTD))[r] = rstd;
        }
#pragma unroll
        for (int j = 0; j < 4; ++j) { xv[j] = xn[j]; ya[j] = yan[j]; yb[j] = ybn[j]; }
        rn = rnn; sn0 = snn0; sn1 = snn1;
    }
}

constexpr int NPHASE = 1 + 7 * DEPTH + (PROBE_P >= 0 ? PROBE_N - 1 : 0);
__global__ void __launch_bounds__(NTHR, 2) fwd(Args a) {
    extern __shared__ __attribute__((aligned(16))) unsigned char lds_raw[];
    Frame F;
    F.lds = (LAS unsigned char*)lds_raw; F.MISC = (volatile LAS unsigned*)(F.lds + MISC_OFF);
    F.tid = threadIdx.x; F.lane = F.tid & 63; F.wave = __builtin_amdgcn_readfirstlane(F.tid >> 6); const int wave_s = F.wave;
    F.G = gridDim.x; { const int bx = blockIdx.x; F.vcu = (F.G % 8 == 0) ? (bx % 8) * (F.G / 8) + bx / 8 : bx; }
    F.ws = a.ws; F.ctl = (gu32*)(a.ws + WS_CTL); F.out = a.out; F.z = 0;
    for (int u = F.tid; u < (LDS_BYTES - LDSCTL_OFF) / 4; u += NTHR) ((LAS unsigned*)(F.lds + LDSCTL_OFF))[u] = 0u;
    __syncthreads();
    XcdBarrier bar; bar.bar = (unsigned*)(F.ctl + CW_BAR); bar.x = 0; bar.st = nullptr;
    const bool one_launch = (a.ph_hi - a.ph_lo) > 1;
    if (one_launch) bar = xcd_barrier_post((unsigned*)(F.ctl + CW_BAR), F.MISC + 8);
    for (int pp = a.ph_lo; pp < a.ph_hi; ++pp) {
        int ph = pp;
        F.dry = 0;
        if (PROBE_P >= 0) { constexpr int P = PROBE_P; if (pp > P) ph = (pp - (PROBE_N - 1) > P) ? pp - (PROBE_N - 1) : P; if (ph == P && pp < P + PROBE_N - 1) F.dry = 1; }
        { int w_ = wave_s; asm volatile("" : "+s"(w_)); int t_; asm volatile("v_mbcnt_lo_u32_b32 %0, -1, 0\n\tv_mbcnt_hi_u32_b32 %0, -1, %0" : "=v"(t_)); t_ += w_ * 64; asm volatile("" : "+v"(t_)); F.tid = t_; F.lane = t_ & 63; F.wave = w_; }
        size_t z_ = 0; asm volatile("" : "+s"(z_)); F.z = z_; F.ws = a.ws + z_; F.out = (float*)((char*)a.out + z_); F.ctl = (gu32*)(a.ws + z_ + WS_CTL);
        unsigned char* ws = F.ws; int bx = (int)blockIdx.x; asm volatile("" : "+s"(bx));
        if (ph == 0) { if (PHSEL(0)) ph_init(F, a); }
        else {
            const int l = (ph - 1) / 7, qq = (ph - 1) % 7, q = qq == 0 ? 0 : (qq < 4 ? qq + 1 : qq + 6);
            if (q == 0 && PHSEL(3)) {
                const bool g256 = (F.G == 256);
                const bool uni = g256 && __builtin_amdgcn_readfirstlane((int)F.MISC[10]) != 0; const int cb = uni ? (int)bar.x + 8 * __builtin_amdgcn_readfirstlane((int)F.MISC[11]) : bx;
                unsigned* pc = (unsigned*)(F.ctl + CW_PROJ + l * 4096);
                { pg8::SchedProj S{{64, 14, 896, F.G, cb, (const char*)(ws + WS_XB), (const char*)(ws + WS_WIN) + (size_t)l * NIN * DM * 2, (size_t)256 * DM * 2, (size_t)256 * DM * 2, 64, 0}, pc, pc + 2048, F.tid, uni};
                  EpiProj E{(bf16_t*)(ws + A_HG), (bf16_t*)(ws + A_QR), (bf16_t*)(ws + A_KF1), (bf16_t*)(ws + A_V), (const float*)(ws + WS_RSTD), (const f32x2*)(ws + WS_CS), (unsigned*)(F.ctl + CW_KMAX + l * 16)};
                  pg8::gemm_phase<EpiProj, pg8::SchedProj, true, true, DM, DM>(F.lds, F.tid, S, E); }
                if (l == 0) {
                    { size_t z2 = 0; asm volatile("" : "+s"(z2)); ws = F.ws + z2; F.ws = ws; int t2 = F.tid; asm volatile("" : "+v"(t2)); F.tid = t2; F.lane = t2 & 63; }
                    if (!g256 || (cb >= 128 && cb < 160)) { SchedKV SK{g256 ? 32 : F.G, g256 ? cb - 128 : bx, (const char*)(ws + WS_MEMN), (const char*)(ws + WS_WKVT)};
                        EpiKV EK{(bf16_t*)(ws + WS_KV), (bf16_t*)(ws + WS_KV) + (size_t)DEPTH * MEMROWS * DM};
                        pg8::gemm_phase<EpiKV, SchedKV, true, true, DM, DM>(F.lds, F.tid, SK, EK); }
                    if (!g256 || cb >= 160) conv_small_l1(F, a, g256 ? (cb - 160) * NWAVES + F.wave : F.vcu * NWAVES + F.wave, g256 ? 96 * NWAVES : F.G * NWAVES);
                }
                { size_t z2 = 0; asm volatile("" : "+s"(z2)); ws = F.ws + z2; F.ws = ws; int t2 = F.tid; asm volatile("" : "+v"(t2)); F.tid = t2; F.lane = t2 & 63; }
                hg_lbt_to_lds(F, l);
                {
                    constexpr int NU = BATCH * HGH * NCHUNK;
                    const int vx = cb & 7, vr = cb >> 3, EA = (l == 0) ? 4 : HGA_EARLY;
                    const int na = g256 ? (vr >= 16 ? EA : 8 - EA) : (NU - F.vcu + F.G - 1) / F.G, j0 = vr >= 16 ? (vr - 16) * EA : 16 * EA + vr * (8 - EA);
                    auto unit_of = [&](int k) -> int { if (!g256) return F.vcu + k * F.G; const int j = j0 + k; return ((vx >> 2) << 9) | ((j & 3) << 7) | ((vx & 3) * 32 + (j >> 4) * 4 + ((j >> 2) & 3)); };
                    if (F.tid == 0) { if (g256) { for (int p = j0 >> 4; p <= (j0 + na - 1) >> 4; ++p) poll_ge(pc + (8 * vx + p) * 32, 4u); } else for (int p = 0; p < 64; ++p) poll_ge(pc + p * 32, 4u);
                        __builtin_amdgcn_fence(__ATOMIC_ACQUIRE, "agent"); asm volatile("s_waitcnt vmcnt(0)" ::: "memory"); }
                    __syncthreads();
                    if (na > 0) { HgIn R = hg_load<false>(F, unit_of(0));
                        for (int k = 0; k < na; ++k) { const HgIn Rn = hg_load<false>(F, unit_of(k + 1 < na ? k + 1 : na - 1)); hg_a2_unit(F, a, l, unit_of(k), R); R = Rn; } }
                    __syncthreads();
                    if (F.tid == 0) { if (g256) { const int tb = 4 * vx + (vr >> 3); poll_ge(pc + 2048 + (2 * tb) * 32, 2u); poll_ge(pc + 2048 + (2 * tb + 1) * 32, 2u); } else for (int p = 0; p < 64; ++p) poll_ge(pc + 2048 + p * 32, 2u);
                        __builtin_amdgcn_fence(__ATOMIC_ACQUIRE, "agent"); asm volatile("s_waitcnt vmcnt(0)" ::: "memory"); }
                    __syncthreads();
                    if (g256) vf_unit(F, (4 * vx + (vr >> 3)) * 8 + (vr & 7)); else for (int u = F.vcu; u < (MT / 512) * ATH; u += F.G) vf_unit(F, u);
                }
            } else if (q == 2 && PHSEL(5)) {
                hg_scan(F);
                if (l == 0) {
                    { size_t z2 = 0; asm volatile("" : "+s"(z2)); ws = F.ws + z2; F.ws = ws; int t2 = F.tid; asm volatile("" : "+v"(t2)); F.tid = t2; F.lane = t2 & 63; }
                    SchedFold SF{F.G, bx, (const char*)(ws + WS_KV), (const char*)(ws + WS_KV) + (size_t)DEPTH * MEMROWS * DM * 2, (const char*)(ws + WS_WQS), (const char*)(ws + WS_WOT)};
                    EpiBf16 EF{(bf16_t*)(ws + WS_WQK), DM, (size_t)DM * DM, 1.f};
                    pg8::gemm_phase<EpiBf16, SchedFold, true, true, DM, 256>(F.lds, F.tid, SF, EF); }
            } else if (q == 3 && PHSEL(6)) {
                hg_lbt_to_lds(F, l);
                for (int rep = 0; rep < PROBE_HGC_N; ++rep) { constexpr int NU = BATCH * HGH * NCHUNK; HgIn R = hg_load<true>(F, F.vcu < NU ? F.vcu : NU - 1);
                    for (int u = F.vcu; u < NU; u += F.G) { const HgIn Rn = hg_load<true>(F, u + F.G < NU ? u + F.G : NU - 1); if (rep + 1 < PROBE_HGC_N) hg_c2_unit<PROBE_HGC_STOP>(F, a, l, u, R); else hg_c2_unit<0>(F, a, l, u, R); R = Rn; } __syncthreads(); }
#if ATT_GOLDEN
                for (int t = F.vcu * NWAVES + F.wave; t < (MT / 64) * ATH; t += F.G * NWAVES) att_task(F, t);
#else
                for (int rep = 0; rep < PROBE_ATT_N; ++rep) for (int u = F.vcu; u < (MT / 512) * ATH; u += F.G) att_unit(F, l, u);
#endif
            } else if (q == 4 && PHSEL(7)) {
                unsigned* ch = (unsigned*)(F.ctl + CW_CHAIN + l * 8192);
                const bool uni = __builtin_amdgcn_readfirstlane((int)F.MISC[10]) != 0; const int cb = uni ? (int)bar.x + 8 * __builtin_amdgcn_readfirstlane((int)F.MISC[11]) : bx;
                { pg8::SchedChain S{{64, 4, 256, F.G, cb, (const char*)YMIX_PTR(l), (const char*)(ws + WS_WOUT) + (size_t)l * DM * DM * 2, (size_t)256 * DM * 2, (size_t)256 * DM * 2, 64, 0}, nullptr, F.tid, uni};
                  EpiResNorm E{IN_F(0), l == 0 ? nullptr : (const bf16_t*)(ws + WS_XB), (bf16_t*)(ws + A_XB2), (float*)(ws + WS_SSQP)};
                  pg8::gemm_phase<EpiResNorm, pg8::SchedChain, true, true, DM, DM>(F.lds, F.tid, S, E); S.signal(ch); }
                { size_t z2 = 0; asm volatile("" : "+s"(z2)); ws = F.ws + z2; F.ws = ws; int t2 = F.tid; asm volatile("" : "+v"(t2)); F.tid = t2; F.lane = t2 & 63; }
                { pg8::SchedChain S{{64, 4, 256, F.G, cb, (const char*)(ws + A_XB2), (const char*)(ws + WS_WQK) + (size_t)l * 2 * DM * DM * 2, (size_t)256 * DM * 2, (size_t)256 * DM * 2, 32, (size_t)DM * DM * 2}, ch, F.tid, uni};
                  EpiSoftmax E{(bf16_t*)(ws + A_P), (const float*)(ws + WS_SSQP)};
                  pg8::gemm_phase<EpiSoftmax, pg8::SchedChain, true, true, DM, DM>(F.lds, F.tid, S, E); S.signal(ch + 2048); }
                { size_t z2 = 0; asm volatile("" : "+s"(z2)); ws = F.ws + z2; F.ws = ws; int t2 = F.tid; asm volatile("" : "+v"(t2)); F.tid = t2; F.lane = t2 & 63; }
                { pg8::SchedChain S{{64, 4, 256, F.G, cb, (const char*)(ws + A_P), (const char*)(ws + WS_WVO) + (size_t)l * 2 * DM * DM * 2, (size_t)256 * DM * 2, (size_t)256 * DM * 2, 32, (size_t)DM * DM * 2}, ch + 2048, F.tid, uni};
                  EpiResAddB E{(const bf16_t*)(ws + A_XB2), (bf16_t*)(ws + WS_XB)};
                  pg8::gemm_phase<EpiResAddB, pg8::SchedChain, true, true, DM, DM>(F.lds, F.tid, S, E); S.signal(ch + 4096); }
                { size_t z2 = 0; asm volatile("" : "+s"(z2)); ws = F.ws + z2; F.ws = ws; int t2 = F.tid; asm volatile("" : "+v"(t2)); F.tid = t2; F.lane = t2 & 63; }
                { int rt0 = -1; if (F.G == 256) { const int wgid = (cb & 7) * 32 + (cb >> 3); rt0 = 4 * ((wgid >> 5) * 8 + (wgid & 7)) + ((wgid & 31) >> 3); }
                  ph_router(F, a, l, ch + 4096, rt0); }
            } else if (q == 10 && PHSEL(13)) {
                moe_prefix(F, l);
                const int total = __builtin_amdgcn_readfirstlane((int)F.MISC[32]) * 4, early = (total / F.G) * F.G;
                SchedMoe S{F.G, bx, DM, F.MISC + 16, (const char*)(ws + WS_XB), (const char*)(ws + A_WGU), (const int*)(ws + A_PERM2), (const unsigned*)(F.ctl + CW_CNT + l * 16 * 64), true, 1, early, total - early, nullptr};
                EpiMoe1 E{(bf16_t*)(ws + A_ACTB), (const float*)(ws + A_SRS2), (const float*)(ws + A_SGW2)};
                pg8::gemm_phase<EpiMoe1, SchedMoe, true, true, DM, DM, true>(F.lds, F.tid, S, E);
            } else if (q == 11 && PHSEL(14)) {
                moe_prefix(F, l);
                const int total = __builtin_amdgcn_readfirstlane((int)F.MISC[32]) * 4, early = (total / F.G) * F.G, rem = total - early;
                unsigned* done = (unsigned*)(F.ctl + CW_DONE + l * 256);
                if (bx < rem) {
                    SchedMoe S{F.G, bx, DM, F.MISC + 16, (const char*)(ws + WS_XB), (const char*)(ws + A_WGU), (const int*)(ws + A_PERM2), (const unsigned*)(F.ctl + CW_CNT + l * 16 * 64), true, 2, early, rem, nullptr};
                    EpiMoe1 E{(bf16_t*)(ws + A_ACTB), (const float*)(ws + A_SRS2), (const float*)(ws + A_SGW2)};
                    pg8::gemm_phase<EpiMoe1, SchedMoe, true, true, DM, DM, true>(F.lds, F.tid, S, E);
                    if (F.tid == 0) { __builtin_amdgcn_fence(__ATOMIC_RELEASE, "agent"); asm volatile("s_waitcnt vmcnt(0)" ::: "memory"); __hip_atomic_fetch_add(done + ((early + bx) >> 2), 1u, __ATOMIC_RELAXED, __HIP_MEMORY_SCOPE_AGENT); }
                }
                { size_t z2 = 0; asm volatile("" : "+s"(z2)); ws = F.ws + z2; F.ws = ws; int t2 = F.tid; asm volatile("" : "+v"(t2)); F.tid = t2; F.lane = t2 & 63; }
                SchedMoe S{F.G, bx, EFF, F.MISC + 16, (const char*)(ws + A_ACTB), (const char*)(ws + A_WD), nullptr, nullptr, false, 3, early, rem, done};
                EpiBf16 E{(bf16_t*)(ws + A_Y), DM, 0, 1.f};
                pg8::gemm_phase<EpiBf16, SchedMoe, true, true, EFF, EFF>(F.lds, F.tid, S, E);
            } else if (q == 12 && PHSEL(15)) ph_combine(F, a, l);
        }
        if (pp + 1 < a.ph_hi) xcd_barrier(bar, F.tid);
    }
}

extern "C" void kernel_launch(void* const* d_in, const int* in_sizes, int n_in, void* d_out, int out_size, void* d_ws, size_t ws_size, hipStream_t stream) {
    static int grid = 0;
    if (grid == 0) {
        if (n_in != 20 || in_sizes[0] != MT * DM || out_size != MT * DM || ws_size < WS_END) { fprintf(stderr, "kernel_launch: unexpected shapes / workspace (%d inputs, ws %zu)\n", n_in, ws_size); grid = -1; return; }
        int dev = 0, cus = 0, per_cu = 0;
        if (hipGetDevice(&dev) != hipSuccess || hipDeviceGetAttribute(&cus, hipDeviceAttributeMultiprocessorCount, dev) != hipSuccess) { grid = -1; return; }
        if (hipFuncSetAttribute((const void*)fwd, hipFuncAttributeMaxDynamicSharedMemorySize, LDS_BYTES) != hipSuccess) { grid = -1; return; }
        if (hipOccupancyMaxActiveBlocksPerMultiprocessor(&per_cu, (const void*)fwd, NTHR, LDS_BYTES) != hipSuccess || per_cu < 1) { fprintf(stderr, "kernel_launch: occupancy query says %d\n", per_cu); per_cu = 1; }
        (void)hipGetLastError();
        grid = cus * 1;
    }
    if (grid < 0) return;
    (void)hipMemsetAsync((char*)d_ws + WS_CTL, 0, CTL_ZERO_BYTES, stream);
    Args a{};
    for (int i = 0; i < 20; ++i) a.in[i] = d_in[i];
    a.out = (float*)d_out; a.ws = (unsigned char*)d_ws;
#if MK_PER_PHASE
    for (int ph = 0; ph < NPHASE; ++ph) { a.ph_lo = ph; a.ph_hi = ph + 1; hipLaunchKernelGGL(fwd, dim3(grid), dim3(NTHR), LDS_BYTES, stream, a); }
#else
    a.ph_lo = 0; a.ph_hi = NPHASE;
    void* kargs[] = {&a};
    hipError_t e = hipLaunchCooperativeKernel((const void*)fwd, dim3(grid), dim3(NTHR), kargs, LDS_BYTES, stream);
    if (e != hipSuccess) fprintf(stderr, "cooperative launch failed: %s (grid %d)\n", hipGetErrorString(e), grid);
#endif
}
```

```cpp
#include <hip/hip_runtime.h>
#include <cstdio>
#include <cstdint>

#ifndef PH_MASK
#define PH_MASK 0xFFFFFFFFu
#endif
#define PHSEL(n) ((PH_MASK >> (n)) & 1u)
#ifndef PROBE_ATT_N
#define PROBE_ATT_N 1
#endif
#ifndef PROBE_HGC_N
#define PROBE_HGC_N 1
#endif
#ifndef PROBE_HGA_N
#define PROBE_HGA_N 1
#endif
#ifndef PROBE_PREP_N
#define PROBE_PREP_N 1
#endif
#ifndef PROBE_HGC_STOP
#define PROBE_HGC_STOP 0
#endif
#ifndef HGA_EARLY
#define HGA_EARLY 6
#endif
#ifndef PROBE_P
#define PROBE_P -1
#endif
#ifndef PROBE_N
#define PROBE_N 1
#endif
#ifndef HG_A_GOLDEN
#define HG_A_GOLDEN 0
#endif
#ifndef HG_C_GOLDEN
#define HG_C_GOLDEN 0
#endif
#ifndef ATT_GOLDEN
#define ATT_GOLDEN 0
#endif
#ifndef MK_PER_PHASE
#define MK_PER_PHASE 0
#endif

#define LAS __attribute__((address_space(3)))
#define GAS __attribute__((address_space(1)))
typedef unsigned short bf16_t;
typedef short bf16x8 __attribute__((ext_vector_type(8)));
typedef float f32x4 __attribute__((ext_vector_type(4)));
typedef float f32x2 __attribute__((ext_vector_type(2)));
typedef unsigned u32x4 __attribute__((ext_vector_type(4)));
typedef int i32x4 __attribute__((ext_vector_type(4)));
typedef int i32x8 __attribute__((ext_vector_type(8)));
typedef unsigned u32x2 __attribute__((ext_vector_type(2)));
typedef GAS unsigned gu32;

constexpr int BATCH = 2, SEQ = 8192, DM = 1024, MT = BATCH * SEQ, DEPTH = 2;
constexpr int MEM_LEN = 256, MEMROWS = BATCH * MEM_LEN;
constexpr int NIN = 3584, HGW = 512, HGH = 4, HGD = 128, CHUNK = 64, NCHUNK = SEQ / CHUNK;
constexpr int ATW = 512, ATH = 8, ATD = 64;
constexpr int NEXP = 16, EFF = 512;
constexpr float EPS = 1e-6f;
constexpr int NWAVES = 8, NTHR = 512;

constexpr size_t MiB = 1u << 20;
constexpr size_t WS_CTL = 0, CTL_ZERO_BYTES = 1 * MiB;
constexpr size_t WS_RSTD = 1 * MiB;
constexpr size_t WS_TOKE = WS_RSTD + 64 * 1024;
constexpr size_t WS_TOKW = WS_TOKE + 128 * 1024;
constexpr size_t WS_TOKL = WS_TOKW + 128 * 1024;
constexpr size_t WS_SLOTRS = WS_TOKL + 128 * 1024;
constexpr size_t WS_SLOTGW = WS_SLOTRS + 160 * 1024;
constexpr size_t WS_PERM = WS_SLOTGW + 160 * 1024;
constexpr size_t WS_WR = 3 * MiB;
constexpr size_t WS_LBT = 3 * MiB + 256 * 1024;
constexpr size_t WS_SSQP = 3 * MiB + 512 * 1024;
constexpr size_t WS_XB = 4 * MiB;
constexpr size_t WS_WIN = 36 * MiB;
constexpr size_t WS_WOUT = 50 * MiB;
constexpr size_t WS_WQS = 54 * MiB;
constexpr size_t WS_WKVT = 58 * MiB;
constexpr size_t WS_WOT = 66 * MiB;
constexpr size_t WS_MEMN = 70 * MiB;
constexpr size_t WS_KV = 72 * MiB;
constexpr size_t WS_WQK = 76 * MiB;
constexpr size_t WS_WVO = 84 * MiB;
constexpr size_t WS_ACT = 92 * MiB;
constexpr size_t WS_CS = 320 * MiB;
constexpr size_t WS_END = 324 * MiB;
constexpr size_t A_HG = WS_ACT + 0 * MiB;
constexpr size_t A_KF1 = WS_ACT + 64 * MiB;
constexpr size_t A_KF4 = WS_ACT + 80 * MiB;
constexpr size_t A_KF16 = WS_ACT + 96 * MiB;
constexpr size_t A_QR = WS_ACT + 112 * MiB;
constexpr size_t A_V = WS_ACT + 128 * MiB;
constexpr size_t A_VT1 = WS_ACT + 144 * MiB;
constexpr size_t A_VT4 = WS_ACT + 160 * MiB;
constexpr size_t A_VT16 = WS_ACT + 176 * MiB;
constexpr size_t A_STATE = WS_ACT + 192 * MiB;
constexpr size_t A_DECAY = WS_ACT + 224 * MiB;
constexpr size_t A_XB2 = WS_ACT + 0 * MiB;
constexpr size_t A_P = WS_ACT + 32 * MiB;
constexpr size_t A_WGU = WS_ACT + 64 * MiB;
constexpr size_t A_WD = WS_ACT + 96 * MiB;
constexpr size_t A_PERM2 = WS_ACT + 112 * MiB;
constexpr size_t A_SRS2 = WS_ACT + 113 * MiB;
constexpr size_t A_SGW2 = WS_ACT + 114 * MiB;
constexpr int WGU_SH = 6, WD_SH = 5, ACT_SH = 4, P_SH = 7, WVO_SH = 1, WQK_SH = 5, Y_SH = 4;
constexpr size_t A_XB8 = WS_ACT + 128 * MiB;
constexpr size_t A_XB28 = WS_ACT + 48 * MiB;
constexpr size_t A_ACT8 = WS_ACT + 0 * MiB;
constexpr size_t A_ACTB = WS_ACT + 120 * MiB;
constexpr size_t A_Y = WS_ACT + 156 * MiB;
constexpr int MAXSLOT = 2 * MT + NEXP * 256;
static_assert(A_Y + (size_t)MAXSLOT * 1024 * 2 <= WS_END, "ws map");
constexpr int CW_BAR = 4096;
constexpr int CW_KMAX = 12288;
constexpr int CW_DONE = 24576;
constexpr int CW_CHAIN = 32768;
constexpr int CW_PROJ = 49152;
constexpr int CW_SCAN = 57344;
constexpr int CW_COMB = 61440;
constexpr int CW_CNT = 16384;
constexpr int RING_BYTES = 131072;
constexpr int SPARE_OFF = RING_BYTES;
constexpr int LDSCTL_OFF = RING_BYTES + 8192, MISC_OFF = LDSCTL_OFF + 64;
constexpr int LDS_BYTES = 147456;

#define RLX_AGENT __ATOMIC_RELAXED, __HIP_MEMORY_SCOPE_AGENT
#define LDS_WAIT() asm volatile("s_waitcnt lgkmcnt(0)" ::: "memory")
#define VM_WAIT() asm volatile("s_waitcnt vmcnt(0)" ::: "memory")

__device__ __forceinline__ unsigned f2bf(float f) { unsigned u = __builtin_bit_cast(unsigned, f); return (u + 0x7fffu + ((u >> 16) & 1u)) >> 16; }
__device__ __forceinline__ unsigned pk2(float lo, float hi) { return f2bf(lo) | (f2bf(hi) << 16); }
__device__ __forceinline__ float bf2f(unsigned short h) { return __builtin_bit_cast(float, (unsigned)h << 16); }
__device__ __forceinline__ float bflo(unsigned w) { return __builtin_bit_cast(float, w << 16); }
__device__ __forceinline__ float bfhi(unsigned w) { return __builtin_bit_cast(float, w & 0xffff0000u); }
typedef __bf16 bf16x2_t __attribute__((ext_vector_type(2)));
__device__ __forceinline__ unsigned cvt_pk_bf16(float lo, float hi) { f32x2 v = {lo, hi}; bf16x2_t b = __builtin_convertvector(v, bf16x2_t); return __builtin_bit_cast(unsigned, b); }
__device__ __forceinline__ int retid(int wave) { int t; asm volatile("v_mbcnt_lo_u32_b32 %0, -1, 0\n\tv_mbcnt_hi_u32_b32 %0, -1, %0" : "=v"(t)); return t + wave * 64; }
__device__ __forceinline__ f32x4 zero4() { float z; asm volatile("v_mov_b32 %0, 0" : "=v"(z)); return (f32x4){z, z, z, z}; }
typedef float f32x2_ __attribute__((ext_vector_type(2)));
__device__ __forceinline__ unsigned pk4_fp8(float a, float b, float c, float d) {
    float hi = 448.f; asm volatile("" : "+v"(hi));
    a = __builtin_amdgcn_fmed3f(a, -hi, hi); b = __builtin_amdgcn_fmed3f(b, -hi, hi); c = __builtin_amdgcn_fmed3f(c, -hi, hi); d = __builtin_amdgcn_fmed3f(d, -hi, hi);
    int w = __builtin_bit_cast(int, a); w = __builtin_amdgcn_cvt_pk_fp8_f32(a, b, w, false); w = __builtin_amdgcn_cvt_pk_fp8_f32(c, d, w, true); return (unsigned)w; }
template <int M> __device__ __forceinline__ float shx(float v) {
    const int x = __builtin_bit_cast(int, v); int r;
    if constexpr (M == 1) r = __builtin_amdgcn_update_dpp(x, x, 0xB1, 0xF, 0xF, false);
    else if constexpr (M == 2) r = __builtin_amdgcn_update_dpp(x, x, 0x4E, 0xF, 0xF, false);
    else if constexpr (M < 32) r = __builtin_amdgcn_ds_swizzle(x, 0x1F | (M << 10));
    else { int s; asm volatile("v_mbcnt_lo_u32_b32 %0, -1, 0\n\tv_mbcnt_hi_u32_b32 %0, -1, %0" : "=v"(s)); r = __builtin_amdgcn_ds_bpermute((s ^ 32) << 2, x); }
    return __builtin_bit_cast(float, r);
}
#define __shfl_xor(v, m) shx<(m)>(v)
__device__ __forceinline__ float wave_sum(float v) {
    v += shx<1>(v); v += shx<2>(v); v += shx<4>(v); v += shx<8>(v); v += shx<16>(v); v += shx<32>(v);
    return v;
}
__device__ __forceinline__ float sigmoidf_(float z) { return __builtin_amdgcn_rcpf(1.f + __builtin_amdgcn_exp2f(-1.4426950408889634f * z)); }
__device__ __forceinline__ float ex2(float x) { return __builtin_amdgcn_exp2f(x); }
constexpr float LOG2E = 1.4426950408889634f;

#define XB_TMO      128
#define XB_XCNT(j)  (256  + 64 * (j))
#define XB_XSUB(j)  (1280 + 64 * (j))
#define XB_XGEN(j)  (2304 + 64 * (j))
#define XB_TOP      3328
#define XB_TOPGEN   3392
#define XCD_BAR_WORDS 3456
#define XB_SPIN_CAP (1u << 18)
__device__ __forceinline__ unsigned xb_ld(unsigned* p)              { return __hip_atomic_load(p, __ATOMIC_RELAXED, __HIP_MEMORY_SCOPE_AGENT); }
__device__ __forceinline__ unsigned xb_add(unsigned* p, unsigned v) { return __hip_atomic_fetch_add(p, v, __ATOMIC_RELAXED, __HIP_MEMORY_SCOPE_AGENT); }
__device__ __forceinline__ unsigned xb_xcc_id() { return (unsigned)__builtin_amdgcn_s_getreg((3 << 11) | 20) & 0xFu; }
__device__ __forceinline__ void poll_ge(const unsigned* p, unsigned need) { unsigned sp = 0; while (__hip_atomic_load(p, __ATOMIC_RELAXED, __HIP_MEMORY_SCOPE_AGENT) < need) { __builtin_amdgcn_s_sleep(4); if (++sp > (1u << 20)) break; } }
#define XB_SPIN(cond, bar) do { unsigned _sp = 0; while (cond) { __builtin_amdgcn_s_sleep(1); \
    if ((++_sp & 255u) == 0u) { if (xb_ld(&(bar)[XB_TMO])) break; if (_sp > XB_SPIN_CAP) { atomicAdd(&(bar)[XB_TMO], 1u); break; } } } } while (0)
struct XcdBarrier { unsigned* bar; unsigned x; volatile LAS unsigned* st; };
__device__ __forceinline__ XcdBarrier xcd_barrier_post(unsigned* bar, volatile LAS unsigned* st) {
    XcdBarrier b; b.bar = bar; b.x = xb_xcc_id(); b.st = st;
    if (threadIdx.x == 0) st[3] = xb_add(&bar[XB_XCNT(b.x)], 1u);
    return b;
}
__device__ __forceinline__ void xcd_barrier_complete(unsigned* bar, unsigned x, unsigned& nloc, unsigned& nx, unsigned& uni) {
    const unsigned G = gridDim.x * gridDim.y * gridDim.z;
    unsigned sum, cnt, mine, sp = 0u;
    for (;;) {
        sum = 0u; cnt = 0u; mine = 0u;
        unsigned cv[16];
#pragma unroll
        for (unsigned j = 0; j < 16; ++j) cv[j] = xb_ld(&bar[XB_XCNT(j)]);
#pragma unroll
        for (unsigned j = 0; j < 16; ++j) { const unsigned c = cv[j]; sum += c; cnt += (c > 0u) ? 1u : 0u; mine = (j == x) ? c : mine; }
        if (sum == G) break;
        __builtin_amdgcn_s_sleep(1);
        if ((++sp & 255u) == 0u) { if (xb_ld(&bar[XB_TMO])) break; if (sp > XB_SPIN_CAP) { atomicAdd(&bar[XB_TMO], 1u); break; } }
    }
    nloc = mine > 0u ? mine : 1u; nx = cnt > 0u ? cnt : 1u;
    unsigned u8 = (sum == 256u && G == 256u) ? 1u : 0u;
#pragma unroll
    for (unsigned j = 0; j < 8; ++j) u8 &= (xb_ld(&bar[XB_XCNT(j)]) == 32u) ? 1u : 0u;
    uni = u8;
}
__device__ __forceinline__ void xcd_barrier(const XcdBarrier& b, int tid) {
    asm volatile("s_waitcnt vmcnt(0)" ::: "memory");
    __syncthreads();
    if (tid == 0) {
        unsigned* bar = b.bar; asm volatile("" : "+s"(bar));
        __builtin_amdgcn_s_waitcnt(0);
        unsigned nloc = b.st[0], nx = b.st[1];
        if (nloc == 0u) { unsigned uni; xcd_barrier_complete(bar, b.x, nloc, nx, uni); b.st[0] = nloc; b.st[1] = nx; b.st[2] = uni; }
        const unsigned old = xb_add(&bar[XB_XSUB(b.x)], 1u);
        const unsigned gen = old / nloc;
        if (old + 1u == (gen + 1u) * nloc) {
            __builtin_amdgcn_fence(__ATOMIC_RELEASE, "agent");
            asm volatile("s_waitcnt vmcnt(0)" ::: "memory");
            const unsigned og = xb_add(&bar[XB_TOP], 1u);
            const unsigned tg = og / nx;
            if (og + 1u == (tg + 1u) * nx) xb_add(&bar[XB_TOPGEN], 1u);
            else XB_SPIN(xb_ld(&bar[XB_TOPGEN]) == tg, bar);
            __builtin_amdgcn_fence(__ATOMIC_ACQUIRE, "agent");
            xb_add(&bar[XB_XGEN(b.x)], 1u);
            asm volatile("s_waitcnt vmcnt(0)" ::: "memory");
        } else {
            XB_SPIN(xb_ld(&bar[XB_XGEN(b.x)]) == gen, bar);
            __builtin_amdgcn_fence(__ATOMIC_ACQUIRE, "agent");
            asm volatile("s_waitcnt vmcnt(0)" ::: "memory");
        }
    }
    __syncthreads();
}

namespace pg8 {
constexpr int BM = 256, BK = 64, HALF = 128, HTB = HALF * BK * 2, STAGE_BYTES = 8 * HTB, NXCD = 8, WGM = 8;
__host__ __device__ __forceinline__ int lds_byte(int r, int c) { const int st = (r >> 4) * 2 + (c >> 5), rr = r & 15, cc = c & 31, ob = rr * 64 + cc * 2; return st * 1024 + (ob ^ (((ob >> 9) & 1) << 5)); }
__host__ __device__ __forceinline__ void stage_rc(int b, int& R, int& C) { const int st = b / 1024, sb = b % 1024, swz = sb ^ (((sb >> 9) & 1) << 5); R = (st >> 1) * 16 + swz / 64; C = (st & 1) * 32 + (swz % 64) / 2; }
__host__ __device__ __forceinline__ int perm32(int rho) { const int n = rho >> 4, i = rho & 15; return 8 * (i >> 2) + 4 * n + (i & 3); }

struct Unit { int pm, pn, aux, lr; const char* a; const char* b; };
typedef f32x4 Acc[2][2][4][2];

__device__ __forceinline__ const char* uni_ptr(const char* p) { const unsigned long long v = (unsigned long long)p; const unsigned lo = (unsigned)__builtin_amdgcn_readfirstlane((int)(unsigned)v), hi = (unsigned)__builtin_amdgcn_readfirstlane((int)(unsigned)(v >> 32)); return (const char*)(((unsigned long long)hi << 32) | lo); }
template <class S> __device__ __forceinline__ auto pre_a_call(const S& s, const Unit& u, int) -> decltype(s.pre_a(u), void()) { s.pre_a(u); }
template <class S> __device__ __forceinline__ void pre_a_call(const S&, const Unit&, long) {}
template <class S> __device__ __forceinline__ auto unit_done_call(const S& s, const Unit& u, int) -> decltype(s.unit_done(u), void()) { s.unit_done(u); }
template <class S> __device__ __forceinline__ void unit_done_call(const S&, const Unit&, long) {}
template <class S> constexpr auto has_unit_done(int) -> decltype(&S::unit_done, true) { return true; }
template <class S> constexpr bool has_unit_done(long) { return false; }
template <class S> constexpr auto has_wait_next(int) -> decltype(&S::wait_next, true) { return true; }
template <class S> constexpr bool has_wait_next(long) { return false; }
template <class E> constexpr auto perm16_of(int) -> decltype(E::PERM16) { return E::PERM16; }
template <class E> constexpr bool perm16_of(long) { return false; }
template <class Epi, class Sched, bool ALIGN_EPI, bool SP2, int LD, int K, bool GATHER = false, int F8S = -1>
__device__ __forceinline__ void gemm_phase(LAS unsigned char* lds, const int tid, const Sched& S, const Epi& E) {
    constexpr int lda = LD, ldb = LD;
    const int wid = __builtin_amdgcn_readfirstlane(tid >> 6), lane = tid & 63, wr = wid >> 2, wc = wid & 3, fr = lane & 15, fq = lane >> 4;
    constexpr int nt = K / BK;
    unsigned voffA[2], voffB[2];
    constexpr bool P16 = perm16_of<Epi>(0);
#pragma unroll
    for (int i = 0; i < 2; ++i) { int R, C; stage_rc(tid * 16 + i * 8192, R, C); const int c5 = perm32(R & 31); const int Rb = P16 ? ((R >> 5) * 64 + (c5 >> 3) * 16 + (c5 & 7)) : (Epi::PERM ? ((R & ~31) + c5) : R);
        voffA[i] = (unsigned)(R * lda + C) * 2u; voffB[i] = (unsigned)(Rb * ldb + C) * 2u; }
    const size_t kstep = (size_t)(BK * 2);
    const size_t hstepA = (size_t)HALF * lda * 2, hstepB = (size_t)(P16 ? 8 : HALF) * ldb * 2;
    const unsigned ldsw = (unsigned)wid * 1024u;
    int aoff = lds_byte(wr * 64 + fr, fq * 8), boff = lds_byte(wc * 32 + fr, fq * 8);
#define PG8_SA(b, h) (((b) * 2 + (h)) * HTB)
#define PG8_SB(b, h) ((4 + (b) * 2 + (h)) * HTB)
#define PG8_STAGE(bufoff, gbase, voff) do { _Pragma("unroll") for (int _i = 0; _i < 2; ++_i) \
        __builtin_amdgcn_raw_ptr_buffer_load_lds(__builtin_amdgcn_make_buffer_rsrc((void*)(gbase), 0, 0x7ffffff0, 0x00020000), (LAS void*)(lds + (bufoff) + ldsw + _i * 8192), 16, (int)(voff)[_i], 0, 0, 0); } while (0)
#define PG8_STAGE_A(bufoff, gbase, half, usenext) do { if constexpr (GATHER) { const unsigned _p = (usenext) ? vn[half] : vc[half]; unsigned _v[2]; _v[0] = (_p & 0xffffu) * (unsigned)(lda * 2) + gc2; _v[1] = (_p >> 16) * (unsigned)(lda * 2) + gc2; PG8_STAGE(bufoff, gbase, _v); } \
        else { PG8_STAGE(bufoff, (gbase) + (half) * hstepA, voffA); } } while (0)
#define PG8_LDA(dst, b, h) do { _Pragma("unroll") for (int m = 0; m < 4; ++m) { if constexpr (F8S >= 0) { const i32x4 lo_ = *(const LAS i32x4*)(lds + PG8_SA(b, h) + aoff + m * 2048), hi_ = *(const LAS i32x4*)(lds + PG8_SA(b, h) + aoff + m * 2048 + 1024); dst##8[m] = __builtin_shufflevector(lo_, hi_, 0, 1, 2, 3, 4, 5, 6, 7); } \
        else { _Pragma("unroll") for (int k = 0; k < 2; ++k) dst[m][k] = *(const LAS bf16x8*)(lds + PG8_SA(b, h) + aoff + m * 2048 + k * 1024); } } } while (0)
#define PG8_LDB(dst, b, h) do { _Pragma("unroll") for (int n = 0; n < 2; ++n) { if constexpr (F8S >= 0) { const i32x4 lo_ = *(const LAS i32x4*)(lds + PG8_SB(b, h) + boff + n * 2048), hi_ = *(const LAS i32x4*)(lds + PG8_SB(b, h) + boff + n * 2048 + 1024); dst##8[n] = __builtin_shufflevector(lo_, hi_, 0, 1, 2, 3, 4, 5, 6, 7); } \
        else { _Pragma("unroll") for (int k = 0; k < 2; ++k) dst[n][k] = *(const LAS bf16x8*)(lds + PG8_SB(b, h) + boff + n * 2048 + k * 1024); } } } while (0)
#define PG8_MMA(ai, bj, At, Bt) do { __builtin_amdgcn_s_setprio(1); _Pragma("unroll") for (int m = 0; m < 4; ++m) _Pragma("unroll") for (int n = 0; n < 2; ++n) { \
        if constexpr (F8S >= 0) { \
            acc[ai][bj][m][n] = __builtin_amdgcn_mfma_scale_f32_16x16x128_f8f6f4(Bt##8[n], At##8[m], acc[ai][bj][m][n], 0, 0, 0, 0, 0, 0); } \
        else { _Pragma("unroll") for (int k = 0; k < 2; ++k) acc[ai][bj][m][n] = __builtin_amdgcn_mfma_f32_16x16x32_bf16(Bt[n][k], At[m][k], acc[ai][bj][m][n], 0, 0, 0); } } __builtin_amdgcn_s_setprio(0); } while (0)
#define PG8_WAIT_V(n) asm volatile("s_waitcnt vmcnt(" #n ")" ::: "memory")
#define PG8_WAIT_L(n) asm volatile("s_waitcnt lgkmcnt(" #n ")" ::: "memory")
#define PG8_BAR __builtin_amdgcn_s_barrier()
#define PG8_SCHED __builtin_amdgcn_sched_barrier(0)
    Unit cur, nxt; int ui = 0;
    if (!S.next(0, cur)) return;
    Acc acc;
#pragma unroll
    for (int a = 0; a < 2; ++a)
#pragma unroll
        for (int b = 0; b < 2; ++b)
#pragma unroll
            for (int m = 0; m < 4; ++m)
#pragma unroll
                for (int n = 0; n < 2; ++n) acc[a][b][m][n] = zero4();
    bf16x8 At[4][2], B0[2][2], B1[2][2]; i32x8 At8[4], B08[2], B18[2];
    const char* cA = uni_ptr(cur.a); const char* cB = uni_ptr(cur.b);
    unsigned vc[2], vn[2], gc2 = 0;
    if constexpr (GATHER) { int R0, C0; stage_rc(tid * 16, R0, C0); gc2 = (unsigned)C0 * 2u;
#pragma unroll
        for (int h = 0; h < 2; ++h) { vc[h] = (unsigned)S.src_row(cur, 128 * h + R0) | ((unsigned)S.src_row(cur, 128 * h + R0 + 64) << 16); vn[h] = vc[h]; }
    }
    static_assert(SP2, "only the two-MFMA-blocks-per-barrier-pair loop is kept");
    {
        PG8_STAGE(PG8_SB(0, 0), cB, voffB); PG8_STAGE(PG8_SB(0, 1), cB + hstepB, voffB); pre_a_call(S, cur, 0);
        PG8_STAGE_A(PG8_SA(0, 0), cA, 0, false); PG8_STAGE_A(PG8_SA(0, 1), cA, 1, false);
        if (wr == 1) PG8_BAR;
        PG8_WAIT_V(2); PG8_BAR;
        PG8_STAGE(PG8_SB(1, 0), cB + kstep, voffB); PG8_STAGE_A(PG8_SA(1, 0), cA + kstep, 0, false); PG8_STAGE(PG8_SB(1, 1), cB + hstepB + kstep, voffB);
        PG8_WAIT_V(6); PG8_BAR;
    }
    for (;;) {
        { const int l2_ = retid(0); aoff = lds_byte(wr * 64 + (l2_ & 15), (l2_ >> 4) * 8); boff = lds_byte(wc * 32 + (l2_ & 15), (l2_ >> 4) * 8); }
        const bool has_next = S.next(ui + 1, nxt);
        const char* nA = uni_ptr(has_next ? nxt.a : cA); const char* nB = uni_ptr(has_next ? nxt.b : cB);
        if constexpr (GATHER) { if (has_next) { int R0, C0; { const int t_ = retid(wid); stage_rc(t_ * 16, R0, C0); }
#pragma unroll
            for (int h = 0; h < 2; ++h) vn[h] = (unsigned)S.src_row(nxt, 128 * h + R0) | ((unsigned)S.src_row(nxt, 128 * h + R0 + 64) << 16); } }
#pragma nounroll
        for (int t = 0; t < nt; t += 2) {
            const bool last = (t == nt - 2);
            const char* a1 = cA + (size_t)(t + 1) * kstep;
            const char* a2 = last ? nA : cA + (size_t)(t + 2) * kstep; const char* b2 = last ? nB : cB + (size_t)(t + 2) * kstep;
            const char* a3 = a2 + kstep; const char* b3 = b2 + kstep;
            {
            if constexpr (has_wait_next<Sched>(0)) { if (last && has_next) S.wait_next(nxt); }
            PG8_LDB(B0, 0, 0); PG8_LDB(B1, 0, 1); PG8_SCHED; PG8_LDA(At, 0, 0); PG8_STAGE_A(PG8_SA(1, 1), a1, 1, false);
            PG8_WAIT_V(8); PG8_WAIT_L(0); PG8_BAR; PG8_MMA(0, 0, At, B0); PG8_MMA(0, 1, At, B1); PG8_BAR; PG8_SCHED;
            PG8_LDA(At, 0, 1); PG8_STAGE(PG8_SB(0, 0), b2, voffB); PG8_STAGE(PG8_SB(0, 1), b2 + hstepB, voffB); PG8_STAGE_A(PG8_SA(0, 0), a2, 0, last);
            PG8_WAIT_V(8); PG8_WAIT_L(0); PG8_BAR; PG8_MMA(1, 0, At, B0); PG8_MMA(1, 1, At, B1); PG8_BAR; PG8_SCHED;
            PG8_LDB(B0, 1, 0); PG8_LDB(B1, 1, 1); PG8_SCHED; PG8_LDA(At, 1, 0); PG8_STAGE_A(PG8_SA(0, 1), a2, 1, last);
            PG8_WAIT_V(8); PG8_WAIT_L(0); PG8_BAR; PG8_MMA(0, 0, At, B0); PG8_MMA(0, 1, At, B1); PG8_BAR; PG8_SCHED;
            PG8_LDA(At, 1, 1); PG8_STAGE(PG8_SB(1, 0), b3, voffB); PG8_STAGE(PG8_SB(1, 1), b3 + hstepB, voffB); PG8_STAGE_A(PG8_SA(1, 0), a3, 0, last);
            PG8_WAIT_V(8); PG8_WAIT_L(0); PG8_BAR; PG8_MMA(1, 0, At, B0); PG8_MMA(1, 1, At, B1); PG8_BAR; PG8_SCHED;
            }
        }
        if constexpr (ALIGN_EPI) { if (wr == 0) PG8_BAR; }
        { int ln_; asm volatile("v_mbcnt_lo_u32_b32 %0, -1, 0\n\tv_mbcnt_hi_u32_b32 %0, -1, %0" : "=v"(ln_)); int fr_e = ln_ & 15, fq_e = ln_ >> 4; E(acc, cur, wr, wc, fr_e, fq_e, lds); }
        if (!has_next) break;
        if constexpr (has_unit_done<Sched>(0)) { if (S.wants(cur)) { PG8_WAIT_V(0); PG8_BAR; S.unit_done(cur); } }
#pragma unroll
        for (int a = 0; a < 2; ++a)
#pragma unroll
            for (int b = 0; b < 2; ++b)
#pragma unroll
                for (int m = 0; m < 4; ++m)
#pragma unroll
                    for (int n = 0; n < 2; ++n) acc[a][b][m][n] = zero4();
        cur = nxt; cA = nA; cB = nB; ++ui;
        if constexpr (GATHER) { vc[0] = vn[0]; vc[1] = vn[1]; }
        if constexpr (ALIGN_EPI) { if (wr == 1) PG8_BAR; }
    }
    PG8_WAIT_V(0);
    if constexpr (!ALIGN_EPI) { if (wr == 0) PG8_BAR; }
    PG8_BAR;
    unit_done_call(S, cur, 0);
#undef PG8_SA
#undef PG8_SB
#undef PG8_STAGE
#undef PG8_STAGE_A
#undef PG8_LDA
#undef PG8_LDB
#undef PG8_MMA
#undef PG8_WAIT_V
#undef PG8_WAIT_L
#undef PG8_BAR
#undef PG8_SCHED
}

struct SchedDense {
    int nM, nN, nwg, G, c; const char* A; const char* B; size_t a_tile, b_tile; int pm_per_batch; size_t b_batch;
    __device__ __forceinline__ bool next(int i, Unit& u) const {
        const long L = (long)i * G + c; if (L >= nwg) return false;
        int wgid = (int)L; { const int q = nwg / NXCD, r = nwg % NXCD, xcd = wgid % NXCD, off = wgid / NXCD; wgid = (xcd < r ? xcd * (q + 1) : r * (q + 1) + (xcd - r) * q) + off; }
        const int nig = WGM * nN, gid = wgid / nig, fm = gid * WGM, gsz = (nM - fm) < WGM ? (nM - fm) : WGM;
        u.pm = fm + ((wgid % nig) % gsz); u.pn = (wgid % nig) / gsz; u.aux = 0;
        u.a = A + (size_t)u.pm * a_tile; u.b = B + (size_t)u.pn * b_tile + (size_t)(u.pm / pm_per_batch) * b_batch; return true;
    }
};
struct SchedChain {
    SchedDense D; const unsigned* wait; int tid; bool same_xcd;
    __device__ __forceinline__ void dep(const Unit& u) const { if (wait) {
            if (tid == 0) { unsigned spins = 0; while (__hip_atomic_load(wait + u.pm * 32, __ATOMIC_RELAXED, __HIP_MEMORY_SCOPE_AGENT) < 4u) { __builtin_amdgcn_s_sleep(4); if (++spins > (1u << 20)) break; }
                __builtin_amdgcn_fence(__ATOMIC_ACQUIRE, "agent"); asm volatile("s_waitcnt vmcnt(0)" ::: "memory"); }
            __builtin_amdgcn_s_barrier(); asm volatile("" ::: "memory"); } }
    __device__ __forceinline__ bool next(int i, Unit& u) const { if (!D.next(i, u)) return false; if (i > 0) dep(u); return true; }
    __device__ __forceinline__ void pre_a(const Unit& u) const { dep(u); }
    __device__ __forceinline__ void signal(unsigned* sig, int tid_now) const { if (tid_now == 0) {
 if (!same_xcd) { __builtin_amdgcn_fence(__ATOMIC_RELEASE, "agent"); asm volatile("s_waitcnt vmcnt(0)" ::: "memory"); }
            Unit u; for (int i = 0; D.next(i, u); ++i) __hip_atomic_fetch_add(sig + u.pm * 32, 1u, __ATOMIC_RELAXED, __HIP_MEMORY_SCOPE_AGENT); } }
};
struct SchedProj {
    SchedDense D; unsigned* cntA; unsigned* cntV; int tid; bool same_xcd; const unsigned* wait; bool swz;
    __device__ __forceinline__ bool next(int i, Unit& u) const { return D.next((swz && i < 3) ? (i + 2) % 3 : i, u); }
    __device__ __forceinline__ void pre_a(const Unit& u) const { if (wait) { if (tid == 0) { if (D.G == 256) poll_ge(wait + u.pm * 32, 4u); else poll_ge(wait + 2048, (unsigned)D.G);
                __builtin_amdgcn_fence(__ATOMIC_ACQUIRE, "agent"); asm volatile("s_waitcnt vmcnt(0)" ::: "memory"); }
            __builtin_amdgcn_s_barrier(); asm volatile("" ::: "memory"); } }
    __device__ __forceinline__ bool wants(const Unit& u) const { return (u.pn >= 2 && u.pn < 6) || u.pn >= 12; }
    __device__ __forceinline__ void unit_done(const Unit& u) const { if (tid == 0) { unsigned* c = (u.pn >= 2 && u.pn < 6) ? cntA : (u.pn >= 12 ? cntV : nullptr);
            if (c) { if (!same_xcd) { __builtin_amdgcn_fence(__ATOMIC_RELEASE, "agent"); asm volatile("s_waitcnt vmcnt(0)" ::: "memory"); } __hip_atomic_fetch_add(c + u.pm * 32, 1u, __ATOMIC_RELAXED, __HIP_MEMORY_SCOPE_AGENT); } } }
};
}
using pg8::Unit; using pg8::Acc;

struct EpiBf16 {
    static constexpr bool PERM = true;
    bf16_t* O; int ldc; size_t aux_stride; float scale;
    __device__ __forceinline__ void operator()(const Acc& acc, const Unit& u, int wr, int wc, int fr, int fq, LAS unsigned char*) const {
        bf16_t* base = O + (size_t)u.aux * aux_stride;
        const int row0 = u.pm * 256 + wr * 64 + fr, col0 = u.pn * 256 + wc * 32 + 8 * fq;
#pragma unroll
        for (int ai = 0; ai < 2; ++ai)
#pragma unroll
            for (int m = 0; m < 4; ++m) { bf16_t* rowp = base + (size_t)(row0 + ai * 128 + m * 16) * ldc + col0;
#pragma unroll
                for (int bj = 0; bj < 2; ++bj) { const f32x4 v0 = acc[ai][bj][m][0] * scale, v1 = acc[ai][bj][m][1] * scale;
                    u32x4 w; w.x = cvt_pk_bf16(v0[0], v0[1]); w.y = cvt_pk_bf16(v0[2], v0[3]); w.z = cvt_pk_bf16(v1[0], v1[1]); w.w = cvt_pk_bf16(v1[2], v1[3]);
                    *(u32x4*)(rowp + bj * 128) = w; } }
    }
};
struct EpiY8 {
    static constexpr bool PERM = true, PERM16 = true;
    unsigned char* O8; int ldc; float scale;
    __device__ __forceinline__ void operator()(const Acc& acc, const Unit& u, int wr, int wc, int fr, int fq, LAS unsigned char*) const {
        unsigned char* base = O8;
        const int row0 = u.pm * 256 + wr * 64 + fr, col0 = u.pn * 256 + wc * 64 + 16 * fq;
#pragma unroll
        for (int ai = 0; ai < 2; ++ai)
#pragma unroll
            for (int m = 0; m < 4; ++m) { unsigned char* rowp = base + (unsigned)((row0 + ai * 128 + m * 16) * ldc + col0);
                const f32x4 v0 = acc[ai][0][m][0] * scale, v1 = acc[ai][0][m][1] * scale, v2 = acc[ai][1][m][0] * scale, v3 = acc[ai][1][m][1] * scale;
                u32x4 w; w.x = pk4_fp8(v0[0], v0[1], v0[2], v0[3]); w.y = pk4_fp8(v1[0], v1[1], v1[2], v1[3]); w.z = pk4_fp8(v2[0], v2[1], v2[2], v2[3]); w.w = pk4_fp8(v3[0], v3[1], v3[2], v3[3]);
                *(u32x4*)rowp = w; }
    }
};
struct EpiFold {
    static constexpr bool PERM = true;
    bf16_t* O; int ldc; size_t aux_stride; float scale;
    __device__ __forceinline__ void operator()(const Acc& acc, const Unit& u, int wr, int wc, int fr, int fq, LAS unsigned char*) const {
        bf16_t* base = O + (size_t)u.aux * aux_stride;
        const int row0 = u.pm * 256 + wr * 64 + fr, col0 = u.pn * 256 + wc * 32 + 8 * fq;
#pragma unroll
        for (int ai = 0; ai < 2; ++ai)
#pragma unroll
            for (int m = 0; m < 4; ++m) { bf16_t* rowp = base + (size_t)(row0 + ai * 128 + m * 16) * ldc + col0;
#pragma unroll
                for (int bj = 0; bj < 2; ++bj) { const f32x4 v0 = acc[ai][bj][m][0] * scale, v1 = acc[ai][bj][m][1] * scale;
                    { const float s8 = u.aux >= 4 ? (float)(1 << WVO_SH) : (float)(1 << WQK_SH); u32x2 w8; w8.x = pk4_fp8(v0[0] * s8, v0[1] * s8, v0[2] * s8, v0[3] * s8); w8.y = pk4_fp8(v1[0] * s8, v1[1] * s8, v1[2] * s8, v1[3] * s8);
                        *(u32x2*)((unsigned char*)O + (u.aux >= 4 ? 8 * aux_stride + (size_t)(u.aux - 4) * aux_stride : (size_t)u.aux * aux_stride) + (size_t)(row0 + ai * 128 + m * 16) * ldc + col0 + bj * 128) = w8; } } }
    }
};
struct EpiKV {
    static constexpr bool PERM = true;
    bf16_t* KB; bf16_t* VB;
    __device__ __forceinline__ void operator()(const Acc& acc, const Unit& u, int wr, int wc, int fr, int fq, LAS unsigned char*) const {
        bf16_t* base = (u.pn < 4 ? KB : VB) + (size_t)u.aux * MEMROWS * DM;
        const int row0 = u.pm * 256 + wr * 64 + fr, col0 = (u.pn & 3) * 256 + wc * 32 + 8 * fq;
#pragma unroll
        for (int ai = 0; ai < 2; ++ai)
#pragma unroll
            for (int m = 0; m < 4; ++m) { bf16_t* rowp = base + (size_t)(row0 + ai * 128 + m * 16) * DM + col0;
#pragma unroll
                for (int bj = 0; bj < 2; ++bj) { const f32x4 v0 = acc[ai][bj][m][0], v1 = acc[ai][bj][m][1];
                    u32x4 w; w.x = cvt_pk_bf16(v0[0], v0[1]); w.y = cvt_pk_bf16(v0[2], v0[3]); w.z = cvt_pk_bf16(v1[0], v1[1]); w.w = cvt_pk_bf16(v1[2], v1[3]);
                    *(u32x4*)(rowp + bj * 128) = w; } }
    }
};
struct EpiProj {
    static constexpr bool PERM = true;
    bf16_t* HG; bf16_t* QR; bf16_t* KF; bf16_t* V; const float* rstd; const f32x2* CS; unsigned* kmax;
    __device__ __forceinline__ void operator()(const Acc& acc, const Unit& u, int wr, int wc, int fr, int fq, LAS unsigned char*) const {
        const int row0 = u.pm * 256 + wr * 64 + fr;
        float rsv[2][4];
#pragma unroll
        for (int ai = 0; ai < 2; ++ai)
#pragma unroll
            for (int m = 0; m < 4; ++m) rsv[ai][m] = rstd[row0 + ai * 128 + m * 16];
        if (u.pn < 8 || u.pn >= 12) {
            bf16_t* base; int ldc, colt;
            if (u.pn < 8) { base = HG; ldc = 2048; colt = u.pn * 256; } else { base = V; ldc = 512; colt = (u.pn - 12) * 256; }
            const int col0 = colt + wc * 32 + 8 * fq;
#pragma unroll
            for (int ai = 0; ai < 2; ++ai)
#pragma unroll
                for (int m = 0; m < 4; ++m) { const int row = row0 + ai * 128 + m * 16; const float rs = rsv[ai][m]; bf16_t* rowp = base + (size_t)row * ldc + col0;
#pragma unroll
                    for (int bj = 0; bj < 2; ++bj) { const f32x4 v0 = acc[ai][bj][m][0] * rs, v1 = acc[ai][bj][m][1] * rs;
                        u32x4 w; w.x = cvt_pk_bf16(v0[0], v0[1]); w.y = cvt_pk_bf16(v0[2], v0[3]); w.z = cvt_pk_bf16(v1[0], v1[1]); w.w = cvt_pk_bf16(v1[2], v1[3]);
                        *(u32x4*)(rowp + bj * 128) = w; } }
        } else {
            const bool isk = u.pn >= 10; const int head = 4 * (u.pn & 1) + wc;
            float kn2max = 0.f;
#pragma unroll
            for (int am = 0; am < 4; ++am) { const int ai = am >> 1;
                f32x4 csv[2][4];
#pragma unroll
                for (int mm = 0; mm < 2; ++mm) { const int m = 2 * (am & 1) + mm; const f32x4* cs = (const f32x4*)(CS + (size_t)(row0 + ai * 128 + m * 16) * 32 + 8 * fq); csv[mm][0] = cs[0]; csv[mm][1] = cs[1]; csv[mm][2] = cs[2]; csv[mm][3] = cs[3]; }
#pragma unroll
                for (int mm = 0; mm < 2; ++mm) { const int m = 2 * (am & 1) + mm; const int row = row0 + ai * 128 + m * 16; const float rs = rsv[ai][m] * (isk ? 1.f : 0.125f * LOG2E);
                    const f32x4 c0 = csv[mm][0], c1 = csv[mm][1], c2 = csv[mm][2], c3 = csv[mm][3];
                    const float co[8] = {c0.x, c0.z, c1.x, c1.z, c2.x, c2.z, c3.x, c3.z}, si[8] = {c0.y, c0.w, c1.y, c1.w, c2.y, c2.w, c3.y, c3.w};
                    float lo[8], hi[8];
#pragma unroll
                    for (int n = 0; n < 2; ++n)
#pragma unroll
                        for (int e = 0; e < 4; ++e) { const int j = 4 * n + e; const float x1 = acc[ai][0][m][n][e] * rs, x2 = acc[ai][1][m][n][e] * rs; lo[j] = x1 * co[j] - x2 * si[j]; hi[j] = x2 * co[j] + x1 * si[j]; }
                    u32x4 wl, wh; wl.x = cvt_pk_bf16(lo[0], lo[1]); wl.y = cvt_pk_bf16(lo[2], lo[3]); wl.z = cvt_pk_bf16(lo[4], lo[5]); wl.w = cvt_pk_bf16(lo[6], lo[7]);
                    wh.x = cvt_pk_bf16(hi[0], hi[1]); wh.y = cvt_pk_bf16(hi[2], hi[3]); wh.z = cvt_pk_bf16(hi[4], hi[5]); wh.w = cvt_pk_bf16(hi[6], hi[7]);
                    if (!isk) { bf16_t* rowp = QR + (size_t)row * 512 + head * 64 + 8 * fq; *(u32x4*)rowp = wl; *(u32x4*)(rowp + 32) = wh; }
                    else { { float n2 = 0.f;
#pragma unroll
                          for (int j = 0; j < 8; ++j) n2 += lo[j] * lo[j] + hi[j] * hi[j];
                          n2 += __shfl_xor(n2, 16); n2 += __shfl_xor(n2, 32); kn2max = fmaxf(kn2max, n2); }
                        const int b = row >> 13, s = row & (SEQ - 1); const size_t bh = (size_t)(b * ATH + head) * (SEQ * 64);
#pragma unroll
                        for (int pat = 0; pat < 3; ++pat) { const int D = pat == 0 ? 1 : (pat == 1 ? 4 : 16), sh = pat * 2; const int r = s & (D - 1), p = s >> sh, T = p >> 5, k5 = p & 31;
                            const int rho = (k5 & 19) | ((k5 & 4) << 1) | ((k5 & 8) >> 1);
                            bf16_t* kf = KF + (size_t)pat * (MT * 512) + bh + ((size_t)(r * (SEQ / 32 >> sh) + T) * 4) * 512;
                            *(u32x4*)(kf + ((fq >> 1) * 64 + rho + 32 * (fq & 1)) * 8) = wl; *(u32x4*)(kf + ((2 + (fq >> 1)) * 64 + rho + 32 * (fq & 1)) * 8) = wh; }
                    } } }
            if (isk) { kn2max = fmaxf(kn2max, __shfl_xor(kn2max, 1)); kn2max = fmaxf(kn2max, __shfl_xor(kn2max, 2)); kn2max = fmaxf(kn2max, __shfl_xor(kn2max, 4)); kn2max = fmaxf(kn2max, __shfl_xor(kn2max, 8));
                if (fr == 0 && fq == 0) __hip_atomic_fetch_max(kmax + ((u.pm >> 5) * ATH + head), __float_as_uint(kn2max), __ATOMIC_RELAXED, __HIP_MEMORY_SCOPE_AGENT); }
        }
    }
};
struct EpiResAdd {
    static constexpr bool PERM = false;
    const float* Xs; float* X; float dm;
    __device__ __forceinline__ void operator()(const Acc& acc, const Unit& u, int wr, int wc, int fr, int fq, LAS unsigned char*) const {
        const int row0 = u.pm * 256 + wr * 64 + fr, col0 = u.pn * 256 + wc * 32 + 4 * fq;
#pragma unroll
        for (int ai = 0; ai < 2; ++ai) {
            f32x4 xv[4][2][2];
#pragma unroll
            for (int m = 0; m < 4; ++m) { const size_t off = (size_t)(row0 + ai * 128 + m * 16) * DM + col0;
#pragma unroll
                for (int bj = 0; bj < 2; ++bj)
#pragma unroll
                    for (int n = 0; n < 2; ++n) xv[m][bj][n] = *(const f32x4*)(Xs + off + bj * 128 + n * 16); }
            asm volatile("" ::: "memory");
#pragma unroll
            for (int m = 0; m < 4; ++m) { const size_t off = (size_t)(row0 + ai * 128 + m * 16) * DM + col0;
#pragma unroll
                for (int bj = 0; bj < 2; ++bj)
#pragma unroll
                    for (int n = 0; n < 2; ++n) *(f32x4*)(X + off + bj * 128 + n * 16) = xv[m][bj][n] + acc[ai][bj][m][n] * dm; }
        }
    }
};
struct EpiResAddB {
    static constexpr bool PERM = true;
    const bf16_t* XBs; bf16_t* XBo; unsigned char* XB8; float sc;
    __device__ __forceinline__ void operator()(const Acc& acc, const Unit& u, int wr, int wc, int fr, int fq, LAS unsigned char*) const {
        const int row0 = u.pm * 256 + wr * 64 + fr, col0 = u.pn * 256 + wc * 32 + 8 * fq;
#pragma unroll
        for (int ai = 0; ai < 2; ++ai) {
            u32x4 xv[4][2];
#pragma unroll
            for (int m = 0; m < 4; ++m) { const unsigned off = (unsigned)((row0 + ai * 128 + m * 16) * DM + col0);
#pragma unroll
                for (int bj = 0; bj < 2; ++bj) xv[m][bj] = *(const u32x4*)(XBs + off + bj * 128); }
            asm volatile("" ::: "memory");
#pragma unroll
            for (int m = 0; m < 4; ++m) { const unsigned off = (unsigned)((row0 + ai * 128 + m * 16) * DM + col0);
#pragma unroll
                for (int bj = 0; bj < 2; ++bj) { const u32x4 w = xv[m][bj]; const f32x4 a4 = acc[ai][bj][m][0] * sc, b4 = acc[ai][bj][m][1] * sc;
                    const float x0 = bflo(w.x) + a4[0], x1 = bfhi(w.x) + a4[1], x2 = bflo(w.y) + a4[2], x3 = bfhi(w.y) + a4[3];
                    const float x4 = bflo(w.z) + b4[0], x5 = bfhi(w.z) + b4[1], x6 = bflo(w.w) + b4[2], x7 = bfhi(w.w) + b4[3];
                    u32x4 o; o.x = cvt_pk_bf16(x0, x1); o.y = cvt_pk_bf16(x2, x3); o.z = cvt_pk_bf16(x4, x5); o.w = cvt_pk_bf16(x6, x7);
                    u32x2 o8; o8.x = pk4_fp8(x0, x1, x2, x3); o8.y = pk4_fp8(x4, x5, x6, x7);
                    *(u32x4*)(XBo + off + bj * 128) = o; *(u32x2*)(XB8 + off + bj * 128) = o8; } }
        }
    }
};
struct EpiResNorm {
    static constexpr bool PERM = true;
    const float* Xs; const bf16_t* XsB; bf16_t* XB; float* SSQP;
    __device__ __forceinline__ void operator()(const Acc& acc, const Unit& u, int wr, int wc, int fr, int fq, LAS unsigned char* lds) const {
        LAS float* EX = (LAS float*)(lds + SPARE_OFF);
        const int row0 = u.pm * 256 + wr * 64 + fr, col0 = u.pn * 256 + wc * 32 + 8 * fq;
#pragma unroll
        for (int ai = 0; ai < 2; ++ai)
#pragma unroll
            for (int m = 0; m < 4; ++m) { const unsigned off = (unsigned)((row0 + ai * 128 + m * 16) * DM + col0); float s = 0.f;
#pragma unroll
                for (int bj = 0; bj < 2; ++bj) { f32x4 xs0, xs1;
                    if (XsB) { const u32x4 w = *(const u32x4*)(XsB + off + bj * 128); xs0 = (f32x4){bflo(w.x), bfhi(w.x), bflo(w.y), bfhi(w.y)}; xs1 = (f32x4){bflo(w.z), bfhi(w.z), bflo(w.w), bfhi(w.w)}; }
                    else { xs0 = *(const f32x4*)(Xs + off + bj * 128); xs1 = *(const f32x4*)(Xs + off + bj * 128 + 4); }
                    const f32x4 v = xs0 + acc[ai][bj][m][0], v2 = xs1 + acc[ai][bj][m][1];
                    u32x4 w; w.x = cvt_pk_bf16(v[0], v[1]); w.y = cvt_pk_bf16(v[2], v[3]); w.z = cvt_pk_bf16(v2[0], v2[1]); w.w = cvt_pk_bf16(v2[2], v2[3]); *(u32x4*)(XB + off + bj * 128) = w;
                    u32x2 w8; w8.x = pk4_fp8(v[0], v[1], v[2], v[3]); w8.y = pk4_fp8(v2[0], v2[1], v2[2], v2[3]);
                    *(u32x2*)((unsigned char*)XB + (A_XB28 - A_XB2) + off + bj * 128) = w8;
                    s += ((v[0] * v[0] + v[1] * v[1]) + (v[2] * v[2] + v[3] * v[3])) + ((v2[0] * v2[0] + v2[1] * v2[1]) + (v2[2] * v2[2] + v2[3] * v2[3])); }
                s += __shfl_xor(s, 16); s += __shfl_xor(s, 32);
                if (fq == 0) EX[(ai * 128 + wr * 64 + m * 16 + fr) * 4 + wc] = s; }
        asm volatile("s_waitcnt lgkmcnt(0)" ::: "memory"); __builtin_amdgcn_s_barrier(); asm volatile("" ::: "memory");
        { const int t = (wr * 4 + wc) * 64 + fq * 16 + fr; if (t < 256) { const f32x4 e = *(const LAS f32x4*)(EX + t * 4); SSQP[(size_t)(u.pm * 256 + t) * 4 + u.pn] = (e.x + e.y) + (e.z + e.w); } }
        asm volatile("s_waitcnt lgkmcnt(0)" ::: "memory"); __builtin_amdgcn_s_barrier(); asm volatile("" ::: "memory");
    }
};
struct EpiSoftmax {
    static constexpr bool PERM = true;
    unsigned char* P8; const float* SSQP;
    __device__ __forceinline__ void operator()(Acc& acc, const Unit& u, int wr, int wc, int fr, int fq, LAS unsigned char* lds) const {
        LAS f32x2* EX = (LAS f32x2*)(lds + SPARE_OFF);
        const int row0 = u.pm * 256 + wr * 64 + fr;
        f32x4 pqv[2][4];
#pragma unroll
        for (int ai = 0; ai < 2; ++ai)
#pragma unroll
            for (int m = 0; m < 4; ++m) pqv[ai][m] = *(const f32x4*)(SSQP + (size_t)(row0 + ai * 128 + m * 16) * 4);
        float mw[2][4];
#pragma unroll
        for (int ai = 0; ai < 2; ++ai)
#pragma unroll
            for (int m = 0; m < 4; ++m) {
                const f32x4 pq = pqv[ai][m]; const float rs = __builtin_amdgcn_rsqf(((pq.x + pq.y) + (pq.z + pq.w)) * (1.f / DM) + EPS) * (1.f / (float)(1 << WQK_SH));
                float mx = -3.0e38f;
#pragma unroll
                for (int bj = 0; bj < 2; ++bj)
#pragma unroll
                    for (int n = 0; n < 2; ++n) { f32x4 v = acc[ai][bj][m][n] * rs; acc[ai][bj][m][n] = v; mx = fmaxf(mx, fmaxf(fmaxf(v[0], v[1]), fmaxf(v[2], v[3]))); }
                mx = fmaxf(mx, __shfl_xor(mx, 16)); mx = fmaxf(mx, __shfl_xor(mx, 32));
                float sm = 0.f;
#pragma unroll
                for (int bj = 0; bj < 2; ++bj)
#pragma unroll
                    for (int n = 0; n < 2; ++n) { f32x4 v = acc[ai][bj][m][n]; v[0] = __expf(v[0] - mx); v[1] = __expf(v[1] - mx); v[2] = __expf(v[2] - mx); v[3] = __expf(v[3] - mx);
                        acc[ai][bj][m][n] = v; sm += (v[0] + v[1]) + (v[2] + v[3]); }
                sm += __shfl_xor(sm, 16); sm += __shfl_xor(sm, 32);
                mw[ai][m] = mx;
                if (fq == 0) EX[(ai * 128 + wr * 64 + m * 16 + fr) * 4 + wc] = (f32x2){mx, sm};
            }
        asm volatile("s_waitcnt lgkmcnt(0)" ::: "memory"); __builtin_amdgcn_s_barrier(); asm volatile("" ::: "memory");
#pragma unroll
        for (int ai = 0; ai < 2; ++ai)
#pragma unroll
            for (int m = 0; m < 4; ++m) {
                const int rl = ai * 128 + wr * 64 + m * 16 + fr;
                const f32x2 e0 = EX[rl * 4 + 0], e1 = EX[rl * 4 + 1], e2 = EX[rl * 4 + 2], e3 = EX[rl * 4 + 3];
                const float M = fmaxf(fmaxf(e0.x, e1.x), fmaxf(e2.x, e3.x));
                const float Ls = e0.y * __expf(e0.x - M) + e1.y * __expf(e1.x - M) + e2.y * __expf(e2.x - M) + e3.y * __expf(e3.x - M);
                const float f = __expf(mw[ai][m] - M) / Ls * (float)(1 << P_SH);
                unsigned char* rowp = P8 + (size_t)(row0 + ai * 128 + m * 16) * DM + u.pn * 256 + wc * 32 + 8 * fq;
#pragma unroll
                for (int bj = 0; bj < 2; ++bj) { const f32x4 v0 = acc[ai][bj][m][0] * f, v1 = acc[ai][bj][m][1] * f;
                    u32x2 w; w.x = pk4_fp8(v0[0], v0[1], v0[2], v0[3]); w.y = pk4_fp8(v1[0], v1[1], v1[2], v1[3]); *(u32x2*)(rowp + bj * 128) = w; }
            }
        asm volatile("s_waitcnt lgkmcnt(0)" ::: "memory"); __builtin_amdgcn_s_barrier(); asm volatile("" ::: "memory");
    }
};
struct EpiMoe1 {
    static constexpr bool PERM = true;
    unsigned char* ACT8; const float* srs; const float* sgw;
    __device__ __forceinline__ void operator()(const Acc& acc, const Unit& u, int wr, int wc, int fr, int fq, LAS unsigned char*) const {
        const int row0 = u.pm * 256 + wr * 64 + fr, col0 = u.pn * 128 + wc * 32 + 8 * fq;
        float asc = (float)(1 << ACT_SH); asm volatile("" : "+v"(asc));
        float rsv[2][4], gwv[2][4];
#pragma unroll
        for (int ai = 0; ai < 2; ++ai)
#pragma unroll
            for (int m = 0; m < 4; ++m) { const unsigned lb = (unsigned)(u.aux * 16384 + u.lr + wr * 64 + fr + ai * 128 + m * 16) * 4u; rsv[ai][m] = *(const float*)((const char*)srs + lb); gwv[ai][m] = *(const float*)((const char*)sgw + lb); }
#pragma unroll
        for (int ai = 0; ai < 2; ++ai)
#pragma unroll
            for (int m = 0; m < 4; ++m) { const int row = row0 + ai * 128 + m * 16; const float rs = rsv[ai][m] * (1.f / (float)(1 << WGU_SH)), gw = gwv[ai][m] * rs * asc;
                float o[8];
#pragma unroll
                for (int n = 0; n < 2; ++n)
#pragma unroll
                    for (int j = 0; j < 4; ++j) { const float g = acc[ai][0][m][n][j] * rs, up = acc[ai][1][m][n][j]; o[n * 4 + j] = g * sigmoidf_(g) * up * gw; }
                u32x2 w; w.x = pk4_fp8(o[0], o[1], o[2], o[3]); w.y = pk4_fp8(o[4], o[5], o[6], o[7]);
                *(u32x2*)(ACT8 + (unsigned)(row * EFF + col0)) = w; }
    }
};

struct Args { const void* in[20]; float* out; unsigned char* ws; int ph_lo, ph_hi; };
struct Frame {
    LAS unsigned char* lds; volatile LAS unsigned* MISC; gu32* ctl;
    int tid, lane, wave, vcu, G;
    unsigned char* ws; float* out; size_t z; int dry;
};

template <int F8 = -1>
__device__ __forceinline__ void transpose_item(const float* W, int N, const float* scale, bf16_t* WT, int ldt, int row_base, int k0, int n0, LAS float* scr, int lane) {
    f32x4 v[8];
#pragma unroll
    for (int i = 0; i < 8; ++i) v[i] = *(const GAS f32x4*)(W + (size_t)(k0 + 8 * i + (lane >> 3)) * N + n0 + 4 * (lane & 7));
#pragma unroll
    for (int i = 0; i < 8; ++i) { const int kk = 8 * i + (lane >> 3); f32x4 x = v[i]; if (scale) x = x * scale[k0 + kk]; if constexpr (F8 >= 0) x = x * (float)(1 << (F8 >= 0 ? F8 : 0)); LAS float* d = scr + kk * 33 + 4 * (lane & 7); d[0] = x.x; d[1] = x.y; d[2] = x.z; d[3] = x.w; }
    LDS_WAIT(); asm volatile("" ::: "memory");
    const int c = lane & 7;
#pragma unroll
    for (int j = 0; j < 4; ++j) { const int n = (lane >> 3) + 8 * j; const LAS float* s = scr + (8 * c) * 33 + n;
        if constexpr (F8 >= 0) { u32x2 o; o.x = pk4_fp8(s[0 * 33], s[1 * 33], s[2 * 33], s[3 * 33]); o.y = pk4_fp8(s[4 * 33], s[5 * 33], s[6 * 33], s[7 * 33]);
            *(GAS u32x2*)((unsigned char*)WT + (size_t)(row_base + n0 + n) * ldt + k0 + 8 * c) = o; }
        else { u32x4 o; o.x = cvt_pk_bf16(s[0 * 33], s[1 * 33]); o.y = cvt_pk_bf16(s[2 * 33], s[3 * 33]); o.z = cvt_pk_bf16(s[4 * 33], s[5 * 33]); o.w = cvt_pk_bf16(s[6 * 33], s[7 * 33]);
        *(GAS u32x4*)(WT + (size_t)(row_base + n0 + n) * ldt + k0 + 8 * c) = o; } }
    LDS_WAIT(); asm volatile("" ::: "memory");
}
template <int F8 = -1>
__device__ __forceinline__ void transpose_mat_item(const float* W, int K, int N, const float* scale, bf16_t* WT, int mode, int it, LAS float* scr, int lane) {
    const int nblk = N / 32, kb = it / nblk, nb = it % nblk, k0 = 64 * kb, n0 = 32 * nb;
    int row_base = 0;
    if (mode == 1 || mode == 2) row_base = 256 * (n0 / 128) + (n0 % 128) + (mode == 2 ? 128 : 0) - n0;
    if (mode == 3 && n0 >= 2048 && n0 < 3072) {
        const int blk = (n0 - 2048) / 512, np = (n0 - 2048) % 512, head = np / 64, d = np % 64;
        row_base = 2048 + blk * 512 + (head / 4) * 256 + 128 * (d / 32) + 32 * (head % 4) + (d % 32) - n0; }
    transpose_item<F8>(W, N, scale, WT, K, row_base, k0, n0, scr, lane);
}

__device__ __forceinline__ float row_norm_prep(const float* xrow, bf16_t* xb_row, float* copy_row, int lane) {
    const GAS f32x4* xr = (const GAS f32x4*)xrow + lane;
    f32x4 v[4]; float s = 0.f;
#pragma unroll
    for (int j = 0; j < 4; ++j) { v[j] = xr[64 * j]; s += (v[j].x * v[j].x + v[j].y * v[j].y) + (v[j].z * v[j].z + v[j].w * v[j].w); }
    const float rstd = 1.f / sqrtf(wave_sum(s) * (1.f / DM) + EPS);
    GAS u32x2* o8 = (GAS u32x2*)xb_row + lane;
#pragma unroll
    for (int j = 0; j < 4; ++j) { u32x2 w; w.x = pk2(v[j].x, v[j].y); w.y = pk2(v[j].z, v[j].w); o8[64 * j] = w; }
    if (copy_row) { GAS f32x4* c = (GAS f32x4*)copy_row + lane;
#pragma unroll
        for (int j = 0; j < 4; ++j) c[64 * j] = v[j]; }
    return rstd;
}

__constant__ double INV_FREQ[32] = {1.0, 0.7498942093324559, 0.5623413251903491, 0.4216965034285822, 0.31622776601683794, 0.23713737056616552, 0.1778279410038923, 0.1333521432163324,
    0.1, 0.07498942093324558, 0.05623413251903491, 0.042169650342858224, 0.03162277660168379, 0.023713737056616554, 0.01778279410038923, 0.01333521432163324,
    0.01, 0.007498942093324558, 0.005623413251903491, 0.004216965034285823, 0.0031622776601683794, 0.0023713737056616554, 0.0017782794100389228, 0.001333521432163324,
    0.001, 0.0007498942093324559, 0.0005623413251903491, 0.00042169650342858224, 0.00031622776601683794, 0.00023713737056616554, 0.00017782794100389227, 0.0001333521432163324};


#define IN_F(i) ((const float*)((const char*)a.in[i] + F.z))
#define YMIX_PTR(l) ((l) == 0 ? (bf16_t*)(F.ws + WS_XB) : (bf16_t*)F.out)
__device__ __forceinline__ float hg_lb(const Frame& F, const Args& a, int l, int c) { if (l == 0) return 0.f; const float* h = IN_F(5); return sigmoidf_(h[HGW + c] - h[c]); }
__device__ __forceinline__ void conv_small_item(Frame& F, const Args& a, int l, int r, LAS float* scr) {
    unsigned char* ws = F.ws; const int lane = F.lane;
    if (r < 1792) { transpose_mat_item(IN_F(4) + (size_t)l * DM * NIN, DM, NIN, IN_F(3) + l * DM, (bf16_t*)(ws + WS_WIN) + (size_t)l * NIN * DM, 3, r, scr, lane); return; } r -= 1792;
    if (r < 512) { transpose_mat_item(IN_F(7) + (size_t)l * DM * DM, DM, DM, nullptr, (bf16_t*)(ws + WS_WOUT) + (size_t)l * DM * DM, 0, r, scr, lane); return; } r -= 512;
    if (r < 1024) { transpose_mat_item(IN_F(11) + (size_t)l * DM * 2 * DM, DM, 2 * DM, nullptr, (bf16_t*)(ws + WS_WKVT) + (size_t)l * 2 * DM * DM, 0, r, scr, lane); return; } r -= 1024;
    transpose_mat_item(IN_F(12) + (size_t)l * DM * DM, DM, DM, nullptr, (bf16_t*)(ws + WS_WOT) + (size_t)l * DM * DM, 0, r, scr, lane);
}
__device__ __forceinline__ void conv_wq_row(Frame& F, const Args& a, int r) {
    const int lane = F.lane; const float sc = IN_F(8)[r] * 0.0625f;
    const GAS f32x4* src = (const GAS f32x4*)(IN_F(10) + (size_t)r * DM) + lane; GAS u32x2* dst = (GAS u32x2*)((bf16_t*)(F.ws + WS_WQS) + (size_t)r * DM) + lane;
#pragma unroll
    for (int j = 0; j < 4; ++j) { const f32x4 v = src[64 * j] * sc; u32x2 w; w.x = pk2(v.x, v.y); w.y = pk2(v.z, v.w); dst[64 * j] = w; }
}
__device__ __forceinline__ void conv_small_l1(Frame& F, const Args& a, int wi, int nw, int part) {
    { const int t9 = retid(F.wave); F.tid = t9; F.lane = t9 & 63; }
    LAS float* scr = (LAS float*)(F.lds + F.wave * 16384);
    if (part == 0) { for (int it = wi; it < 512; it += nw) conv_small_item(F, a, 1, 3328 + it, scr);
        for (int r = wi; r < DM; r += nw) conv_wq_row(F, a, DM + r); }
    else for (int it = wi; it < 2304; it += nw) conv_small_item(F, a, 1, it, scr);
}
__device__ __forceinline__ void ph_init(Frame& F, const Args& a) {
    { const int t9 = retid(F.wave); F.tid = t9; F.lane = t9 & 63; }
    LAS float* scr = (LAS float*)(F.lds + F.wave * 16384);
    const int gw = F.vcu * NWAVES + F.wave, NGW = F.G * NWAVES, lane = F.lane;
    unsigned char* ws = F.ws;
    for (int it = gw; it < 3840 + 1024; it += NGW) {
        if (it < 3840) conv_small_item(F, a, 0, it, scr); else conv_small_item(F, a, 1, 2304 + (it - 3840), scr); }
    for (int r = gw; r < DM; r += NGW) conv_wq_row(F, a, r);
    for (int r = gw; r < MEMROWS; r += NGW) {
        const GAS f32x4* xr = (const GAS f32x4*)(IN_F(1) + (size_t)r * DM) + lane;
        f32x4 v[4]; float s = 0.f;
#pragma unroll
        for (int j = 0; j < 4; ++j) { v[j] = xr[64 * j]; s += (v[j].x * v[j].x + v[j].y * v[j].y) + (v[j].z * v[j].z + v[j].w * v[j].w); }
        const float rstd = 1.f / sqrtf(wave_sum(s) * (1.f / DM) + EPS);
        for (int l = 0; l < DEPTH; ++l) {
            const GAS f32x4* g = (const GAS f32x4*)(IN_F(9) + l * DM) + lane; GAS u32x2* dst = (GAS u32x2*)((bf16_t*)(ws + WS_MEMN) + ((size_t)l * MEMROWS + r) * DM) + lane;
#pragma unroll
            for (int j = 0; j < 4; ++j) { const f32x4 o = v[j] * rstd * g[64 * j]; u32x2 w; w.x = pk2(o.x, o.y); w.y = pk2(o.z, o.w); dst[64 * j] = w; }
        }
    }
    for (int r = gw; r < MT; r += NGW) {
        const float rs = row_norm_prep(IN_F(0) + (size_t)r * DM, (bf16_t*)(ws + WS_XB) + (size_t)r * DM, nullptr, lane);
        if (lane == 0) ((float*)(ws + WS_RSTD))[r] = rs;
    }
    for (int i = (F.vcu * NTHR + F.tid); i < DEPTH * HGW; i += F.G * NTHR) ((float*)(ws + WS_LBT))[i] = hg_lb(F, a, i / HGW, i % HGW);
    { const int* pos = (const int*)((const char*)a.in[2] + F.z);
      for (int i = (F.vcu * NTHR + F.tid); i < MT * 32; i += F.G * NTHR) { const double ang = (double)pos[i >> 5] * INV_FREQ[i & 31]; double rev = ang * 0.15915494309189535; rev = rev - __builtin_floor(rev);
          const float fr = (float)rev; ((f32x2*)(ws + WS_CS))[i] = (f32x2){__builtin_amdgcn_cosf(fr), __builtin_amdgcn_sinf(fr)}; } }
    for (int i = (F.vcu * NTHR + F.tid); i < DEPTH * 32 * DM; i += F.G * NTHR) {
        const int l = i / (32 * DM), n = (i / DM) % 32, k = i % DM;
        float w = 0.f;
        if (n < 4) w = IN_F(14)[((size_t)l * DM + k) * 4 + n]; else if (n < 20) w = IN_F(15)[((size_t)l * DM + k) * 16 + (n - 4)];
        w *= IN_F(13)[l * DM + k];
        const unsigned hi = f2bf(w); const float rem = w - bf2f((unsigned short)hi);
        ((bf16_t*)(ws + WS_WR))[i] = (bf16_t)hi; ((bf16_t*)(ws + WS_WR) + DEPTH * 32 * DM)[i] = (bf16_t)f2bf(rem);
    }
}

struct SchedKV {
    int G, c; const char* memn; const char* wkvt;
    __device__ __forceinline__ bool next(int i, Unit& u) const {
        const int L = i * G + c; if (L >= 32) return false;
        const int l = L >> 4; u.pm = (L >> 3) & 1; u.pn = L & 7; u.aux = l;
        u.a = memn + ((size_t)l * MEMROWS + u.pm * 256) * DM * 2; u.b = wkvt + ((size_t)l * 2 * DM + u.pn * 256) * DM * 2; return true;
    }
};
struct SchedFold {
    int G, c; const char* kb; const char* vb; const char* wqs; const char* wot;
    __device__ __forceinline__ bool next(int i, Unit& u) const {
        const int L = i * G + c; if (L >= 128) return false;
        const int ty = L >> 6, l = (L >> 5) & 1, b = (L >> 4) & 1, h = (L >> 2) & 3, t = L & 3; u.aux = ty * 4 + l * 2 + b;
        if (ty == 0) { u.pm = h; u.pn = t; u.a = kb + (((size_t)l * MEMROWS + b * 256) * DM + h * 256) * 2; u.b = wqs + (((size_t)l * DM + t * 256) * DM + h * 256) * 2; }
        else { u.pm = t; u.pn = h; u.a = wot + (((size_t)l * DM + t * 256) * DM + h * 256) * 2; u.b = vb + (((size_t)l * MEMROWS + b * 256) * DM + h * 256) * 2; }
        return true;
    }
};
struct SchedMoe {
    int G, c, kdim; volatile LAS unsigned* tb; const char* A; const char* B; const int* perm2; const unsigned* cnt; bool gather; int mode, early, rem; unsigned* done;
    __device__ __forceinline__ bool next(int i, Unit& u) const {
        const int total = __builtin_amdgcn_readfirstlane((int)tb[16]) * 4; int L;
        if (mode == 0) L = i * G + c;
        else if (mode == 1) { L = i * G + c; if (L >= early) return false; }
        else if (mode == 2) { if (i > 0 || c >= rem) return false; L = early + c; }
        else { const int cc = c >= rem ? c - rem : c - rem + G; L = c >= rem ? (i == 0 ? cc : (G - rem) + (i - 1) * G + cc) : (G - rem) + i * G + cc; }
        if (L >= total) return false;
        if (G == 256 && L < (mode == 1 || mode == 3 ? early : (total / 256) * 256)) { const int rd = L >> 8, idx = L & 255, xcd = idx & 7, q = idx >> 3; L = ((rd * 64 + xcd * 8 + (q >> 2)) << 2) + (q & 3); }
        L = __builtin_amdgcn_readfirstlane(L);
        const int mt = L >> 2; u.pm = mt; u.pn = L & 3; int e = 0;
#pragma unroll
        for (int j = 1; j < 16; ++j) e += (mt >= __builtin_amdgcn_readfirstlane((int)tb[j])) ? 1 : 0;
        e = __builtin_amdgcn_readfirstlane(e); u.aux = e; u.lr = (mt - __builtin_amdgcn_readfirstlane((int)tb[e])) * 256; u.a = gather ? A : A + (size_t)mt * 256 * kdim * 2; u.b = B + ((size_t)e * 1024 + u.pn * 256) * kdim * 2;
        if (mode == 3) { u.lr = (L >= early) ? 1 : 0; if (i == 0) wait_next(u); }
        return true;
    }
    __device__ __forceinline__ void wait_next(const Unit& u) const {
        if (mode == 3 && u.lr) { unsigned spins = 0; while (__hip_atomic_load(done + u.pm, __ATOMIC_RELAXED, __HIP_MEMORY_SCOPE_AGENT) < 4u) { __builtin_amdgcn_s_sleep(8); if (++spins > (1u << 18)) break; }
            __builtin_amdgcn_fence(__ATOMIC_ACQUIRE, "agent"); asm volatile("s_waitcnt vmcnt(0)" ::: "memory"); } }
    __device__ __forceinline__ int src_row(const Unit& u, int r) const { const int lrow = u.lr + r; const int n = __builtin_amdgcn_readfirstlane((int)tb[24 + u.aux]); const int v = *(const int*)((const char*)perm2 + (unsigned)(u.aux * 16384 + lrow) * 4u); return lrow < n ? v : 0; }
};

__device__ __forceinline__ void vf_unit(Frame& F, int unit) {
    unsigned char* ws = F.ws; const int tid = F.tid;
    const int tb = unit >> 3, h = unit & 7, b = tb >> 4, s_base = (tb & 15) * 512;
    LAS unsigned short* Vl = (LAS unsigned short*)F.lds;
    const bf16_t* V = (const bf16_t*)(ws + A_V) + ((size_t)b * SEQ + s_base) * 512 + h * 64;
#pragma unroll
    for (int p = 0; p < 8; ++p) { const int c = p * 512 + tid, row = c >> 3, ch = c & 7; *(LAS u32x4*)(Vl + row * 72 + ch * 8) = *(const GAS u32x4*)(V + (size_t)row * 512 + ch * 8); }
    __syncthreads();
    const size_t bh = (size_t)(b * ATH + h) * (SEQ * 64);
    for (int it = 0; it < 24; ++it) { const int pc = it * 512 + tid, tile = pc >> 8, q = pc & 255, s = q >> 7, mt = (q >> 6) & 1, ln = q & 63, dim = (ln & 31) + 32 * mt, hi = ln >> 5;
        const int pat = tile >> 4, j16 = tile & 15, sh = pat * 2, D = 1 << sh;
        const int TPC = 16 >> sh, r = j16 / TPC, tl = j16 % TPC;
        const int pl = tl * 32 + 16 * s + 8 * hi;
        unsigned w[4];
#pragma unroll
        for (int jj = 0; jj < 4; ++jj) { const int t0 = ((pl + 2 * jj) << sh) + r, t1 = ((pl + 2 * jj + 1) << sh) + r; w[jj] = (unsigned)Vl[t0 * 72 + dim] | ((unsigned)Vl[t1 * 72 + dim] << 16); }
        const int T = (s_base >> sh >> 5) + tl;
        bf16_t* vf = (bf16_t*)(ws + A_VT1) + (size_t)pat * (MT * 512) + bh + ((size_t)(r * (SEQ / 32 >> sh) + T) * 4 + s * 2 + mt) * 512 + ln * 8;
        *(GAS u32x4*)vf = (u32x4){w[0], w[1], w[2], w[3]}; }
    __syncthreads();
}

constexpr int HG_LBT_OFF = 122880;
__device__ __forceinline__ void hg_build_b(Frame& F, int l, int h, const u32x4 z0, const u32x4 z1, int k0, float (&bb)[16], float (&kk)[16]) {
    const int tid = F.tid, lane = F.lane, wave = F.wave, tl = lane & 7;
    LAS float* WT = (LAS float*)F.lds; LAS float* REF = (LAS float*)(F.lds + 4096);
    const unsigned zz[8] = {z0.x, z0.y, z0.z, z0.w, z1.x, z1.y, z1.z, z1.w};
    float lbv[16];
#pragma unroll
    for (int i = 0; i < 16; i += 4) { const f32x4 t4 = *(const LAS f32x4*)(F.lds + HG_LBT_OFF + (h * 128 + k0 + i) * 4); lbv[i] = t4.x; lbv[i + 1] = t4.y; lbv[i + 2] = t4.z; lbv[i + 3] = t4.w; }
#pragma unroll
    for (int i = 0; i < 16; ++i) { const float z = (i & 1) ? bfhi(zz[i >> 1]) : bflo(zz[i >> 1]); const float lb = lbv[i];
        const float e = ex2(-LOG2E * z), sg = __builtin_amdgcn_rcpf(1.f + e), f = lb + (1.f - lb) * sg; bb[i] = __builtin_amdgcn_logf(f); kk[i] = (1.f - lb) * (e * sg); }
#pragma unroll
    for (int i = 0; i < 16; ++i) { float x = bb[i]; float y;
        y = __builtin_bit_cast(float, __builtin_amdgcn_update_dpp(0, __builtin_bit_cast(int, x), 0x111, 0xf, 0xf, true)); if (tl >= 1) x += y;
        y = __builtin_bit_cast(float, __builtin_amdgcn_update_dpp(0, __builtin_bit_cast(int, x), 0x112, 0xf, 0xf, true)); if (tl >= 2) x += y;
        y = __builtin_bit_cast(float, __builtin_amdgcn_update_dpp(0, __builtin_bit_cast(int, x), 0x114, 0xf, 0xf, true)); if (tl >= 4) x += y;
        bb[i] = x; }
    if (tl == 7) {
#pragma unroll
        for (int i = 0; i < 16; i += 4) *(LAS f32x4*)(WT + wave * 128 + k0 + i) = (f32x4){bb[i], bb[i + 1], bb[i + 2], bb[i + 3]}; }
    __syncthreads();
    for (int w = 0; w < wave; ++w) {
#pragma unroll
        for (int i = 0; i < 16; i += 4) { const f32x4 p = *(const LAS f32x4*)(WT + w * 128 + k0 + i); bb[i] += p.x; bb[i + 1] += p.y; bb[i + 2] += p.z; bb[i + 3] += p.w; } }
    if (tl == 7 && (wave & 1)) {
#pragma unroll
        for (int i = 0; i < 16; i += 4) *(LAS f32x4*)(REF + (wave >> 1) * 128 + k0 + i) = (f32x4){bb[i], bb[i + 1], bb[i + 2], bb[i + 3]}; }
    __syncthreads();
    (void)tid;
}
__device__ __forceinline__ void st_row16(LAS unsigned char* base, int byteoff, const float (&v)[16]) {
    u32x4 w0, w1; w0.x = cvt_pk_bf16(v[0], v[1]); w0.y = cvt_pk_bf16(v[2], v[3]); w0.z = cvt_pk_bf16(v[4], v[5]); w0.w = cvt_pk_bf16(v[6], v[7]); w1.x = cvt_pk_bf16(v[8], v[9]); w1.y = cvt_pk_bf16(v[10], v[11]); w1.z = cvt_pk_bf16(v[12], v[13]); w1.w = cvt_pk_bf16(v[14], v[15]);
    *(LAS u32x4*)(base + byteoff) = w0; *(LAS u32x4*)(base + byteoff + 16) = w1;
}
constexpr int HL_RED = 6144, HL_QD = 8192, HL_KD = 25600, HL_QE = 43008, HL_Q1 = 60416, HL_K1 = 69120, HL_Q2 = 77824, HL_K2 = 86528, HL_VT = 95232, HL_SC = 113664;
constexpr int RS_TR = 288;
typedef short s16x4 __attribute__((ext_vector_type(4)));
constexpr int HA_KT = 8192, HA_VT = 8192 + 64 * 288;
constexpr int RS128 = 272, RS64 = 144;

__device__ __forceinline__ void hg_lbt_to_lds(Frame& F, int l) { if (F.tid < 128) *(LAS f32x4*)(F.lds + HG_LBT_OFF + F.tid * 16) = *(const GAS f32x4*)((const float*)(F.ws + WS_LBT) + l * HGW + F.tid * 4); __syncthreads(); }
struct HgIn { u32x4 z0, z1, q0, q1, v0, v1; };
template <bool NEEDQ> __device__ __forceinline__ HgIn hg_load(Frame& F, int unit) {
    HgIn R;
    const int b = unit >> 9, h = (unit >> 7) & 3, c = unit & 127; const int row0 = b * SEQ + c * CHUNK, t = (F.tid >> 6) * 8 + (F.tid & 7), k0 = ((F.tid >> 3) & 7) * 16;
    const bf16_t* rowp = (const bf16_t*)(F.ws + A_HG) + (size_t)(row0 + t) * 2048 + h * 128 + k0;
    R.z0 = *(const GAS u32x4*)(rowp + 512); R.z1 = *(const GAS u32x4*)(rowp + 512 + 8); R.v0 = *(const GAS u32x4*)(rowp + 1024); R.v1 = *(const GAS u32x4*)(rowp + 1024 + 8);
    if (NEEDQ) { R.q0 = *(const GAS u32x4*)(rowp); R.q1 = *(const GAS u32x4*)(rowp + 8); } else { R.q0 = R.z0; R.q1 = R.z1; }
    return R;
}
__device__ __forceinline__ void hg_a2_unit(Frame& F, const Args& a, int l, int unit, const HgIn& R) {
    unsigned char* ws = F.ws; const int tid = F.tid, lane = F.lane, wave = F.wave;
    const int h = (unit >> 7) & 3;
    const int t = (tid >> 6) * 8 + (tid & 7), k0 = ((tid >> 3) & 7) * 16;
    const u32x4 v0 = R.v0, v1 = R.v1;
    float bb[16], kk[16];
    hg_build_b(F, l, h, R.z0, R.z1, k0, bb, kk);
    const LAS float* REF = (const LAS float*)(F.lds + 4096);
    { float tmp[16];
#pragma unroll
      for (int i = 0; i < 16; ++i) tmp[i] = kk[i] * ex2(REF[3 * 128 + k0 + i] - bb[i]);
      st_row16(F.lds, HA_KT + t * RS_TR + k0 * 2, tmp);
      *(LAS u32x4*)(F.lds + HA_VT + t * RS_TR + k0 * 2) = v0; *(LAS u32x4*)(F.lds + HA_VT + t * RS_TR + k0 * 2 + 16) = v1; }
    if (tid < 128) ((float*)(ws + A_DECAY))[(size_t)unit * 128 + tid] = ex2(REF[3 * 128 + tid]);
    __syncthreads();
    { const int fr = lane & 15, g = lane >> 4;
      const int q = fr >> 2, p = fr & 3;
      auto trfrag = [&](int base, int c0, int ks) -> bf16x8 {
          const LAS unsigned char* a0 = F.lds + base + (32 * ks + 8 * g + q) * RS_TR + (c0 + 4 * p) * 2;
          const s16x4 lo = __builtin_bit_cast(s16x4, __builtin_amdgcn_ds_read_tr16_b64_v4i16((LAS s16x4*)a0));
          const s16x4 hi = __builtin_bit_cast(s16x4, __builtin_amdgcn_ds_read_tr16_b64_v4i16((LAS s16x4*)(a0 + 4 * RS_TR)));
          return (bf16x8){lo[0], lo[1], lo[2], lo[3], hi[0], hi[1], hi[2], hi[3]}; };
      const int kb32 = (wave & 3) * 32, vt0 = (wave >> 2) * 4;
      auto trfragk = [&](int kb, int ks) -> bf16x8 {
          const LAS unsigned char* a0 = F.lds + HA_KT + (32 * ks + 8 * g + q) * RS_TR + (kb32 + 8 * p + 4 * kb) * 2;
          const s16x4 lo = __builtin_bit_cast(s16x4, __builtin_amdgcn_ds_read_tr16_b64_v4i16((LAS s16x4*)a0));
          const s16x4 hi = __builtin_bit_cast(s16x4, __builtin_amdgcn_ds_read_tr16_b64_v4i16((LAS s16x4*)(a0 + 4 * RS_TR)));
          return (bf16x8){lo[0], lo[1], lo[2], lo[3], hi[0], hi[1], hi[2], hi[3]}; };
      bf16x8 af[2][2];
#pragma unroll
      for (int kb = 0; kb < 2; ++kb)
#pragma unroll
          for (int ks = 0; ks < 2; ++ks) af[kb][ks] = trfragk(kb, ks);
      bf16_t* st = (bf16_t*)(ws + A_STATE) + (size_t)unit * 16384;
#pragma unroll
      for (int vi = 0; vi < 4; ++vi) { const int vt = vt0 + vi; f32x4 acc0 = zero4(), acc1 = zero4();
#pragma unroll
          for (int ks = 0; ks < 2; ++ks) { const bf16x8 bf = trfrag(HA_VT, vt * 16, ks); acc0 = __builtin_amdgcn_mfma_f32_16x16x32_bf16(af[0][ks], bf, acc0, 0, 0, 0); acc1 = __builtin_amdgcn_mfma_f32_16x16x32_bf16(af[1][ks], bf, acc1, 0, 0, 0); }
          u32x4 w; w.x = cvt_pk_bf16(acc0[0], acc0[1]); w.y = cvt_pk_bf16(acc0[2], acc0[3]); w.z = cvt_pk_bf16(acc1[0], acc1[1]); w.w = cvt_pk_bf16(acc1[2], acc1[3]);
          *(GAS u32x4*)(st + (vt * 16 + fr) * 128 + kb32 + 8 * g) = w; } }
}

template <int STOP> __device__ __forceinline__ void hg_c2_unit(Frame& F, const Args& a, int l, int unit, const HgIn& R) {
    unsigned char* ws = F.ws; const int tid = F.tid, lane = F.lane, wave = F.wave;
    const int b = unit >> 9, h = (unit >> 7) & 3, c = unit & 127; const int row0 = b * SEQ + c * CHUNK;
    const int t = (tid >> 6) * 8 + (tid & 7), k0 = ((tid >> 3) & 7) * 16;
    const int fr = lane & 15, g = lane >> 4;
    const bf16_t* HG = (const bf16_t*)(ws + A_HG);
    const u32x4 q0 = R.q0, q1 = R.q1, v0 = R.v0, v1 = R.v1;
    bf16x8 sf[4]; u32x2 gwv[4];
    { const bf16_t* st = (const bf16_t*)(ws + A_STATE) + (size_t)unit * 16384 + (wave * 16 + fr) * 128;
#pragma unroll
      for (int ks = 0; ks < 4; ++ks) sf[ks] = *(const GAS bf16x8*)(st + 32 * ks + 8 * g);
#pragma unroll
      for (int I = 0; I < 4; ++I) gwv[I] = *(const GAS u32x2*)(HG + (size_t)(row0 + 16 * I + fr) * 2048 + 1536 + h * 128 + wave * 16 + 4 * g); }
    const f32x4 gain = *(const GAS f32x4*)(IN_F(6) + l * HGW + h * 128 + wave * 16 + 4 * g);
    float bb[16], kk[16];
    hg_build_b(F, l, h, R.z0, R.z1, k0, bb, kk);
    if (STOP == 1) { asm volatile("" :: "v"(bb[0]), "v"(kk[0]), "v"(sf[0]), "v"(gwv[0]), "v"(gain)); return; }
    const LAS float* REF = (const LAS float*)(F.lds + 4096);
    { const unsigned qq[8] = {q0.x, q0.y, q0.z, q0.w, q1.x, q1.y, q1.z, q1.w}, vv[8] = {v0.x, v0.y, v0.z, v0.w, v1.x, v1.y, v1.z, v1.w};
      LAS unsigned short* VT = (LAS unsigned short*)(F.lds + HL_VT);
      float qv[16], tmp[16];
#pragma unroll
      for (int i = 0; i < 16; ++i) { qv[i] = (i & 1) ? bfhi(qq[i >> 1]) : bflo(qq[i >> 1]); VT[(k0 + i) * (RS64 / 2) + t] = (unsigned short)((i & 1) ? (vv[i >> 1] >> 16) : (vv[i >> 1] & 0xffffu)); }
      const int I = wave >> 1;
      float rf[16];
#pragma unroll
      for (int i = 0; i < 16; i += 4) { f32x4 r4 = zero4(); if (I) r4 = *(const LAS f32x4*)(REF + (I - 1) * 128 + k0 + i); rf[i] = r4.x; rf[i + 1] = r4.y; rf[i + 2] = r4.z; rf[i + 3] = r4.w; }
#pragma unroll
      for (int i = 0; i < 16; ++i) tmp[i] = qv[i] * ex2(bb[i] - rf[i]);
      st_row16(F.lds, HL_QD + t * RS128 + k0 * 2, tmp);
#pragma unroll
      for (int i = 0; i < 16; ++i) tmp[i] = kk[i] * ex2(fminf(rf[i] - bb[i], 86.f));
      st_row16(F.lds, HL_KD + t * RS128 + k0 * 2, tmp);
#pragma unroll
      for (int i = 0; i < 16; ++i) tmp[i] = qv[i] * ex2(bb[i]);
      st_row16(F.lds, HL_QE + t * RS128 + k0 * 2, tmp);
#pragma unroll
      for (int i = 0; i < 16; i += 4) { const f32x4 r4 = *(const LAS f32x4*)(REF + 1 * 128 + k0 + i); rf[i] = r4.x; rf[i + 1] = r4.y; rf[i + 2] = r4.z; rf[i + 3] = r4.w; }
      if (wave >= 4) {
#pragma unroll
          for (int i = 0; i < 16; ++i) tmp[i] = qv[i] * ex2(bb[i] - rf[i]);
          st_row16(F.lds, HL_Q1 + (t & 31) * RS128 + k0 * 2, tmp);
      } else {
#pragma unroll
          for (int i = 0; i < 16; ++i) tmp[i] = kk[i] * ex2(rf[i] - bb[i]);
          st_row16(F.lds, HL_K1 + (t & 31) * RS128 + k0 * 2, tmp);
      }
#pragma unroll
      for (int i = 0; i < 16; i += 4) { const f32x4 r4 = *(const LAS f32x4*)(REF + ((wave >= 4) ? 2 : 0) * 128 + k0 + i); rf[i] = r4.x; rf[i + 1] = r4.y; rf[i + 2] = r4.z; rf[i + 3] = r4.w; }
      if (wave & 2) {
#pragma unroll
          for (int i = 0; i < 16; ++i) tmp[i] = qv[i] * ex2(bb[i] - rf[i]);
          st_row16(F.lds, HL_Q2 + ((t & 15) + ((wave >= 4) ? 16 : 0)) * RS128 + k0 * 2, tmp);
      } else {
#pragma unroll
          for (int i = 0; i < 16; ++i) tmp[i] = kk[i] * ex2(rf[i] - bb[i]);
          st_row16(F.lds, HL_K2 + ((t & 15) + ((wave >= 4) ? 16 : 0)) * RS128 + k0 * 2, tmp);
      }
      for (int i = tid; i < 64 * RS64 / 16; i += NTHR) *(LAS u32x4*)(F.lds + HL_SC + i * 16) = __builtin_bit_cast(u32x4, zero4());
    }
    __syncthreads();
    if (STOP == 2) { asm volatile("" :: "v"(sf[0]), "v"(gwv[0]), "v"(gain)); return; }
    for (int blk = wave; blk < 10; blk += 8) {
        int ko, qo, J, I; bool diag = false;
        if (blk < 4) { ko = HL_KD + blk * 16 * RS128; qo = HL_QD + blk * 16 * RS128; J = blk; I = blk; diag = true; }
        else if (blk == 4) { ko = HL_K2; qo = HL_Q2; J = 0; I = 1; }
        else if (blk == 5) { ko = HL_K2 + 16 * RS128; qo = HL_Q2 + 16 * RS128; J = 2; I = 3; }
        else { const int jj = (blk - 6) >> 1, ii = (blk - 6) & 1; ko = HL_K1 + jj * 16 * RS128; qo = HL_Q1 + ii * 16 * RS128; J = jj; I = 2 + ii; }
        f32x4 acc = zero4();
#pragma unroll
        for (int ks = 0; ks < 4; ++ks) { const bf16x8 af = *(const LAS bf16x8*)(F.lds + ko + fr * RS128 + (32 * ks + 8 * g) * 2), bf = *(const LAS bf16x8*)(F.lds + qo + fr * RS128 + (32 * ks + 8 * g) * 2);
            acc = __builtin_amdgcn_mfma_f32_16x16x32_bf16(af, bf, acc, 0, 0, 0); }
        if (diag) {
#pragma unroll
            for (int rg = 0; rg < 4; ++rg) if (4 * g + rg > fr) acc[rg] = 0.f; }
        u32x2 w; w.x = cvt_pk_bf16(acc[0], acc[1]); w.y = cvt_pk_bf16(acc[2], acc[3]);
        *(LAS u32x2*)(F.lds + HL_SC + (16 * I + fr) * RS64 + (16 * J + 4 * g) * 2) = w;
    }
    __syncthreads();
    if (STOP == 3) { asm volatile("" :: "v"(sf[0]), "v"(gwv[0]), "v"(gain)); return; }
    f32x4 o[4];
#pragma unroll
    for (int I = 0; I < 4; ++I) o[I] = zero4();
    { bf16x8 af[2];
#pragma unroll
      for (int ks = 0; ks < 2; ++ks) af[ks] = *(const LAS bf16x8*)(F.lds + HL_VT + (wave * 16 + fr) * RS64 + (32 * ks + 8 * g) * 2);
#pragma unroll
      for (int I = 0; I < 4; ++I)
#pragma unroll
          for (int ks = 0; ks < 2; ++ks) { const bf16x8 bf = *(const LAS bf16x8*)(F.lds + HL_SC + (16 * I + fr) * RS64 + (32 * ks + 8 * g) * 2); o[I] = __builtin_amdgcn_mfma_f32_16x16x32_bf16(af[ks], bf, o[I], 0, 0, 0); }
#pragma unroll
      for (int I = 0; I < 4; ++I)
#pragma unroll
          for (int ks = 0; ks < 4; ++ks) { const bf16x8 bf = *(const LAS bf16x8*)(F.lds + HL_QE + (16 * I + fr) * RS128 + (32 * ks + 8 * g) * 2); o[I] = __builtin_amdgcn_mfma_f32_16x16x32_bf16(sf[ks], bf, o[I], 0, 0, 0); }
    }
    if (STOP == 4) { asm volatile("" :: "v"(o[0]), "v"(o[1]), "v"(o[2]), "v"(o[3]), "v"(gwv[0]), "v"(gain)); return; }
    LAS float* RED = (LAS float*)(F.lds + HL_RED);
#pragma unroll
    for (int I = 0; I < 4; ++I) { float q = (o[I][0] * o[I][0] + o[I][1] * o[I][1]) + (o[I][2] * o[I][2] + o[I][3] * o[I][3]); q += __shfl_xor(q, 16); q += __shfl_xor(q, 32); if (g == 0) RED[wave * 64 + 16 * I + fr] = q; }
    __syncthreads();
    { bf16_t* Y = YMIX_PTR(l);
#pragma unroll
      for (int I = 0; I < 4; ++I) { const int tt = 16 * I + fr; float ssq = 0.f;
#pragma unroll
          for (int w = 0; w < 8; ++w) ssq += RED[w * 64 + tt];
          const float rs = __builtin_amdgcn_rsqf(ssq * (1.f / 128.f) + EPS);
          const u32x2 gw = gwv[I];
          const float g0 = bflo(gw.x), g1 = bfhi(gw.x), g2 = bflo(gw.y), g3 = bfhi(gw.y);
          u32x2 w; w.x = cvt_pk_bf16(o[I][0] * rs * gain.x * (g0 * sigmoidf_(g0)), o[I][1] * rs * gain.y * (g1 * sigmoidf_(g1)));
          w.y = cvt_pk_bf16(o[I][2] * rs * gain.z * (g2 * sigmoidf_(g2)), o[I][3] * rs * gain.w * (g3 * sigmoidf_(g3)));
          *(GAS u32x2*)(Y + (size_t)(row0 + tt) * DM + h * 128 + wave * 16 + 4 * g) = w; } }
}

__device__ __forceinline__ void hg_scan(Frame& F, int vcu) {
    { const int t9 = retid(F.wave); F.tid = t9; F.lane = t9 & 63; }
    unsigned char* ws = F.ws;
    for (int gid = vcu * NTHR + F.tid; gid < BATCH * HGH * 16384; gid += F.G * NTHR) {
        const int bh = gid >> 14, e = gid & 16383, k = e & 127;
        bf16_t* st = (bf16_t*)(ws + A_STATE) + (size_t)bh * NCHUNK * 16384 + e; const float* dc = (const float*)(ws + A_DECAY) + (size_t)bh * NCHUNK * 128 + k;
        float S = 0.f;
        for (int c0 = 0; c0 < NCHUNK; c0 += 32) { float kv[32], d[32];
#pragma unroll
            for (int i = 0; i < 32; ++i) { kv[i] = bf2f(st[(size_t)(c0 + i) * 16384]); d[i] = dc[(c0 + i) * 128]; }
#pragma unroll
            for (int i = 0; i < 32; ++i) { st[(size_t)(c0 + i) * 16384] = (bf16_t)f2bf(F.dry ? kv[i] : S); S = d[i] * S + kv[i]; } }
    }
}


typedef float f32x16 __attribute__((ext_vector_type(16)));
template <int D, int PAT>
__device__ __forceinline__ void att_pattern(Frame& F, int b, int h, int s_base, float kmax2, const bf16_t* QR, const bf16_t* KF, const bf16_t* VF) {
    const int lane = F.lane, wave = F.wave, r32 = lane & 31, hi = lane >> 5;
    LAS float* ACC = (LAS float*)F.lds; LAS float* LS = (LAS float*)(F.lds + 131072);
    constexpr int TPC = 16 / D, NT = SEQ / D / 32;
    const size_t bh = (size_t)(b * ATH + h) * (SEQ * 64);
    f32x16 mlo, mhi;
#pragma unroll
    for (int rg = 0; rg < 16; ++rg) { const int kap = 16 * (rg >> 3) + 8 * hi + (rg & 7); mlo[rg] = kap < r32 ? -1.0e30f : 0.f; mhi[rg] = kap > r32 ? -1.0e30f : 0.f; }
    for (int jj = 0; jj < 2; ++jj) {
        const int j = wave + 8 * jj, r = j / TPC, tile = j % TPC, p0 = s_base / D + tile * 32;
        const size_t qrow = (size_t)b * SEQ + (size_t)(p0 + r32) * D + r;
        bf16x8 qf[4];
#pragma unroll
        for (int kk = 0; kk < 4; ++kk) qf[kk] = *(const GAS bf16x8*)(QR + qrow * 512 + h * 64 + 16 * kk + 8 * hi);
        float qn2 = 0.f;
#pragma unroll
        for (int kk = 0; kk < 4; ++kk)
#pragma unroll
            for (int e = 0; e < 8; ++e) { const float x = bf2f((unsigned short)qf[kk][e]); qn2 += x * x; }
        qn2 += __shfl_xor(qn2, 32);
        const float negM = -__builtin_amdgcn_sqrtf(qn2 * kmax2);
        f32x16 o[2] = {{}, {}}; f32x2 ls2 = {0.f, 0.f};
        const unsigned short c0b = (unsigned short)(cvt_pk_bf16(negM, negM) & 0xffffu);
        const bf16x8 onesA = {(short)(hi == 0 ? 0x3F80 : 0), 0, 0, 0, 0, 0, 0, 0};
        const bf16x8 refB = {(short)(hi == 0 ? c0b : 0), 0, 0, 0, 0, 0, 0, 0}, offB = {(short)(hi == 0 ? (short)0xF149 : 0), 0, 0, 0, 0, 0, 0, 0};
#pragma unroll
        for (int kt = 0; kt < 5; ++kt) {
            const bool off_tile = (p0 - 128 + 32 * kt) < 0;
            bf16x8 vfr[2][2], kf[4];
            { const int kb = p0 - 128 + 32 * kt, kbc = kb < 0 ? 0 : kb;
              const bf16_t* kp = KF + bh + ((size_t)(r * NT + (kbc >> 5)) * 4) * 512 + lane * 8;
#pragma unroll
              for (int kk = 0; kk < 4; ++kk) kf[kk] = *(const GAS bf16x8*)(kp + kk * 512);
#pragma unroll
              for (int s = 0; s < 2; ++s)
#pragma unroll
                  for (int mt = 0; mt < 2; ++mt) vfr[s][mt] = *(const GAS bf16x8*)(VF + bh + ((size_t)(r * NT + (kbc >> 5)) * 4 + s * 2 + mt) * 512 + lane * 8); }
            f32x16 acc = __builtin_amdgcn_mfma_f32_32x32x16_bf16(onesA, off_tile ? offB : refB, kt == 0 ? mlo : (kt == 4 ? mhi : (f32x16){}), 0, 0, 0);
#pragma unroll
            for (int kk = 0; kk < 4; ++kk) acc = __builtin_amdgcn_mfma_f32_32x32x16_bf16(kf[kk], qf[kk], acc, 0, 0, 0);
#pragma unroll
            for (int rg = 0; rg < 16; ++rg) acc[rg] = ex2(acc[rg]);
#pragma unroll
            for (int rg = 0; rg < 16; rg += 2) ls2 += (f32x2){acc[rg], acc[rg + 1]};
#pragma unroll
            for (int s = 0; s < 2; ++s) {
                u32x4 pw; pw.x = cvt_pk_bf16(acc[8 * s + 0], acc[8 * s + 1]); pw.y = cvt_pk_bf16(acc[8 * s + 2], acc[8 * s + 3]);
                pw.z = cvt_pk_bf16(acc[8 * s + 4], acc[8 * s + 5]); pw.w = cvt_pk_bf16(acc[8 * s + 6], acc[8 * s + 7]);
                const bf16x8 pf = __builtin_bit_cast(bf16x8, pw);
#pragma unroll
                for (int mt = 0; mt < 2; ++mt) o[mt] = __builtin_amdgcn_mfma_f32_32x32x16_bf16(vfr[s][mt], pf, o[mt], 0, 0, 0);
            }
        }
        float lsum = ls2.x + ls2.y; lsum += __shfl_xor(lsum, 32);
        const int tau = (p0 + r32) * D + r - s_base, gsw = (tau ^ (tau >> 5)) & 31;
        LAS float* arow = ACC + tau * 64;
#pragma unroll
        for (int mt = 0; mt < 2; ++mt)
#pragma unroll
            for (int rg = 0; rg < 16; ++rg) { LAS float* p = arow + ((((rg & 3) + 8 * (rg >> 2) + 4 * hi) ^ gsw) + 32 * mt); if (PAT == 0) *p = o[mt][rg]; else *p += o[mt][rg]; }
        if (hi == 0) { if (PAT == 0) LS[tau] = lsum; else LS[tau] += lsum; }
    }
}
__device__ __forceinline__ void att_unit(Frame& F, int l, int unit) {
    const int tb = unit >> 3, h = unit & 7, b = tb >> 4, s_base = (tb & 15) * 512;
    const bf16_t* QR = (const bf16_t*)(F.ws + A_QR);
    LAS float* ACC = (LAS float*)F.lds; LAS float* LS = (LAS float*)(F.lds + 131072);
    float margin = 1.02f; asm volatile("" : "+v"(margin));
    const float kmax2 = __uint_as_float(__hip_atomic_load((unsigned*)(F.ctl + CW_KMAX + l * 16) + b * ATH + h, RLX_AGENT)) * margin;
    if (F.wave >= 4) __builtin_amdgcn_s_setprio(1);
    att_pattern<1, 0>(F, b, h, s_base, kmax2, QR, (const bf16_t*)(F.ws + A_KF1), (const bf16_t*)(F.ws + A_VT1));
    __syncthreads();
    att_pattern<4, 1>(F, b, h, s_base, kmax2, QR, (const bf16_t*)(F.ws + A_KF4), (const bf16_t*)(F.ws + A_VT4));
    __syncthreads();
    att_pattern<16, 2>(F, b, h, s_base, kmax2, QR, (const bf16_t*)(F.ws + A_KF16), (const bf16_t*)(F.ws + A_VT16));
    __syncthreads();
    { const int tau = F.tid, gsw = (tau ^ (tau >> 5)) & 31; const LAS float* arow = ACC + tau * 64; const float inv = __builtin_amdgcn_rcpf(LS[tau]);
      bf16_t* yrow = YMIX_PTR(l) + ((size_t)b * SEQ + s_base + tau) * DM + 512 + h * 64;
#pragma unroll
      for (int c = 0; c < 8; ++c) { float v[8];
#pragma unroll
          for (int e = 0; e < 8; ++e) v[e] = arow[((8 * c + e) & 32) + (((8 * c + e) & 31) ^ gsw)] * inv;
          u32x4 w; w.x = cvt_pk_bf16(v[0], v[1]); w.y = cvt_pk_bf16(v[2], v[3]); w.z = cvt_pk_bf16(v[4], v[5]); w.w = cvt_pk_bf16(v[6], v[7]); *(GAS u32x4*)(yrow + 8 * c) = w; } }
    __builtin_amdgcn_s_setprio(0);
    __syncthreads();
}

__device__ __forceinline__ void ph_norm(Frame& F, const Args& a) {
    const int gw = F.vcu * NWAVES + F.wave, NGW = F.G * NWAVES;
    for (int r = gw; r < MT; r += NGW) { const float rs = row_norm_prep(F.out + (size_t)r * DM, (bf16_t*)(F.ws + WS_XB) + (size_t)r * DM, nullptr, F.lane); if (F.lane == 0) ((float*)(F.ws + WS_RSTD))[r] = rs; }
}

__device__ __forceinline__ void ph_router(Frame& F, const Args& a, int l, const unsigned* wait, int rt0, bool router_first) {
    { const int t9 = retid(F.wave); F.tid = t9; F.lane = t9 & 63; }
    unsigned char* ws = F.ws; const int lane = F.lane;
    const int gw = F.vcu * NWAVES + F.wave, NGW = F.G * NWAVES;
    const int rt_first = rt0 >= 0 ? rt0 : F.vcu, rt_step = rt0 >= 0 ? MT / 64 : F.G;
    unsigned* cnt = (unsigned*)(F.ctl + CW_CNT + l * 16 * 64);
    LAS unsigned* LCNT = (LAS unsigned*)(F.lds + SPARE_OFF); LAS unsigned* LBASE = (LAS unsigned*)(F.lds + SPARE_OFF + 64);
    LAS float* LG = (LAS float*)F.lds;
    LAS float* SS = (LAS float*)(F.lds + 16384);
    for (int step = 0; step < 2; ++step) {
    if ((step == 0) != router_first) {
    { LAS float* scr = (LAS float*)(F.lds + F.wave * 16384);
      for (int it = gw; it < 3 * 4096; it += NGW) { const int ty = it >> 12, e = (it >> 8) & 15, r = it & 255;
          if (ty == 0) transpose_mat_item<WGU_SH>(IN_F(16) + ((size_t)l * NEXP + e) * DM * EFF, DM, EFF, IN_F(13) + l * DM, (bf16_t*)(ws + A_WGU + (size_t)e * DM * DM), 1, r, scr, lane);
          else if (ty == 1) transpose_mat_item<WGU_SH>(IN_F(17) + ((size_t)l * NEXP + e) * DM * EFF, DM, EFF, IN_F(13) + l * DM, (bf16_t*)(ws + A_WGU + (size_t)e * DM * DM), 2, r, scr, lane);
          else transpose_mat_item<WD_SH>(IN_F(18) + ((size_t)l * NEXP + e) * EFF * DM, EFF, DM, nullptr, (bf16_t*)(ws + A_WD + (size_t)e * DM * EFF), 0, r, scr, lane); } }
    __syncthreads();
    } else {
    if (wait && F.tid == 0) { if (rt0 >= 0) poll_ge(wait + (rt0 >> 2) * 32, 4u); else for (int p = 0; p < 64; ++p) poll_ge(wait + p * 32, 4u);
        __builtin_amdgcn_fence(__ATOMIC_ACQUIRE, "agent"); asm volatile("s_waitcnt vmcnt(0)" ::: "memory"); }
    __syncthreads();
    if (F.tid < 16) LCNT[F.tid] = 0u;
    const bf16_t* WH = (const bf16_t*)(ws + WS_WR) + (size_t)l * 32 * DM; const bf16_t* WL = WH + DEPTH * 32 * DM;
    const int fr = lane & 15, g = lane >> 4, tile = F.wave & 3, kh = F.wave >> 2;
    for (int rt = rt_first; rt < MT / 64; rt += rt_step) {
        const int row = rt * 64 + tile * 16 + fr;
        const bf16_t* xbrow = (const bf16_t*)(ws + WS_XB) + (size_t)row * DM + kh * 512 + 8 * g;
        f32x4 acc[2] = {zero4(), zero4()}; float ssq = 0.f;
#pragma unroll 4
        for (int ks = 0; ks < 16; ++ks) {
            const u32x4 hw = *(const GAS u32x4*)(xbrow + 32 * ks);
            { const float x0 = bflo(hw.x), x1 = bfhi(hw.x), x2 = bflo(hw.y), x3 = bfhi(hw.y), x4 = bflo(hw.z), x5 = bfhi(hw.z), x6 = bflo(hw.w), x7 = bfhi(hw.w);
              ssq += ((x0 * x0 + x1 * x1) + (x2 * x2 + x3 * x3)) + ((x4 * x4 + x5 * x5) + (x6 * x6 + x7 * x7)); }
            const bf16x8 ah = __builtin_bit_cast(bf16x8, hw);
#pragma unroll
            for (int ct = 0; ct < 2; ++ct) { const size_t wo = (size_t)(16 * ct + fr) * DM + kh * 512 + 32 * ks + 8 * g;
                const bf16x8 bh = *(const GAS bf16x8*)(WH + wo), bl = *(const GAS bf16x8*)(WL + wo);
                acc[ct] = __builtin_amdgcn_mfma_f32_16x16x32_bf16(ah, bh, acc[ct], 0, 0, 0); acc[ct] = __builtin_amdgcn_mfma_f32_16x16x32_bf16(ah, bl, acc[ct], 0, 0, 0); }
        }
        ssq += __shfl_xor(ssq, 16); ssq += __shfl_xor(ssq, 32);
        if (g == 0) SS[kh * 64 + tile * 16 + fr] = ssq;
#pragma unroll
        for (int ct = 0; ct < 2; ++ct)
#pragma unroll
            for (int rg = 0; rg < 4; ++rg) LG[(kh * 64 + tile * 16 + 4 * g + rg) * 32 + 16 * ct + fr] = acc[ct][rg];
        __syncthreads();
        if (F.tid < 64) { const int rl = F.tid, r = rt * 64 + rl;
            const float rstd = __builtin_amdgcn_rsqf((SS[rl] + SS[64 + rl]) * (1.f / DM) + EPS);
            float lg[20];
#pragma unroll
            for (int q = 0; q < 20; q += 4) { const f32x4 p0 = *(const LAS f32x4*)(LG + rl * 32 + q), p1 = *(const LAS f32x4*)(LG + (64 + rl) * 32 + q); lg[q] = (p0.x + p1.x) * rstd; lg[q + 1] = (p0.y + p1.y) * rstd; lg[q + 2] = (p0.z + p1.z) * rstd; lg[q + 3] = (p0.w + p1.w) * rstd; }
            ((float*)(ws + WS_RSTD))[r] = rstd;
            int gs = 0; float gm = lg[0];
#pragma unroll
            for (int q = 1; q < 4; ++q) if (lg[q] > gm) { gm = lg[q]; gs = q; }
            float den = 0.f;
#pragma unroll
            for (int q = 0; q < 4; ++q) den += __expf(lg[q] - gm);
            const float gwt = __builtin_amdgcn_rcpf(den);
            float e4[4];
#pragma unroll
            for (int q = 0; q < 4; ++q) e4[q] = gs == 0 ? lg[4 + q] : (gs == 1 ? lg[8 + q] : (gs == 2 ? lg[12 + q] : lg[16 + q]));
            int i1 = 0; float v1 = e4[0];
#pragma unroll
            for (int q = 1; q < 4; ++q) if (e4[q] > v1) { v1 = e4[q]; i1 = q; }
            int i2 = -1; float v2 = -3.0e38f;
#pragma unroll
            for (int q = 0; q < 4; ++q) if (q != i1 && e4[q] > v2) { v2 = e4[q]; i2 = q; }
            const float ex = __expf(v2 - v1), w1 = __builtin_amdgcn_rcpf(1.f + ex), w2 = ex * w1;
            const int id1 = gs * 4 + i1, id2 = gs * 4 + i2;
            int* te = (int*)(ws + WS_TOKE) + 2 * r; float* tw = (float*)(ws + WS_TOKW) + 2 * r; int* tl = (int*)(ws + WS_TOKL) + 2 * r;
            te[0] = id1; te[1] = id2; tw[0] = w1 * gwt; tw[1] = w2 * gwt;
            tl[0] = (int)__hip_atomic_fetch_add(LCNT + id1, 1u, __ATOMIC_RELAXED, __HIP_MEMORY_SCOPE_WORKGROUP); tl[1] = (int)__hip_atomic_fetch_add(LCNT + id2, 1u, __ATOMIC_RELAXED, __HIP_MEMORY_SCOPE_WORKGROUP);
        }
        __syncthreads();
    }
    __syncthreads();
    if (F.tid < 16) LBASE[F.tid] = __hip_atomic_fetch_add(cnt + 64 * F.tid, F.dry ? 0u : LCNT[F.tid], RLX_AGENT);
    }
    }
    __syncthreads();
    for (int rt = rt_first; rt < MT / 64; rt += rt_step) {
        if (F.tid < 128) { const int r = rt * 64 + (F.tid >> 1), k = F.tid & 1;
            const int e = ((const int*)(ws + WS_TOKE))[2 * r + k]; const int li = ((const int*)(ws + WS_TOKL))[2 * r + k] + (int)LBASE[e];
            ((int*)(ws + WS_TOKL))[2 * r + k] = li; ((int*)(ws + A_PERM2))[e * 16384 + li] = r; ((float*)(ws + A_SRS2))[e * 16384 + li] = ((const float*)(ws + WS_RSTD))[r]; ((float*)(ws + A_SGW2))[e * 16384 + li] = ((const float*)(ws + WS_TOKW))[2 * r + k]; } }
}

__device__ __forceinline__ void moe_prefix(Frame& F, int l) {
    if (F.tid == 0) { unsigned n[16];
#pragma unroll
        for (int e = 0; e < 16; ++e) n[e] = __hip_atomic_load((unsigned*)(F.ctl + CW_CNT + l * 16 * 64) + 64 * e, RLX_AGENT);
        unsigned acc = 0;
#pragma unroll
        for (int e = 0; e < 16; ++e) { F.MISC[16 + e] = acc; F.MISC[40 + e] = n[e]; acc += (n[e] + 255u) >> 8; }
        F.MISC[32] = acc; }
    __syncthreads();
}

__device__ __forceinline__ void ph_combine(Frame& F, const Args& a, int l, int rbase, int rstep, int rcount, bool have_prefix) {
    { const int t9 = retid(F.wave); F.tid = t9; F.lane = t9 & 63; }
    unsigned char* ws = F.ws; const int lane = F.lane;
    if (!have_prefix) moe_prefix(F, l);
    const int* tlr = (const int*)(ws + WS_TOKL); const int* te = (const int*)(ws + WS_TOKE); const unsigned char* Y = (const unsigned char*)(ws + A_Y);
    auto slot_of = [&](int p) { return (int)F.MISC[16 + te[p]] * 256 + tlr[p]; };
    auto rowk = [&](int k) { return rbase + (k < rcount ? k : rcount - 1) * rstep; };
    if (rcount <= 0) return;
    int r = rbase;
    int s0 = slot_of(2 * r), s1 = slot_of(2 * r + 1);
    int rn = rowk(1); int sn0 = slot_of(2 * rn), sn1 = slot_of(2 * rn + 1);
    const bf16_t* XBp = (const bf16_t*)(ws + WS_XB);
    u32x2 xv[4]; unsigned ya[4], yb[4];
#pragma unroll
    for (int j = 0; j < 4; ++j) { xv[j] = ((const GAS u32x2*)(XBp + (size_t)r * DM) + lane)[64 * j]; ya[j] = ((const GAS unsigned*)(Y + (size_t)s0 * DM) + lane)[64 * j]; yb[j] = ((const GAS unsigned*)(Y + (size_t)s1 * DM) + lane)[64 * j]; }
    for (int k = 0; k < rcount; ++k) {
        const int rnn = rowk(k + 2); const int snn0 = slot_of(2 * rnn), snn1 = slot_of(2 * rnn + 1);
        u32x2 xn[4]; unsigned yan[4], ybn[4];
#pragma unroll
        for (int j = 0; j < 4; ++j) { xn[j] = ((const GAS u32x2*)(XBp + (size_t)rn * DM) + lane)[64 * j]; yan[j] = ((const GAS unsigned*)(Y + (size_t)sn0 * DM) + lane)[64 * j]; ybn[j] = ((const GAS unsigned*)(Y + (size_t)sn1 * DM) + lane)[64 * j]; }
        GAS f32x4* xr = (GAS f32x4*)(F.out + (size_t)r * DM) + lane;
        f32x4 v[4]; float s = 0.f;
#pragma unroll
        for (int j = 0; j < 4; ++j) { const f32x2_ a0 = __builtin_amdgcn_cvt_pk_f32_fp8((int)ya[j], false), a1 = __builtin_amdgcn_cvt_pk_f32_fp8((int)ya[j], true), b0 = __builtin_amdgcn_cvt_pk_f32_fp8((int)yb[j], false), b1 = __builtin_amdgcn_cvt_pk_f32_fp8((int)yb[j], true);
            f32x4 x = {bflo(xv[j].x), bfhi(xv[j].x), bflo(xv[j].y), bfhi(xv[j].y)};
            const float dm = F.dry ? 0.f : 1.f / (float)(1 << Y_SH); x.x += dm * (a0.x + b0.x); x.y += dm * (a0.y + b0.y); x.z += dm * (a1.x + b1.x); x.w += dm * (a1.y + b1.y);
            v[j] = x; s += (x.x * x.x + x.y * x.y) + (x.z * x.z + x.w * x.w); }
        const float rstd = __builtin_amdgcn_rsqf(wave_sum(s) * (1.f / DM) + EPS);
        if (l == DEPTH - 1) { const GAS f32x4* g = (const GAS f32x4*)IN_F(19) + lane;
#pragma unroll
            for (int j = 0; j < 4; ++j) xr[64 * j] = v[j] * rstd * g[64 * j];
        } else {
            GAS u32x2* o8 = (GAS u32x2*)((bf16_t*)(ws + WS_XB) + (size_t)r * DM) + lane;
#pragma unroll
            for (int j = 0; j < 4; ++j) { u32x2 w; w.x = cvt_pk_bf16(v[j].x, v[j].y); w.y = cvt_pk_bf16(v[j].z, v[j].w); o8[64 * j] = w; }
            if (lane == 0) ((float*)(ws + WS_RSTD))[r] = rstd;
        }
#pragma unroll
        for (int j = 0; j < 4; ++j) { xv[j] = xn[j]; ya[j] = yan[j]; yb[j] = ybn[j]; }
        r = rn; rn = rnn; sn0 = snn0; sn1 = snn1;
    }
}

constexpr int NPHASE = 1 + 6 * DEPTH + (PROBE_P >= 0 ? PROBE_N - 1 : 0);
__global__ void __launch_bounds__(NTHR, 2) fwd(Args a) {
    extern __shared__ __attribute__((aligned(16))) unsigned char lds_raw[];
    Frame F;
    F.lds = (LAS unsigned char*)lds_raw; F.MISC = (volatile LAS unsigned*)(F.lds + MISC_OFF);
    F.tid = threadIdx.x; F.lane = F.tid & 63; F.wave = __builtin_amdgcn_readfirstlane(F.tid >> 6); const int wave_s = F.wave;
    F.G = gridDim.x; { const int bx = blockIdx.x; F.vcu = (F.G % 8 == 0) ? (bx % 8) * (F.G / 8) + bx / 8 : bx; }
    F.ws = a.ws; F.ctl = (gu32*)(a.ws + WS_CTL); F.out = a.out; F.z = 0;
    for (int u = F.tid; u < (LDS_BYTES - LDSCTL_OFF) / 4; u += NTHR) ((LAS unsigned*)(F.lds + LDSCTL_OFF))[u] = 0u;
    __syncthreads();
    XcdBarrier bar; bar.bar = (unsigned*)(F.ctl + CW_BAR); bar.x = 0; bar.st = nullptr;
    const bool one_launch = (a.ph_hi - a.ph_lo) > 1;
    if (one_launch) bar = xcd_barrier_post((unsigned*)(F.ctl + CW_BAR), F.MISC + 8);
    for (int pp = a.ph_lo; pp < a.ph_hi; ++pp) {
        int ph = pp;
        F.dry = 0;
        if (PROBE_P >= 0) { constexpr int P = PROBE_P; if (pp > P) ph = (pp - (PROBE_N - 1) > P) ? pp - (PROBE_N - 1) : P; if (ph == P && pp < P + PROBE_N - 1) F.dry = 1; }
        { int w_ = wave_s; asm volatile("" : "+s"(w_)); F.wave = w_; }
#define RETID_F() do { const int t_ = retid(F.wave); F.tid = t_; F.lane = t_ & 63; } while (0)
        size_t z_ = 0; asm volatile("" : "+s"(z_)); F.z = z_; F.ws = a.ws + z_; F.out = (float*)((char*)a.out + z_); F.ctl = (gu32*)(a.ws + z_ + WS_CTL);
        unsigned char* ws = F.ws; int bx = (int)blockIdx.x; asm volatile("" : "+s"(bx));
        { int g_ = (int)gridDim.x; asm volatile("" : "+s"(g_)); F.G = g_; }
        if (ph == 0) { RETID_F(); if (PHSEL(0)) ph_init(F, a); }
        else {
            const int l = (ph - 1) / 6, qq = (ph - 1) % 6, q = qq == 0 ? 0 : (qq == 1 ? 2 : (qq == 2 ? 4 : qq + 7));
            if (q == 0 && PHSEL(3)) {
                RETID_F();
                const bool g256 = (F.G == 256);
                const bool uni = g256 && __builtin_amdgcn_readfirstlane((int)F.MISC[10]) != 0; const int cb = uni ? (int)bar.x + 8 * __builtin_amdgcn_readfirstlane((int)F.MISC[11]) : bx;
                unsigned* pc = (unsigned*)(F.ctl + CW_PROJ + l * 4096);
                { pg8::SchedProj S{{64, 14, 896, F.G, cb, (const char*)(ws + WS_XB), (const char*)(ws + WS_WIN) + (size_t)l * NIN * DM * 2, (size_t)256 * DM * 2, (size_t)256 * DM * 2, 64, 0}, pc, pc + 2048, F.tid, uni, (l > 0 && one_launch) ? (const unsigned*)(F.ctl + CW_COMB + (l - 1) * 4096) : nullptr, g256 && ((cb >> 3) & 1)};
                  EpiProj E{(bf16_t*)(ws + A_HG), (bf16_t*)(ws + A_QR), (bf16_t*)(ws + A_KF1), (bf16_t*)(ws + A_V), (const float*)(ws + WS_RSTD), (const f32x2*)(ws + WS_CS), (unsigned*)(F.ctl + CW_KMAX + l * 16)};
                  pg8::gemm_phase<EpiProj, pg8::SchedProj, true, true, DM, DM>(F.lds, F.tid, S, E); }
                if (l == 0) {
                    { size_t z2 = 0; asm volatile("" : "+s"(z2)); ws = F.ws + z2; F.ws = ws; const int t2 = retid(F.wave); F.tid = t2; F.lane = t2 & 63; }
                    if (!g256 || (cb >= 128 && cb < 160)) { SchedKV SK{g256 ? 32 : F.G, g256 ? cb - 128 : bx, (const char*)(ws + WS_MEMN), (const char*)(ws + WS_WKVT)};
                        EpiKV EK{(bf16_t*)(ws + WS_KV), (bf16_t*)(ws + WS_KV) + (size_t)DEPTH * MEMROWS * DM};
                        pg8::gemm_phase<EpiKV, SchedKV, true, true, DM, DM>(F.lds, F.tid, SK, EK); }
                    if (!g256 || cb >= 160) conv_small_l1(F, a, g256 ? (cb - 160) * NWAVES + F.wave : F.vcu * NWAVES + F.wave, g256 ? 96 * NWAVES : F.G * NWAVES, 0);
                }
                { size_t z2 = 0; asm volatile("" : "+s"(z2)); ws = F.ws + z2; F.ws = ws; const int t2 = retid(F.wave); F.tid = t2; F.lane = t2 & 63; }
                hg_lbt_to_lds(F, l);
                {
                    constexpr int NU = BATCH * HGH * NCHUNK;
                    const int vx = cb & 7, vr = cb >> 3, EA = HGA_EARLY;
                    int na, j0; if (l == 0) { if (vr < 16) { na = 3; j0 = 3 * vr; } else if (vr < 20) { na = 2; j0 = 48 + 2 * (vr - 16); } else { na = 6; j0 = 56 + 6 * (vr - 20); } }
                    else if (vr >= 16) { na = EA; j0 = (vr - 16) * EA; } else { na = 8 - EA; j0 = 16 * EA + vr * (8 - EA); }
                    if (!g256) na = (NU - F.vcu + F.G - 1) / F.G;
                    auto unit_of = [&](int k) -> int { if (!g256) return F.vcu + k * F.G; const int j = j0 + k; return ((vx >> 2) << 9) | ((j & 3) << 7) | ((vx & 3) * 32 + (j >> 4) * 4 + ((j >> 2) & 3)); };
                    if (F.tid == 0) { if (l > 0 && one_launch) poll_ge((const unsigned*)(F.ctl + CW_COMB + (l - 1) * 4096) + 2048, (unsigned)F.G);
                        if (g256) { for (int p = j0 >> 4; p <= (j0 + na - 1) >> 4; ++p) poll_ge(pc + (8 * vx + p) * 32, 4u); } else for (int p = 0; p < 64; ++p) poll_ge(pc + p * 32, 4u);
                        __builtin_amdgcn_fence(__ATOMIC_ACQUIRE, "agent"); asm volatile("s_waitcnt vmcnt(0)" ::: "memory"); }
                    __syncthreads();
                    if (na > 0) { HgIn R = hg_load<false>(F, unit_of(0));
                        for (int k = 0; k < na; ++k) { const HgIn Rn = hg_load<false>(F, unit_of(k + 1 < na ? k + 1 : na - 1)); hg_a2_unit(F, a, l, unit_of(k), R); R = Rn; } }
                    __syncthreads();
                    if (F.tid == 0) { if (g256) { const int tb = 4 * vx + (vr >> 3); poll_ge(pc + 2048 + (2 * tb) * 32, 2u); poll_ge(pc + 2048 + (2 * tb + 1) * 32, 2u); } else for (int p = 0; p < 64; ++p) poll_ge(pc + 2048 + p * 32, 2u);
                        __builtin_amdgcn_fence(__ATOMIC_ACQUIRE, "agent"); asm volatile("s_waitcnt vmcnt(0)" ::: "memory"); }
                    __syncthreads();
                    if (g256) vf_unit(F, (4 * vx + (vr >> 3)) * 8 + (vr & 7)); else for (int u = F.vcu; u < (MT / 512) * ATH; u += F.G) vf_unit(F, u);
                }
            } else if (q == 2 && PHSEL(5)) {
                RETID_F();
                const bool g256 = (F.G == 256);
                const bool uni = g256 && __builtin_amdgcn_readfirstlane((int)F.MISC[10]) != 0; const int cb = uni ? (int)bar.x + 8 * __builtin_amdgcn_readfirstlane((int)F.MISC[11]) : bx;
                const int vx = cb & 7, vr = cb >> 3, vcu2 = g256 ? vx * 32 + vr : F.vcu;
                unsigned* sc = (unsigned*)(F.ctl + CW_SCAN + l * 512);
                hg_scan(F, vcu2);
                asm volatile("s_waitcnt vmcnt(0)" ::: "memory"); __syncthreads();
                if (F.tid == 0) { if (!uni) { __builtin_amdgcn_fence(__ATOMIC_RELEASE, "agent"); asm volatile("s_waitcnt vmcnt(0)" ::: "memory"); }
                    __hip_atomic_fetch_add(sc + (g256 ? vx * 32 : 0), 1u, __ATOMIC_RELAXED, __HIP_MEMORY_SCOPE_AGENT); }
                if (l == 0) {
                    { size_t z2 = 0; asm volatile("" : "+s"(z2)); ws = F.ws + z2; F.ws = ws; const int t2 = retid(F.wave); F.tid = t2; F.lane = t2 & 63; }
                    SchedFold SF{F.G, bx, (const char*)(ws + WS_KV), (const char*)(ws + WS_KV) + (size_t)DEPTH * MEMROWS * DM * 2, (const char*)(ws + WS_WQS), (const char*)(ws + WS_WOT)};
                    EpiFold EF{(bf16_t*)(ws + WS_WQK), DM, (size_t)DM * DM, 1.f};
                    pg8::gemm_phase<EpiFold, SchedFold, true, true, DM, 256>(F.lds, F.tid, SF, EF); }
                { size_t z2 = 0; asm volatile("" : "+s"(z2)); ws = F.ws + z2; F.ws = ws; const int t2 = retid(F.wave); F.tid = t2; F.lane = t2 & 63; }
#if ATT_GOLDEN
                for (int t = F.vcu * NWAVES + F.wave; t < (MT / 64) * ATH; t += F.G * NWAVES) att_task(F, t);
#else
                for (int u = vcu2; u < (MT / 512) * ATH; u += F.G) att_unit(F, l, u);
#endif
                __syncthreads();
                hg_lbt_to_lds(F, l);
                if (F.tid == 0) { poll_ge(sc + (g256 ? vx * 32 : 0), g256 ? 32u : (unsigned)F.G); __builtin_amdgcn_fence(__ATOMIC_ACQUIRE, "agent"); asm volatile("s_waitcnt vmcnt(0)" ::: "memory"); }
                __syncthreads();
                {
                    constexpr int NU = BATCH * HGH * NCHUNK; const int u0 = g256 ? (vx << 7) | (vr * 4) : F.vcu, ustep = g256 ? 1 : F.G, nu = g256 ? 4 : (NU - F.vcu + F.G - 1) / F.G;
                    if (nu > 0) { HgIn R = hg_load<true>(F, u0);
                        for (int k = 0; k < nu; ++k) { const int u = u0 + k * ustep; const HgIn Rn = hg_load<true>(F, k + 1 < nu ? u + ustep : u); hg_c2_unit<0>(F, a, l, u, R); R = Rn; } }
                    __syncthreads(); }
            } else if (q == 4 && PHSEL(7)) {
                RETID_F();
                unsigned* ch = (unsigned*)(F.ctl + CW_CHAIN + l * 8192);
                const bool uni = __builtin_amdgcn_readfirstlane((int)F.MISC[10]) != 0; const int cb = uni ? (int)bar.x + 8 * __builtin_amdgcn_readfirstlane((int)F.MISC[11]) : bx;
                { pg8::SchedChain S{{64, 4, 256, F.G, cb, (const char*)YMIX_PTR(l), (const char*)(ws + WS_WOUT) + (size_t)l * DM * DM * 2, (size_t)256 * DM * 2, (size_t)256 * DM * 2, 64, 0}, nullptr, F.tid, uni};
                  EpiResNorm E{IN_F(0), l == 0 ? nullptr : (const bf16_t*)(ws + WS_XB), (bf16_t*)(ws + A_XB2), (float*)(ws + WS_SSQP)};
                  pg8::gemm_phase<EpiResNorm, pg8::SchedChain, true, true, DM, DM>(F.lds, F.tid, S, E); S.signal(ch, retid(F.wave)); }
                { size_t z2 = 0; asm volatile("" : "+s"(z2)); ws = F.ws + z2; F.ws = ws; const int t2 = retid(F.wave); F.tid = t2; F.lane = t2 & 63; }
                { pg8::SchedChain S{{64, 4, 256, F.G, cb, (const char*)(ws + A_XB28), (const char*)(ws + WS_WQK) + (size_t)l * 2 * DM * DM, (size_t)256 * DM, (size_t)256 * DM, 32, (size_t)DM * DM}, ch, F.tid, uni};
                  EpiSoftmax E{(unsigned char*)(ws + A_P), (const float*)(ws + WS_SSQP)};
                  pg8::gemm_phase<EpiSoftmax, pg8::SchedChain, true, true, DM / 2, DM / 2, false, 0>(F.lds, F.tid, S, E); S.signal(ch + 2048, retid(F.wave)); }
                { size_t z2 = 0; asm volatile("" : "+s"(z2)); ws = F.ws + z2; F.ws = ws; const int t2 = retid(F.wave); F.tid = t2; F.lane = t2 & 63; }
                { pg8::SchedChain S{{64, 4, 256, F.G, cb, (const char*)(ws + A_P), (const char*)(ws + WS_WVO) + (size_t)l * 2 * DM * DM, (size_t)256 * DM, (size_t)256 * DM, 32, (size_t)DM * DM}, ch + 2048, F.tid, uni};
                  EpiResAddB E{(const bf16_t*)(ws + A_XB2), (bf16_t*)(ws + WS_XB), (unsigned char*)(ws + A_XB8), 1.f / (float)(1 << (P_SH + WVO_SH))};
                  pg8::gemm_phase<EpiResAddB, pg8::SchedChain, true, true, DM / 2, DM / 2, false, 0>(F.lds, F.tid, S, E); S.signal(ch + 4096, retid(F.wave)); }
                { size_t z2 = 0; asm volatile("" : "+s"(z2)); ws = F.ws + z2; F.ws = ws; const int t2 = retid(F.wave); F.tid = t2; F.lane = t2 & 63; }
                { int rt0 = -1; if (F.G == 256) { const int wgid = (cb & 7) * 32 + (cb >> 3); rt0 = 4 * ((wgid >> 5) * 8 + (wgid & 7)) + ((wgid & 31) >> 3); }
                  ph_router(F, a, l, ch + 4096, rt0, F.G == 256 && ((cb >> 3) & 1)); }
            } else if (q == 10 && PHSEL(13)) {
                RETID_F();
                moe_prefix(F, l);
                const int total = __builtin_amdgcn_readfirstlane((int)F.MISC[32]) * 4, early = (total / F.G) * F.G;
                SchedMoe S{F.G, bx, DM / 2, F.MISC + 16, (const char*)(ws + A_XB8), (const char*)(ws + A_WGU), (const int*)(ws + A_PERM2), (const unsigned*)(F.ctl + CW_CNT + l * 16 * 64), true, 1, early, total - early, nullptr};
                EpiMoe1 E{(unsigned char*)(ws + A_ACT8), (const float*)(ws + A_SRS2), (const float*)(ws + A_SGW2)};
                pg8::gemm_phase<EpiMoe1, SchedMoe, true, true, DM / 2, DM / 2, true, 0>(F.lds, F.tid, S, E);
            } else if (q == 11 && PHSEL(14)) {
                RETID_F();
                if (!one_launch) moe_prefix(F, l);
                const int total = __builtin_amdgcn_readfirstlane((int)F.MISC[32]) * 4, early = (total / F.G) * F.G, rem = total - early;
                unsigned* done = (unsigned*)(F.ctl + CW_DONE + l * 256);
                if (bx < rem) {
                    SchedMoe S{F.G, bx, DM / 2, F.MISC + 16, (const char*)(ws + A_XB8), (const char*)(ws + A_WGU), (const int*)(ws + A_PERM2), (const unsigned*)(F.ctl + CW_CNT + l * 16 * 64), true, 2, early, rem, nullptr};
                    EpiMoe1 E{(unsigned char*)(ws + A_ACT8), (const float*)(ws + A_SRS2), (const float*)(ws + A_SGW2)};
                    pg8::gemm_phase<EpiMoe1, SchedMoe, true, true, DM / 2, DM / 2, true, 0>(F.lds, F.tid, S, E);
                    if (retid(F.wave) == 0) { __builtin_amdgcn_fence(__ATOMIC_RELEASE, "agent"); asm volatile("s_waitcnt vmcnt(0)" ::: "memory"); __hip_atomic_fetch_add(done + ((early + bx) >> 2), 1u, __ATOMIC_RELAXED, __HIP_MEMORY_SCOPE_AGENT); }
                }
                { size_t z2 = 0; asm volatile("" : "+s"(z2)); ws = F.ws + z2; F.ws = ws; const int t2 = retid(F.wave); F.tid = t2; F.lane = t2 & 63; }
                SchedMoe S{F.G, bx, EFF / 2, F.MISC + 16, (const char*)(ws + A_ACT8), (const char*)(ws + A_WD), nullptr, nullptr, false, 3, early, rem, done};
                EpiY8 E{(unsigned char*)(ws + A_Y), DM, (float)(1 << Y_SH) / (float)(1 << (WD_SH + ACT_SH))};
                pg8::gemm_phase<EpiY8, SchedMoe, true, true, EFF / 2, EFF / 2, false, 0>(F.lds, F.tid, S, E);
                if (l == 0 && DEPTH > 1) {
                    { size_t z2 = 0; asm volatile("" : "+s"(z2)); ws = F.ws + z2; F.ws = ws; const int t2 = retid(F.wave); F.tid = t2; F.lane = t2 & 63; }
                    int s0 = 3 * rem; if (s0 > F.G - 64) s0 = 0;
                    if (bx >= s0) conv_small_l1(F, a, (bx - s0) * NWAVES + F.wave, (F.G - s0) * NWAVES, 1); }
            } else if (q == 12 && PHSEL(15)) {
                RETID_F();
                const bool g256 = (F.G == 256);
                const bool uni = g256 && __builtin_amdgcn_readfirstlane((int)F.MISC[10]) != 0; const int cb = uni ? (int)bar.x + 8 * __builtin_amdgcn_readfirstlane((int)F.MISC[11]) : bx;
                const int vx = cb & 7, vr = cb >> 3, gw = F.vcu * NWAVES + F.wave, NGW = F.G * NWAVES;
                if (g256) ph_combine(F, a, l, 2048 * vx + 64 * vr + 8 * F.wave, 1, 8, one_launch); else ph_combine(F, a, l, gw, NGW, (MT - gw + NGW - 1) / NGW, one_launch);
                if (l < DEPTH - 1) { asm volatile("s_waitcnt vmcnt(0)" ::: "memory"); __syncthreads();
                    if (F.tid == 0) { unsigned* cc = (unsigned*)(F.ctl + CW_COMB + l * 4096);
                        if (!uni) { __builtin_amdgcn_fence(__ATOMIC_RELEASE, "agent"); asm volatile("s_waitcnt vmcnt(0)" ::: "memory"); }
                        if (g256) __hip_atomic_fetch_add(cc + (8 * vx + (vr >> 2)) * 32, 1u, __ATOMIC_RELAXED, __HIP_MEMORY_SCOPE_AGENT);
                        __hip_atomic_fetch_add(cc + 2048, 1u, __ATOMIC_RELAXED, __HIP_MEMORY_SCOPE_AGENT); } }
            }
        }
        if (pp + 1 < a.ph_hi && !(ph > 0 && (ph - 1) % 6 == 5 && (ph - 1) / 6 < DEPTH - 1)) xcd_barrier(bar, retid(F.wave));
    }
}

extern "C" void kernel_launch(void* const* d_in, const int* in_sizes, int n_in, void* d_out, int out_size, void* d_ws, size_t ws_size, hipStream_t stream) {
    static int grid = 0;
    if (grid == 0) {
        if (n_in != 20 || in_sizes[0] != MT * DM || out_size != MT * DM || ws_size < WS_END) { fprintf(stderr, "kernel_launch: unexpected shapes / workspace (%d inputs, ws %zu)\n", n_in, ws_size); grid = -1; return; }
        int dev = 0, cus = 0, per_cu = 0;
        if (hipGetDevice(&dev) != hipSuccess || hipDeviceGetAttribute(&cus, hipDeviceAttributeMultiprocessorCount, dev) != hipSuccess) { grid = -1; return; }
        if (hipFuncSetAttribute((const void*)fwd, hipFuncAttributeMaxDynamicSharedMemorySize, LDS_BYTES) != hipSuccess) { grid = -1; return; }
        if (hipOccupancyMaxActiveBlocksPerMultiprocessor(&per_cu, (const void*)fwd, NTHR, LDS_BYTES) != hipSuccess || per_cu < 1) { fprintf(stderr, "kernel_launch: occupancy query says %d\n", per_cu); per_cu = 1; }
        (void)hipGetLastError();
        grid = cus * 1;
    }
    if (grid < 0) return;
    (void)hipMemsetAsync((char*)d_ws + WS_CTL, 0, CTL_ZERO_BYTES, stream);
    Args a{};
    for (int i = 0; i < 20; ++i) a.in[i] = d_in[i];
    a.out = (float*)d_out; a.ws = (unsigned char*)d_ws;
#if MK_PER_PHASE
    for (int ph = 0; ph < NPHASE; ++ph) { a.ph_lo = ph; a.ph_hi = ph + 1; hipLaunchKernelGGL(fwd, dim3(grid), dim3(NTHR), LDS_BYTES, stream, a); }
#else
    a.ph_lo = 0; a.ph_hi = NPHASE;
    void* kargs[] = {&a};
    hipError_t e = hipLaunchCooperativeKernel((const void*)fwd, dim3(grid), dim3(NTHR), kargs, LDS_BYTES, stream);
    if (e != hipSuccess) fprintf(stderr, "cooperative launch failed: %s (grid %d)\n", hipGetErrorString(e), grid);
#endif
}
```
